# Optimizing an MI355X kernel written in HIP

```python
import math
import jax, jax.numpy as jnp
from jax import lax
import numpy as np

D_MODEL = 1024
BATCH = 16
SEQ = 2048
DEPTH = 1

CTX_LEN = 256
GRID_W = 64
A_HEADS = 4
A_DK = 128
A_DV = 128
A_KW = A_HEADS * A_DK
A_VW = A_HEADS * A_DV
A_CHUNK = 64
B_WIDTH = 512
HYENA_ORDER = 2
HYENA_SHORT = 3
HYENA_EMB = 33
HYENA_BANDS = (HYENA_EMB - 1) // 2
HYENA_FFN = 64
HYENA_FAST_DECAY = 0.3
HYENA_SLOW_DECAY = 1.5
HYENA_TARGET = 1e-2
HYENA_SHIFT = 0.05
HYENA_L1_EPS = 1e-6
D_FF = 2816
N_MOD = 9
RMS_EPS = 1e-6
COL_V = 0
COL_FFW = COL_V + A_VW
COL_FBW = COL_FFW + A_KW
COL_Q = COL_FBW + A_KW
COL_G = COL_Q + A_KW
COL_HY = COL_G + A_VW
COL_MERGE = COL_HY + 3 * B_WIDTH
IN_COLS = COL_MERGE + 2 * D_MODEL

kernel_name = 'hgrn2_hyena_macaron_dit_layer'


def rms_norm(x):
    xf = x.astype(jnp.float32)
    return (xf * lax.rsqrt(jnp.mean(xf * xf, axis=-1, keepdims=True) + RMS_EPS)).astype(x.dtype)


def modulate(x, shift, scale):
    return x * (1.0 + scale) + shift


def swiglu(x, wg, wu, wd):
    return (jax.nn.silu(x @ wg) * (x @ wu)) @ wd


def half_ffn(h, shift, scale, gate, wg, wu, wd):
    return h + 0.5 * gate * swiglu(modulate(rms_norm(h), shift, scale), wg, wu, wd)


def grid_pos_embed(n_tokens):
    rows = n_tokens // GRID_W
    quarter = D_MODEL // 4
    omega = 1.0 / (10000.0 ** (jnp.arange(quarter, dtype=jnp.float32) / quarter))
    ar = jnp.arange(rows, dtype=jnp.float32)[:, None] * omega
    ac = jnp.arange(GRID_W, dtype=jnp.float32)[:, None] * omega
    er = jnp.concatenate([jnp.sin(ar), jnp.cos(ar)], axis=-1)
    ec = jnp.concatenate([jnp.sin(ac), jnp.cos(ac)], axis=-1)
    emb = jnp.concatenate([jnp.broadcast_to(er[:, None, :], (rows, GRID_W, D_MODEL // 2)),
                           jnp.broadcast_to(ec[None, :, :], (rows, GRID_W, D_MODEL // 2))], axis=-1)
    return emb.reshape(rows * GRID_W, D_MODEL)


def to_heads(a):
    b, l, w = a.shape
    return a.reshape(b, l, A_HEADS, w // A_HEADS).transpose(0, 2, 1, 3)


def hgrn2_forget(z, lb):
    f = lb + (1.0 - lb) * jax.nn.sigmoid(z.astype(jnp.float32))
    return to_heads(jnp.log(f)), to_heads(1.0 - f)


def hgrn2_chunk_scan(q, k, v, logf, s0):
    b, h, l, dk = q.shape
    n_chunks = l // A_CHUNK

    def to_chunks(a):
        return a.reshape(b, h, n_chunks, A_CHUNK, a.shape[-1]).transpose(2, 0, 1, 3, 4)

    within_scan = jnp.tril(jnp.ones((A_CHUNK, A_CHUNK), dtype=bool))[:, :, None]

    def step(s, inp):
        qb, kb, vb, gb = inp
        cum = jnp.cumsum(gb, axis=2)
        diff = cum[:, :, :, None, :] - cum[:, :, None, :, :]
        decay = jnp.exp(jnp.where(within_scan, diff, -jnp.inf))
        scores = jnp.einsum('bhtsd,bhsd->bhts', qb[:, :, :, None, :] * decay, kb)
        o = scores @ vb + (qb * jnp.exp(cum)) @ s
        last = cum[:, :, -1:, :]
        s_new = jnp.exp(last[:, :, 0, :])[..., None] * s + jnp.einsum('bhsd,bhse->bhde', kb * jnp.exp(last - cum), vb)
        return s_new, o

    s_final, oc = lax.scan(step, s0, (to_chunks(q), to_chunks(k), to_chunks(v), to_chunks(logf)))
    o = oc.transpose(1, 2, 0, 3, 4).reshape(b, h, l, v.shape[-1])
    return o, s_final


def hgrn2_final_state(k, v, logf):
    cum = jnp.cumsum(logf, axis=2)
    return jnp.einsum('bhld,bhle->bhde', k * jnp.exp(cum[:, :, -1:, :] - cum), v)


def flip_seq(a):
    return jnp.flip(a, axis=2)


def hgrn2_bidir(q, v, logf_fw, k_fw, logf_bw, k_bw, s0_fw, s0_bw):
    o_fw, s_fw = hgrn2_chunk_scan(q, k_fw, v, logf_fw, s0_fw)
    o_bw, s_bw = hgrn2_chunk_scan(flip_seq(q), flip_seq(k_bw), flip_seq(v), flip_seq(logf_bw), s0_bw)
    return o_fw + flip_seq(o_bw), s_fw, s_bw


def context_states(nc, w_in, lb):
    p = nc @ w_in[:, :COL_Q]
    v = to_heads(p[..., COL_V:COL_FFW]).astype(jnp.float32)
    logf_fw, k_fw = hgrn2_forget(p[..., COL_FFW:COL_FBW], lb[0])
    logf_bw, k_bw = hgrn2_forget(p[..., COL_FBW:COL_Q], lb[1])
    s_fw = hgrn2_final_state(k_fw, v, logf_fw)
    s_bw = hgrn2_final_state(flip_seq(k_bw), flip_seq(v), flip_seq(logf_bw))
    return s_fw, s_bw


def short_conv(u, w, bias):
    l = u.shape[1]
    pad = HYENA_SHORT // 2
    up = jnp.pad(u, ((0, 0), (pad, pad), (0, 0)))
    out = bias
    for j in range(HYENA_SHORT):
        out = out + up[:, j:j + l] * w[j]
    return out


def hyena_pos_features(l):
    p = jnp.arange(l, dtype=jnp.float32)
    t = p / (l - 1)
    w = 2.0 * math.pi * p / l
    f = jnp.linspace(1e-4, HYENA_BANDS - 1, HYENA_BANDS, dtype=jnp.float32)
    ang = w[:, None] * f[None, :]
    z = jnp.concatenate([t[:, None], jnp.cos(ang), -jnp.sin(ang)], axis=-1)
    return t, z


def hyena_kernels(l, w1, b1, fr1, w2, b2, fr2, w3):
    t, z = hyena_pos_features(l)
    h = jnp.sin(fr1 * (z @ w1 + b1))
    h = jnp.sin(fr2 * (h @ w2 + b2))
    h = (h @ w3).astype(jnp.float32).reshape(l, HYENA_ORDER, 2, B_WIDTH)
    max_decay = math.log(HYENA_TARGET) / HYENA_FAST_DECAY
    min_decay = math.log(HYENA_TARGET) / HYENA_SLOW_DECAY
    deltas = jnp.abs(jnp.linspace(min_decay, max_decay, B_WIDTH, dtype=jnp.float32))
    window = jnp.exp(-t[:, None] * deltas[None, :]) + HYENA_SHIFT
    h = h * window[:, None, None, :]
    kern = jnp.concatenate([h[:, :, 0], jnp.flip(h[:, :, 1], axis=0)], axis=0)
    return kern / (jnp.sum(jnp.abs(kern), axis=0, keepdims=True) + HYENA_L1_EPS)


def fft_conv(u, kern):
    l = u.shape[1]
    uf = jnp.fft.rfft(u.astype(jnp.float32), n=2 * l, axis=1)
    kf = jnp.fft.rfft(kern, n=2 * l, axis=0)
    return jnp.fft.irfft(uf * kf[None], n=2 * l, axis=1)[:, :l]


def hyena(u3, kern, hy_bias):
    v, x1, x2 = jnp.split(u3, 3, axis=-1)
    z = v
    for o, gate in enumerate((x1, x2)):
        z = gate * (fft_conv(z, kern[:, o]).astype(z.dtype) + hy_bias[o] * z)
    return z


def token_mixers(n, s0_fw, s0_bw, kern, w_in, lb, a_norm_w, conv_w, conv_b, hy_bias, w_pa, w_pb, w_out):
    b, l, _ = n.shape
    p = n @ w_in
    v = to_heads(p[..., COL_V:COL_FFW]).astype(jnp.float32)
    logf_fw, k_fw = hgrn2_forget(p[..., COL_FFW:COL_FBW], lb[0])
    logf_bw, k_bw = hgrn2_forget(p[..., COL_FBW:COL_Q], lb[1])
    q = to_heads(jax.nn.silu(p[..., COL_Q:COL_G])).astype(jnp.float32)
    o, s_fw, s_bw = hgrn2_bidir(q, v, logf_fw, k_fw, logf_bw, k_bw, s0_fw, s0_bw)
    o = rms_norm(o.transpose(0, 2, 1, 3)) * a_norm_w
    o_a = o.reshape(b, l, A_VW).astype(n.dtype) * jax.nn.silu(p[..., COL_G:COL_HY])
    u3 = short_conv(p[..., COL_HY:COL_MERGE], conv_w, conv_b)
    o_b = hyena(u3, kern, hy_bias)
    g_a, g_b = jnp.split(p[..., COL_MERGE:], 2, axis=-1)
    y = jax.nn.sigmoid(g_a) * (o_a @ w_pa) + jax.nn.sigmoid(g_b) * (o_b @ w_pb)
    return y @ w_out, s_fw, s_bw


def setup_inputs(seed: int = 0) -> dict:
    key = jax.random.key(seed)
    ks = jax.random.split(key, 32)
    nrm = jax.random.normal
    f32 = jnp.float32
    d = D_MODEL
    return {
        'x': nrm(ks[0], (BATCH, SEQ, d), f32),
        'c': nrm(ks[1], (BATCH, d), f32),
        'ctx': nrm(ks[2], (BATCH, CTX_LEN, d), f32),
        'c_ctx': nrm(ks[3], (d,), f32),
        'mod_w': nrm(ks[4], (DEPTH, d, N_MOD * d), f32) * d ** -0.5,
        'mod_b': nrm(ks[5], (DEPTH, N_MOD * d), f32) * 0.01,
        'ffn_w_gate': nrm(ks[6], (DEPTH, 2, d, D_FF), f32) * d ** -0.5,
        'ffn_w_up': nrm(ks[7], (DEPTH, 2, d, D_FF), f32) * d ** -0.5,
        'ffn_w_down': nrm(ks[8], (DEPTH, 2, D_FF, d), f32) * D_FF ** -0.5,
        'w_in': nrm(ks[9], (DEPTH, d, IN_COLS), f32) * d ** -0.5,
        'hgrn_lb_logits': nrm(ks[10], (DEPTH + 1, 2, A_KW), f32) * 0.1,
        'hgrn_norm_w': 1.0 + 0.1 * nrm(ks[11], (DEPTH, A_DV), f32),
        'hyena_conv_w': nrm(ks[12], (DEPTH, HYENA_SHORT, 3 * B_WIDTH), f32) * HYENA_SHORT ** -0.5,
        'hyena_conv_b': nrm(ks[13], (DEPTH, 3 * B_WIDTH), f32) * 0.01,
        'hyena_w1': nrm(ks[14], (DEPTH, HYENA_EMB, HYENA_FFN), f32) * HYENA_EMB ** -0.5,
        'hyena_b1': nrm(ks[15], (DEPTH, HYENA_FFN), f32) * 0.1,
        'hyena_freq1': 1.0 + 0.1 * nrm(ks[16], (DEPTH, HYENA_FFN), f32),
        'hyena_w2': nrm(ks[17], (DEPTH, HYENA_FFN, HYENA_FFN), f32) * HYENA_FFN ** -0.5,
        'hyena_b2': nrm(ks[18], (DEPTH, HYENA_FFN), f32) * 0.1,
        'hyena_freq2': 1.0 + 0.1 * nrm(ks[19], (DEPTH, HYENA_FFN), f32),
        'hyena_w3': nrm(ks[20], (DEPTH, HYENA_FFN, HYENA_ORDER * 2 * B_WIDTH), f32) * HYENA_FFN ** -0.5,
        'hyena_bias': nrm(ks[21], (DEPTH, HYENA_ORDER, B_WIDTH), f32),
        'w_proj_a': nrm(ks[22], (DEPTH, A_VW, d), f32) * A_VW ** -0.5,
        'w_proj_b': nrm(ks[23], (DEPTH, B_WIDTH, d), f32) * B_WIDTH ** -0.5,
        'w_out': nrm(ks[24], (DEPTH, d, d), f32) * d ** -0.5,
        'final_norm_w': 1.0 + 0.1 * nrm(ks[25], (d,), f32),
    }


def reference(x, c, ctx, c_ctx, mod_w, mod_b, ffn_w_gate, ffn_w_up, ffn_w_down, w_in, hgrn_lb_logits,
              hgrn_norm_w, hyena_conv_w, hyena_conv_b, hyena_w1, hyena_b1, hyena_freq1, hyena_w2, hyena_b2,
              hyena_freq2, hyena_w3, hyena_bias, w_proj_a, w_proj_b, w_out, final_norm_w):
    n_lat = x.shape[1]
    n_ctx = ctx.shape[1]
    h = x + grid_pos_embed(n_lat).astype(x.dtype)[None]
    hc = ctx
    lb_all = jnp.cumsum(jax.nn.softmax(hgrn_lb_logits.astype(jnp.float32), axis=0), axis=0)
    for l in range(DEPTH):
        last = l == DEPTH - 1
        m = jnp.split((jax.nn.silu(c) @ mod_w[l] + mod_b[l])[:, None, :], N_MOD, axis=-1)
        mc = jnp.split((jax.nn.silu(c_ctx) @ mod_w[l] + mod_b[l])[None, None, :], N_MOD, axis=-1)
        h = half_ffn(h, m[0], m[1], m[2], ffn_w_gate[l, 0], ffn_w_up[l, 0], ffn_w_down[l, 0])
        hc = half_ffn(hc, mc[0], mc[1], mc[2], ffn_w_gate[l, 0], ffn_w_up[l, 0], ffn_w_down[l, 0])
        n = modulate(rms_norm(h), m[3], m[4])
        nc = modulate(rms_norm(hc), mc[3], mc[4])
        mix_w = (w_in[l], lb_all[l], hgrn_norm_w[l], hyena_conv_w[l], hyena_conv_b[l], hyena_bias[l],
                 w_proj_a[l], w_proj_b[l], w_out[l])
        filt_w = (hyena_w1[l], hyena_b1[l], hyena_freq1[l], hyena_w2[l], hyena_b2[l], hyena_freq2[l], hyena_w3[l])
        if last:
            s_fw, s_bw = context_states(nc, w_in[l], lb_all[l])
        else:
            zeros = jnp.zeros((hc.shape[0], A_HEADS, A_DK, A_DV), jnp.float32)
            out_c, s_fw, s_bw = token_mixers(nc, zeros, zeros, hyena_kernels(n_ctx, *filt_w), *mix_w)
            hc = hc + mc[5] * out_c
            hc = half_ffn(hc, mc[6], mc[7], mc[8], ffn_w_gate[l, 1], ffn_w_up[l, 1], ffn_w_down[l, 1])
        out, _, _ = token_mixers(n, s_fw, s_bw, hyena_kernels(n_lat, *filt_w), *mix_w)
        h = h + m[5] * out
        h = half_ffn(h, m[6], m[7], m[8], ffn_w_gate[l, 1], ffn_w_up[l, 1], ffn_w_down[l, 1])
    return rms_norm(h) * final_norm_w
```

```cpp
#include <hip/hip_runtime.h>
#include <hip/hip_cooperative_groups.h>
#include <cstdio>
namespace cg = cooperative_groups;

#ifndef N_LAUNCH_MODE
#define N_LAUNCH_MODE 0
#endif
#ifndef USE_PG8
#define USE_PG8 0
#endif

#define LAS __attribute__((address_space(3)))
typedef unsigned short bf16_t;
typedef _Float16 f16_t;
typedef float f32x4 __attribute__((ext_vector_type(4)));
typedef unsigned u32x4 __attribute__((ext_vector_type(4)));
typedef unsigned u32x2 __attribute__((ext_vector_type(2)));

constexpr int D = 1024, NB = 16, SEQ = 2048, T = NB * SEQ, CL = 256, TC = NB * CL, MT = T + TC;
constexpr int DFF = 2816, NGU = 2 * DFF, NIN = 6144, MODW = 9 * D;
constexpr int AKW = 512, AVW = 512, BW = 512, NHY = 3 * BW;
constexpr int KR_LEN = 4128, KR_OFF = 2056;
constexpr float RMS_EPS = 1e-6f;
constexpr int NTHR = 512, NWAVES = 8;
constexpr int LDS_BYTES = 152 * 1024;

constexpr size_t MiB = 1024 * 1024;
constexpr size_t al256(size_t x) { return (x + 255) & ~(size_t)255; }
constexpr size_t WS_CTL = 0;
constexpr size_t WS_MODV = WS_CTL + 65536;
constexpr size_t WS_SWIN = WS_MODV + al256((size_t)17 * MODW * 4);
constexpr size_t WS_SW2 = WS_SWIN + al256((size_t)17 * NIN * 4);
constexpr size_t WS_ER = WS_SW2 + al256((size_t)17 * NGU * 4);
constexpr size_t WS_EC = WS_ER + 32 * 512 * 4;
constexpr size_t WS_LBV = WS_EC + 64 * 512 * 4;
constexpr size_t WS_H2 = WS_LBV + 4096;
constexpr size_t WS_KREV = WS_H2 + 2048 * 64 * 4;
constexpr size_t WS_WIN_T = WS_KREV + al256((size_t)2 * 512 * KR_LEN * 2);
constexpr size_t WS_WPA_T = WS_WIN_T + (size_t)NIN * D * 2;
constexpr size_t WS_WPB_T = WS_WPA_T + (size_t)D * 512 * 2;
constexpr size_t WS_WOUT_T = WS_WPB_T + (size_t)D * 512 * 2;
constexpr size_t WS_PERSIST_END = WS_WOUT_T + (size_t)D * D * 2;
constexpr size_t AR = 27 * MiB;
static_assert(WS_PERSIST_END <= AR, "persistent region");
constexpr size_t WS_HID = AR + 0 * MiB;
constexpr size_t WS_N1 = AR + 198 * MiB;
constexpr size_t WS_WG1_T = AR + 270 * MiB;
constexpr size_t WS_WD1_T = AR + 281 * MiB;
constexpr size_t WS_SSQ1 = AR + 410 * MiB;
constexpr size_t WS_A2 = AR + 413 * MiB;
constexpr size_t WS_GAB = AR + 0 * MiB;
constexpr size_t WS_V = AR + 128 * MiB;
constexpr size_t WS_LFW = AR + 164 * MiB;
constexpr size_t WS_LBW = AR + 200 * MiB;
constexpr size_t WS_Q = AR + 236 * MiB;
constexpr size_t WS_G = AR + 268 * MiB;
constexpr size_t WS_HY = AR + 300 * MiB;
constexpr size_t WS_WG2_T = AR + 436 * MiB;
constexpr size_t WS_WD2_T = AR + 447 * MiB;
constexpr size_t WS_ZB = AR + 453 * MiB;
constexpr size_t WS_OFW = AR + 300 * MiB;
constexpr size_t WS_OBW = AR + 364 * MiB;
constexpr size_t WS_OA = AR + 128 * MiB;
constexpr size_t WS_OB = AR + 160 * MiB;
constexpr size_t WS_YTMP = AR + 192 * MiB;
constexpr size_t WS_Y = AR + 320 * MiB;
constexpr size_t WS_A3 = AR + 0 * MiB;
constexpr size_t WS_SSQ2 = AR + 64 * MiB;
constexpr size_t WS_SSQ3 = AR + 66 * MiB;
constexpr size_t WS_HID2 = AR + 128 * MiB;
constexpr size_t WS_TOTAL = AR + 485 * MiB;

struct Params {
    const float *x, *c, *ctx, *c_ctx, *mod_w, *mod_b, *ffn_wg, *ffn_wu, *ffn_wd, *w_in, *lb_logits, *a_norm_w, *conv_w, *conv_b;
    const float *hw1, *hb1, *hfr1, *hw2, *hb2, *hfr2, *hw3, *hy_bias, *w_pa, *w_pb, *w_out, *fnw;
    float* out; unsigned char* ws;
    int ph_lo, ph_hi;
};

__device__ __forceinline__ float bf2f(bf16_t b) { return __uint_as_float(((unsigned)b) << 16); }
__device__ __forceinline__ bf16_t f2bf(float f) { unsigned u = __float_as_uint(f); u += 0x7FFFu + ((u >> 16) & 1u); return (bf16_t)(u >> 16); }
__device__ __forceinline__ unsigned pk2(float lo, float hi) { return (unsigned)f2bf(lo) | ((unsigned)f2bf(hi) << 16); }
__device__ __forceinline__ float bfround(float f) { return bf2f(f2bf(f)); }
__device__ __forceinline__ float sigmoidf_(float x) { return 1.0f / (1.0f + __expf(-x)); }
__device__ __forceinline__ float siluf_(float x) { return x / (1.0f + __expf(-x)); }
__device__ __forceinline__ float wave_sum(float v) {
#pragma unroll
    for (int o = 1; o < 64; o <<= 1) v += __shfl_xor(v, o);
    return v;
}
__device__ __forceinline__ float pos_embed(const float* er, const float* ec, int t, int col) {
    return col < 512 ? er[(t >> 6) * 512 + col] : ec[(t & 63) * 512 + (col - 512)];
}
__device__ __forceinline__ float rstd_from_ssq(const float* ssq16) {
    const f32x4* s = (const f32x4*)ssq16; float tot = 0.f;
#pragma unroll
    for (int i = 0; i < 4; ++i) { const f32x4 v = s[i]; tot += (v[0] + v[1]) + (v[2] + v[3]); }
    return 1.0f / sqrtf(tot * (1.0f / D) + RMS_EPS);
}

__device__ __forceinline__ void transpose_item(const float* W, int K, int N, bf16_t* WT, int k0, int n0, int dst_row0, LAS float* scr, int lane) {
#pragma unroll 8
    for (int i = 0; i < 32; ++i) { const int kk = 2 * i + (lane >> 5); scr[kk * 33 + (lane & 31)] = W[(size_t)(k0 + kk) * N + n0 + (lane & 31)]; }
    asm volatile("s_waitcnt lgkmcnt(0)" ::: "memory");
    const int c = lane & 7;
#pragma unroll
    for (int j = 0; j < 4; ++j) { const int n = (lane >> 3) + 8 * j; const LAS float* s = scr + (8 * c) * 33 + n;
        u32x4 o; o.x = pk2(s[0 * 33], s[1 * 33]); o.y = pk2(s[2 * 33], s[3 * 33]); o.z = pk2(s[4 * 33], s[5 * 33]); o.w = pk2(s[6 * 33], s[7 * 33]);
        *(u32x4*)(WT + (size_t)(dst_row0 + n) * K + k0 + 8 * c) = o; }
    asm volatile("s_waitcnt lgkmcnt(0)" ::: "memory");
}
__device__ __forceinline__ void transpose_matrix(const float* W, int K, int N, bf16_t* WT, LAS float* scr, int gw, int ngw, int lane) {
    const int nblk = N / 32, items = (K / 64) * nblk;
    for (int it = gw; it < items; it += ngw) { const int kb = it / nblk, nb = it % nblk; transpose_item(W, K, N, WT, 64 * kb, 32 * nb, 32 * nb, scr, lane); }
}
__device__ __forceinline__ void transpose_gu(const float* W, int half, bf16_t* WT, LAS float* scr, int gw, int ngw, int lane) {
    const int nblk = DFF / 32, items = (D / 64) * nblk;
    for (int it = gw; it < items; it += ngw) { const int kb = it / nblk, nb = it % nblk, n0 = 32 * nb;
        transpose_item(W, D, DFF, WT, 64 * kb, n0, 256 * (n0 >> 7) + 128 * half + (n0 & 127), scr, lane); }
}

template <bool GU>
__device__ __forceinline__ void gemv17(const LAS float* xs, LAS float* part, const float* W, int N, const float* bias, float* out, int ldo, int half, int blk0, int nblk_stride) {
    const int tid = threadIdx.x, wid = tid >> 6, lane = tid & 63;
    for (int cb = blk0; cb < N / 64; cb += nblk_stride) {
        const int n = cb * 64 + lane;
        float acc[17];
#pragma unroll
        for (int r = 0; r < 17; ++r) acc[r] = 0.f;
        const float* wp = W + (size_t)(wid * 128) * N + n;
#pragma unroll 4
        for (int k = 0; k < 128; ++k) { const float w = wp[(size_t)k * N];
#pragma unroll
            for (int r = 0; r < 17; ++r) acc[r] += xs[r * 1024 + wid * 128 + k] * w; }
#pragma unroll
        for (int r = 0; r < 17; ++r) part[(wid * 17 + r) * 64 + lane] = acc[r];
        __syncthreads();
        for (int o = tid; o < 17 * 64; o += NTHR) { const int r = o >> 6, l = o & 63; float s = 0.f;
#pragma unroll
            for (int w = 0; w < 8; ++w) s += part[(w * 17 + r) * 64 + l];
            const int nn = cb * 64 + l; if (bias) s += bias[nn];
            const int on = GU ? (256 * (nn >> 7) + 128 * half + (nn & 127)) : nn;
            out[(size_t)r * ldo + on] = s; }
        __syncthreads();
    }
}

__device__ __forceinline__ void store_bf16x8(bf16_t* p, const float (&v)[8]) { u32x4 w; w.x = pk2(v[0], v[1]); w.y = pk2(v[2], v[3]); w.z = pk2(v[4], v[5]); w.w = pk2(v[6], v[7]); *(u32x4*)p = w; }
__device__ __forceinline__ void load_f32x8(const float* p, float (&v)[8]) { const f32x4 a = *(const f32x4*)p, b = *(const f32x4*)(p + 4); v[0] = a[0]; v[1] = a[1]; v[2] = a[2]; v[3] = a[3]; v[4] = b[0]; v[5] = b[1]; v[6] = b[2]; v[7] = b[3]; }
__device__ __forceinline__ void store_f32x8(float* p, const float (&v)[8]) { *(f32x4*)p = (f32x4){v[0], v[1], v[2], v[3]}; *(f32x4*)(p + 4) = (f32x4){v[4], v[5], v[6], v[7]}; }
__device__ __forceinline__ void load_bf16x8(const bf16_t* p, float (&v)[8]) { const u32x4 w = *(const u32x4*)p; v[0] = __uint_as_float(w.x << 16); v[1] = __uint_as_float(w.x & 0xffff0000u); v[2] = __uint_as_float(w.y << 16); v[3] = __uint_as_float(w.y & 0xffff0000u);
    v[4] = __uint_as_float(w.z << 16); v[5] = __uint_as_float(w.z & 0xffff0000u); v[6] = __uint_as_float(w.w << 16); v[7] = __uint_as_float(w.w & 0xffff0000u); }

struct EpiGateUp1 {
    bf16_t* hid;
    __device__ __forceinline__ float apply(int row, int pn, int c, const float (&v0)[8], const float (&v1)[8]) const {
        float o[8];
#pragma unroll
        for (int j = 0; j < 8; ++j) o[j] = siluf_(v0[j]) * v1[j];
        store_bf16x8(hid + (size_t)row * DFF + 128 * pn + c, o); return 0.f; }
};
struct EpiGateUp2 {
    bf16_t* hid; const float* ssq; const float* sw;
    __device__ __forceinline__ float apply(int row, int pn, int c, const float (&v0)[8], const float (&v1)[8]) const {
        const float rs = rstd_from_ssq(ssq + (size_t)row * 16); const int b = row >> 11;
        float s0[8], s1[8], o[8]; load_f32x8(sw + (size_t)b * NGU + 256 * pn + c, s0); load_f32x8(sw + (size_t)b * NGU + 256 * pn + 128 + c, s1);
#pragma unroll
        for (int j = 0; j < 8; ++j) o[j] = siluf_(rs * v0[j] + s0[j]) * (rs * v1[j] + s1[j]);
        store_bf16x8(hid + (size_t)row * DFF + 128 * pn + c, o); return 0.f; }
};
struct EpiDown1 {
    const float *x, *ctx, *er, *ec, *modv; float* hout; bf16_t* a2;
    __device__ __forceinline__ float half_(int row, int col, const float (&v)[8]) const {
        const bool lat = row < T; const int b = lat ? (row >> 11) : 16, t = row & (SEQ - 1);
        float base[8], m2[8], m4[8], h[8], a[8];
        if (lat) { load_f32x8(x + (size_t)row * D + col, base);
#pragma unroll
            for (int j = 0; j < 8; ++j) base[j] += pos_embed(er, ec, t, col + j); }
        else load_f32x8(ctx + (size_t)(row - T) * D + col, base);
        load_f32x8(modv + (size_t)b * MODW + 2 * D + col, m2); load_f32x8(modv + (size_t)b * MODW + 4 * D + col, m4);
        float s = 0.f;
#pragma unroll
        for (int j = 0; j < 8; ++j) { h[j] = base[j] + 0.5f * m2[j] * v[j]; s += h[j] * h[j]; a[j] = h[j] * (1.0f + m4[j]); }
        if (lat) store_f32x8(hout + (size_t)row * D + col, h);
        store_bf16x8(a2 + (size_t)row * D + col, a); return s; }
    __device__ __forceinline__ float apply(int row, int pn, int c, const float (&v0)[8], const float (&v1)[8]) const { return half_(row, 256 * pn + c, v0) + half_(row, 256 * pn + 128 + c, v1); }
};
struct EpiWin {
    const float *ssq, *sw, *lbv; bf16_t *v, *q, *g, *hy, *gab; f16_t *lfw, *lbw;
    __device__ __forceinline__ void half_(int row, int n, float rs, int b, const float (&a)[8]) const {
        float s[8], p[8]; load_f32x8(sw + (size_t)b * NIN + n, s);
#pragma unroll
        for (int j = 0; j < 8; ++j) p[j] = rs * a[j] + s[j];
        const int grp = n >> 9;
        if (grp == 0) { store_bf16x8(v + (size_t)row * 512 + n, p); }
        else if (grp <= 2) { const int nn = n - 512 * grp; f16_t* dst = (grp == 1 ? lfw : lbw) + (size_t)row * 512 + nn; f16_t o[8];
#pragma unroll
            for (int j = 0; j < 8; ++j) { const float lb = lbv[(grp - 1) * 512 + nn + j]; const float f = lb + (1.0f - lb) * sigmoidf_(p[j]); o[j] = (f16_t)__logf(f); }
            *(u32x4*)dst = *(const u32x4*)o; }
        else if (grp == 3) {
#pragma unroll
            for (int j = 0; j < 8; ++j) p[j] = siluf_(p[j]);
            store_bf16x8(q + (size_t)row * 512 + (n - 1536), p); }
        else if (grp == 4) {
#pragma unroll
            for (int j = 0; j < 8; ++j) p[j] = siluf_(p[j]);
            store_bf16x8(g + (size_t)row * 512 + (n - 2048), p); }
        else if (grp <= 7) { const int ch = n - 2560, t = row & (SEQ - 1); store_bf16x8(hy + (((size_t)(ch >> 3) * NB + b) * SEQ + t) * 8, p); }
        else {
#pragma unroll
            for (int j = 0; j < 8; ++j) p[j] = sigmoidf_(p[j]);
            store_bf16x8(gab + (size_t)row * 2048 + (n - 4096), p); }
    }
    __device__ __forceinline__ float apply(int row, int pn, int c, const float (&v0)[8], const float (&v1)[8]) const {
        const float rs = rstd_from_ssq(ssq + (size_t)row * 16); const int b = row < T ? (row >> 11) : 16;
        half_(row, 256 * pn + c, rs, b, v0); half_(row, 256 * pn + 128 + c, rs, b, v1); return 0.f; }
};
struct EpiProjA {
    const bf16_t* gab; float* ytmp;
    __device__ __forceinline__ void half_(int row, int col, const float (&a)[8]) const { float gt[8], o[8]; load_bf16x8(gab + (size_t)row * 2048 + col, gt);
#pragma unroll
        for (int j = 0; j < 8; ++j) o[j] = gt[j] * a[j];
        store_f32x8(ytmp + (size_t)row * D + col, o); }
    __device__ __forceinline__ float apply(int row, int pn, int c, const float (&v0)[8], const float (&v1)[8]) const { half_(row, 256 * pn + c, v0); half_(row, 256 * pn + 128 + c, v1); return 0.f; }
};
struct EpiProjB {
    const bf16_t* gab; const float* ytmp; bf16_t* y;
    __device__ __forceinline__ void half_(int row, int col, const float (&a)[8]) const { float gt[8], yt[8], o[8]; load_bf16x8(gab + (size_t)row * 2048 + 1024 + col, gt); load_f32x8(ytmp + (size_t)row * D + col, yt);
#pragma unroll
        for (int j = 0; j < 8; ++j) o[j] = yt[j] + gt[j] * a[j];
        store_bf16x8(y + (size_t)row * D + col, o); }
    __device__ __forceinline__ float apply(int row, int pn, int c, const float (&v0)[8], const float (&v1)[8]) const { half_(row, 256 * pn + c, v0); half_(row, 256 * pn + 128 + c, v1); return 0.f; }
};
struct EpiWout {
    const float* modv; float* h; bf16_t* a3;
    __device__ __forceinline__ float half_(int row, int col, const float (&v)[8]) const {
        const int b = row >> 11; float base[8], m5[8], m7[8], a[8];
        load_f32x8(h + (size_t)row * D + col, base); load_f32x8(modv + (size_t)b * MODW + 5 * D + col, m5); load_f32x8(modv + (size_t)b * MODW + 7 * D + col, m7);
        float s = 0.f;
#pragma unroll
        for (int j = 0; j < 8; ++j) { base[j] += m5[j] * v[j]; s += base[j] * base[j]; a[j] = base[j] * (1.0f + m7[j]); }
        store_f32x8(h + (size_t)row * D + col, base); store_bf16x8(a3 + (size_t)row * D + col, a); return s; }
    __device__ __forceinline__ float apply(int row, int pn, int c, const float (&v0)[8], const float (&v1)[8]) const { return half_(row, 256 * pn + c, v0) + half_(row, 256 * pn + 128 + c, v1); }
};
struct EpiDown2 {
    const float* modv; float* h;
    __device__ __forceinline__ float half_(int row, int col, const float (&v)[8]) const {
        const int b = row >> 11; float base[8], m8[8];
        load_f32x8(h + (size_t)row * D + col, base); load_f32x8(modv + (size_t)b * MODW + 8 * D + col, m8);
        float s = 0.f;
#pragma unroll
        for (int j = 0; j < 8; ++j) { base[j] += 0.5f * m8[j] * v[j]; s += base[j] * base[j]; }
        store_f32x8(h + (size_t)row * D + col, base); return s; }
    __device__ __forceinline__ float apply(int row, int pn, int c, const float (&v0)[8], const float (&v1)[8]) const { return half_(row, 256 * pn + c, v0) + half_(row, 256 * pn + 128 + c, v1); }
};

template <class Epi>
__device__ __forceinline__ void gemm_simple(LAS unsigned char* lds, const bf16_t* A, const bf16_t* Bt, int K, int row0, int nrows, int npn, const Epi& E, float* ssq) {
    LAS float* As = (LAS float*)lds;
    LAS float* Bs = (LAS float*)(lds + 8192);
    const int tid = threadIdx.x, c8 = tid & 15, rg = tid >> 4;
    const int nrt = nrows / 64, nunits = nrt * npn;
    for (int unit = blockIdx.x; unit < nunits; unit += gridDim.x) {
        const int rt = unit / npn, pn = unit % npn, r0 = row0 + rt * 64;
        float a0[2][8], a1[2][8];
#pragma unroll
        for (int r = 0; r < 2; ++r)
#pragma unroll
            for (int j = 0; j < 8; ++j) { a0[r][j] = 0.f; a1[r][j] = 0.f; }
        for (int k0 = 0; k0 < K; k0 += 32) {
            { const int row = tid >> 3, kq = tid & 7; const u32x2 w = *(const u32x2*)(A + (size_t)(r0 + row) * K + k0 + 4 * kq);
              As[(4 * kq + 0) * 64 + row] = __uint_as_float(w.x << 16); As[(4 * kq + 1) * 64 + row] = __uint_as_float(w.x & 0xffff0000u);
              As[(4 * kq + 2) * 64 + row] = __uint_as_float(w.y << 16); As[(4 * kq + 3) * 64 + row] = __uint_as_float(w.y & 0xffff0000u); }
            { const int n = tid >> 1, kh = tid & 1; const bf16_t* src = Bt + (size_t)(pn * 256 + n) * K + k0 + 16 * kh; float t8[8];
              load_bf16x8(src, t8);
#pragma unroll
              for (int i = 0; i < 8; ++i) Bs[(16 * kh + i) * 256 + n] = t8[i];
              load_bf16x8(src + 8, t8);
#pragma unroll
              for (int i = 0; i < 8; ++i) Bs[(16 * kh + 8 + i) * 256 + n] = t8[i]; }
            __syncthreads();
#pragma unroll 8
            for (int k = 0; k < 32; ++k) {
                const float x0 = As[k * 64 + 2 * rg], x1 = As[k * 64 + 2 * rg + 1];
                const f32x4 b00 = *(const LAS f32x4*)(Bs + k * 256 + 8 * c8), b01 = *(const LAS f32x4*)(Bs + k * 256 + 8 * c8 + 4);
                const f32x4 b10 = *(const LAS f32x4*)(Bs + k * 256 + 128 + 8 * c8), b11 = *(const LAS f32x4*)(Bs + k * 256 + 128 + 8 * c8 + 4);
#pragma unroll
                for (int j = 0; j < 4; ++j) { a0[0][j] += x0 * b00[j]; a0[0][4 + j] += x0 * b01[j]; a1[0][j] += x0 * b10[j]; a1[0][4 + j] += x0 * b11[j];
                                              a0[1][j] += x1 * b00[j]; a0[1][4 + j] += x1 * b01[j]; a1[1][j] += x1 * b10[j]; a1[1][4 + j] += x1 * b11[j]; }
            }
            __syncthreads();
        }
#pragma unroll
        for (int r = 0; r < 2; ++r) { const int row = r0 + 2 * rg + r; float s = E.apply(row, pn, 8 * c8, a0[r], a1[r]);
            s += __shfl_xor(s, 1); s += __shfl_xor(s, 2); s += __shfl_xor(s, 4); s += __shfl_xor(s, 8);
            if (ssq && c8 == 0) *(f32x4*)(ssq + (size_t)row * 16 + pn * 4) = (f32x4){s, 0.f, 0.f, 0.f}; }
    }
}

struct Ctx { LAS unsigned char* lds; int tid, lane, wid, gw, ngw; };

__device__ __forceinline__ void phase_prep(const Params& p, const Ctx& c) {
    unsigned char* ws = p.ws;
    LAS float* scr = (LAS float*)(c.lds + c.wid * 8448);
    transpose_matrix(p.w_in, D, NIN, (bf16_t*)(ws + WS_WIN_T), scr, c.gw, c.ngw, c.lane);
    transpose_matrix(p.w_pa, 512, D, (bf16_t*)(ws + WS_WPA_T), scr, c.gw, c.ngw, c.lane);
    transpose_matrix(p.w_pb, 512, D, (bf16_t*)(ws + WS_WPB_T), scr, c.gw, c.ngw, c.lane);
    transpose_matrix(p.w_out, D, D, (bf16_t*)(ws + WS_WOUT_T), scr, c.gw, c.ngw, c.lane);
    transpose_gu(p.ffn_wg, 0, (bf16_t*)(ws + WS_WG1_T), scr, c.gw, c.ngw, c.lane);
    transpose_gu(p.ffn_wu, 1, (bf16_t*)(ws + WS_WG1_T), scr, c.gw, c.ngw, c.lane);
    transpose_matrix(p.ffn_wd, DFF, D, (bf16_t*)(ws + WS_WD1_T), scr, c.gw, c.ngw, c.lane);
    __syncthreads();
    if ((int)blockIdx.x < MODW / 64) {
        LAS float* xs = (LAS float*)c.lds; LAS float* part = (LAS float*)(c.lds + 17 * 1024 * 4);
        for (int i = c.tid; i < 17 * 1024; i += NTHR) { const int r = i >> 10, k = i & 1023; const float v = r < 16 ? p.c[r * D + k] : p.c_ctx[k]; xs[i] = v / (1.0f + expf(-v)); }
        __syncthreads();
        gemv17<false>(xs, part, p.mod_w, MODW, p.mod_b, (float*)(ws + WS_MODV), MODW, 0, blockIdx.x, gridDim.x);
    }
    { float* er = (float*)(ws + WS_ER); float* ec = (float*)(ws + WS_EC); float* lbv = (float*)(ws + WS_LBV);
      const int gt = blockIdx.x * NTHR + c.tid, ngt = gridDim.x * NTHR;
      for (int i = gt; i < 96 * 512; i += ngt) { const int r = i >> 9, j = i & 511, jj = j & 255; const float omega = 1.0f / powf(10000.0f, (float)jj / 256.0f);
          const int pos = r < 32 ? r : r - 32; const float a = (float)pos * omega; const float v = j < 256 ? sinf(a) : cosf(a);
          if (r < 32) er[r * 512 + j] = v; else ec[(r - 32) * 512 + j] = v; }
      for (int i = gt; i < 1024; i += ngt) { const float l0 = p.lb_logits[i], l1 = p.lb_logits[1024 + i]; lbv[i] = 1.0f / (1.0f + expf(l1 - l0)); } }
    { LAS float* zf = (LAS float*)c.lds; LAS float* h1 = zf + 8 * 40; float* h2o = (float*)(ws + WS_H2);
      for (int it = blockIdx.x; it < SEQ / 8; it += gridDim.x) {
          __syncthreads();
          if (c.tid < 8 * 33) { const int r = c.tid / 33, f = c.tid % 33; const int pp = it * 8 + r; float v;
              if (f == 0) v = (float)pp / (float)(SEQ - 1);
              else { const int i = (f - 1) & 15; const float w = 6.283185307179586f * (float)pp / (float)SEQ; const float fr = 1e-4f + (float)i * ((15.0f - 1e-4f) / 15.0f); const float ang = w * fr; v = f <= 16 ? cosf(ang) : -sinf(ang); }
              zf[r * 40 + f] = v; }
          __syncthreads();
          { const int r = c.tid >> 6, j = c.tid & 63; float s = p.hb1[j];
            for (int f = 0; f < 33; ++f) s += zf[r * 40 + f] * p.hw1[f * 64 + j];
            h1[r * 64 + j] = sinf(p.hfr1[j] * s); }
          __syncthreads();
          { const int r = c.tid >> 6, j = c.tid & 63; float s = p.hb2[j];
            for (int k = 0; k < 64; ++k) s += h1[r * 64 + k] * p.hw2[k * 64 + j];
            h2o[(size_t)(it * 8 + r) * 64 + j] = sinf(p.hfr2[j] * s); }
      } }
}

__device__ __forceinline__ void phase_n1(const Params& p, const Ctx& c) {
    unsigned char* ws = p.ws;
    const float* modv = (const float*)(ws + WS_MODV); const float* er = (const float*)(ws + WS_ER); const float* ec = (const float*)(ws + WS_EC);
    bf16_t* n1 = (bf16_t*)(ws + WS_N1);
    for (int row = c.gw; row < MT; row += c.ngw) {
        const bool lat = row < T; const int b = lat ? (row >> 11) : 16, t = row & (SEQ - 1);
        const float* src = lat ? p.x + (size_t)row * D : p.ctx + (size_t)(row - T) * D;
        f32x4 v[4]; float s = 0.f;
#pragma unroll
        for (int j = 0; j < 4; ++j) { const int col = 4 * c.lane + 256 * j; v[j] = *(const f32x4*)(src + col);
            if (lat) { const float* pe = col < 512 ? er + (t >> 6) * 512 + col : ec + (t & 63) * 512 + (col - 512); v[j] += *(const f32x4*)pe; }
            s += (v[j][0] * v[j][0] + v[j][1] * v[j][1]) + (v[j][2] * v[j][2] + v[j][3] * v[j][3]); }
        const float rs = 1.0f / sqrtf(wave_sum(s) * (1.0f / D) + RMS_EPS);
#pragma unroll
        for (int j = 0; j < 4; ++j) { const int col = 4 * c.lane + 256 * j; const f32x4 sh = *(const f32x4*)(modv + (size_t)b * MODW + col), sc = *(const f32x4*)(modv + (size_t)b * MODW + D + col);
            const f32x4 o = v[j] * rs * (sc + 1.0f) + sh; u32x2 w; w.x = pk2(o[0], o[1]); w.y = pk2(o[2], o[3]); *(u32x2*)(n1 + (size_t)row * D + col) = w; }
    }
    { LAS float* xs = (LAS float*)c.lds; LAS float* part = (LAS float*)(c.lds + 17 * 1024 * 4);
      const int nb_in = NIN / 64, nb_g = DFF / 64;
      for (int bx = blockIdx.x; bx < nb_in + 2 * nb_g; bx += gridDim.x) {
          __syncthreads();
          if (bx < nb_in) {
              for (int i = c.tid; i < 17 * 1024; i += NTHR) xs[i] = modv[(size_t)(i >> 10) * MODW + 3 * D + (i & 1023)];
              __syncthreads();
              gemv17<false>(xs, part, p.w_in, NIN, nullptr, (float*)(ws + WS_SWIN), NIN, 0, bx, nb_in); }
          else { const int half = (bx - nb_in) / nb_g, blk = (bx - nb_in) % nb_g;
              for (int i = c.tid; i < 17 * 1024; i += NTHR) xs[i] = modv[(size_t)(i >> 10) * MODW + 6 * D + (i & 1023)];
              __syncthreads();
              const float* W = (half ? p.ffn_wu : p.ffn_wg) + (size_t)D * DFF;
              gemv17<true>(xs, part, W, DFF, nullptr, (float*)(ws + WS_SW2), NGU, half, blk, nb_g); }
      }
    }
    { LAS float* w3s = (LAS float*)c.lds;
      LAS float* hk = w3s + 512;
      LAS float* red = hk + 2048 * 8;
      const float* h2 = (const float*)(ws + WS_H2); bf16_t* krev = (bf16_t*)(ws + WS_KREV);
      for (int it = blockIdx.x; it < 256; it += gridDim.x) {
          const int c0 = 2 * it;
          __syncthreads();
          { const int k = c.tid >> 3, q = c.tid & 7; w3s[c.tid] = p.hw3[(size_t)k * 2048 + (q >> 2) * 1024 + ((q >> 1) & 1) * 512 + c0 + (q & 1)]; }
          __syncthreads();
          float l1[4] = {0.f, 0.f, 0.f, 0.f};
          for (int idx = c.tid; idx < 2048 * 8; idx += NTHR) { const int t = idx >> 3, q = idx & 7; float s = 0.f;
              const float* hr = h2 + (size_t)t * 64;
#pragma unroll 8
              for (int k = 0; k < 64; ++k) s += hr[k] * w3s[k * 8 + q];
              const int ch = c0 + (q & 1); const float delta = fabsf(-3.0701134573253945f + (float)ch * ((-15.350567286626973f + 3.0701134573253945f) / 511.0f));
              const float tn = (float)t / (float)(SEQ - 1); s *= expf(-tn * delta) + 0.05f;
              hk[idx] = s; l1[0] += fabsf(s); }
          { float s = l1[0]; s += __shfl_xor(s, 2); s += __shfl_xor(s, 8); s += __shfl_xor(s, 16); s += __shfl_xor(s, 32);
            if ((c.lane & ~5) == 0) red[c.wid * 4 + ((c.lane >> 2) & 1) * 2 + (c.lane & 1)] = s; }
          __syncthreads();
          for (int e = c.tid; e < 4 * KR_LEN; e += NTHR) { const int oc = e / KR_LEN, i = (e % KR_LEN) - KR_OFF, o = oc >> 1, cc = oc & 1;
              float tot = 0.f;
#pragma unroll
              for (int w = 0; w < 8; ++w) tot += red[w * 4 + oc];
              const int lag = -i; float v = 0.f;
              if (lag >= 0 && lag <= SEQ - 1) v = hk[lag * 8 + o * 4 + 0 + cc]; else if (lag < 0 && lag >= -(SEQ - 1)) v = hk[(-lag - 1) * 8 + o * 4 + 2 + cc];
              krev[((size_t)o * 512 + c0 + cc) * KR_LEN + (e % KR_LEN)] = f2bf(v / (tot + 1e-6f)); }
      } }
}

__device__ __forceinline__ void phase_hgrn_simple(const Params& p, const Ctx& c) {
    unsigned char* ws = p.ws;
    const bf16_t* vb = (const bf16_t*)(ws + WS_V); const bf16_t* qb = (const bf16_t*)(ws + WS_Q);
    LAS float* F = (LAS float*)c.lds; LAS float* Kk = F + 64 * 128; LAS float* Q = Kk + 64 * 128; LAS float* V = Q + 64 * 128;
    const int dg = c.tid & 3, e = c.tid >> 2;
    for (int it = blockIdx.x; it < NB * 4 * 2; it += gridDim.x) {
        const int dir = it & 1, h = (it >> 1) & 3, b = it >> 3;
        const f16_t* lf = (const f16_t*)(ws + (dir ? WS_LBW : WS_LFW)); float* outp = (float*)(ws + (dir ? WS_OBW : WS_OFW));
        float S[32];
#pragma unroll
        for (int i = 0; i < 32; ++i) S[i] = 0.f;
        for (int ci = 0; ci < 36; ++ci) {
            const bool lat = ci >= 4;
            __syncthreads();
            for (int idx = c.tid; idx < 64 * 128; idx += NTHR) { const int j = idx >> 7, d = idx & 127; const int pp = (lat ? ci - 4 : ci) * 64 + j;
                const int row = lat ? b * SEQ + (dir ? SEQ - 1 - pp : pp) : T + b * CL + (dir ? CL - 1 - pp : pp);
                const float f = __expf((float)lf[(size_t)row * 512 + h * 128 + d]);
                F[idx] = f; Kk[idx] = 1.0f - f; V[idx] = bf2f(vb[(size_t)row * 512 + h * 128 + d]); Q[idx] = lat ? bf2f(qb[(size_t)row * 512 + h * 128 + d]) : 0.f; }
            __syncthreads();
            for (int j = 0; j < 64; ++j) { const float ve = V[j * 128 + e]; float part = 0.f;
#pragma unroll
                for (int i = 0; i < 32; ++i) { const int d = dg * 32 + i; S[i] = F[j * 128 + d] * S[i] + Kk[j * 128 + d] * ve; part += S[i] * Q[j * 128 + d]; }
                part += __shfl_xor(part, 1); part += __shfl_xor(part, 2);
                if (lat && dg == 0) { const int pp = (ci - 4) * 64 + j; const int row = b * SEQ + (dir ? SEQ - 1 - pp : pp); outp[(size_t)row * 512 + h * 128 + e] = part; } }
        }
    }
}

__device__ __forceinline__ float hy_tap(const bf16_t* hy, const float* cw, const float* cb, int ch, int b, int t) {
    const bf16_t* src = hy + (((size_t)(ch >> 3) * NB + b) * SEQ) * 8 + (ch & 7); float s = cb[ch];
#pragma unroll
    for (int j = 0; j < 3; ++j) { const int tt = t + j - 1; if (tt >= 0 && tt < SEQ) s += cw[j * NHY + ch] * bf2f(src[(size_t)tt * 8]); }
    return s;
}
__device__ __forceinline__ void phase_hyena_simple(const Params& p, const Ctx& c) {
    unsigned char* ws = p.ws;
    const bf16_t* hy = (const bf16_t*)(ws + WS_HY); const bf16_t* krev = (const bf16_t*)(ws + WS_KREV); bf16_t* zb = (bf16_t*)(ws + WS_ZB);
    LAS float* zs = (LAS float*)c.lds;
    LAS float* kr = zs + 2048 * 16;
    for (int ch = blockIdx.x; ch < BW; ch += gridDim.x) {
        __syncthreads();
        for (int idx = c.tid; idx < NB * SEQ; idx += NTHR) { const int b = idx >> 11, t = idx & (SEQ - 1); zs[t * 16 + b] = bfround(hy_tap(hy, p.conv_w, p.conv_b, ch, b, t)); }
        for (int o = 0; o < 2; ++o) {
            for (int i = c.tid; i < KR_LEN; i += NTHR) kr[i] = bf2f(krev[((size_t)o * 512 + ch) * KR_LEN + i]);
            __syncthreads();
            const int t0 = 4 * c.tid;
            float acc[4][16];
#pragma unroll
            for (int r = 0; r < 4; ++r)
#pragma unroll
                for (int b = 0; b < 16; ++b) acc[r][b] = 0.f;
            float w0, w1 = kr[KR_OFF - t0 - 1], w2 = kr[KR_OFF - t0 - 2], w3 = kr[KR_OFF - t0 - 3];
            for (int s = 0; s < SEQ; ++s) {
                w0 = kr[KR_OFF + s - t0];
                const f32x4 z0 = *(const LAS f32x4*)(zs + s * 16), z1 = *(const LAS f32x4*)(zs + s * 16 + 4), z2 = *(const LAS f32x4*)(zs + s * 16 + 8), z3 = *(const LAS f32x4*)(zs + s * 16 + 12);
#pragma unroll
                for (int j = 0; j < 4; ++j) { acc[0][j] += w0 * z0[j]; acc[0][4 + j] += w0 * z1[j]; acc[0][8 + j] += w0 * z2[j]; acc[0][12 + j] += w0 * z3[j];
                                              acc[1][j] += w1 * z0[j]; acc[1][4 + j] += w1 * z1[j]; acc[1][8 + j] += w1 * z2[j]; acc[1][12 + j] += w1 * z3[j];
                                              acc[2][j] += w2 * z0[j]; acc[2][4 + j] += w2 * z1[j]; acc[2][8 + j] += w2 * z2[j]; acc[2][12 + j] += w2 * z3[j];
                                              acc[3][j] += w3 * z0[j]; acc[3][4 + j] += w3 * z1[j]; acc[3][8 + j] += w3 * z2[j]; acc[3][12 + j] += w3 * z3[j]; }
                w3 = w2; w2 = w1; w1 = w0;
            }
            const float bias = p.hy_bias[o * 512 + ch];
#pragma unroll
            for (int r = 0; r < 4; ++r)
#pragma unroll
                for (int b = 0; b < 16; ++b) acc[r][b] += bias * zs[(t0 + r) * 16 + b];
            __syncthreads();
#pragma unroll
            for (int r = 0; r < 4; ++r)
#pragma unroll
                for (int b4 = 0; b4 < 4; ++b4) *(LAS f32x4*)(zs + (t0 + r) * 16 + 4 * b4) = (f32x4){acc[r][4 * b4], acc[r][4 * b4 + 1], acc[r][4 * b4 + 2], acc[r][4 * b4 + 3]};
#pragma unroll 1
            for (int i = 0; i < 64; ++i) { const int r = i >> 4, b = i & 15, t = t0 + r; const float gate = hy_tap(hy, p.conv_w, p.conv_b, (o + 1) * 512 + ch, b, t);
                const float zn = gate * zs[t * 16 + b];
                if (o == 0) zs[t * 16 + b] = bfround(zn); else zb[((size_t)ch * NB + b) * SEQ + t] = f2bf(zn); }
            __syncthreads();
        }
    }
}

__device__ __forceinline__ void phase_combine(const Params& p, const Ctx& c) {
    unsigned char* ws = p.ws;
    const float* ofw = (const float*)(ws + WS_OFW); const float* obw = (const float*)(ws + WS_OBW); const bf16_t* g = (const bf16_t*)(ws + WS_G);
    bf16_t* oa = (bf16_t*)(ws + WS_OA); bf16_t* ob = (bf16_t*)(ws + WS_OB); const bf16_t* zb = (const bf16_t*)(ws + WS_ZB);
    for (int row = c.gw; row < T; row += c.ngw) { const int col = 8 * c.lane; float a[8], bq[8], gg[8], w[8], o[8];
        load_f32x8(ofw + (size_t)row * 512 + col, a); load_f32x8(obw + (size_t)row * 512 + col, bq); load_bf16x8(g + (size_t)row * 512 + col, gg); load_f32x8(p.a_norm_w + (col & 127), w);
        float s = 0.f;
#pragma unroll
        for (int j = 0; j < 8; ++j) { a[j] += bq[j]; s += a[j] * a[j]; }
        s += __shfl_xor(s, 1); s += __shfl_xor(s, 2); s += __shfl_xor(s, 4); s += __shfl_xor(s, 8);
        const float rs = 1.0f / sqrtf(s * (1.0f / 128.0f) + RMS_EPS);
#pragma unroll
        for (int j = 0; j < 8; ++j) o[j] = a[j] * rs * w[j] * gg[j];
        store_bf16x8(oa + (size_t)row * 512 + col, o); }
    LAS bf16_t* tile = (LAS bf16_t*)c.lds;
    for (int it = blockIdx.x; it < NB * 32 * 8; it += gridDim.x) { const int cb = it & 7, tb = (it >> 3) & 31, b = it >> 8;
        __syncthreads();
        { const int cl = c.tid >> 3, t8 = (c.tid & 7) * 8; const u32x4 w = *(const u32x4*)(zb + ((size_t)(cb * 64 + cl) * NB + b) * SEQ + tb * 64 + t8); *(LAS u32x4*)(tile + cl * 72 + t8) = w; }
        __syncthreads();
        { const int tl = c.tid >> 3, c8 = (c.tid & 7) * 8; bf16_t v[8];
#pragma unroll
          for (int i = 0; i < 8; ++i) v[i] = tile[(c8 + i) * 72 + tl];
          u32x4 w; w.x = v[0] | ((unsigned)v[1] << 16); w.y = v[2] | ((unsigned)v[3] << 16); w.z = v[4] | ((unsigned)v[5] << 16); w.w = v[6] | ((unsigned)v[7] << 16);
          *(u32x4*)(ob + ((size_t)b * SEQ + tb * 64 + tl) * 512 + cb * 64 + c8) = w; }
    }
}

__device__ __forceinline__ void phase_final(const Params& p, const Ctx& c) {
    const float* ssq = (const float*)(p.ws + WS_SSQ3);
    for (int row = c.gw; row < T; row += c.ngw) { const float rs = rstd_from_ssq(ssq + (size_t)row * 16);
#pragma unroll
        for (int j = 0; j < 4; ++j) { const int col = 4 * c.lane + 256 * j; f32x4* ptr = (f32x4*)(p.out + (size_t)row * D + col); *ptr = *ptr * rs * *(const f32x4*)(p.fnw + col); } }
}

constexpr int N_PHASES = 13;
__global__ void __launch_bounds__(NTHR, 2) fwd_kernel(Params p) {
    extern __shared__ __attribute__((aligned(16))) unsigned char lds_raw[];
    Ctx c; c.lds = (LAS unsigned char*)lds_raw; c.tid = threadIdx.x; c.lane = c.tid & 63; c.wid = __builtin_amdgcn_readfirstlane(c.tid >> 6);
    c.gw = blockIdx.x * NWAVES + c.wid; c.ngw = gridDim.x * NWAVES;
    unsigned char* ws = p.ws;
    const float* modv = (const float*)(ws + WS_MODV);
#if N_LAUNCH_MODE == 1
    cg::grid_group grid = cg::this_grid();
#define SEAM() grid.sync()
#else
#define SEAM() do { } while (0)
#endif
#ifdef ONLY_PHASE
#define IN(k) ((k) == ONLY_PHASE && p.ph_lo <= (k) && (k) < p.ph_hi)
#else
#define IN(k) (p.ph_lo <= (k) && (k) < p.ph_hi)
#endif
#define GEMM(A_, Bt_, K_, row0_, nrows_, npn_, E_, ssq_) gemm_simple(c.lds, A_, Bt_, K_, row0_, nrows_, npn_, E_, ssq_)
    if (IN(0)) { phase_prep(p, c); if (IN(1)) SEAM(); }
    if (IN(1)) { phase_n1(p, c); if (IN(2)) SEAM(); }
    if (IN(2)) { EpiGateUp1 E{(bf16_t*)(ws + WS_HID)};
        GEMM((const bf16_t*)(ws + WS_N1), (const bf16_t*)(ws + WS_WG1_T), D, 0, MT, NGU / 256, E, nullptr); if (IN(3)) SEAM(); }
    if (IN(3)) { EpiDown1 E{p.x, p.ctx, (const float*)(ws + WS_ER), (const float*)(ws + WS_EC), modv, p.out, (bf16_t*)(ws + WS_A2)};
        GEMM((const bf16_t*)(ws + WS_HID), (const bf16_t*)(ws + WS_WD1_T), DFF, 0, MT, D / 256, E, (float*)(ws + WS_SSQ1)); if (IN(4)) SEAM(); }
    if (IN(4)) { EpiWin E{(const float*)(ws + WS_SSQ1), (const float*)(ws + WS_SWIN), (const float*)(ws + WS_LBV), (bf16_t*)(ws + WS_V), (bf16_t*)(ws + WS_Q), (bf16_t*)(ws + WS_G), (bf16_t*)(ws + WS_HY), (bf16_t*)(ws + WS_GAB), (f16_t*)(ws + WS_LFW), (f16_t*)(ws + WS_LBW)};
        GEMM((const bf16_t*)(ws + WS_A2), (const bf16_t*)(ws + WS_WIN_T), D, 0, T, NIN / 256, E, nullptr);
        GEMM((const bf16_t*)(ws + WS_A2), (const bf16_t*)(ws + WS_WIN_T), D, T, TC, 6, E, nullptr); if (IN(5)) SEAM(); }
    if (IN(5)) {
        { LAS float* scr = (LAS float*)(c.lds + c.wid * 8448);
          transpose_gu(p.ffn_wg + (size_t)D * DFF, 0, (bf16_t*)(ws + WS_WG2_T), scr, c.gw, c.ngw, c.lane);
          transpose_gu(p.ffn_wu + (size_t)D * DFF, 1, (bf16_t*)(ws + WS_WG2_T), scr, c.gw, c.ngw, c.lane);
          transpose_matrix(p.ffn_wd + (size_t)DFF * D, DFF, D, (bf16_t*)(ws + WS_WD2_T), scr, c.gw, c.ngw, c.lane); }
        phase_hyena_simple(p, c); if (IN(6)) SEAM(); }
    if (IN(6)) { phase_hgrn_simple(p, c); if (IN(7)) SEAM(); }
    if (IN(7)) { phase_combine(p, c); if (IN(8)) SEAM(); }
    if (IN(8)) { EpiProjA EA{(const bf16_t*)(ws + WS_GAB), (float*)(ws + WS_YTMP)}; EpiProjB EB{(const bf16_t*)(ws + WS_GAB), (const float*)(ws + WS_YTMP), (bf16_t*)(ws + WS_Y)};
        GEMM((const bf16_t*)(ws + WS_OA), (const bf16_t*)(ws + WS_WPA_T), 512, 0, T, D / 256, EA, nullptr);
        GEMM((const bf16_t*)(ws + WS_OB), (const bf16_t*)(ws + WS_WPB_T), 512, 0, T, D / 256, EB, nullptr); if (IN(9)) SEAM(); }
    if (IN(9)) { EpiWout E{modv, p.out, (bf16_t*)(ws + WS_A3)};
        GEMM((const bf16_t*)(ws + WS_Y), (const bf16_t*)(ws + WS_WOUT_T), D, 0, T, D / 256, E, (float*)(ws + WS_SSQ2)); if (IN(10)) SEAM(); }
    if (IN(10)) { EpiGateUp2 E{(bf16_t*)(ws + WS_HID2), (const float*)(ws + WS_SSQ2), (const float*)(ws + WS_SW2)};
        GEMM((const bf16_t*)(ws + WS_A3), (const bf16_t*)(ws + WS_WG2_T), D, 0, T, NGU / 256, E, nullptr); if (IN(11)) SEAM(); }
    if (IN(11)) { EpiDown2 E{modv, p.out};
        GEMM((const bf16_t*)(ws + WS_HID2), (const bf16_t*)(ws + WS_WD2_T), DFF, 0, T, D / 256, E, (float*)(ws + WS_SSQ3)); if (IN(12)) SEAM(); }
    if (IN(12)) { phase_final(p, c); }
}

extern "C" void kernel_launch(void* const* d_in, const int* in_sizes, int n_in, void* d_out, int out_size, void* d_ws, size_t ws_size, hipStream_t stream) {
    static int grid = 0;
    if (grid == 0) {
        if (n_in != 26 || in_sizes[0] != T * D || out_size != T * D || ws_size < WS_TOTAL) { fprintf(stderr, "kernel_launch: unexpected shapes (n_in %d, in0 %d, out %d, ws %zu < %zu)\n", n_in, n_in > 0 ? in_sizes[0] : -1, out_size, ws_size, (size_t)WS_TOTAL); grid = -1; return; }
        int dev = 0, cus = 0, per_cu = 0;
        (void)hipGetDevice(&dev); (void)hipDeviceGetAttribute(&cus, hipDeviceAttributeMultiprocessorCount, dev);
        if (hipFuncSetAttribute((const void*)fwd_kernel, hipFuncAttributeMaxDynamicSharedMemorySize, LDS_BYTES) != hipSuccess) { fprintf(stderr, "kernel_launch: hipFuncSetAttribute failed\n"); grid = -1; return; }
        (void)hipOccupancyMaxActiveBlocksPerMultiprocessor(&per_cu, (const void*)fwd_kernel, NTHR, LDS_BYTES);
        if (per_cu < 1) { fprintf(stderr, "kernel_launch: occupancy query says %d blocks per CU\n", per_cu); per_cu = 1; }
        (void)hipGetLastError();
        grid = cus;
    }
    if (grid < 0) return;
    Params p{};
    const float** f = (const float**)&p;
    for (int i = 0; i < 26; ++i) f[i] = (const float*)d_in[i];
    p.out = (float*)d_out; p.ws = (unsigned char*)d_ws;
#if N_LAUNCH_MODE == 1
    p.ph_lo = 0; p.ph_hi = N_PHASES;
    void* args[] = {&p};
    hipError_t e = hipLaunchCooperativeKernel((const void*)fwd_kernel, dim3(grid), dim3(NTHR), args, LDS_BYTES, stream);
    if (e != hipSuccess) fprintf(stderr, "cooperative launch failed: %s (grid %d)\n", hipGetErrorString(e), grid);
#else
    for (int k = 0; k < N_PHASES; ++k) { p.ph_lo = k; p.ph_hi = k + 1; hipLaunchKernelGGL(fwd_kernel, dim3(grid), dim3(NTHR), LDS_BYTES, stream, p); }
#endif
}
```

```cpp
#include <hip/hip_runtime.h>
#include <hip/hip_cooperative_groups.h>
#include <cstdio>
namespace cg = cooperative_groups;

#ifndef N_LAUNCH_MODE
#define N_LAUNCH_MODE 1
#endif
#ifndef USE_PG8
#define USE_PG8 0
#endif

#define LAS __attribute__((address_space(3)))
typedef unsigned short bf16_t;
typedef _Float16 f16_t;
typedef float f32x4 __attribute__((ext_vector_type(4)));
typedef unsigned u32x4 __attribute__((ext_vector_type(4)));
typedef unsigned u32x2 __attribute__((ext_vector_type(2)));

constexpr int D = 1024, NB = 16, SEQ = 2048, T = NB * SEQ, CL = 256, TC = NB * CL, MT = T + TC;
constexpr int DFF = 2816, NGU = 2 * DFF, NIN = 6144, MODW = 9 * D;
constexpr int AKW = 512, AVW = 512, BW = 512, NHY = 3 * BW;
constexpr int KR_LEN = 4128, KR_OFF = 2056;
constexpr float RMS_EPS = 1e-6f;
constexpr int NTHR = 512, NWAVES = 8;
constexpr int LDS_BYTES = 152 * 1024;

constexpr size_t MiB = 1024 * 1024;
constexpr size_t al256(size_t x) { return (x + 255) & ~(size_t)255; }
constexpr size_t WS_CTL = 0;
constexpr size_t WS_MODV = WS_CTL + 65536;
constexpr size_t WS_SWIN = WS_MODV + al256((size_t)17 * MODW * 4);
constexpr size_t WS_SW2 = WS_SWIN + al256((size_t)17 * NIN * 4);
constexpr size_t WS_ER = WS_SW2 + al256((size_t)17 * NGU * 4);
constexpr size_t WS_EC = WS_ER + 32 * 512 * 4;
constexpr size_t WS_LBV = WS_EC + 64 * 512 * 4;
constexpr size_t WS_H2 = WS_LBV + 4096;
constexpr size_t WS_KREV = WS_H2 + 2048 * 64 * 4;
constexpr size_t WS_WIN_T = WS_KREV + al256((size_t)2 * 512 * KR_LEN * 2);
constexpr size_t WS_WPA_T = WS_WIN_T + (size_t)NIN * D * 2;
constexpr size_t WS_WPB_T = WS_WPA_T + (size_t)D * 512 * 2;
constexpr size_t WS_WOUT_T = WS_WPB_T + (size_t)D * 512 * 2;
constexpr size_t WS_PERSIST_END = WS_WOUT_T + (size_t)D * D * 2;
constexpr size_t AR = 27 * MiB;
static_assert(WS_PERSIST_END <= AR, "persistent region");
constexpr size_t WS_HID = AR + 0 * MiB;
constexpr size_t WS_N1 = AR + 198 * MiB;
constexpr size_t WS_WG1_T = AR + 270 * MiB;
constexpr size_t WS_WD1_T = AR + 281 * MiB;
constexpr size_t WS_SSQ1 = AR + 410 * MiB;
constexpr size_t WS_A2 = AR + 413 * MiB;
constexpr size_t WS_GAB = AR + 0 * MiB;
constexpr size_t WS_V = AR + 128 * MiB;
constexpr size_t WS_LFW = AR + 164 * MiB;
constexpr size_t WS_LBW = AR + 200 * MiB;
constexpr size_t WS_Q = AR + 236 * MiB;
constexpr size_t WS_G = AR + 268 * MiB;
constexpr size_t WS_HY = AR + 300 * MiB;
constexpr size_t WS_WG2_T = AR + 436 * MiB;
constexpr size_t WS_WD2_T = AR + 447 * MiB;
constexpr size_t WS_ZB = AR + 453 * MiB;
constexpr size_t WS_OFW = AR + 300 * MiB;
constexpr size_t WS_OBW = AR + 364 * MiB;
constexpr size_t WS_OA = AR + 128 * MiB;
constexpr size_t WS_OB = AR + 160 * MiB;
constexpr size_t WS_YTMP = AR + 192 * MiB;
constexpr size_t WS_Y = AR + 320 * MiB;
constexpr size_t WS_A3 = AR + 0 * MiB;
constexpr size_t WS_SSQ2 = AR + 64 * MiB;
constexpr size_t WS_SSQ3 = AR + 66 * MiB;
constexpr size_t WS_HID2 = AR + 128 * MiB;
constexpr size_t WS_TOTAL = AR + 485 * MiB;

struct Params {
    const float *x, *c, *ctx, *c_ctx, *mod_w, *mod_b, *ffn_wg, *ffn_wu, *ffn_wd, *w_in, *lb_logits, *a_norm_w, *conv_w, *conv_b;
    const float *hw1, *hb1, *hfr1, *hw2, *hb2, *hfr2, *hw3, *hy_bias, *w_pa, *w_pb, *w_out, *fnw;
    float* out; unsigned char* ws;
    int ph_lo, ph_hi;
};

__device__ __forceinline__ float bf2f(bf16_t b) { return __uint_as_float(((unsigned)b) << 16); }
__device__ __forceinline__ bf16_t f2bf(float f) { unsigned u = __float_as_uint(f); u += 0x7FFFu + ((u >> 16) & 1u); return (bf16_t)(u >> 16); }
__device__ __forceinline__ unsigned pk2(float lo, float hi) { return (unsigned)f2bf(lo) | ((unsigned)f2bf(hi) << 16); }
__device__ __forceinline__ float bfround(float f) { return bf2f(f2bf(f)); }
__device__ __forceinline__ float sigmoidf_(float x) { return 1.0f / (1.0f + __expf(-x)); }
__device__ __forceinline__ float siluf_(float x) { return x / (1.0f + __expf(-x)); }
__device__ __forceinline__ float wave_sum(float v) {
#pragma unroll
    for (int o = 1; o < 64; o <<= 1) v += __shfl_xor(v, o);
    return v;
}
__device__ __forceinline__ float pos_embed(const float* er, const float* ec, int t, int col) {
    return col < 512 ? er[(t >> 6) * 512 + col] : ec[(t & 63) * 512 + (col - 512)];
}
__device__ __forceinline__ float rstd_from_ssq(const float* ssq16) {
    const f32x4* s = (const f32x4*)ssq16; float tot = 0.f;
#pragma unroll
    for (int i = 0; i < 4; ++i) { const f32x4 v = s[i]; tot += (v[0] + v[1]) + (v[2] + v[3]); }
    return 1.0f / sqrtf(tot * (1.0f / D) + RMS_EPS);
}

__device__ __forceinline__ void transpose_item(const float* W, int K, int N, bf16_t* WT, int k0, int n0, int dst_row0, LAS float* scr, int lane) {
#pragma unroll 8
    for (int i = 0; i < 32; ++i) { const int kk = 2 * i + (lane >> 5); scr[kk * 33 + (lane & 31)] = W[(size_t)(k0 + kk) * N + n0 + (lane & 31)]; }
    asm volatile("s_waitcnt lgkmcnt(0)" ::: "memory");
    const int c = lane & 7;
#pragma unroll
    for (int j = 0; j < 4; ++j) { const int n = (lane >> 3) + 8 * j; const LAS float* s = scr + (8 * c) * 33 + n;
        u32x4 o; o.x = pk2(s[0 * 33], s[1 * 33]); o.y = pk2(s[2 * 33], s[3 * 33]); o.z = pk2(s[4 * 33], s[5 * 33]); o.w = pk2(s[6 * 33], s[7 * 33]);
        *(u32x4*)(WT + (size_t)(dst_row0 + n) * K + k0 + 8 * c) = o; }
    asm volatile("s_waitcnt lgkmcnt(0)" ::: "memory");
}
__device__ __forceinline__ void transpose_matrix(const float* W, int K, int N, bf16_t* WT, LAS float* scr, int gw, int ngw, int lane) {
    const int nblk = N / 32, items = (K / 64) * nblk;
    for (int it = gw; it < items; it += ngw) { const int kb = it / nblk, nb = it % nblk; transpose_item(W, K, N, WT, 64 * kb, 32 * nb, 32 * nb, scr, lane); }
}
__device__ __forceinline__ void transpose_gu(const float* W, int half, bf16_t* WT, LAS float* scr, int gw, int ngw, int lane) {
    const int nblk = DFF / 32, items = (D / 64) * nblk;
    for (int it = gw; it < items; it += ngw) { const int kb = it / nblk, nb = it % nblk, n0 = 32 * nb;
        transpose_item(W, D, DFF, WT, 64 * kb, n0, 256 * (n0 >> 7) + 128 * half + (n0 & 127), scr, lane); }
}

template <bool GU>
__device__ __forceinline__ void gemv17(const LAS float* xs, LAS float* part, const float* W, int N, const float* bias, float* out, int ldo, int half, int blk0, int nblk_stride) {
    const int tid = threadIdx.x, wid = tid >> 6, lane = tid & 63;
    for (int cb = blk0; cb < N / 64; cb += nblk_stride) {
        const int n = cb * 64 + lane;
        float acc[17];
#pragma unroll
        for (int r = 0; r < 17; ++r) acc[r] = 0.f;
        const float* wp = W + (size_t)(wid * 128) * N + n;
#pragma unroll 4
        for (int k = 0; k < 128; ++k) { const float w = wp[(size_t)k * N];
#pragma unroll
            for (int r = 0; r < 17; ++r) acc[r] += xs[r * 1024 + wid * 128 + k] * w; }
#pragma unroll
        for (int r = 0; r < 17; ++r) part[(wid * 17 + r) * 64 + lane] = acc[r];
        __syncthreads();
        for (int o = tid; o < 17 * 64; o += NTHR) { const int r = o >> 6, l = o & 63; float s = 0.f;
#pragma unroll
            for (int w = 0; w < 8; ++w) s += part[(w * 17 + r) * 64 + l];
            const int nn = cb * 64 + l; if (bias) s += bias[nn];
            const int on = GU ? (256 * (nn >> 7) + 128 * half + (nn & 127)) : nn;
            out[(size_t)r * ldo + on] = s; }
        __syncthreads();
    }
}

__device__ __forceinline__ void store_bf16x8(bf16_t* p, const float (&v)[8]) { u32x4 w; w.x = pk2(v[0], v[1]); w.y = pk2(v[2], v[3]); w.z = pk2(v[4], v[5]); w.w = pk2(v[6], v[7]); *(u32x4*)p = w; }
__device__ __forceinline__ void load_f32x8(const float* p, float (&v)[8]) { const f32x4 a = *(const f32x4*)p, b = *(const f32x4*)(p + 4); v[0] = a[0]; v[1] = a[1]; v[2] = a[2]; v[3] = a[3]; v[4] = b[0]; v[5] = b[1]; v[6] = b[2]; v[7] = b[3]; }
__device__ __forceinline__ void store_f32x8(float* p, const float (&v)[8]) { *(f32x4*)p = (f32x4){v[0], v[1], v[2], v[3]}; *(f32x4*)(p + 4) = (f32x4){v[4], v[5], v[6], v[7]}; }
__device__ __forceinline__ void load_bf16x8(const bf16_t* p, float (&v)[8]) { const u32x4 w = *(const u32x4*)p; v[0] = __uint_as_float(w.x << 16); v[1] = __uint_as_float(w.x & 0xffff0000u); v[2] = __uint_as_float(w.y << 16); v[3] = __uint_as_float(w.y & 0xffff0000u);
    v[4] = __uint_as_float(w.z << 16); v[5] = __uint_as_float(w.z & 0xffff0000u); v[6] = __uint_as_float(w.w << 16); v[7] = __uint_as_float(w.w & 0xffff0000u); }

struct EpiGateUp1 {
    bf16_t* hid;
    __device__ __forceinline__ float apply(int row, int pn, int c, const float (&v0)[8], const float (&v1)[8]) const {
        float o[8];
#pragma unroll
        for (int j = 0; j < 8; ++j) o[j] = siluf_(v0[j]) * v1[j];
        store_bf16x8(hid + (size_t)row * DFF + 128 * pn + c, o); return 0.f; }
};
struct EpiGateUp2 {
    bf16_t* hid; const float* ssq; const float* sw;
    __device__ __forceinline__ float apply(int row, int pn, int c, const float (&v0)[8], const float (&v1)[8]) const {
        const float rs = rstd_from_ssq(ssq + (size_t)row * 16); const int b = row >> 11;
        float s0[8], s1[8], o[8]; load_f32x8(sw + (size_t)b * NGU + 256 * pn + c, s0); load_f32x8(sw + (size_t)b * NGU + 256 * pn + 128 + c, s1);
#pragma unroll
        for (int j = 0; j < 8; ++j) o[j] = siluf_(rs * v0[j] + s0[j]) * (rs * v1[j] + s1[j]);
        store_bf16x8(hid + (size_t)row * DFF + 128 * pn + c, o); return 0.f; }
};
struct EpiDown1 {
    const float *x, *ctx, *er, *ec, *modv; float* hout; bf16_t* a2;
    __device__ __forceinline__ float half_(int row, int col, const float (&v)[8]) const {
        const bool lat = row < T; const int b = lat ? (row >> 11) : 16, t = row & (SEQ - 1);
        float base[8], m2[8], m4[8], h[8], a[8];
        if (lat) { load_f32x8(x + (size_t)row * D + col, base);
#pragma unroll
            for (int j = 0; j < 8; ++j) base[j] += pos_embed(er, ec, t, col + j); }
        else load_f32x8(ctx + (size_t)(row - T) * D + col, base);
        load_f32x8(modv + (size_t)b * MODW + 2 * D + col, m2); load_f32x8(modv + (size_t)b * MODW + 4 * D + col, m4);
        float s = 0.f;
#pragma unroll
        for (int j = 0; j < 8; ++j) { h[j] = base[j] + 0.5f * m2[j] * v[j]; s += h[j] * h[j]; a[j] = h[j] * (1.0f + m4[j]); }
        if (lat) store_f32x8(hout + (size_t)row * D + col, h);
        store_bf16x8(a2 + (size_t)row * D + col, a); return s; }
    __device__ __forceinline__ float apply(int row, int pn, int c, const float (&v0)[8], const float (&v1)[8]) const { return half_(row, 256 * pn + c, v0) + half_(row, 256 * pn + 128 + c, v1); }
};
struct EpiWin {
    const float *ssq, *sw, *lbv; bf16_t *v, *q, *g, *hy, *gab; f16_t *lfw, *lbw;
    __device__ __forceinline__ void half_(int row, int n, float rs, int b, const float (&a)[8]) const {
        float s[8], p[8]; load_f32x8(sw + (size_t)b * NIN + n, s);
#pragma unroll
        for (int j = 0; j < 8; ++j) p[j] = rs * a[j] + s[j];
        const int grp = n >> 9;
        if (grp == 0) { store_bf16x8(v + (size_t)row * 512 + n, p); }
        else if (grp <= 2) { const int nn = n - 512 * grp; f16_t* dst = (grp == 1 ? lfw : lbw) + (size_t)row * 512 + nn; f16_t o[8];
#pragma unroll
            for (int j = 0; j < 8; ++j) { const float lb = lbv[(grp - 1) * 512 + nn + j]; const float f = lb + (1.0f - lb) * sigmoidf_(p[j]); o[j] = (f16_t)__logf(f); }
            *(u32x4*)dst = *(const u32x4*)o; }
        else if (grp == 3) {
#pragma unroll
            for (int j = 0; j < 8; ++j) p[j] = siluf_(p[j]);
            store_bf16x8(q + (size_t)row * 512 + (n - 1536), p); }
        else if (grp == 4) {
#pragma unroll
            for (int j = 0; j < 8; ++j) p[j] = siluf_(p[j]);
            store_bf16x8(g + (size_t)row * 512 + (n - 2048), p); }
        else if (grp <= 7) { const int ch = n - 2560, t = row & (SEQ - 1); store_bf16x8(hy + (((size_t)(ch >> 3) * NB + b) * SEQ + t) * 8, p); }
        else {
#pragma unroll
            for (int j = 0; j < 8; ++j) p[j] = sigmoidf_(p[j]);
            store_bf16x8(gab + (size_t)row * 2048 + (n - 4096), p); }
    }
    __device__ __forceinline__ float apply(int row, int pn, int c, const float (&v0)[8], const float (&v1)[8]) const {
        const float rs = rstd_from_ssq(ssq + (size_t)row * 16); const int b = row < T ? (row >> 11) : 16;
        half_(row, 256 * pn + c, rs, b, v0); half_(row, 256 * pn + 128 + c, rs, b, v1); return 0.f; }
};
struct EpiProjA {
    const bf16_t* gab; float* ytmp;
    __device__ __forceinline__ void half_(int row, int col, const float (&a)[8]) const { float gt[8], o[8]; load_bf16x8(gab + (size_t)row * 2048 + col, gt);
#pragma unroll
        for (int j = 0; j < 8; ++j) o[j] = gt[j] * a[j];
        store_f32x8(ytmp + (size_t)row * D + col, o); }
    __device__ __forceinline__ float apply(int row, int pn, int c, const float (&v0)[8], const float (&v1)[8]) const { half_(row, 256 * pn + c, v0); half_(row, 256 * pn + 128 + c, v1); return 0.f; }
};
struct EpiProjB {
    const bf16_t* gab; const float* ytmp; bf16_t* y;
    __device__ __forceinline__ void half_(int row, int col, const float (&a)[8]) const { float gt[8], yt[8], o[8]; load_bf16x8(gab + (size_t)row * 2048 + 1024 + col, gt); load_f32x8(ytmp + (size_t)row * D + col, yt);
#pragma unroll
        for (int j = 0; j < 8; ++j) o[j] = yt[j] + gt[j] * a[j];
        store_bf16x8(y + (size_t)row * D + col, o); }
    __device__ __forceinline__ float apply(int row, int pn, int c, const float (&v0)[8], const float (&v1)[8]) const { half_(row, 256 * pn + c, v0); half_(row, 256 * pn + 128 + c, v1); return 0.f; }
};
struct EpiWout {
    const float* modv; float* h; bf16_t* a3;
    __device__ __forceinline__ float half_(int row, int col, const float (&v)[8]) const {
        const int b = row >> 11; float base[8], m5[8], m7[8], a[8];
        load_f32x8(h + (size_t)row * D + col, base); load_f32x8(modv + (size_t)b * MODW + 5 * D + col, m5); load_f32x8(modv + (size_t)b * MODW + 7 * D + col, m7);
        float s = 0.f;
#pragma unroll
        for (int j = 0; j < 8; ++j) { base[j] += m5[j] * v[j]; s += base[j] * base[j]; a[j] = base[j] * (1.0f + m7[j]); }
        store_f32x8(h + (size_t)row * D + col, base); store_bf16x8(a3 + (size_t)row * D + col, a); return s; }
    __device__ __forceinline__ float apply(int row, int pn, int c, const float (&v0)[8], const float (&v1)[8]) const { return half_(row, 256 * pn + c, v0) + half_(row, 256 * pn + 128 + c, v1); }
};
struct EpiDown2 {
    const float* modv; float* h;
    __device__ __forceinline__ float half_(int row, int col, const float (&v)[8]) const {
        const int b = row >> 11; float base[8], m8[8];
        load_f32x8(h + (size_t)row * D + col, base); load_f32x8(modv + (size_t)b * MODW + 8 * D + col, m8);
        float s = 0.f;
#pragma unroll
        for (int j = 0; j < 8; ++j) { base[j] += 0.5f * m8[j] * v[j]; s += base[j] * base[j]; }
        store_f32x8(h + (size_t)row * D + col, base); return s; }
    __device__ __forceinline__ float apply(int row, int pn, int c, const float (&v0)[8], const float (&v1)[8]) const { return half_(row, 256 * pn + c, v0) + half_(row, 256 * pn + 128 + c, v1); }
};

template <class Epi>
__device__ __forceinline__ void gemm_simple(LAS unsigned char* lds, const bf16_t* A, const bf16_t* Bt, int K, int row0, int nrows, int npn, const Epi& E, float* ssq) {
    LAS float* As = (LAS float*)lds;
    LAS float* Bs = (LAS float*)(lds + 8192);
    const int tid = threadIdx.x, c8 = tid & 15, rg = tid >> 4;
    const int nrt = nrows / 64, nunits = nrt * npn;
    for (int unit = blockIdx.x; unit < nunits; unit += gridDim.x) {
        const int rt = unit / npn, pn = unit % npn, r0 = row0 + rt * 64;
        float a0[2][8], a1[2][8];
#pragma unroll
        for (int r = 0; r < 2; ++r)
#pragma unroll
            for (int j = 0; j < 8; ++j) { a0[r][j] = 0.f; a1[r][j] = 0.f; }
        for (int k0 = 0; k0 < K; k0 += 32) {
            { const int row = tid >> 3, kq = tid & 7; const u32x2 w = *(const u32x2*)(A + (size_t)(r0 + row) * K + k0 + 4 * kq);
              As[(4 * kq + 0) * 64 + row] = __uint_as_float(w.x << 16); As[(4 * kq + 1) * 64 + row] = __uint_as_float(w.x & 0xffff0000u);
              As[(4 * kq + 2) * 64 + row] = __uint_as_float(w.y << 16); As[(4 * kq + 3) * 64 + row] = __uint_as_float(w.y & 0xffff0000u); }
            { const int n = tid >> 1, kh = tid & 1; const bf16_t* src = Bt + (size_t)(pn * 256 + n) * K + k0 + 16 * kh; float t8[8];
              load_bf16x8(src, t8);
#pragma unroll
              for (int i = 0; i < 8; ++i) Bs[(16 * kh + i) * 256 + n] = t8[i];
              load_bf16x8(src + 8, t8);
#pragma unroll
              for (int i = 0; i < 8; ++i) Bs[(16 * kh + 8 + i) * 256 + n] = t8[i]; }
            __syncthreads();
#pragma unroll 8
            for (int k = 0; k < 32; ++k) {
                const float x0 = As[k * 64 + 2 * rg], x1 = As[k * 64 + 2 * rg + 1];
                const f32x4 b00 = *(const LAS f32x4*)(Bs + k * 256 + 8 * c8), b01 = *(const LAS f32x4*)(Bs + k * 256 + 8 * c8 + 4);
                const f32x4 b10 = *(const LAS f32x4*)(Bs + k * 256 + 128 + 8 * c8), b11 = *(const LAS f32x4*)(Bs + k * 256 + 128 + 8 * c8 + 4);
#pragma unroll
                for (int j = 0; j < 4; ++j) { a0[0][j] += x0 * b00[j]; a0[0][4 + j] += x0 * b01[j]; a1[0][j] += x0 * b10[j]; a1[0][4 + j] += x0 * b11[j];
                                              a0[1][j] += x1 * b00[j]; a0[1][4 + j] += x1 * b01[j]; a1[1][j] += x1 * b10[j]; a1[1][4 + j] += x1 * b11[j]; }
            }
            __syncthreads();
        }
#pragma unroll
        for (int r = 0; r < 2; ++r) { const int row = r0 + 2 * rg + r; float s = E.apply(row, pn, 8 * c8, a0[r], a1[r]);
            s += __shfl_xor(s, 1); s += __shfl_xor(s, 2); s += __shfl_xor(s, 4); s += __shfl_xor(s, 8);
            if (ssq && c8 == 0) *(f32x4*)(ssq + (size_t)row * 16 + pn * 4) = (f32x4){s, 0.f, 0.f, 0.f}; }
    }
}

struct Ctx { LAS unsigned char* lds; int tid, lane, wid, gw, ngw; };

__device__ __forceinline__ void phase_prep(const Params& p, const Ctx& c) {
    unsigned char* ws = p.ws;
    LAS float* scr = (LAS float*)(c.lds + c.wid * 8448);
    transpose_matrix(p.w_in, D, NIN, (bf16_t*)(ws + WS_WIN_T), scr, c.gw, c.ngw, c.lane);
    transpose_matrix(p.w_pa, 512, D, (bf16_t*)(ws + WS_WPA_T), scr, c.gw, c.ngw, c.lane);
    transpose_matrix(p.w_pb, 512, D, (bf16_t*)(ws + WS_WPB_T), scr, c.gw, c.ngw, c.lane);
    transpose_matrix(p.w_out, D, D, (bf16_t*)(ws + WS_WOUT_T), scr, c.gw, c.ngw, c.lane);
    transpose_gu(p.ffn_wg, 0, (bf16_t*)(ws + WS_WG1_T), scr, c.gw, c.ngw, c.lane);
    transpose_gu(p.ffn_wu, 1, (bf16_t*)(ws + WS_WG1_T), scr, c.gw, c.ngw, c.lane);
    transpose_matrix(p.ffn_wd, DFF, D, (bf16_t*)(ws + WS_WD1_T), scr, c.gw, c.ngw, c.lane);
    __syncthreads();
    if ((int)blockIdx.x < MODW / 64) {
        LAS float* xs = (LAS float*)c.lds; LAS float* part = (LAS float*)(c.lds + 17 * 1024 * 4);
        for (int i = c.tid; i < 17 * 1024; i += NTHR) { const int r = i >> 10, k = i & 1023; const float v = r < 16 ? p.c[r * D + k] : p.c_ctx[k]; xs[i] = v / (1.0f + expf(-v)); }
        __syncthreads();
        gemv17<false>(xs, part, p.mod_w, MODW, p.mod_b, (float*)(ws + WS_MODV), MODW, 0, blockIdx.x, gridDim.x);
    }
    { float* er = (float*)(ws + WS_ER); float* ec = (float*)(ws + WS_EC); float* lbv = (float*)(ws + WS_LBV);
      const int gt = blockIdx.x * NTHR + c.tid, ngt = gridDim.x * NTHR;
      for (int i = gt; i < 96 * 512; i += ngt) { const int r = i >> 9, j = i & 511, jj = j & 255; const float omega = 1.0f / powf(10000.0f, (float)jj / 256.0f);
          const int pos = r < 32 ? r : r - 32; const float a = (float)pos * omega; const float v = j < 256 ? sinf(a) : cosf(a);
          if (r < 32) er[r * 512 + j] = v; else ec[(r - 32) * 512 + j] = v; }
      for (int i = gt; i < 1024; i += ngt) { const float l0 = p.lb_logits[i], l1 = p.lb_logits[1024 + i]; lbv[i] = 1.0f / (1.0f + expf(l1 - l0)); } }
    { LAS float* zf = (LAS float*)c.lds; LAS float* h1 = zf + 8 * 40; float* h2o = (float*)(ws + WS_H2);
      for (int it = blockIdx.x; it < SEQ / 8; it += gridDim.x) {
          __syncthreads();
          if (c.tid < 8 * 33) { const int r = c.tid / 33, f = c.tid % 33; const int pp = it * 8 + r; float v;
              if (f == 0) v = (float)pp / (float)(SEQ - 1);
              else { const int i = (f - 1) & 15; const float w = 6.283185307179586f * (float)pp / (float)SEQ; const float fr = 1e-4f + (float)i * ((15.0f - 1e-4f) / 15.0f); const float ang = w * fr; v = f <= 16 ? cosf(ang) : -sinf(ang); }
              zf[r * 40 + f] = v; }
          __syncthreads();
          { const int r = c.tid >> 6, j = c.tid & 63; float s = p.hb1[j];
            for (int f = 0; f < 33; ++f) s += zf[r * 40 + f] * p.hw1[f * 64 + j];
            h1[r * 64 + j] = sinf(p.hfr1[j] * s); }
          __syncthreads();
          { const int r = c.tid >> 6, j = c.tid & 63; float s = p.hb2[j];
            for (int k = 0; k < 64; ++k) s += h1[r * 64 + k] * p.hw2[k * 64 + j];
            h2o[(size_t)(it * 8 + r) * 64 + j] = sinf(p.hfr2[j] * s); }
      } }
}

__device__ __forceinline__ void phase_n1(const Params& p, const Ctx& c) {
    unsigned char* ws = p.ws;
    const float* modv = (const float*)(ws + WS_MODV); const float* er = (const float*)(ws + WS_ER); const float* ec = (const float*)(ws + WS_EC);
    bf16_t* n1 = (bf16_t*)(ws + WS_N1);
    for (int row = c.gw; row < MT; row += c.ngw) {
        const bool lat = row < T; const int b = lat ? (row >> 11) : 16, t = row & (SEQ - 1);
        const float* src = lat ? p.x + (size_t)row * D : p.ctx + (size_t)(row - T) * D;
        f32x4 v[4]; float s = 0.f;
#pragma unroll
        for (int j = 0; j < 4; ++j) { const int col = 4 * c.lane + 256 * j; v[j] = *(const f32x4*)(src + col);
            if (lat) { const float* pe = col < 512 ? er + (t >> 6) * 512 + col : ec + (t & 63) * 512 + (col - 512); v[j] += *(const f32x4*)pe; }
            s += (v[j][0] * v[j][0] + v[j][1] * v[j][1]) + (v[j][2] * v[j][2] + v[j][3] * v[j][3]); }
        const float rs = 1.0f / sqrtf(wave_sum(s) * (1.0f / D) + RMS_EPS);
#pragma unroll
        for (int j = 0; j < 4; ++j) { const int col = 4 * c.lane + 256 * j; const f32x4 sh = *(const f32x4*)(modv + (size_t)b * MODW + col), sc = *(const f32x4*)(modv + (size_t)b * MODW + D + col);
            const f32x4 o = v[j] * rs * (sc + 1.0f) + sh; u32x2 w; w.x = pk2(o[0], o[1]); w.y = pk2(o[2], o[3]); *(u32x2*)(n1 + (size_t)row * D + col) = w; }
    }
    { LAS float* xs = (LAS float*)c.lds; LAS float* part = (LAS float*)(c.lds + 17 * 1024 * 4);
      const int nb_in = NIN / 64, nb_g = DFF / 64;
      for (int bx = blockIdx.x; bx < nb_in + 2 * nb_g; bx += gridDim.x) {
          __syncthreads();
          if (bx < nb_in) {
              for (int i = c.tid; i < 17 * 1024; i += NTHR) xs[i] = modv[(size_t)(i >> 10) * MODW + 3 * D + (i & 1023)];
              __syncthreads();
              gemv17<false>(xs, part, p.w_in, NIN, nullptr, (float*)(ws + WS_SWIN), NIN, 0, bx, nb_in); }
          else { const int half = (bx - nb_in) / nb_g, blk = (bx - nb_in) % nb_g;
              for (int i = c.tid; i < 17 * 1024; i += NTHR) xs[i] = modv[(size_t)(i >> 10) * MODW + 6 * D + (i & 1023)];
              __syncthreads();
              const float* W = (half ? p.ffn_wu : p.ffn_wg) + (size_t)D * DFF;
              gemv17<true>(xs, part, W, DFF, nullptr, (float*)(ws + WS_SW2), NGU, half, blk, nb_g); }
      }
    }
    { LAS float* w3s = (LAS float*)c.lds;
      LAS float* hk = w3s + 512;
      LAS float* red = hk + 2048 * 8;
      const float* h2 = (const float*)(ws + WS_H2); bf16_t* krev = (bf16_t*)(ws + WS_KREV);
      for (int it = blockIdx.x; it < 256; it += gridDim.x) {
          const int c0 = 2 * it;
          __syncthreads();
          { const int k = c.tid >> 3, q = c.tid & 7; w3s[c.tid] = p.hw3[(size_t)k * 2048 + (q >> 2) * 1024 + ((q >> 1) & 1) * 512 + c0 + (q & 1)]; }
          __syncthreads();
          float l1[4] = {0.f, 0.f, 0.f, 0.f};
          for (int idx = c.tid; idx < 2048 * 8; idx += NTHR) { const int t = idx >> 3, q = idx & 7; float s = 0.f;
              const float* hr = h2 + (size_t)t * 64;
#pragma unroll 8
              for (int k = 0; k < 64; ++k) s += hr[k] * w3s[k * 8 + q];
              const int ch = c0 + (q & 1); const float delta = fabsf(-3.0701134573253945f + (float)ch * ((-15.350567286626973f + 3.0701134573253945f) / 511.0f));
              const float tn = (float)t / (float)(SEQ - 1); s *= expf(-tn * delta) + 0.05f;
              hk[idx] = s; l1[0] += fabsf(s); }
          { float s = l1[0]; s += __shfl_xor(s, 2); s += __shfl_xor(s, 8); s += __shfl_xor(s, 16); s += __shfl_xor(s, 32);
            if ((c.lane & ~5) == 0) red[c.wid * 4 + ((c.lane >> 2) & 1) * 2 + (c.lane & 1)] = s; }
          __syncthreads();
          for (int e = c.tid; e < 4 * KR_LEN; e += NTHR) { const int oc = e / KR_LEN, i = (e % KR_LEN) - KR_OFF, o = oc >> 1, cc = oc & 1;
              float tot = 0.f;
#pragma unroll
              for (int w = 0; w < 8; ++w) tot += red[w * 4 + oc];
              const int lag = -i; float v = 0.f;
              if (lag >= 0 && lag <= SEQ - 1) v = hk[lag * 8 + o * 4 + 0 + cc]; else if (lag < 0 && lag >= -(SEQ - 1)) v = hk[(-lag - 1) * 8 + o * 4 + 2 + cc];
              krev[((size_t)o * 512 + c0 + cc) * KR_LEN + (e % KR_LEN)] = f2bf(v / (tot + 1e-6f)); }
      } }
}

__device__ __forceinline__ void phase_hgrn_simple(const Params& p, const Ctx& c) {
    unsigned char* ws = p.ws;
    const bf16_t* vb = (const bf16_t*)(ws + WS_V); const bf16_t* qb = (const bf16_t*)(ws + WS_Q);
    LAS float* F = (LAS float*)c.lds; LAS float* Kk = F + 64 * 128; LAS float* Q = Kk + 64 * 128; LAS float* V = Q + 64 * 128;
    const int dg = c.tid & 3, e = c.tid >> 2;
    for (int it = blockIdx.x; it < NB * 4 * 2; it += gridDim.x) {
        const int dir = it & 1, h = (it >> 1) & 3, b = it >> 3;
        const f16_t* lf = (const f16_t*)(ws + (dir ? WS_LBW : WS_LFW)); float* outp = (float*)(ws + (dir ? WS_OBW : WS_OFW));
        float S[32];
#pragma unroll
        for (int i = 0; i < 32; ++i) S[i] = 0.f;
        for (int ci = 0; ci < 36; ++ci) {
            const bool lat = ci >= 4;
            __syncthreads();
            for (int idx = c.tid; idx < 64 * 128; idx += NTHR) { const int j = idx >> 7, d = idx & 127; const int pp = (lat ? ci - 4 : ci) * 64 + j;
                const int row = lat ? b * SEQ + (dir ? SEQ - 1 - pp : pp) : T + b * CL + (dir ? CL - 1 - pp : pp);
                const float f = __expf((float)lf[(size_t)row * 512 + h * 128 + d]);
                F[idx] = f; Kk[idx] = 1.0f - f; V[idx] = bf2f(vb[(size_t)row * 512 + h * 128 + d]); Q[idx] = lat ? bf2f(qb[(size_t)row * 512 + h * 128 + d]) : 0.f; }
            __syncthreads();
            for (int j = 0; j < 64; ++j) { const float ve = V[j * 128 + e]; float part = 0.f;
#pragma unroll
                for (int i = 0; i < 32; ++i) { const int d = dg * 32 + i; S[i] = F[j * 128 + d] * S[i] + Kk[j * 128 + d] * ve; part += S[i] * Q[j * 128 + d]; }
                part += __shfl_xor(part, 1); part += __shfl_xor(part, 2);
                if (lat && dg == 0) { const int pp = (ci - 4) * 64 + j; const int row = b * SEQ + (dir ? SEQ - 1 - pp : pp); outp[(size_t)row * 512 + h * 128 + e] = part; } }
        }
    }
}

__device__ __forceinline__ float hy_tap(const bf16_t* hy, const float* cw, const float* cb, int ch, int b, int t) {
    const bf16_t* src = hy + (((size_t)(ch >> 3) * NB + b) * SEQ) * 8 + (ch & 7); float s = cb[ch];
#pragma unroll
    for (int j = 0; j < 3; ++j) { const int tt = t + j - 1; if (tt >= 0 && tt < SEQ) s += cw[j * NHY + ch] * bf2f(src[(size_t)tt * 8]); }
    return s;
}
__device__ __forceinline__ void phase_hyena_simple(const Params& p, const Ctx& c) {
    unsigned char* ws = p.ws;
    const bf16_t* hy = (const bf16_t*)(ws + WS_HY); const bf16_t* krev = (const bf16_t*)(ws + WS_KREV); bf16_t* zb = (bf16_t*)(ws + WS_ZB);
    LAS float* zs = (LAS float*)c.lds;
    LAS float* kr = zs + 2048 * 16;
    for (int ch = blockIdx.x; ch < BW; ch += gridDim.x) {
        __syncthreads();
        for (int idx = c.tid; idx < NB * SEQ; idx += NTHR) { const int b = idx >> 11, t = idx & (SEQ - 1); zs[t * 16 + b] = bfround(hy_tap(hy, p.conv_w, p.conv_b, ch, b, t)); }
        for (int o = 0; o < 2; ++o) {
            for (int i = c.tid; i < KR_LEN; i += NTHR) kr[i] = bf2f(krev[((size_t)o * 512 + ch) * KR_LEN + i]);
            __syncthreads();
            const int t0 = 4 * c.tid;
            float acc[4][16];
#pragma unroll
            for (int r = 0; r < 4; ++r)
#pragma unroll
                for (int b = 0; b < 16; ++b) acc[r][b] = 0.f;
            float w0, w1 = kr[KR_OFF - t0 - 1], w2 = kr[KR_OFF - t0 - 2], w3 = kr[KR_OFF - t0 - 3];
            for (int s = 0; s < SEQ; ++s) {
                w0 = kr[KR_OFF + s - t0];
                const f32x4 z0 = *(const LAS f32x4*)(zs + s * 16), z1 = *(const LAS f32x4*)(zs + s * 16 + 4), z2 = *(const LAS f32x4*)(zs + s * 16 + 8), z3 = *(const LAS f32x4*)(zs + s * 16 + 12);
#pragma unroll
                for (int j = 0; j < 4; ++j) { acc[0][j] += w0 * z0[j]; acc[0][4 + j] += w0 * z1[j]; acc[0][8 + j] += w0 * z2[j]; acc[0][12 + j] += w0 * z3[j];
                                              acc[1][j] += w1 * z0[j]; acc[1][4 + j] += w1 * z1[j]; acc[1][8 + j] += w1 * z2[j]; acc[1][12 + j] += w1 * z3[j];
                                              acc[2][j] += w2 * z0[j]; acc[2][4 + j] += w2 * z1[j]; acc[2][8 + j] += w2 * z2[j]; acc[2][12 + j] += w2 * z3[j];
                                              acc[3][j] += w3 * z0[j]; acc[3][4 + j] += w3 * z1[j]; acc[3][8 + j] += w3 * z2[j]; acc[3][12 + j] += w3 * z3[j]; }
                w3 = w2; w2 = w1; w1 = w0;
            }
            const float bias = p.hy_bias[o * 512 + ch];
#pragma unroll
            for (int r = 0; r < 4; ++r)
#pragma unroll
                for (int b = 0; b < 16; ++b) acc[r][b] += bias * zs[(t0 + r) * 16 + b];
            __syncthreads();
#pragma unroll
            for (int r = 0; r < 4; ++r)
#pragma unroll
                for (int b4 = 0; b4 < 4; ++b4) *(LAS f32x4*)(zs + (t0 + r) * 16 + 4 * b4) = (f32x4){acc[r][4 * b4], acc[r][4 * b4 + 1], acc[r][4 * b4 + 2], acc[r][4 * b4 + 3]};
#pragma unroll 1
            for (int i = 0; i < 64; ++i) { const int r = i >> 4, b = i & 15, t = t0 + r; const float gate = hy_tap(hy, p.conv_w, p.conv_b, (o + 1) * 512 + ch, b, t);
                const float zn = gate * zs[t * 16 + b];
                if (o == 0) zs[t * 16 + b] = bfround(zn); else zb[((size_t)ch * NB + b) * SEQ + t] = f2bf(zn); }
            __syncthreads();
        }
    }
}

__device__ __forceinline__ void phase_combine(const Params& p, const Ctx& c) {
    unsigned char* ws = p.ws;
    const float* ofw = (const float*)(ws + WS_OFW); const float* obw = (const float*)(ws + WS_OBW); const bf16_t* g = (const bf16_t*)(ws + WS_G);
    bf16_t* oa = (bf16_t*)(ws + WS_OA); bf16_t* ob = (bf16_t*)(ws + WS_OB); const bf16_t* zb = (const bf16_t*)(ws + WS_ZB);
    for (int row = c.gw; row < T; row += c.ngw) { const int col = 8 * c.lane; float a[8], bq[8], gg[8], w[8], o[8];
        load_f32x8(ofw + (size_t)row * 512 + col, a); load_f32x8(obw + (size_t)row * 512 + col, bq); load_bf16x8(g + (size_t)row * 512 + col, gg); load_f32x8(p.a_norm_w + (col & 127), w);
        float s = 0.f;
#pragma unroll
        for (int j = 0; j < 8; ++j) { a[j] += bq[j]; s += a[j] * a[j]; }
        s += __shfl_xor(s, 1); s += __shfl_xor(s, 2); s += __shfl_xor(s, 4); s += __shfl_xor(s, 8);
        const float rs = 1.0f / sqrtf(s * (1.0f / 128.0f) + RMS_EPS);
#pragma unroll
        for (int j = 0; j < 8; ++j) o[j] = a[j] * rs * w[j] * gg[j];
        store_bf16x8(oa + (size_t)row * 512 + col, o); }
    LAS bf16_t* tile = (LAS bf16_t*)c.lds;
    for (int it = blockIdx.x; it < NB * 32 * 8; it += gridDim.x) { const int cb = it & 7, tb = (it >> 3) & 31, b = it >> 8;
        __syncthreads();
        { const int cl = c.tid >> 3, t8 = (c.tid & 7) * 8; const u32x4 w = *(const u32x4*)(zb + ((size_t)(cb * 64 + cl) * NB + b) * SEQ + tb * 64 + t8); *(LAS u32x4*)(tile + cl * 72 + t8) = w; }
        __syncthreads();
        { const int tl = c.tid >> 3, c8 = (c.tid & 7) * 8; bf16_t v[8];
#pragma unroll
          for (int i = 0; i < 8; ++i) v[i] = tile[(c8 + i) * 72 + tl];
          u32x4 w; w.x = v[0] | ((unsigned)v[1] << 16); w.y = v[2] | ((unsigned)v[3] << 16); w.z = v[4] | ((unsigned)v[5] << 16); w.w = v[6] | ((unsigned)v[7] << 16);
          *(u32x4*)(ob + ((size_t)b * SEQ + tb * 64 + tl) * 512 + cb * 64 + c8) = w; }
    }
}

__device__ __forceinline__ void phase_final(const Params& p, const Ctx& c) {
    const float* ssq = (const float*)(p.ws + WS_SSQ3);
    for (int row = c.gw; row < T; row += c.ngw) { const float rs = rstd_from_ssq(ssq + (size_t)row * 16);
#pragma unroll
        for (int j = 0; j < 4; ++j) { const int col = 4 * c.lane + 256 * j; f32x4* ptr = (f32x4*)(p.out + (size_t)row * D + col); *ptr = *ptr * rs * *(const f32x4*)(p.fnw + col); } }
}

constexpr int N_PHASES = 13;
__global__ void __launch_bounds__(NTHR, 2) fwd_kernel(Params p) {
    extern __shared__ __attribute__((aligned(16))) unsigned char lds_raw[];
    Ctx c; c.lds = (LAS unsigned char*)lds_raw; c.tid = threadIdx.x; c.lane = c.tid & 63; c.wid = __builtin_amdgcn_readfirstlane(c.tid >> 6);
    c.gw = blockIdx.x * NWAVES + c.wid; c.ngw = gridDim.x * NWAVES;
    unsigned char* ws = p.ws;
    const float* modv = (const float*)(ws + WS_MODV);
#if N_LAUNCH_MODE == 1
    cg::grid_group grid = cg::this_grid();
#define SEAM() grid.sync()
#else
#define SEAM() do { } while (0)
#endif
#ifdef ONLY_PHASE
#define IN(k) ((k) == ONLY_PHASE && p.ph_lo <= (k) && (k) < p.ph_hi)
#else
#define IN(k) (p.ph_lo <= (k) && (k) < p.ph_hi)
#endif
#define GEMM(A_, Bt_, K_, row0_, nrows_, npn_, E_, ssq_) gemm_simple(c.lds, A_, Bt_, K_, row0_, nrows_, npn_, E_, ssq_)
    if (IN(0)) { phase_prep(p, c); if (IN(1)) SEAM(); }
    if (IN(1)) { phase_n1(p, c); if (IN(2)) SEAM(); }
    if (IN(2)) { EpiGateUp1 E{(bf16_t*)(ws + WS_HID)};
        GEMM((const bf16_t*)(ws + WS_N1), (const bf16_t*)(ws + WS_WG1_T), D, 0, MT, NGU / 256, E, nullptr); if (IN(3)) SEAM(); }
    if (IN(3)) { EpiDown1 E{p.x, p.ctx, (const float*)(ws + WS_ER), (const float*)(ws + WS_EC), modv, p.out, (bf16_t*)(ws + WS_A2)};
        GEMM((const bf16_t*)(ws + WS_HID), (const bf16_t*)(ws + WS_WD1_T), DFF, 0, MT, D / 256, E, (float*)(ws + WS_SSQ1)); if (IN(4)) SEAM(); }
    if (IN(4)) { EpiWin E{(const float*)(ws + WS_SSQ1), (const float*)(ws + WS_SWIN), (const float*)(ws + WS_LBV), (bf16_t*)(ws + WS_V), (bf16_t*)(ws + WS_Q), (bf16_t*)(ws + WS_G), (bf16_t*)(ws + WS_HY), (bf16_t*)(ws + WS_GAB), (f16_t*)(ws + WS_LFW), (f16_t*)(ws + WS_LBW)};
        GEMM((const bf16_t*)(ws + WS_A2), (const bf16_t*)(ws + WS_WIN_T), D, 0, T, NIN / 256, E, nullptr);
        GEMM((const bf16_t*)(ws + WS_A2), (const bf16_t*)(ws + WS_WIN_T), D, T, TC, 6, E, nullptr); if (IN(5)) SEAM(); }
    if (IN(5)) {
        { LAS float* scr = (LAS float*)(c.lds + c.wid * 8448);
          transpose_gu(p.ffn_wg + (size_t)D * DFF, 0, (bf16_t*)(ws + WS_WG2_T), scr, c.gw, c.ngw, c.lane);
          transpose_gu(p.ffn_wu + (size_t)D * DFF, 1, (bf16_t*)(ws + WS_WG2_T), scr, c.gw, c.ngw, c.lane);
          transpose_matrix(p.ffn_wd + (size_t)DFF * D, DFF, D, (bf16_t*)(ws + WS_WD2_T), scr, c.gw, c.ngw, c.lane); }
        phase_hyena_simple(p, c); if (IN(6)) SEAM(); }
    if (IN(6)) { phase_hgrn_simple(p, c); if (IN(7)) SEAM(); }
    if (IN(7)) { phase_combine(p, c); if (IN(8)) SEAM(); }
    if (IN(8)) { EpiProjA EA{(const bf16_t*)(ws + WS_GAB), (float*)(ws + WS_YTMP)}; EpiProjB EB{(const bf16_t*)(ws + WS_GAB), (const float*)(ws + WS_YTMP), (bf16_t*)(ws + WS_Y)};
        GEMM((const bf16_t*)(ws + WS_OA), (const bf16_t*)(ws + WS_WPA_T), 512, 0, T, D / 256, EA, nullptr);
        GEMM((const bf16_t*)(ws + WS_OB), (const bf16_t*)(ws + WS_WPB_T), 512, 0, T, D / 256, EB, nullptr); if (IN(9)) SEAM(); }
    if (IN(9)) { EpiWout E{modv, p.out, (bf16_t*)(ws + WS_A3)};
        GEMM((const bf16_t*)(ws + WS_Y), (const bf16_t*)(ws + WS_WOUT_T), D, 0, T, D / 256, E, (float*)(ws + WS_SSQ2)); if (IN(10)) SEAM(); }
    if (IN(10)) { EpiGateUp2 E{(bf16_t*)(ws + WS_HID2), (const float*)(ws + WS_SSQ2), (const float*)(ws + WS_SW2)};
        GEMM((const bf16_t*)(ws + WS_A3), (const bf16_t*)(ws + WS_WG2_T), D, 0, T, NGU / 256, E, nullptr); if (IN(11)) SEAM(); }
    if (IN(11)) { EpiDown2 E{modv, p.out};
        GEMM((const bf16_t*)(ws + WS_HID2), (const bf16_t*)(ws + WS_WD2_T), DFF, 0, T, D / 256, E, (float*)(ws + WS_SSQ3)); if (IN(12)) SEAM(); }
    if (IN(12)) { phase_final(p, c); }
}

extern "C" void kernel_launch(void* const* d_in, const int* in_sizes, int n_in, void* d_out, int out_size, void* d_ws, size_t ws_size, hipStream_t stream) {
    static int grid = 0;
    if (grid == 0) {
        if (n_in != 26 || in_sizes[0] != T * D || out_size != T * D || ws_size < WS_TOTAL) { fprintf(stderr, "kernel_launch: unexpected shapes (n_in %d, in0 %d, out %d, ws %zu < %zu)\n", n_in, n_in > 0 ? in_sizes[0] : -1, out_size, ws_size, (size_t)WS_TOTAL); grid = -1; return; }
        int dev = 0, cus = 0, per_cu = 0;
        (void)hipGetDevice(&dev); (void)hipDeviceGetAttribute(&cus, hipDeviceAttributeMultiprocessorCount, dev);
        if (hipFuncSetAttribute((const void*)fwd_kernel, hipFuncAttributeMaxDynamicSharedMemorySize, LDS_BYTES) != hipSuccess) { fprintf(stderr, "kernel_launch: hipFuncSetAttribute failed\n"); grid = -1; return; }
        (void)hipOccupancyMaxActiveBlocksPerMultiprocessor(&per_cu, (const void*)fwd_kernel, NTHR, LDS_BYTES);
        if (per_cu < 1) { fprintf(stderr, "kernel_launch: occupancy query says %d blocks per CU\n", per_cu); per_cu = 1; }
        (void)hipGetLastError();
        grid = cus;
    }
    if (grid < 0) return;
    Params p{};
    const float** f = (const float**)&p;
    for (int i = 0; i < 26; ++i) f[i] = (const float*)d_in[i];
    p.out = (float*)d_out; p.ws = (unsigned char*)d_ws;
#if N_LAUNCH_MODE == 1
    p.ph_lo = 0; p.ph_hi = N_PHASES;
    void* args[] = {&p};
    hipError_t e = hipLaunchCooperativeKernel((const void*)fwd_kernel, dim3(grid), dim3(NTHR), args, LDS_BYTES, stream);
    if (e != hipSuccess) fprintf(stderr, "cooperative launch failed: %s (grid %d)\n", hipGetErrorString(e), grid);
#else
    for (int k = 0; k < N_PHASES; ++k) { p.ph_lo = k; p.ph_hi = k + 1; hipLaunchKernelGGL(fwd_kernel, dim3(grid), dim3(NTHR), LDS_BYTES, stream, p); }
#endif
}
```

```cpp
#include <hip/hip_runtime.h>
#include <hip/hip_cooperative_groups.h>
#include <cstdio>
namespace cg = cooperative_groups;

#ifndef N_LAUNCH_MODE
#define N_LAUNCH_MODE 1
#endif
#ifndef USE_PG8
#define USE_PG8 1
#endif

#define LAS __attribute__((address_space(3)))
typedef unsigned short bf16_t;
typedef _Float16 f16_t;
typedef float f32x4 __attribute__((ext_vector_type(4)));
typedef unsigned u32x4 __attribute__((ext_vector_type(4)));
typedef unsigned u32x2 __attribute__((ext_vector_type(2)));

constexpr int D = 1024, NB = 16, SEQ = 2048, T = NB * SEQ, CL = 256, TC = NB * CL, MT = T + TC;
constexpr int DFF = 2816, NGU = 2 * DFF, NIN = 6144, MODW = 9 * D;
constexpr int AKW = 512, AVW = 512, BW = 512, NHY = 3 * BW;
constexpr int KR_LEN = 4128, KR_OFF = 2056;
constexpr float RMS_EPS = 1e-6f;
constexpr int NTHR = 512, NWAVES = 8;
constexpr int LDS_BYTES = 152 * 1024;

constexpr size_t MiB = 1024 * 1024;
constexpr size_t al256(size_t x) { return (x + 255) & ~(size_t)255; }
constexpr size_t WS_CTL = 0;
constexpr size_t WS_MODV = WS_CTL + 65536;
constexpr size_t WS_SWIN = WS_MODV + al256((size_t)17 * MODW * 4);
constexpr size_t WS_SW2 = WS_SWIN + al256((size_t)17 * NIN * 4);
constexpr size_t WS_ER = WS_SW2 + al256((size_t)17 * NGU * 4);
constexpr size_t WS_EC = WS_ER + 32 * 512 * 4;
constexpr size_t WS_LBV = WS_EC + 64 * 512 * 4;
constexpr size_t WS_H2 = WS_LBV + 4096;
constexpr size_t WS_KREV = WS_H2 + 2048 * 64 * 4;
constexpr size_t WS_WIN_T = WS_KREV + al256((size_t)2 * 512 * KR_LEN * 2);
constexpr size_t WS_WPA_T = WS_WIN_T + (size_t)NIN * D * 2;
constexpr size_t WS_WPB_T = WS_WPA_T + (size_t)D * 512 * 2;
constexpr size_t WS_WOUT_T = WS_WPB_T + (size_t)D * 512 * 2;
constexpr size_t WS_PERSIST_END = WS_WOUT_T + (size_t)D * D * 2;
constexpr size_t AR = 27 * MiB;
static_assert(WS_PERSIST_END <= AR, "persistent region");
constexpr size_t WS_HID = AR + 0 * MiB;
constexpr size_t WS_N1 = AR + 198 * MiB;
constexpr size_t WS_WG1_T = AR + 270 * MiB;
constexpr size_t WS_WD1_T = AR + 281 * MiB;
constexpr size_t WS_SSQ1 = AR + 410 * MiB;
constexpr size_t WS_A2 = AR + 413 * MiB;
constexpr size_t WS_GAB = AR + 0 * MiB;
constexpr size_t WS_V = AR + 128 * MiB;
constexpr size_t WS_LFW = AR + 164 * MiB;
constexpr size_t WS_LBW = AR + 200 * MiB;
constexpr size_t WS_Q = AR + 236 * MiB;
constexpr size_t WS_G = AR + 268 * MiB;
constexpr size_t WS_HY = AR + 300 * MiB;
constexpr size_t WS_WG2_T = AR + 436 * MiB;
constexpr size_t WS_WD2_T = AR + 447 * MiB;
constexpr size_t WS_ZB = AR + 453 * MiB;
constexpr size_t WS_OFW = AR + 300 * MiB;
constexpr size_t WS_OBW = AR + 364 * MiB;
constexpr size_t WS_OA = AR + 128 * MiB;
constexpr size_t WS_OB = AR + 160 * MiB;
constexpr size_t WS_YTMP = AR + 192 * MiB;
constexpr size_t WS_Y = AR + 320 * MiB;
constexpr size_t WS_A3 = AR + 0 * MiB;
constexpr size_t WS_SSQ2 = AR + 64 * MiB;
constexpr size_t WS_SSQ3 = AR + 66 * MiB;
constexpr size_t WS_HID2 = AR + 128 * MiB;
constexpr size_t WS_TOTAL = AR + 485 * MiB;

struct Params {
    const float *x, *c, *ctx, *c_ctx, *mod_w, *mod_b, *ffn_wg, *ffn_wu, *ffn_wd, *w_in, *lb_logits, *a_norm_w, *conv_w, *conv_b;
    const float *hw1, *hb1, *hfr1, *hw2, *hb2, *hfr2, *hw3, *hy_bias, *w_pa, *w_pb, *w_out, *fnw;
    float* out; unsigned char* ws;
    int ph_lo, ph_hi;
};

__device__ __forceinline__ float bf2f(bf16_t b) { return __uint_as_float(((unsigned)b) << 16); }
__device__ __forceinline__ bf16_t f2bf(float f) { unsigned u = __float_as_uint(f); u += 0x7FFFu + ((u >> 16) & 1u); return (bf16_t)(u >> 16); }
__device__ __forceinline__ unsigned pk2(float lo, float hi) { return (unsigned)f2bf(lo) | ((unsigned)f2bf(hi) << 16); }
__device__ __forceinline__ float bfround(float f) { return bf2f(f2bf(f)); }
__device__ __forceinline__ float sigmoidf_(float x) { return 1.0f / (1.0f + __expf(-x)); }
__device__ __forceinline__ float siluf_(float x) { return x / (1.0f + __expf(-x)); }
__device__ __forceinline__ float wave_sum(float v) {
#pragma unroll
    for (int o = 1; o < 64; o <<= 1) v += __shfl_xor(v, o);
    return v;
}
__device__ __forceinline__ float pos_embed(const float* er, const float* ec, int t, int col) {
    return col < 512 ? er[(t >> 6) * 512 + col] : ec[(t & 63) * 512 + (col - 512)];
}
__device__ __forceinline__ float rstd_from_ssq(const float* ssq16) {
    const f32x4* s = (const f32x4*)ssq16; float tot = 0.f;
#pragma unroll
    for (int i = 0; i < 4; ++i) { const f32x4 v = s[i]; tot += (v[0] + v[1]) + (v[2] + v[3]); }
    return 1.0f / sqrtf(tot * (1.0f / D) + RMS_EPS);
}

__device__ __forceinline__ void transpose_item(const float* W, int K, int N, bf16_t* WT, int k0, int n0, int dst_row0, LAS float* scr, int lane) {
#pragma unroll 8
    for (int i = 0; i < 32; ++i) { const int kk = 2 * i + (lane >> 5); scr[kk * 33 + (lane & 31)] = W[(size_t)(k0 + kk) * N + n0 + (lane & 31)]; }
    asm volatile("s_waitcnt lgkmcnt(0)" ::: "memory");
    const int c = lane & 7;
#pragma unroll
    for (int j = 0; j < 4; ++j) { const int n = (lane >> 3) + 8 * j; const LAS float* s = scr + (8 * c) * 33 + n;
        u32x4 o; o.x = pk2(s[0 * 33], s[1 * 33]); o.y = pk2(s[2 * 33], s[3 * 33]); o.z = pk2(s[4 * 33], s[5 * 33]); o.w = pk2(s[6 * 33], s[7 * 33]);
        *(u32x4*)(WT + (size_t)(dst_row0 + n) * K + k0 + 8 * c) = o; }
    asm volatile("s_waitcnt lgkmcnt(0)" ::: "memory");
}
__device__ __forceinline__ void transpose_matrix(const float* W, int K, int N, bf16_t* WT, LAS float* scr, int gw, int ngw, int lane) {
    const int nblk = N / 32, items = (K / 64) * nblk;
    for (int it = gw; it < items; it += ngw) { const int kb = it / nblk, nb = it % nblk; transpose_item(W, K, N, WT, 64 * kb, 32 * nb, 32 * nb, scr, lane); }
}
__device__ __forceinline__ void transpose_gu(const float* W, int half, bf16_t* WT, LAS float* scr, int gw, int ngw, int lane) {
    const int nblk = DFF / 32, items = (D / 64) * nblk;
    for (int it = gw; it < items; it += ngw) { const int kb = it / nblk, nb = it % nblk, n0 = 32 * nb;
        transpose_item(W, D, DFF, WT, 64 * kb, n0, 256 * (n0 >> 7) + 128 * half + (n0 & 127), scr, lane); }
}

template <bool GU>
__device__ __forceinline__ void gemv17(const LAS float* xs, LAS float* part, const float* W, int N, const float* bias, float* out, int ldo, int half, int blk0, int nblk_stride) {
    const int tid = threadIdx.x, wid = tid >> 6, lane = tid & 63;
    for (int cb = blk0; cb < N / 64; cb += nblk_stride) {
        const int n = cb * 64 + lane;
        float acc[17];
#pragma unroll
        for (int r = 0; r < 17; ++r) acc[r] = 0.f;
        const float* wp = W + (size_t)(wid * 128) * N + n;
#pragma unroll 4
        for (int k = 0; k < 128; ++k) { const float w = wp[(size_t)k * N];
#pragma unroll
            for (int r = 0; r < 17; ++r) acc[r] += xs[r * 1024 + wid * 128 + k] * w; }
#pragma unroll
        for (int r = 0; r < 17; ++r) part[(wid * 17 + r) * 64 + lane] = acc[r];
        __syncthreads();
        for (int o = tid; o < 17 * 64; o += NTHR) { const int r = o >> 6, l = o & 63; float s = 0.f;
#pragma unroll
            for (int w = 0; w < 8; ++w) s += part[(w * 17 + r) * 64 + l];
            const int nn = cb * 64 + l; if (bias) s += bias[nn];
            const int on = GU ? (256 * (nn >> 7) + 128 * half + (nn & 127)) : nn;
            out[(size_t)r * ldo + on] = s; }
        __syncthreads();
    }
}

__device__ __forceinline__ void store_bf16x8(bf16_t* p, const float (&v)[8]) { u32x4 w; w.x = pk2(v[0], v[1]); w.y = pk2(v[2], v[3]); w.z = pk2(v[4], v[5]); w.w = pk2(v[6], v[7]); *(u32x4*)p = w; }
__device__ __forceinline__ void load_f32x8(const float* p, float (&v)[8]) { const f32x4 a = *(const f32x4*)p, b = *(const f32x4*)(p + 4); v[0] = a[0]; v[1] = a[1]; v[2] = a[2]; v[3] = a[3]; v[4] = b[0]; v[5] = b[1]; v[6] = b[2]; v[7] = b[3]; }
__device__ __forceinline__ void store_f32x8(float* p, const float (&v)[8]) { *(f32x4*)p = (f32x4){v[0], v[1], v[2], v[3]}; *(f32x4*)(p + 4) = (f32x4){v[4], v[5], v[6], v[7]}; }
__device__ __forceinline__ void load_bf16x8(const bf16_t* p, float (&v)[8]) { const u32x4 w = *(const u32x4*)p; v[0] = __uint_as_float(w.x << 16); v[1] = __uint_as_float(w.x & 0xffff0000u); v[2] = __uint_as_float(w.y << 16); v[3] = __uint_as_float(w.y & 0xffff0000u);
    v[4] = __uint_as_float(w.z << 16); v[5] = __uint_as_float(w.z & 0xffff0000u); v[6] = __uint_as_float(w.w << 16); v[7] = __uint_as_float(w.w & 0xffff0000u); }

struct EpiGateUp1 {
    bf16_t* hid;
    __device__ __forceinline__ float apply(int row, int pn, int c, const float (&v0)[8], const float (&v1)[8]) const {
        float o[8];
#pragma unroll
        for (int j = 0; j < 8; ++j) o[j] = siluf_(v0[j]) * v1[j];
        store_bf16x8(hid + (size_t)row * DFF + 128 * pn + c, o); return 0.f; }
};
struct EpiGateUp2 {
    bf16_t* hid; const float* ssq; const float* sw;
    __device__ __forceinline__ float apply(int row, int pn, int c, const float (&v0)[8], const float (&v1)[8]) const {
        const float rs = rstd_from_ssq(ssq + (size_t)row * 16); const int b = row >> 11;
        float s0[8], s1[8], o[8]; load_f32x8(sw + (size_t)b * NGU + 256 * pn + c, s0); load_f32x8(sw + (size_t)b * NGU + 256 * pn + 128 + c, s1);
#pragma unroll
        for (int j = 0; j < 8; ++j) o[j] = siluf_(rs * v0[j] + s0[j]) * (rs * v1[j] + s1[j]);
        store_bf16x8(hid + (size_t)row * DFF + 128 * pn + c, o); return 0.f; }
};
struct EpiDown1 {
    const float *x, *ctx, *er, *ec, *modv; float* hout; bf16_t* a2;
    __device__ __forceinline__ float half_(int row, int col, const float (&v)[8]) const {
        const bool lat = row < T; const int b = lat ? (row >> 11) : 16, t = row & (SEQ - 1);
        float base[8], m2[8], m4[8], h[8], a[8];
        if (lat) { load_f32x8(x + (size_t)row * D + col, base);
#pragma unroll
            for (int j = 0; j < 8; ++j) base[j] += pos_embed(er, ec, t, col + j); }
        else load_f32x8(ctx + (size_t)(row - T) * D + col, base);
        load_f32x8(modv + (size_t)b * MODW + 2 * D + col, m2); load_f32x8(modv + (size_t)b * MODW + 4 * D + col, m4);
        float s = 0.f;
#pragma unroll
        for (int j = 0; j < 8; ++j) { h[j] = base[j] + 0.5f * m2[j] * v[j]; s += h[j] * h[j]; a[j] = h[j] * (1.0f + m4[j]); }
        if (lat) store_f32x8(hout + (size_t)row * D + col, h);
        store_bf16x8(a2 + (size_t)row * D + col, a); return s; }
    __device__ __forceinline__ float apply(int row, int pn, int c, const float (&v0)[8], const float (&v1)[8]) const { return half_(row, 256 * pn + c, v0) + half_(row, 256 * pn + 128 + c, v1); }
};
struct EpiWin {
    const float *ssq, *sw, *lbv; bf16_t *v, *q, *g, *hy, *gab; f16_t *lfw, *lbw;
    __device__ __forceinline__ void half_(int row, int n, float rs, int b, const float (&a)[8]) const {
        float s[8], p[8]; load_f32x8(sw + (size_t)b * NIN + n, s);
#pragma unroll
        for (int j = 0; j < 8; ++j) p[j] = rs * a[j] + s[j];
        const int grp = n >> 9;
        if (grp == 0) { store_bf16x8(v + (size_t)row * 512 + n, p); }
        else if (grp <= 2) { const int nn = n - 512 * grp; f16_t* dst = (grp == 1 ? lfw : lbw) + (size_t)row * 512 + nn; f16_t o[8];
#pragma unroll
            for (int j = 0; j < 8; ++j) { const float lb = lbv[(grp - 1) * 512 + nn + j]; const float f = lb + (1.0f - lb) * sigmoidf_(p[j]); o[j] = (f16_t)__logf(f); }
            *(u32x4*)dst = *(const u32x4*)o; }
        else if (grp == 3) {
#pragma unroll
            for (int j = 0; j < 8; ++j) p[j] = siluf_(p[j]);
            store_bf16x8(q + (size_t)row * 512 + (n - 1536), p); }
        else if (grp == 4) {
#pragma unroll
            for (int j = 0; j < 8; ++j) p[j] = siluf_(p[j]);
            store_bf16x8(g + (size_t)row * 512 + (n - 2048), p); }
        else if (grp <= 7) { const int ch = n - 2560, t = row & (SEQ - 1); store_bf16x8(hy + (((size_t)(ch >> 3) * NB + b) * SEQ + t) * 8, p); }
        else {
#pragma unroll
            for (int j = 0; j < 8; ++j) p[j] = sigmoidf_(p[j]);
            store_bf16x8(gab + (size_t)row * 2048 + (n - 4096), p); }
    }
    __device__ __forceinline__ float apply(int row, int pn, int c, const float (&v0)[8], const float (&v1)[8]) const {
        const float rs = rstd_from_ssq(ssq + (size_t)row * 16); const int b = row < T ? (row >> 11) : 16;
        half_(row, 256 * pn + c, rs, b, v0); half_(row, 256 * pn + 128 + c, rs, b, v1); return 0.f; }
};
struct EpiProjA {
    const bf16_t* gab; float* ytmp;
    __device__ __forceinline__ void half_(int row, int col, const float (&a)[8]) const { float gt[8], o[8]; load_bf16x8(gab + (size_t)row * 2048 + col, gt);
#pragma unroll
        for (int j = 0; j < 8; ++j) o[j] = gt[j] * a[j];
        store_f32x8(ytmp + (size_t)row * D + col, o); }
    __device__ __forceinline__ float apply(int row, int pn, int c, const float (&v0)[8], const float (&v1)[8]) const { half_(row, 256 * pn + c, v0); half_(row, 256 * pn + 128 + c, v1); return 0.f; }
};
struct EpiProjB {
    const bf16_t* gab; const float* ytmp; bf16_t* y;
    __device__ __forceinline__ void half_(int row, int col, const float (&a)[8]) const { float gt[8], yt[8], o[8]; load_bf16x8(gab + (size_t)row * 2048 + 1024 + col, gt); load_f32x8(ytmp + (size_t)row * D + col, yt);
#pragma unroll
        for (int j = 0; j < 8; ++j) o[j] = yt[j] + gt[j] * a[j];
        store_bf16x8(y + (size_t)row * D + col, o); }
    __device__ __forceinline__ float apply(int row, int pn, int c, const float (&v0)[8], const float (&v1)[8]) const { half_(row, 256 * pn + c, v0); half_(row, 256 * pn + 128 + c, v1); return 0.f; }
};
struct EpiWout {
    const float* modv; float* h; bf16_t* a3;
    __device__ __forceinline__ float half_(int row, int col, const float (&v)[8]) const {
        const int b = row >> 11; float base[8], m5[8], m7[8], a[8];
        load_f32x8(h + (size_t)row * D + col, base); load_f32x8(modv + (size_t)b * MODW + 5 * D + col, m5); load_f32x8(modv + (size_t)b * MODW + 7 * D + col, m7);
        float s = 0.f;
#pragma unroll
        for (int j = 0; j < 8; ++j) { base[j] += m5[j] * v[j]; s += base[j] * base[j]; a[j] = base[j] * (1.0f + m7[j]); }
        store_f32x8(h + (size_t)row * D + col, base); store_bf16x8(a3 + (size_t)row * D + col, a); return s; }
    __device__ __forceinline__ float apply(int row, int pn, int c, const float (&v0)[8], const float (&v1)[8]) const { return half_(row, 256 * pn + c, v0) + half_(row, 256 * pn + 128 + c, v1); }
};
struct EpiDown2 {
    const float* modv; float* h;
    __device__ __forceinline__ float half_(int row, int col, const float (&v)[8]) const {
        const int b = row >> 11; float base[8], m8[8];
        load_f32x8(h + (size_t)row * D + col, base); load_f32x8(modv + (size_t)b * MODW + 8 * D + col, m8);
        float s = 0.f;
#pragma unroll
        for (int j = 0; j < 8; ++j) { base[j] += 0.5f * m8[j] * v[j]; s += base[j] * base[j]; }
        store_f32x8(h + (size_t)row * D + col, base); return s; }
    __device__ __forceinline__ float apply(int row, int pn, int c, const float (&v0)[8], const float (&v1)[8]) const { return half_(row, 256 * pn + c, v0) + half_(row, 256 * pn + 128 + c, v1); }
};

template <class Epi>
__device__ __forceinline__ void gemm_simple(LAS unsigned char* lds, const bf16_t* A, const bf16_t* Bt, int K, int row0, int nrows, int npn, const Epi& E, float* ssq) {
    LAS float* As = (LAS float*)lds;
    LAS float* Bs = (LAS float*)(lds + 8192);
    const int tid = threadIdx.x, c8 = tid & 15, rg = tid >> 4;
    const int nrt = nrows / 64, nunits = nrt * npn;
    for (int unit = blockIdx.x; unit < nunits; unit += gridDim.x) {
        const int rt = unit / npn, pn = unit % npn, r0 = row0 + rt * 64;
        float a0[2][8], a1[2][8];
#pragma unroll
        for (int r = 0; r < 2; ++r)
#pragma unroll
            for (int j = 0; j < 8; ++j) { a0[r][j] = 0.f; a1[r][j] = 0.f; }
        for (int k0 = 0; k0 < K; k0 += 32) {
            { const int row = tid >> 3, kq = tid & 7; const u32x2 w = *(const u32x2*)(A + (size_t)(r0 + row) * K + k0 + 4 * kq);
              As[(4 * kq + 0) * 64 + row] = __uint_as_float(w.x << 16); As[(4 * kq + 1) * 64 + row] = __uint_as_float(w.x & 0xffff0000u);
              As[(4 * kq + 2) * 64 + row] = __uint_as_float(w.y << 16); As[(4 * kq + 3) * 64 + row] = __uint_as_float(w.y & 0xffff0000u); }
            { const int n = tid >> 1, kh = tid & 1; const bf16_t* src = Bt + (size_t)(pn * 256 + n) * K + k0 + 16 * kh; float t8[8];
              load_bf16x8(src, t8);
#pragma unroll
              for (int i = 0; i < 8; ++i) Bs[(16 * kh + i) * 256 + n] = t8[i];
              load_bf16x8(src + 8, t8);
#pragma unroll
              for (int i = 0; i < 8; ++i) Bs[(16 * kh + 8 + i) * 256 + n] = t8[i]; }
            __syncthreads();
#pragma unroll 8
            for (int k = 0; k < 32; ++k) {
                const float x0 = As[k * 64 + 2 * rg], x1 = As[k * 64 + 2 * rg + 1];
                const f32x4 b00 = *(const LAS f32x4*)(Bs + k * 256 + 8 * c8), b01 = *(const LAS f32x4*)(Bs + k * 256 + 8 * c8 + 4);
                const f32x4 b10 = *(const LAS f32x4*)(Bs + k * 256 + 128 + 8 * c8), b11 = *(const LAS f32x4*)(Bs + k * 256 + 128 + 8 * c8 + 4);
#pragma unroll
                for (int j = 0; j < 4; ++j) { a0[0][j] += x0 * b00[j]; a0[0][4 + j] += x0 * b01[j]; a1[0][j] += x0 * b10[j]; a1[0][4 + j] += x0 * b11[j];
                                              a0[1][j] += x1 * b00[j]; a0[1][4 + j] += x1 * b01[j]; a1[1][j] += x1 * b10[j]; a1[1][4 + j] += x1 * b11[j]; }
            }
            __syncthreads();
        }
#pragma unroll
        for (int r = 0; r < 2; ++r) { const int row = r0 + 2 * rg + r; float s = E.apply(row, pn, 8 * c8, a0[r], a1[r]);
            s += __shfl_xor(s, 1); s += __shfl_xor(s, 2); s += __shfl_xor(s, 4); s += __shfl_xor(s, 8);
            if (ssq && c8 == 0) *(f32x4*)(ssq + (size_t)row * 16 + pn * 4) = (f32x4){s, 0.f, 0.f, 0.f}; }
    }
}

namespace pg8 {
#define PG8_LAS __attribute__((address_space(3)))
typedef unsigned short bf16_t;
typedef short bf16x8 __attribute__((ext_vector_type(8)));
typedef float f32x4 __attribute__((ext_vector_type(4)));
typedef unsigned u32x4 __attribute__((ext_vector_type(4)));
constexpr int BM = 256, BK = 64, HALF = 128, HTB = HALF * BK * 2  , STAGE_BYTES = 8 * HTB, NXCD = 8, WGM = 8;

__host__ __device__ __forceinline__ int lds_byte(int r, int c) { const int st = (r >> 4) * 2 + (c >> 5), rr = r & 15, cc = c & 31, ob = rr * 64 + cc * 2; return st * 1024 + (ob ^ (((ob >> 9) & 1) << 5)); }
__host__ __device__ __forceinline__ void stage_rc(int b, int& R, int& C) { const int st = b / 1024, sb = b % 1024, swz = sb ^ (((sb >> 9) & 1) << 5); R = (st >> 1) * 16 + swz / 64; C = (st & 1) * 32 + (swz % 64) / 2; }
__host__ __device__ __forceinline__ int perm32(int rho) { const int n = rho >> 4, i = rho & 15; return 8 * (i >> 2) + 4 * n + (i & 3); }

struct Unit { int pm, pn; };
struct Gemm { const bf16_t* A; const bf16_t* Bt; int M, N, K; };

struct StaticOrder {
    int nM, nN, nwg, G, c;
    __host__ __device__ void init(int M, int N, int G_, int c_) { nM = M / BM; nN = N / BM; nwg = nM * nN; G = G_; c = c_; }
    __host__ __device__ bool next(int i, Unit& u) const {
        const long L = (long)i * G + c; if (L >= nwg) return false;
        int wgid = (int)L; { const int q = nwg / NXCD, r = nwg % NXCD, xcd = wgid % NXCD, off = wgid / NXCD; wgid = (xcd < r ? xcd * (q + 1) : r * (q + 1) + (xcd - r) * q) + off; }
        const int nig = WGM * nN, gid = wgid / nig, fm = gid * WGM, gsz = (nM - fm) < WGM ? (nM - fm) : WGM;
        u.pm = fm + ((wgid % nig) % gsz); u.pn = (wgid % nig) / gsz; return true;
    }
    __device__ __forceinline__ void a_ready(const Unit&) const {}
    __device__ __forceinline__ void done(const Unit&) const {}
};
template <class Epi, class Sched>
__device__ __forceinline__ void gemm_phase(PG8_LAS unsigned char* lds, const Gemm g, const Sched& S, const Epi& E) {
    const int tid = threadIdx.x, wid = __builtin_amdgcn_readfirstlane(tid >> 6), lane = tid & 63, wr = wid >> 2, wc = wid & 3, fr = lane & 15, fq = lane >> 4;
    const int K = g.K, nt = K / BK;
    unsigned voffA[2], voffB[2];
#pragma unroll
    for (int i = 0; i < 2; ++i) { int R, C; stage_rc(tid * 16 + i * 8192, R, C); const int Rb = Epi::PERM ? ((R & ~31) + perm32(R & 31)) : R;
        voffA[i] = (unsigned)(R * K + C) * 2u; voffB[i] = (unsigned)(Rb * K + C) * 2u; }
    const size_t kstep = (size_t)(BK * 2);
    const size_t hstep = (size_t)HALF * K * 2;
    const size_t tstep = 2 * hstep;
    const unsigned ldsw = (unsigned)wid * 1024u;
    const int aoff = lds_byte(wr * 64 + fr, fq * 8), boff = lds_byte(wc * 32 + fr, fq * 8);
#define PG8_SA(b, h) (((b) * 2 + (h)) * HTB)
#define PG8_SB(b, h) ((4 + (b) * 2 + (h)) * HTB)
#define PG8_STAGE(bufoff, gbase, voff) do { _Pragma("unroll") for (int _i = 0; _i < 2; ++_i) \
        __builtin_amdgcn_global_load_lds((const unsigned*)((const char*)(gbase) + (voff)[_i]), (PG8_LAS unsigned*)(lds + (bufoff) + ldsw + _i * 8192), 16, 0, 0); } while (0)
#define PG8_LDA(dst, b, h) do { _Pragma("unroll") for (int m = 0; m < 4; ++m) _Pragma("unroll") for (int k = 0; k < 2; ++k) dst[m][k] = *(const PG8_LAS bf16x8*)(lds + PG8_SA(b, h) + aoff + m * 2048 + k * 1024); } while (0)
#define PG8_LDB(dst, b, h) do { _Pragma("unroll") for (int n = 0; n < 2; ++n) _Pragma("unroll") for (int k = 0; k < 2; ++k) dst[n][k] = *(const PG8_LAS bf16x8*)(lds + PG8_SB(b, h) + boff + n * 2048 + k * 1024); } while (0)
#define PG8_MMA(ai, bj, At, Bt) do { __builtin_amdgcn_s_setprio(1); _Pragma("unroll") for (int m = 0; m < 4; ++m) _Pragma("unroll") for (int n = 0; n < 2; ++n) _Pragma("unroll") for (int k = 0; k < 2; ++k) \
        acc[ai][bj][m][n] = __builtin_amdgcn_mfma_f32_16x16x32_bf16(Bt[n][k], At[m][k], acc[ai][bj][m][n], 0, 0, 0); __builtin_amdgcn_s_setprio(0); } while (0)
#define PG8_WAIT_V(n) asm volatile("s_waitcnt vmcnt(" #n ")" ::: "memory")
#define PG8_WAIT_L(n) asm volatile("s_waitcnt lgkmcnt(" #n ")" ::: "memory")
#define PG8_BAR __builtin_amdgcn_s_barrier()
#define PG8_SCHED __builtin_amdgcn_sched_barrier(0)
    Unit cur, nxt; int ui = 0;
    if (!S.next(0, cur)) return;
    f32x4 acc[2][2][4][2];
#pragma unroll
    for (int a = 0; a < 2; ++a)
#pragma unroll
        for (int b = 0; b < 2; ++b)
#pragma unroll
            for (int m = 0; m < 4; ++m)
#pragma unroll
                for (int n = 0; n < 2; ++n) acc[a][b][m][n] = (f32x4){0.f, 0.f, 0.f, 0.f};
    bf16x8 At[4][2], B0[2][2], B1[2][2];
    const char* cA = (const char*)g.A + (size_t)cur.pm * tstep; const char* cB = (const char*)g.Bt + (size_t)cur.pn * tstep;
    S.a_ready(cur);
    PG8_STAGE(PG8_SB(0, 0), cB, voffB); PG8_STAGE(PG8_SA(0, 0), cA, voffA); PG8_STAGE(PG8_SB(0, 1), cB + hstep, voffB); PG8_STAGE(PG8_SA(0, 1), cA + hstep, voffA);
    if (wr == 1) PG8_BAR;
    PG8_WAIT_V(4); PG8_BAR;
    PG8_STAGE(PG8_SB(1, 0), cB + kstep, voffB); PG8_STAGE(PG8_SA(1, 0), cA + kstep, voffA); PG8_STAGE(PG8_SB(1, 1), cB + hstep + kstep, voffB);
    PG8_WAIT_V(6); PG8_BAR;
    for (;;) {
        const bool has_next = S.next(ui + 1, nxt);
        const char* nA = has_next ? (const char*)g.A + (size_t)nxt.pm * tstep : cA; const char* nB = has_next ? (const char*)g.Bt + (size_t)nxt.pn * tstep : cB;
        for (int t = 0; t < nt; t += 2) {
            const bool last = (t == nt - 2);
            const char* a1 = cA + (size_t)(t + 1) * kstep;
            const char* a2 = last ? nA : cA + (size_t)(t + 2) * kstep; const char* b2 = last ? nB : cB + (size_t)(t + 2) * kstep;
            const char* a3 = a2 + kstep; const char* b3 = b2 + kstep;
            if (last && has_next) S.a_ready(nxt);
            PG8_LDB(B0, 0, 0); PG8_SCHED; PG8_LDA(At, 0, 0); PG8_STAGE(PG8_SA(1, 1), a1 + hstep, voffA);
            PG8_WAIT_L(8); PG8_BAR; PG8_WAIT_L(0); PG8_MMA(0, 0, At, B0); PG8_BAR; PG8_SCHED;
            PG8_LDB(B1, 0, 1); PG8_STAGE(PG8_SB(0, 0), b2, voffB);
            PG8_BAR; PG8_WAIT_L(0); PG8_MMA(0, 1, At, B1); PG8_BAR;
            PG8_LDA(At, 0, 1); PG8_STAGE(PG8_SA(0, 0), a2, voffA);
            PG8_BAR; PG8_WAIT_L(0); PG8_MMA(1, 0, At, B0); PG8_BAR; PG8_SCHED;
            PG8_STAGE(PG8_SB(0, 1), b2 + hstep, voffB);
            PG8_WAIT_V(6); PG8_BAR; PG8_MMA(1, 1, At, B1); PG8_BAR;
            PG8_LDB(B0, 1, 0); PG8_SCHED; PG8_LDA(At, 1, 0); PG8_STAGE(PG8_SA(0, 1), a2 + hstep, voffA);
            PG8_WAIT_L(8); PG8_BAR; PG8_WAIT_L(0); PG8_MMA(0, 0, At, B0); PG8_BAR; PG8_SCHED;
            PG8_LDB(B1, 1, 1); PG8_STAGE(PG8_SB(1, 0), b3, voffB);
            PG8_BAR; PG8_WAIT_L(0); PG8_MMA(0, 1, At, B1); PG8_BAR;
            PG8_LDA(At, 1, 1); PG8_STAGE(PG8_SA(1, 0), a3, voffA);
            PG8_BAR; PG8_WAIT_L(0); PG8_MMA(1, 0, At, B0); PG8_BAR; PG8_SCHED;
            PG8_STAGE(PG8_SB(1, 1), b3 + hstep, voffB);
            PG8_WAIT_V(6); PG8_BAR; PG8_MMA(1, 1, At, B1); PG8_BAR;
        }
        if constexpr (!Epi::AFTER_DRAIN) { E(acc, cur, wr, wc, fr, fq); S.done(cur); }
        if (!has_next) break;
#pragma unroll
        for (int a = 0; a < 2; ++a)
#pragma unroll
            for (int b = 0; b < 2; ++b)
#pragma unroll
                for (int m = 0; m < 4; ++m)
#pragma unroll
                    for (int n = 0; n < 2; ++n) acc[a][b][m][n] = (f32x4){0.f, 0.f, 0.f, 0.f};
        cur = nxt; cA = nA; cB = nB; ++ui;
    }
    PG8_WAIT_V(0);
    if (wr == 0) PG8_BAR;
    PG8_BAR;
    if constexpr (Epi::AFTER_DRAIN) { E.fused(acc, cur, wr, wc, fr, fq, lds, wid, lane); S.done(cur); }
#undef PG8_SA
#undef PG8_SB
#undef PG8_STAGE
#undef PG8_LDA
#undef PG8_LDB
#undef PG8_MMA
#undef PG8_WAIT_V
#undef PG8_WAIT_L
#undef PG8_BAR
#undef PG8_SCHED
}
}

template <class F> struct EpiAd {
    static constexpr bool PERM = true, AFTER_DRAIN = false;
    F f; float* ssq;
    __device__ __forceinline__ void operator()(const pg8::f32x4 (&acc)[2][2][4][2], const pg8::Unit& u, int wr, int wc, int fr, int fq) const {
#pragma unroll
        for (int ai = 0; ai < 2; ++ai)
#pragma unroll
            for (int m = 0; m < 4; ++m) { const int row = u.pm * 256 + ai * 128 + wr * 64 + m * 16 + fr;
                float v0[8], v1[8];
#pragma unroll
                for (int n = 0; n < 2; ++n)
#pragma unroll
                    for (int e = 0; e < 4; ++e) { v0[4 * n + e] = acc[ai][0][m][n][e]; v1[4 * n + e] = acc[ai][1][m][n][e]; }
                float s = f.apply(row, u.pn, wc * 32 + 8 * fq, v0, v1);
                if (ssq) { s += __shfl_xor(s, 16); s += __shfl_xor(s, 32); if (fq == 0) ssq[(size_t)row * 16 + u.pn * 4 + wc] = s; } }
    }
};
struct TwoPartOrder {
    pg8::StaticOrder s1; int n1, nM1, nM2, n2, G, c;
    __device__ void init(int nM1_, int nN1, int nM2_, int nN2, int G_, int c_) { s1.init(nM1_ * 256, nN1 * 256, G_, c_); n1 = nM1_ * nN1; nM1 = nM1_; nM2 = nM2_; n2 = nM2_ * nN2; G = G_; c = c_; }
    __device__ bool next(int i, pg8::Unit& u) const { long L = (long)i * G + c; if (L < n1) return s1.next(i, u); L -= n1; if (L >= n2) return false; u.pm = nM1 + (int)(L % nM2); u.pn = (int)(L / nM2); return true; }
    __device__ __forceinline__ void a_ready(const pg8::Unit&) const {}
    __device__ __forceinline__ void done(const pg8::Unit&) const {}
};
template <class F>
__device__ __forceinline__ void gemm_mfma(LAS unsigned char* lds, const bf16_t* A, const bf16_t* Bt, int K, int nrows1, int npn1, int nrows2, int npn2, const F& f, float* ssq) {
    __syncthreads();
    pg8::Gemm g{A, Bt, nrows1 + nrows2, npn1 * 256, K}; TwoPartOrder S; S.init(nrows1 / 256, npn1, nrows2 / 256, npn2, (int)gridDim.x, (int)blockIdx.x);
    EpiAd<F> E{f, ssq};
    pg8::gemm_phase(lds, g, S, E);
    __syncthreads();
}

struct Ctx { LAS unsigned char* lds; int tid, lane, wid, gw, ngw; };

__device__ __forceinline__ void phase_prep(const Params& p, const Ctx& c) {
    unsigned char* ws = p.ws;
    LAS float* scr = (LAS float*)(c.lds + c.wid * 8448);
    transpose_matrix(p.w_in, D, NIN, (bf16_t*)(ws + WS_WIN_T), scr, c.gw, c.ngw, c.lane);
    transpose_matrix(p.w_pa, 512, D, (bf16_t*)(ws + WS_WPA_T), scr, c.gw, c.ngw, c.lane);
    transpose_matrix(p.w_pb, 512, D, (bf16_t*)(ws + WS_WPB_T), scr, c.gw, c.ngw, c.lane);
    transpose_matrix(p.w_out, D, D, (bf16_t*)(ws + WS_WOUT_T), scr, c.gw, c.ngw, c.lane);
    transpose_gu(p.ffn_wg, 0, (bf16_t*)(ws + WS_WG1_T), scr, c.gw, c.ngw, c.lane);
    transpose_gu(p.ffn_wu, 1, (bf16_t*)(ws + WS_WG1_T), scr, c.gw, c.ngw, c.lane);
    transpose_matrix(p.ffn_wd, DFF, D, (bf16_t*)(ws + WS_WD1_T), scr, c.gw, c.ngw, c.lane);
    __syncthreads();
    if ((int)blockIdx.x < MODW / 64) {
        LAS float* xs = (LAS float*)c.lds; LAS float* part = (LAS float*)(c.lds + 17 * 1024 * 4);
        for (int i = c.tid; i < 17 * 1024; i += NTHR) { const int r = i >> 10, k = i & 1023; const float v = r < 16 ? p.c[r * D + k] : p.c_ctx[k]; xs[i] = v / (1.0f + expf(-v)); }
        __syncthreads();
        gemv17<false>(xs, part, p.mod_w, MODW, p.mod_b, (float*)(ws + WS_MODV), MODW, 0, blockIdx.x, gridDim.x);
    }
    { float* er = (float*)(ws + WS_ER); float* ec = (float*)(ws + WS_EC); float* lbv = (float*)(ws + WS_LBV);
      const int gt = blockIdx.x * NTHR + c.tid, ngt = gridDim.x * NTHR;
      for (int i = gt; i < 96 * 512; i += ngt) { const int r = i >> 9, j = i & 511, jj = j & 255; const float omega = 1.0f / powf(10000.0f, (float)jj / 256.0f);
          const int pos = r < 32 ? r : r - 32; const float a = (float)pos * omega; const float v = j < 256 ? sinf(a) : cosf(a);
          if (r < 32) er[r * 512 + j] = v; else ec[(r - 32) * 512 + j] = v; }
      for (int i = gt; i < 1024; i += ngt) { const float l0 = p.lb_logits[i], l1 = p.lb_logits[1024 + i]; lbv[i] = 1.0f / (1.0f + expf(l1 - l0)); } }
    { LAS float* zf = (LAS float*)c.lds; LAS float* h1 = zf + 8 * 40; float* h2o = (float*)(ws + WS_H2);
      for (int it = blockIdx.x; it < SEQ / 8; it += gridDim.x) {
          __syncthreads();
          if (c.tid < 8 * 33) { const int r = c.tid / 33, f = c.tid % 33; const int pp = it * 8 + r; float v;
              if (f == 0) v = (float)pp / (float)(SEQ - 1);
              else { const int i = (f - 1) & 15; const float w = 6.283185307179586f * (float)pp / (float)SEQ; const float fr = 1e-4f + (float)i * ((15.0f - 1e-4f) / 15.0f); const float ang = w * fr; v = f <= 16 ? cosf(ang) : -sinf(ang); }
              zf[r * 40 + f] = v; }
          __syncthreads();
          { const int r = c.tid >> 6, j = c.tid & 63; float s = p.hb1[j];
            for (int f = 0; f < 33; ++f) s += zf[r * 40 + f] * p.hw1[f * 64 + j];
            h1[r * 64 + j] = sinf(p.hfr1[j] * s); }
          __syncthreads();
          { const int r = c.tid >> 6, j = c.tid & 63; float s = p.hb2[j];
            for (int k = 0; k < 64; ++k) s += h1[r * 64 + k] * p.hw2[k * 64 + j];
            h2o[(size_t)(it * 8 + r) * 64 + j] = sinf(p.hfr2[j] * s); }
      } }
}

__device__ __forceinline__ void phase_n1(const Params& p, const Ctx& c) {
    unsigned char* ws = p.ws;
    const float* modv = (const float*)(ws + WS_MODV); const float* er = (const float*)(ws + WS_ER); const float* ec = (const float*)(ws + WS_EC);
    bf16_t* n1 = (bf16_t*)(ws + WS_N1);
    for (int row = c.gw; row < MT; row += c.ngw) {
        const bool lat = row < T; const int b = lat ? (row >> 11) : 16, t = row & (SEQ - 1);
        const float* src = lat ? p.x + (size_t)row * D : p.ctx + (size_t)(row - T) * D;
        f32x4 v[4]; float s = 0.f;
#pragma unroll
        for (int j = 0; j < 4; ++j) { const int col = 4 * c.lane + 256 * j; v[j] = *(const f32x4*)(src + col);
            if (lat) { const float* pe = col < 512 ? er + (t >> 6) * 512 + col : ec + (t & 63) * 512 + (col - 512); v[j] += *(const f32x4*)pe; }
            s += (v[j][0] * v[j][0] + v[j][1] * v[j][1]) + (v[j][2] * v[j][2] + v[j][3] * v[j][3]); }
        const float rs = 1.0f / sqrtf(wave_sum(s) * (1.0f / D) + RMS_EPS);
#pragma unroll
        for (int j = 0; j < 4; ++j) { const int col = 4 * c.lane + 256 * j; const f32x4 sh = *(const f32x4*)(modv + (size_t)b * MODW + col), sc = *(const f32x4*)(modv + (size_t)b * MODW + D + col);
            const f32x4 o = v[j] * rs * (sc + 1.0f) + sh; u32x2 w; w.x = pk2(o[0], o[1]); w.y = pk2(o[2], o[3]); *(u32x2*)(n1 + (size_t)row * D + col) = w; }
    }
    { LAS float* xs = (LAS float*)c.lds; LAS float* part = (LAS float*)(c.lds + 17 * 1024 * 4);
      const int nb_in = NIN / 64, nb_g = DFF / 64;
      for (int bx = blockIdx.x; bx < nb_in + 2 * nb_g; bx += gridDim.x) {
          __syncthreads();
          if (bx < nb_in) {
              for (int i = c.tid; i < 17 * 1024; i += NTHR) xs[i] = modv[(size_t)(i >> 10) * MODW + 3 * D + (i & 1023)];
              __syncthreads();
              gemv17<false>(xs, part, p.w_in, NIN, nullptr, (float*)(ws + WS_SWIN), NIN, 0, bx, nb_in); }
          else { const int half = (bx - nb_in) / nb_g, blk = (bx - nb_in) % nb_g;
              for (int i = c.tid; i < 17 * 1024; i += NTHR) xs[i] = modv[(size_t)(i >> 10) * MODW + 6 * D + (i & 1023)];
              __syncthreads();
              const float* W = (half ? p.ffn_wu : p.ffn_wg) + (size_t)D * DFF;
              gemv17<true>(xs, part, W, DFF, nullptr, (float*)(ws + WS_SW2), NGU, half, blk, nb_g); }
      }
    }
    { LAS float* w3s = (LAS float*)c.lds;
      LAS float* hk = w3s + 512;
      LAS float* red = hk + 2048 * 8;
      const float* h2 = (const float*)(ws + WS_H2); bf16_t* krev = (bf16_t*)(ws + WS_KREV);
      for (int it = blockIdx.x; it < 256; it += gridDim.x) {
          const int c0 = 2 * it;
          __syncthreads();
          { const int k = c.tid >> 3, q = c.tid & 7; w3s[c.tid] = p.hw3[(size_t)k * 2048 + (q >> 2) * 1024 + ((q >> 1) & 1) * 512 + c0 + (q & 1)]; }
          __syncthreads();
          float l1[4] = {0.f, 0.f, 0.f, 0.f};
          for (int idx = c.tid; idx < 2048 * 8; idx += NTHR) { const int t = idx >> 3, q = idx & 7; float s = 0.f;
              const float* hr = h2 + (size_t)t * 64;
#pragma unroll 8
              for (int k = 0; k < 64; ++k) s += hr[k] * w3s[k * 8 + q];
              const int ch = c0 + (q & 1); const float delta = fabsf(-3.0701134573253945f + (float)ch * ((-15.350567286626973f + 3.0701134573253945f) / 511.0f));
              const float tn = (float)t / (float)(SEQ - 1); s *= expf(-tn * delta) + 0.05f;
              hk[idx] = s; l1[0] += fabsf(s); }
          { float s = l1[0]; s += __shfl_xor(s, 2); s += __shfl_xor(s, 8); s += __shfl_xor(s, 16); s += __shfl_xor(s, 32);
            if ((c.lane & ~5) == 0) red[c.wid * 4 + ((c.lane >> 2) & 1) * 2 + (c.lane & 1)] = s; }
          __syncthreads();
          for (int e = c.tid; e < 4 * KR_LEN; e += NTHR) { const int oc = e / KR_LEN, i = (e % KR_LEN) - KR_OFF, o = oc >> 1, cc = oc & 1;
              float tot = 0.f;
#pragma unroll
              for (int w = 0; w < 8; ++w) tot += red[w * 4 + oc];
              const int lag = -i; float v = 0.f;
              if (lag >= 0 && lag <= SEQ - 1) v = hk[lag * 8 + o * 4 + 0 + cc]; else if (lag < 0 && lag >= -(SEQ - 1)) v = hk[(-lag - 1) * 8 + o * 4 + 2 + cc];
              krev[((size_t)o * 512 + c0 + cc) * KR_LEN + (e % KR_LEN)] = f2bf(v / (tot + 1e-6f)); }
      } }
}

__device__ __forceinline__ void phase_hgrn_simple(const Params& p, const Ctx& c) {
    unsigned char* ws = p.ws;
    const bf16_t* vb = (const bf16_t*)(ws + WS_V); const bf16_t* qb = (const bf16_t*)(ws + WS_Q);
    LAS float* F = (LAS float*)c.lds; LAS float* Kk = F + 64 * 128; LAS float* Q = Kk + 64 * 128; LAS float* V = Q + 64 * 128;
    const int dg = c.tid & 3, e = c.tid >> 2;
    for (int it = blockIdx.x; it < NB * 4 * 2; it += gridDim.x) {
        const int dir = it & 1, h = (it >> 1) & 3, b = it >> 3;
        const f16_t* lf = (const f16_t*)(ws + (dir ? WS_LBW : WS_LFW)); float* outp = (float*)(ws + (dir ? WS_OBW : WS_OFW));
        float S[32];
#pragma unroll
        for (int i = 0; i < 32; ++i) S[i] = 0.f;
        for (int ci = 0; ci < 36; ++ci) {
            const bool lat = ci >= 4;
            __syncthreads();
            for (int idx = c.tid; idx < 64 * 128; idx += NTHR) { const int j = idx >> 7, d = idx & 127; const int pp = (lat ? ci - 4 : ci) * 64 + j;
                const int row = lat ? b * SEQ + (dir ? SEQ - 1 - pp : pp) : T + b * CL + (dir ? CL - 1 - pp : pp);
                const float f = __expf((float)lf[(size_t)row * 512 + h * 128 + d]);
                F[idx] = f; Kk[idx] = 1.0f - f; V[idx] = bf2f(vb[(size_t)row * 512 + h * 128 + d]); Q[idx] = lat ? bf2f(qb[(size_t)row * 512 + h * 128 + d]) : 0.f; }
            __syncthreads();
            for (int j = 0; j < 64; ++j) { const float ve = V[j * 128 + e]; float part = 0.f;
#pragma unroll
                for (int i = 0; i < 32; ++i) { const int d = dg * 32 + i; S[i] = F[j * 128 + d] * S[i] + Kk[j * 128 + d] * ve; part += S[i] * Q[j * 128 + d]; }
                part += __shfl_xor(part, 1); part += __shfl_xor(part, 2);
                if (lat && dg == 0) { const int pp = (ci - 4) * 64 + j; const int row = b * SEQ + (dir ? SEQ - 1 - pp : pp); outp[(size_t)row * 512 + h * 128 + e] = part; } }
        }
    }
}

__device__ __forceinline__ float hy_tap(const bf16_t* hy, const float* cw, const float* cb, int ch, int b, int t) {
    const bf16_t* src = hy + (((size_t)(ch >> 3) * NB + b) * SEQ) * 8 + (ch & 7); float s = cb[ch];
#pragma unroll
    for (int j = 0; j < 3; ++j) { const int tt = t + j - 1; if (tt >= 0 && tt < SEQ) s += cw[j * NHY + ch] * bf2f(src[(size_t)tt * 8]); }
    return s;
}
__device__ __forceinline__ void phase_hyena_simple(const Params& p, const Ctx& c) {
    unsigned char* ws = p.ws;
    const bf16_t* hy = (const bf16_t*)(ws + WS_HY); const bf16_t* krev = (const bf16_t*)(ws + WS_KREV); bf16_t* zb = (bf16_t*)(ws + WS_ZB);
    LAS float* zs = (LAS float*)c.lds;
    LAS float* kr = zs + 2048 * 16;
    for (int ch = blockIdx.x; ch < BW; ch += gridDim.x) {
        __syncthreads();
        for (int idx = c.tid; idx < NB * SEQ; idx += NTHR) { const int b = idx >> 11, t = idx & (SEQ - 1); zs[t * 16 + b] = bfround(hy_tap(hy, p.conv_w, p.conv_b, ch, b, t)); }
        for (int o = 0; o < 2; ++o) {
            for (int i = c.tid; i < KR_LEN; i += NTHR) kr[i] = bf2f(krev[((size_t)o * 512 + ch) * KR_LEN + i]);
            __syncthreads();
            const int t0 = 4 * c.tid;
            float acc[4][16];
#pragma unroll
            for (int r = 0; r < 4; ++r)
#pragma unroll
                for (int b = 0; b < 16; ++b) acc[r][b] = 0.f;
            float w0, w1 = kr[KR_OFF - t0 - 1], w2 = kr[KR_OFF - t0 - 2], w3 = kr[KR_OFF - t0 - 3];
            for (int s = 0; s < SEQ; ++s) {
                w0 = kr[KR_OFF + s - t0];
                const f32x4 z0 = *(const LAS f32x4*)(zs + s * 16), z1 = *(const LAS f32x4*)(zs + s * 16 + 4), z2 = *(const LAS f32x4*)(zs + s * 16 + 8), z3 = *(const LAS f32x4*)(zs + s * 16 + 12);
#pragma unroll
                for (int j = 0; j < 4; ++j) { acc[0][j] += w0 * z0[j]; acc[0][4 + j] += w0 * z1[j]; acc[0][8 + j] += w0 * z2[j]; acc[0][12 + j] += w0 * z3[j];
                                              acc[1][j] += w1 * z0[j]; acc[1][4 + j] += w1 * z1[j]; acc[1][8 + j] += w1 * z2[j]; acc[1][12 + j] += w1 * z3[j];
                                              acc[2][j] += w2 * z0[j]; acc[2][4 + j] += w2 * z1[j]; acc[2][8 + j] += w2 * z2[j]; acc[2][12 + j] += w2 * z3[j];
                                              acc[3][j] += w3 * z0[j]; acc[3][4 + j] += w3 * z1[j]; acc[3][8 + j] += w3 * z2[j]; acc[3][12 + j] += w3 * z3[j]; }
                w3 = w2; w2 = w1; w1 = w0;
            }
            const float bias = p.hy_bias[o * 512 + ch];
#pragma unroll
            for (int r = 0; r < 4; ++r)
#pragma unroll
                for (int b = 0; b < 16; ++b) acc[r][b] += bias * zs[(t0 + r) * 16 + b];
            __syncthreads();
#pragma unroll
            for (int r = 0; r < 4; ++r)
#pragma unroll
                for (int b4 = 0; b4 < 4; ++b4) *(LAS f32x4*)(zs + (t0 + r) * 16 + 4 * b4) = (f32x4){acc[r][4 * b4], acc[r][4 * b4 + 1], acc[r][4 * b4 + 2], acc[r][4 * b4 + 3]};
#pragma unroll 1
            for (int i = 0; i < 64; ++i) { const int r = i >> 4, b = i & 15, t = t0 + r; const float gate = hy_tap(hy, p.conv_w, p.conv_b, (o + 1) * 512 + ch, b, t);
                const float zn = gate * zs[t * 16 + b];
                if (o == 0) zs[t * 16 + b] = bfround(zn); else zb[((size_t)ch * NB + b) * SEQ + t] = f2bf(zn); }
            __syncthreads();
        }
    }
}

__device__ __forceinline__ void phase_combine(const Params& p, const Ctx& c) {
    unsigned char* ws = p.ws;
    const float* ofw = (const float*)(ws + WS_OFW); const float* obw = (const float*)(ws + WS_OBW); const bf16_t* g = (const bf16_t*)(ws + WS_G);
    bf16_t* oa = (bf16_t*)(ws + WS_OA); bf16_t* ob = (bf16_t*)(ws + WS_OB); const bf16_t* zb = (const bf16_t*)(ws + WS_ZB);
    for (int row = c.gw; row < T; row += c.ngw) { const int col = 8 * c.lane; float a[8], bq[8], gg[8], w[8], o[8];
        load_f32x8(ofw + (size_t)row * 512 + col, a); load_f32x8(obw + (size_t)row * 512 + col, bq); load_bf16x8(g + (size_t)row * 512 + col, gg); load_f32x8(p.a_norm_w + (col & 127), w);
        float s = 0.f;
#pragma unroll
        for (int j = 0; j < 8; ++j) { a[j] += bq[j]; s += a[j] * a[j]; }
        s += __shfl_xor(s, 1); s += __shfl_xor(s, 2); s += __shfl_xor(s, 4); s += __shfl_xor(s, 8);
        const float rs = 1.0f / sqrtf(s * (1.0f / 128.0f) + RMS_EPS);
#pragma unroll
        for (int j = 0; j < 8; ++j) o[j] = a[j] * rs * w[j] * gg[j];
        store_bf16x8(oa + (size_t)row * 512 + col, o); }
    LAS bf16_t* tile = (LAS bf16_t*)c.lds;
    for (int it = blockIdx.x; it < NB * 32 * 8; it += gridDim.x) { const int cb = it & 7, tb = (it >> 3) & 31, b = it >> 8;
        __syncthreads();
        { const int cl = c.tid >> 3, t8 = (c.tid & 7) * 8; const u32x4 w = *(const u32x4*)(zb + ((size_t)(cb * 64 + cl) * NB + b) * SEQ + tb * 64 + t8); *(LAS u32x4*)(tile + cl * 72 + t8) = w; }
        __syncthreads();
        { const int tl = c.tid >> 3, c8 = (c.tid & 7) * 8; bf16_t v[8];
#pragma unroll
          for (int i = 0; i < 8; ++i) v[i] = tile[(c8 + i) * 72 + tl];
          u32x4 w; w.x = v[0] | ((unsigned)v[1] << 16); w.y = v[2] | ((unsigned)v[3] << 16); w.z = v[4] | ((unsigned)v[5] << 16); w.w = v[6] | ((unsigned)v[7] << 16);
          *(u32x4*)(ob + ((size_t)b * SEQ + tb * 64 + tl) * 512 + cb * 64 + c8) = w; }
    }
}

__device__ __forceinline__ void phase_final(const Params& p, const Ctx& c) {
    const float* ssq = (const float*)(p.ws + WS_SSQ3);
    for (int row = c.gw; row < T; row += c.ngw) { const float rs = rstd_from_ssq(ssq + (size_t)row * 16);
#pragma unroll
        for (int j = 0; j < 4; ++j) { const int col = 4 * c.lane + 256 * j; f32x4* ptr = (f32x4*)(p.out + (size_t)row * D + col); *ptr = *ptr * rs * *(const f32x4*)(p.fnw + col); } }
}

constexpr int N_PHASES = 13;
__global__ void __launch_bounds__(NTHR, 2) fwd_kernel(Params p) {
    extern __shared__ __attribute__((aligned(16))) unsigned char lds_raw[];
    Ctx c; c.lds = (LAS unsigned char*)lds_raw; c.tid = threadIdx.x; c.lane = c.tid & 63; c.wid = __builtin_amdgcn_readfirstlane(c.tid >> 6);
    c.gw = blockIdx.x * NWAVES + c.wid; c.ngw = gridDim.x * NWAVES;
    unsigned char* ws = p.ws;
    const float* modv = (const float*)(ws + WS_MODV);
#if N_LAUNCH_MODE == 1
    cg::grid_group grid = cg::this_grid();
#define SEAM() grid.sync()
#else
#define SEAM() do { } while (0)
#endif
#ifdef ONLY_PHASE
#define IN(k) ((k) == ONLY_PHASE && p.ph_lo <= (k) && (k) < p.ph_hi)
#else
#define IN(k) (p.ph_lo <= (k) && (k) < p.ph_hi)
#endif
#if USE_PG8
#define GEMM2(A_, Bt_, K_, nrows1_, npn1_, nrows2_, npn2_, E_, ssq_) gemm_mfma(c.lds, A_, Bt_, K_, nrows1_, npn1_, nrows2_, npn2_, E_, ssq_)
#else
#define GEMM2(A_, Bt_, K_, nrows1_, npn1_, nrows2_, npn2_, E_, ssq_) do { gemm_simple(c.lds, A_, Bt_, K_, 0, nrows1_, npn1_, E_, ssq_); if ((nrows2_) > 0) gemm_simple(c.lds, A_, Bt_, K_, nrows1_, nrows2_, npn2_, E_, ssq_); } while (0)
#endif
#define GEMM(A_, Bt_, K_, row0_, nrows_, npn_, E_, ssq_) GEMM2(A_, Bt_, K_, nrows_, npn_, 0, 0, E_, ssq_)
    if (IN(0)) { phase_prep(p, c); if (IN(1)) SEAM(); }
    if (IN(1)) { phase_n1(p, c); if (IN(2)) SEAM(); }
    if (IN(2)) { EpiGateUp1 E{(bf16_t*)(ws + WS_HID)};
        GEMM((const bf16_t*)(ws + WS_N1), (const bf16_t*)(ws + WS_WG1_T), D, 0, MT, NGU / 256, E, nullptr); if (IN(3)) SEAM(); }
    if (IN(3)) { EpiDown1 E{p.x, p.ctx, (const float*)(ws + WS_ER), (const float*)(ws + WS_EC), modv, p.out, (bf16_t*)(ws + WS_A2)};
        GEMM((const bf16_t*)(ws + WS_HID), (const bf16_t*)(ws + WS_WD1_T), DFF, 0, MT, D / 256, E, (float*)(ws + WS_SSQ1)); if (IN(4)) SEAM(); }
    if (IN(4)) { EpiWin E{(const float*)(ws + WS_SSQ1), (const float*)(ws + WS_SWIN), (const float*)(ws + WS_LBV), (bf16_t*)(ws + WS_V), (bf16_t*)(ws + WS_Q), (bf16_t*)(ws + WS_G), (bf16_t*)(ws + WS_HY), (bf16_t*)(ws + WS_GAB), (f16_t*)(ws + WS_LFW), (f16_t*)(ws + WS_LBW)};
        GEMM2((const bf16_t*)(ws + WS_A2), (const bf16_t*)(ws + WS_WIN_T), D, T, NIN / 256, TC, 6, E, nullptr); if (IN(5)) SEAM(); }
    if (IN(5)) {
        { LAS float* scr = (LAS float*)(c.lds + c.wid * 8448);
          transpose_gu(p.ffn_wg + (size_t)D * DFF, 0, (bf16_t*)(ws + WS_WG2_T), scr, c.gw, c.ngw, c.lane);
          transpose_gu(p.ffn_wu + (size_t)D * DFF, 1, (bf16_t*)(ws + WS_WG2_T), scr, c.gw, c.ngw, c.lane);
          transpose_matrix(p.ffn_wd + (size_t)DFF * D, DFF, D, (bf16_t*)(ws + WS_WD2_T), scr, c.gw, c.ngw, c.lane); }
        phase_hyena_simple(p, c); if (IN(6)) SEAM(); }
    if (IN(6)) { phase_hgrn_simple(p, c); if (IN(7)) SEAM(); }
    if (IN(7)) { phase_combine(p, c); if (IN(8)) SEAM(); }
    if (IN(8)) { EpiProjA EA{(const bf16_t*)(ws + WS_GAB), (float*)(ws + WS_YTMP)}; EpiProjB EB{(const bf16_t*)(ws + WS_GAB), (const float*)(ws + WS_YTMP), (bf16_t*)(ws + WS_Y)};
        GEMM((const bf16_t*)(ws + WS_OA), (const bf16_t*)(ws + WS_WPA_T), 512, 0, T, D / 256, EA, nullptr);
        GEMM((const bf16_t*)(ws + WS_OB), (const bf16_t*)(ws + WS_WPB_T), 512, 0, T, D / 256, EB, nullptr); if (IN(9)) SEAM(); }
    if (IN(9)) { EpiWout E{modv, p.out, (bf16_t*)(ws + WS_A3)};
        GEMM((const bf16_t*)(ws + WS_Y), (const bf16_t*)(ws + WS_WOUT_T), D, 0, T, D / 256, E, (float*)(ws + WS_SSQ2)); if (IN(10)) SEAM(); }
    if (IN(10)) { EpiGateUp2 E{(bf16_t*)(ws + WS_HID2), (const float*)(ws + WS_SSQ2), (const float*)(ws + WS_SW2)};
        GEMM((const bf16_t*)(ws + WS_A3), (const bf16_t*)(ws + WS_WG2_T), D, 0, T, NGU / 256, E, nullptr); if (IN(11)) SEAM(); }
    if (IN(11)) { EpiDown2 E{modv, p.out};
        GEMM((const bf16_t*)(ws + WS_HID2), (const bf16_t*)(ws + WS_WD2_T), DFF, 0, T, D / 256, E, (float*)(ws + WS_SSQ3)); if (IN(12)) SEAM(); }
    if (IN(12)) { phase_final(p, c); }
}

extern "C" void kernel_launch(void* const* d_in, const int* in_sizes, int n_in, void* d_out, int out_size, void* d_ws, size_t ws_size, hipStream_t stream) {
    static int grid = 0;
    if (grid == 0) {
        if (n_in != 26 || in_sizes[0] != T * D || out_size != T * D || ws_size < WS_TOTAL) { fprintf(stderr, "kernel_launch: unexpected shapes (n_in %d, in0 %d, out %d, ws %zu < %zu)\n", n_in, n_in > 0 ? in_sizes[0] : -1, out_size, ws_size, (size_t)WS_TOTAL); grid = -1; return; }
        int dev = 0, cus = 0, per_cu = 0;
        (void)hipGetDevice(&dev); (void)hipDeviceGetAttribute(&cus, hipDeviceAttributeMultiprocessorCount, dev);
        if (hipFuncSetAttribute((const void*)fwd_kernel, hipFuncAttributeMaxDynamicSharedMemorySize, LDS_BYTES) != hipSuccess) { fprintf(stderr, "kernel_launch: hipFuncSetAttribute failed\n"); grid = -1; return; }
        (void)hipOccupancyMaxActiveBlocksPerMultiprocessor(&per_cu, (const void*)fwd_kernel, NTHR, LDS_BYTES);
        if (per_cu < 1) { fprintf(stderr, "kernel_launch: occupancy query says %d blocks per CU\n", per_cu); per_cu = 1; }
        (void)hipGetLastError();
        grid = cus;
    }
    if (grid < 0) return;
    Params p{};
    const float** f = (const float**)&p;
    for (int i = 0; i < 26; ++i) f[i] = (const float*)d_in[i];
    p.out = (float*)d_out; p.ws = (unsigned char*)d_ws;
#if N_LAUNCH_MODE == 1
    p.ph_lo = 0; p.ph_hi = N_PHASES;
    void* args[] = {&p};
    hipError_t e = hipLaunchCooperativeKernel((const void*)fwd_kernel, dim3(grid), dim3(NTHR), args, LDS_BYTES, stream);
    if (e != hipSuccess) fprintf(stderr, "cooperative launch failed: %s (grid %d)\n", hipGetErrorString(e), grid);
#else
    for (int k = 0; k < N_PHASES; ++k) { p.ph_lo = k; p.ph_hi = k + 1; hipLaunchKernelGGL(fwd_kernel, dim3(grid), dim3(NTHR), LDS_BYTES, stream, p); }
#endif
}
```

```cpp
#include <hip/hip_runtime.h>
#include <hip/hip_cooperative_groups.h>
#include <cstdio>
namespace cg = cooperative_groups;

#ifndef N_LAUNCH_MODE
#define N_LAUNCH_MODE 1
#endif
#ifndef USE_MFMA_HYENA
#define USE_MFMA_HYENA 1
#endif
#ifndef USE_PG8
#define USE_PG8 1
#endif

#define LAS __attribute__((address_space(3)))
typedef unsigned short bf16_t;
typedef _Float16 f16_t;
typedef float f32x4 __attribute__((ext_vector_type(4)));
typedef unsigned u32x4 __attribute__((ext_vector_type(4)));
typedef unsigned u32x2 __attribute__((ext_vector_type(2)));

constexpr int D = 1024, NB = 16, SEQ = 2048, T = NB * SEQ, CL = 256, TC = NB * CL, MT = T + TC;
constexpr int DFF = 2816, NGU = 2 * DFF, NIN = 6144, MODW = 9 * D;
constexpr int AKW = 512, AVW = 512, BW = 512, NHY = 3 * BW;
constexpr int KR_LEN = 4128, KR_OFF = 2056;
constexpr float RMS_EPS = 1e-6f;
constexpr int NTHR = 512, NWAVES = 8;
constexpr int LDS_BYTES = 152 * 1024;

constexpr size_t MiB = 1024 * 1024;
constexpr size_t al256(size_t x) { return (x + 255) & ~(size_t)255; }
constexpr size_t WS_CTL = 0;
constexpr size_t WS_MODV = WS_CTL + 65536;
constexpr size_t WS_SWIN = WS_MODV + al256((size_t)17 * MODW * 4);
constexpr size_t WS_SW2 = WS_SWIN + al256((size_t)17 * NIN * 4);
constexpr size_t WS_ER = WS_SW2 + al256((size_t)17 * NGU * 4);
constexpr size_t WS_EC = WS_ER + 32 * 512 * 4;
constexpr size_t WS_LBV = WS_EC + 64 * 512 * 4;
constexpr size_t WS_H2 = WS_LBV + 4096;
constexpr size_t WS_KREV = WS_H2 + 2048 * 64 * 4;
constexpr size_t WS_WIN_T = WS_KREV + al256((size_t)2 * 512 * KR_LEN * 2);
constexpr size_t WS_WPA_T = WS_WIN_T + (size_t)NIN * D * 2;
constexpr size_t WS_WPB_T = WS_WPA_T + (size_t)D * 512 * 2;
constexpr size_t WS_WOUT_T = WS_WPB_T + (size_t)D * 512 * 2;
constexpr size_t WS_PERSIST_END = WS_WOUT_T + (size_t)D * D * 2;
constexpr size_t AR = 27 * MiB;
static_assert(WS_PERSIST_END <= AR, "persistent region");
constexpr size_t WS_HID = AR + 0 * MiB;
constexpr size_t WS_N1 = AR + 198 * MiB;
constexpr size_t WS_WG1_T = AR + 270 * MiB;
constexpr size_t WS_WD1_T = AR + 281 * MiB;
constexpr size_t WS_SSQ1 = AR + 410 * MiB;
constexpr size_t WS_A2 = AR + 413 * MiB;
constexpr size_t WS_GAB = AR + 0 * MiB;
constexpr size_t WS_V = AR + 128 * MiB;
constexpr size_t WS_LFW = AR + 164 * MiB;
constexpr size_t WS_LBW = AR + 200 * MiB;
constexpr size_t WS_Q = AR + 236 * MiB;
constexpr size_t WS_G = AR + 268 * MiB;
constexpr size_t WS_HY = AR + 300 * MiB;
constexpr size_t WS_WG2_T = AR + 436 * MiB;
constexpr size_t WS_WD2_T = AR + 447 * MiB;
constexpr size_t WS_ZB = AR + 453 * MiB;
constexpr size_t WS_OFW = AR + 300 * MiB;
constexpr size_t WS_OBW = AR + 364 * MiB;
constexpr size_t WS_OA = AR + 128 * MiB;
constexpr size_t WS_OB = AR + 160 * MiB;
constexpr size_t WS_YTMP = AR + 192 * MiB;
constexpr size_t WS_Y = AR + 320 * MiB;
constexpr size_t WS_A3 = AR + 0 * MiB;
constexpr size_t WS_SSQ2 = AR + 64 * MiB;
constexpr size_t WS_SSQ3 = AR + 66 * MiB;
constexpr size_t WS_HID2 = AR + 128 * MiB;
constexpr size_t WS_TOTAL = AR + 485 * MiB;

struct Params {
    const float *x, *c, *ctx, *c_ctx, *mod_w, *mod_b, *ffn_wg, *ffn_wu, *ffn_wd, *w_in, *lb_logits, *a_norm_w, *conv_w, *conv_b;
    const float *hw1, *hb1, *hfr1, *hw2, *hb2, *hfr2, *hw3, *hy_bias, *w_pa, *w_pb, *w_out, *fnw;
    float* out; unsigned char* ws;
    int ph_lo, ph_hi;
};

__device__ __forceinline__ float bf2f(bf16_t b) { return __uint_as_float(((unsigned)b) << 16); }
__device__ __forceinline__ bf16_t f2bf(float f) { unsigned u = __float_as_uint(f); u += 0x7FFFu + ((u >> 16) & 1u); return (bf16_t)(u >> 16); }
__device__ __forceinline__ unsigned pk2(float lo, float hi) { return (unsigned)f2bf(lo) | ((unsigned)f2bf(hi) << 16); }
__device__ __forceinline__ float bfround(float f) { return bf2f(f2bf(f)); }
__device__ __forceinline__ float sigmoidf_(float x) { return 1.0f / (1.0f + __expf(-x)); }
__device__ __forceinline__ float siluf_(float x) { return x / (1.0f + __expf(-x)); }
__device__ __forceinline__ float wave_sum(float v) {
#pragma unroll
    for (int o = 1; o < 64; o <<= 1) v += __shfl_xor(v, o);
    return v;
}
__device__ __forceinline__ float pos_embed(const float* er, const float* ec, int t, int col) {
    return col < 512 ? er[(t >> 6) * 512 + col] : ec[(t & 63) * 512 + (col - 512)];
}
__device__ __forceinline__ float rstd_from_ssq(const float* ssq16) {
    const f32x4* s = (const f32x4*)ssq16; float tot = 0.f;
#pragma unroll
    for (int i = 0; i < 4; ++i) { const f32x4 v = s[i]; tot += (v[0] + v[1]) + (v[2] + v[3]); }
    return 1.0f / sqrtf(tot * (1.0f / D) + RMS_EPS);
}

__device__ __forceinline__ void transpose_item(const float* W, int K, int N, bf16_t* WT, int k0, int n0, int dst_row0, LAS float* scr, int lane) {
#pragma unroll 8
    for (int i = 0; i < 32; ++i) { const int kk = 2 * i + (lane >> 5); scr[kk * 33 + (lane & 31)] = W[(size_t)(k0 + kk) * N + n0 + (lane & 31)]; }
    asm volatile("s_waitcnt lgkmcnt(0)" ::: "memory");
    const int c = lane & 7;
#pragma unroll
    for (int j = 0; j < 4; ++j) { const int n = (lane >> 3) + 8 * j; const LAS float* s = scr + (8 * c) * 33 + n;
        u32x4 o; o.x = pk2(s[0 * 33], s[1 * 33]); o.y = pk2(s[2 * 33], s[3 * 33]); o.z = pk2(s[4 * 33], s[5 * 33]); o.w = pk2(s[6 * 33], s[7 * 33]);
        *(u32x4*)(WT + (size_t)(dst_row0 + n) * K + k0 + 8 * c) = o; }
    asm volatile("s_waitcnt lgkmcnt(0)" ::: "memory");
}
__device__ __forceinline__ void transpose_matrix(const float* W, int K, int N, bf16_t* WT, LAS float* scr, int gw, int ngw, int lane) {
    const int nblk = N / 32, items = (K / 64) * nblk;
    for (int it = gw; it < items; it += ngw) { const int kb = it / nblk, nb = it % nblk; transpose_item(W, K, N, WT, 64 * kb, 32 * nb, 32 * nb, scr, lane); }
}
__device__ __forceinline__ void transpose_gu(const float* W, int half, bf16_t* WT, LAS float* scr, int gw, int ngw, int lane) {
    const int nblk = DFF / 32, items = (D / 64) * nblk;
    for (int it = gw; it < items; it += ngw) { const int kb = it / nblk, nb = it % nblk, n0 = 32 * nb;
        transpose_item(W, D, DFF, WT, 64 * kb, n0, 256 * (n0 >> 7) + 128 * half + (n0 & 127), scr, lane); }
}

template <bool GU>
__device__ __forceinline__ void gemv17(const LAS float* xs, LAS float* part, const float* W, int N, const float* bias, float* out, int ldo, int half, int blk0, int nblk_stride) {
    const int tid = threadIdx.x, wid = tid >> 6, lane = tid & 63;
    for (int cb = blk0; cb < N / 64; cb += nblk_stride) {
        const int n = cb * 64 + lane;
        float acc[17];
#pragma unroll
        for (int r = 0; r < 17; ++r) acc[r] = 0.f;
        const float* wp = W + (size_t)(wid * 128) * N + n;
#pragma unroll 4
        for (int k = 0; k < 128; ++k) { const float w = wp[(size_t)k * N];
#pragma unroll
            for (int r = 0; r < 17; ++r) acc[r] += xs[r * 1024 + wid * 128 + k] * w; }
#pragma unroll
        for (int r = 0; r < 17; ++r) part[(wid * 17 + r) * 64 + lane] = acc[r];
        __syncthreads();
        for (int o = tid; o < 17 * 64; o += NTHR) { const int r = o >> 6, l = o & 63; float s = 0.f;
#pragma unroll
            for (int w = 0; w < 8; ++w) s += part[(w * 17 + r) * 64 + l];
            const int nn = cb * 64 + l; if (bias) s += bias[nn];
            const int on = GU ? (256 * (nn >> 7) + 128 * half + (nn & 127)) : nn;
            out[(size_t)r * ldo + on] = s; }
        __syncthreads();
    }
}

__device__ __forceinline__ void store_bf16x8(bf16_t* p, const float (&v)[8]) { u32x4 w; w.x = pk2(v[0], v[1]); w.y = pk2(v[2], v[3]); w.z = pk2(v[4], v[5]); w.w = pk2(v[6], v[7]); *(u32x4*)p = w; }
__device__ __forceinline__ void load_f32x8(const float* p, float (&v)[8]) { const f32x4 a = *(const f32x4*)p, b = *(const f32x4*)(p + 4); v[0] = a[0]; v[1] = a[1]; v[2] = a[2]; v[3] = a[3]; v[4] = b[0]; v[5] = b[1]; v[6] = b[2]; v[7] = b[3]; }
__device__ __forceinline__ void store_f32x8(float* p, const float (&v)[8]) { *(f32x4*)p = (f32x4){v[0], v[1], v[2], v[3]}; *(f32x4*)(p + 4) = (f32x4){v[4], v[5], v[6], v[7]}; }
__device__ __forceinline__ void load_bf16x8(const bf16_t* p, float (&v)[8]) { const u32x4 w = *(const u32x4*)p; v[0] = __uint_as_float(w.x << 16); v[1] = __uint_as_float(w.x & 0xffff0000u); v[2] = __uint_as_float(w.y << 16); v[3] = __uint_as_float(w.y & 0xffff0000u);
    v[4] = __uint_as_float(w.z << 16); v[5] = __uint_as_float(w.z & 0xffff0000u); v[6] = __uint_as_float(w.w << 16); v[7] = __uint_as_float(w.w & 0xffff0000u); }

struct EpiGateUp1 {
    bf16_t* hid;
    __device__ __forceinline__ float apply(int row, int pn, int c, const float (&v0)[8], const float (&v1)[8]) const {
        float o[8];
#pragma unroll
        for (int j = 0; j < 8; ++j) o[j] = siluf_(v0[j]) * v1[j];
        store_bf16x8(hid + (size_t)row * DFF + 128 * pn + c, o); return 0.f; }
};
struct EpiGateUp2 {
    bf16_t* hid; const float* ssq; const float* sw;
    __device__ __forceinline__ float apply(int row, int pn, int c, const float (&v0)[8], const float (&v1)[8]) const {
        const float rs = rstd_from_ssq(ssq + (size_t)row * 16); const int b = row >> 11;
        float s0[8], s1[8], o[8]; load_f32x8(sw + (size_t)b * NGU + 256 * pn + c, s0); load_f32x8(sw + (size_t)b * NGU + 256 * pn + 128 + c, s1);
#pragma unroll
        for (int j = 0; j < 8; ++j) o[j] = siluf_(rs * v0[j] + s0[j]) * (rs * v1[j] + s1[j]);
        store_bf16x8(hid + (size_t)row * DFF + 128 * pn + c, o); return 0.f; }
};
struct EpiDown1 {
    const float *x, *ctx, *er, *ec, *modv; float* hout; bf16_t* a2;
    __device__ __forceinline__ float half_(int row, int col, const float (&v)[8]) const {
        const bool lat = row < T; const int b = lat ? (row >> 11) : 16, t = row & (SEQ - 1);
        float base[8], m2[8], m4[8], h[8], a[8];
        if (lat) { load_f32x8(x + (size_t)row * D + col, base);
#pragma unroll
            for (int j = 0; j < 8; ++j) base[j] += pos_embed(er, ec, t, col + j); }
        else load_f32x8(ctx + (size_t)(row - T) * D + col, base);
        load_f32x8(modv + (size_t)b * MODW + 2 * D + col, m2); load_f32x8(modv + (size_t)b * MODW + 4 * D + col, m4);
        float s = 0.f;
#pragma unroll
        for (int j = 0; j < 8; ++j) { h[j] = base[j] + 0.5f * m2[j] * v[j]; s += h[j] * h[j]; a[j] = h[j] * (1.0f + m4[j]); }
        if (lat) store_f32x8(hout + (size_t)row * D + col, h);
        store_bf16x8(a2 + (size_t)row * D + col, a); return s; }
    __device__ __forceinline__ float apply(int row, int pn, int c, const float (&v0)[8], const float (&v1)[8]) const { return half_(row, 256 * pn + c, v0) + half_(row, 256 * pn + 128 + c, v1); }
};
struct EpiWin {
    const float *ssq, *sw, *lbv; bf16_t *v, *q, *g, *hy, *gab; f16_t *lfw, *lbw;
    __device__ __forceinline__ void half_(int row, int n, float rs, int b, const float (&a)[8]) const {
        float s[8], p[8]; load_f32x8(sw + (size_t)b * NIN + n, s);
#pragma unroll
        for (int j = 0; j < 8; ++j) p[j] = rs * a[j] + s[j];
        const int grp = n >> 9;
        if (grp == 0) { store_bf16x8(v + (size_t)row * 512 + n, p); }
        else if (grp <= 2) { const int nn = n - 512 * grp; f16_t* dst = (grp == 1 ? lfw : lbw) + (size_t)row * 512 + nn; f16_t o[8];
#pragma unroll
            for (int j = 0; j < 8; ++j) { const float lb = lbv[(grp - 1) * 512 + nn + j]; const float f = lb + (1.0f - lb) * sigmoidf_(p[j]); o[j] = (f16_t)__logf(f); }
            *(u32x4*)dst = *(const u32x4*)o; }
        else if (grp == 3) {
#pragma unroll
            for (int j = 0; j < 8; ++j) p[j] = siluf_(p[j]);
            store_bf16x8(q + (size_t)row * 512 + (n - 1536), p); }
        else if (grp == 4) {
#pragma unroll
            for (int j = 0; j < 8; ++j) p[j] = siluf_(p[j]);
            store_bf16x8(g + (size_t)row * 512 + (n - 2048), p); }
        else if (grp <= 7) { const int ch = n - 2560, t = row & (SEQ - 1); store_bf16x8(hy + (((size_t)(ch >> 3) * NB + b) * SEQ + t) * 8, p); }
        else {
#pragma unroll
            for (int j = 0; j < 8; ++j) p[j] = sigmoidf_(p[j]);
            store_bf16x8(gab + (size_t)row * 2048 + (n - 4096), p); }
    }
    __device__ __forceinline__ float apply(int row, int pn, int c, const float (&v0)[8], const float (&v1)[8]) const {
        const float rs = rstd_from_ssq(ssq + (size_t)row * 16); const int b = row < T ? (row >> 11) : 16;
        half_(row, 256 * pn + c, rs, b, v0); half_(row, 256 * pn + 128 + c, rs, b, v1); return 0.f; }
};
struct EpiProjA {
    const bf16_t* gab; float* ytmp;
    __device__ __forceinline__ void half_(int row, int col, const float (&a)[8]) const { float gt[8], o[8]; load_bf16x8(gab + (size_t)row * 2048 + col, gt);
#pragma unroll
        for (int j = 0; j < 8; ++j) o[j] = gt[j] * a[j];
        store_f32x8(ytmp + (size_t)row * D + col, o); }
    __device__ __forceinline__ float apply(int row, int pn, int c, const float (&v0)[8], const float (&v1)[8]) const { half_(row, 256 * pn + c, v0); half_(row, 256 * pn + 128 + c, v1); return 0.f; }
};
struct EpiProjB {
    const bf16_t* gab; const float* ytmp; bf16_t* y;
    __device__ __forceinline__ void half_(int row, int col, const float (&a)[8]) const { float gt[8], yt[8], o[8]; load_bf16x8(gab + (size_t)row * 2048 + 1024 + col, gt); load_f32x8(ytmp + (size_t)row * D + col, yt);
#pragma unroll
        for (int j = 0; j < 8; ++j) o[j] = yt[j] + gt[j] * a[j];
        store_bf16x8(y + (size_t)row * D + col, o); }
    __device__ __forceinline__ float apply(int row, int pn, int c, const float (&v0)[8], const float (&v1)[8]) const { half_(row, 256 * pn + c, v0); half_(row, 256 * pn + 128 + c, v1); return 0.f; }
};
struct EpiWout {
    const float* modv; float* h; bf16_t* a3;
    __device__ __forceinline__ float half_(int row, int col, const float (&v)[8]) const {
        const int b = row >> 11; float base[8], m5[8], m7[8], a[8];
        load_f32x8(h + (size_t)row * D + col, base); load_f32x8(modv + (size_t)b * MODW + 5 * D + col, m5); load_f32x8(modv + (size_t)b * MODW + 7 * D + col, m7);
        float s = 0.f;
#pragma unroll
        for (int j = 0; j < 8; ++j) { base[j] += m5[j] * v[j]; s += base[j] * base[j]; a[j] = base[j] * (1.0f + m7[j]); }
        store_f32x8(h + (size_t)row * D + col, base); store_bf16x8(a3 + (size_t)row * D + col, a); return s; }
    __device__ __forceinline__ float apply(int row, int pn, int c, const float (&v0)[8], const float (&v1)[8]) const { return half_(row, 256 * pn + c, v0) + half_(row, 256 * pn + 128 + c, v1); }
};
struct EpiDown2 {
    const float* modv; float* h;
    __device__ __forceinline__ float half_(int row, int col, const float (&v)[8]) const {
        const int b = row >> 11; float base[8], m8[8];
        load_f32x8(h + (size_t)row * D + col, base); load_f32x8(modv + (size_t)b * MODW + 8 * D + col, m8);
        float s = 0.f;
#pragma unroll
        for (int j = 0; j < 8; ++j) { base[j] += 0.5f * m8[j] * v[j]; s += base[j] * base[j]; }
        store_f32x8(h + (size_t)row * D + col, base); return s; }
    __device__ __forceinline__ float apply(int row, int pn, int c, const float (&v0)[8], const float (&v1)[8]) const { return half_(row, 256 * pn + c, v0) + half_(row, 256 * pn + 128 + c, v1); }
};

template <class Epi>
__device__ __forceinline__ void gemm_simple(LAS unsigned char* lds, const bf16_t* A, const bf16_t* Bt, int K, int row0, int nrows, int npn, const Epi& E, float* ssq) {
    LAS float* As = (LAS float*)lds;
    LAS float* Bs = (LAS float*)(lds + 8192);
    const int tid = threadIdx.x, c8 = tid & 15, rg = tid >> 4;
    const int nrt = nrows / 64, nunits = nrt * npn;
    for (int unit = blockIdx.x; unit < nunits; unit += gridDim.x) {
        const int rt = unit / npn, pn = unit % npn, r0 = row0 + rt * 64;
        float a0[2][8], a1[2][8];
#pragma unroll
        for (int r = 0; r < 2; ++r)
#pragma unroll
            for (int j = 0; j < 8; ++j) { a0[r][j] = 0.f; a1[r][j] = 0.f; }
        for (int k0 = 0; k0 < K; k0 += 32) {
            { const int row = tid >> 3, kq = tid & 7; const u32x2 w = *(const u32x2*)(A + (size_t)(r0 + row) * K + k0 + 4 * kq);
              As[(4 * kq + 0) * 64 + row] = __uint_as_float(w.x << 16); As[(4 * kq + 1) * 64 + row] = __uint_as_float(w.x & 0xffff0000u);
              As[(4 * kq + 2) * 64 + row] = __uint_as_float(w.y << 16); As[(4 * kq + 3) * 64 + row] = __uint_as_float(w.y & 0xffff0000u); }
            { const int n = tid >> 1, kh = tid & 1; const bf16_t* src = Bt + (size_t)(pn * 256 + n) * K + k0 + 16 * kh; float t8[8];
              load_bf16x8(src, t8);
#pragma unroll
              for (int i = 0; i < 8; ++i) Bs[(16 * kh + i) * 256 + n] = t8[i];
              load_bf16x8(src + 8, t8);
#pragma unroll
              for (int i = 0; i < 8; ++i) Bs[(16 * kh + 8 + i) * 256 + n] = t8[i]; }
            __syncthreads();
#pragma unroll 8
            for (int k = 0; k < 32; ++k) {
                const float x0 = As[k * 64 + 2 * rg], x1 = As[k * 64 + 2 * rg + 1];
                const f32x4 b00 = *(const LAS f32x4*)(Bs + k * 256 + 8 * c8), b01 = *(const LAS f32x4*)(Bs + k * 256 + 8 * c8 + 4);
                const f32x4 b10 = *(const LAS f32x4*)(Bs + k * 256 + 128 + 8 * c8), b11 = *(const LAS f32x4*)(Bs + k * 256 + 128 + 8 * c8 + 4);
#pragma unroll
                for (int j = 0; j < 4; ++j) { a0[0][j] += x0 * b00[j]; a0[0][4 + j] += x0 * b01[j]; a1[0][j] += x0 * b10[j]; a1[0][4 + j] += x0 * b11[j];
                                              a0[1][j] += x1 * b00[j]; a0[1][4 + j] += x1 * b01[j]; a1[1][j] += x1 * b10[j]; a1[1][4 + j] += x1 * b11[j]; }
            }
            __syncthreads();
        }
#pragma unroll
        for (int r = 0; r < 2; ++r) { const int row = r0 + 2 * rg + r; float s = E.apply(row, pn, 8 * c8, a0[r], a1[r]);
            s += __shfl_xor(s, 1); s += __shfl_xor(s, 2); s += __shfl_xor(s, 4); s += __shfl_xor(s, 8);
            if (ssq && c8 == 0) *(f32x4*)(ssq + (size_t)row * 16 + pn * 4) = (f32x4){s, 0.f, 0.f, 0.f}; }
    }
}

namespace pg8 {
#define PG8_LAS __attribute__((address_space(3)))
typedef unsigned short bf16_t;
typedef short bf16x8 __attribute__((ext_vector_type(8)));
typedef float f32x4 __attribute__((ext_vector_type(4)));
typedef unsigned u32x4 __attribute__((ext_vector_type(4)));
constexpr int BM = 256, BK = 64, HALF = 128, HTB = HALF * BK * 2  , STAGE_BYTES = 8 * HTB, NXCD = 8, WGM = 8;

__host__ __device__ __forceinline__ int lds_byte(int r, int c) { const int st = (r >> 4) * 2 + (c >> 5), rr = r & 15, cc = c & 31, ob = rr * 64 + cc * 2; return st * 1024 + (ob ^ (((ob >> 9) & 1) << 5)); }
__host__ __device__ __forceinline__ void stage_rc(int b, int& R, int& C) { const int st = b / 1024, sb = b % 1024, swz = sb ^ (((sb >> 9) & 1) << 5); R = (st >> 1) * 16 + swz / 64; C = (st & 1) * 32 + (swz % 64) / 2; }
__host__ __device__ __forceinline__ int perm32(int rho) { const int n = rho >> 4, i = rho & 15; return 8 * (i >> 2) + 4 * n + (i & 3); }

struct Unit { int pm, pn; };
struct Gemm { const bf16_t* A; const bf16_t* Bt; int M, N, K; };

struct StaticOrder {
    int nM, nN, nwg, G, c;
    __host__ __device__ void init(int M, int N, int G_, int c_) { nM = M / BM; nN = N / BM; nwg = nM * nN; G = G_; c = c_; }
    __host__ __device__ bool next(int i, Unit& u) const {
        const long L = (long)i * G + c; if (L >= nwg) return false;
        int wgid = (int)L; { const int q = nwg / NXCD, r = nwg % NXCD, xcd = wgid % NXCD, off = wgid / NXCD; wgid = (xcd < r ? xcd * (q + 1) : r * (q + 1) + (xcd - r) * q) + off; }
        const int nig = WGM * nN, gid = wgid / nig, fm = gid * WGM, gsz = (nM - fm) < WGM ? (nM - fm) : WGM;
        u.pm = fm + ((wgid % nig) % gsz); u.pn = (wgid % nig) / gsz; return true;
    }
    __device__ __forceinline__ void a_ready(const Unit&) const {}
    __device__ __forceinline__ void done(const Unit&) const {}
};
template <class Epi, class Sched>
__device__ __forceinline__ void gemm_phase(PG8_LAS unsigned char* lds, const Gemm g, const Sched& S, const Epi& E) {
    const int tid = threadIdx.x, wid = __builtin_amdgcn_readfirstlane(tid >> 6), lane = tid & 63, wr = wid >> 2, wc = wid & 3, fr = lane & 15, fq = lane >> 4;
    const int K = g.K, nt = K / BK;
    unsigned voffA[2], voffB[2];
#pragma unroll
    for (int i = 0; i < 2; ++i) { int R, C; stage_rc(tid * 16 + i * 8192, R, C); const int Rb = Epi::PERM ? ((R & ~31) + perm32(R & 31)) : R;
        voffA[i] = (unsigned)(R * K + C) * 2u; voffB[i] = (unsigned)(Rb * K + C) * 2u; }
    const size_t kstep = (size_t)(BK * 2);
    const size_t hstep = (size_t)HALF * K * 2;
    const size_t tstep = 2 * hstep;
    const unsigned ldsw = (unsigned)wid * 1024u;
    const int aoff = lds_byte(wr * 64 + fr, fq * 8), boff = lds_byte(wc * 32 + fr, fq * 8);
#define PG8_SA(b, h) (((b) * 2 + (h)) * HTB)
#define PG8_SB(b, h) ((4 + (b) * 2 + (h)) * HTB)
#define PG8_STAGE(bufoff, gbase, voff) do { _Pragma("unroll") for (int _i = 0; _i < 2; ++_i) \
        __builtin_amdgcn_global_load_lds((const unsigned*)((const char*)(gbase) + (voff)[_i]), (PG8_LAS unsigned*)(lds + (bufoff) + ldsw + _i * 8192), 16, 0, 0); } while (0)
#define PG8_LDA(dst, b, h) do { _Pragma("unroll") for (int m = 0; m < 4; ++m) _Pragma("unroll") for (int k = 0; k < 2; ++k) dst[m][k] = *(const PG8_LAS bf16x8*)(lds + PG8_SA(b, h) + aoff + m * 2048 + k * 1024); } while (0)
#define PG8_LDB(dst, b, h) do { _Pragma("unroll") for (int n = 0; n < 2; ++n) _Pragma("unroll") for (int k = 0; k < 2; ++k) dst[n][k] = *(const PG8_LAS bf16x8*)(lds + PG8_SB(b, h) + boff + n * 2048 + k * 1024); } while (0)
#define PG8_MMA(ai, bj, At, Bt) do { __builtin_amdgcn_s_setprio(1); _Pragma("unroll") for (int m = 0; m < 4; ++m) _Pragma("unroll") for (int n = 0; n < 2; ++n) _Pragma("unroll") for (int k = 0; k < 2; ++k) \
        acc[ai][bj][m][n] = __builtin_amdgcn_mfma_f32_16x16x32_bf16(Bt[n][k], At[m][k], acc[ai][bj][m][n], 0, 0, 0); __builtin_amdgcn_s_setprio(0); } while (0)
#define PG8_WAIT_V(n) asm volatile("s_waitcnt vmcnt(" #n ")" ::: "memory")
#define PG8_WAIT_L(n) asm volatile("s_waitcnt lgkmcnt(" #n ")" ::: "memory")
#define PG8_BAR __builtin_amdgcn_s_barrier()
#define PG8_SCHED __builtin_amdgcn_sched_barrier(0)
    Unit cur, nxt; int ui = 0;
    if (!S.next(0, cur)) return;
    f32x4 acc[2][2][4][2];
#pragma unroll
    for (int a = 0; a < 2; ++a)
#pragma unroll
        for (int b = 0; b < 2; ++b)
#pragma unroll
            for (int m = 0; m < 4; ++m)
#pragma unroll
                for (int n = 0; n < 2; ++n) acc[a][b][m][n] = (f32x4){0.f, 0.f, 0.f, 0.f};
    bf16x8 At[4][2], B0[2][2], B1[2][2];
    const char* cA = (const char*)g.A + (size_t)cur.pm * tstep; const char* cB = (const char*)g.Bt + (size_t)cur.pn * tstep;
    S.a_ready(cur);
    PG8_STAGE(PG8_SB(0, 0), cB, voffB); PG8_STAGE(PG8_SA(0, 0), cA, voffA); PG8_STAGE(PG8_SB(0, 1), cB + hstep, voffB); PG8_STAGE(PG8_SA(0, 1), cA + hstep, voffA);
    if (wr == 1) PG8_BAR;
    PG8_WAIT_V(4); PG8_BAR;
    PG8_STAGE(PG8_SB(1, 0), cB + kstep, voffB); PG8_STAGE(PG8_SA(1, 0), cA + kstep, voffA); PG8_STAGE(PG8_SB(1, 1), cB + hstep + kstep, voffB);
    PG8_WAIT_V(6); PG8_BAR;
    for (;;) {
        const bool has_next = S.next(ui + 1, nxt);
        const char* nA = has_next ? (const char*)g.A + (size_t)nxt.pm * tstep : cA; const char* nB = has_next ? (const char*)g.Bt + (size_t)nxt.pn * tstep : cB;
        for (int t = 0; t < nt; t += 2) {
            const bool last = (t == nt - 2);
            const char* a1 = cA + (size_t)(t + 1) * kstep;
            const char* a2 = last ? nA : cA + (size_t)(t + 2) * kstep; const char* b2 = last ? nB : cB + (size_t)(t + 2) * kstep;
            const char* a3 = a2 + kstep; const char* b3 = b2 + kstep;
            if (last && has_next) S.a_ready(nxt);
            PG8_LDB(B0, 0, 0); PG8_SCHED; PG8_LDA(At, 0, 0); PG8_STAGE(PG8_SA(1, 1), a1 + hstep, voffA);
            PG8_WAIT_L(8); PG8_BAR; PG8_WAIT_L(0); PG8_MMA(0, 0, At, B0); PG8_BAR; PG8_SCHED;
            PG8_LDB(B1, 0, 1); PG8_STAGE(PG8_SB(0, 0), b2, voffB);
            PG8_BAR; PG8_WAIT_L(0); PG8_MMA(0, 1, At, B1); PG8_BAR;
            PG8_LDA(At, 0, 1); PG8_STAGE(PG8_SA(0, 0), a2, voffA);
            PG8_BAR; PG8_WAIT_L(0); PG8_MMA(1, 0, At, B0); PG8_BAR; PG8_SCHED;
            PG8_STAGE(PG8_SB(0, 1), b2 + hstep, voffB);
            PG8_WAIT_V(6); PG8_BAR; PG8_MMA(1, 1, At, B1); PG8_BAR;
            PG8_LDB(B0, 1, 0); PG8_SCHED; PG8_LDA(At, 1, 0); PG8_STAGE(PG8_SA(0, 1), a2 + hstep, voffA);
            PG8_WAIT_L(8); PG8_BAR; PG8_WAIT_L(0); PG8_MMA(0, 0, At, B0); PG8_BAR; PG8_SCHED;
            PG8_LDB(B1, 1, 1); PG8_STAGE(PG8_SB(1, 0), b3, voffB);
            PG8_BAR; PG8_WAIT_L(0); PG8_MMA(0, 1, At, B1); PG8_BAR;
            PG8_LDA(At, 1, 1); PG8_STAGE(PG8_SA(1, 0), a3, voffA);
            PG8_BAR; PG8_WAIT_L(0); PG8_MMA(1, 0, At, B0); PG8_BAR; PG8_SCHED;
            PG8_STAGE(PG8_SB(1, 1), b3 + hstep, voffB);
            PG8_WAIT_V(6); PG8_BAR; PG8_MMA(1, 1, At, B1); PG8_BAR;
        }
        if constexpr (!Epi::AFTER_DRAIN) { E(acc, cur, wr, wc, fr, fq); S.done(cur); }
        if (!has_next) break;
#pragma unroll
        for (int a = 0; a < 2; ++a)
#pragma unroll
            for (int b = 0; b < 2; ++b)
#pragma unroll
                for (int m = 0; m < 4; ++m)
#pragma unroll
                    for (int n = 0; n < 2; ++n) acc[a][b][m][n] = (f32x4){0.f, 0.f, 0.f, 0.f};
        cur = nxt; cA = nA; cB = nB; ++ui;
    }
    PG8_WAIT_V(0);
    if (wr == 0) PG8_BAR;
    PG8_BAR;
    if constexpr (Epi::AFTER_DRAIN) { E.fused(acc, cur, wr, wc, fr, fq, lds, wid, lane); S.done(cur); }
#undef PG8_SA
#undef PG8_SB
#undef PG8_STAGE
#undef PG8_LDA
#undef PG8_LDB
#undef PG8_MMA
#undef PG8_WAIT_V
#undef PG8_WAIT_L
#undef PG8_BAR
#undef PG8_SCHED
}
}

template <class F> struct EpiAd {
    static constexpr bool PERM = true, AFTER_DRAIN = false;
    F f; float* ssq;
    __device__ __forceinline__ void operator()(const pg8::f32x4 (&acc)[2][2][4][2], const pg8::Unit& u, int wr, int wc, int fr, int fq) const {
#pragma unroll
        for (int ai = 0; ai < 2; ++ai)
#pragma unroll
            for (int m = 0; m < 4; ++m) { const int row = u.pm * 256 + ai * 128 + wr * 64 + m * 16 + fr;
                float v0[8], v1[8];
#pragma unroll
                for (int n = 0; n < 2; ++n)
#pragma unroll
                    for (int e = 0; e < 4; ++e) { v0[4 * n + e] = acc[ai][0][m][n][e]; v1[4 * n + e] = acc[ai][1][m][n][e]; }
                float s = f.apply(row, u.pn, wc * 32 + 8 * fq, v0, v1);
                if (ssq) { s += __shfl_xor(s, 16); s += __shfl_xor(s, 32); if (fq == 0) ssq[(size_t)row * 16 + u.pn * 4 + wc] = s; } }
    }
};
struct TwoPartOrder {
    pg8::StaticOrder s1; int n1, nM1, nM2, n2, G, c;
    __device__ void init(int nM1_, int nN1, int nM2_, int nN2, int G_, int c_) { s1.init(nM1_ * 256, nN1 * 256, G_, c_); n1 = nM1_ * nN1; nM1 = nM1_; nM2 = nM2_; n2 = nM2_ * nN2; G = G_; c = c_; }
    __device__ bool next(int i, pg8::Unit& u) const { long L = (long)i * G + c; if (L < n1) return s1.next(i, u); L -= n1; if (L >= n2) return false; u.pm = nM1 + (int)(L % nM2); u.pn = (int)(L / nM2); return true; }
    __device__ __forceinline__ void a_ready(const pg8::Unit&) const {}
    __device__ __forceinline__ void done(const pg8::Unit&) const {}
};
template <class F>
__device__ __forceinline__ void gemm_mfma(LAS unsigned char* lds, const bf16_t* A, const bf16_t* Bt, int K, int nrows1, int npn1, int nrows2, int npn2, const F& f, float* ssq) {
    __syncthreads();
    pg8::Gemm g{A, Bt, nrows1 + nrows2, npn1 * 256, K}; TwoPartOrder S; S.init(nrows1 / 256, npn1, nrows2 / 256, npn2, (int)gridDim.x, (int)blockIdx.x);
    EpiAd<F> E{f, ssq};
    pg8::gemm_phase(lds, g, S, E);
    __syncthreads();
}

struct Ctx { LAS unsigned char* lds; int tid, lane, wid, gw, ngw; };

__device__ __forceinline__ void phase_prep(const Params& p, const Ctx& c) {
    unsigned char* ws = p.ws;
    LAS float* scr = (LAS float*)(c.lds + c.wid * 8448);
    transpose_matrix(p.w_in, D, NIN, (bf16_t*)(ws + WS_WIN_T), scr, c.gw, c.ngw, c.lane);
    transpose_matrix(p.w_pa, 512, D, (bf16_t*)(ws + WS_WPA_T), scr, c.gw, c.ngw, c.lane);
    transpose_matrix(p.w_pb, 512, D, (bf16_t*)(ws + WS_WPB_T), scr, c.gw, c.ngw, c.lane);
    transpose_matrix(p.w_out, D, D, (bf16_t*)(ws + WS_WOUT_T), scr, c.gw, c.ngw, c.lane);
    transpose_gu(p.ffn_wg, 0, (bf16_t*)(ws + WS_WG1_T), scr, c.gw, c.ngw, c.lane);
    transpose_gu(p.ffn_wu, 1, (bf16_t*)(ws + WS_WG1_T), scr, c.gw, c.ngw, c.lane);
    transpose_matrix(p.ffn_wd, DFF, D, (bf16_t*)(ws + WS_WD1_T), scr, c.gw, c.ngw, c.lane);
    __syncthreads();
    if ((int)blockIdx.x < MODW / 64) {
        LAS float* xs = (LAS float*)c.lds; LAS float* part = (LAS float*)(c.lds + 17 * 1024 * 4);
        for (int i = c.tid; i < 17 * 1024; i += NTHR) { const int r = i >> 10, k = i & 1023; const float v = r < 16 ? p.c[r * D + k] : p.c_ctx[k]; xs[i] = v / (1.0f + expf(-v)); }
        __syncthreads();
        gemv17<false>(xs, part, p.mod_w, MODW, p.mod_b, (float*)(ws + WS_MODV), MODW, 0, blockIdx.x, gridDim.x);
    }
    { float* er = (float*)(ws + WS_ER); float* ec = (float*)(ws + WS_EC); float* lbv = (float*)(ws + WS_LBV);
      const int gt = blockIdx.x * NTHR + c.tid, ngt = gridDim.x * NTHR;
      for (int i = gt; i < 96 * 512; i += ngt) { const int r = i >> 9, j = i & 511, jj = j & 255; const float omega = 1.0f / powf(10000.0f, (float)jj / 256.0f);
          const int pos = r < 32 ? r : r - 32; const float a = (float)pos * omega; const float v = j < 256 ? sinf(a) : cosf(a);
          if (r < 32) er[r * 512 + j] = v; else ec[(r - 32) * 512 + j] = v; }
      for (int i = gt; i < 1024; i += ngt) { const float l0 = p.lb_logits[i], l1 = p.lb_logits[1024 + i]; lbv[i] = 1.0f / (1.0f + expf(l1 - l0)); } }
    { LAS float* zf = (LAS float*)c.lds; LAS float* h1 = zf + 8 * 40; float* h2o = (float*)(ws + WS_H2);
      for (int it = blockIdx.x; it < SEQ / 8; it += gridDim.x) {
          __syncthreads();
          if (c.tid < 8 * 33) { const int r = c.tid / 33, f = c.tid % 33; const int pp = it * 8 + r; float v;
              if (f == 0) v = (float)pp / (float)(SEQ - 1);
              else { const int i = (f - 1) & 15; const float w = 6.283185307179586f * (float)pp / (float)SEQ; const float fr = 1e-4f + (float)i * ((15.0f - 1e-4f) / 15.0f); const float ang = w * fr; v = f <= 16 ? cosf(ang) : -sinf(ang); }
              zf[r * 40 + f] = v; }
          __syncthreads();
          { const int r = c.tid >> 6, j = c.tid & 63; float s = p.hb1[j];
            for (int f = 0; f < 33; ++f) s += zf[r * 40 + f] * p.hw1[f * 64 + j];
            h1[r * 64 + j] = sinf(p.hfr1[j] * s); }
          __syncthreads();
          { const int r = c.tid >> 6, j = c.tid & 63; float s = p.hb2[j];
            for (int k = 0; k < 64; ++k) s += h1[r * 64 + k] * p.hw2[k * 64 + j];
            h2o[(size_t)(it * 8 + r) * 64 + j] = sinf(p.hfr2[j] * s); }
      } }
}

__device__ __forceinline__ void phase_n1(const Params& p, const Ctx& c) {
    unsigned char* ws = p.ws;
    const float* modv = (const float*)(ws + WS_MODV); const float* er = (const float*)(ws + WS_ER); const float* ec = (const float*)(ws + WS_EC);
    bf16_t* n1 = (bf16_t*)(ws + WS_N1);
    for (int row = c.gw; row < MT; row += c.ngw) {
        const bool lat = row < T; const int b = lat ? (row >> 11) : 16, t = row & (SEQ - 1);
        const float* src = lat ? p.x + (size_t)row * D : p.ctx + (size_t)(row - T) * D;
        f32x4 v[4]; float s = 0.f;
#pragma unroll
        for (int j = 0; j < 4; ++j) { const int col = 4 * c.lane + 256 * j; v[j] = *(const f32x4*)(src + col);
            if (lat) { const float* pe = col < 512 ? er + (t >> 6) * 512 + col : ec + (t & 63) * 512 + (col - 512); v[j] += *(const f32x4*)pe; }
            s += (v[j][0] * v[j][0] + v[j][1] * v[j][1]) + (v[j][2] * v[j][2] + v[j][3] * v[j][3]); }
        const float rs = 1.0f / sqrtf(wave_sum(s) * (1.0f / D) + RMS_EPS);
#pragma unroll
        for (int j = 0; j < 4; ++j) { const int col = 4 * c.lane + 256 * j; const f32x4 sh = *(const f32x4*)(modv + (size_t)b * MODW + col), sc = *(const f32x4*)(modv + (size_t)b * MODW + D + col);
            const f32x4 o = v[j] * rs * (sc + 1.0f) + sh; u32x2 w; w.x = pk2(o[0], o[1]); w.y = pk2(o[2], o[3]); *(u32x2*)(n1 + (size_t)row * D + col) = w; }
    }
    { LAS float* xs = (LAS float*)c.lds; LAS float* part = (LAS float*)(c.lds + 17 * 1024 * 4);
      const int nb_in = NIN / 64, nb_g = DFF / 64;
      for (int bx = blockIdx.x; bx < nb_in + 2 * nb_g; bx += gridDim.x) {
          __syncthreads();
          if (bx < nb_in) {
              for (int i = c.tid; i < 17 * 1024; i += NTHR) xs[i] = modv[(size_t)(i >> 10) * MODW + 3 * D + (i & 1023)];
              __syncthreads();
              gemv17<false>(xs, part, p.w_in, NIN, nullptr, (float*)(ws + WS_SWIN), NIN, 0, bx, nb_in); }
          else { const int half = (bx - nb_in) / nb_g, blk = (bx - nb_in) % nb_g;
              for (int i = c.tid; i < 17 * 1024; i += NTHR) xs[i] = modv[(size_t)(i >> 10) * MODW + 6 * D + (i & 1023)];
              __syncthreads();
              const float* W = (half ? p.ffn_wu : p.ffn_wg) + (size_t)D * DFF;
              gemv17<true>(xs, part, W, DFF, nullptr, (float*)(ws + WS_SW2), NGU, half, blk, nb_g); }
      }
    }
    { LAS float* w3s = (LAS float*)c.lds;
      LAS float* hk = w3s + 512;
      LAS float* red = hk + 2048 * 8;
      const float* h2 = (const float*)(ws + WS_H2); bf16_t* krev = (bf16_t*)(ws + WS_KREV);
      for (int it = blockIdx.x; it < 256; it += gridDim.x) {
          const int c0 = 2 * it;
          __syncthreads();
          { const int k = c.tid >> 3, q = c.tid & 7; w3s[c.tid] = p.hw3[(size_t)k * 2048 + (q >> 2) * 1024 + ((q >> 1) & 1) * 512 + c0 + (q & 1)]; }
          __syncthreads();
          float l1[4] = {0.f, 0.f, 0.f, 0.f};
          for (int idx = c.tid; idx < 2048 * 8; idx += NTHR) { const int t = idx >> 3, q = idx & 7; float s = 0.f;
              const float* hr = h2 + (size_t)t * 64;
#pragma unroll 8
              for (int k = 0; k < 64; ++k) s += hr[k] * w3s[k * 8 + q];
              const int ch = c0 + (q & 1); const float delta = fabsf(-3.0701134573253945f + (float)ch * ((-15.350567286626973f + 3.0701134573253945f) / 511.0f));
              const float tn = (float)t / (float)(SEQ - 1); s *= expf(-tn * delta) + 0.05f;
              hk[idx] = s; l1[0] += fabsf(s); }
          { float s = l1[0]; s += __shfl_xor(s, 2); s += __shfl_xor(s, 8); s += __shfl_xor(s, 16); s += __shfl_xor(s, 32);
            if ((c.lane & ~5) == 0) red[c.wid * 4 + ((c.lane >> 2) & 1) * 2 + (c.lane & 1)] = s; }
          __syncthreads();
          for (int e = c.tid; e < 4 * KR_LEN; e += NTHR) { const int oc = e / KR_LEN, i = (e % KR_LEN) - KR_OFF, o = oc >> 1, cc = oc & 1;
              float tot = 0.f;
#pragma unroll
              for (int w = 0; w < 8; ++w) tot += red[w * 4 + oc];
              const int lag = -i; float v = 0.f;
              if (lag >= 0 && lag <= SEQ - 1) v = hk[lag * 8 + o * 4 + 0 + cc]; else if (lag < 0 && lag >= -(SEQ - 1)) v = hk[(-lag - 1) * 8 + o * 4 + 2 + cc];
              krev[((size_t)o * 512 + c0 + cc) * KR_LEN + (e % KR_LEN)] = f2bf(v / (tot + 1e-6f)); }
      } }
}

__device__ __forceinline__ void phase_hgrn_simple(const Params& p, const Ctx& c) {
    unsigned char* ws = p.ws;
    const bf16_t* vb = (const bf16_t*)(ws + WS_V); const bf16_t* qb = (const bf16_t*)(ws + WS_Q);
    LAS float* F = (LAS float*)c.lds; LAS float* Kk = F + 64 * 128; LAS float* Q = Kk + 64 * 128; LAS float* V = Q + 64 * 128;
    const int dg = c.tid & 3, e = c.tid >> 2;
    for (int it = blockIdx.x; it < NB * 4 * 2; it += gridDim.x) {
        const int dir = it & 1, h = (it >> 1) & 3, b = it >> 3;
        const f16_t* lf = (const f16_t*)(ws + (dir ? WS_LBW : WS_LFW)); float* outp = (float*)(ws + (dir ? WS_OBW : WS_OFW));
        float S[32];
#pragma unroll
        for (int i = 0; i < 32; ++i) S[i] = 0.f;
        for (int ci = 0; ci < 36; ++ci) {
            const bool lat = ci >= 4;
            __syncthreads();
            for (int idx = c.tid; idx < 64 * 128; idx += NTHR) { const int j = idx >> 7, d = idx & 127; const int pp = (lat ? ci - 4 : ci) * 64 + j;
                const int row = lat ? b * SEQ + (dir ? SEQ - 1 - pp : pp) : T + b * CL + (dir ? CL - 1 - pp : pp);
                const float f = __expf((float)lf[(size_t)row * 512 + h * 128 + d]);
                F[idx] = f; Kk[idx] = 1.0f - f; V[idx] = bf2f(vb[(size_t)row * 512 + h * 128 + d]); Q[idx] = lat ? bf2f(qb[(size_t)row * 512 + h * 128 + d]) : 0.f; }
            __syncthreads();
            for (int j = 0; j < 64; ++j) { const float ve = V[j * 128 + e]; float part = 0.f;
#pragma unroll
                for (int i = 0; i < 32; ++i) { const int d = dg * 32 + i; S[i] = F[j * 128 + d] * S[i] + Kk[j * 128 + d] * ve; part += S[i] * Q[j * 128 + d]; }
                part += __shfl_xor(part, 1); part += __shfl_xor(part, 2);
                if (lat && dg == 0) { const int pp = (ci - 4) * 64 + j; const int row = b * SEQ + (dir ? SEQ - 1 - pp : pp); outp[(size_t)row * 512 + h * 128 + e] = part; } }
        }
    }
}

__device__ __forceinline__ float hy_tap(const bf16_t* hy, const float* cw, const float* cb, int ch, int b, int t) {
    const bf16_t* src = hy + (((size_t)(ch >> 3) * NB + b) * SEQ) * 8 + (ch & 7); float s = cb[ch];
#pragma unroll
    for (int j = 0; j < 3; ++j) { const int tt = t + j - 1; if (tt >= 0 && tt < SEQ) s += cw[j * NHY + ch] * bf2f(src[(size_t)tt * 8]); }
    return s;
}
__device__ __forceinline__ void phase_hyena_simple(const Params& p, const Ctx& c) {
    unsigned char* ws = p.ws;
    const bf16_t* hy = (const bf16_t*)(ws + WS_HY); const bf16_t* krev = (const bf16_t*)(ws + WS_KREV); bf16_t* zb = (bf16_t*)(ws + WS_ZB);
    LAS float* zs = (LAS float*)c.lds;
    LAS float* kr = zs + 2048 * 16;
    for (int ch = blockIdx.x; ch < BW; ch += gridDim.x) {
        __syncthreads();
        for (int idx = c.tid; idx < NB * SEQ; idx += NTHR) { const int b = idx >> 11, t = idx & (SEQ - 1); zs[t * 16 + b] = bfround(hy_tap(hy, p.conv_w, p.conv_b, ch, b, t)); }
        for (int o = 0; o < 2; ++o) {
            for (int i = c.tid; i < KR_LEN; i += NTHR) kr[i] = bf2f(krev[((size_t)o * 512 + ch) * KR_LEN + i]);
            __syncthreads();
            const int t0 = 4 * c.tid;
            float acc[4][16];
#pragma unroll
            for (int r = 0; r < 4; ++r)
#pragma unroll
                for (int b = 0; b < 16; ++b) acc[r][b] = 0.f;
            float w0, w1 = kr[KR_OFF - t0 - 1], w2 = kr[KR_OFF - t0 - 2], w3 = kr[KR_OFF - t0 - 3];
            for (int s = 0; s < SEQ; ++s) {
                w0 = kr[KR_OFF + s - t0];
                const f32x4 z0 = *(const LAS f32x4*)(zs + s * 16), z1 = *(const LAS f32x4*)(zs + s * 16 + 4), z2 = *(const LAS f32x4*)(zs + s * 16 + 8), z3 = *(const LAS f32x4*)(zs + s * 16 + 12);
#pragma unroll
                for (int j = 0; j < 4; ++j) { acc[0][j] += w0 * z0[j]; acc[0][4 + j] += w0 * z1[j]; acc[0][8 + j] += w0 * z2[j]; acc[0][12 + j] += w0 * z3[j];
                                              acc[1][j] += w1 * z0[j]; acc[1][4 + j] += w1 * z1[j]; acc[1][8 + j] += w1 * z2[j]; acc[1][12 + j] += w1 * z3[j];
                                              acc[2][j] += w2 * z0[j]; acc[2][4 + j] += w2 * z1[j]; acc[2][8 + j] += w2 * z2[j]; acc[2][12 + j] += w2 * z3[j];
                                              acc[3][j] += w3 * z0[j]; acc[3][4 + j] += w3 * z1[j]; acc[3][8 + j] += w3 * z2[j]; acc[3][12 + j] += w3 * z3[j]; }
                w3 = w2; w2 = w1; w1 = w0;
            }
            const float bias = p.hy_bias[o * 512 + ch];
#pragma unroll
            for (int r = 0; r < 4; ++r)
#pragma unroll
                for (int b = 0; b < 16; ++b) acc[r][b] += bias * zs[(t0 + r) * 16 + b];
            __syncthreads();
#pragma unroll
            for (int r = 0; r < 4; ++r)
#pragma unroll
                for (int b4 = 0; b4 < 4; ++b4) *(LAS f32x4*)(zs + (t0 + r) * 16 + 4 * b4) = (f32x4){acc[r][4 * b4], acc[r][4 * b4 + 1], acc[r][4 * b4 + 2], acc[r][4 * b4 + 3]};
#pragma unroll 1
            for (int i = 0; i < 64; ++i) { const int r = i >> 4, b = i & 15, t = t0 + r; const float gate = hy_tap(hy, p.conv_w, p.conv_b, (o + 1) * 512 + ch, b, t);
                const float zn = gate * zs[t * 16 + b];
                if (o == 0) zs[t * 16 + b] = bfround(zn); else zb[((size_t)ch * NB + b) * SEQ + t] = f2bf(zn); }
            __syncthreads();
        }
    }
}


typedef short bf16x8 __attribute__((ext_vector_type(8)));
constexpr int ZROW = 2056;
__device__ __forceinline__ void hy_conv4(const bf16_t* src, int t, float w0, float w1, float w2, float cb, float (&o)[4]) {
    float x[6];
#pragma unroll
    for (int i = 0; i < 6; ++i) { const int tt = t - 1 + i; x[i] = (tt >= 0 && tt < SEQ) ? bf2f(src[(size_t)tt * 8]) : 0.f; }
#pragma unroll
    for (int r = 0; r < 4; ++r) o[r] = cb + w0 * x[r] + w1 * x[r + 1] + w2 * x[r + 2];
}
__device__ __forceinline__ void hy_fill(LAS bf16_t* dst, const bf16_t* hy, const float* cw, const float* cbv, int chx, int tid) {
    const float w0 = cw[chx], w1 = cw[NHY + chx], w2 = cw[2 * NHY + chx], cb = cbv[chx];
    for (int b = 0; b < NB; ++b) { const bf16_t* src = hy + (((size_t)(chx >> 3) * NB + b) * SEQ) * 8 + (chx & 7); float o[4];
        hy_conv4(src, 4 * tid, w0, w1, w2, cb, o);
        u32x2 w; w.x = pk2(o[0], o[1]); w.y = pk2(o[2], o[3]); *(LAS u32x2*)(dst + b * ZROW + 4 * tid) = w; }
}
template <int KIND>
__device__ __forceinline__ void hy_block(pg8::f32x4 (&acc)[16], bf16x8 (&Bw)[16], const LAS bf16_t* zl, const LAS bf16_t* krl, int ub, int i0, int lane) {
    const int fr = lane & 15, fq = lane >> 4;
    const LAS bf16_t* bbase = zl + fr * ZROW + 8 * fq;
    const int abase = KR_OFF - 16 * i0 - fr + 8 * fq;
    const unsigned sh = (unsigned)(fr & 1) * 16u;
#pragma unroll
    for (int uu = 0; uu < 16; ++uu) {
        const int u = ub + uu;
        const bool ldb = KIND == 0 ? (uu >= 1) : (KIND == 1 ? true : (uu == 0));
        if (ldb) Bw[(uu + 15) & 15] = *(const LAS bf16x8*)(bbase + 32 * (u + 15));
        const LAS unsigned* ap = (const LAS unsigned*)(krl + ((abase + 32 * u) & ~1));
        const unsigned d0 = ap[0], d1 = ap[1], d2 = ap[2], d3 = ap[3], d4 = ap[4];
        u32x4 aw; aw.x = __builtin_amdgcn_alignbit(d1, d0, sh); aw.y = __builtin_amdgcn_alignbit(d2, d1, sh); aw.z = __builtin_amdgcn_alignbit(d3, d2, sh); aw.w = __builtin_amdgcn_alignbit(d4, d3, sh);
        const bf16x8 A = __builtin_bit_cast(bf16x8, aw);
#pragma unroll
        for (int m = 0; m < 16; ++m) { const bool on = KIND == 0 ? (m >= 16 - uu) : (KIND == 1 ? true : (m <= 15 - uu));
            if (on) acc[m] = __builtin_amdgcn_mfma_f32_16x16x32_bf16(A, Bw[(uu + m) & 15], acc[m], 0, 0, 0); }
    }
}
__device__ __forceinline__ void phase_hyena_mfma(const Params& p, const Ctx& c) {
    unsigned char* ws = p.ws;
    const bf16_t* hy = (const bf16_t*)(ws + WS_HY); const bf16_t* krev = (const bf16_t*)(ws + WS_KREV); bf16_t* zb = (bf16_t*)(ws + WS_ZB);
    LAS bf16_t* zl = (LAS bf16_t*)c.lds;
    LAS bf16_t* gl = zl + NB * ZROW;
    LAS bf16_t* krl = gl + NB * ZROW;
    const int i0 = 32 * (c.wid >> 1) + (c.wid & 1), fr = c.lane & 15, fq = c.lane >> 4;
    for (int ch = blockIdx.x; ch < BW; ch += gridDim.x) {
        __syncthreads();
        hy_fill(zl, hy, p.conv_w, p.conv_b, ch, c.tid);
        for (int o = 0; o < 2; ++o) {
            hy_fill(gl, hy, p.conv_w, p.conv_b, (o + 1) * 512 + ch, c.tid);
            for (int i = c.tid; i < KR_LEN / 8; i += NTHR) *(LAS u32x4*)(krl + 8 * i) = *(const u32x4*)(krev + ((size_t)o * 512 + ch) * KR_LEN + 8 * i);
            __syncthreads();
            pg8::f32x4 acc[16]; bf16x8 Bw[16];
#pragma unroll
            for (int m = 0; m < 16; ++m) { acc[m] = (pg8::f32x4){0.f, 0.f, 0.f, 0.f}; Bw[m] = (bf16x8){0, 0, 0, 0, 0, 0, 0, 0}; }
            hy_block<0>(acc, Bw, zl, krl, -16, i0, c.lane);
            for (int ub = 0; ub < 48; ub += 16) hy_block<1>(acc, Bw, zl, krl, ub, i0, c.lane);
            hy_block<2>(acc, Bw, zl, krl, 48, i0, c.lane);
            const float bias = p.hy_bias[o * 512 + ch];
            u32x2 res[16];
#pragma unroll
            for (int m = 0; m < 16; ++m) { const int t = 16 * (i0 + 2 * m) + 4 * fq; const u32x2 zo = *(const LAS u32x2*)(zl + fr * ZROW + t), gg = *(const LAS u32x2*)(gl + fr * ZROW + t);
                const float z0 = __uint_as_float(zo.x << 16), z1 = __uint_as_float(zo.x & 0xffff0000u), z2 = __uint_as_float(zo.y << 16), z3 = __uint_as_float(zo.y & 0xffff0000u);
                const float g0 = __uint_as_float(gg.x << 16), g1 = __uint_as_float(gg.x & 0xffff0000u), g2 = __uint_as_float(gg.y << 16), g3 = __uint_as_float(gg.y & 0xffff0000u);
                res[m].x = pk2(g0 * (acc[m][0] + bias * z0), g1 * (acc[m][1] + bias * z1)); res[m].y = pk2(g2 * (acc[m][2] + bias * z2), g3 * (acc[m][3] + bias * z3)); }
            __syncthreads();
#pragma unroll
            for (int m = 0; m < 16; ++m) { const int t = 16 * (i0 + 2 * m) + 4 * fq;
                if (o == 0) *(LAS u32x2*)(zl + fr * ZROW + t) = res[m]; else *(u32x2*)(zb + ((size_t)ch * NB + fr) * SEQ + t) = res[m]; }
        }
    }
}

__device__ __forceinline__ void phase_combine(const Params& p, const Ctx& c) {
    unsigned char* ws = p.ws;
    const float* ofw = (const float*)(ws + WS_OFW); const float* obw = (const float*)(ws + WS_OBW); const bf16_t* g = (const bf16_t*)(ws + WS_G);
    bf16_t* oa = (bf16_t*)(ws + WS_OA); bf16_t* ob = (bf16_t*)(ws + WS_OB); const bf16_t* zb = (const bf16_t*)(ws + WS_ZB);
    for (int row = c.gw; row < T; row += c.ngw) { const int col = 8 * c.lane; float a[8], bq[8], gg[8], w[8], o[8];
        load_f32x8(ofw + (size_t)row * 512 + col, a); load_f32x8(obw + (size_t)row * 512 + col, bq); load_bf16x8(g + (size_t)row * 512 + col, gg); load_f32x8(p.a_norm_w + (col & 127), w);
        float s = 0.f;
#pragma unroll
        for (int j = 0; j < 8; ++j) { a[j] += bq[j]; s += a[j] * a[j]; }
        s += __shfl_xor(s, 1); s += __shfl_xor(s, 2); s += __shfl_xor(s, 4); s += __shfl_xor(s, 8);
        const float rs = 1.0f / sqrtf(s * (1.0f / 128.0f) + RMS_EPS);
#pragma unroll
        for (int j = 0; j < 8; ++j) o[j] = a[j] * rs * w[j] * gg[j];
        store_bf16x8(oa + (size_t)row * 512 + col, o); }
    LAS bf16_t* tile = (LAS bf16_t*)c.lds;
    for (int it = blockIdx.x; it < NB * 32 * 8; it += gridDim.x) { const int cb = it & 7, tb = (it >> 3) & 31, b = it >> 8;
        __syncthreads();
        { const int cl = c.tid >> 3, t8 = (c.tid & 7) * 8; const u32x4 w = *(const u32x4*)(zb + ((size_t)(cb * 64 + cl) * NB + b) * SEQ + tb * 64 + t8); *(LAS u32x4*)(tile + cl * 72 + t8) = w; }
        __syncthreads();
        { const int tl = c.tid >> 3, c8 = (c.tid & 7) * 8; bf16_t v[8];
#pragma unroll
          for (int i = 0; i < 8; ++i) v[i] = tile[(c8 + i) * 72 + tl];
          u32x4 w; w.x = v[0] | ((unsigned)v[1] << 16); w.y = v[2] | ((unsigned)v[3] << 16); w.z = v[4] | ((unsigned)v[5] << 16); w.w = v[6] | ((unsigned)v[7] << 16);
          *(u32x4*)(ob + ((size_t)b * SEQ + tb * 64 + tl) * 512 + cb * 64 + c8) = w; }
    }
}

__device__ __forceinline__ void phase_final(const Params& p, const Ctx& c) {
    const float* ssq = (const float*)(p.ws + WS_SSQ3);
    for (int row = c.gw; row < T; row += c.ngw) { const float rs = rstd_from_ssq(ssq + (size_t)row * 16);
#pragma unroll
        for (int j = 0; j < 4; ++j) { const int col = 4 * c.lane + 256 * j; f32x4* ptr = (f32x4*)(p.out + (size_t)row * D + col); *ptr = *ptr * rs * *(const f32x4*)(p.fnw + col); } }
}

constexpr int N_PHASES = 13;
__global__ void __launch_bounds__(NTHR, 2) fwd_kernel(Params p) {
    extern __shared__ __attribute__((aligned(16))) unsigned char lds_raw[];
    Ctx c; c.lds = (LAS unsigned char*)lds_raw; c.tid = threadIdx.x; c.lane = c.tid & 63; c.wid = __builtin_amdgcn_readfirstlane(c.tid >> 6);
    c.gw = blockIdx.x * NWAVES + c.wid; c.ngw = gridDim.x * NWAVES;
    unsigned char* ws = p.ws;
    const float* modv = (const float*)(ws + WS_MODV);
#if N_LAUNCH_MODE == 1
    cg::grid_group grid = cg::this_grid();
#define SEAM() grid.sync()
#else
#define SEAM() do { } while (0)
#endif
#ifdef ONLY_PHASE
#define IN(k) ((k) == ONLY_PHASE && p.ph_lo <= (k) && (k) < p.ph_hi)
#else
#define IN(k) (p.ph_lo <= (k) && (k) < p.ph_hi)
#endif
#if USE_PG8
#define GEMM2(A_, Bt_, K_, nrows1_, npn1_, nrows2_, npn2_, E_, ssq_) gemm_mfma(c.lds, A_, Bt_, K_, nrows1_, npn1_, nrows2_, npn2_, E_, ssq_)
#else
#define GEMM2(A_, Bt_, K_, nrows1_, npn1_, nrows2_, npn2_, E_, ssq_) do { gemm_simple(c.lds, A_, Bt_, K_, 0, nrows1_, npn1_, E_, ssq_); if ((nrows2_) > 0) gemm_simple(c.lds, A_, Bt_, K_, nrows1_, nrows2_, npn2_, E_, ssq_); } while (0)
#endif
#define GEMM(A_, Bt_, K_, row0_, nrows_, npn_, E_, ssq_) GEMM2(A_, Bt_, K_, nrows_, npn_, 0, 0, E_, ssq_)
    if (IN(0)) { phase_prep(p, c); if (IN(1)) SEAM(); }
    if (IN(1)) { phase_n1(p, c); if (IN(2)) SEAM(); }
    if (IN(2)) { EpiGateUp1 E{(bf16_t*)(ws + WS_HID)};
        GEMM((const bf16_t*)(ws + WS_N1), (const bf16_t*)(ws + WS_WG1_T), D, 0, MT, NGU / 256, E, nullptr); if (IN(3)) SEAM(); }
    if (IN(3)) { EpiDown1 E{p.x, p.ctx, (const float*)(ws + WS_ER), (const float*)(ws + WS_EC), modv, p.out, (bf16_t*)(ws + WS_A2)};
        GEMM((const bf16_t*)(ws + WS_HID), (const bf16_t*)(ws + WS_WD1_T), DFF, 0, MT, D / 256, E, (float*)(ws + WS_SSQ1)); if (IN(4)) SEAM(); }
    if (IN(4)) { EpiWin E{(const float*)(ws + WS_SSQ1), (const float*)(ws + WS_SWIN), (const float*)(ws + WS_LBV), (bf16_t*)(ws + WS_V), (bf16_t*)(ws + WS_Q), (bf16_t*)(ws + WS_G), (bf16_t*)(ws + WS_HY), (bf16_t*)(ws + WS_GAB), (f16_t*)(ws + WS_LFW), (f16_t*)(ws + WS_LBW)};
        GEMM2((const bf16_t*)(ws + WS_A2), (const bf16_t*)(ws + WS_WIN_T), D, T, NIN / 256, TC, 6, E, nullptr); if (IN(5)) SEAM(); }
    if (IN(5)) {
        { LAS float* scr = (LAS float*)(c.lds + c.wid * 8448);
          transpose_gu(p.ffn_wg + (size_t)D * DFF, 0, (bf16_t*)(ws + WS_WG2_T), scr, c.gw, c.ngw, c.lane);
          transpose_gu(p.ffn_wu + (size_t)D * DFF, 1, (bf16_t*)(ws + WS_WG2_T), scr, c.gw, c.ngw, c.lane);
          transpose_matrix(p.ffn_wd + (size_t)DFF * D, DFF, D, (bf16_t*)(ws + WS_WD2_T), scr, c.gw, c.ngw, c.lane); }
#if USE_MFMA_HYENA
        phase_hyena_mfma(p, c);
#else
        phase_hyena_simple(p, c);
#endif
        if (IN(6)) SEAM(); }
    if (IN(6)) { phase_hgrn_simple(p, c); if (IN(7)) SEAM(); }
    if (IN(7)) { phase_combine(p, c); if (IN(8)) SEAM(); }
    if (IN(8)) { EpiProjA EA{(const bf16_t*)(ws + WS_GAB), (float*)(ws + WS_YTMP)}; EpiProjB EB{(const bf16_t*)(ws + WS_GAB), (const float*)(ws + WS_YTMP), (bf16_t*)(ws + WS_Y)};
        GEMM((const bf16_t*)(ws + WS_OA), (const bf16_t*)(ws + WS_WPA_T), 512, 0, T, D / 256, EA, nullptr);
        GEMM((const bf16_t*)(ws + WS_OB), (const bf16_t*)(ws + WS_WPB_T), 512, 0, T, D / 256, EB, nullptr); if (IN(9)) SEAM(); }
    if (IN(9)) { EpiWout E{modv, p.out, (bf16_t*)(ws + WS_A3)};
        GEMM((const bf16_t*)(ws + WS_Y), (const bf16_t*)(ws + WS_WOUT_T), D, 0, T, D / 256, E, (float*)(ws + WS_SSQ2)); if (IN(10)) SEAM(); }
    if (IN(10)) { EpiGateUp2 E{(bf16_t*)(ws + WS_HID2), (const float*)(ws + WS_SSQ2), (const float*)(ws + WS_SW2)};
        GEMM((const bf16_t*)(ws + WS_A3), (const bf16_t*)(ws + WS_WG2_T), D, 0, T, NGU / 256, E, nullptr); if (IN(11)) SEAM(); }
    if (IN(11)) { EpiDown2 E{modv, p.out};
        GEMM((const bf16_t*)(ws + WS_HID2), (const bf16_t*)(ws + WS_WD2_T), DFF, 0, T, D / 256, E, (float*)(ws + WS_SSQ3)); if (IN(12)) SEAM(); }
    if (IN(12)) { phase_final(p, c); }
}

extern "C" void kernel_launch(void* const* d_in, const int* in_sizes, int n_in, void* d_out, int out_size, void* d_ws, size_t ws_size, hipStream_t stream) {
    static int grid = 0;
    if (grid == 0) {
        if (n_in != 26 || in_sizes[0] != T * D || out_size != T * D || ws_size < WS_TOTAL) { fprintf(stderr, "kernel_launch: unexpected shapes (n_in %d, in0 %d, out %d, ws %zu < %zu)\n", n_in, n_in > 0 ? in_sizes[0] : -1, out_size, ws_size, (size_t)WS_TOTAL); grid = -1; return; }
        int dev = 0, cus = 0, per_cu = 0;
        (void)hipGetDevice(&dev); (void)hipDeviceGetAttribute(&cus, hipDeviceAttributeMultiprocessorCount, dev);
        if (hipFuncSetAttribute((const void*)fwd_kernel, hipFuncAttributeMaxDynamicSharedMemorySize, LDS_BYTES) != hipSuccess) { fprintf(stderr, "kernel_launch: hipFuncSetAttribute failed\n"); grid = -1; return; }
        (void)hipOccupancyMaxActiveBlocksPerMultiprocessor(&per_cu, (const void*)fwd_kernel, NTHR, LDS_BYTES);
        if (per_cu < 1) { fprintf(stderr, "kernel_launch: occupancy query says %d blocks per CU\n", per_cu); per_cu = 1; }
        (void)hipGetLastError();
        grid = cus;
    }
    if (grid < 0) return;
    Params p{};
    const float** f = (const float**)&p;
    for (int i = 0; i < 26; ++i) f[i] = (const float*)d_in[i];
    p.out = (float*)d_out; p.ws = (unsigned char*)d_ws;
#if N_LAUNCH_MODE == 1
    p.ph_lo = 0; p.ph_hi = N_PHASES;
    void* args[] = {&p};
    hipError_t e = hipLaunchCooperativeKernel((const void*)fwd_kernel, dim3(grid), dim3(NTHR), args, LDS_BYTES, stream);
    if (e != hipSuccess) fprintf(stderr, "cooperative launch failed: %s (grid %d)\n", hipGetErrorString(e), grid);
#else
    for (int k = 0; k < N_PHASES; ++k) { p.ph_lo = k; p.ph_hi = k + 1; hipLaunchKernelGGL(fwd_kernel, dim3(grid), dim3(NTHR), LDS_BYTES, stream, p); }
#endif
}
```

```cpp
#include <hip/hip_runtime.h>
#include <hip/hip_cooperative_groups.h>
#include <cstdio>
namespace cg = cooperative_groups;

#ifndef N_LAUNCH_MODE
#define N_LAUNCH_MODE 1
#endif
#ifndef USE_MFMA_HYENA
#define USE_MFMA_HYENA 1
#endif
#ifndef USE_MFMA_HGRN
#define USE_MFMA_HGRN 1
#endif
#ifndef USE_PG8
#define USE_PG8 1
#endif

#define LAS __attribute__((address_space(3)))
typedef unsigned short bf16_t;
typedef _Float16 f16_t;
typedef float f32x4 __attribute__((ext_vector_type(4)));
typedef unsigned u32x4 __attribute__((ext_vector_type(4)));
typedef unsigned u32x2 __attribute__((ext_vector_type(2)));

constexpr int D = 1024, NB = 16, SEQ = 2048, T = NB * SEQ, CL = 256, TC = NB * CL, MT = T + TC;
constexpr int DFF = 2816, NGU = 2 * DFF, NIN = 6144, MODW = 9 * D;
constexpr int AKW = 512, AVW = 512, BW = 512, NHY = 3 * BW;
constexpr int KR_LEN = 4128, KR_OFF = 2056;
constexpr float RMS_EPS = 1e-6f;
constexpr int NTHR = 512, NWAVES = 8;
constexpr int LDS_BYTES = 152 * 1024;

constexpr size_t MiB = 1024 * 1024;
constexpr size_t al256(size_t x) { return (x + 255) & ~(size_t)255; }
constexpr size_t WS_CTL = 0;
constexpr size_t WS_MODV = WS_CTL + 65536;
constexpr size_t WS_SWIN = WS_MODV + al256((size_t)17 * MODW * 4);
constexpr size_t WS_SW2 = WS_SWIN + al256((size_t)17 * NIN * 4);
constexpr size_t WS_ER = WS_SW2 + al256((size_t)17 * NGU * 4);
constexpr size_t WS_EC = WS_ER + 32 * 512 * 4;
constexpr size_t WS_LBV = WS_EC + 64 * 512 * 4;
constexpr size_t WS_H2 = WS_LBV + 4096;
constexpr size_t WS_KREV = WS_H2 + 2048 * 64 * 4;
constexpr size_t WS_WIN_T = WS_KREV + al256((size_t)2 * 512 * KR_LEN * 2);
constexpr size_t WS_WPA_T = WS_WIN_T + (size_t)NIN * D * 2;
constexpr size_t WS_WPB_T = WS_WPA_T + (size_t)D * 512 * 2;
constexpr size_t WS_WOUT_T = WS_WPB_T + (size_t)D * 512 * 2;
constexpr size_t WS_PERSIST_END = WS_WOUT_T + (size_t)D * D * 2;
constexpr size_t AR = 27 * MiB;
static_assert(WS_PERSIST_END <= AR, "persistent region");
constexpr size_t WS_HID = AR + 0 * MiB;
constexpr size_t WS_N1 = AR + 198 * MiB;
constexpr size_t WS_WG1_T = AR + 270 * MiB;
constexpr size_t WS_WD1_T = AR + 281 * MiB;
constexpr size_t WS_SSQ1 = AR + 410 * MiB;
constexpr size_t WS_A2 = AR + 413 * MiB;
constexpr size_t WS_GAB = AR + 0 * MiB;
constexpr size_t WS_V = AR + 128 * MiB;
constexpr size_t WS_LFW = AR + 164 * MiB;
constexpr size_t WS_LBW = AR + 200 * MiB;
constexpr size_t WS_Q = AR + 236 * MiB;
constexpr size_t WS_G = AR + 268 * MiB;
constexpr size_t WS_HY = AR + 300 * MiB;
constexpr size_t WS_WG2_T = AR + 436 * MiB;
constexpr size_t WS_WD2_T = AR + 447 * MiB;
constexpr size_t WS_ZB = AR + 453 * MiB;
constexpr size_t WS_OFW = AR + 300 * MiB;
constexpr size_t WS_OBW = AR + 364 * MiB;
constexpr size_t WS_OA = AR + 128 * MiB;
constexpr size_t WS_OB = AR + 160 * MiB;
constexpr size_t WS_YTMP = AR + 192 * MiB;
constexpr size_t WS_Y = AR + 320 * MiB;
constexpr size_t WS_A3 = AR + 0 * MiB;
constexpr size_t WS_SSQ2 = AR + 64 * MiB;
constexpr size_t WS_SSQ3 = AR + 66 * MiB;
constexpr size_t WS_HID2 = AR + 128 * MiB;
constexpr size_t WS_TOTAL = AR + 485 * MiB;

struct Params {
    const float *x, *c, *ctx, *c_ctx, *mod_w, *mod_b, *ffn_wg, *ffn_wu, *ffn_wd, *w_in, *lb_logits, *a_norm_w, *conv_w, *conv_b;
    const float *hw1, *hb1, *hfr1, *hw2, *hb2, *hfr2, *hw3, *hy_bias, *w_pa, *w_pb, *w_out, *fnw;
    float* out; unsigned char* ws;
    int ph_lo, ph_hi;
};

__device__ __forceinline__ float bf2f(bf16_t b) { return __uint_as_float(((unsigned)b) << 16); }
__device__ __forceinline__ bf16_t f2bf(float f) { unsigned u = __float_as_uint(f); u += 0x7FFFu + ((u >> 16) & 1u); return (bf16_t)(u >> 16); }
__device__ __forceinline__ unsigned pk2(float lo, float hi) { return (unsigned)f2bf(lo) | ((unsigned)f2bf(hi) << 16); }
__device__ __forceinline__ float bfround(float f) { return bf2f(f2bf(f)); }
__device__ __forceinline__ float sigmoidf_(float x) { return 1.0f / (1.0f + __expf(-x)); }
__device__ __forceinline__ float siluf_(float x) { return x / (1.0f + __expf(-x)); }
__device__ __forceinline__ float wave_sum(float v) {
#pragma unroll
    for (int o = 1; o < 64; o <<= 1) v += __shfl_xor(v, o);
    return v;
}
__device__ __forceinline__ float pos_embed(const float* er, const float* ec, int t, int col) {
    return col < 512 ? er[(t >> 6) * 512 + col] : ec[(t & 63) * 512 + (col - 512)];
}
__device__ __forceinline__ float rstd_from_ssq(const float* ssq16) {
    const f32x4* s = (const f32x4*)ssq16; float tot = 0.f;
#pragma unroll
    for (int i = 0; i < 4; ++i) { const f32x4 v = s[i]; tot += (v[0] + v[1]) + (v[2] + v[3]); }
    return 1.0f / sqrtf(tot * (1.0f / D) + RMS_EPS);
}

__device__ __forceinline__ void transpose_item(const float* W, int K, int N, bf16_t* WT, int k0, int n0, int dst_row0, LAS float* scr, int lane) {
#pragma unroll 8
    for (int i = 0; i < 32; ++i) { const int kk = 2 * i + (lane >> 5); scr[kk * 33 + (lane & 31)] = W[(size_t)(k0 + kk) * N + n0 + (lane & 31)]; }
    asm volatile("s_waitcnt lgkmcnt(0)" ::: "memory");
    const int c = lane & 7;
#pragma unroll
    for (int j = 0; j < 4; ++j) { const int n = (lane >> 3) + 8 * j; const LAS float* s = scr + (8 * c) * 33 + n;
        u32x4 o; o.x = pk2(s[0 * 33], s[1 * 33]); o.y = pk2(s[2 * 33], s[3 * 33]); o.z = pk2(s[4 * 33], s[5 * 33]); o.w = pk2(s[6 * 33], s[7 * 33]);
        *(u32x4*)(WT + (size_t)(dst_row0 + n) * K + k0 + 8 * c) = o; }
    asm volatile("s_waitcnt lgkmcnt(0)" ::: "memory");
}
__device__ __forceinline__ void transpose_matrix(const float* W, int K, int N, bf16_t* WT, LAS float* scr, int gw, int ngw, int lane) {
    const int nblk = N / 32, items = (K / 64) * nblk;
    for (int it = gw; it < items; it += ngw) { const int kb = it / nblk, nb = it % nblk; transpose_item(W, K, N, WT, 64 * kb, 32 * nb, 32 * nb, scr, lane); }
}
__device__ __forceinline__ void transpose_gu(const float* W, int half, bf16_t* WT, LAS float* scr, int gw, int ngw, int lane) {
    const int nblk = DFF / 32, items = (D / 64) * nblk;
    for (int it = gw; it < items; it += ngw) { const int kb = it / nblk, nb = it % nblk, n0 = 32 * nb;
        transpose_item(W, D, DFF, WT, 64 * kb, n0, 256 * (n0 >> 7) + 128 * half + (n0 & 127), scr, lane); }
}

template <bool GU>
__device__ __forceinline__ void gemv17(const LAS float* xs, LAS float* part, const float* W, int N, const float* bias, float* out, int ldo, int half, int blk0, int nblk_stride) {
    const int tid = threadIdx.x, wid = tid >> 6, lane = tid & 63;
    for (int cb = blk0; cb < N / 64; cb += nblk_stride) {
        const int n = cb * 64 + lane;
        float acc[17];
#pragma unroll
        for (int r = 0; r < 17; ++r) acc[r] = 0.f;
        const float* wp = W + (size_t)(wid * 128) * N + n;
#pragma unroll 4
        for (int k = 0; k < 128; ++k) { const float w = wp[(size_t)k * N];
#pragma unroll
            for (int r = 0; r < 17; ++r) acc[r] += xs[r * 1024 + wid * 128 + k] * w; }
#pragma unroll
        for (int r = 0; r < 17; ++r) part[(wid * 17 + r) * 64 + lane] = acc[r];
        __syncthreads();
        for (int o = tid; o < 17 * 64; o += NTHR) { const int r = o >> 6, l = o & 63; float s = 0.f;
#pragma unroll
            for (int w = 0; w < 8; ++w) s += part[(w * 17 + r) * 64 + l];
            const int nn = cb * 64 + l; if (bias) s += bias[nn];
            const int on = GU ? (256 * (nn >> 7) + 128 * half + (nn & 127)) : nn;
            out[(size_t)r * ldo + on] = s; }
        __syncthreads();
    }
}

__device__ __forceinline__ void store_bf16x8(bf16_t* p, const float (&v)[8]) { u32x4 w; w.x = pk2(v[0], v[1]); w.y = pk2(v[2], v[3]); w.z = pk2(v[4], v[5]); w.w = pk2(v[6], v[7]); *(u32x4*)p = w; }
__device__ __forceinline__ void load_f32x8(const float* p, float (&v)[8]) { const f32x4 a = *(const f32x4*)p, b = *(const f32x4*)(p + 4); v[0] = a[0]; v[1] = a[1]; v[2] = a[2]; v[3] = a[3]; v[4] = b[0]; v[5] = b[1]; v[6] = b[2]; v[7] = b[3]; }
__device__ __forceinline__ void store_f32x8(float* p, const float (&v)[8]) { *(f32x4*)p = (f32x4){v[0], v[1], v[2], v[3]}; *(f32x4*)(p + 4) = (f32x4){v[4], v[5], v[6], v[7]}; }
__device__ __forceinline__ void load_bf16x8(const bf16_t* p, float (&v)[8]) { const u32x4 w = *(const u32x4*)p; v[0] = __uint_as_float(w.x << 16); v[1] = __uint_as_float(w.x & 0xffff0000u); v[2] = __uint_as_float(w.y << 16); v[3] = __uint_as_float(w.y & 0xffff0000u);
    v[4] = __uint_as_float(w.z << 16); v[5] = __uint_as_float(w.z & 0xffff0000u); v[6] = __uint_as_float(w.w << 16); v[7] = __uint_as_float(w.w & 0xffff0000u); }

struct EpiGateUp1 {
    bf16_t* hid;
    __device__ __forceinline__ float apply(int row, int pn, int c, const float (&v0)[8], const float (&v1)[8]) const {
        float o[8];
#pragma unroll
        for (int j = 0; j < 8; ++j) o[j] = siluf_(v0[j]) * v1[j];
        store_bf16x8(hid + (size_t)row * DFF + 128 * pn + c, o); return 0.f; }
};
struct EpiGateUp2 {
    bf16_t* hid; const float* ssq; const float* sw;
    __device__ __forceinline__ float apply(int row, int pn, int c, const float (&v0)[8], const float (&v1)[8]) const {
        const float rs = rstd_from_ssq(ssq + (size_t)row * 16); const int b = row >> 11;
        float s0[8], s1[8], o[8]; load_f32x8(sw + (size_t)b * NGU + 256 * pn + c, s0); load_f32x8(sw + (size_t)b * NGU + 256 * pn + 128 + c, s1);
#pragma unroll
        for (int j = 0; j < 8; ++j) o[j] = siluf_(rs * v0[j] + s0[j]) * (rs * v1[j] + s1[j]);
        store_bf16x8(hid + (size_t)row * DFF + 128 * pn + c, o); return 0.f; }
};
struct EpiDown1 {
    const float *x, *ctx, *er, *ec, *modv; float* hout; bf16_t* a2;
    __device__ __forceinline__ float half_(int row, int col, const float (&v)[8]) const {
        const bool lat = row < T; const int b = lat ? (row >> 11) : 16, t = row & (SEQ - 1);
        float base[8], m2[8], m4[8], h[8], a[8];
        if (lat) { load_f32x8(x + (size_t)row * D + col, base);
#pragma unroll
            for (int j = 0; j < 8; ++j) base[j] += pos_embed(er, ec, t, col + j); }
        else load_f32x8(ctx + (size_t)(row - T) * D + col, base);
        load_f32x8(modv + (size_t)b * MODW + 2 * D + col, m2); load_f32x8(modv + (size_t)b * MODW + 4 * D + col, m4);
        float s = 0.f;
#pragma unroll
        for (int j = 0; j < 8; ++j) { h[j] = base[j] + 0.5f * m2[j] * v[j]; s += h[j] * h[j]; a[j] = h[j] * (1.0f + m4[j]); }
        if (lat) store_f32x8(hout + (size_t)row * D + col, h);
        store_bf16x8(a2 + (size_t)row * D + col, a); return s; }
    __device__ __forceinline__ float apply(int row, int pn, int c, const float (&v0)[8], const float (&v1)[8]) const { return half_(row, 256 * pn + c, v0) + half_(row, 256 * pn + 128 + c, v1); }
};
struct EpiWin {
    const float *ssq, *sw, *lbv; bf16_t *v, *q, *g, *hy, *gab; f16_t *lfw, *lbw;
    __device__ __forceinline__ void half_(int row, int n, float rs, int b, const float (&a)[8]) const {
        float s[8], p[8]; load_f32x8(sw + (size_t)b * NIN + n, s);
#pragma unroll
        for (int j = 0; j < 8; ++j) p[j] = rs * a[j] + s[j];
        const int grp = n >> 9;
        if (grp == 0) { store_bf16x8(v + (size_t)row * 512 + n, p); }
        else if (grp <= 2) { const int nn = n - 512 * grp; f16_t* dst = (grp == 1 ? lfw : lbw) + (size_t)row * 512 + nn; f16_t o[8];
#pragma unroll
            for (int j = 0; j < 8; ++j) { const float lb = lbv[(grp - 1) * 512 + nn + j]; const float f = lb + (1.0f - lb) * sigmoidf_(p[j]); o[j] = (f16_t)__logf(f); }
            *(u32x4*)dst = *(const u32x4*)o; }
        else if (grp == 3) {
#pragma unroll
            for (int j = 0; j < 8; ++j) p[j] = siluf_(p[j]);
            store_bf16x8(q + (size_t)row * 512 + (n - 1536), p); }
        else if (grp == 4) {
#pragma unroll
            for (int j = 0; j < 8; ++j) p[j] = siluf_(p[j]);
            store_bf16x8(g + (size_t)row * 512 + (n - 2048), p); }
        else if (grp <= 7) { const int ch = n - 2560, t = row & (SEQ - 1); store_bf16x8(hy + (((size_t)(ch >> 3) * NB + b) * SEQ + t) * 8, p); }
        else {
#pragma unroll
            for (int j = 0; j < 8; ++j) p[j] = sigmoidf_(p[j]);
            store_bf16x8(gab + (size_t)row * 2048 + (n - 4096), p); }
    }
    __device__ __forceinline__ float apply(int row, int pn, int c, const float (&v0)[8], const float (&v1)[8]) const {
        const float rs = rstd_from_ssq(ssq + (size_t)row * 16); const int b = row < T ? (row >> 11) : 16;
        half_(row, 256 * pn + c, rs, b, v0); half_(row, 256 * pn + 128 + c, rs, b, v1); return 0.f; }
};
struct EpiProjA {
    const bf16_t* gab; float* ytmp;
    __device__ __forceinline__ void half_(int row, int col, const float (&a)[8]) const { float gt[8], o[8]; load_bf16x8(gab + (size_t)row * 2048 + col, gt);
#pragma unroll
        for (int j = 0; j < 8; ++j) o[j] = gt[j] * a[j];
        store_f32x8(ytmp + (size_t)row * D + col, o); }
    __device__ __forceinline__ float apply(int row, int pn, int c, const float (&v0)[8], const float (&v1)[8]) const { half_(row, 256 * pn + c, v0); half_(row, 256 * pn + 128 + c, v1); return 0.f; }
};
struct EpiProjB {
    const bf16_t* gab; const float* ytmp; bf16_t* y;
    __device__ __forceinline__ void half_(int row, int col, const float (&a)[8]) const { float gt[8], yt[8], o[8]; load_bf16x8(gab + (size_t)row * 2048 + 1024 + col, gt); load_f32x8(ytmp + (size_t)row * D + col, yt);
#pragma unroll
        for (int j = 0; j < 8; ++j) o[j] = yt[j] + gt[j] * a[j];
        store_bf16x8(y + (size_t)row * D + col, o); }
    __device__ __forceinline__ float apply(int row, int pn, int c, const float (&v0)[8], const float (&v1)[8]) const { half_(row, 256 * pn + c, v0); half_(row, 256 * pn + 128 + c, v1); return 0.f; }
};
struct EpiWout {
    const float* modv; float* h; bf16_t* a3;
    __device__ __forceinline__ float half_(int row, int col, const float (&v)[8]) const {
        const int b = row >> 11; float base[8], m5[8], m7[8], a[8];
        load_f32x8(h + (size_t)row * D + col, base); load_f32x8(modv + (size_t)b * MODW + 5 * D + col, m5); load_f32x8(modv + (size_t)b * MODW + 7 * D + col, m7);
        float s = 0.f;
#pragma unroll
        for (int j = 0; j < 8; ++j) { base[j] += m5[j] * v[j]; s += base[j] * base[j]; a[j] = base[j] * (1.0f + m7[j]); }
        store_f32x8(h + (size_t)row * D + col, base); store_bf16x8(a3 + (size_t)row * D + col, a); return s; }
    __device__ __forceinline__ float apply(int row, int pn, int c, const float (&v0)[8], const float (&v1)[8]) const { return half_(row, 256 * pn + c, v0) + half_(row, 256 * pn + 128 + c, v1); }
};
struct EpiDown2 {
    const float* modv; float* h;
    __device__ __forceinline__ float half_(int row, int col, const float (&v)[8]) const {
        const int b = row >> 11; float base[8], m8[8];
        load_f32x8(h + (size_t)row * D + col, base); load_f32x8(modv + (size_t)b * MODW + 8 * D + col, m8);
        float s = 0.f;
#pragma unroll
        for (int j = 0; j < 8; ++j) { base[j] += 0.5f * m8[j] * v[j]; s += base[j] * base[j]; }
        store_f32x8(h + (size_t)row * D + col, base); return s; }
    __device__ __forceinline__ float apply(int row, int pn, int c, const float (&v0)[8], const float (&v1)[8]) const { return half_(row, 256 * pn + c, v0) + half_(row, 256 * pn + 128 + c, v1); }
};

template <class Epi>
__device__ __forceinline__ void gemm_simple(LAS unsigned char* lds, const bf16_t* A, const bf16_t* Bt, int K, int row0, int nrows, int npn, const Epi& E, float* ssq) {
    LAS float* As = (LAS float*)lds;
    LAS float* Bs = (LAS float*)(lds + 8192);
    const int tid = threadIdx.x, c8 = tid & 15, rg = tid >> 4;
    const int nrt = nrows / 64, nunits = nrt * npn;
    for (int unit = blockIdx.x; unit < nunits; unit += gridDim.x) {
        const int rt = unit / npn, pn = unit % npn, r0 = row0 + rt * 64;
        float a0[2][8], a1[2][8];
#pragma unroll
        for (int r = 0; r < 2; ++r)
#pragma unroll
            for (int j = 0; j < 8; ++j) { a0[r][j] = 0.f; a1[r][j] = 0.f; }
        for (int k0 = 0; k0 < K; k0 += 32) {
            { const int row = tid >> 3, kq = tid & 7; const u32x2 w = *(const u32x2*)(A + (size_t)(r0 + row) * K + k0 + 4 * kq);
              As[(4 * kq + 0) * 64 + row] = __uint_as_float(w.x << 16); As[(4 * kq + 1) * 64 + row] = __uint_as_float(w.x & 0xffff0000u);
              As[(4 * kq + 2) * 64 + row] = __uint_as_float(w.y << 16); As[(4 * kq + 3) * 64 + row] = __uint_as_float(w.y & 0xffff0000u); }
            { const int n = tid >> 1, kh = tid & 1; const bf16_t* src = Bt + (size_t)(pn * 256 + n) * K + k0 + 16 * kh; float t8[8];
              load_bf16x8(src, t8);
#pragma unroll
              for (int i = 0; i < 8; ++i) Bs[(16 * kh + i) * 256 + n] = t8[i];
              load_bf16x8(src + 8, t8);
#pragma unroll
              for (int i = 0; i < 8; ++i) Bs[(16 * kh + 8 + i) * 256 + n] = t8[i]; }
            __syncthreads();
#pragma unroll 8
            for (int k = 0; k < 32; ++k) {
                const float x0 = As[k * 64 + 2 * rg], x1 = As[k * 64 + 2 * rg + 1];
                const f32x4 b00 = *(const LAS f32x4*)(Bs + k * 256 + 8 * c8), b01 = *(const LAS f32x4*)(Bs + k * 256 + 8 * c8 + 4);
                const f32x4 b10 = *(const LAS f32x4*)(Bs + k * 256 + 128 + 8 * c8), b11 = *(const LAS f32x4*)(Bs + k * 256 + 128 + 8 * c8 + 4);
#pragma unroll
                for (int j = 0; j < 4; ++j) { a0[0][j] += x0 * b00[j]; a0[0][4 + j] += x0 * b01[j]; a1[0][j] += x0 * b10[j]; a1[0][4 + j] += x0 * b11[j];
                                              a0[1][j] += x1 * b00[j]; a0[1][4 + j] += x1 * b01[j]; a1[1][j] += x1 * b10[j]; a1[1][4 + j] += x1 * b11[j]; }
            }
            __syncthreads();
        }
#pragma unroll
        for (int r = 0; r < 2; ++r) { const int row = r0 + 2 * rg + r; float s = E.apply(row, pn, 8 * c8, a0[r], a1[r]);
            s += __shfl_xor(s, 1); s += __shfl_xor(s, 2); s += __shfl_xor(s, 4); s += __shfl_xor(s, 8);
            if (ssq && c8 == 0) *(f32x4*)(ssq + (size_t)row * 16 + pn * 4) = (f32x4){s, 0.f, 0.f, 0.f}; }
    }
}

namespace pg8 {
#define PG8_LAS __attribute__((address_space(3)))
typedef unsigned short bf16_t;
typedef short bf16x8 __attribute__((ext_vector_type(8)));
typedef float f32x4 __attribute__((ext_vector_type(4)));
typedef unsigned u32x4 __attribute__((ext_vector_type(4)));
constexpr int BM = 256, BK = 64, HALF = 128, HTB = HALF * BK * 2  , STAGE_BYTES = 8 * HTB, NXCD = 8, WGM = 8;

__host__ __device__ __forceinline__ int lds_byte(int r, int c) { const int st = (r >> 4) * 2 + (c >> 5), rr = r & 15, cc = c & 31, ob = rr * 64 + cc * 2; return st * 1024 + (ob ^ (((ob >> 9) & 1) << 5)); }
__host__ __device__ __forceinline__ void stage_rc(int b, int& R, int& C) { const int st = b / 1024, sb = b % 1024, swz = sb ^ (((sb >> 9) & 1) << 5); R = (st >> 1) * 16 + swz / 64; C = (st & 1) * 32 + (swz % 64) / 2; }
__host__ __device__ __forceinline__ int perm32(int rho) { const int n = rho >> 4, i = rho & 15; return 8 * (i >> 2) + 4 * n + (i & 3); }

struct Unit { int pm, pn; };
struct Gemm { const bf16_t* A; const bf16_t* Bt; int M, N, K; };

struct StaticOrder {
    int nM, nN, nwg, G, c;
    __host__ __device__ void init(int M, int N, int G_, int c_) { nM = M / BM; nN = N / BM; nwg = nM * nN; G = G_; c = c_; }
    __host__ __device__ bool next(int i, Unit& u) const {
        const long L = (long)i * G + c; if (L >= nwg) return false;
        int wgid = (int)L; { const int q = nwg / NXCD, r = nwg % NXCD, xcd = wgid % NXCD, off = wgid / NXCD; wgid = (xcd < r ? xcd * (q + 1) : r * (q + 1) + (xcd - r) * q) + off; }
        const int nig = WGM * nN, gid = wgid / nig, fm = gid * WGM, gsz = (nM - fm) < WGM ? (nM - fm) : WGM;
        u.pm = fm + ((wgid % nig) % gsz); u.pn = (wgid % nig) / gsz; return true;
    }
    __device__ __forceinline__ void a_ready(const Unit&) const {}
    __device__ __forceinline__ void done(const Unit&) const {}
};
template <class Epi, class Sched>
__device__ __forceinline__ void gemm_phase(PG8_LAS unsigned char* lds, const Gemm g, const Sched& S, const Epi& E) {
    const int tid = threadIdx.x, wid = __builtin_amdgcn_readfirstlane(tid >> 6), lane = tid & 63, wr = wid >> 2, wc = wid & 3, fr = lane & 15, fq = lane >> 4;
    const int K = g.K, nt = K / BK;
    unsigned voffA[2], voffB[2];
#pragma unroll
    for (int i = 0; i < 2; ++i) { int R, C; stage_rc(tid * 16 + i * 8192, R, C); const int Rb = Epi::PERM ? ((R & ~31) + perm32(R & 31)) : R;
        voffA[i] = (unsigned)(R * K + C) * 2u; voffB[i] = (unsigned)(Rb * K + C) * 2u; }
    const size_t kstep = (size_t)(BK * 2);
    const size_t hstep = (size_t)HALF * K * 2;
    const size_t tstep = 2 * hstep;
    const unsigned ldsw = (unsigned)wid * 1024u;
    const int aoff = lds_byte(wr * 64 + fr, fq * 8), boff = lds_byte(wc * 32 + fr, fq * 8);
#define PG8_SA(b, h) (((b) * 2 + (h)) * HTB)
#define PG8_SB(b, h) ((4 + (b) * 2 + (h)) * HTB)
#define PG8_STAGE(bufoff, gbase, voff) do { _Pragma("unroll") for (int _i = 0; _i < 2; ++_i) \
        __builtin_amdgcn_global_load_lds((const unsigned*)((const char*)(gbase) + (voff)[_i]), (PG8_LAS unsigned*)(lds + (bufoff) + ldsw + _i * 8192), 16, 0, 0); } while (0)
#define PG8_LDA(dst, b, h) do { _Pragma("unroll") for (int m = 0; m < 4; ++m) _Pragma("unroll") for (int k = 0; k < 2; ++k) dst[m][k] = *(const PG8_LAS bf16x8*)(lds + PG8_SA(b, h) + aoff + m * 2048 + k * 1024); } while (0)
#define PG8_LDB(dst, b, h) do { _Pragma("unroll") for (int n = 0; n < 2; ++n) _Pragma("unroll") for (int k = 0; k < 2; ++k) dst[n][k] = *(const PG8_LAS bf16x8*)(lds + PG8_SB(b, h) + boff + n * 2048 + k * 1024); } while (0)
#define PG8_MMA(ai, bj, At, Bt) do { __builtin_amdgcn_s_setprio(1); _Pragma("unroll") for (int m = 0; m < 4; ++m) _Pragma("unroll") for (int n = 0; n < 2; ++n) _Pragma("unroll") for (int k = 0; k < 2; ++k) \
        acc[ai][bj][m][n] = __builtin_amdgcn_mfma_f32_16x16x32_bf16(Bt[n][k], At[m][k], acc[ai][bj][m][n], 0, 0, 0); __builtin_amdgcn_s_setprio(0); } while (0)
#define PG8_WAIT_V(n) asm volatile("s_waitcnt vmcnt(" #n ")" ::: "memory")
#define PG8_WAIT_L(n) asm volatile("s_waitcnt lgkmcnt(" #n ")" ::: "memory")
#define PG8_BAR __builtin_amdgcn_s_barrier()
#define PG8_SCHED __builtin_amdgcn_sched_barrier(0)
    Unit cur, nxt; int ui = 0;
    if (!S.next(0, cur)) return;
    f32x4 acc[2][2][4][2];
#pragma unroll
    for (int a = 0; a < 2; ++a)
#pragma unroll
        for (int b = 0; b < 2; ++b)
#pragma unroll
            for (int m = 0; m < 4; ++m)
#pragma unroll
                for (int n = 0; n < 2; ++n) acc[a][b][m][n] = (f32x4){0.f, 0.f, 0.f, 0.f};
    bf16x8 At[4][2], B0[2][2], B1[2][2];
    const char* cA = (const char*)g.A + (size_t)cur.pm * tstep; const char* cB = (const char*)g.Bt + (size_t)cur.pn * tstep;
    S.a_ready(cur);
    PG8_STAGE(PG8_SB(0, 0), cB, voffB); PG8_STAGE(PG8_SA(0, 0), cA, voffA); PG8_STAGE(PG8_SB(0, 1), cB + hstep, voffB); PG8_STAGE(PG8_SA(0, 1), cA + hstep, voffA);
    if (wr == 1) PG8_BAR;
    PG8_WAIT_V(4); PG8_BAR;
    PG8_STAGE(PG8_SB(1, 0), cB + kstep, voffB); PG8_STAGE(PG8_SA(1, 0), cA + kstep, voffA); PG8_STAGE(PG8_SB(1, 1), cB + hstep + kstep, voffB);
    PG8_WAIT_V(6); PG8_BAR;
    for (;;) {
        const bool has_next = S.next(ui + 1, nxt);
        const char* nA = has_next ? (const char*)g.A + (size_t)nxt.pm * tstep : cA; const char* nB = has_next ? (const char*)g.Bt + (size_t)nxt.pn * tstep : cB;
        for (int t = 0; t < nt; t += 2) {
            const bool last = (t == nt - 2);
            const char* a1 = cA + (size_t)(t + 1) * kstep;
            const char* a2 = last ? nA : cA + (size_t)(t + 2) * kstep; const char* b2 = last ? nB : cB + (size_t)(t + 2) * kstep;
            const char* a3 = a2 + kstep; const char* b3 = b2 + kstep;
            if (last && has_next) S.a_ready(nxt);
            PG8_LDB(B0, 0, 0); PG8_SCHED; PG8_LDA(At, 0, 0); PG8_STAGE(PG8_SA(1, 1), a1 + hstep, voffA);
            PG8_WAIT_L(8); PG8_BAR; PG8_WAIT_L(0); PG8_MMA(0, 0, At, B0); PG8_BAR; PG8_SCHED;
            PG8_LDB(B1, 0, 1); PG8_STAGE(PG8_SB(0, 0), b2, voffB);
            PG8_BAR; PG8_WAIT_L(0); PG8_MMA(0, 1, At, B1); PG8_BAR;
            PG8_LDA(At, 0, 1); PG8_STAGE(PG8_SA(0, 0), a2, voffA);
            PG8_BAR; PG8_WAIT_L(0); PG8_MMA(1, 0, At, B0); PG8_BAR; PG8_SCHED;
            PG8_STAGE(PG8_SB(0, 1), b2 + hstep, voffB);
            PG8_WAIT_V(6); PG8_BAR; PG8_MMA(1, 1, At, B1); PG8_BAR;
            PG8_LDB(B0, 1, 0); PG8_SCHED; PG8_LDA(At, 1, 0); PG8_STAGE(PG8_SA(0, 1), a2 + hstep, voffA);
            PG8_WAIT_L(8); PG8_BAR; PG8_WAIT_L(0); PG8_MMA(0, 0, At, B0); PG8_BAR; PG8_SCHED;
            PG8_LDB(B1, 1, 1); PG8_STAGE(PG8_SB(1, 0), b3, voffB);
            PG8_BAR; PG8_WAIT_L(0); PG8_MMA(0, 1, At, B1); PG8_BAR;
            PG8_LDA(At, 1, 1); PG8_STAGE(PG8_SA(1, 0), a3, voffA);
            PG8_BAR; PG8_WAIT_L(0); PG8_MMA(1, 0, At, B0); PG8_BAR; PG8_SCHED;
            PG8_STAGE(PG8_SB(1, 1), b3 + hstep, voffB);
            PG8_WAIT_V(6); PG8_BAR; PG8_MMA(1, 1, At, B1); PG8_BAR;
        }
        if constexpr (!Epi::AFTER_DRAIN) { E(acc, cur, wr, wc, fr, fq); S.done(cur); }
        if (!has_next) break;
#pragma unroll
        for (int a = 0; a < 2; ++a)
#pragma unroll
            for (int b = 0; b < 2; ++b)
#pragma unroll
                for (int m = 0; m < 4; ++m)
#pragma unroll
                    for (int n = 0; n < 2; ++n) acc[a][b][m][n] = (f32x4){0.f, 0.f, 0.f, 0.f};
        cur = nxt; cA = nA; cB = nB; ++ui;
    }
    PG8_WAIT_V(0);
    if (wr == 0) PG8_BAR;
    PG8_BAR;
    if constexpr (Epi::AFTER_DRAIN) { E.fused(acc, cur, wr, wc, fr, fq, lds, wid, lane); S.done(cur); }
#undef PG8_SA
#undef PG8_SB
#undef PG8_STAGE
#undef PG8_LDA
#undef PG8_LDB
#undef PG8_MMA
#undef PG8_WAIT_V
#undef PG8_WAIT_L
#undef PG8_BAR
#undef PG8_SCHED
}
}

template <class F> struct EpiAd {
    static constexpr bool PERM = true, AFTER_DRAIN = false;
    F f; float* ssq;
    __device__ __forceinline__ void operator()(const pg8::f32x4 (&acc)[2][2][4][2], const pg8::Unit& u, int wr, int wc, int fr, int fq) const {
#pragma unroll
        for (int ai = 0; ai < 2; ++ai)
#pragma unroll
            for (int m = 0; m < 4; ++m) { const int row = u.pm * 256 + ai * 128 + wr * 64 + m * 16 + fr;
                float v0[8], v1[8];
#pragma unroll
                for (int n = 0; n < 2; ++n)
#pragma unroll
                    for (int e = 0; e < 4; ++e) { v0[4 * n + e] = acc[ai][0][m][n][e]; v1[4 * n + e] = acc[ai][1][m][n][e]; }
                float s = f.apply(row, u.pn, wc * 32 + 8 * fq, v0, v1);
                if (ssq) { s += __shfl_xor(s, 16); s += __shfl_xor(s, 32); if (fq == 0) ssq[(size_t)row * 16 + u.pn * 4 + wc] = s; } }
    }
};
struct TwoPartOrder {
    pg8::StaticOrder s1; int n1, nM1, nM2, n2, G, c;
    __device__ void init(int nM1_, int nN1, int nM2_, int nN2, int G_, int c_) { s1.init(nM1_ * 256, nN1 * 256, G_, c_); n1 = nM1_ * nN1; nM1 = nM1_; nM2 = nM2_; n2 = nM2_ * nN2; G = G_; c = c_; }
    __device__ bool next(int i, pg8::Unit& u) const { long L = (long)i * G + c; if (L < n1) return s1.next(i, u); L -= n1; if (L >= n2) return false; u.pm = nM1 + (int)(L % nM2); u.pn = (int)(L / nM2); return true; }
    __device__ __forceinline__ void a_ready(const pg8::Unit&) const {}
    __device__ __forceinline__ void done(const pg8::Unit&) const {}
};
template <class F>
__device__ __forceinline__ void gemm_mfma(LAS unsigned char* lds, const bf16_t* A, const bf16_t* Bt, int K, int nrows1, int npn1, int nrows2, int npn2, const F& f, float* ssq) {
    __syncthreads();
    pg8::Gemm g{A, Bt, nrows1 + nrows2, npn1 * 256, K}; TwoPartOrder S; S.init(nrows1 / 256, npn1, nrows2 / 256, npn2, (int)gridDim.x, (int)blockIdx.x);
    EpiAd<F> E{f, ssq};
    pg8::gemm_phase(lds, g, S, E);
    __syncthreads();
}

struct Ctx { LAS unsigned char* lds; int tid, lane, wid, gw, ngw; };

__device__ __forceinline__ void phase_prep(const Params& p, const Ctx& c) {
    unsigned char* ws = p.ws;
    LAS float* scr = (LAS float*)(c.lds + c.wid * 8448);
    transpose_matrix(p.w_in, D, NIN, (bf16_t*)(ws + WS_WIN_T), scr, c.gw, c.ngw, c.lane);
    transpose_matrix(p.w_pa, 512, D, (bf16_t*)(ws + WS_WPA_T), scr, c.gw, c.ngw, c.lane);
    transpose_matrix(p.w_pb, 512, D, (bf16_t*)(ws + WS_WPB_T), scr, c.gw, c.ngw, c.lane);
    transpose_matrix(p.w_out, D, D, (bf16_t*)(ws + WS_WOUT_T), scr, c.gw, c.ngw, c.lane);
    transpose_gu(p.ffn_wg, 0, (bf16_t*)(ws + WS_WG1_T), scr, c.gw, c.ngw, c.lane);
    transpose_gu(p.ffn_wu, 1, (bf16_t*)(ws + WS_WG1_T), scr, c.gw, c.ngw, c.lane);
    transpose_matrix(p.ffn_wd, DFF, D, (bf16_t*)(ws + WS_WD1_T), scr, c.gw, c.ngw, c.lane);
    __syncthreads();
    if ((int)blockIdx.x < MODW / 64) {
        LAS float* xs = (LAS float*)c.lds; LAS float* part = (LAS float*)(c.lds + 17 * 1024 * 4);
        for (int i = c.tid; i < 17 * 1024; i += NTHR) { const int r = i >> 10, k = i & 1023; const float v = r < 16 ? p.c[r * D + k] : p.c_ctx[k]; xs[i] = v / (1.0f + expf(-v)); }
        __syncthreads();
        gemv17<false>(xs, part, p.mod_w, MODW, p.mod_b, (float*)(ws + WS_MODV), MODW, 0, blockIdx.x, gridDim.x);
    }
    { float* er = (float*)(ws + WS_ER); float* ec = (float*)(ws + WS_EC); float* lbv = (float*)(ws + WS_LBV);
      const int gt = blockIdx.x * NTHR + c.tid, ngt = gridDim.x * NTHR;
      for (int i = gt; i < 96 * 512; i += ngt) { const int r = i >> 9, j = i & 511, jj = j & 255; const float omega = 1.0f / powf(10000.0f, (float)jj / 256.0f);
          const int pos = r < 32 ? r : r - 32; const float a = (float)pos * omega; const float v = j < 256 ? sinf(a) : cosf(a);
          if (r < 32) er[r * 512 + j] = v; else ec[(r - 32) * 512 + j] = v; }
      for (int i = gt; i < 1024; i += ngt) { const float l0 = p.lb_logits[i], l1 = p.lb_logits[1024 + i]; lbv[i] = 1.0f / (1.0f + expf(l1 - l0)); } }
    { LAS float* zf = (LAS float*)c.lds; LAS float* h1 = zf + 8 * 40; float* h2o = (float*)(ws + WS_H2);
      for (int it = blockIdx.x; it < SEQ / 8; it += gridDim.x) {
          __syncthreads();
          if (c.tid < 8 * 33) { const int r = c.tid / 33, f = c.tid % 33; const int pp = it * 8 + r; float v;
              if (f == 0) v = (float)pp / (float)(SEQ - 1);
              else { const int i = (f - 1) & 15; const float w = 6.283185307179586f * (float)pp / (float)SEQ; const float fr = 1e-4f + (float)i * ((15.0f - 1e-4f) / 15.0f); const float ang = w * fr; v = f <= 16 ? cosf(ang) : -sinf(ang); }
              zf[r * 40 + f] = v; }
          __syncthreads();
          { const int r = c.tid >> 6, j = c.tid & 63; float s = p.hb1[j];
            for (int f = 0; f < 33; ++f) s += zf[r * 40 + f] * p.hw1[f * 64 + j];
            h1[r * 64 + j] = sinf(p.hfr1[j] * s); }
          __syncthreads();
          { const int r = c.tid >> 6, j = c.tid & 63; float s = p.hb2[j];
            for (int k = 0; k < 64; ++k) s += h1[r * 64 + k] * p.hw2[k * 64 + j];
            h2o[(size_t)(it * 8 + r) * 64 + j] = sinf(p.hfr2[j] * s); }
      } }
}

__device__ __forceinline__ void phase_n1(const Params& p, const Ctx& c) {
    unsigned char* ws = p.ws;
    const float* modv = (const float*)(ws + WS_MODV); const float* er = (const float*)(ws + WS_ER); const float* ec = (const float*)(ws + WS_EC);
    bf16_t* n1 = (bf16_t*)(ws + WS_N1);
    for (int row = c.gw; row < MT; row += c.ngw) {
        const bool lat = row < T; const int b = lat ? (row >> 11) : 16, t = row & (SEQ - 1);
        const float* src = lat ? p.x + (size_t)row * D : p.ctx + (size_t)(row - T) * D;
        f32x4 v[4]; float s = 0.f;
#pragma unroll
        for (int j = 0; j < 4; ++j) { const int col = 4 * c.lane + 256 * j; v[j] = *(const f32x4*)(src + col);
            if (lat) { const float* pe = col < 512 ? er + (t >> 6) * 512 + col : ec + (t & 63) * 512 + (col - 512); v[j] += *(const f32x4*)pe; }
            s += (v[j][0] * v[j][0] + v[j][1] * v[j][1]) + (v[j][2] * v[j][2] + v[j][3] * v[j][3]); }
        const float rs = 1.0f / sqrtf(wave_sum(s) * (1.0f / D) + RMS_EPS);
#pragma unroll
        for (int j = 0; j < 4; ++j) { const int col = 4 * c.lane + 256 * j; const f32x4 sh = *(const f32x4*)(modv + (size_t)b * MODW + col), sc = *(const f32x4*)(modv + (size_t)b * MODW + D + col);
            const f32x4 o = v[j] * rs * (sc + 1.0f) + sh; u32x2 w; w.x = pk2(o[0], o[1]); w.y = pk2(o[2], o[3]); *(u32x2*)(n1 + (size_t)row * D + col) = w; }
    }
    { LAS float* xs = (LAS float*)c.lds; LAS float* part = (LAS float*)(c.lds + 17 * 1024 * 4);
      const int nb_in = NIN / 64, nb_g = DFF / 64;
      for (int bx = blockIdx.x; bx < nb_in + 2 * nb_g; bx += gridDim.x) {
          __syncthreads();
          if (bx < nb_in) {
              for (int i = c.tid; i < 17 * 1024; i += NTHR) xs[i] = modv[(size_t)(i >> 10) * MODW + 3 * D + (i & 1023)];
              __syncthreads();
              gemv17<false>(xs, part, p.w_in, NIN, nullptr, (float*)(ws + WS_SWIN), NIN, 0, bx, nb_in); }
          else { const int half = (bx - nb_in) / nb_g, blk = (bx - nb_in) % nb_g;
              for (int i = c.tid; i < 17 * 1024; i += NTHR) xs[i] = modv[(size_t)(i >> 10) * MODW + 6 * D + (i & 1023)];
              __syncthreads();
              const float* W = (half ? p.ffn_wu : p.ffn_wg) + (size_t)D * DFF;
              gemv17<true>(xs, part, W, DFF, nullptr, (float*)(ws + WS_SW2), NGU, half, blk, nb_g); }
      }
    }
    { LAS float* w3s = (LAS float*)c.lds;
      LAS float* hk = w3s + 512;
      LAS float* red = hk + 2048 * 8;
      const float* h2 = (const float*)(ws + WS_H2); bf16_t* krev = (bf16_t*)(ws + WS_KREV);
      for (int it = blockIdx.x; it < 256; it += gridDim.x) {
          const int c0 = 2 * it;
          __syncthreads();
          { const int k = c.tid >> 3, q = c.tid & 7; w3s[c.tid] = p.hw3[(size_t)k * 2048 + (q >> 2) * 1024 + ((q >> 1) & 1) * 512 + c0 + (q & 1)]; }
          __syncthreads();
          float l1[4] = {0.f, 0.f, 0.f, 0.f};
          for (int idx = c.tid; idx < 2048 * 8; idx += NTHR) { const int t = idx >> 3, q = idx & 7; float s = 0.f;
              const float* hr = h2 + (size_t)t * 64;
#pragma unroll 8
              for (int k = 0; k < 64; ++k) s += hr[k] * w3s[k * 8 + q];
              const int ch = c0 + (q & 1); const float delta = fabsf(-3.0701134573253945f + (float)ch * ((-15.350567286626973f + 3.0701134573253945f) / 511.0f));
              const float tn = (float)t / (float)(SEQ - 1); s *= expf(-tn * delta) + 0.05f;
              hk[idx] = s; l1[0] += fabsf(s); }
          { float s = l1[0]; s += __shfl_xor(s, 2); s += __shfl_xor(s, 8); s += __shfl_xor(s, 16); s += __shfl_xor(s, 32);
            if ((c.lane & ~5) == 0) red[c.wid * 4 + ((c.lane >> 2) & 1) * 2 + (c.lane & 1)] = s; }
          __syncthreads();
          for (int e = c.tid; e < 4 * KR_LEN; e += NTHR) { const int oc = e / KR_LEN, i = (e % KR_LEN) - KR_OFF, o = oc >> 1, cc = oc & 1;
              float tot = 0.f;
#pragma unroll
              for (int w = 0; w < 8; ++w) tot += red[w * 4 + oc];
              const int lag = -i; float v = 0.f;
              if (lag >= 0 && lag <= SEQ - 1) v = hk[lag * 8 + o * 4 + 0 + cc]; else if (lag < 0 && lag >= -(SEQ - 1)) v = hk[(-lag - 1) * 8 + o * 4 + 2 + cc];
              krev[((size_t)o * 512 + c0 + cc) * KR_LEN + (e % KR_LEN)] = f2bf(v / (tot + 1e-6f)); }
      } }
}

__device__ __forceinline__ void phase_hgrn_simple(const Params& p, const Ctx& c) {
    unsigned char* ws = p.ws;
    const bf16_t* vb = (const bf16_t*)(ws + WS_V); const bf16_t* qb = (const bf16_t*)(ws + WS_Q);
    LAS float* F = (LAS float*)c.lds; LAS float* Kk = F + 64 * 128; LAS float* Q = Kk + 64 * 128; LAS float* V = Q + 64 * 128;
    const int dg = c.tid & 3, e = c.tid >> 2;
    for (int it = blockIdx.x; it < NB * 4 * 2; it += gridDim.x) {
        const int dir = it & 1, h = (it >> 1) & 3, b = it >> 3;
        const f16_t* lf = (const f16_t*)(ws + (dir ? WS_LBW : WS_LFW)); float* outp = (float*)(ws + (dir ? WS_OBW : WS_OFW));
        float S[32];
#pragma unroll
        for (int i = 0; i < 32; ++i) S[i] = 0.f;
        for (int ci = 0; ci < 36; ++ci) {
            const bool lat = ci >= 4;
            __syncthreads();
            for (int idx = c.tid; idx < 64 * 128; idx += NTHR) { const int j = idx >> 7, d = idx & 127; const int pp = (lat ? ci - 4 : ci) * 64 + j;
                const int row = lat ? b * SEQ + (dir ? SEQ - 1 - pp : pp) : T + b * CL + (dir ? CL - 1 - pp : pp);
                const float f = __expf((float)lf[(size_t)row * 512 + h * 128 + d]);
                F[idx] = f; Kk[idx] = 1.0f - f; V[idx] = bf2f(vb[(size_t)row * 512 + h * 128 + d]); Q[idx] = lat ? bf2f(qb[(size_t)row * 512 + h * 128 + d]) : 0.f; }
            __syncthreads();
            for (int j = 0; j < 64; ++j) { const float ve = V[j * 128 + e]; float part = 0.f;
#pragma unroll
                for (int i = 0; i < 32; ++i) { const int d = dg * 32 + i; S[i] = F[j * 128 + d] * S[i] + Kk[j * 128 + d] * ve; part += S[i] * Q[j * 128 + d]; }
                part += __shfl_xor(part, 1); part += __shfl_xor(part, 2);
                if (lat && dg == 0) { const int pp = (ci - 4) * 64 + j; const int row = b * SEQ + (dir ? SEQ - 1 - pp : pp); outp[(size_t)row * 512 + h * 128 + e] = part; } }
        }
    }
}


typedef short bf16x8 __attribute__((ext_vector_type(8)));
constexpr int QROW = 136, TROW = 72;
__device__ __forceinline__ int hg_pos(int x) { return (x & ~31) + ((x >> 2) & 3) * 8 + ((x >> 4) & 1) * 4 + (x & 3); }
__device__ __forceinline__ pg8::f32x4 mfma16(bf16x8 a, bf16x8 b, pg8::f32x4 c) { return __builtin_amdgcn_mfma_f32_16x16x32_bf16(a, b, c, 0, 0, 0); }
__device__ __forceinline__ void phase_hgrn_mfma(const Params& p, const Ctx& c) {
    unsigned char* ws = p.ws;
    const bf16_t* vb = (const bf16_t*)(ws + WS_V); const bf16_t* qb = (const bf16_t*)(ws + WS_Q);
    LAS bf16_t* Qt = (LAS bf16_t*)c.lds;
    LAS bf16_t* Kt = Qt + 64 * QROW;
    LAS bf16_t* KhT = Kt + 64 * QROW;
    LAS bf16_t* VT = KhT + 128 * TROW;
    LAS bf16_t* ST0 = VT + 64 * TROW;
    LAS bf16_t* ST1 = ST0 + 64 * QROW;
    LAS float* qt = (LAS float*)(ST1 + 64 * QROW);
    LAS float* El = qt + 8 * 128;
    const int wid = c.wid, lane = c.lane, fr = lane & 15, fq = lane >> 4, dp = lane, ti = wid & 3, eh = wid >> 2;
    for (int it = blockIdx.x; it < 256; it += gridDim.x) {
        const int dvh = (it >> 3) & 1, idx = (it & 7) | ((it >> 4) << 3), dir = idx & 1, h = (idx >> 1) & 3, b = idx >> 3;
        const f16_t* lf = (const f16_t*)(ws + (dir ? WS_LBW : WS_LFW)); float* outp = (float*)(ws + (dir ? WS_OBW : WS_OFW));
        const int colq = h * 128 + 2 * dp, colv = h * 128 + dvh * 64 + (c.tid & 7) * 8, pv = c.tid >> 3;
        pg8::f32x4 S[4];
#pragma unroll
        for (int e = 0; e < 4; ++e) S[e] = (pg8::f32x4){0.f, 0.f, 0.f, 0.f};
#define HG_ROW(ci_, p_) (((ci_) >= 4) ? (b * SEQ + (dir ? SEQ - 1 - (((ci_) - 4) * 64 + (p_)) : (((ci_) - 4) * 64 + (p_)))) : (T + b * CL + (dir ? CL - 1 - ((ci_) * 64 + (p_)) : ((ci_) * 64 + (p_)))))
        unsigned lfr[8], qr[8]; u32x4 vr;
#pragma unroll
        for (int i = 0; i < 8; ++i) { const int row = HG_ROW(0, 8 * wid + i); lfr[i] = *(const unsigned*)(lf + (size_t)row * 512 + colq); qr[i] = 0u; }
        vr = *(const u32x4*)(vb + (size_t)HG_ROW(0, pv) * 512 + colv);
        __syncthreads();
        for (int ci = 0; ci < 36; ++ci) {
            const bool lat = ci >= 4;
            float l0[8], l1[8], c0[8], c1[8]; float run0 = 0.f, run1 = 0.f;
#pragma unroll
            for (int i = 0; i < 8; ++i) { const __fp16 a0 = __builtin_bit_cast(__fp16, (unsigned short)(lfr[i] & 0xffffu)), a1 = __builtin_bit_cast(__fp16, (unsigned short)(lfr[i] >> 16));
                l0[i] = (float)a0; l1[i] = (float)a1; run0 += l0[i]; run1 += l1[i]; c0[i] = run0; c1[i] = run1; }
            qt[wid * 128 + 2 * dp] = run0; qt[wid * 128 + 2 * dp + 1] = run1;
            __syncthreads();
            float off0 = 0.f, off1 = 0.f, tot0 = 0.f, tot1 = 0.f;
#pragma unroll
            for (int w = 0; w < 8; ++w) { const float a0 = qt[w * 128 + 2 * dp], a1 = qt[w * 128 + 2 * dp + 1]; tot0 += a0; tot1 += a1; if (w < wid) { off0 += a0; off1 += a1; } }
            const float E0 = __expf(tot0), E1 = __expf(tot1);
            if (wid == 0) { El[2 * dp] = E0; El[2 * dp + 1] = E1; }
            const int qpos = hg_pos(2 * dp);
            float kh0[8], kh1[8];
#pragma unroll
            for (int i = 0; i < 8; ++i) { const int pp = 8 * wid + i; const float cu0 = off0 + c0[i], cu1 = off1 + c1[i];
                const float e0 = __expf(cu0), e1 = __expf(cu1), r0 = __expf(-cu0), r1 = __expf(-cu1);
                const float k0 = (1.0f - __expf(l0[i])) * r0, k1 = (1.0f - __expf(l1[i])) * r1;
                *(LAS unsigned*)(Kt + pp * QROW + qpos) = pk2(k0, k1);
                if (lat) { const float q0 = __uint_as_float(qr[i] << 16), q1 = __uint_as_float(qr[i] & 0xffff0000u); *(LAS unsigned*)(Qt + pp * QROW + qpos) = pk2(q0 * e0, q1 * e1); }
                kh0[i] = k0 * E0; kh1[i] = k1 * E1; }
            { const int base0 = 32 * (wid >> 2) + 16 * (wid & 1) + 4 * ((wid >> 1) & 1);
              u32x2 w; w.x = pk2(kh0[0], kh0[1]); w.y = pk2(kh0[2], kh0[3]); *(LAS u32x2*)(KhT + (2 * dp) * TROW + base0) = w;
              w.x = pk2(kh0[4], kh0[5]); w.y = pk2(kh0[6], kh0[7]); *(LAS u32x2*)(KhT + (2 * dp) * TROW + base0 + 8) = w;
              w.x = pk2(kh1[0], kh1[1]); w.y = pk2(kh1[2], kh1[3]); *(LAS u32x2*)(KhT + (2 * dp + 1) * TROW + base0) = w;
              w.x = pk2(kh1[4], kh1[5]); w.y = pk2(kh1[6], kh1[7]); *(LAS u32x2*)(KhT + (2 * dp + 1) * TROW + base0 + 8) = w; }
            { const int e8 = (c.tid & 7) * 8, sp = hg_pos(pv); const unsigned wv[4] = {vr.x, vr.y, vr.z, vr.w};
#pragma unroll
              for (int j = 0; j < 4; ++j) { VT[(e8 + 2 * j) * TROW + sp] = (bf16_t)(wv[j] & 0xffffu); VT[(e8 + 2 * j + 1) * TROW + sp] = (bf16_t)(wv[j] >> 16); } }
            if (ci + 1 < 36) { const bool nlat = ci + 1 >= 4;
#pragma unroll
                for (int i = 0; i < 8; ++i) { const int row = HG_ROW(ci + 1, 8 * wid + i); lfr[i] = *(const unsigned*)(lf + (size_t)row * 512 + colq); if (nlat) qr[i] = *(const unsigned*)(qb + (size_t)row * 512 + colq); }
                vr = *(const u32x4*)(vb + (size_t)HG_ROW(ci + 1, pv) * 512 + colv); }
            __syncthreads();
            const LAS bf16_t* STr = (ci & 1) ? ST1 : ST0; LAS bf16_t* STw = (ci & 1) ? ST0 : ST1;
            bf16x8 VF[4][2];
#pragma unroll
            for (int ei = 0; ei < 4; ++ei)
#pragma unroll
                for (int a = 0; a < 2; ++a) VF[ei][a] = *(const LAS bf16x8*)(VT + (16 * ei + fr) * TROW + 32 * a + 8 * fq);
            if (lat) {
                bf16x8 QF[4];
#pragma unroll
                for (int k = 0; k < 4; ++k) QF[k] = *(const LAS bf16x8*)(Qt + (16 * ti + fr) * QROW + 32 * k + 8 * fq);
                pg8::f32x4 P[4];
#pragma unroll
                for (int si = 0; si < 4; ++si) { pg8::f32x4 acc = (pg8::f32x4){0.f, 0.f, 0.f, 0.f};
                    if (si <= ti) {
#pragma unroll
                        for (int k = 0; k < 4; ++k) acc = mfma16(*(const LAS bf16x8*)(Kt + (16 * si + fr) * QROW + 32 * k + 8 * fq), QF[k], acc);
                        if (si == ti) {
#pragma unroll
                            for (int r = 0; r < 4; ++r) acc[r] = (4 * fq + r <= fr) ? acc[r] : 0.f; } }
                    P[si] = acc; }
                bf16x8 PB[2];
#pragma unroll
                for (int a = 0; a < 2; ++a) { u32x4 w; w.x = pk2(P[2 * a][0], P[2 * a][1]); w.y = pk2(P[2 * a][2], P[2 * a][3]); w.z = pk2(P[2 * a + 1][0], P[2 * a + 1][1]); w.w = pk2(P[2 * a + 1][2], P[2 * a + 1][3]); PB[a] = __builtin_bit_cast(bf16x8, w); }
#pragma unroll
                for (int e2 = 0; e2 < 2; ++e2) { const int ei = 2 * eh + e2; pg8::f32x4 acc = (pg8::f32x4){0.f, 0.f, 0.f, 0.f};
#pragma unroll
                    for (int a = 0; a < 2; ++a) if (2 * a <= ti) acc = mfma16(*(const LAS bf16x8*)(VT + (16 * ei + fr) * TROW + 32 * a + 8 * fq), PB[a], acc);
#pragma unroll
                    for (int k = 0; k < 4; ++k) acc = mfma16(*(const LAS bf16x8*)(STr + (16 * ei + fr) * QROW + 32 * k + 8 * fq), QF[k], acc);
                    const int row = HG_ROW(ci, 16 * ti + fr);
                    *(pg8::f32x4*)(outp + (size_t)row * 512 + h * 128 + dvh * 64 + 16 * ei + 4 * fq) = acc; }
            }
            { const pg8::f32x4 dl = *(const LAS pg8::f32x4*)(El + 16 * wid + 4 * fq);
              bf16x8 KH[2];
#pragma unroll
              for (int a = 0; a < 2; ++a) KH[a] = *(const LAS bf16x8*)(KhT + (16 * wid + fr) * TROW + 32 * a + 8 * fq);
#pragma unroll
              for (int ei = 0; ei < 4; ++ei) { S[ei] = S[ei] * dl;
#pragma unroll
                  for (int a = 0; a < 2; ++a) S[ei] = mfma16(KH[a], VF[ei][a], S[ei]);
                  u32x2 w; w.x = pk2(S[ei][0], S[ei][1]); w.y = pk2(S[ei][2], S[ei][3]);
                  *(LAS u32x2*)(STw + (16 * ei + fr) * QROW + 32 * (wid >> 1) + 8 * fq + 4 * (wid & 1)) = w; } }
            __syncthreads();
        }
#undef HG_ROW
    }
}

__device__ __forceinline__ float hy_tap(const bf16_t* hy, const float* cw, const float* cb, int ch, int b, int t) {
    const bf16_t* src = hy + (((size_t)(ch >> 3) * NB + b) * SEQ) * 8 + (ch & 7); float s = cb[ch];
#pragma unroll
    for (int j = 0; j < 3; ++j) { const int tt = t + j - 1; if (tt >= 0 && tt < SEQ) s += cw[j * NHY + ch] * bf2f(src[(size_t)tt * 8]); }
    return s;
}
__device__ __forceinline__ void phase_hyena_simple(const Params& p, const Ctx& c) {
    unsigned char* ws = p.ws;
    const bf16_t* hy = (const bf16_t*)(ws + WS_HY); const bf16_t* krev = (const bf16_t*)(ws + WS_KREV); bf16_t* zb = (bf16_t*)(ws + WS_ZB);
    LAS float* zs = (LAS float*)c.lds;
    LAS float* kr = zs + 2048 * 16;
    for (int ch = blockIdx.x; ch < BW; ch += gridDim.x) {
        __syncthreads();
        for (int idx = c.tid; idx < NB * SEQ; idx += NTHR) { const int b = idx >> 11, t = idx & (SEQ - 1); zs[t * 16 + b] = bfround(hy_tap(hy, p.conv_w, p.conv_b, ch, b, t)); }
        for (int o = 0; o < 2; ++o) {
            for (int i = c.tid; i < KR_LEN; i += NTHR) kr[i] = bf2f(krev[((size_t)o * 512 + ch) * KR_LEN + i]);
            __syncthreads();
            const int t0 = 4 * c.tid;
            float acc[4][16];
#pragma unroll
            for (int r = 0; r < 4; ++r)
#pragma unroll
                for (int b = 0; b < 16; ++b) acc[r][b] = 0.f;
            float w0, w1 = kr[KR_OFF - t0 - 1], w2 = kr[KR_OFF - t0 - 2], w3 = kr[KR_OFF - t0 - 3];
            for (int s = 0; s < SEQ; ++s) {
                w0 = kr[KR_OFF + s - t0];
                const f32x4 z0 = *(const LAS f32x4*)(zs + s * 16), z1 = *(const LAS f32x4*)(zs + s * 16 + 4), z2 = *(const LAS f32x4*)(zs + s * 16 + 8), z3 = *(const LAS f32x4*)(zs + s * 16 + 12);
#pragma unroll
                for (int j = 0; j < 4; ++j) { acc[0][j] += w0 * z0[j]; acc[0][4 + j] += w0 * z1[j]; acc[0][8 + j] += w0 * z2[j]; acc[0][12 + j] += w0 * z3[j];
                                              acc[1][j] += w1 * z0[j]; acc[1][4 + j] += w1 * z1[j]; acc[1][8 + j] += w1 * z2[j]; acc[1][12 + j] += w1 * z3[j];
                                              acc[2][j] += w2 * z0[j]; acc[2][4 + j] += w2 * z1[j]; acc[2][8 + j] += w2 * z2[j]; acc[2][12 + j] += w2 * z3[j];
                                              acc[3][j] += w3 * z0[j]; acc[3][4 + j] += w3 * z1[j]; acc[3][8 + j] += w3 * z2[j]; acc[3][12 + j] += w3 * z3[j]; }
                w3 = w2; w2 = w1; w1 = w0;
            }
            const float bias = p.hy_bias[o * 512 + ch];
#pragma unroll
            for (int r = 0; r < 4; ++r)
#pragma unroll
                for (int b = 0; b < 16; ++b) acc[r][b] += bias * zs[(t0 + r) * 16 + b];
            __syncthreads();
#pragma unroll
            for (int r = 0; r < 4; ++r)
#pragma unroll
                for (int b4 = 0; b4 < 4; ++b4) *(LAS f32x4*)(zs + (t0 + r) * 16 + 4 * b4) = (f32x4){acc[r][4 * b4], acc[r][4 * b4 + 1], acc[r][4 * b4 + 2], acc[r][4 * b4 + 3]};
#pragma unroll 1
            for (int i = 0; i < 64; ++i) { const int r = i >> 4, b = i & 15, t = t0 + r; const float gate = hy_tap(hy, p.conv_w, p.conv_b, (o + 1) * 512 + ch, b, t);
                const float zn = gate * zs[t * 16 + b];
                if (o == 0) zs[t * 16 + b] = bfround(zn); else zb[((size_t)ch * NB + b) * SEQ + t] = f2bf(zn); }
            __syncthreads();
        }
    }
}


constexpr int ZROW = 2056;
__device__ __forceinline__ void hy_conv4(const bf16_t* src, int t, float w0, float w1, float w2, float cb, float (&o)[4]) {
    float x[6];
#pragma unroll
    for (int i = 0; i < 6; ++i) { const int tt = t - 1 + i; x[i] = (tt >= 0 && tt < SEQ) ? bf2f(src[(size_t)tt * 8]) : 0.f; }
#pragma unroll
    for (int r = 0; r < 4; ++r) o[r] = cb + w0 * x[r] + w1 * x[r + 1] + w2 * x[r + 2];
}
__device__ __forceinline__ void hy_fill(LAS bf16_t* dst, const bf16_t* hy, const float* cw, const float* cbv, int chx, int tid) {
    const float w0 = cw[chx], w1 = cw[NHY + chx], w2 = cw[2 * NHY + chx], cb = cbv[chx];
    for (int b = 0; b < NB; ++b) { const bf16_t* src = hy + (((size_t)(chx >> 3) * NB + b) * SEQ) * 8 + (chx & 7); float o[4];
        hy_conv4(src, 4 * tid, w0, w1, w2, cb, o);
        u32x2 w; w.x = pk2(o[0], o[1]); w.y = pk2(o[2], o[3]); *(LAS u32x2*)(dst + b * ZROW + 4 * tid) = w; }
}
template <int KIND>
__device__ __forceinline__ void hy_block(pg8::f32x4 (&acc)[16], bf16x8 (&Bw)[16], const LAS bf16_t* zl, const LAS bf16_t* krl, int ub, int i0, int lane) {
    const int fr = lane & 15, fq = lane >> 4;
    const LAS bf16_t* bbase = zl + fr * ZROW + 8 * fq;
    const int abase = KR_OFF - 16 * i0 - fr + 8 * fq;
    const unsigned sh = (unsigned)(fr & 1) * 16u;
#pragma unroll
    for (int uu = 0; uu < 16; ++uu) {
        const int u = ub + uu;
        const bool ldb = KIND == 0 ? (uu >= 1) : (KIND == 1 ? true : (uu == 0));
        if (ldb) Bw[(uu + 15) & 15] = *(const LAS bf16x8*)(bbase + 32 * (u + 15));
        const LAS unsigned* ap = (const LAS unsigned*)(krl + ((abase + 32 * u) & ~1));
        const unsigned d0 = ap[0], d1 = ap[1], d2 = ap[2], d3 = ap[3], d4 = ap[4];
        u32x4 aw; aw.x = __builtin_amdgcn_alignbit(d1, d0, sh); aw.y = __builtin_amdgcn_alignbit(d2, d1, sh); aw.z = __builtin_amdgcn_alignbit(d3, d2, sh); aw.w = __builtin_amdgcn_alignbit(d4, d3, sh);
        const bf16x8 A = __builtin_bit_cast(bf16x8, aw);
#pragma unroll
        for (int m = 0; m < 16; ++m) { const bool on = KIND == 0 ? (m >= 16 - uu) : (KIND == 1 ? true : (m <= 15 - uu));
            if (on) acc[m] = __builtin_amdgcn_mfma_f32_16x16x32_bf16(A, Bw[(uu + m) & 15], acc[m], 0, 0, 0); }
    }
}
__device__ __forceinline__ void phase_hyena_mfma(const Params& p, const Ctx& c) {
    unsigned char* ws = p.ws;
    const bf16_t* hy = (const bf16_t*)(ws + WS_HY); const bf16_t* krev = (const bf16_t*)(ws + WS_KREV); bf16_t* zb = (bf16_t*)(ws + WS_ZB);
    LAS bf16_t* zl = (LAS bf16_t*)c.lds;
    LAS bf16_t* gl = zl + NB * ZROW;
    LAS bf16_t* krl = gl + NB * ZROW;
    const int i0 = 32 * (c.wid >> 1) + (c.wid & 1), fr = c.lane & 15, fq = c.lane >> 4;
    for (int ch = blockIdx.x; ch < BW; ch += gridDim.x) {
        __syncthreads();
        hy_fill(zl, hy, p.conv_w, p.conv_b, ch, c.tid);
        for (int o = 0; o < 2; ++o) {
            hy_fill(gl, hy, p.conv_w, p.conv_b, (o + 1) * 512 + ch, c.tid);
            for (int i = c.tid; i < KR_LEN / 8; i += NTHR) *(LAS u32x4*)(krl + 8 * i) = *(const u32x4*)(krev + ((size_t)o * 512 + ch) * KR_LEN + 8 * i);
            __syncthreads();
            pg8::f32x4 acc[16]; bf16x8 Bw[16];
#pragma unroll
            for (int m = 0; m < 16; ++m) { acc[m] = (pg8::f32x4){0.f, 0.f, 0.f, 0.f}; Bw[m] = (bf16x8){0, 0, 0, 0, 0, 0, 0, 0}; }
            hy_block<0>(acc, Bw, zl, krl, -16, i0, c.lane);
            for (int ub = 0; ub < 48; ub += 16) hy_block<1>(acc, Bw, zl, krl, ub, i0, c.lane);
            hy_block<2>(acc, Bw, zl, krl, 48, i0, c.lane);
            const float bias = p.hy_bias[o * 512 + ch];
            u32x2 res[16];
#pragma unroll
            for (int m = 0; m < 16; ++m) { const int t = 16 * (i0 + 2 * m) + 4 * fq; const u32x2 zo = *(const LAS u32x2*)(zl + fr * ZROW + t), gg = *(const LAS u32x2*)(gl + fr * ZROW + t);
                const float z0 = __uint_as_float(zo.x << 16), z1 = __uint_as_float(zo.x & 0xffff0000u), z2 = __uint_as_float(zo.y << 16), z3 = __uint_as_float(zo.y & 0xffff0000u);
                const float g0 = __uint_as_float(gg.x << 16), g1 = __uint_as_float(gg.x & 0xffff0000u), g2 = __uint_as_float(gg.y << 16), g3 = __uint_as_float(gg.y & 0xffff0000u);
                res[m].x = pk2(g0 * (acc[m][0] + bias * z0), g1 * (acc[m][1] + bias * z1)); res[m].y = pk2(g2 * (acc[m][2] + bias * z2), g3 * (acc[m][3] + bias * z3)); }
            __syncthreads();
#pragma unroll
            for (int m = 0; m < 16; ++m) { const int t = 16 * (i0 + 2 * m) + 4 * fq;
                if (o == 0) *(LAS u32x2*)(zl + fr * ZROW + t) = res[m]; else *(u32x2*)(zb + ((size_t)ch * NB + fr) * SEQ + t) = res[m]; }
        }
    }
}

__device__ __forceinline__ void phase_combine(const Params& p, const Ctx& c) {
    unsigned char* ws = p.ws;
    const float* ofw = (const float*)(ws + WS_OFW); const float* obw = (const float*)(ws + WS_OBW); const bf16_t* g = (const bf16_t*)(ws + WS_G);
    bf16_t* oa = (bf16_t*)(ws + WS_OA); bf16_t* ob = (bf16_t*)(ws + WS_OB); const bf16_t* zb = (const bf16_t*)(ws + WS_ZB);
    for (int row = c.gw; row < T; row += c.ngw) { const int col = 8 * c.lane; float a[8], bq[8], gg[8], w[8], o[8];
        load_f32x8(ofw + (size_t)row * 512 + col, a); load_f32x8(obw + (size_t)row * 512 + col, bq); load_bf16x8(g + (size_t)row * 512 + col, gg); load_f32x8(p.a_norm_w + (col & 127), w);
        float s = 0.f;
#pragma unroll
        for (int j = 0; j < 8; ++j) { a[j] += bq[j]; s += a[j] * a[j]; }
        s += __shfl_xor(s, 1); s += __shfl_xor(s, 2); s += __shfl_xor(s, 4); s += __shfl_xor(s, 8);
        const float rs = 1.0f / sqrtf(s * (1.0f / 128.0f) + RMS_EPS);
#pragma unroll
        for (int j = 0; j < 8; ++j) o[j] = a[j] * rs * w[j] * gg[j];
        store_bf16x8(oa + (size_t)row * 512 + col, o); }
    LAS bf16_t* tile = (LAS bf16_t*)c.lds;
    for (int it = blockIdx.x; it < NB * 32 * 8; it += gridDim.x) { const int cb = it & 7, tb = (it >> 3) & 31, b = it >> 8;
        __syncthreads();
        { const int cl = c.tid >> 3, t8 = (c.tid & 7) * 8; const u32x4 w = *(const u32x4*)(zb + ((size_t)(cb * 64 + cl) * NB + b) * SEQ + tb * 64 + t8); *(LAS u32x4*)(tile + cl * 72 + t8) = w; }
        __syncthreads();
        { const int tl = c.tid >> 3, c8 = (c.tid & 7) * 8; bf16_t v[8];
#pragma unroll
          for (int i = 0; i < 8; ++i) v[i] = tile[(c8 + i) * 72 + tl];
          u32x4 w; w.x = v[0] | ((unsigned)v[1] << 16); w.y = v[2] | ((unsigned)v[3] << 16); w.z = v[4] | ((unsigned)v[5] << 16); w.w = v[6] | ((unsigned)v[7] << 16);
          *(u32x4*)(ob + ((size_t)b * SEQ + tb * 64 + tl) * 512 + cb * 64 + c8) = w; }
    }
}

__device__ __forceinline__ void phase_final(const Params& p, const Ctx& c) {
    const float* ssq = (const float*)(p.ws + WS_SSQ3);
    for (int row = c.gw; row < T; row += c.ngw) { const float rs = rstd_from_ssq(ssq + (size_t)row * 16);
#pragma unroll
        for (int j = 0; j < 4; ++j) { const int col = 4 * c.lane + 256 * j; f32x4* ptr = (f32x4*)(p.out + (size_t)row * D + col); *ptr = *ptr * rs * *(const f32x4*)(p.fnw + col); } }
}

constexpr int N_PHASES = 13;
__global__ void __launch_bounds__(NTHR, 2) fwd_kernel(Params p) {
    extern __shared__ __attribute__((aligned(16))) unsigned char lds_raw[];
    Ctx c; c.lds = (LAS unsigned char*)lds_raw; c.tid = threadIdx.x; c.lane = c.tid & 63; c.wid = __builtin_amdgcn_readfirstlane(c.tid >> 6);
    c.gw = blockIdx.x * NWAVES + c.wid; c.ngw = gridDim.x * NWAVES;
    unsigned char* ws = p.ws;
    const float* modv = (const float*)(ws + WS_MODV);
#if N_LAUNCH_MODE == 1
    cg::grid_group grid = cg::this_grid();
#define SEAM() grid.sync()
#else
#define SEAM() do { } while (0)
#endif
#ifdef ONLY_PHASE
#define IN(k) ((k) == ONLY_PHASE && p.ph_lo <= (k) && (k) < p.ph_hi)
#else
#define IN(k) (p.ph_lo <= (k) && (k) < p.ph_hi)
#endif
#if USE_PG8
#define GEMM2(A_, Bt_, K_, nrows1_, npn1_, nrows2_, npn2_, E_, ssq_) gemm_mfma(c.lds, A_, Bt_, K_, nrows1_, npn1_, nrows2_, npn2_, E_, ssq_)
#else
#define GEMM2(A_, Bt_, K_, nrows1_, npn1_, nrows2_, npn2_, E_, ssq_) do { gemm_simple(c.lds, A_, Bt_, K_, 0, nrows1_, npn1_, E_, ssq_); if ((nrows2_) > 0) gemm_simple(c.lds, A_, Bt_, K_, nrows1_, nrows2_, npn2_, E_, ssq_); } while (0)
#endif
#define GEMM(A_, Bt_, K_, row0_, nrows_, npn_, E_, ssq_) GEMM2(A_, Bt_, K_, nrows_, npn_, 0, 0, E_, ssq_)
    if (IN(0)) { phase_prep(p, c); if (IN(1)) SEAM(); }
    if (IN(1)) { phase_n1(p, c); if (IN(2)) SEAM(); }
    if (IN(2)) { EpiGateUp1 E{(bf16_t*)(ws + WS_HID)};
        GEMM((const bf16_t*)(ws + WS_N1), (const bf16_t*)(ws + WS_WG1_T), D, 0, MT, NGU / 256, E, nullptr); if (IN(3)) SEAM(); }
    if (IN(3)) { EpiDown1 E{p.x, p.ctx, (const float*)(ws + WS_ER), (const float*)(ws + WS_EC), modv, p.out, (bf16_t*)(ws + WS_A2)};
        GEMM((const bf16_t*)(ws + WS_HID), (const bf16_t*)(ws + WS_WD1_T), DFF, 0, MT, D / 256, E, (float*)(ws + WS_SSQ1)); if (IN(4)) SEAM(); }
    if (IN(4)) { EpiWin E{(const float*)(ws + WS_SSQ1), (const float*)(ws + WS_SWIN), (const float*)(ws + WS_LBV), (bf16_t*)(ws + WS_V), (bf16_t*)(ws + WS_Q), (bf16_t*)(ws + WS_G), (bf16_t*)(ws + WS_HY), (bf16_t*)(ws + WS_GAB), (f16_t*)(ws + WS_LFW), (f16_t*)(ws + WS_LBW)};
        GEMM2((const bf16_t*)(ws + WS_A2), (const bf16_t*)(ws + WS_WIN_T), D, T, NIN / 256, TC, 6, E, nullptr); if (IN(5)) SEAM(); }
    if (IN(5)) {
        { LAS float* scr = (LAS float*)(c.lds + c.wid * 8448);
          transpose_gu(p.ffn_wg + (size_t)D * DFF, 0, (bf16_t*)(ws + WS_WG2_T), scr, c.gw, c.ngw, c.lane);
          transpose_gu(p.ffn_wu + (size_t)D * DFF, 1, (bf16_t*)(ws + WS_WG2_T), scr, c.gw, c.ngw, c.lane);
          transpose_matrix(p.ffn_wd + (size_t)DFF * D, DFF, D, (bf16_t*)(ws + WS_WD2_T), scr, c.gw, c.ngw, c.lane); }
#if USE_MFMA_HYENA
        phase_hyena_mfma(p, c);
#else
        phase_hyena_simple(p, c);
#endif
        if (IN(6)) SEAM(); }
    if (IN(6)) {
#if USE_MFMA_HGRN
        phase_hgrn_mfma(p, c);
#else
        phase_hgrn_simple(p, c);
#endif
        if (IN(7)) SEAM(); }
    if (IN(7)) { phase_combine(p, c); if (IN(8)) SEAM(); }
    if (IN(8)) { EpiProjA EA{(const bf16_t*)(ws + WS_GAB), (float*)(ws + WS_YTMP)}; EpiProjB EB{(const bf16_t*)(ws + WS_GAB), (const float*)(ws + WS_YTMP), (bf16_t*)(ws + WS_Y)};
        GEMM((const bf16_t*)(ws + WS_OA), (const bf16_t*)(ws + WS_WPA_T), 512, 0, T, D / 256, EA, nullptr);
        GEMM((const bf16_t*)(ws + WS_OB), (const bf16_t*)(ws + WS_WPB_T), 512, 0, T, D / 256, EB, nullptr); if (IN(9)) SEAM(); }
    if (IN(9)) { EpiWout E{modv, p.out, (bf16_t*)(ws + WS_A3)};
        GEMM((const bf16_t*)(ws + WS_Y), (const bf16_t*)(ws + WS_WOUT_T), D, 0, T, D / 256, E, (float*)(ws + WS_SSQ2)); if (IN(10)) SEAM(); }
    if (IN(10)) { EpiGateUp2 E{(bf16_t*)(ws + WS_HID2), (const float*)(ws + WS_SSQ2), (const float*)(ws + WS_SW2)};
        GEMM((const bf16_t*)(ws + WS_A3), (const bf16_t*)(ws + WS_WG2_T), D, 0, T, NGU / 256, E, nullptr); if (IN(11)) SEAM(); }
    if (IN(11)) { EpiDown2 E{modv, p.out};
        GEMM((const bf16_t*)(ws + WS_HID2), (const bf16_t*)(ws + WS_WD2_T), DFF, 0, T, D / 256, E, (float*)(ws + WS_SSQ3)); if (IN(12)) SEAM(); }
    if (IN(12)) { phase_final(p, c); }
}

extern "C" void kernel_launch(void* const* d_in, const int* in_sizes, int n_in, void* d_out, int out_size, void* d_ws, size_t ws_size, hipStream_t stream) {
    static int grid = 0;
    if (grid == 0) {
        if (n_in != 26 || in_sizes[0] != T * D || out_size != T * D || ws_size < WS_TOTAL) { fprintf(stderr, "kernel_launch: unexpected shapes (n_in %d, in0 %d, out %d, ws %zu < %zu)\n", n_in, n_in > 0 ? in_sizes[0] : -1, out_size, ws_size, (size_t)WS_TOTAL); grid = -1; return; }
        int dev = 0, cus = 0, per_cu = 0;
        (void)hipGetDevice(&dev); (void)hipDeviceGetAttribute(&cus, hipDeviceAttributeMultiprocessorCount, dev);
        if (hipFuncSetAttribute((const void*)fwd_kernel, hipFuncAttributeMaxDynamicSharedMemorySize, LDS_BYTES) != hipSuccess) { fprintf(stderr, "kernel_launch: hipFuncSetAttribute failed\n"); grid = -1; return; }
        (void)hipOccupancyMaxActiveBlocksPerMultiprocessor(&per_cu, (const void*)fwd_kernel, NTHR, LDS_BYTES);
        if (per_cu < 1) { fprintf(stderr, "kernel_launch: occupancy query says %d blocks per CU\n", per_cu); per_cu = 1; }
        (void)hipGetLastError();
        grid = cus;
    }
    if (grid < 0) return;
    Params p{};
    const float** f = (const float**)&p;
    for (int i = 0; i < 26; ++i) f[i] = (const float*)d_in[i];
    p.out = (float*)d_out; p.ws = (unsigned char*)d_ws;
#if N_LAUNCH_MODE == 1
    p.ph_lo = 0; p.ph_hi = N_PHASES;
    void* args[] = {&p};
    hipError_t e = hipLaunchCooperativeKernel((const void*)fwd_kernel, dim3(grid), dim3(NTHR), args, LDS_BYTES, stream);
    if (e != hipSuccess) fprintf(stderr, "cooperative launch failed: %s (grid %d)\n", hipGetErrorString(e), grid);
#else
    for (int k = 0; k < N_PHASES; ++k) { p.ph_lo = k; p.ph_hi = k + 1; hipLaunchKernelGGL(fwd_kernel, dim3(grid), dim3(NTHR), LDS_BYTES, stream, p); }
#endif
}
```

```cpp
#include <hip/hip_runtime.h>
#include <hip/hip_cooperative_groups.h>
#include <cstdio>
namespace cg = cooperative_groups;

#ifndef N_LAUNCH_MODE
#define N_LAUNCH_MODE 1
#endif
#ifndef USE_MFMA_HYENA
#define USE_MFMA_HYENA 1
#endif
#ifndef USE_MFMA_HGRN
#define USE_MFMA_HGRN 1
#endif
#ifndef USE_PG8
#define USE_PG8 1
#endif

#define LAS __attribute__((address_space(3)))
typedef unsigned short bf16_t;
typedef _Float16 f16_t;
typedef float f32x4 __attribute__((ext_vector_type(4)));
typedef unsigned u32x4 __attribute__((ext_vector_type(4)));
typedef unsigned u32x2 __attribute__((ext_vector_type(2)));

constexpr int D = 1024, NB = 16, SEQ = 2048, T = NB * SEQ, CL = 256, TC = NB * CL, MT = T + TC;
constexpr int DFF = 2816, NGU = 2 * DFF, NIN = 6144, MODW = 9 * D;
constexpr int AKW = 512, AVW = 512, BW = 512, NHY = 3 * BW;
constexpr int KR_LEN = 4128, KR_OFF = 2056;
constexpr float RMS_EPS = 1e-6f;
constexpr int NTHR = 512, NWAVES = 8;
constexpr int LDS_BYTES = 152 * 1024;

constexpr size_t MiB = 1024 * 1024;
constexpr size_t al256(size_t x) { return (x + 255) & ~(size_t)255; }
constexpr size_t WS_CTL = 0;
constexpr size_t WS_MODV = WS_CTL + 65536;
constexpr size_t WS_SWIN = WS_MODV + al256((size_t)17 * MODW * 4);
constexpr size_t WS_SW2 = WS_SWIN + al256((size_t)17 * NIN * 4);
constexpr size_t WS_ER = WS_SW2 + al256((size_t)17 * NGU * 4);
constexpr size_t WS_EC = WS_ER + 32 * 512 * 4;
constexpr size_t WS_LBV = WS_EC + 64 * 512 * 4;
constexpr size_t WS_H2 = WS_LBV + 4096;
constexpr size_t WS_KREV = WS_H2 + 2048 * 64 * 4;
constexpr size_t WS_WIN_T = WS_KREV + al256((size_t)2 * 512 * KR_LEN * 2);
constexpr size_t WS_WPA_T = WS_WIN_T + (size_t)NIN * D * 2;
constexpr size_t WS_WPB_T = WS_WPA_T + (size_t)D * 512 * 2;
constexpr size_t WS_WOUT_T = WS_WPB_T + (size_t)D * 512 * 2;
constexpr size_t WS_PERSIST_END = WS_WOUT_T + (size_t)D * D * 2;
constexpr size_t AR = 27 * MiB;
static_assert(WS_PERSIST_END <= AR, "persistent region");
constexpr size_t WS_HID = AR + 0 * MiB;
constexpr size_t WS_N1 = AR + 198 * MiB;
constexpr size_t WS_WG1_T = AR + 270 * MiB;
constexpr size_t WS_WD1_T = AR + 281 * MiB;
constexpr size_t WS_SSQ1 = AR + 410 * MiB;
constexpr size_t WS_A2 = AR + 413 * MiB;
constexpr size_t WS_GAB = AR + 0 * MiB;
constexpr size_t WS_V = AR + 128 * MiB;
constexpr size_t WS_LFW = AR + 164 * MiB;
constexpr size_t WS_LBW = AR + 200 * MiB;
constexpr size_t WS_Q = AR + 236 * MiB;
constexpr size_t WS_G = AR + 268 * MiB;
constexpr size_t WS_HY = AR + 300 * MiB;
constexpr size_t WS_WG2_T = AR + 436 * MiB;
constexpr size_t WS_WD2_T = AR + 447 * MiB;
constexpr size_t WS_ZB = AR + 453 * MiB;
constexpr size_t WS_OFW = AR + 300 * MiB;
constexpr size_t WS_OBW = AR + 364 * MiB;
constexpr size_t WS_OA = AR + 128 * MiB;
constexpr size_t WS_OB = AR + 160 * MiB;
constexpr size_t WS_YTMP = AR + 192 * MiB;
constexpr size_t WS_Y = AR + 320 * MiB;
constexpr size_t WS_A3 = AR + 0 * MiB;
constexpr size_t WS_SSQ2 = AR + 64 * MiB;
constexpr size_t WS_SSQ3 = AR + 66 * MiB;
constexpr size_t WS_HID2 = AR + 128 * MiB;
constexpr size_t WS_TOTAL = AR + 485 * MiB;

struct Params {
    const float *x, *c, *ctx, *c_ctx, *mod_w, *mod_b, *ffn_wg, *ffn_wu, *ffn_wd, *w_in, *lb_logits, *a_norm_w, *conv_w, *conv_b;
    const float *hw1, *hb1, *hfr1, *hw2, *hb2, *hfr2, *hw3, *hy_bias, *w_pa, *w_pb, *w_out, *fnw;
    float* out; unsigned char* ws;
    int ph_lo, ph_hi;
};

__device__ __forceinline__ float bf2f(bf16_t b) { return __uint_as_float(((unsigned)b) << 16); }
__device__ __forceinline__ bf16_t f2bf(float f) { unsigned u = __float_as_uint(f); u += 0x7FFFu + ((u >> 16) & 1u); return (bf16_t)(u >> 16); }
__device__ __forceinline__ unsigned pk2(float lo, float hi) { return (unsigned)f2bf(lo) | ((unsigned)f2bf(hi) << 16); }
__device__ __forceinline__ float bfround(float f) { return bf2f(f2bf(f)); }
__device__ __forceinline__ float sigmoidf_(float x) { return 1.0f / (1.0f + __expf(-x)); }
__device__ __forceinline__ float siluf_(float x) { return x / (1.0f + __expf(-x)); }
__device__ __forceinline__ float wave_sum(float v) {
#pragma unroll
    for (int o = 1; o < 64; o <<= 1) v += __shfl_xor(v, o);
    return v;
}
__device__ __forceinline__ float pos_embed(const float* er, const float* ec, int t, int col) {
    return col < 512 ? er[(t >> 6) * 512 + col] : ec[(t & 63) * 512 + (col - 512)];
}
__device__ __forceinline__ float rstd_from_ssq(const float* ssq16) {
    const f32x4* s = (const f32x4*)ssq16; float tot = 0.f;
#pragma unroll
    for (int i = 0; i < 4; ++i) { const f32x4 v = s[i]; tot += (v[0] + v[1]) + (v[2] + v[3]); }
    return 1.0f / sqrtf(tot * (1.0f / D) + RMS_EPS);
}

__device__ __forceinline__ void transpose_item(const float* W, int K, int N, bf16_t* WT, int k0, int n0, int dst_row0, LAS float* scr, int lane) {
#pragma unroll 8
    for (int i = 0; i < 32; ++i) { const int kk = 2 * i + (lane >> 5); scr[kk * 33 + (lane & 31)] = W[(size_t)(k0 + kk) * N + n0 + (lane & 31)]; }
    asm volatile("s_waitcnt lgkmcnt(0)" ::: "memory");
    const int c = lane & 7;
#pragma unroll
    for (int j = 0; j < 4; ++j) { const int n = (lane >> 3) + 8 * j; const LAS float* s = scr + (8 * c) * 33 + n;
        u32x4 o; o.x = pk2(s[0 * 33], s[1 * 33]); o.y = pk2(s[2 * 33], s[3 * 33]); o.z = pk2(s[4 * 33], s[5 * 33]); o.w = pk2(s[6 * 33], s[7 * 33]);
        *(u32x4*)(WT + (size_t)(dst_row0 + n) * K + k0 + 8 * c) = o; }
    asm volatile("s_waitcnt lgkmcnt(0)" ::: "memory");
}
__device__ __forceinline__ void transpose_matrix(const float* W, int K, int N, bf16_t* WT, LAS float* scr, int gw, int ngw, int lane) {
    const int nblk = N / 32, items = (K / 64) * nblk;
    for (int it = gw; it < items; it += ngw) { const int kb = it / nblk, nb = it % nblk; transpose_item(W, K, N, WT, 64 * kb, 32 * nb, 32 * nb, scr, lane); }
}
__device__ __forceinline__ void transpose_gu(const float* W, int half, bf16_t* WT, LAS float* scr, int gw, int ngw, int lane) {
    const int nblk = DFF / 32, items = (D / 64) * nblk;
    for (int it = gw; it < items; it += ngw) { const int kb = it / nblk, nb = it % nblk, n0 = 32 * nb;
        transpose_item(W, D, DFF, WT, 64 * kb, n0, 256 * (n0 >> 7) + 128 * half + (n0 & 127), scr, lane); }
}

template <bool GU>
__device__ __forceinline__ void gemv17(const LAS float* xs, LAS float* part, const float* W, int N, const float* bias, float* out, int ldo, int half, int blk0, int nblk_stride) {
    const int tid = threadIdx.x, wid = tid >> 6, lane = tid & 63;
    for (int cb = blk0; cb < N / 64; cb += nblk_stride) {
        const int n = cb * 64 + lane;
        float acc[17];
#pragma unroll
        for (int r = 0; r < 17; ++r) acc[r] = 0.f;
        const float* wp = W + (size_t)(wid * 128) * N + n;
#pragma unroll 4
        for (int k = 0; k < 128; ++k) { const float w = wp[(size_t)k * N];
#pragma unroll
            for (int r = 0; r < 17; ++r) acc[r] += xs[r * 1024 + wid * 128 + k] * w; }
#pragma unroll
        for (int r = 0; r < 17; ++r) part[(wid * 17 + r) * 64 + lane] = acc[r];
        __syncthreads();
        for (int o = tid; o < 17 * 64; o += NTHR) { const int r = o >> 6, l = o & 63; float s = 0.f;
#pragma unroll
            for (int w = 0; w < 8; ++w) s += part[(w * 17 + r) * 64 + l];
            const int nn = cb * 64 + l; if (bias) s += bias[nn];
            const int on = GU ? (256 * (nn >> 7) + 128 * half + (nn & 127)) : nn;
            out[(size_t)r * ldo + on] = s; }
        __syncthreads();
    }
}

__device__ __forceinline__ void store_bf16x8(bf16_t* p, const float (&v)[8]) { u32x4 w; w.x = pk2(v[0], v[1]); w.y = pk2(v[2], v[3]); w.z = pk2(v[4], v[5]); w.w = pk2(v[6], v[7]); *(u32x4*)p = w; }
__device__ __forceinline__ void load_f32x8(const float* p, float (&v)[8]) { const f32x4 a = *(const f32x4*)p, b = *(const f32x4*)(p + 4); v[0] = a[0]; v[1] = a[1]; v[2] = a[2]; v[3] = a[3]; v[4] = b[0]; v[5] = b[1]; v[6] = b[2]; v[7] = b[3]; }
__device__ __forceinline__ void store_f32x8(float* p, const float (&v)[8]) { *(f32x4*)p = (f32x4){v[0], v[1], v[2], v[3]}; *(f32x4*)(p + 4) = (f32x4){v[4], v[5], v[6], v[7]}; }
__device__ __forceinline__ void load_bf16x8(const bf16_t* p, float (&v)[8]) { const u32x4 w = *(const u32x4*)p; v[0] = __uint_as_float(w.x << 16); v[1] = __uint_as_float(w.x & 0xffff0000u); v[2] = __uint_as_float(w.y << 16); v[3] = __uint_as_float(w.y & 0xffff0000u);
    v[4] = __uint_as_float(w.z << 16); v[5] = __uint_as_float(w.z & 0xffff0000u); v[6] = __uint_as_float(w.w << 16); v[7] = __uint_as_float(w.w & 0xffff0000u); }

struct EpiGateUp1 {
    bf16_t* hid;
    __device__ __forceinline__ float apply(int row, int pn, int c, const float (&v0)[8], const float (&v1)[8]) const {
        float o[8];
#pragma unroll
        for (int j = 0; j < 8; ++j) o[j] = siluf_(v0[j]) * v1[j];
        store_bf16x8(hid + (size_t)row * DFF + 128 * pn + c, o); return 0.f; }
};
struct EpiGateUp2 {
    bf16_t* hid; const float* ssq; const float* sw;
    __device__ __forceinline__ float apply(int row, int pn, int c, const float (&v0)[8], const float (&v1)[8]) const {
        const float rs = rstd_from_ssq(ssq + (size_t)row * 16); const int b = row >> 11;
        float s0[8], s1[8], o[8]; load_f32x8(sw + (size_t)b * NGU + 256 * pn + c, s0); load_f32x8(sw + (size_t)b * NGU + 256 * pn + 128 + c, s1);
#pragma unroll
        for (int j = 0; j < 8; ++j) o[j] = siluf_(rs * v0[j] + s0[j]) * (rs * v1[j] + s1[j]);
        store_bf16x8(hid + (size_t)row * DFF + 128 * pn + c, o); return 0.f; }
};
struct EpiDown1 {
    const float *x, *ctx, *er, *ec, *modv; float* hout; bf16_t* a2;
    __device__ __forceinline__ float half_(int row, int col, const float (&v)[8]) const {
        const bool lat = row < T; const int b = lat ? (row >> 11) : 16, t = row & (SEQ - 1);
        float base[8], m2[8], m4[8], h[8], a[8];
        if (lat) { load_f32x8(x + (size_t)row * D + col, base);
#pragma unroll
            for (int j = 0; j < 8; ++j) base[j] += pos_embed(er, ec, t, col + j); }
        else load_f32x8(ctx + (size_t)(row - T) * D + col, base);
        load_f32x8(modv + (size_t)b * MODW + 2 * D + col, m2); load_f32x8(modv + (size_t)b * MODW + 4 * D + col, m4);
        float s = 0.f;
#pragma unroll
        for (int j = 0; j < 8; ++j) { h[j] = base[j] + 0.5f * m2[j] * v[j]; s += h[j] * h[j]; a[j] = h[j] * (1.0f + m4[j]); }
        if (lat) store_f32x8(hout + (size_t)row * D + col, h);
        store_bf16x8(a2 + (size_t)row * D + col, a); return s; }
    __device__ __forceinline__ float apply(int row, int pn, int c, const float (&v0)[8], const float (&v1)[8]) const { return half_(row, 256 * pn + c, v0) + half_(row, 256 * pn + 128 + c, v1); }
};
struct EpiWin {
    const float *ssq, *sw, *lbv; bf16_t *v, *q, *g, *hy, *gab; f16_t *lfw, *lbw;
    __device__ __forceinline__ void half_(int row, int n, float rs, int b, const float (&a)[8]) const {
        float s[8], p[8]; load_f32x8(sw + (size_t)b * NIN + n, s);
#pragma unroll
        for (int j = 0; j < 8; ++j) p[j] = rs * a[j] + s[j];
        const int grp = n >> 9;
        if (grp == 0) { store_bf16x8(v + (size_t)row * 512 + n, p); }
        else if (grp <= 2) { const int nn = n - 512 * grp; f16_t* dst = (grp == 1 ? lfw : lbw) + (size_t)row * 512 + nn; f16_t o[8];
#pragma unroll
            for (int j = 0; j < 8; ++j) { const float lb = lbv[(grp - 1) * 512 + nn + j]; const float f = lb + (1.0f - lb) * sigmoidf_(p[j]); o[j] = (f16_t)__logf(f); }
            *(u32x4*)dst = *(const u32x4*)o; }
        else if (grp == 3) {
#pragma unroll
            for (int j = 0; j < 8; ++j) p[j] = siluf_(p[j]);
            store_bf16x8(q + (size_t)row * 512 + (n - 1536), p); }
        else if (grp == 4) {
#pragma unroll
            for (int j = 0; j < 8; ++j) p[j] = siluf_(p[j]);
            store_bf16x8(g + (size_t)row * 512 + (n - 2048), p); }
        else if (grp <= 7) { const int ch = n - 2560, t = row & (SEQ - 1); store_bf16x8(hy + (((size_t)(ch >> 3) * NB + b) * SEQ + t) * 8, p); }
        else {
#pragma unroll
            for (int j = 0; j < 8; ++j) p[j] = sigmoidf_(p[j]);
            store_bf16x8(gab + (size_t)row * 2048 + (n - 4096), p); }
    }
    __device__ __forceinline__ float apply(int row, int pn, int c, const float (&v0)[8], const float (&v1)[8]) const {
        const float rs = rstd_from_ssq(ssq + (size_t)row * 16); const int b = row < T ? (row >> 11) : 16;
        half_(row, 256 * pn + c, rs, b, v0); half_(row, 256 * pn + 128 + c, rs, b, v1); return 0.f; }
};
struct EpiProjA {
    const bf16_t* gab; float* ytmp;
    __device__ __forceinline__ void half_(int row, int col, const float (&a)[8]) const { float gt[8], o[8]; load_bf16x8(gab + (size_t)row * 2048 + col, gt);
#pragma unroll
        for (int j = 0; j < 8; ++j) o[j] = gt[j] * a[j];
        store_f32x8(ytmp + (size_t)row * D + col, o); }
    __device__ __forceinline__ float apply(int row, int pn, int c, const float (&v0)[8], const float (&v1)[8]) const { half_(row, 256 * pn + c, v0); half_(row, 256 * pn + 128 + c, v1); return 0.f; }
};
struct EpiProjB {
    const bf16_t* gab; const float* ytmp; bf16_t* y;
    __device__ __forceinline__ void half_(int row, int col, const float (&a)[8]) const { float gt[8], yt[8], o[8]; load_bf16x8(gab + (size_t)row * 2048 + 1024 + col, gt); load_f32x8(ytmp + (size_t)row * D + col, yt);
#pragma unroll
        for (int j = 0; j < 8; ++j) o[j] = yt[j] + gt[j] * a[j];
        store_bf16x8(y + (size_t)row * D + col, o); }
    __device__ __forceinline__ float apply(int row, int pn, int c, const float (&v0)[8], const float (&v1)[8]) const { half_(row, 256 * pn + c, v0); half_(row, 256 * pn + 128 + c, v1); return 0.f; }
};
struct EpiWout {
    const float* modv; float* h; bf16_t* a3;
    __device__ __forceinline__ float half_(int row, int col, const float (&v)[8]) const {
        const int b = row >> 11; float base[8], m5[8], m7[8], a[8];
        load_f32x8(h + (size_t)row * D + col, base); load_f32x8(modv + (size_t)b * MODW + 5 * D + col, m5); load_f32x8(modv + (size_t)b * MODW + 7 * D + col, m7);
        float s = 0.f;
#pragma unroll
        for (int j = 0; j < 8; ++j) { base[j] += m5[j] * v[j]; s += base[j] * base[j]; a[j] = base[j] * (1.0f + m7[j]); }
        store_f32x8(h + (size_t)row * D + col, base); store_bf16x8(a3 + (size_t)row * D + col, a); return s; }
    __device__ __forceinline__ float apply(int row, int pn, int c, const float (&v0)[8], const float (&v1)[8]) const { return half_(row, 256 * pn + c, v0) + half_(row, 256 * pn + 128 + c, v1); }
};
struct EpiDown2 {
    const float* modv; float* h;
    __device__ __forceinline__ float half_(int row, int col, const float (&v)[8]) const {
        const int b = row >> 11; float base[8], m8[8];
        load_f32x8(h + (size_t)row * D + col, base); load_f32x8(modv + (size_t)b * MODW + 8 * D + col, m8);
        float s = 0.f;
#pragma unroll
        for (int j = 0; j < 8; ++j) { base[j] += 0.5f * m8[j] * v[j]; s += base[j] * base[j]; }
        store_f32x8(h + (size_t)row * D + col, base); return s; }
    __device__ __forceinline__ float apply(int row, int pn, int c, const float (&v0)[8], const float (&v1)[8]) const { return half_(row, 256 * pn + c, v0) + half_(row, 256 * pn + 128 + c, v1); }
};

template <class Epi>
__device__ __forceinline__ void gemm_simple(LAS unsigned char* lds, const bf16_t* A, const bf16_t* Bt, int K, int row0, int nrows, int npn, const Epi& E, float* ssq) {
    LAS float* As = (LAS float*)lds;
    LAS float* Bs = (LAS float*)(lds + 8192);
    const int tid = threadIdx.x, c8 = tid & 15, rg = tid >> 4;
    const int nrt = nrows / 64, nunits = nrt * npn;
    for (int unit = blockIdx.x; unit < nunits; unit += gridDim.x) {
        const int rt = unit / npn, pn = unit % npn, r0 = row0 + rt * 64;
        float a0[2][8], a1[2][8];
#pragma unroll
        for (int r = 0; r < 2; ++r)
#pragma unroll
            for (int j = 0; j < 8; ++j) { a0[r][j] = 0.f; a1[r][j] = 0.f; }
        for (int k0 = 0; k0 < K; k0 += 32) {
            { const int row = tid >> 3, kq = tid & 7; const u32x2 w = *(const u32x2*)(A + (size_t)(r0 + row) * K + k0 + 4 * kq);
              As[(4 * kq + 0) * 64 + row] = __uint_as_float(w.x << 16); As[(4 * kq + 1) * 64 + row] = __uint_as_float(w.x & 0xffff0000u);
              As[(4 * kq + 2) * 64 + row] = __uint_as_float(w.y << 16); As[(4 * kq + 3) * 64 + row] = __uint_as_float(w.y & 0xffff0000u); }
            { const int n = tid >> 1, kh = tid & 1; const bf16_t* src = Bt + (size_t)(pn * 256 + n) * K + k0 + 16 * kh; float t8[8];
              load_bf16x8(src, t8);
#pragma unroll
              for (int i = 0; i < 8; ++i) Bs[(16 * kh + i) * 256 + n] = t8[i];
              load_bf16x8(src + 8, t8);
#pragma unroll
              for (int i = 0; i < 8; ++i) Bs[(16 * kh + 8 + i) * 256 + n] = t8[i]; }
            __syncthreads();
#pragma unroll 8
            for (int k = 0; k < 32; ++k) {
                const float x0 = As[k * 64 + 2 * rg], x1 = As[k * 64 + 2 * rg + 1];
                const f32x4 b00 = *(const LAS f32x4*)(Bs + k * 256 + 8 * c8), b01 = *(const LAS f32x4*)(Bs + k * 256 + 8 * c8 + 4);
                const f32x4 b10 = *(const LAS f32x4*)(Bs + k * 256 + 128 + 8 * c8), b11 = *(const LAS f32x4*)(Bs + k * 256 + 128 + 8 * c8 + 4);
#pragma unroll
                for (int j = 0; j < 4; ++j) { a0[0][j] += x0 * b00[j]; a0[0][4 + j] += x0 * b01[j]; a1[0][j] += x0 * b10[j]; a1[0][4 + j] += x0 * b11[j];
                                              a0[1][j] += x1 * b00[j]; a0[1][4 + j] += x1 * b01[j]; a1[1][j] += x1 * b10[j]; a1[1][4 + j] += x1 * b11[j]; }
            }
            __syncthreads();
        }
#pragma unroll
        for (int r = 0; r < 2; ++r) { const int row = r0 + 2 * rg + r; float s = E.apply(row, pn, 8 * c8, a0[r], a1[r]);
            s += __shfl_xor(s, 1); s += __shfl_xor(s, 2); s += __shfl_xor(s, 4); s += __shfl_xor(s, 8);
            if (ssq && c8 == 0) *(f32x4*)(ssq + (size_t)row * 16 + pn * 4) = (f32x4){s, 0.f, 0.f, 0.f}; }
    }
}

namespace pg8 {
#define PG8_LAS __attribute__((address_space(3)))
typedef unsigned short bf16_t;
typedef short bf16x8 __attribute__((ext_vector_type(8)));
typedef float f32x4 __attribute__((ext_vector_type(4)));
typedef unsigned u32x4 __attribute__((ext_vector_type(4)));
constexpr int BM = 256, BK = 64, HALF = 128, HTB = HALF * BK * 2  , STAGE_BYTES = 8 * HTB, NXCD = 8, WGM = 8;

__host__ __device__ __forceinline__ int lds_byte(int r, int c) { const int st = (r >> 4) * 2 + (c >> 5), rr = r & 15, cc = c & 31, ob = rr * 64 + cc * 2; return st * 1024 + (ob ^ (((ob >> 9) & 1) << 5)); }
__host__ __device__ __forceinline__ void stage_rc(int b, int& R, int& C) { const int st = b / 1024, sb = b % 1024, swz = sb ^ (((sb >> 9) & 1) << 5); R = (st >> 1) * 16 + swz / 64; C = (st & 1) * 32 + (swz % 64) / 2; }
__host__ __device__ __forceinline__ int perm32(int rho) { const int n = rho >> 4, i = rho & 15; return 8 * (i >> 2) + 4 * n + (i & 3); }

struct Unit { int pm, pn; };
struct Gemm { const bf16_t* A; const bf16_t* Bt; int M, N, K; };

struct StaticOrder {
    int nM, nN, nwg, G, c;
    __host__ __device__ void init(int M, int N, int G_, int c_) { nM = M / BM; nN = N / BM; nwg = nM * nN; G = G_; c = c_; }
    __host__ __device__ bool next(int i, Unit& u) const {
        const long L = (long)i * G + c; if (L >= nwg) return false;
        int wgid = (int)L; { const int q = nwg / NXCD, r = nwg % NXCD, xcd = wgid % NXCD, off = wgid / NXCD; wgid = (xcd < r ? xcd * (q + 1) : r * (q + 1) + (xcd - r) * q) + off; }
        const int nig = WGM * nN, gid = wgid / nig, fm = gid * WGM, gsz = (nM - fm) < WGM ? (nM - fm) : WGM;
        u.pm = fm + ((wgid % nig) % gsz); u.pn = (wgid % nig) / gsz; return true;
    }
    __device__ __forceinline__ void a_ready(const Unit&) const {}
    __device__ __forceinline__ void done(const Unit&) const {}
};
template <class Epi, class Sched>
__device__ __forceinline__ void gemm_phase(PG8_LAS unsigned char* lds, const Gemm g, const Sched& S, const Epi& E) {
    const int tid = threadIdx.x, wid = __builtin_amdgcn_readfirstlane(tid >> 6), lane = tid & 63, wr = wid >> 2, wc = wid & 3, fr = lane & 15, fq = lane >> 4;
    const int K = g.K, nt = K / BK;
    unsigned voffA[2], voffB[2];
#pragma unroll
    for (int i = 0; i < 2; ++i) { int R, C; stage_rc(tid * 16 + i * 8192, R, C); const int Rb = Epi::PERM ? ((R & ~31) + perm32(R & 31)) : R;
        voffA[i] = (unsigned)(R * K + C) * 2u; voffB[i] = (unsigned)(Rb * K + C) * 2u; }
    const size_t kstep = (size_t)(BK * 2);
    const size_t hstep = (size_t)HALF * K * 2;
    const size_t tstep = 2 * hstep;
    const unsigned ldsw = (unsigned)wid * 1024u;
    const int aoff = lds_byte(wr * 64 + fr, fq * 8), boff = lds_byte(wc * 32 + fr, fq * 8);
#define PG8_SA(b, h) (((b) * 2 + (h)) * HTB)
#define PG8_SB(b, h) ((4 + (b) * 2 + (h)) * HTB)
#define PG8_STAGE(bufoff, gbase, voff) do { _Pragma("unroll") for (int _i = 0; _i < 2; ++_i) \
        __builtin_amdgcn_global_load_lds((const unsigned*)((const char*)(gbase) + (voff)[_i]), (PG8_LAS unsigned*)(lds + (bufoff) + ldsw + _i * 8192), 16, 0, 0); } while (0)
#define PG8_LDA(dst, b, h) do { _Pragma("unroll") for (int m = 0; m < 4; ++m) _Pragma("unroll") for (int k = 0; k < 2; ++k) dst[m][k] = *(const PG8_LAS bf16x8*)(lds + PG8_SA(b, h) + aoff + m * 2048 + k * 1024); } while (0)
#define PG8_LDB(dst, b, h) do { _Pragma("unroll") for (int n = 0; n < 2; ++n) _Pragma("unroll") for (int k = 0; k < 2; ++k) dst[n][k] = *(const PG8_LAS bf16x8*)(lds + PG8_SB(b, h) + boff + n * 2048 + k * 1024); } while (0)
#define PG8_MMA(ai, bj, At, Bt) do { __builtin_amdgcn_s_setprio(1); _Pragma("unroll") for (int m = 0; m < 4; ++m) _Pragma("unroll") for (int n = 0; n < 2; ++n) _Pragma("unroll") for (int k = 0; k < 2; ++k) \
        acc[ai][bj][m][n] = __builtin_amdgcn_mfma_f32_16x16x32_bf16(Bt[n][k], At[m][k], acc[ai][bj][m][n], 0, 0, 0); __builtin_amdgcn_s_setprio(0); } while (0)
#define PG8_WAIT_V(n) asm volatile("s_waitcnt vmcnt(" #n ")" ::: "memory")
#define PG8_WAIT_L(n) asm volatile("s_waitcnt lgkmcnt(" #n ")" ::: "memory")
#define PG8_BAR __builtin_amdgcn_s_barrier()
#define PG8_SCHED __builtin_amdgcn_sched_barrier(0)
    Unit cur, nxt; int ui = 0;
    if (!S.next(0, cur)) return;
    f32x4 acc[2][2][4][2];
#pragma unroll
    for (int a = 0; a < 2; ++a)
#pragma unroll
        for (int b = 0; b < 2; ++b)
#pragma unroll
            for (int m = 0; m < 4; ++m)
#pragma unroll
                for (int n = 0; n < 2; ++n) acc[a][b][m][n] = (f32x4){0.f, 0.f, 0.f, 0.f};
    bf16x8 At[4][2], B0[2][2], B1[2][2];
    const char* cA = (const char*)g.A + (size_t)cur.pm * tstep; const char* cB = (const char*)g.Bt + (size_t)cur.pn * tstep;
    S.a_ready(cur);
    PG8_STAGE(PG8_SB(0, 0), cB, voffB); PG8_STAGE(PG8_SA(0, 0), cA, voffA); PG8_STAGE(PG8_SB(0, 1), cB + hstep, voffB); PG8_STAGE(PG8_SA(0, 1), cA + hstep, voffA);
    if (wr == 1) PG8_BAR;
    PG8_WAIT_V(4); PG8_BAR;
    PG8_STAGE(PG8_SB(1, 0), cB + kstep, voffB); PG8_STAGE(PG8_SA(1, 0), cA + kstep, voffA); PG8_STAGE(PG8_SB(1, 1), cB + hstep + kstep, voffB);
    PG8_WAIT_V(6); PG8_BAR;
    for (;;) {
        const bool has_next = S.next(ui + 1, nxt);
        const char* nA = has_next ? (const char*)g.A + (size_t)nxt.pm * tstep : cA; const char* nB = has_next ? (const char*)g.Bt + (size_t)nxt.pn * tstep : cB;
        for (int t = 0; t < nt; t += 2) {
            const bool last = (t == nt - 2);
            const char* a1 = cA + (size_t)(t + 1) * kstep;
            const char* a2 = last ? nA : cA + (size_t)(t + 2) * kstep; const char* b2 = last ? nB : cB + (size_t)(t + 2) * kstep;
            const char* a3 = a2 + kstep; const char* b3 = b2 + kstep;
            if (last && has_next) S.a_ready(nxt);
            PG8_LDB(B0, 0, 0); PG8_SCHED; PG8_LDA(At, 0, 0); PG8_STAGE(PG8_SA(1, 1), a1 + hstep, voffA);
            PG8_WAIT_L(8); PG8_BAR; PG8_WAIT_L(0); PG8_MMA(0, 0, At, B0); PG8_BAR; PG8_SCHED;
            PG8_LDB(B1, 0, 1); PG8_STAGE(PG8_SB(0, 0), b2, voffB);
            PG8_BAR; PG8_WAIT_L(0); PG8_MMA(0, 1, At, B1); PG8_BAR;
            PG8_LDA(At, 0, 1); PG8_STAGE(PG8_SA(0, 0), a2, voffA);
            PG8_BAR; PG8_WAIT_L(0); PG8_MMA(1, 0, At, B0); PG8_BAR; PG8_SCHED;
            PG8_STAGE(PG8_SB(0, 1), b2 + hstep, voffB);
            PG8_WAIT_V(6); PG8_BAR; PG8_MMA(1, 1, At, B1); PG8_BAR;
            PG8_LDB(B0, 1, 0); PG8_SCHED; PG8_LDA(At, 1, 0); PG8_STAGE(PG8_SA(0, 1), a2 + hstep, voffA);
            PG8_WAIT_L(8); PG8_BAR; PG8_WAIT_L(0); PG8_MMA(0, 0, At, B0); PG8_BAR; PG8_SCHED;
            PG8_LDB(B1, 1, 1); PG8_STAGE(PG8_SB(1, 0), b3, voffB);
            PG8_BAR; PG8_WAIT_L(0); PG8_MMA(0, 1, At, B1); PG8_BAR;
            PG8_LDA(At, 1, 1); PG8_STAGE(PG8_SA(1, 0), a3, voffA);
            PG8_BAR; PG8_WAIT_L(0); PG8_MMA(1, 0, At, B0); PG8_BAR; PG8_SCHED;
            PG8_STAGE(PG8_SB(1, 1), b3 + hstep, voffB);
            PG8_WAIT_V(6); PG8_BAR; PG8_MMA(1, 1, At, B1); PG8_BAR;
        }
        if constexpr (!Epi::AFTER_DRAIN) { E(acc, cur, wr, wc, fr, fq); S.done(cur); }
        if (!has_next) break;
#pragma unroll
        for (int a = 0; a < 2; ++a)
#pragma unroll
            for (int b = 0; b < 2; ++b)
#pragma unroll
                for (int m = 0; m < 4; ++m)
#pragma unroll
                    for (int n = 0; n < 2; ++n) acc[a][b][m][n] = (f32x4){0.f, 0.f, 0.f, 0.f};
        cur = nxt; cA = nA; cB = nB; ++ui;
    }
    PG8_WAIT_V(0);
    if (wr == 0) PG8_BAR;
    PG8_BAR;
    if constexpr (Epi::AFTER_DRAIN) { E.fused(acc, cur, wr, wc, fr, fq, lds, wid, lane); S.done(cur); }
#undef PG8_SA
#undef PG8_SB
#undef PG8_STAGE
#undef PG8_LDA
#undef PG8_LDB
#undef PG8_MMA
#undef PG8_WAIT_V
#undef PG8_WAIT_L
#undef PG8_BAR
#undef PG8_SCHED
}
}

template <class F> struct EpiAd {
    static constexpr bool PERM = true, AFTER_DRAIN = false;
    F f; float* ssq;
    __device__ __forceinline__ void operator()(const pg8::f32x4 (&acc)[2][2][4][2], const pg8::Unit& u, int wr, int wc, int fr, int fq) const {
#pragma unroll
        for (int ai = 0; ai < 2; ++ai)
#pragma unroll
            for (int m = 0; m < 4; ++m) { const int row = u.pm * 256 + ai * 128 + wr * 64 + m * 16 + fr;
                float v0[8], v1[8];
#pragma unroll
                for (int n = 0; n < 2; ++n)
#pragma unroll
                    for (int e = 0; e < 4; ++e) { v0[4 * n + e] = acc[ai][0][m][n][e]; v1[4 * n + e] = acc[ai][1][m][n][e]; }
                float s = f.apply(row, u.pn, wc * 32 + 8 * fq, v0, v1);
                if (ssq) { s += __shfl_xor(s, 16); s += __shfl_xor(s, 32); if (fq == 0) ssq[(size_t)row * 16 + u.pn * 4 + wc] = s; } }
    }
};
struct TwoPartOrder {
    pg8::StaticOrder s1; int n1, nM1, nM2, n2, G, c;
    __device__ void init(int nM1_, int nN1, int nM2_, int nN2, int G_, int c_) { s1.init(nM1_ * 256, nN1 * 256, G_, c_); n1 = nM1_ * nN1; nM1 = nM1_; nM2 = nM2_; n2 = nM2_ * nN2; G = G_; c = c_; }
    __device__ bool next(int i, pg8::Unit& u) const { long L = (long)i * G + c; if (L < n1) return s1.next(i, u); L -= n1; if (L >= n2) return false; u.pm = nM1 + (int)(L % nM2); u.pn = (int)(L / nM2); return true; }
    __device__ __forceinline__ void a_ready(const pg8::Unit&) const {}
    __device__ __forceinline__ void done(const pg8::Unit&) const {}
};
template <class F>
__device__ __forceinline__ void gemm_mfma(LAS unsigned char* lds, const bf16_t* A, const bf16_t* Bt, int K, int nrows1, int npn1, int nrows2, int npn2, const F& f, float* ssq) {
    __syncthreads();
    pg8::Gemm g{A, Bt, nrows1 + nrows2, npn1 * 256, K}; TwoPartOrder S; S.init(nrows1 / 256, npn1, nrows2 / 256, npn2, (int)gridDim.x, (int)blockIdx.x);
    EpiAd<F> E{f, ssq};
    pg8::gemm_phase(lds, g, S, E);
    __syncthreads();
}

struct Ctx { LAS unsigned char* lds; int tid, lane, wid, gw, ngw; };

__device__ __forceinline__ void phase_prep(const Params& p, const Ctx& c) {
    unsigned char* ws = p.ws;
    LAS float* scr = (LAS float*)(c.lds + c.wid * 8448);
    transpose_matrix(p.w_in, D, NIN, (bf16_t*)(ws + WS_WIN_T), scr, c.gw, c.ngw, c.lane);
    transpose_matrix(p.w_pa, 512, D, (bf16_t*)(ws + WS_WPA_T), scr, c.gw, c.ngw, c.lane);
    transpose_matrix(p.w_pb, 512, D, (bf16_t*)(ws + WS_WPB_T), scr, c.gw, c.ngw, c.lane);
    transpose_matrix(p.w_out, D, D, (bf16_t*)(ws + WS_WOUT_T), scr, c.gw, c.ngw, c.lane);
    transpose_gu(p.ffn_wg, 0, (bf16_t*)(ws + WS_WG1_T), scr, c.gw, c.ngw, c.lane);
    transpose_gu(p.ffn_wu, 1, (bf16_t*)(ws + WS_WG1_T), scr, c.gw, c.ngw, c.lane);
    transpose_matrix(p.ffn_wd, DFF, D, (bf16_t*)(ws + WS_WD1_T), scr, c.gw, c.ngw, c.lane);
    __syncthreads();
    if ((int)blockIdx.x < MODW / 64) {
        LAS float* xs = (LAS float*)c.lds; LAS float* part = (LAS float*)(c.lds + 17 * 1024 * 4);
        for (int i = c.tid; i < 17 * 1024; i += NTHR) { const int r = i >> 10, k = i & 1023; const float v = r < 16 ? p.c[r * D + k] : p.c_ctx[k]; xs[i] = v / (1.0f + expf(-v)); }
        __syncthreads();
        gemv17<false>(xs, part, p.mod_w, MODW, p.mod_b, (float*)(ws + WS_MODV), MODW, 0, blockIdx.x, gridDim.x);
    }
    { float* er = (float*)(ws + WS_ER); float* ec = (float*)(ws + WS_EC); float* lbv = (float*)(ws + WS_LBV);
      const int gt = blockIdx.x * NTHR + c.tid, ngt = gridDim.x * NTHR;
      for (int i = gt; i < 96 * 512; i += ngt) { const int r = i >> 9, j = i & 511, jj = j & 255; const float omega = 1.0f / powf(10000.0f, (float)jj / 256.0f);
          const int pos = r < 32 ? r : r - 32; const float a = (float)pos * omega; const float v = j < 256 ? sinf(a) : cosf(a);
          if (r < 32) er[r * 512 + j] = v; else ec[(r - 32) * 512 + j] = v; }
      for (int i = gt; i < 1024; i += ngt) { const float l0 = p.lb_logits[i], l1 = p.lb_logits[1024 + i]; lbv[i] = 1.0f / (1.0f + expf(l1 - l0)); } }
    { LAS float* zf = (LAS float*)c.lds; LAS float* h1 = zf + 8 * 40; float* h2o = (float*)(ws + WS_H2);
      for (int it = blockIdx.x; it < SEQ / 8; it += gridDim.x) {
          __syncthreads();
          if (c.tid < 8 * 33) { const int r = c.tid / 33, f = c.tid % 33; const int pp = it * 8 + r; float v;
              if (f == 0) v = (float)pp / (float)(SEQ - 1);
              else { const int i = (f - 1) & 15; const float w = 6.283185307179586f * (float)pp / (float)SEQ; const float fr = 1e-4f + (float)i * ((15.0f - 1e-4f) / 15.0f); const float ang = w * fr; v = f <= 16 ? cosf(ang) : -sinf(ang); }
              zf[r * 40 + f] = v; }
          __syncthreads();
          { const int r = c.tid >> 6, j = c.tid & 63; float s = p.hb1[j];
            for (int f = 0; f < 33; ++f) s += zf[r * 40 + f] * p.hw1[f * 64 + j];
            h1[r * 64 + j] = sinf(p.hfr1[j] * s); }
          __syncthreads();
          { const int r = c.tid >> 6, j = c.tid & 63; float s = p.hb2[j];
            for (int k = 0; k < 64; ++k) s += h1[r * 64 + k] * p.hw2[k * 64 + j];
            h2o[(size_t)(it * 8 + r) * 64 + j] = sinf(p.hfr2[j] * s); }
      } }
}

__device__ __forceinline__ void phase_n1(const Params& p, const Ctx& c) {
    unsigned char* ws = p.ws;
    const float* modv = (const float*)(ws + WS_MODV); const float* er = (const float*)(ws + WS_ER); const float* ec = (const float*)(ws + WS_EC);
    bf16_t* n1 = (bf16_t*)(ws + WS_N1);
    for (int row = c.gw; row < MT; row += c.ngw) {
        const bool lat = row < T; const int b = lat ? (row >> 11) : 16, t = row & (SEQ - 1);
        const float* src = lat ? p.x + (size_t)row * D : p.ctx + (size_t)(row - T) * D;
        f32x4 v[4]; float s = 0.f;
#pragma unroll
        for (int j = 0; j < 4; ++j) { const int col = 4 * c.lane + 256 * j; v[j] = *(const f32x4*)(src + col);
            if (lat) { const float* pe = col < 512 ? er + (t >> 6) * 512 + col : ec + (t & 63) * 512 + (col - 512); v[j] += *(const f32x4*)pe; }
            s += (v[j][0] * v[j][0] + v[j][1] * v[j][1]) + (v[j][2] * v[j][2] + v[j][3] * v[j][3]); }
        const float rs = 1.0f / sqrtf(wave_sum(s) * (1.0f / D) + RMS_EPS);
#pragma unroll
        for (int j = 0; j < 4; ++j) { const int col = 4 * c.lane + 256 * j; const f32x4 sh = *(const f32x4*)(modv + (size_t)b * MODW + col), sc = *(const f32x4*)(modv + (size_t)b * MODW + D + col);
            const f32x4 o = v[j] * rs * (sc + 1.0f) + sh; u32x2 w; w.x = pk2(o[0], o[1]); w.y = pk2(o[2], o[3]); *(u32x2*)(n1 + (size_t)row * D + col) = w; }
    }
    { LAS float* xs = (LAS float*)c.lds; LAS float* part = (LAS float*)(c.lds + 17 * 1024 * 4);
      const int nb_in = NIN / 64, nb_g = DFF / 64;
      for (int bx = blockIdx.x; bx < nb_in + 2 * nb_g; bx += gridDim.x) {
          __syncthreads();
          if (bx < nb_in) {
              for (int i = c.tid; i < 17 * 1024; i += NTHR) xs[i] = modv[(size_t)(i >> 10) * MODW + 3 * D + (i & 1023)];
              __syncthreads();
              gemv17<false>(xs, part, p.w_in, NIN, nullptr, (float*)(ws + WS_SWIN), NIN, 0, bx, nb_in); }
          else { const int half = (bx - nb_in) / nb_g, blk = (bx - nb_in) % nb_g;
              for (int i = c.tid; i < 17 * 1024; i += NTHR) xs[i] = modv[(size_t)(i >> 10) * MODW + 6 * D + (i & 1023)];
              __syncthreads();
              const float* W = (half ? p.ffn_wu : p.ffn_wg) + (size_t)D * DFF;
              gemv17<true>(xs, part, W, DFF, nullptr, (float*)(ws + WS_SW2), NGU, half, blk, nb_g); }
      }
    }
    { LAS float* w3s = (LAS float*)c.lds;
      LAS float* hk = w3s + 512;
      LAS float* red = hk + 2048 * 8;
      const float* h2 = (const float*)(ws + WS_H2); bf16_t* krev = (bf16_t*)(ws + WS_KREV);
      for (int it = blockIdx.x; it < 256; it += gridDim.x) {
          const int c0 = 2 * it;
          __syncthreads();
          { const int k = c.tid >> 3, q = c.tid & 7; w3s[c.tid] = p.hw3[(size_t)k * 2048 + (q >> 2) * 1024 + ((q >> 1) & 1) * 512 + c0 + (q & 1)]; }
          __syncthreads();
          float l1[4] = {0.f, 0.f, 0.f, 0.f};
          for (int idx = c.tid; idx < 2048 * 8; idx += NTHR) { const int t = idx >> 3, q = idx & 7; float s = 0.f;
              const float* hr = h2 + (size_t)t * 64;
#pragma unroll 8
              for (int k = 0; k < 64; ++k) s += hr[k] * w3s[k * 8 + q];
              const int ch = c0 + (q & 1); const float delta = fabsf(-3.0701134573253945f + (float)ch * ((-15.350567286626973f + 3.0701134573253945f) / 511.0f));
              const float tn = (float)t / (float)(SEQ - 1); s *= expf(-tn * delta) + 0.05f;
              hk[idx] = s; l1[0] += fabsf(s); }
          { float s = l1[0]; s += __shfl_xor(s, 2); s += __shfl_xor(s, 8); s += __shfl_xor(s, 16); s += __shfl_xor(s, 32);
            if ((c.lane & ~5) == 0) red[c.wid * 4 + ((c.lane >> 2) & 1) * 2 + (c.lane & 1)] = s; }
          __syncthreads();
          for (int e = c.tid; e < 4 * KR_LEN; e += NTHR) { const int oc = e / KR_LEN, i = (e % KR_LEN) - KR_OFF, o = oc >> 1, cc = oc & 1;
              float tot = 0.f;
#pragma unroll
              for (int w = 0; w < 8; ++w) tot += red[w * 4 + oc];
              const int lag = -i; float v = 0.f;
              if (lag >= 0 && lag <= SEQ - 1) v = hk[lag * 8 + o * 4 + 0 + cc]; else if (lag < 0 && lag >= -(SEQ - 1)) v = hk[(-lag - 1) * 8 + o * 4 + 2 + cc];
              krev[((size_t)o * 512 + c0 + cc) * KR_LEN + (e % KR_LEN)] = f2bf(v / (tot + 1e-6f)); }
      } }
}

__device__ __forceinline__ void phase_hgrn_simple(const Params& p, const Ctx& c) {
    unsigned char* ws = p.ws;
    const bf16_t* vb = (const bf16_t*)(ws + WS_V); const bf16_t* qb = (const bf16_t*)(ws + WS_Q);
    LAS float* F = (LAS float*)c.lds; LAS float* Kk = F + 64 * 128; LAS float* Q = Kk + 64 * 128; LAS float* V = Q + 64 * 128;
    const int dg = c.tid & 3, e = c.tid >> 2;
    for (int it = blockIdx.x; it < NB * 4 * 2; it += gridDim.x) {
        const int dir = it & 1, h = (it >> 1) & 3, b = it >> 3;
        const f16_t* lf = (const f16_t*)(ws + (dir ? WS_LBW : WS_LFW)); float* outp = (float*)(ws + (dir ? WS_OBW : WS_OFW));
        float S[32];
#pragma unroll
        for (int i = 0; i < 32; ++i) S[i] = 0.f;
        for (int ci = 0; ci < 36; ++ci) {
            const bool lat = ci >= 4;
            __syncthreads();
            for (int idx = c.tid; idx < 64 * 128; idx += NTHR) { const int j = idx >> 7, d = idx & 127; const int pp = (lat ? ci - 4 : ci) * 64 + j;
                const int row = lat ? b * SEQ + (dir ? SEQ - 1 - pp : pp) : T + b * CL + (dir ? CL - 1 - pp : pp);
                const float f = __expf((float)lf[(size_t)row * 512 + h * 128 + d]);
                F[idx] = f; Kk[idx] = 1.0f - f; V[idx] = bf2f(vb[(size_t)row * 512 + h * 128 + d]); Q[idx] = lat ? bf2f(qb[(size_t)row * 512 + h * 128 + d]) : 0.f; }
            __syncthreads();
            for (int j = 0; j < 64; ++j) { const float ve = V[j * 128 + e]; float part = 0.f;
#pragma unroll
                for (int i = 0; i < 32; ++i) { const int d = dg * 32 + i; S[i] = F[j * 128 + d] * S[i] + Kk[j * 128 + d] * ve; part += S[i] * Q[j * 128 + d]; }
                part += __shfl_xor(part, 1); part += __shfl_xor(part, 2);
                if (lat && dg == 0) { const int pp = (ci - 4) * 64 + j; const int row = b * SEQ + (dir ? SEQ - 1 - pp : pp); outp[(size_t)row * 512 + h * 128 + e] = part; } }
        }
    }
}


typedef short bf16x8 __attribute__((ext_vector_type(8)));
constexpr int QROW = 136, TROW = 72;
__device__ __forceinline__ int hg_pos(int x) { return (x & ~31) + ((x >> 2) & 3) * 8 + ((x >> 4) & 1) * 4 + (x & 3); }
__device__ __forceinline__ pg8::f32x4 mfma16(bf16x8 a, bf16x8 b, pg8::f32x4 c) { return __builtin_amdgcn_mfma_f32_16x16x32_bf16(a, b, c, 0, 0, 0); }
__device__ __forceinline__ void phase_hgrn_mfma(const Params& p, const Ctx& c) {
    unsigned char* ws = p.ws;
    const bf16_t* vb = (const bf16_t*)(ws + WS_V); const bf16_t* qb = (const bf16_t*)(ws + WS_Q);
    LAS bf16_t* Qt = (LAS bf16_t*)c.lds;
    LAS bf16_t* Kt = Qt + 64 * QROW;
    LAS bf16_t* KhT = Kt + 64 * QROW;
    LAS bf16_t* VT = KhT + 128 * TROW;
    LAS bf16_t* ST0 = VT + 64 * TROW;
    LAS bf16_t* ST1 = ST0 + 64 * QROW;
    LAS float* qt = (LAS float*)(ST1 + 64 * QROW);
    LAS float* El = qt + 8 * 128;
    const int wid = c.wid, lane = c.lane, fr = lane & 15, fq = lane >> 4, dp = lane, ti = wid & 3, eh = wid >> 2;
    for (int it = blockIdx.x; it < 256; it += gridDim.x) {
        const int dvh = (it >> 3) & 1, idx = (it & 7) | ((it >> 4) << 3), dir = idx & 1, h = (idx >> 1) & 3, b = idx >> 3;
        const f16_t* lf = (const f16_t*)(ws + (dir ? WS_LBW : WS_LFW)); float* outp = (float*)(ws + (dir ? WS_OBW : WS_OFW));
        const int colq = h * 128 + 2 * dp, colv = h * 128 + dvh * 64 + (c.tid & 7) * 8, pv = c.tid >> 3;
        pg8::f32x4 S[4];
#pragma unroll
        for (int e = 0; e < 4; ++e) S[e] = (pg8::f32x4){0.f, 0.f, 0.f, 0.f};
#define HG_ROW(ci_, p_) (((ci_) >= 4) ? (b * SEQ + (dir ? SEQ - 1 - (((ci_) - 4) * 64 + (p_)) : (((ci_) - 4) * 64 + (p_)))) : (T + b * CL + (dir ? CL - 1 - ((ci_) * 64 + (p_)) : ((ci_) * 64 + (p_)))))
        unsigned lfr[8], qr[8]; u32x4 vr;
#pragma unroll
        for (int i = 0; i < 8; ++i) { const int row = HG_ROW(0, 8 * wid + i); lfr[i] = *(const unsigned*)(lf + (size_t)row * 512 + colq); qr[i] = 0u; }
        vr = *(const u32x4*)(vb + (size_t)HG_ROW(0, pv) * 512 + colv);
        __syncthreads();
        for (int ci = 0; ci < 36; ++ci) {
            const bool lat = ci >= 4;
            float l0[8], l1[8], c0[8], c1[8]; float run0 = 0.f, run1 = 0.f;
#pragma unroll
            for (int i = 0; i < 8; ++i) { const __fp16 a0 = __builtin_bit_cast(__fp16, (unsigned short)(lfr[i] & 0xffffu)), a1 = __builtin_bit_cast(__fp16, (unsigned short)(lfr[i] >> 16));
                l0[i] = (float)a0; l1[i] = (float)a1; run0 += l0[i]; run1 += l1[i]; c0[i] = run0; c1[i] = run1; }
            qt[wid * 128 + 2 * dp] = run0; qt[wid * 128 + 2 * dp + 1] = run1;
            __syncthreads();
            float off0 = 0.f, off1 = 0.f, tot0 = 0.f, tot1 = 0.f;
#pragma unroll
            for (int w = 0; w < 8; ++w) { const float a0 = qt[w * 128 + 2 * dp], a1 = qt[w * 128 + 2 * dp + 1]; tot0 += a0; tot1 += a1; if (w < wid) { off0 += a0; off1 += a1; } }
            const float E0 = __expf(tot0), E1 = __expf(tot1);
            if (wid == 0) { El[2 * dp] = E0; El[2 * dp + 1] = E1; }
            const int qpos = hg_pos(2 * dp);
            float kh0[8], kh1[8];
#pragma unroll
            for (int i = 0; i < 8; ++i) { const int pp = 8 * wid + i; const float cu0 = off0 + c0[i], cu1 = off1 + c1[i];
                const float e0 = __expf(cu0), e1 = __expf(cu1), r0 = __expf(-cu0), r1 = __expf(-cu1);
                const float k0 = (1.0f - __expf(l0[i])) * r0, k1 = (1.0f - __expf(l1[i])) * r1;
                *(LAS unsigned*)(Kt + pp * QROW + qpos) = pk2(k0, k1);
                if (lat) { const float q0 = __uint_as_float(qr[i] << 16), q1 = __uint_as_float(qr[i] & 0xffff0000u); *(LAS unsigned*)(Qt + pp * QROW + qpos) = pk2(q0 * e0, q1 * e1); }
                kh0[i] = k0 * E0; kh1[i] = k1 * E1; }
            { const int base0 = 32 * (wid >> 2) + 16 * (wid & 1) + 4 * ((wid >> 1) & 1);
              u32x2 w; w.x = pk2(kh0[0], kh0[1]); w.y = pk2(kh0[2], kh0[3]); *(LAS u32x2*)(KhT + (2 * dp) * TROW + base0) = w;
              w.x = pk2(kh0[4], kh0[5]); w.y = pk2(kh0[6], kh0[7]); *(LAS u32x2*)(KhT + (2 * dp) * TROW + base0 + 8) = w;
              w.x = pk2(kh1[0], kh1[1]); w.y = pk2(kh1[2], kh1[3]); *(LAS u32x2*)(KhT + (2 * dp + 1) * TROW + base0) = w;
              w.x = pk2(kh1[4], kh1[5]); w.y = pk2(kh1[6], kh1[7]); *(LAS u32x2*)(KhT + (2 * dp + 1) * TROW + base0 + 8) = w; }
            { const int e8 = (c.tid & 7) * 8, sp = hg_pos(pv); const unsigned wv[4] = {vr.x, vr.y, vr.z, vr.w};
#pragma unroll
              for (int j = 0; j < 4; ++j) { VT[(e8 + 2 * j) * TROW + sp] = (bf16_t)(wv[j] & 0xffffu); VT[(e8 + 2 * j + 1) * TROW + sp] = (bf16_t)(wv[j] >> 16); } }
            if (ci + 1 < 36) { const bool nlat = ci + 1 >= 4;
#pragma unroll
                for (int i = 0; i < 8; ++i) { const int row = HG_ROW(ci + 1, 8 * wid + i); lfr[i] = *(const unsigned*)(lf + (size_t)row * 512 + colq); if (nlat) qr[i] = *(const unsigned*)(qb + (size_t)row * 512 + colq); }
                vr = *(const u32x4*)(vb + (size_t)HG_ROW(ci + 1, pv) * 512 + colv); }
            __syncthreads();
            const LAS bf16_t* STr = (ci & 1) ? ST1 : ST0; LAS bf16_t* STw = (ci & 1) ? ST0 : ST1;
            bf16x8 VF[4][2];
#pragma unroll
            for (int ei = 0; ei < 4; ++ei)
#pragma unroll
                for (int a = 0; a < 2; ++a) VF[ei][a] = *(const LAS bf16x8*)(VT + (16 * ei + fr) * TROW + 32 * a + 8 * fq);
            if (lat) {
                bf16x8 QF[4];
#pragma unroll
                for (int k = 0; k < 4; ++k) QF[k] = *(const LAS bf16x8*)(Qt + (16 * ti + fr) * QROW + 32 * k + 8 * fq);
                pg8::f32x4 P[4];
#pragma unroll
                for (int si = 0; si < 4; ++si) { pg8::f32x4 acc = (pg8::f32x4){0.f, 0.f, 0.f, 0.f};
                    if (si <= ti) {
#pragma unroll
                        for (int k = 0; k < 4; ++k) acc = mfma16(*(const LAS bf16x8*)(Kt + (16 * si + fr) * QROW + 32 * k + 8 * fq), QF[k], acc);
                        if (si == ti) {
#pragma unroll
                            for (int r = 0; r < 4; ++r) acc[r] = (4 * fq + r <= fr) ? acc[r] : 0.f; } }
                    P[si] = acc; }
                bf16x8 PB[2];
#pragma unroll
                for (int a = 0; a < 2; ++a) { u32x4 w; w.x = pk2(P[2 * a][0], P[2 * a][1]); w.y = pk2(P[2 * a][2], P[2 * a][3]); w.z = pk2(P[2 * a + 1][0], P[2 * a + 1][1]); w.w = pk2(P[2 * a + 1][2], P[2 * a + 1][3]); PB[a] = __builtin_bit_cast(bf16x8, w); }
#pragma unroll
                for (int e2 = 0; e2 < 2; ++e2) { const int ei = 2 * eh + e2; pg8::f32x4 acc = (pg8::f32x4){0.f, 0.f, 0.f, 0.f};
#pragma unroll
                    for (int a = 0; a < 2; ++a) if (2 * a <= ti) acc = mfma16(*(const LAS bf16x8*)(VT + (16 * ei + fr) * TROW + 32 * a + 8 * fq), PB[a], acc);
#pragma unroll
                    for (int k = 0; k < 4; ++k) acc = mfma16(*(const LAS bf16x8*)(STr + (16 * ei + fr) * QROW + 32 * k + 8 * fq), QF[k], acc);
                    const int row = HG_ROW(ci, 16 * ti + fr);
                    *(pg8::f32x4*)(outp + (size_t)row * 512 + h * 128 + dvh * 64 + 16 * ei + 4 * fq) = acc; }
            }
            { const pg8::f32x4 dl = *(const LAS pg8::f32x4*)(El + 16 * wid + 4 * fq);
              bf16x8 KH[2];
#pragma unroll
              for (int a = 0; a < 2; ++a) KH[a] = *(const LAS bf16x8*)(KhT + (16 * wid + fr) * TROW + 32 * a + 8 * fq);
#pragma unroll
              for (int ei = 0; ei < 4; ++ei) { S[ei] = S[ei] * dl;
#pragma unroll
                  for (int a = 0; a < 2; ++a) S[ei] = mfma16(KH[a], VF[ei][a], S[ei]);
                  u32x2 w; w.x = pk2(S[ei][0], S[ei][1]); w.y = pk2(S[ei][2], S[ei][3]);
                  *(LAS u32x2*)(STw + (16 * ei + fr) * QROW + 32 * (wid >> 1) + 8 * fq + 4 * (wid & 1)) = w; } }
            __syncthreads();
        }
#undef HG_ROW
    }
}

__device__ __forceinline__ float hy_tap(const bf16_t* hy, const float* cw, const float* cb, int ch, int b, int t) {
    const bf16_t* src = hy + (((size_t)(ch >> 3) * NB + b) * SEQ) * 8 + (ch & 7); float s = cb[ch];
#pragma unroll
    for (int j = 0; j < 3; ++j) { const int tt = t + j - 1; if (tt >= 0 && tt < SEQ) s += cw[j * NHY + ch] * bf2f(src[(size_t)tt * 8]); }
    return s;
}
__device__ __forceinline__ void phase_hyena_simple(const Params& p, const Ctx& c) {
    unsigned char* ws = p.ws;
    const bf16_t* hy = (const bf16_t*)(ws + WS_HY); const bf16_t* krev = (const bf16_t*)(ws + WS_KREV); bf16_t* zb = (bf16_t*)(ws + WS_ZB);
    LAS float* zs = (LAS float*)c.lds;
    LAS float* kr = zs + 2048 * 16;
    for (int ch = blockIdx.x; ch < BW; ch += gridDim.x) {
        __syncthreads();
        for (int idx = c.tid; idx < NB * SEQ; idx += NTHR) { const int b = idx >> 11, t = idx & (SEQ - 1); zs[t * 16 + b] = bfround(hy_tap(hy, p.conv_w, p.conv_b, ch, b, t)); }
        for (int o = 0; o < 2; ++o) {
            for (int i = c.tid; i < KR_LEN; i += NTHR) kr[i] = bf2f(krev[((size_t)o * 512 + ch) * KR_LEN + i]);
            __syncthreads();
            const int t0 = 4 * c.tid;
            float acc[4][16];
#pragma unroll
            for (int r = 0; r < 4; ++r)
#pragma unroll
                for (int b = 0; b < 16; ++b) acc[r][b] = 0.f;
            float w0, w1 = kr[KR_OFF - t0 - 1], w2 = kr[KR_OFF - t0 - 2], w3 = kr[KR_OFF - t0 - 3];
            for (int s = 0; s < SEQ; ++s) {
                w0 = kr[KR_OFF + s - t0];
                const f32x4 z0 = *(const LAS f32x4*)(zs + s * 16), z1 = *(const LAS f32x4*)(zs + s * 16 + 4), z2 = *(const LAS f32x4*)(zs + s * 16 + 8), z3 = *(const LAS f32x4*)(zs + s * 16 + 12);
#pragma unroll
                for (int j = 0; j < 4; ++j) { acc[0][j] += w0 * z0[j]; acc[0][4 + j] += w0 * z1[j]; acc[0][8 + j] += w0 * z2[j]; acc[0][12 + j] += w0 * z3[j];
                                              acc[1][j] += w1 * z0[j]; acc[1][4 + j] += w1 * z1[j]; acc[1][8 + j] += w1 * z2[j]; acc[1][12 + j] += w1 * z3[j];
                                              acc[2][j] += w2 * z0[j]; acc[2][4 + j] += w2 * z1[j]; acc[2][8 + j] += w2 * z2[j]; acc[2][12 + j] += w2 * z3[j];
                                              acc[3][j] += w3 * z0[j]; acc[3][4 + j] += w3 * z1[j]; acc[3][8 + j] += w3 * z2[j]; acc[3][12 + j] += w3 * z3[j]; }
                w3 = w2; w2 = w1; w1 = w0;
            }
            const float bias = p.hy_bias[o * 512 + ch];
#pragma unroll
            for (int r = 0; r < 4; ++r)
#pragma unroll
                for (int b = 0; b < 16; ++b) acc[r][b] += bias * zs[(t0 + r) * 16 + b];
            __syncthreads();
#pragma unroll
            for (int r = 0; r < 4; ++r)
#pragma unroll
                for (int b4 = 0; b4 < 4; ++b4) *(LAS f32x4*)(zs + (t0 + r) * 16 + 4 * b4) = (f32x4){acc[r][4 * b4], acc[r][4 * b4 + 1], acc[r][4 * b4 + 2], acc[r][4 * b4 + 3]};
#pragma unroll 1
            for (int i = 0; i < 64; ++i) { const int r = i >> 4, b = i & 15, t = t0 + r; const float gate = hy_tap(hy, p.conv_w, p.conv_b, (o + 1) * 512 + ch, b, t);
                const float zn = gate * zs[t * 16 + b];
                if (o == 0) zs[t * 16 + b] = bfround(zn); else zb[((size_t)ch * NB + b) * SEQ + t] = f2bf(zn); }
            __syncthreads();
        }
    }
}


constexpr int ZROW = 2056;
__device__ __forceinline__ void hy_conv4(const bf16_t* src, int t, float w0, float w1, float w2, float cb, float (&o)[4]) {
    float x[6];
#pragma unroll
    for (int i = 0; i < 6; ++i) { const int tt = t - 1 + i; x[i] = (tt >= 0 && tt < SEQ) ? bf2f(src[(size_t)tt * 8]) : 0.f; }
#pragma unroll
    for (int r = 0; r < 4; ++r) o[r] = cb + w0 * x[r] + w1 * x[r + 1] + w2 * x[r + 2];
}
__device__ __forceinline__ void hy_fill(LAS bf16_t* dst, const bf16_t* hy, const float* cw, const float* cbv, int chx, int tid) {
    const float w0 = cw[chx], w1 = cw[NHY + chx], w2 = cw[2 * NHY + chx], cb = cbv[chx];
    for (int b = 0; b < NB; ++b) { const bf16_t* src = hy + (((size_t)(chx >> 3) * NB + b) * SEQ) * 8 + (chx & 7); float o[4];
        hy_conv4(src, 4 * tid, w0, w1, w2, cb, o);
        u32x2 w; w.x = pk2(o[0], o[1]); w.y = pk2(o[2], o[3]); *(LAS u32x2*)(dst + b * ZROW + 4 * tid) = w; }
}
template <int KIND>
__device__ __forceinline__ void hy_block(pg8::f32x4 (&acc)[16], bf16x8 (&Bw)[16], const LAS bf16_t* zl, const LAS bf16_t* krl, int ub, int i0, int lane) {
    const int fr = lane & 15, fq = lane >> 4;
    const LAS bf16_t* bbase = zl + fr * ZROW + 8 * fq;
    const int abase = KR_OFF - 16 * i0 - fr + 8 * fq;
    const unsigned sh = (unsigned)(fr & 1) * 16u;
#pragma unroll
    for (int uu = 0; uu < 16; ++uu) {
        const int u = ub + uu;
        const bool ldb = KIND == 0 ? (uu >= 1) : (KIND == 1 ? true : (uu == 0));
        if (ldb) Bw[(uu + 15) & 15] = *(const LAS bf16x8*)(bbase + 32 * (u + 15));
        const LAS unsigned* ap = (const LAS unsigned*)(krl + ((abase + 32 * u) & ~1));
        const unsigned d0 = ap[0], d1 = ap[1], d2 = ap[2], d3 = ap[3], d4 = ap[4];
        u32x4 aw; aw.x = __builtin_amdgcn_alignbit(d1, d0, sh); aw.y = __builtin_amdgcn_alignbit(d2, d1, sh); aw.z = __builtin_amdgcn_alignbit(d3, d2, sh); aw.w = __builtin_amdgcn_alignbit(d4, d3, sh);
        const bf16x8 A = __builtin_bit_cast(bf16x8, aw);
#pragma unroll
        for (int m = 0; m < 16; ++m) { const bool on = KIND == 0 ? (m >= 16 - uu) : (KIND == 1 ? true : (m <= 15 - uu));
            if (on) acc[m] = __builtin_amdgcn_mfma_f32_16x16x32_bf16(A, Bw[(uu + m) & 15], acc[m], 0, 0, 0); }
    }
}
__device__ __forceinline__ void phase_hyena_mfma(const Params& p, const Ctx& c) {
    unsigned char* ws = p.ws;
    const bf16_t* hy = (const bf16_t*)(ws + WS_HY); const bf16_t* krev = (const bf16_t*)(ws + WS_KREV); bf16_t* zb = (bf16_t*)(ws + WS_ZB);
    LAS bf16_t* zl = (LAS bf16_t*)c.lds;
    LAS bf16_t* gl = zl + NB * ZROW;
    LAS bf16_t* krl = gl + NB * ZROW;
    const int i0 = 32 * (c.wid >> 1) + (c.wid & 1), fr = c.lane & 15, fq = c.lane >> 4;
    for (int ch = blockIdx.x; ch < BW; ch += gridDim.x) {
        __syncthreads();
        hy_fill(zl, hy, p.conv_w, p.conv_b, ch, c.tid);
        for (int o = 0; o < 2; ++o) {
            hy_fill(gl, hy, p.conv_w, p.conv_b, (o + 1) * 512 + ch, c.tid);
            for (int i = c.tid; i < KR_LEN / 8; i += NTHR) *(LAS u32x4*)(krl + 8 * i) = *(const u32x4*)(krev + ((size_t)o * 512 + ch) * KR_LEN + 8 * i);
            __syncthreads();
            pg8::f32x4 acc[16]; bf16x8 Bw[16];
#pragma unroll
            for (int m = 0; m < 16; ++m) { acc[m] = (pg8::f32x4){0.f, 0.f, 0.f, 0.f}; Bw[m] = (bf16x8){0, 0, 0, 0, 0, 0, 0, 0}; }
            hy_block<0>(acc, Bw, zl, krl, -16, i0, c.lane);
            for (int ub = 0; ub < 48; ub += 16) hy_block<1>(acc, Bw, zl, krl, ub, i0, c.lane);
            hy_block<2>(acc, Bw, zl, krl, 48, i0, c.lane);
            const float bias = p.hy_bias[o * 512 + ch];
            u32x2 res[16];
#pragma unroll
            for (int m = 0; m < 16; ++m) { const int t = 16 * (i0 + 2 * m) + 4 * fq; const u32x2 zo = *(const LAS u32x2*)(zl + fr * ZROW + t), gg = *(const LAS u32x2*)(gl + fr * ZROW + t);
                const float z0 = __uint_as_float(zo.x << 16), z1 = __uint_as_float(zo.x & 0xffff0000u), z2 = __uint_as_float(zo.y << 16), z3 = __uint_as_float(zo.y & 0xffff0000u);
                const float g0 = __uint_as_float(gg.x << 16), g1 = __uint_as_float(gg.x & 0xffff0000u), g2 = __uint_as_float(gg.y << 16), g3 = __uint_as_float(gg.y & 0xffff0000u);
                res[m].x = pk2(g0 * (acc[m][0] + bias * z0), g1 * (acc[m][1] + bias * z1)); res[m].y = pk2(g2 * (acc[m][2] + bias * z2), g3 * (acc[m][3] + bias * z3)); }
            __syncthreads();
#pragma unroll
            for (int m = 0; m < 16; ++m) { const int t = 16 * (i0 + 2 * m) + 4 * fq;
                if (o == 0) *(LAS u32x2*)(zl + fr * ZROW + t) = res[m]; else *(u32x2*)(zb + ((size_t)ch * NB + fr) * SEQ + t) = res[m]; }
        }
    }
}

__device__ __forceinline__ void phase_combine(const Params& p, const Ctx& c) {
    unsigned char* ws = p.ws;
    const float* ofw = (const float*)(ws + WS_OFW); const float* obw = (const float*)(ws + WS_OBW); const bf16_t* g = (const bf16_t*)(ws + WS_G);
    bf16_t* oa = (bf16_t*)(ws + WS_OA); bf16_t* ob = (bf16_t*)(ws + WS_OB); const bf16_t* zb = (const bf16_t*)(ws + WS_ZB);
    for (int row = c.gw; row < T; row += c.ngw) { const int col = 8 * c.lane; float a[8], bq[8], gg[8], w[8], o[8];
        load_f32x8(ofw + (size_t)row * 512 + col, a); load_f32x8(obw + (size_t)row * 512 + col, bq); load_bf16x8(g + (size_t)row * 512 + col, gg); load_f32x8(p.a_norm_w + (col & 127), w);
        float s = 0.f;
#pragma unroll
        for (int j = 0; j < 8; ++j) { a[j] += bq[j]; s += a[j] * a[j]; }
        s += __shfl_xor(s, 1); s += __shfl_xor(s, 2); s += __shfl_xor(s, 4); s += __shfl_xor(s, 8);
        const float rs = 1.0f / sqrtf(s * (1.0f / 128.0f) + RMS_EPS);
#pragma unroll
        for (int j = 0; j < 8; ++j) o[j] = a[j] * rs * w[j] * gg[j];
        store_bf16x8(oa + (size_t)row * 512 + col, o); }
    LAS bf16_t* tile = (LAS bf16_t*)c.lds;
    for (int it = blockIdx.x; it < NB * 32 * 8; it += gridDim.x) { const int cb = it & 7, tb = (it >> 3) & 31, b = it >> 8;
        __syncthreads();
        { const int cl = c.tid >> 3, t8 = (c.tid & 7) * 8; const u32x4 w = *(const u32x4*)(zb + ((size_t)(cb * 64 + cl) * NB + b) * SEQ + tb * 64 + t8); *(LAS u32x4*)(tile + cl * 72 + t8) = w; }
        __syncthreads();
        { const int tl = c.tid >> 3, c8 = (c.tid & 7) * 8; bf16_t v[8];
#pragma unroll
          for (int i = 0; i < 8; ++i) v[i] = tile[(c8 + i) * 72 + tl];
          u32x4 w; w.x = v[0] | ((unsigned)v[1] << 16); w.y = v[2] | ((unsigned)v[3] << 16); w.z = v[4] | ((unsigned)v[5] << 16); w.w = v[6] | ((unsigned)v[7] << 16);
          *(u32x4*)(ob + ((size_t)b * SEQ + tb * 64 + tl) * 512 + cb * 64 + c8) = w; }
    }
}

__device__ __forceinline__ void phase_final(const Params& p, const Ctx& c) {
    const float* ssq = (const float*)(p.ws + WS_SSQ3);
    for (int row = c.gw; row < T; row += c.ngw) { const float rs = rstd_from_ssq(ssq + (size_t)row * 16);
#pragma unroll
        for (int j = 0; j < 4; ++j) { const int col = 4 * c.lane + 256 * j; f32x4* ptr = (f32x4*)(p.out + (size_t)row * D + col); *ptr = *ptr * rs * *(const f32x4*)(p.fnw + col); } }
}


#define XB_TMO      128
#define XB_XCNT(j)  (256  + 64 * (j))
#define XB_XSUB(j)  (1280 + 64 * (j))
#define XB_XGEN(j)  (2304 + 64 * (j))
#define XB_TOP      3328
#define XB_TOPGEN   3392
#define XCD_BAR_WORDS 3456
#define XB_SPIN_CAP (1u << 18)
__device__ __forceinline__ unsigned xb_ld(unsigned* p)              { return __hip_atomic_load(p, __ATOMIC_RELAXED, __HIP_MEMORY_SCOPE_AGENT); }
__device__ __forceinline__ unsigned xb_add(unsigned* p, unsigned v) { return __hip_atomic_fetch_add(p, v, __ATOMIC_RELAXED, __HIP_MEMORY_SCOPE_AGENT); }
__device__ __forceinline__ unsigned xb_xcc_id() { return (unsigned)__builtin_amdgcn_s_getreg((3 << 11) | 20) & 0xFu; }
#define XB_SPIN(cond, bar) do { unsigned _sp = 0; while (cond) { __builtin_amdgcn_s_sleep(1); \
    if ((++_sp & 255u) == 0u) { if (xb_ld(&(bar)[XB_TMO])) break; if (_sp > XB_SPIN_CAP) { atomicAdd(&(bar)[XB_TMO], 1u); break; } } } } while (0)
struct XcdBarrier { unsigned* bar; unsigned x; volatile LAS unsigned* st; };
__device__ __forceinline__ XcdBarrier xcd_barrier_post(unsigned* bar, volatile LAS unsigned* st) {
    XcdBarrier b; b.bar = bar; b.x = xb_xcc_id(); b.st = st;
    if (threadIdx.x == 0) (void)xb_add(&bar[XB_XCNT(b.x)], 1u);
    return b;
}
__device__ __forceinline__ void xcd_barrier_complete(unsigned* bar, unsigned x, unsigned& nloc, unsigned& nx) {
    const unsigned G = gridDim.x * gridDim.y * gridDim.z;
    unsigned sum, cnt, mine, sp = 0u;
    for (;;) {
        sum = 0u; cnt = 0u; mine = 0u;
#pragma unroll
        for (unsigned j = 0; j < 16; ++j) { const unsigned c = xb_ld(&bar[XB_XCNT(j)]); sum += c; cnt += (c > 0u) ? 1u : 0u; mine = (j == x) ? c : mine; }
        if (sum == G) break;
        __builtin_amdgcn_s_sleep(1);
        if ((++sp & 255u) == 0u) { if (xb_ld(&bar[XB_TMO])) break; if (sp > XB_SPIN_CAP) { atomicAdd(&bar[XB_TMO], 1u); break; } }
    }
    nloc = mine > 0u ? mine : 1u; nx = cnt > 0u ? cnt : 1u;
}
__device__ __forceinline__ void xcd_barrier(const XcdBarrier& b) {
    asm volatile("s_waitcnt vmcnt(0)" ::: "memory");
    __syncthreads();
    if (threadIdx.x == 0) {
        unsigned* bar = b.bar;
        __builtin_amdgcn_s_waitcnt(0);
        unsigned nloc = b.st[0], nx = b.st[1];
        if (nloc == 0u) { xcd_barrier_complete(bar, b.x, nloc, nx); b.st[0] = nloc; b.st[1] = nx; }
        const unsigned old = xb_add(&bar[XB_XSUB(b.x)], 1u);
        const unsigned gen = old / nloc;
        if (old + 1u == (gen + 1u) * nloc) {
            __builtin_amdgcn_fence(__ATOMIC_RELEASE, "agent");
            asm volatile("s_waitcnt vmcnt(0)" ::: "memory");
            const unsigned og = xb_add(&bar[XB_TOP], 1u);
            const unsigned tg = og / nx;
            if (og + 1u == (tg + 1u) * nx) xb_add(&bar[XB_TOPGEN], 1u);
            else XB_SPIN(xb_ld(&bar[XB_TOPGEN]) == tg, bar);
            __builtin_amdgcn_fence(__ATOMIC_ACQUIRE, "agent");
            xb_add(&bar[XB_XGEN(b.x)], 1u);
            asm volatile("s_waitcnt vmcnt(0)" ::: "memory");
        } else {
            XB_SPIN(xb_ld(&bar[XB_XGEN(b.x)]) == gen, bar);
            __builtin_amdgcn_fence(__ATOMIC_ACQUIRE, "agent");
            asm volatile("s_waitcnt vmcnt(0)" ::: "memory");
        }
    }
    __syncthreads();
}

constexpr int N_PHASES = 13;
#ifndef REPEAT_MASK
#define REPEAT_MASK 0
#endif
#ifndef USE_XCD_BARRIER
#define USE_XCD_BARRIER 1
#endif
__global__ void __launch_bounds__(NTHR, 2) fwd_kernel(Params p) {
    extern __shared__ __attribute__((aligned(16))) unsigned char lds_raw[];
    Ctx c; c.lds = (LAS unsigned char*)lds_raw; c.tid = threadIdx.x; c.lane = c.tid & 63; c.wid = __builtin_amdgcn_readfirstlane(c.tid >> 6);
    c.gw = blockIdx.x * NWAVES + c.wid; c.ngw = gridDim.x * NWAVES;
    unsigned char* ws = p.ws;
    const float* modv = (const float*)(ws + WS_MODV);
#if N_LAUNCH_MODE == 1
    cg::grid_group grid = cg::this_grid();
#if USE_XCD_BARRIER
    volatile LAS unsigned* xst = (volatile LAS unsigned*)(c.lds + LDS_BYTES - 16);
    if (c.tid < 4) xst[c.tid] = 0u;
    __syncthreads();
    XcdBarrier xbar = xcd_barrier_post((unsigned*)(ws + WS_CTL), xst);
    bool first_seam = true;
#define SEAM() do { if (first_seam) { grid.sync(); first_seam = false; } else xcd_barrier(xbar); } while (0)
#else
#define SEAM() grid.sync()
#endif
#else
#define SEAM() do { } while (0)
#endif
#ifdef ONLY_PHASE
#define IN(k) ((k) == ONLY_PHASE && p.ph_lo <= (k) && (k) < p.ph_hi)
#else
#define IN(k) (p.ph_lo <= (k) && (k) < p.ph_hi)
#endif
#define PHASE(k, ...) if (IN(k)) { for (int rep_ = 0; rep_ <= ((REPEAT_MASK >> (k)) & 1); ++rep_) { __VA_ARGS__; if (rep_ < ((REPEAT_MASK >> (k)) & 1)) SEAM(); } if (IN((k) + 1)) SEAM(); }
#if USE_PG8
#define GEMM2(A_, Bt_, K_, nrows1_, npn1_, nrows2_, npn2_, E_, ssq_) gemm_mfma(c.lds, A_, Bt_, K_, nrows1_, npn1_, nrows2_, npn2_, E_, ssq_)
#else
#define GEMM2(A_, Bt_, K_, nrows1_, npn1_, nrows2_, npn2_, E_, ssq_) do { gemm_simple(c.lds, A_, Bt_, K_, 0, nrows1_, npn1_, E_, ssq_); if ((nrows2_) > 0) gemm_simple(c.lds, A_, Bt_, K_, nrows1_, nrows2_, npn2_, E_, ssq_); } while (0)
#endif
#define GEMM(A_, Bt_, K_, nrows_, npn_, E_, ssq_) GEMM2(A_, Bt_, K_, nrows_, npn_, 0, 0, E_, ssq_)
    PHASE(0, phase_prep(p, c))
    PHASE(1, phase_n1(p, c))
    PHASE(2, { EpiGateUp1 E{(bf16_t*)(ws + WS_HID)};
        GEMM((const bf16_t*)(ws + WS_N1), (const bf16_t*)(ws + WS_WG1_T), D, MT, NGU / 256, E, nullptr); })
    PHASE(3, { EpiDown1 E{p.x, p.ctx, (const float*)(ws + WS_ER), (const float*)(ws + WS_EC), modv, p.out, (bf16_t*)(ws + WS_A2)};
        GEMM((const bf16_t*)(ws + WS_HID), (const bf16_t*)(ws + WS_WD1_T), DFF, MT, D / 256, E, (float*)(ws + WS_SSQ1)); })
    PHASE(4, { EpiWin E{(const float*)(ws + WS_SSQ1), (const float*)(ws + WS_SWIN), (const float*)(ws + WS_LBV), (bf16_t*)(ws + WS_V), (bf16_t*)(ws + WS_Q), (bf16_t*)(ws + WS_G), (bf16_t*)(ws + WS_HY), (bf16_t*)(ws + WS_GAB), (f16_t*)(ws + WS_LFW), (f16_t*)(ws + WS_LBW)};
        GEMM2((const bf16_t*)(ws + WS_A2), (const bf16_t*)(ws + WS_WIN_T), D, T, NIN / 256, TC, 6, E, nullptr); })
    PHASE(5, {
        { LAS float* scr = (LAS float*)(c.lds + c.wid * 8448);
          transpose_gu(p.ffn_wg + (size_t)D * DFF, 0, (bf16_t*)(ws + WS_WG2_T), scr, c.gw, c.ngw, c.lane);
          transpose_gu(p.ffn_wu + (size_t)D * DFF, 1, (bf16_t*)(ws + WS_WG2_T), scr, c.gw, c.ngw, c.lane);
          transpose_matrix(p.ffn_wd + (size_t)DFF * D, DFF, D, (bf16_t*)(ws + WS_WD2_T), scr, c.gw, c.ngw, c.lane); }
        if (USE_MFMA_HYENA) phase_hyena_mfma(p, c); else phase_hyena_simple(p, c); })
    PHASE(6, { if (USE_MFMA_HGRN) phase_hgrn_mfma(p, c); else phase_hgrn_simple(p, c); })
    PHASE(7, phase_combine(p, c))
    PHASE(8, { EpiProjA EA{(const bf16_t*)(ws + WS_GAB), (float*)(ws + WS_YTMP)}; EpiProjB EB{(const bf16_t*)(ws + WS_GAB), (const float*)(ws + WS_YTMP), (bf16_t*)(ws + WS_Y)};
        GEMM((const bf16_t*)(ws + WS_OA), (const bf16_t*)(ws + WS_WPA_T), 512, T, D / 256, EA, nullptr);
        GEMM((const bf16_t*)(ws + WS_OB), (const bf16_t*)(ws + WS_WPB_T), 512, T, D / 256, EB, nullptr); })
    PHASE(9, { EpiWout E{modv, p.out, (bf16_t*)(ws + WS_A3)};
        GEMM((const bf16_t*)(ws + WS_Y), (const bf16_t*)(ws + WS_WOUT_T), D, T, D / 256, E, (float*)(ws + WS_SSQ2)); })
    PHASE(10, { EpiGateUp2 E{(bf16_t*)(ws + WS_HID2), (const float*)(ws + WS_SSQ2), (const float*)(ws + WS_SW2)};
        GEMM((const bf16_t*)(ws + WS_A3), (const bf16_t*)(ws + WS_WG2_T), D, T, NGU / 256, E, nullptr); })
    PHASE(11, { EpiDown2 E{modv, p.out};
        GEMM((const bf16_t*)(ws + WS_HID2), (const bf16_t*)(ws + WS_WD2_T), DFF, T, D / 256, E, (float*)(ws + WS_SSQ3)); })
    PHASE(12, phase_final(p, c))
}

extern "C" void kernel_launch(void* const* d_in, const int* in_sizes, int n_in, void* d_out, int out_size, void* d_ws, size_t ws_size, hipStream_t stream) {
    static int grid = 0;
    if (grid == 0) {
        if (n_in != 26 || in_sizes[0] != T * D || out_size != T * D || ws_size < WS_TOTAL) { fprintf(stderr, "kernel_launch: unexpected shapes (n_in %d, in0 %d, out %d, ws %zu < %zu)\n", n_in, n_in > 0 ? in_sizes[0] : -1, out_size, ws_size, (size_t)WS_TOTAL); grid = -1; return; }
        int dev = 0, cus = 0, per_cu = 0;
        (void)hipGetDevice(&dev); (void)hipDeviceGetAttribute(&cus, hipDeviceAttributeMultiprocessorCount, dev);
        if (hipFuncSetAttribute((const void*)fwd_kernel, hipFuncAttributeMaxDynamicSharedMemorySize, LDS_BYTES) != hipSuccess) { fprintf(stderr, "kernel_launch: hipFuncSetAttribute failed\n"); grid = -1; return; }
        (void)hipOccupancyMaxActiveBlocksPerMultiprocessor(&per_cu, (const void*)fwd_kernel, NTHR, LDS_BYTES);
        if (per_cu < 1) { fprintf(stderr, "kernel_launch: occupancy query says %d blocks per CU\n", per_cu); per_cu = 1; }
        (void)hipGetLastError();
        grid = cus;
    }
    if (grid < 0) return;
    Params p{};
    const float** f = (const float**)&p;
    for (int i = 0; i < 26; ++i) f[i] = (const float*)d_in[i];
    p.out = (float*)d_out; p.ws = (unsigned char*)d_ws;
#if N_LAUNCH_MODE == 1
    p.ph_lo = 0; p.ph_hi = N_PHASES;
#if USE_XCD_BARRIER
    (void)hipMemsetAsync((unsigned char*)d_ws + WS_CTL, 0, XCD_BAR_WORDS * 4, stream);
#endif
    void* args[] = {&p};
    hipError_t e = hipLaunchCooperativeKernel((const void*)fwd_kernel, dim3(grid), dim3(NTHR), args, LDS_BYTES, stream);
    if (e != hipSuccess) fprintf(stderr, "cooperative launch failed: %s (grid %d)\n", hipGetErrorString(e), grid);
#else
    for (int k = 0; k < N_PHASES; ++k) { p.ph_lo = k; p.ph_hi = k + 1; hipLaunchKernelGGL(fwd_kernel, dim3(grid), dim3(NTHR), LDS_BYTES, stream, p); }
#endif
}
```

```cpp
#include <hip/hip_runtime.h>
#include <hip/hip_cooperative_groups.h>
#include <cstdio>
namespace cg = cooperative_groups;

#ifndef N_LAUNCH_MODE
#define N_LAUNCH_MODE 1
#endif
#ifndef USE_MFMA_HYENA
#define USE_MFMA_HYENA 1
#endif
#ifndef USE_MFMA_HGRN
#define USE_MFMA_HGRN 1
#endif
#ifndef USE_PG8
#define USE_PG8 1
#endif

#define LAS __attribute__((address_space(3)))
typedef unsigned short bf16_t;
typedef _Float16 f16_t;
typedef float f32x4 __attribute__((ext_vector_type(4)));
typedef unsigned u32x4 __attribute__((ext_vector_type(4)));
typedef unsigned u32x2 __attribute__((ext_vector_type(2)));

constexpr int D = 1024, NB = 16, SEQ = 2048, T = NB * SEQ, CL = 256, TC = NB * CL, MT = T + TC;
constexpr int DFF = 2816, NGU = 2 * DFF, NIN = 6144, MODW = 9 * D;
constexpr int AKW = 512, AVW = 512, BW = 512, NHY = 3 * BW;
constexpr int KR_LEN = 4128, KR_OFF = 2056;
constexpr float RMS_EPS = 1e-6f;
constexpr int NTHR = 512, NWAVES = 8;
constexpr int LDS_BYTES = 152 * 1024;

constexpr size_t MiB = 1024 * 1024;
constexpr size_t al256(size_t x) { return (x + 255) & ~(size_t)255; }
constexpr size_t WS_CTL = 0;
constexpr size_t WS_MODV = WS_CTL + 65536;
constexpr size_t WS_SWIN = WS_MODV + al256((size_t)17 * MODW * 4);
constexpr size_t WS_SW2 = WS_SWIN + al256((size_t)17 * NIN * 4);
constexpr size_t WS_ER = WS_SW2 + al256((size_t)17 * NGU * 4);
constexpr size_t WS_EC = WS_ER + 32 * 512 * 4;
constexpr size_t WS_LBV = WS_EC + 64 * 512 * 4;
constexpr size_t WS_H2 = WS_LBV + 4096;
constexpr size_t WS_KREV = WS_H2 + 2048 * 64 * 4;
constexpr size_t WS_WIN_T = WS_KREV + al256((size_t)2 * 512 * KR_LEN * 2);
constexpr size_t WS_WPA_T = WS_WIN_T + (size_t)NIN * D * 2;
constexpr size_t WS_WPB_T = WS_WPA_T + (size_t)D * 512 * 2;
constexpr size_t WS_WOUT_T = WS_WPB_T + (size_t)D * 512 * 2;
constexpr size_t WS_PERSIST_END = WS_WOUT_T + (size_t)D * D * 2;
constexpr size_t AR = 27 * MiB;
static_assert(WS_PERSIST_END <= AR, "persistent region");
constexpr size_t WS_HID = AR + 0 * MiB;
constexpr size_t WS_N1 = AR + 198 * MiB;
constexpr size_t WS_WG1_T = AR + 270 * MiB;
constexpr size_t WS_WD1_T = AR + 281 * MiB;
constexpr size_t WS_SSQ1 = AR + 410 * MiB;
constexpr size_t WS_A2 = AR + 413 * MiB;
constexpr size_t WS_GAB = AR + 0 * MiB;
constexpr size_t WS_V = AR + 128 * MiB;
constexpr size_t WS_LFW = AR + 164 * MiB;
constexpr size_t WS_LBW = AR + 200 * MiB;
constexpr size_t WS_Q = AR + 236 * MiB;
constexpr size_t WS_G = AR + 268 * MiB;
constexpr size_t WS_HY = AR + 300 * MiB;
constexpr size_t WS_WG2_T = AR + 436 * MiB;
constexpr size_t WS_WD2_T = AR + 447 * MiB;
constexpr size_t WS_ZB = AR + 453 * MiB;
constexpr size_t WS_OFW = AR + 300 * MiB;
constexpr size_t WS_OBW = AR + 364 * MiB;
constexpr size_t WS_OA = AR + 128 * MiB;
constexpr size_t WS_OB = AR + 160 * MiB;
constexpr size_t WS_YTMP = AR + 192 * MiB;
constexpr size_t WS_Y = AR + 320 * MiB;
constexpr size_t WS_A3 = AR + 0 * MiB;
constexpr size_t WS_SSQ2 = AR + 64 * MiB;
constexpr size_t WS_SSQ3 = AR + 66 * MiB;
constexpr size_t WS_HID2 = AR + 128 * MiB;
constexpr size_t WS_TOTAL = AR + 485 * MiB;

struct Params {
    const float *x, *c, *ctx, *c_ctx, *mod_w, *mod_b, *ffn_wg, *ffn_wu, *ffn_wd, *w_in, *lb_logits, *a_norm_w, *conv_w, *conv_b;
    const float *hw1, *hb1, *hfr1, *hw2, *hb2, *hfr2, *hw3, *hy_bias, *w_pa, *w_pb, *w_out, *fnw;
    float* out; unsigned char* ws;
    int ph_lo, ph_hi;
};

__device__ __forceinline__ float bf2f(bf16_t b) { return __uint_as_float(((unsigned)b) << 16); }
__device__ __forceinline__ bf16_t f2bf(float f) { unsigned u = __float_as_uint(f); u += 0x7FFFu + ((u >> 16) & 1u); return (bf16_t)(u >> 16); }
__device__ __forceinline__ unsigned pk2(float lo, float hi) { return (unsigned)f2bf(lo) | ((unsigned)f2bf(hi) << 16); }
__device__ __forceinline__ float bfround(float f) { return bf2f(f2bf(f)); }
__device__ __forceinline__ float sigmoidf_(float x) { return __builtin_amdgcn_rcpf(1.0f + __builtin_amdgcn_exp2f(x * -1.4426950408889634f)); }
__device__ __forceinline__ float siluf_(float x) { return x * sigmoidf_(x); }
__device__ __forceinline__ float wave_sum(float v) {
#pragma unroll
    for (int o = 1; o < 64; o <<= 1) v += __shfl_xor(v, o);
    return v;
}
__device__ __forceinline__ float pos_embed(const float* er, const float* ec, int t, int col) {
    return col < 512 ? er[(t >> 6) * 512 + col] : ec[(t & 63) * 512 + (col - 512)];
}
__device__ __forceinline__ float rstd_from_ssq(const float* ssq16) {
    const f32x4* s = (const f32x4*)ssq16; float tot = 0.f;
#pragma unroll
    for (int i = 0; i < 4; ++i) { const f32x4 v = s[i]; tot += (v[0] + v[1]) + (v[2] + v[3]); }
    return __builtin_amdgcn_rsqf(tot * (1.0f / D) + RMS_EPS);
}

__device__ __forceinline__ void transpose_item(const float* W, int K, int N, bf16_t* WT, int k0, int n0, int dst_row0, LAS float* scr, int lane) {
#pragma unroll 8
    for (int i = 0; i < 32; ++i) { const int kk = 2 * i + (lane >> 5); scr[kk * 33 + (lane & 31)] = W[(size_t)(k0 + kk) * N + n0 + (lane & 31)]; }
    asm volatile("s_waitcnt lgkmcnt(0)" ::: "memory");
    const int c = lane & 7;
#pragma unroll
    for (int j = 0; j < 4; ++j) { const int n = (lane >> 3) + 8 * j; const LAS float* s = scr + (8 * c) * 33 + n;
        u32x4 o; o.x = pk2(s[0 * 33], s[1 * 33]); o.y = pk2(s[2 * 33], s[3 * 33]); o.z = pk2(s[4 * 33], s[5 * 33]); o.w = pk2(s[6 * 33], s[7 * 33]);
        *(u32x4*)(WT + (size_t)(dst_row0 + n) * K + k0 + 8 * c) = o; }
    asm volatile("s_waitcnt lgkmcnt(0)" ::: "memory");
}
__device__ __forceinline__ void transpose_matrix(const float* W, int K, int N, bf16_t* WT, LAS float* scr, int gw, int ngw, int lane) {
    const int nblk = N / 32, items = (K / 64) * nblk;
    for (int it = gw; it < items; it += ngw) { const int kb = it / nblk, nb = it % nblk; transpose_item(W, K, N, WT, 64 * kb, 32 * nb, 32 * nb, scr, lane); }
}
__device__ __forceinline__ void transpose_gu(const float* W, int half, bf16_t* WT, LAS float* scr, int gw, int ngw, int lane) {
    const int nblk = DFF / 32, items = (D / 64) * nblk;
    for (int it = gw; it < items; it += ngw) { const int kb = it / nblk, nb = it % nblk, n0 = 32 * nb;
        transpose_item(W, D, DFF, WT, 64 * kb, n0, 256 * (n0 >> 7) + 128 * half + (n0 & 127), scr, lane); }
}

template <bool GU>
__device__ __forceinline__ void gemv17(const LAS float* xs, LAS float* part, const float* W, int N, const float* bias, float* out, int ldo, int half, int blk0, int nblk_stride) {
    const int tid = threadIdx.x, wid = tid >> 6, lane = tid & 63;
    for (int cb = blk0; cb < N / 64; cb += nblk_stride) {
        const int n = cb * 64 + lane;
        float acc[17];
#pragma unroll
        for (int r = 0; r < 17; ++r) acc[r] = 0.f;
        const float* wp = W + (size_t)(wid * 128) * N + n;
#pragma unroll 4
        for (int k = 0; k < 128; ++k) { const float w = wp[(size_t)k * N];
#pragma unroll
            for (int r = 0; r < 17; ++r) acc[r] += xs[r * 1024 + wid * 128 + k] * w; }
#pragma unroll
        for (int r = 0; r < 17; ++r) part[(wid * 17 + r) * 64 + lane] = acc[r];
        __syncthreads();
        for (int o = tid; o < 17 * 64; o += NTHR) { const int r = o >> 6, l = o & 63; float s = 0.f;
#pragma unroll
            for (int w = 0; w < 8; ++w) s += part[(w * 17 + r) * 64 + l];
            const int nn = cb * 64 + l; if (bias) s += bias[nn];
            const int on = GU ? (256 * (nn >> 7) + 128 * half + (nn & 127)) : nn;
            out[(size_t)r * ldo + on] = s; }
        __syncthreads();
    }
}

__device__ __forceinline__ void store_bf16x8(bf16_t* p, const float (&v)[8]) { u32x4 w; w.x = pk2(v[0], v[1]); w.y = pk2(v[2], v[3]); w.z = pk2(v[4], v[5]); w.w = pk2(v[6], v[7]); *(u32x4*)p = w; }
__device__ __forceinline__ void load_f32x8(const float* p, float (&v)[8]) { const f32x4 a = *(const f32x4*)p, b = *(const f32x4*)(p + 4); v[0] = a[0]; v[1] = a[1]; v[2] = a[2]; v[3] = a[3]; v[4] = b[0]; v[5] = b[1]; v[6] = b[2]; v[7] = b[3]; }
__device__ __forceinline__ void store_f32x8(float* p, const float (&v)[8]) { *(f32x4*)p = (f32x4){v[0], v[1], v[2], v[3]}; *(f32x4*)(p + 4) = (f32x4){v[4], v[5], v[6], v[7]}; }
__device__ __forceinline__ void load_bf16x8(const bf16_t* p, float (&v)[8]) { const u32x4 w = *(const u32x4*)p; v[0] = __uint_as_float(w.x << 16); v[1] = __uint_as_float(w.x & 0xffff0000u); v[2] = __uint_as_float(w.y << 16); v[3] = __uint_as_float(w.y & 0xffff0000u);
    v[4] = __uint_as_float(w.z << 16); v[5] = __uint_as_float(w.z & 0xffff0000u); v[6] = __uint_as_float(w.w << 16); v[7] = __uint_as_float(w.w & 0xffff0000u); }

struct EpiGateUp1 {
    bf16_t* hid;
    __device__ __forceinline__ float apply(int row, int pn, int c, const float (&v0)[8], const float (&v1)[8]) const {
        float o[8];
#pragma unroll
        for (int j = 0; j < 8; ++j) o[j] = siluf_(v0[j]) * v1[j];
        store_bf16x8(hid + (size_t)row * DFF + 128 * pn + c, o); return 0.f; }
};
struct EpiGateUp2 {
    bf16_t* hid; const float* ssq; const float* sw;
    __device__ __forceinline__ float apply(int row, int pn, int c, const float (&v0)[8], const float (&v1)[8]) const {
        const float rs = rstd_from_ssq(ssq + (size_t)row * 16); const int b = row >> 11;
        float s0[8], s1[8], o[8]; load_f32x8(sw + (size_t)b * NGU + 256 * pn + c, s0); load_f32x8(sw + (size_t)b * NGU + 256 * pn + 128 + c, s1);
#pragma unroll
        for (int j = 0; j < 8; ++j) o[j] = siluf_(rs * v0[j] + s0[j]) * (rs * v1[j] + s1[j]);
        store_bf16x8(hid + (size_t)row * DFF + 128 * pn + c, o); return 0.f; }
};
struct EpiDown1 {
    const float *x, *ctx, *er, *ec, *modv; float* hout; bf16_t* a2;
    __device__ __forceinline__ float half_(int row, int col, const float (&v)[8]) const {
        const bool lat = row < T; const int b = lat ? (row >> 11) : 16, t = row & (SEQ - 1);
        float base[8], m2[8], m4[8], h[8], a[8];
        if (lat) { float pe[8]; load_f32x8(x + (size_t)row * D + col, base); load_f32x8(col < 512 ? er + (t >> 6) * 512 + col : ec + (t & 63) * 512 + (col - 512), pe);
#pragma unroll
            for (int j = 0; j < 8; ++j) base[j] += pe[j]; }
        else load_f32x8(ctx + (size_t)(row - T) * D + col, base);
        load_f32x8(modv + (size_t)b * MODW + 2 * D + col, m2); load_f32x8(modv + (size_t)b * MODW + 4 * D + col, m4);
        float s = 0.f;
#pragma unroll
        for (int j = 0; j < 8; ++j) { h[j] = base[j] + 0.5f * m2[j] * v[j]; s += h[j] * h[j]; a[j] = h[j] * (1.0f + m4[j]); }
        if (lat) store_f32x8(hout + (size_t)row * D + col, h);
        store_bf16x8(a2 + (size_t)row * D + col, a); return s; }
    __device__ __forceinline__ float apply(int row, int pn, int c, const float (&v0)[8], const float (&v1)[8]) const { return half_(row, 256 * pn + c, v0) + half_(row, 256 * pn + 128 + c, v1); }
};
struct EpiWin {
    const float *ssq, *sw, *lbv; bf16_t *v, *q, *g, *hy, *gab; f16_t *lfw, *lbw;
    __device__ __forceinline__ void half_(int row, int n, float rs, int b, const float (&a)[8]) const {
        float s[8], p[8]; load_f32x8(sw + (size_t)b * NIN + n, s);
#pragma unroll
        for (int j = 0; j < 8; ++j) p[j] = rs * a[j] + s[j];
        const int grp = n >> 9;
        if (grp == 0) { store_bf16x8(v + (size_t)row * 512 + n, p); }
        else if (grp <= 2) { const int nn = n - 512 * grp; f16_t* dst = (grp == 1 ? lfw : lbw) + (size_t)row * 512 + nn; f16_t o[8];
#pragma unroll
            for (int j = 0; j < 8; ++j) { const float lb = lbv[(grp - 1) * 512 + nn + j]; const float f = lb + (1.0f - lb) * sigmoidf_(p[j]); o[j] = (f16_t)(__builtin_amdgcn_logf(f) * 0.6931471805599453f); }
            *(u32x4*)dst = *(const u32x4*)o; }
        else if (grp == 3) {
#pragma unroll
            for (int j = 0; j < 8; ++j) p[j] = siluf_(p[j]);
            store_bf16x8(q + (size_t)row * 512 + (n - 1536), p); }
        else if (grp == 4) {
#pragma unroll
            for (int j = 0; j < 8; ++j) p[j] = siluf_(p[j]);
            store_bf16x8(g + (size_t)row * 512 + (n - 2048), p); }
        else if (grp <= 7) { const int ch = n - 2560, t = row & (SEQ - 1); store_bf16x8(hy + (((size_t)(ch >> 3) * NB + b) * SEQ + t) * 8, p); }
        else {
#pragma unroll
            for (int j = 0; j < 8; ++j) p[j] = sigmoidf_(p[j]);
            store_bf16x8(gab + (size_t)row * 2048 + (n - 4096), p); }
    }
    __device__ __forceinline__ float apply(int row, int pn, int c, const float (&v0)[8], const float (&v1)[8]) const {
        const float rs = rstd_from_ssq(ssq + (size_t)row * 16); const int b = row < T ? (row >> 11) : 16;
        half_(row, 256 * pn + c, rs, b, v0); half_(row, 256 * pn + 128 + c, rs, b, v1); return 0.f; }
};
struct EpiProjA {
    const bf16_t* gab; float* ytmp;
    __device__ __forceinline__ void half_(int row, int col, const float (&a)[8]) const { float gt[8], o[8]; load_bf16x8(gab + (size_t)row * 2048 + col, gt);
#pragma unroll
        for (int j = 0; j < 8; ++j) o[j] = gt[j] * a[j];
        store_f32x8(ytmp + (size_t)row * D + col, o); }
    __device__ __forceinline__ float apply(int row, int pn, int c, const float (&v0)[8], const float (&v1)[8]) const { half_(row, 256 * pn + c, v0); half_(row, 256 * pn + 128 + c, v1); return 0.f; }
};
struct EpiProjB {
    const bf16_t* gab; const float* ytmp; bf16_t* y;
    __device__ __forceinline__ void half_(int row, int col, const float (&a)[8]) const { float gt[8], yt[8], o[8]; load_bf16x8(gab + (size_t)row * 2048 + 1024 + col, gt); load_f32x8(ytmp + (size_t)row * D + col, yt);
#pragma unroll
        for (int j = 0; j < 8; ++j) o[j] = yt[j] + gt[j] * a[j];
        store_bf16x8(y + (size_t)row * D + col, o); }
    __device__ __forceinline__ float apply(int row, int pn, int c, const float (&v0)[8], const float (&v1)[8]) const { half_(row, 256 * pn + c, v0); half_(row, 256 * pn + 128 + c, v1); return 0.f; }
};
struct EpiWout {
    const float* modv; float* h; bf16_t* a3;
    __device__ __forceinline__ float half_(int row, int col, const float (&v)[8]) const {
        const int b = row >> 11; float base[8], m5[8], m7[8], a[8];
        load_f32x8(h + (size_t)row * D + col, base); load_f32x8(modv + (size_t)b * MODW + 5 * D + col, m5); load_f32x8(modv + (size_t)b * MODW + 7 * D + col, m7);
        float s = 0.f;
#pragma unroll
        for (int j = 0; j < 8; ++j) { base[j] += m5[j] * v[j]; s += base[j] * base[j]; a[j] = base[j] * (1.0f + m7[j]); }
        store_f32x8(h + (size_t)row * D + col, base); store_bf16x8(a3 + (size_t)row * D + col, a); return s; }
    __device__ __forceinline__ float apply(int row, int pn, int c, const float (&v0)[8], const float (&v1)[8]) const { return half_(row, 256 * pn + c, v0) + half_(row, 256 * pn + 128 + c, v1); }
};
struct EpiDown2 {
    const float* modv; float* h;
    __device__ __forceinline__ float half_(int row, int col, const float (&v)[8]) const {
        const int b = row >> 11; float base[8], m8[8];
        load_f32x8(h + (size_t)row * D + col, base); load_f32x8(modv + (size_t)b * MODW + 8 * D + col, m8);
        float s = 0.f;
#pragma unroll
        for (int j = 0; j < 8; ++j) { base[j] += 0.5f * m8[j] * v[j]; s += base[j] * base[j]; }
        store_f32x8(h + (size_t)row * D + col, base); return s; }
    __device__ __forceinline__ float apply(int row, int pn, int c, const float (&v0)[8], const float (&v1)[8]) const { return half_(row, 256 * pn + c, v0) + half_(row, 256 * pn + 128 + c, v1); }
};

template <class Epi>
__device__ __forceinline__ void gemm_simple(LAS unsigned char* lds, const bf16_t* A, const bf16_t* Bt, int K, int row0, int nrows, int npn, const Epi& E, float* ssq) {
    LAS float* As = (LAS float*)lds;
    LAS float* Bs = (LAS float*)(lds + 8192);
    const int tid = threadIdx.x, c8 = tid & 15, rg = tid >> 4;
    const int nrt = nrows / 64, nunits = nrt * npn;
    for (int unit = blockIdx.x; unit < nunits; unit += gridDim.x) {
        const int rt = unit / npn, pn = unit % npn, r0 = row0 + rt * 64;
        float a0[2][8], a1[2][8];
#pragma unroll
        for (int r = 0; r < 2; ++r)
#pragma unroll
            for (int j = 0; j < 8; ++j) { a0[r][j] = 0.f; a1[r][j] = 0.f; }
        for (int k0 = 0; k0 < K; k0 += 32) {
            { const int row = tid >> 3, kq = tid & 7; const u32x2 w = *(const u32x2*)(A + (size_t)(r0 + row) * K + k0 + 4 * kq);
              As[(4 * kq + 0) * 64 + row] = __uint_as_float(w.x << 16); As[(4 * kq + 1) * 64 + row] = __uint_as_float(w.x & 0xffff0000u);
              As[(4 * kq + 2) * 64 + row] = __uint_as_float(w.y << 16); As[(4 * kq + 3) * 64 + row] = __uint_as_float(w.y & 0xffff0000u); }
            { const int n = tid >> 1, kh = tid & 1; const bf16_t* src = Bt + (size_t)(pn * 256 + n) * K + k0 + 16 * kh; float t8[8];
              load_bf16x8(src, t8);
#pragma unroll
              for (int i = 0; i < 8; ++i) Bs[(16 * kh + i) * 256 + n] = t8[i];
              load_bf16x8(src + 8, t8);
#pragma unroll
              for (int i = 0; i < 8; ++i) Bs[(16 * kh + 8 + i) * 256 + n] = t8[i]; }
            __syncthreads();
#pragma unroll 8
            for (int k = 0; k < 32; ++k) {
                const float x0 = As[k * 64 + 2 * rg], x1 = As[k * 64 + 2 * rg + 1];
                const f32x4 b00 = *(const LAS f32x4*)(Bs + k * 256 + 8 * c8), b01 = *(const LAS f32x4*)(Bs + k * 256 + 8 * c8 + 4);
                const f32x4 b10 = *(const LAS f32x4*)(Bs + k * 256 + 128 + 8 * c8), b11 = *(const LAS f32x4*)(Bs + k * 256 + 128 + 8 * c8 + 4);
#pragma unroll
                for (int j = 0; j < 4; ++j) { a0[0][j] += x0 * b00[j]; a0[0][4 + j] += x0 * b01[j]; a1[0][j] += x0 * b10[j]; a1[0][4 + j] += x0 * b11[j];
                                              a0[1][j] += x1 * b00[j]; a0[1][4 + j] += x1 * b01[j]; a1[1][j] += x1 * b10[j]; a1[1][4 + j] += x1 * b11[j]; }
            }
            __syncthreads();
        }
#pragma unroll
        for (int r = 0; r < 2; ++r) { const int row = r0 + 2 * rg + r; float s = E.apply(row, pn, 8 * c8, a0[r], a1[r]);
            s += __shfl_xor(s, 1); s += __shfl_xor(s, 2); s += __shfl_xor(s, 4); s += __shfl_xor(s, 8);
            if (ssq && c8 == 0) *(f32x4*)(ssq + (size_t)row * 16 + pn * 4) = (f32x4){s, 0.f, 0.f, 0.f}; }
    }
}

namespace pg8 {
#define PG8_LAS __attribute__((address_space(3)))
typedef unsigned short bf16_t;
typedef short bf16x8 __attribute__((ext_vector_type(8)));
typedef float f32x4 __attribute__((ext_vector_type(4)));
typedef unsigned u32x4 __attribute__((ext_vector_type(4)));
constexpr int BM = 256, BK = 64, HALF = 128, HTB = HALF * BK * 2  , STAGE_BYTES = 8 * HTB, NXCD = 8, WGM = 8;

__host__ __device__ __forceinline__ int lds_byte(int r, int c) { const int st = (r >> 4) * 2 + (c >> 5), rr = r & 15, cc = c & 31, ob = rr * 64 + cc * 2; return st * 1024 + (ob ^ (((ob >> 9) & 1) << 5)); }
__host__ __device__ __forceinline__ void stage_rc(int b, int& R, int& C) { const int st = b / 1024, sb = b % 1024, swz = sb ^ (((sb >> 9) & 1) << 5); R = (st >> 1) * 16 + swz / 64; C = (st & 1) * 32 + (swz % 64) / 2; }
__host__ __device__ __forceinline__ int perm32(int rho) { const int n = rho >> 4, i = rho & 15; return 8 * (i >> 2) + 4 * n + (i & 3); }

struct Unit { int pm, pn; };
struct Gemm { const bf16_t* A; const bf16_t* Bt; int M, N, K; };

struct StaticOrder {
    int nM, nN, nwg, G, c;
    __host__ __device__ void init(int M, int N, int G_, int c_) { nM = M / BM; nN = N / BM; nwg = nM * nN; G = G_; c = c_; }
    __host__ __device__ bool next(int i, Unit& u) const {
        const long L = (long)i * G + c; if (L >= nwg) return false;
        int wgid = (int)L; { const int q = nwg / NXCD, r = nwg % NXCD, xcd = wgid % NXCD, off = wgid / NXCD; wgid = (xcd < r ? xcd * (q + 1) : r * (q + 1) + (xcd - r) * q) + off; }
        const int nig = WGM * nN, gid = wgid / nig, fm = gid * WGM, gsz = (nM - fm) < WGM ? (nM - fm) : WGM;
        u.pm = fm + ((wgid % nig) % gsz); u.pn = (wgid % nig) / gsz; return true;
    }
    __device__ __forceinline__ void a_ready(const Unit&) const {}
    __device__ __forceinline__ void done(const Unit&) const {}
};
template <class Epi, class Sched>
__device__ __forceinline__ void gemm_phase(PG8_LAS unsigned char* lds, const Gemm g, const Sched& S, const Epi& E) {
    const int tid = threadIdx.x, wid = __builtin_amdgcn_readfirstlane(tid >> 6), lane = tid & 63, wr = wid >> 2, wc = wid & 3, fr = lane & 15, fq = lane >> 4;
    const int K = g.K, nt = K / BK;
    unsigned voffA[2], voffB[2];
#pragma unroll
    for (int i = 0; i < 2; ++i) { int R, C; stage_rc(tid * 16 + i * 8192, R, C); const int Rb = Epi::PERM ? ((R & ~31) + perm32(R & 31)) : R;
        voffA[i] = (unsigned)(R * K + C) * 2u; voffB[i] = (unsigned)(Rb * K + C) * 2u; }
    const size_t kstep = (size_t)(BK * 2);
    const size_t hstep = (size_t)HALF * K * 2;
    const size_t tstep = 2 * hstep;
    const unsigned ldsw = (unsigned)wid * 1024u;
    const int aoff = lds_byte(wr * 64 + fr, fq * 8), boff = lds_byte(wc * 32 + fr, fq * 8);
#define PG8_SA(b, h) (((b) * 2 + (h)) * HTB)
#define PG8_SB(b, h) ((4 + (b) * 2 + (h)) * HTB)
#define PG8_STAGE(bufoff, gbase, voff) do { _Pragma("unroll") for (int _i = 0; _i < 2; ++_i) \
        __builtin_amdgcn_global_load_lds((const unsigned*)((const char*)(gbase) + (voff)[_i]), (PG8_LAS unsigned*)(lds + (bufoff) + ldsw + _i * 8192), 16, 0, 0); } while (0)
#define PG8_LDA(dst, b, h) do { _Pragma("unroll") for (int m = 0; m < 4; ++m) _Pragma("unroll") for (int k = 0; k < 2; ++k) dst[m][k] = *(const PG8_LAS bf16x8*)(lds + PG8_SA(b, h) + aoff + m * 2048 + k * 1024); } while (0)
#define PG8_LDB(dst, b, h) do { _Pragma("unroll") for (int n = 0; n < 2; ++n) _Pragma("unroll") for (int k = 0; k < 2; ++k) dst[n][k] = *(const PG8_LAS bf16x8*)(lds + PG8_SB(b, h) + boff + n * 2048 + k * 1024); } while (0)
#define PG8_MMA(ai, bj, At, Bt) do { __builtin_amdgcn_s_setprio(1); _Pragma("unroll") for (int m = 0; m < 4; ++m) _Pragma("unroll") for (int n = 0; n < 2; ++n) _Pragma("unroll") for (int k = 0; k < 2; ++k) \
        acc[ai][bj][m][n] = __builtin_amdgcn_mfma_f32_16x16x32_bf16(Bt[n][k], At[m][k], acc[ai][bj][m][n], 0, 0, 0); __builtin_amdgcn_s_setprio(0); } while (0)
#define PG8_WAIT_V(n) asm volatile("s_waitcnt vmcnt(" #n ")" ::: "memory")
#define PG8_WAIT_L(n) asm volatile("s_waitcnt lgkmcnt(" #n ")" ::: "memory")
#define PG8_BAR __builtin_amdgcn_s_barrier()
#define PG8_SCHED __builtin_amdgcn_sched_barrier(0)
    Unit cur, nxt; int ui = 0;
    if (!S.next(0, cur)) return;
    f32x4 acc[2][2][4][2];
#pragma unroll
    for (int a = 0; a < 2; ++a)
#pragma unroll
        for (int b = 0; b < 2; ++b)
#pragma unroll
            for (int m = 0; m < 4; ++m)
#pragma unroll
                for (int n = 0; n < 2; ++n) acc[a][b][m][n] = (f32x4){0.f, 0.f, 0.f, 0.f};
    bf16x8 At[4][2], B0[2][2], B1[2][2];
    const char* cA = (const char*)g.A + (size_t)cur.pm * tstep; const char* cB = (const char*)g.Bt + (size_t)cur.pn * tstep;
    S.a_ready(cur);
    PG8_STAGE(PG8_SB(0, 0), cB, voffB); PG8_STAGE(PG8_SA(0, 0), cA, voffA); PG8_STAGE(PG8_SB(0, 1), cB + hstep, voffB); PG8_STAGE(PG8_SA(0, 1), cA + hstep, voffA);
    if (wr == 1) PG8_BAR;
    PG8_WAIT_V(4); PG8_BAR;
    PG8_STAGE(PG8_SB(1, 0), cB + kstep, voffB); PG8_STAGE(PG8_SA(1, 0), cA + kstep, voffA); PG8_STAGE(PG8_SB(1, 1), cB + hstep + kstep, voffB);
    PG8_WAIT_V(6); PG8_BAR;
    for (;;) {
        const bool has_next = S.next(ui + 1, nxt);
        const char* nA = has_next ? (const char*)g.A + (size_t)nxt.pm * tstep : cA; const char* nB = has_next ? (const char*)g.Bt + (size_t)nxt.pn * tstep : cB;
        for (int t = 0; t < nt; t += 2) {
            const bool last = (t == nt - 2);
            const char* a1 = cA + (size_t)(t + 1) * kstep;
            const char* a2 = last ? nA : cA + (size_t)(t + 2) * kstep; const char* b2 = last ? nB : cB + (size_t)(t + 2) * kstep;
            const char* a3 = a2 + kstep; const char* b3 = b2 + kstep;
            if (last && has_next) S.a_ready(nxt);
            PG8_LDB(B0, 0, 0); PG8_SCHED; PG8_LDA(At, 0, 0); PG8_STAGE(PG8_SA(1, 1), a1 + hstep, voffA);
            PG8_WAIT_L(8); PG8_BAR; PG8_WAIT_L(0); PG8_MMA(0, 0, At, B0); PG8_BAR; PG8_SCHED;
            PG8_LDB(B1, 0, 1); PG8_STAGE(PG8_SB(0, 0), b2, voffB);
            PG8_BAR; PG8_WAIT_L(0); PG8_MMA(0, 1, At, B1); PG8_BAR;
            PG8_LDA(At, 0, 1); PG8_STAGE(PG8_SA(0, 0), a2, voffA);
            PG8_BAR; PG8_WAIT_L(0); PG8_MMA(1, 0, At, B0); PG8_BAR; PG8_SCHED;
            PG8_STAGE(PG8_SB(0, 1), b2 + hstep, voffB);
            PG8_WAIT_V(6); PG8_BAR; PG8_MMA(1, 1, At, B1); PG8_BAR;
            PG8_LDB(B0, 1, 0); PG8_SCHED; PG8_LDA(At, 1, 0); PG8_STAGE(PG8_SA(0, 1), a2 + hstep, voffA);
            PG8_WAIT_L(8); PG8_BAR; PG8_WAIT_L(0); PG8_MMA(0, 0, At, B0); PG8_BAR; PG8_SCHED;
            PG8_LDB(B1, 1, 1); PG8_STAGE(PG8_SB(1, 0), b3, voffB);
            PG8_BAR; PG8_WAIT_L(0); PG8_MMA(0, 1, At, B1); PG8_BAR;
            PG8_LDA(At, 1, 1); PG8_STAGE(PG8_SA(1, 0), a3, voffA);
            PG8_BAR; PG8_WAIT_L(0); PG8_MMA(1, 0, At, B0); PG8_BAR; PG8_SCHED;
            PG8_STAGE(PG8_SB(1, 1), b3 + hstep, voffB);
            PG8_WAIT_V(6); PG8_BAR; PG8_MMA(1, 1, At, B1); PG8_BAR;
        }
        if constexpr (!Epi::AFTER_DRAIN) { E(acc, cur, wr, wc, fr, fq); S.done(cur); }
        if (!has_next) break;
#pragma unroll
        for (int a = 0; a < 2; ++a)
#pragma unroll
            for (int b = 0; b < 2; ++b)
#pragma unroll
                for (int m = 0; m < 4; ++m)
#pragma unroll
                    for (int n = 0; n < 2; ++n) acc[a][b][m][n] = (f32x4){0.f, 0.f, 0.f, 0.f};
        cur = nxt; cA = nA; cB = nB; ++ui;
    }
    PG8_WAIT_V(0);
    if (wr == 0) PG8_BAR;
    PG8_BAR;
    if constexpr (Epi::AFTER_DRAIN) { E.fused(acc, cur, wr, wc, fr, fq, lds, wid, lane); S.done(cur); }
#undef PG8_SA
#undef PG8_SB
#undef PG8_STAGE
#undef PG8_LDA
#undef PG8_LDB
#undef PG8_MMA
#undef PG8_WAIT_V
#undef PG8_WAIT_L
#undef PG8_BAR
#undef PG8_SCHED
}
}

template <class F> struct EpiAd {
    static constexpr bool PERM = true, AFTER_DRAIN = false;
    F f; float* ssq;
    __device__ __forceinline__ void operator()(const pg8::f32x4 (&acc)[2][2][4][2], const pg8::Unit& u, int wr, int wc, int fr, int fq) const {
#pragma unroll
        for (int ai = 0; ai < 2; ++ai)
#pragma unroll
            for (int m = 0; m < 4; ++m) { const int row = u.pm * 256 + ai * 128 + wr * 64 + m * 16 + fr;
                float v0[8], v1[8];
#pragma unroll
                for (int n = 0; n < 2; ++n)
#pragma unroll
                    for (int e = 0; e < 4; ++e) { v0[4 * n + e] = acc[ai][0][m][n][e]; v1[4 * n + e] = acc[ai][1][m][n][e]; }
                float s = f.apply(row, u.pn, wc * 32 + 8 * fq, v0, v1);
                if (ssq) { s += __shfl_xor(s, 16); s += __shfl_xor(s, 32); if (fq == 0) ssq[(size_t)row * 16 + u.pn * 4 + wc] = s; } }
    }
};
struct TwoPartOrder {
    pg8::StaticOrder s1; int n1, nM1, nM2, n2, G, c;
    __device__ void init(int nM1_, int nN1, int nM2_, int nN2, int G_, int c_) { s1.init(nM1_ * 256, nN1 * 256, G_, c_); n1 = nM1_ * nN1; nM1 = nM1_; nM2 = nM2_; n2 = nM2_ * nN2; G = G_; c = c_; }
    __device__ bool next(int i, pg8::Unit& u) const { long L = (long)i * G + c; if (L < n1) return s1.next(i, u); L -= n1; if (L >= n2) return false; u.pm = nM1 + (int)(L % nM2); u.pn = (int)(L / nM2); return true; }
    __device__ __forceinline__ void a_ready(const pg8::Unit&) const {}
    __device__ __forceinline__ void done(const pg8::Unit&) const {}
};
template <class F>
__device__ __forceinline__ void gemm_mfma(LAS unsigned char* lds, const bf16_t* A, const bf16_t* Bt, int K, int nrows1, int npn1, int nrows2, int npn2, const F& f, float* ssq) {
    __syncthreads();
    pg8::Gemm g{A, Bt, nrows1 + nrows2, npn1 * 256, K}; TwoPartOrder S; S.init(nrows1 / 256, npn1, nrows2 / 256, npn2, (int)gridDim.x, (int)blockIdx.x);
    EpiAd<F> E{f, ssq};
    pg8::gemm_phase(lds, g, S, E);
    __syncthreads();
}

struct Ctx { LAS unsigned char* lds; int tid, lane, wid, gw, ngw; };

__device__ __forceinline__ void phase_prep(const Params& p, const Ctx& c) {
    unsigned char* ws = p.ws;
    LAS float* scr = (LAS float*)(c.lds + c.wid * 8448);
    transpose_matrix(p.w_in, D, NIN, (bf16_t*)(ws + WS_WIN_T), scr, c.gw, c.ngw, c.lane);
    transpose_matrix(p.w_pa, 512, D, (bf16_t*)(ws + WS_WPA_T), scr, c.gw, c.ngw, c.lane);
    transpose_matrix(p.w_pb, 512, D, (bf16_t*)(ws + WS_WPB_T), scr, c.gw, c.ngw, c.lane);
    transpose_matrix(p.w_out, D, D, (bf16_t*)(ws + WS_WOUT_T), scr, c.gw, c.ngw, c.lane);
    transpose_gu(p.ffn_wg, 0, (bf16_t*)(ws + WS_WG1_T), scr, c.gw, c.ngw, c.lane);
    transpose_gu(p.ffn_wu, 1, (bf16_t*)(ws + WS_WG1_T), scr, c.gw, c.ngw, c.lane);
    transpose_matrix(p.ffn_wd, DFF, D, (bf16_t*)(ws + WS_WD1_T), scr, c.gw, c.ngw, c.lane);
    __syncthreads();
    if ((int)blockIdx.x < MODW / 64) {
        LAS float* xs = (LAS float*)c.lds; LAS float* part = (LAS float*)(c.lds + 17 * 1024 * 4);
        for (int i = c.tid; i < 17 * 1024; i += NTHR) { const int r = i >> 10, k = i & 1023; const float v = r < 16 ? p.c[r * D + k] : p.c_ctx[k]; xs[i] = v / (1.0f + expf(-v)); }
        __syncthreads();
        gemv17<false>(xs, part, p.mod_w, MODW, p.mod_b, (float*)(ws + WS_MODV), MODW, 0, blockIdx.x, gridDim.x);
    }
    { float* er = (float*)(ws + WS_ER); float* ec = (float*)(ws + WS_EC); float* lbv = (float*)(ws + WS_LBV);
      const int gt = blockIdx.x * NTHR + c.tid, ngt = gridDim.x * NTHR;
      for (int i = gt; i < 96 * 512; i += ngt) { const int r = i >> 9, j = i & 511, jj = j & 255; const float omega = 1.0f / powf(10000.0f, (float)jj / 256.0f);
          const int pos = r < 32 ? r : r - 32; const float a = (float)pos * omega; const float v = j < 256 ? sinf(a) : cosf(a);
          if (r < 32) er[r * 512 + j] = v; else ec[(r - 32) * 512 + j] = v; }
      for (int i = gt; i < 1024; i += ngt) { const float l0 = p.lb_logits[i], l1 = p.lb_logits[1024 + i]; lbv[i] = 1.0f / (1.0f + expf(l1 - l0)); } }
    { LAS float* zf = (LAS float*)c.lds; LAS float* h1 = zf + 8 * 40; float* h2o = (float*)(ws + WS_H2);
      for (int it = blockIdx.x; it < SEQ / 8; it += gridDim.x) {
          __syncthreads();
          if (c.tid < 8 * 33) { const int r = c.tid / 33, f = c.tid % 33; const int pp = it * 8 + r; float v;
              if (f == 0) v = (float)pp / (float)(SEQ - 1);
              else { const int i = (f - 1) & 15; const float w = 6.283185307179586f * (float)pp / (float)SEQ; const float fr = 1e-4f + (float)i * ((15.0f - 1e-4f) / 15.0f); const float ang = w * fr; v = f <= 16 ? cosf(ang) : -sinf(ang); }
              zf[r * 40 + f] = v; }
          __syncthreads();
          { const int r = c.tid >> 6, j = c.tid & 63; float s = p.hb1[j];
            for (int f = 0; f < 33; ++f) s += zf[r * 40 + f] * p.hw1[f * 64 + j];
            h1[r * 64 + j] = sinf(p.hfr1[j] * s); }
          __syncthreads();
          { const int r = c.tid >> 6, j = c.tid & 63; float s = p.hb2[j];
            for (int k = 0; k < 64; ++k) s += h1[r * 64 + k] * p.hw2[k * 64 + j];
            h2o[(size_t)(it * 8 + r) * 64 + j] = sinf(p.hfr2[j] * s); }
      } }
}

__device__ __forceinline__ void phase_n1(const Params& p, const Ctx& c) {
    unsigned char* ws = p.ws;
    const float* modv = (const float*)(ws + WS_MODV); const float* er = (const float*)(ws + WS_ER); const float* ec = (const float*)(ws + WS_EC);
    bf16_t* n1 = (bf16_t*)(ws + WS_N1);
    for (int row = c.gw; row < MT; row += c.ngw) {
        const bool lat = row < T; const int b = lat ? (row >> 11) : 16, t = row & (SEQ - 1);
        const float* src = lat ? p.x + (size_t)row * D : p.ctx + (size_t)(row - T) * D;
        f32x4 v[4]; float s = 0.f;
#pragma unroll
        for (int j = 0; j < 4; ++j) { const int col = 4 * c.lane + 256 * j; v[j] = *(const f32x4*)(src + col);
            if (lat) { const float* pe = col < 512 ? er + (t >> 6) * 512 + col : ec + (t & 63) * 512 + (col - 512); v[j] += *(const f32x4*)pe; }
            s += (v[j][0] * v[j][0] + v[j][1] * v[j][1]) + (v[j][2] * v[j][2] + v[j][3] * v[j][3]); }
        const float rs = 1.0f / sqrtf(wave_sum(s) * (1.0f / D) + RMS_EPS);
#pragma unroll
        for (int j = 0; j < 4; ++j) { const int col = 4 * c.lane + 256 * j; const f32x4 sh = *(const f32x4*)(modv + (size_t)b * MODW + col), sc = *(const f32x4*)(modv + (size_t)b * MODW + D + col);
            const f32x4 o = v[j] * rs * (sc + 1.0f) + sh; u32x2 w; w.x = pk2(o[0], o[1]); w.y = pk2(o[2], o[3]); *(u32x2*)(n1 + (size_t)row * D + col) = w; }
    }
    { LAS float* xs = (LAS float*)c.lds; LAS float* part = (LAS float*)(c.lds + 17 * 1024 * 4);
      const int nb_in = NIN / 64, nb_g = DFF / 64;
      for (int bx = blockIdx.x; bx < nb_in + 2 * nb_g; bx += gridDim.x) {
          __syncthreads();
          if (bx < nb_in) {
              for (int i = c.tid; i < 17 * 1024; i += NTHR) xs[i] = modv[(size_t)(i >> 10) * MODW + 3 * D + (i & 1023)];
              __syncthreads();
              gemv17<false>(xs, part, p.w_in, NIN, nullptr, (float*)(ws + WS_SWIN), NIN, 0, bx, nb_in); }
          else { const int half = (bx - nb_in) / nb_g, blk = (bx - nb_in) % nb_g;
              for (int i = c.tid; i < 17 * 1024; i += NTHR) xs[i] = modv[(size_t)(i >> 10) * MODW + 6 * D + (i & 1023)];
              __syncthreads();
              const float* W = (half ? p.ffn_wu : p.ffn_wg) + (size_t)D * DFF;
              gemv17<true>(xs, part, W, DFF, nullptr, (float*)(ws + WS_SW2), NGU, half, blk, nb_g); }
      }
    }
    { LAS float* w3s = (LAS float*)c.lds;
      LAS float* hk = w3s + 512;
      LAS float* red = hk + 2048 * 8;
      const float* h2 = (const float*)(ws + WS_H2); bf16_t* krev = (bf16_t*)(ws + WS_KREV);
      for (int it = blockIdx.x; it < 256; it += gridDim.x) {
          const int c0 = 2 * it;
          __syncthreads();
          { const int k = c.tid >> 3, q = c.tid & 7; w3s[c.tid] = p.hw3[(size_t)k * 2048 + (q >> 2) * 1024 + ((q >> 1) & 1) * 512 + c0 + (q & 1)]; }
          __syncthreads();
          float l1[4] = {0.f, 0.f, 0.f, 0.f};
          for (int idx = c.tid; idx < 2048 * 8; idx += NTHR) { const int t = idx >> 3, q = idx & 7; float s = 0.f;
              const float* hr = h2 + (size_t)t * 64;
#pragma unroll 8
              for (int k = 0; k < 64; ++k) s += hr[k] * w3s[k * 8 + q];
              const int ch = c0 + (q & 1); const float delta = fabsf(-3.0701134573253945f + (float)ch * ((-15.350567286626973f + 3.0701134573253945f) / 511.0f));
              const float tn = (float)t / (float)(SEQ - 1); s *= expf(-tn * delta) + 0.05f;
              hk[idx] = s; l1[0] += fabsf(s); }
          { float s = l1[0]; s += __shfl_xor(s, 2); s += __shfl_xor(s, 8); s += __shfl_xor(s, 16); s += __shfl_xor(s, 32);
            if ((c.lane & ~5) == 0) red[c.wid * 4 + ((c.lane >> 2) & 1) * 2 + (c.lane & 1)] = s; }
          __syncthreads();
          for (int e = c.tid; e < 4 * KR_LEN; e += NTHR) { const int oc = e / KR_LEN, i = (e % KR_LEN) - KR_OFF, o = oc >> 1, cc = oc & 1;
              float tot = 0.f;
#pragma unroll
              for (int w = 0; w < 8; ++w) tot += red[w * 4 + oc];
              const int lag = -i; float v = 0.f;
              if (lag >= 0 && lag <= SEQ - 1) v = hk[lag * 8 + o * 4 + 0 + cc]; else if (lag < 0 && lag >= -(SEQ - 1)) v = hk[(-lag - 1) * 8 + o * 4 + 2 + cc];
              krev[((size_t)o * 512 + c0 + cc) * KR_LEN + (e % KR_LEN)] = f2bf(v / (tot + 1e-6f)); }
      } }
}

__device__ __forceinline__ void phase_hgrn_simple(const Params& p, const Ctx& c) {
    unsigned char* ws = p.ws;
    const bf16_t* vb = (const bf16_t*)(ws + WS_V); const bf16_t* qb = (const bf16_t*)(ws + WS_Q);
    LAS float* F = (LAS float*)c.lds; LAS float* Kk = F + 64 * 128; LAS float* Q = Kk + 64 * 128; LAS float* V = Q + 64 * 128;
    const int dg = c.tid & 3, e = c.tid >> 2;
    for (int it = blockIdx.x; it < NB * 4 * 2; it += gridDim.x) {
        const int dir = it & 1, h = (it >> 1) & 3, b = it >> 3;
        const f16_t* lf = (const f16_t*)(ws + (dir ? WS_LBW : WS_LFW)); float* outp = (float*)(ws + (dir ? WS_OBW : WS_OFW));
        float S[32];
#pragma unroll
        for (int i = 0; i < 32; ++i) S[i] = 0.f;
        for (int ci = 0; ci < 36; ++ci) {
            const bool lat = ci >= 4;
            __syncthreads();
            for (int idx = c.tid; idx < 64 * 128; idx += NTHR) { const int j = idx >> 7, d = idx & 127; const int pp = (lat ? ci - 4 : ci) * 64 + j;
                const int row = lat ? b * SEQ + (dir ? SEQ - 1 - pp : pp) : T + b * CL + (dir ? CL - 1 - pp : pp);
                const float f = __expf((float)lf[(size_t)row * 512 + h * 128 + d]);
                F[idx] = f; Kk[idx] = 1.0f - f; V[idx] = bf2f(vb[(size_t)row * 512 + h * 128 + d]); Q[idx] = lat ? bf2f(qb[(size_t)row * 512 + h * 128 + d]) : 0.f; }
            __syncthreads();
            for (int j = 0; j < 64; ++j) { const float ve = V[j * 128 + e]; float part = 0.f;
#pragma unroll
                for (int i = 0; i < 32; ++i) { const int d = dg * 32 + i; S[i] = F[j * 128 + d] * S[i] + Kk[j * 128 + d] * ve; part += S[i] * Q[j * 128 + d]; }
                part += __shfl_xor(part, 1); part += __shfl_xor(part, 2);
                if (lat && dg == 0) { const int pp = (ci - 4) * 64 + j; const int row = b * SEQ + (dir ? SEQ - 1 - pp : pp); outp[(size_t)row * 512 + h * 128 + e] = part; } }
        }
    }
}


typedef short bf16x8 __attribute__((ext_vector_type(8)));
constexpr int QROW = 136, TROW = 72;
__device__ __forceinline__ int hg_pos(int x) { return (x & ~31) + ((x >> 2) & 3) * 8 + ((x >> 4) & 1) * 4 + (x & 3); }
__device__ __forceinline__ pg8::f32x4 mfma16(bf16x8 a, bf16x8 b, pg8::f32x4 c) { return __builtin_amdgcn_mfma_f32_16x16x32_bf16(a, b, c, 0, 0, 0); }
__device__ __forceinline__ void phase_hgrn_mfma(const Params& p, const Ctx& c) {
    unsigned char* ws = p.ws;
    const bf16_t* vb = (const bf16_t*)(ws + WS_V); const bf16_t* qb = (const bf16_t*)(ws + WS_Q);
    LAS bf16_t* Qt = (LAS bf16_t*)c.lds;
    LAS bf16_t* Kt = Qt + 64 * QROW;
    LAS bf16_t* KhT = Kt + 64 * QROW;
    LAS bf16_t* VT = KhT + 128 * TROW;
    LAS bf16_t* ST0 = VT + 64 * TROW;
    LAS bf16_t* ST1 = ST0 + 64 * QROW;
    LAS float* qt = (LAS float*)(ST1 + 64 * QROW);
    LAS float* El = qt + 8 * 128;
    const int wid = c.wid, lane = c.lane, fr = lane & 15, fq = lane >> 4, dp = lane, ti = wid & 3, eh = wid >> 2;
    for (int it = blockIdx.x; it < 256; it += gridDim.x) {
        const int dvh = (it >> 3) & 1, idx = (it & 7) | ((it >> 4) << 3), dir = idx & 1, h = (idx >> 1) & 3, b = idx >> 3;
        const f16_t* lf = (const f16_t*)(ws + (dir ? WS_LBW : WS_LFW)); float* outp = (float*)(ws + (dir ? WS_OBW : WS_OFW));
        const int colq = h * 128 + 2 * dp, colv = h * 128 + dvh * 64 + (c.tid & 7) * 8, pv = c.tid >> 3;
        pg8::f32x4 S[4];
#pragma unroll
        for (int e = 0; e < 4; ++e) S[e] = (pg8::f32x4){0.f, 0.f, 0.f, 0.f};
#define HG_ROW(ci_, p_) (((ci_) >= 4) ? (b * SEQ + (dir ? SEQ - 1 - (((ci_) - 4) * 64 + (p_)) : (((ci_) - 4) * 64 + (p_)))) : (T + b * CL + (dir ? CL - 1 - ((ci_) * 64 + (p_)) : ((ci_) * 64 + (p_)))))
        unsigned lfr[8], qr[8]; u32x4 vr;
#pragma unroll
        for (int i = 0; i < 8; ++i) { const int row = HG_ROW(0, 8 * wid + i); lfr[i] = *(const unsigned*)(lf + (size_t)row * 512 + colq); qr[i] = 0u; }
        vr = *(const u32x4*)(vb + (size_t)HG_ROW(0, pv) * 512 + colv);
        __syncthreads();
        for (int ci = 0; ci < 36; ++ci) {
            const bool lat = ci >= 4;
            float l0[8], l1[8], c0[8], c1[8]; float run0 = 0.f, run1 = 0.f;
#pragma unroll
            for (int i = 0; i < 8; ++i) { const __fp16 a0 = __builtin_bit_cast(__fp16, (unsigned short)(lfr[i] & 0xffffu)), a1 = __builtin_bit_cast(__fp16, (unsigned short)(lfr[i] >> 16));
                l0[i] = (float)a0; l1[i] = (float)a1; run0 += l0[i]; run1 += l1[i]; c0[i] = run0; c1[i] = run1; }
            qt[wid * 128 + 2 * dp] = run0; qt[wid * 128 + 2 * dp + 1] = run1;
            __syncthreads();
            float off0 = 0.f, off1 = 0.f, tot0 = 0.f, tot1 = 0.f;
#pragma unroll
            for (int w = 0; w < 8; ++w) { const float a0 = qt[w * 128 + 2 * dp], a1 = qt[w * 128 + 2 * dp + 1]; tot0 += a0; tot1 += a1; if (w < wid) { off0 += a0; off1 += a1; } }
            const float E0 = __expf(tot0), E1 = __expf(tot1);
            if (wid == 0) { El[2 * dp] = E0; El[2 * dp + 1] = E1; }
            const int qpos = hg_pos(2 * dp);
            float kh0[8], kh1[8];
#pragma unroll
            for (int i = 0; i < 8; ++i) { const int pp = 8 * wid + i; const float cu0 = off0 + c0[i], cu1 = off1 + c1[i];
                const float e0 = __expf(cu0), e1 = __expf(cu1), r0 = __expf(-cu0), r1 = __expf(-cu1);
                const float k0 = (1.0f - __expf(l0[i])) * r0, k1 = (1.0f - __expf(l1[i])) * r1;
                *(LAS unsigned*)(Kt + pp * QROW + qpos) = pk2(k0, k1);
                if (lat) { const float q0 = __uint_as_float(qr[i] << 16), q1 = __uint_as_float(qr[i] & 0xffff0000u); *(LAS unsigned*)(Qt + pp * QROW + qpos) = pk2(q0 * e0, q1 * e1); }
                kh0[i] = k0 * E0; kh1[i] = k1 * E1; }
            { const int base0 = 32 * (wid >> 2) + 16 * (wid & 1) + 4 * ((wid >> 1) & 1);
              u32x2 w; w.x = pk2(kh0[0], kh0[1]); w.y = pk2(kh0[2], kh0[3]); *(LAS u32x2*)(KhT + (2 * dp) * TROW + base0) = w;
              w.x = pk2(kh0[4], kh0[5]); w.y = pk2(kh0[6], kh0[7]); *(LAS u32x2*)(KhT + (2 * dp) * TROW + base0 + 8) = w;
              w.x = pk2(kh1[0], kh1[1]); w.y = pk2(kh1[2], kh1[3]); *(LAS u32x2*)(KhT + (2 * dp + 1) * TROW + base0) = w;
              w.x = pk2(kh1[4], kh1[5]); w.y = pk2(kh1[6], kh1[7]); *(LAS u32x2*)(KhT + (2 * dp + 1) * TROW + base0 + 8) = w; }
            { const int e8 = (c.tid & 7) * 8, sp = hg_pos(pv); const unsigned wv[4] = {vr.x, vr.y, vr.z, vr.w};
#pragma unroll
              for (int j = 0; j < 4; ++j) { VT[(e8 + 2 * j) * TROW + sp] = (bf16_t)(wv[j] & 0xffffu); VT[(e8 + 2 * j + 1) * TROW + sp] = (bf16_t)(wv[j] >> 16); } }
            if (ci + 1 < 36) { const bool nlat = ci + 1 >= 4;
#pragma unroll
                for (int i = 0; i < 8; ++i) { const int row = HG_ROW(ci + 1, 8 * wid + i); lfr[i] = *(const unsigned*)(lf + (size_t)row * 512 + colq); if (nlat) qr[i] = *(const unsigned*)(qb + (size_t)row * 512 + colq); }
                vr = *(const u32x4*)(vb + (size_t)HG_ROW(ci + 1, pv) * 512 + colv); }
            __syncthreads();
            const LAS bf16_t* STr = (ci & 1) ? ST1 : ST0; LAS bf16_t* STw = (ci & 1) ? ST0 : ST1;
            bf16x8 VF[4][2];
#pragma unroll
            for (int ei = 0; ei < 4; ++ei)
#pragma unroll
                for (int a = 0; a < 2; ++a) VF[ei][a] = *(const LAS bf16x8*)(VT + (16 * ei + fr) * TROW + 32 * a + 8 * fq);
            if (lat) {
                bf16x8 QF[4];
#pragma unroll
                for (int k = 0; k < 4; ++k) QF[k] = *(const LAS bf16x8*)(Qt + (16 * ti + fr) * QROW + 32 * k + 8 * fq);
                pg8::f32x4 P[4];
#pragma unroll
                for (int si = 0; si < 4; ++si) { pg8::f32x4 acc = (pg8::f32x4){0.f, 0.f, 0.f, 0.f};
                    if (si <= ti) {
#pragma unroll
                        for (int k = 0; k < 4; ++k) acc = mfma16(*(const LAS bf16x8*)(Kt + (16 * si + fr) * QROW + 32 * k + 8 * fq), QF[k], acc);
                        if (si == ti) {
#pragma unroll
                            for (int r = 0; r < 4; ++r) acc[r] = (4 * fq + r <= fr) ? acc[r] : 0.f; } }
                    P[si] = acc; }
                bf16x8 PB[2];
#pragma unroll
                for (int a = 0; a < 2; ++a) { u32x4 w; w.x = pk2(P[2 * a][0], P[2 * a][1]); w.y = pk2(P[2 * a][2], P[2 * a][3]); w.z = pk2(P[2 * a + 1][0], P[2 * a + 1][1]); w.w = pk2(P[2 * a + 1][2], P[2 * a + 1][3]); PB[a] = __builtin_bit_cast(bf16x8, w); }
#pragma unroll
                for (int e2 = 0; e2 < 2; ++e2) { const int ei = 2 * eh + e2; pg8::f32x4 acc = (pg8::f32x4){0.f, 0.f, 0.f, 0.f};
#pragma unroll
                    for (int a = 0; a < 2; ++a) if (2 * a <= ti) acc = mfma16(*(const LAS bf16x8*)(VT + (16 * ei + fr) * TROW + 32 * a + 8 * fq), PB[a], acc);
#pragma unroll
                    for (int k = 0; k < 4; ++k) acc = mfma16(*(const LAS bf16x8*)(STr + (16 * ei + fr) * QROW + 32 * k + 8 * fq), QF[k], acc);
                    const int row = HG_ROW(ci, 16 * ti + fr);
                    *(pg8::f32x4*)(outp + (size_t)row * 512 + h * 128 + dvh * 64 + 16 * ei + 4 * fq) = acc; }
            }
            { const pg8::f32x4 dl = *(const LAS pg8::f32x4*)(El + 16 * wid + 4 * fq);
              bf16x8 KH[2];
#pragma unroll
              for (int a = 0; a < 2; ++a) KH[a] = *(const LAS bf16x8*)(KhT + (16 * wid + fr) * TROW + 32 * a + 8 * fq);
#pragma unroll
              for (int ei = 0; ei < 4; ++ei) { S[ei] = S[ei] * dl;
#pragma unroll
                  for (int a = 0; a < 2; ++a) S[ei] = mfma16(KH[a], VF[ei][a], S[ei]);
                  u32x2 w; w.x = pk2(S[ei][0], S[ei][1]); w.y = pk2(S[ei][2], S[ei][3]);
                  *(LAS u32x2*)(STw + (16 * ei + fr) * QROW + 32 * (wid >> 1) + 8 * fq + 4 * (wid & 1)) = w; } }
            __syncthreads();
        }
#undef HG_ROW
    }
}

__device__ __forceinline__ float hy_tap(const bf16_t* hy, const float* cw, const float* cb, int ch, int b, int t) {
    const bf16_t* src = hy + (((size_t)(ch >> 3) * NB + b) * SEQ) * 8 + (ch & 7); float s = cb[ch];
#pragma unroll
    for (int j = 0; j < 3; ++j) { const int tt = t + j - 1; if (tt >= 0 && tt < SEQ) s += cw[j * NHY + ch] * bf2f(src[(size_t)tt * 8]); }
    return s;
}
__device__ __forceinline__ void phase_hyena_simple(const Params& p, const Ctx& c) {
    unsigned char* ws = p.ws;
    const bf16_t* hy = (const bf16_t*)(ws + WS_HY); const bf16_t* krev = (const bf16_t*)(ws + WS_KREV); bf16_t* zb = (bf16_t*)(ws + WS_ZB);
    LAS float* zs = (LAS float*)c.lds;
    LAS float* kr = zs + 2048 * 16;
    for (int ch = blockIdx.x; ch < BW; ch += gridDim.x) {
        __syncthreads();
        for (int idx = c.tid; idx < NB * SEQ; idx += NTHR) { const int b = idx >> 11, t = idx & (SEQ - 1); zs[t * 16 + b] = bfround(hy_tap(hy, p.conv_w, p.conv_b, ch, b, t)); }
        for (int o = 0; o < 2; ++o) {
            for (int i = c.tid; i < KR_LEN; i += NTHR) kr[i] = bf2f(krev[((size_t)o * 512 + ch) * KR_LEN + i]);
            __syncthreads();
            const int t0 = 4 * c.tid;
            float acc[4][16];
#pragma unroll
            for (int r = 0; r < 4; ++r)
#pragma unroll
                for (int b = 0; b < 16; ++b) acc[r][b] = 0.f;
            float w0, w1 = kr[KR_OFF - t0 - 1], w2 = kr[KR_OFF - t0 - 2], w3 = kr[KR_OFF - t0 - 3];
            for (int s = 0; s < SEQ; ++s) {
                w0 = kr[KR_OFF + s - t0];
                const f32x4 z0 = *(const LAS f32x4*)(zs + s * 16), z1 = *(const LAS f32x4*)(zs + s * 16 + 4), z2 = *(const LAS f32x4*)(zs + s * 16 + 8), z3 = *(const LAS f32x4*)(zs + s * 16 + 12);
#pragma unroll
                for (int j = 0; j < 4; ++j) { acc[0][j] += w0 * z0[j]; acc[0][4 + j] += w0 * z1[j]; acc[0][8 + j] += w0 * z2[j]; acc[0][12 + j] += w0 * z3[j];
                                              acc[1][j] += w1 * z0[j]; acc[1][4 + j] += w1 * z1[j]; acc[1][8 + j] += w1 * z2[j]; acc[1][12 + j] += w1 * z3[j];
                                              acc[2][j] += w2 * z0[j]; acc[2][4 + j] += w2 * z1[j]; acc[2][8 + j] += w2 * z2[j]; acc[2][12 + j] += w2 * z3[j];
                                              acc[3][j] += w3 * z0[j]; acc[3][4 + j] += w3 * z1[j]; acc[3][8 + j] += w3 * z2[j]; acc[3][12 + j] += w3 * z3[j]; }
                w3 = w2; w2 = w1; w1 = w0;
            }
            const float bias = p.hy_bias[o * 512 + ch];
#pragma unroll
            for (int r = 0; r < 4; ++r)
#pragma unroll
                for (int b = 0; b < 16; ++b) acc[r][b] += bias * zs[(t0 + r) * 16 + b];
            __syncthreads();
#pragma unroll
            for (int r = 0; r < 4; ++r)
#pragma unroll
                for (int b4 = 0; b4 < 4; ++b4) *(LAS f32x4*)(zs + (t0 + r) * 16 + 4 * b4) = (f32x4){acc[r][4 * b4], acc[r][4 * b4 + 1], acc[r][4 * b4 + 2], acc[r][4 * b4 + 3]};
#pragma unroll 1
            for (int i = 0; i < 64; ++i) { const int r = i >> 4, b = i & 15, t = t0 + r; const float gate = hy_tap(hy, p.conv_w, p.conv_b, (o + 1) * 512 + ch, b, t);
                const float zn = gate * zs[t * 16 + b];
                if (o == 0) zs[t * 16 + b] = bfround(zn); else zb[((size_t)ch * NB + b) * SEQ + t] = f2bf(zn); }
            __syncthreads();
        }
    }
}


constexpr int ZROW = 2056;
__device__ __forceinline__ void hy_conv4(const bf16_t* src, int t, float w0, float w1, float w2, float cb, float (&o)[4]) {
    float x[6];
#pragma unroll
    for (int i = 0; i < 6; ++i) { const int tt = t - 1 + i; x[i] = (tt >= 0 && tt < SEQ) ? bf2f(src[(size_t)tt * 8]) : 0.f; }
#pragma unroll
    for (int r = 0; r < 4; ++r) o[r] = cb + w0 * x[r] + w1 * x[r + 1] + w2 * x[r + 2];
}
__device__ __forceinline__ void hy_fill(LAS bf16_t* dst, const bf16_t* hy, const float* cw, const float* cbv, int chx, int tid) {
    const float w0 = cw[chx], w1 = cw[NHY + chx], w2 = cw[2 * NHY + chx], cb = cbv[chx];
    for (int b = 0; b < NB; ++b) { const bf16_t* src = hy + (((size_t)(chx >> 3) * NB + b) * SEQ) * 8 + (chx & 7); float o[4];
        hy_conv4(src, 4 * tid, w0, w1, w2, cb, o);
        u32x2 w; w.x = pk2(o[0], o[1]); w.y = pk2(o[2], o[3]); *(LAS u32x2*)(dst + b * ZROW + 4 * tid) = w; }
}
template <int KIND>
__device__ __forceinline__ void hy_block(pg8::f32x4 (&acc)[16], bf16x8 (&Bw)[16], const LAS bf16_t* zl, const LAS bf16_t* krl, int ub, int i0, int lane) {
    const int fr = lane & 15, fq = lane >> 4;
    const LAS bf16_t* bbase = zl + fr * ZROW + 8 * fq;
    const int abase = KR_OFF - 16 * i0 - fr + 8 * fq;
    const unsigned sh = (unsigned)(fr & 1) * 16u;
#pragma unroll
    for (int uu = 0; uu < 16; ++uu) {
        const int u = ub + uu;
        const bool ldb = KIND == 0 ? (uu >= 1) : (KIND == 1 ? true : (uu == 0));
        if (ldb) Bw[(uu + 15) & 15] = *(const LAS bf16x8*)(bbase + 32 * (u + 15));
        const LAS unsigned* ap = (const LAS unsigned*)(krl + ((abase + 32 * u) & ~1));
        const unsigned d0 = ap[0], d1 = ap[1], d2 = ap[2], d3 = ap[3], d4 = ap[4];
        u32x4 aw; aw.x = __builtin_amdgcn_alignbit(d1, d0, sh); aw.y = __builtin_amdgcn_alignbit(d2, d1, sh); aw.z = __builtin_amdgcn_alignbit(d3, d2, sh); aw.w = __builtin_amdgcn_alignbit(d4, d3, sh);
        const bf16x8 A = __builtin_bit_cast(bf16x8, aw);
#pragma unroll
        for (int m = 0; m < 16; ++m) { const bool on = KIND == 0 ? (m >= 16 - uu) : (KIND == 1 ? true : (m <= 15 - uu));
            if (on) acc[m] = __builtin_amdgcn_mfma_f32_16x16x32_bf16(A, Bw[(uu + m) & 15], acc[m], 0, 0, 0); }
    }
}
__device__ __forceinline__ void phase_hyena_mfma(const Params& p, const Ctx& c) {
    unsigned char* ws = p.ws;
    const bf16_t* hy = (const bf16_t*)(ws + WS_HY); const bf16_t* krev = (const bf16_t*)(ws + WS_KREV); bf16_t* zb = (bf16_t*)(ws + WS_ZB);
    LAS bf16_t* zl = (LAS bf16_t*)c.lds;
    LAS bf16_t* gl = zl + NB * ZROW;
    LAS bf16_t* krl = gl + NB * ZROW;
    const int i0 = 32 * (c.wid >> 1) + (c.wid & 1), fr = c.lane & 15, fq = c.lane >> 4;
    for (int ch = blockIdx.x; ch < BW; ch += gridDim.x) {
        __syncthreads();
        hy_fill(zl, hy, p.conv_w, p.conv_b, ch, c.tid);
        for (int o = 0; o < 2; ++o) {
            hy_fill(gl, hy, p.conv_w, p.conv_b, (o + 1) * 512 + ch, c.tid);
            for (int i = c.tid; i < KR_LEN / 8; i += NTHR) *(LAS u32x4*)(krl + 8 * i) = *(const u32x4*)(krev + ((size_t)o * 512 + ch) * KR_LEN + 8 * i);
            __syncthreads();
            pg8::f32x4 acc[16]; bf16x8 Bw[16];
#pragma unroll
            for (int m = 0; m < 16; ++m) { acc[m] = (pg8::f32x4){0.f, 0.f, 0.f, 0.f}; Bw[m] = (bf16x8){0, 0, 0, 0, 0, 0, 0, 0}; }
            hy_block<0>(acc, Bw, zl, krl, -16, i0, c.lane);
            for (int ub = 0; ub < 48; ub += 16) hy_block<1>(acc, Bw, zl, krl, ub, i0, c.lane);
            hy_block<2>(acc, Bw, zl, krl, 48, i0, c.lane);
            const float bias = p.hy_bias[o * 512 + ch];
            u32x2 res[16];
#pragma unroll
            for (int m = 0; m < 16; ++m) { const int t = 16 * (i0 + 2 * m) + 4 * fq; const u32x2 zo = *(const LAS u32x2*)(zl + fr * ZROW + t), gg = *(const LAS u32x2*)(gl + fr * ZROW + t);
                const float z0 = __uint_as_float(zo.x << 16), z1 = __uint_as_float(zo.x & 0xffff0000u), z2 = __uint_as_float(zo.y << 16), z3 = __uint_as_float(zo.y & 0xffff0000u);
                const float g0 = __uint_as_float(gg.x << 16), g1 = __uint_as_float(gg.x & 0xffff0000u), g2 = __uint_as_float(gg.y << 16), g3 = __uint_as_float(gg.y & 0xffff0000u);
                res[m].x = pk2(g0 * (acc[m][0] + bias * z0), g1 * (acc[m][1] + bias * z1)); res[m].y = pk2(g2 * (acc[m][2] + bias * z2), g3 * (acc[m][3] + bias * z3)); }
            __syncthreads();
#pragma unroll
            for (int m = 0; m < 16; ++m) { const int t = 16 * (i0 + 2 * m) + 4 * fq;
                if (o == 0) *(LAS u32x2*)(zl + fr * ZROW + t) = res[m]; else *(u32x2*)(zb + ((size_t)ch * NB + fr) * SEQ + t) = res[m]; }
        }
    }
}

__device__ __forceinline__ void phase_combine(const Params& p, const Ctx& c) {
    unsigned char* ws = p.ws;
    const float* ofw = (const float*)(ws + WS_OFW); const float* obw = (const float*)(ws + WS_OBW); const bf16_t* g = (const bf16_t*)(ws + WS_G);
    bf16_t* oa = (bf16_t*)(ws + WS_OA); bf16_t* ob = (bf16_t*)(ws + WS_OB); const bf16_t* zb = (const bf16_t*)(ws + WS_ZB);
    for (int row = c.gw; row < T; row += c.ngw) { const int col = 8 * c.lane; float a[8], bq[8], gg[8], w[8], o[8];
        load_f32x8(ofw + (size_t)row * 512 + col, a); load_f32x8(obw + (size_t)row * 512 + col, bq); load_bf16x8(g + (size_t)row * 512 + col, gg); load_f32x8(p.a_norm_w + (col & 127), w);
        float s = 0.f;
#pragma unroll
        for (int j = 0; j < 8; ++j) { a[j] += bq[j]; s += a[j] * a[j]; }
        s += __shfl_xor(s, 1); s += __shfl_xor(s, 2); s += __shfl_xor(s, 4); s += __shfl_xor(s, 8);
        const float rs = 1.0f / sqrtf(s * (1.0f / 128.0f) + RMS_EPS);
#pragma unroll
        for (int j = 0; j < 8; ++j) o[j] = a[j] * rs * w[j] * gg[j];
        store_bf16x8(oa + (size_t)row * 512 + col, o); }
    LAS bf16_t* tile = (LAS bf16_t*)c.lds;
    for (int it = blockIdx.x; it < NB * 32 * 8; it += gridDim.x) { const int cb = it & 7, tb = (it >> 3) & 31, b = it >> 8;
        __syncthreads();
        { const int cl = c.tid >> 3, t8 = (c.tid & 7) * 8; const u32x4 w = *(const u32x4*)(zb + ((size_t)(cb * 64 + cl) * NB + b) * SEQ + tb * 64 + t8); *(LAS u32x4*)(tile + cl * 72 + t8) = w; }
        __syncthreads();
        { const int tl = c.tid >> 3, c8 = (c.tid & 7) * 8; bf16_t v[8];
#pragma unroll
          for (int i = 0; i < 8; ++i) v[i] = tile[(c8 + i) * 72 + tl];
          u32x4 w; w.x = v[0] | ((unsigned)v[1] << 16); w.y = v[2] | ((unsigned)v[3] << 16); w.z = v[4] | ((unsigned)v[5] << 16); w.w = v[6] | ((unsigned)v[7] << 16);
          *(u32x4*)(ob + ((size_t)b * SEQ + tb * 64 + tl) * 512 + cb * 64 + c8) = w; }
    }
}

__device__ __forceinline__ void phase_final(const Params& p, const Ctx& c) {
    const float* ssq = (const float*)(p.ws + WS_SSQ3);
    for (int row = c.gw; row < T; row += c.ngw) { const float rs = rstd_from_ssq(ssq + (size_t)row * 16);
#pragma unroll
        for (int j = 0; j < 4; ++j) { const int col = 4 * c.lane + 256 * j; f32x4* ptr = (f32x4*)(p.out + (size_t)row * D + col); *ptr = *ptr * rs * *(const f32x4*)(p.fnw + col); } }
}


#define XB_TMO      128
#define XB_XCNT(j)  (256  + 64 * (j))
#define XB_XSUB(j)  (1280 + 64 * (j))
#define XB_XGEN(j)  (2304 + 64 * (j))
#define XB_TOP      3328
#define XB_TOPGEN   3392
#define XCD_BAR_WORDS 3456
#define XB_SPIN_CAP (1u << 18)
__device__ __forceinline__ unsigned xb_ld(unsigned* p)              { return __hip_atomic_load(p, __ATOMIC_RELAXED, __HIP_MEMORY_SCOPE_AGENT); }
__device__ __forceinline__ unsigned xb_add(unsigned* p, unsigned v) { return __hip_atomic_fetch_add(p, v, __ATOMIC_RELAXED, __HIP_MEMORY_SCOPE_AGENT); }
__device__ __forceinline__ unsigned xb_xcc_id() { return (unsigned)__builtin_amdgcn_s_getreg((3 << 11) | 20) & 0xFu; }
#define XB_SPIN(cond, bar) do { unsigned _sp = 0; while (cond) { __builtin_amdgcn_s_sleep(1); \
    if ((++_sp & 255u) == 0u) { if (xb_ld(&(bar)[XB_TMO])) break; if (_sp > XB_SPIN_CAP) { atomicAdd(&(bar)[XB_TMO], 1u); break; } } } } while (0)
struct XcdBarrier { unsigned* bar; unsigned x; volatile LAS unsigned* st; };
__device__ __forceinline__ XcdBarrier xcd_barrier_post(unsigned* bar, volatile LAS unsigned* st) {
    XcdBarrier b; b.bar = bar; b.x = xb_xcc_id(); b.st = st;
    if (threadIdx.x == 0) (void)xb_add(&bar[XB_XCNT(b.x)], 1u);
    return b;
}
__device__ __forceinline__ void xcd_barrier_complete(unsigned* bar, unsigned x, unsigned& nloc, unsigned& nx) {
    const unsigned G = gridDim.x * gridDim.y * gridDim.z;
    unsigned sum, cnt, mine, sp = 0u;
    for (;;) {
        sum = 0u; cnt = 0u; mine = 0u;
#pragma unroll
        for (unsigned j = 0; j < 16; ++j) { const unsigned c = xb_ld(&bar[XB_XCNT(j)]); sum += c; cnt += (c > 0u) ? 1u : 0u; mine = (j == x) ? c : mine; }
        if (sum == G) break;
        __builtin_amdgcn_s_sleep(1);
        if ((++sp & 255u) == 0u) { if (xb_ld(&bar[XB_TMO])) break; if (sp > XB_SPIN_CAP) { atomicAdd(&bar[XB_TMO], 1u); break; } }
    }
    nloc = mine > 0u ? mine : 1u; nx = cnt > 0u ? cnt : 1u;
}
__device__ __forceinline__ void xcd_barrier(const XcdBarrier& b) {
    asm volatile("s_waitcnt vmcnt(0)" ::: "memory");
    __syncthreads();
    if (threadIdx.x == 0) {
        unsigned* bar = b.bar;
        __builtin_amdgcn_s_waitcnt(0);
        unsigned nloc = b.st[0], nx = b.st[1];
        if (nloc == 0u) { xcd_barrier_complete(bar, b.x, nloc, nx); b.st[0] = nloc; b.st[1] = nx; }
        const unsigned old = xb_add(&bar[XB_XSUB(b.x)], 1u);
        const unsigned gen = old / nloc;
        if (old + 1u == (gen + 1u) * nloc) {
            __builtin_amdgcn_fence(__ATOMIC_RELEASE, "agent");
            asm volatile("s_waitcnt vmcnt(0)" ::: "memory");
            const unsigned og = xb_add(&bar[XB_TOP], 1u);
            const unsigned tg = og / nx;
            if (og + 1u == (tg + 1u) * nx) xb_add(&bar[XB_TOPGEN], 1u);
            else XB_SPIN(xb_ld(&bar[XB_TOPGEN]) == tg, bar);
            __builtin_amdgcn_fence(__ATOMIC_ACQUIRE, "agent");
            xb_add(&bar[XB_XGEN(b.x)], 1u);
            asm volatile("s_waitcnt vmcnt(0)" ::: "memory");
        } else {
            XB_SPIN(xb_ld(&bar[XB_XGEN(b.x)]) == gen, bar);
            __builtin_amdgcn_fence(__ATOMIC_ACQUIRE, "agent");
            asm volatile("s_waitcnt vmcnt(0)" ::: "memory");
        }
    }
    __syncthreads();
}

constexpr int N_PHASES = 13;
#ifndef REPEAT_MASK
#define REPEAT_MASK 0
#endif
#ifndef HOST_REPEAT_MASK
#define HOST_REPEAT_MASK 0
#endif
#ifndef USE_XCD_BARRIER
#define USE_XCD_BARRIER 1
#endif
__global__ void __launch_bounds__(NTHR, 2) fwd_kernel(Params p) {
    extern __shared__ __attribute__((aligned(16))) unsigned char lds_raw[];
    Ctx c; c.lds = (LAS unsigned char*)lds_raw; c.tid = threadIdx.x; c.lane = c.tid & 63; c.wid = __builtin_amdgcn_readfirstlane(c.tid >> 6);
    c.gw = blockIdx.x * NWAVES + c.wid; c.ngw = gridDim.x * NWAVES;
    unsigned char* ws = p.ws;
    const float* modv = (const float*)(ws + WS_MODV);
#if N_LAUNCH_MODE == 1
    cg::grid_group grid = cg::this_grid();
#if USE_XCD_BARRIER
    volatile LAS unsigned* xst = (volatile LAS unsigned*)(c.lds + LDS_BYTES - 16);
    if (c.tid < 4) xst[c.tid] = 0u;
    __syncthreads();
    XcdBarrier xbar = xcd_barrier_post((unsigned*)(ws + WS_CTL), xst);
    bool first_seam = true;
#define SEAM() do { if (first_seam) { grid.sync(); first_seam = false; } else xcd_barrier(xbar); } while (0)
#else
#define SEAM() grid.sync()
#endif
#else
#define SEAM() do { } while (0)
#endif
#ifdef ONLY_PHASE
#define IN(k) ((k) == ONLY_PHASE && p.ph_lo <= (k) && (k) < p.ph_hi)
#else
#define IN(k) (p.ph_lo <= (k) && (k) < p.ph_hi)
#endif
#define PHASE(k, ...) if (IN(k)) { for (int rep_ = 0; rep_ <= ((REPEAT_MASK >> (k)) & 1); ++rep_) { __VA_ARGS__; if (rep_ < ((REPEAT_MASK >> (k)) & 1)) SEAM(); } if (IN((k) + 1)) SEAM(); }
#if USE_PG8
#define GEMM2(A_, Bt_, K_, nrows1_, npn1_, nrows2_, npn2_, E_, ssq_) gemm_mfma(c.lds, A_, Bt_, K_, nrows1_, npn1_, nrows2_, npn2_, E_, ssq_)
#else
#define GEMM2(A_, Bt_, K_, nrows1_, npn1_, nrows2_, npn2_, E_, ssq_) do { gemm_simple(c.lds, A_, Bt_, K_, 0, nrows1_, npn1_, E_, ssq_); if ((nrows2_) > 0) gemm_simple(c.lds, A_, Bt_, K_, nrows1_, nrows2_, npn2_, E_, ssq_); } while (0)
#endif
#define GEMM(A_, Bt_, K_, nrows_, npn_, E_, ssq_) GEMM2(A_, Bt_, K_, nrows_, npn_, 0, 0, E_, ssq_)
    PHASE(0, phase_prep(p, c))
    PHASE(1, phase_n1(p, c))
    PHASE(2, { EpiGateUp1 E{(bf16_t*)(ws + WS_HID)};
        GEMM((const bf16_t*)(ws + WS_N1), (const bf16_t*)(ws + WS_WG1_T), D, MT, NGU / 256, E, nullptr); })
    PHASE(3, { EpiDown1 E{p.x, p.ctx, (const float*)(ws + WS_ER), (const float*)(ws + WS_EC), modv, p.out, (bf16_t*)(ws + WS_A2)};
        GEMM((const bf16_t*)(ws + WS_HID), (const bf16_t*)(ws + WS_WD1_T), DFF, MT, D / 256, E, (float*)(ws + WS_SSQ1)); })
    PHASE(4, { EpiWin E{(const float*)(ws + WS_SSQ1), (const float*)(ws + WS_SWIN), (const float*)(ws + WS_LBV), (bf16_t*)(ws + WS_V), (bf16_t*)(ws + WS_Q), (bf16_t*)(ws + WS_G), (bf16_t*)(ws + WS_HY), (bf16_t*)(ws + WS_GAB), (f16_t*)(ws + WS_LFW), (f16_t*)(ws + WS_LBW)};
        GEMM2((const bf16_t*)(ws + WS_A2), (const bf16_t*)(ws + WS_WIN_T), D, T, NIN / 256, TC, 6, E, nullptr); })
    PHASE(5, {
        { LAS float* scr = (LAS float*)(c.lds + c.wid * 8448);
          transpose_gu(p.ffn_wg + (size_t)D * DFF, 0, (bf16_t*)(ws + WS_WG2_T), scr, c.gw, c.ngw, c.lane);
          transpose_gu(p.ffn_wu + (size_t)D * DFF, 1, (bf16_t*)(ws + WS_WG2_T), scr, c.gw, c.ngw, c.lane);
          transpose_matrix(p.ffn_wd + (size_t)DFF * D, DFF, D, (bf16_t*)(ws + WS_WD2_T), scr, c.gw, c.ngw, c.lane); }
        if (USE_MFMA_HYENA) phase_hyena_mfma(p, c); else phase_hyena_simple(p, c); })
    PHASE(6, { if (USE_MFMA_HGRN) phase_hgrn_mfma(p, c); else phase_hgrn_simple(p, c); })
    PHASE(7, phase_combine(p, c))
    PHASE(8, { EpiProjA EA{(const bf16_t*)(ws + WS_GAB), (float*)(ws + WS_YTMP)}; EpiProjB EB{(const bf16_t*)(ws + WS_GAB), (const float*)(ws + WS_YTMP), (bf16_t*)(ws + WS_Y)};
        GEMM((const bf16_t*)(ws + WS_OA), (const bf16_t*)(ws + WS_WPA_T), 512, T, D / 256, EA, nullptr);
        GEMM((const bf16_t*)(ws + WS_OB), (const bf16_t*)(ws + WS_WPB_T), 512, T, D / 256, EB, nullptr); })
    PHASE(9, { EpiWout E{modv, p.out, (bf16_t*)(ws + WS_A3)};
        GEMM((const bf16_t*)(ws + WS_Y), (const bf16_t*)(ws + WS_WOUT_T), D, T, D / 256, E, (float*)(ws + WS_SSQ2)); })
    PHASE(10, { EpiGateUp2 E{(bf16_t*)(ws + WS_HID2), (const float*)(ws + WS_SSQ2), (const float*)(ws + WS_SW2)};
        GEMM((const bf16_t*)(ws + WS_A3), (const bf16_t*)(ws + WS_WG2_T), D, T, NGU / 256, E, nullptr); })
    PHASE(11, { EpiDown2 E{modv, p.out};
        GEMM((const bf16_t*)(ws + WS_HID2), (const bf16_t*)(ws + WS_WD2_T), DFF, T, D / 256, E, (float*)(ws + WS_SSQ3)); })
    PHASE(12, phase_final(p, c))
}

extern "C" void kernel_launch(void* const* d_in, const int* in_sizes, int n_in, void* d_out, int out_size, void* d_ws, size_t ws_size, hipStream_t stream) {
    static int grid = 0;
    if (grid == 0) {
        if (n_in != 26 || in_sizes[0] != T * D || out_size != T * D || ws_size < WS_TOTAL) { fprintf(stderr, "kernel_launch: unexpected shapes (n_in %d, in0 %d, out %d, ws %zu < %zu)\n", n_in, n_in > 0 ? in_sizes[0] : -1, out_size, ws_size, (size_t)WS_TOTAL); grid = -1; return; }
        int dev = 0, cus = 0, per_cu = 0;
        (void)hipGetDevice(&dev); (void)hipDeviceGetAttribute(&cus, hipDeviceAttributeMultiprocessorCount, dev);
        if (hipFuncSetAttribute((const void*)fwd_kernel, hipFuncAttributeMaxDynamicSharedMemorySize, LDS_BYTES) != hipSuccess) { fprintf(stderr, "kernel_launch: hipFuncSetAttribute failed\n"); grid = -1; return; }
        (void)hipOccupancyMaxActiveBlocksPerMultiprocessor(&per_cu, (const void*)fwd_kernel, NTHR, LDS_BYTES);
        if (per_cu < 1) { fprintf(stderr, "kernel_launch: occupancy query says %d blocks per CU\n", per_cu); per_cu = 1; }
        (void)hipGetLastError();
        grid = cus;
    }
    if (grid < 0) return;
    Params p{};
    const float** f = (const float**)&p;
    for (int i = 0; i < 26; ++i) f[i] = (const float*)d_in[i];
    p.out = (float*)d_out; p.ws = (unsigned char*)d_ws;
#if N_LAUNCH_MODE == 1
    p.ph_lo = 0; p.ph_hi = N_PHASES;
#if USE_XCD_BARRIER
    (void)hipMemsetAsync((unsigned char*)d_ws + WS_CTL, 0, XCD_BAR_WORDS * 4, stream);
#endif
    void* args[] = {&p};
    hipError_t e = hipLaunchCooperativeKernel((const void*)fwd_kernel, dim3(grid), dim3(NTHR), args, LDS_BYTES, stream);
    if (e != hipSuccess) fprintf(stderr, "cooperative launch failed: %s (grid %d)\n", hipGetErrorString(e), grid);
#else
    for (int k = 0; k < N_PHASES; ++k) { p.ph_lo = k; p.ph_hi = k + 1; for (int r = 0; r <= ((HOST_REPEAT_MASK >> k) & 1); ++r) hipLaunchKernelGGL(fwd_kernel, dim3(grid), dim3(NTHR), LDS_BYTES, stream, p); }
#endif
}
```

```cpp
#include <hip/hip_runtime.h>
#include <hip/hip_cooperative_groups.h>
#include <cstdio>
namespace cg = cooperative_groups;

#ifndef N_LAUNCH_MODE
#define N_LAUNCH_MODE 1
#endif
#ifndef USE_MFMA_HYENA
#define USE_MFMA_HYENA 1
#endif
#ifndef USE_MFMA_HGRN
#define USE_MFMA_HGRN 1
#endif
#ifndef USE_PG8
#define USE_PG8 1
#endif

#define LAS __attribute__((address_space(3)))
typedef unsigned short bf16_t;
typedef _Float16 f16_t;
typedef float f32x4 __attribute__((ext_vector_type(4)));
typedef unsigned u32x4 __attribute__((ext_vector_type(4)));
typedef unsigned u32x2 __attribute__((ext_vector_type(2)));

constexpr int D = 1024, NB = 16, SEQ = 2048, T = NB * SEQ, CL = 256, TC = NB * CL, MT = T + TC;
constexpr int DFF = 2816, NGU = 2 * DFF, NIN = 6144, MODW = 9 * D;
constexpr int AKW = 512, AVW = 512, BW = 512, NHY = 3 * BW;
constexpr int KR_LEN = 4128, KR_OFF = 2056;
constexpr float RMS_EPS = 1e-6f;
constexpr int NTHR = 512, NWAVES = 8;
constexpr int LDS_BYTES = 152 * 1024;

constexpr size_t MiB = 1024 * 1024;
constexpr size_t al256(size_t x) { return (x + 255) & ~(size_t)255; }
constexpr size_t WS_CTL = 0;
constexpr size_t WS_MODV = WS_CTL + 65536;
constexpr size_t WS_SWIN = WS_MODV + al256((size_t)17 * MODW * 4);
constexpr size_t WS_SW2 = WS_SWIN + al256((size_t)17 * NIN * 4);
constexpr size_t WS_ER = WS_SW2 + al256((size_t)17 * NGU * 4);
constexpr size_t WS_EC = WS_ER + 32 * 512 * 4;
constexpr size_t WS_LBV = WS_EC + 64 * 512 * 4;
constexpr size_t WS_H2 = WS_LBV + 4096;
constexpr size_t WS_KREV = WS_H2 + 2048 * 64 * 4;
constexpr size_t WS_WIN_T = WS_KREV + al256((size_t)2 * 512 * KR_LEN * 2);
constexpr size_t WS_WPA_T = WS_WIN_T + (size_t)NIN * D * 2;
constexpr size_t WS_WPB_T = WS_WPA_T + (size_t)D * 512 * 2;
constexpr size_t WS_WOUT_T = WS_WPB_T + (size_t)D * 512 * 2;
constexpr size_t WS_RSTD1 = WS_WOUT_T + (size_t)D * D * 2;
constexpr size_t WS_RSTD2 = WS_RSTD1 + (size_t)MT * 4;
constexpr size_t WS_PERSIST_END = WS_RSTD2 + (size_t)T * 4;
constexpr size_t AR = 27 * MiB;
static_assert(WS_PERSIST_END <= AR, "persistent region");
constexpr size_t WS_HID = AR + 0 * MiB;
constexpr size_t WS_N1 = AR + 198 * MiB;
constexpr size_t WS_WG1_T = AR + 270 * MiB;
constexpr size_t WS_WD1_T = AR + 281 * MiB;
constexpr size_t WS_SSQ1 = AR + 410 * MiB;
constexpr size_t WS_A2 = AR + 413 * MiB;
constexpr size_t WS_GAB = AR + 0 * MiB;
constexpr size_t WS_V = AR + 128 * MiB;
constexpr size_t WS_LFW = AR + 164 * MiB;
constexpr size_t WS_LBW = AR + 200 * MiB;
constexpr size_t WS_Q = AR + 236 * MiB;
constexpr size_t WS_G = AR + 268 * MiB;
constexpr size_t WS_HY = AR + 300 * MiB;
constexpr size_t WS_WG2_T = AR + 436 * MiB;
constexpr size_t WS_WD2_T = AR + 447 * MiB;
constexpr size_t WS_ZB = AR + 453 * MiB;
constexpr size_t WS_OFW = AR + 300 * MiB;
constexpr size_t WS_OBW = AR + 364 * MiB;
constexpr size_t WS_OA = AR + 128 * MiB;
constexpr size_t WS_OB = AR + 160 * MiB;
constexpr size_t WS_YTMP = AR + 192 * MiB;
constexpr size_t WS_Y = AR + 320 * MiB;
constexpr size_t WS_A3 = AR + 0 * MiB;
constexpr size_t WS_SSQ2 = AR + 64 * MiB;
constexpr size_t WS_SSQ3 = AR + 66 * MiB;
constexpr size_t WS_HID2 = AR + 128 * MiB;
constexpr size_t WS_TOTAL = AR + 485 * MiB;

struct Params {
    const float *x, *c, *ctx, *c_ctx, *mod_w, *mod_b, *ffn_wg, *ffn_wu, *ffn_wd, *w_in, *lb_logits, *a_norm_w, *conv_w, *conv_b;
    const float *hw1, *hb1, *hfr1, *hw2, *hb2, *hfr2, *hw3, *hy_bias, *w_pa, *w_pb, *w_out, *fnw;
    float* out; unsigned char* ws;
    int ph_lo, ph_hi;
};

__device__ __forceinline__ float bf2f(bf16_t b) { return __uint_as_float(((unsigned)b) << 16); }
__device__ __forceinline__ bf16_t f2bf(float f) { unsigned u = __float_as_uint(f); u += 0x7FFFu + ((u >> 16) & 1u); return (bf16_t)(u >> 16); }
__device__ __forceinline__ unsigned pk2(float lo, float hi) { return (unsigned)f2bf(lo) | ((unsigned)f2bf(hi) << 16); }
__device__ __forceinline__ float bfround(float f) { return bf2f(f2bf(f)); }
__device__ __forceinline__ float sigmoidf_(float x) { return __builtin_amdgcn_rcpf(1.0f + __builtin_amdgcn_exp2f(x * -1.4426950408889634f)); }
__device__ __forceinline__ float siluf_(float x) { return x * sigmoidf_(x); }
__device__ __forceinline__ float wave_sum(float v) {
#pragma unroll
    for (int o = 1; o < 64; o <<= 1) v += __shfl_xor(v, o);
    return v;
}
__device__ __forceinline__ float pos_embed(const float* er, const float* ec, int t, int col) {
    return col < 512 ? er[(t >> 6) * 512 + col] : ec[(t & 63) * 512 + (col - 512)];
}
__device__ __forceinline__ float rstd_from_ssq(const float* ssq16) {
    const f32x4* s = (const f32x4*)ssq16; float tot = 0.f;
#pragma unroll
    for (int i = 0; i < 4; ++i) { const f32x4 v = s[i]; tot += (v[0] + v[1]) + (v[2] + v[3]); }
    return __builtin_amdgcn_rsqf(tot * (1.0f / D) + RMS_EPS);
}

__device__ __forceinline__ void transpose_item(const float* W, int K, int N, bf16_t* WT, int k0, int n0, int dst_row0, LAS float* scr, int lane) {
#pragma unroll 8
    for (int i = 0; i < 32; ++i) { const int kk = 2 * i + (lane >> 5); scr[kk * 33 + (lane & 31)] = W[(size_t)(k0 + kk) * N + n0 + (lane & 31)]; }
    asm volatile("s_waitcnt lgkmcnt(0)" ::: "memory");
    const int c = lane & 7;
#pragma unroll
    for (int j = 0; j < 4; ++j) { const int n = (lane >> 3) + 8 * j; const LAS float* s = scr + (8 * c) * 33 + n;
        u32x4 o; o.x = pk2(s[0 * 33], s[1 * 33]); o.y = pk2(s[2 * 33], s[3 * 33]); o.z = pk2(s[4 * 33], s[5 * 33]); o.w = pk2(s[6 * 33], s[7 * 33]);
        *(u32x4*)(WT + (size_t)(dst_row0 + n) * K + k0 + 8 * c) = o; }
    asm volatile("s_waitcnt lgkmcnt(0)" ::: "memory");
}
__device__ __forceinline__ void transpose_matrix(const float* W, int K, int N, bf16_t* WT, LAS float* scr, int gw, int ngw, int lane) {
    const int nblk = N / 32, items = (K / 64) * nblk;
    for (int it = gw; it < items; it += ngw) { const int kb = it / nblk, nb = it % nblk; transpose_item(W, K, N, WT, 64 * kb, 32 * nb, 32 * nb, scr, lane); }
}
__device__ __forceinline__ void transpose_gu(const float* W, int half, bf16_t* WT, LAS float* scr, int gw, int ngw, int lane) {
    const int nblk = DFF / 32, items = (D / 64) * nblk;
    for (int it = gw; it < items; it += ngw) { const int kb = it / nblk, nb = it % nblk, n0 = 32 * nb;
        transpose_item(W, D, DFF, WT, 64 * kb, n0, 256 * (n0 >> 7) + 128 * half + (n0 & 127), scr, lane); }
}

template <bool GU>
__device__ __forceinline__ void gemv17(const LAS float* xs, LAS float* part, const float* W, int N, const float* bias, float* out, int ldo, int half, int blk0, int nblk_stride) {
    const int tid = threadIdx.x, wid = tid >> 6, lane = tid & 63;
    for (int cb = blk0; cb < N / 64; cb += nblk_stride) {
        const int n = cb * 64 + lane;
        float acc[17];
#pragma unroll
        for (int r = 0; r < 17; ++r) acc[r] = 0.f;
        const float* wp = W + (size_t)(wid * 128) * N + n;
#pragma unroll 4
        for (int k = 0; k < 128; ++k) { const float w = wp[(size_t)k * N];
#pragma unroll
            for (int r = 0; r < 17; ++r) acc[r] += xs[r * 1024 + wid * 128 + k] * w; }
#pragma unroll
        for (int r = 0; r < 17; ++r) part[(wid * 17 + r) * 64 + lane] = acc[r];
        __syncthreads();
        for (int o = tid; o < 17 * 64; o += NTHR) { const int r = o >> 6, l = o & 63; float s = 0.f;
#pragma unroll
            for (int w = 0; w < 8; ++w) s += part[(w * 17 + r) * 64 + l];
            const int nn = cb * 64 + l; if (bias) s += bias[nn];
            const int on = GU ? (256 * (nn >> 7) + 128 * half + (nn & 127)) : nn;
            out[(size_t)r * ldo + on] = s; }
        __syncthreads();
    }
}

__device__ __forceinline__ void store_bf16x8(bf16_t* p, const float (&v)[8]) { u32x4 w; w.x = pk2(v[0], v[1]); w.y = pk2(v[2], v[3]); w.z = pk2(v[4], v[5]); w.w = pk2(v[6], v[7]); *(u32x4*)p = w; }
__device__ __forceinline__ void load_f32x8(const float* p, float (&v)[8]) { const f32x4 a = *(const f32x4*)p, b = *(const f32x4*)(p + 4); v[0] = a[0]; v[1] = a[1]; v[2] = a[2]; v[3] = a[3]; v[4] = b[0]; v[5] = b[1]; v[6] = b[2]; v[7] = b[3]; }
__device__ __forceinline__ void store_f32x8(float* p, const float (&v)[8]) { *(f32x4*)p = (f32x4){v[0], v[1], v[2], v[3]}; *(f32x4*)(p + 4) = (f32x4){v[4], v[5], v[6], v[7]}; }
__device__ __forceinline__ void unpack_bf16x8(const u32x4 w, float (&v)[8]) { v[0] = __uint_as_float(w.x << 16); v[1] = __uint_as_float(w.x & 0xffff0000u); v[2] = __uint_as_float(w.y << 16); v[3] = __uint_as_float(w.y & 0xffff0000u);
    v[4] = __uint_as_float(w.z << 16); v[5] = __uint_as_float(w.z & 0xffff0000u); v[6] = __uint_as_float(w.w << 16); v[7] = __uint_as_float(w.w & 0xffff0000u); }
__device__ __forceinline__ void load_bf16x8(const bf16_t* p, float (&v)[8]) { const u32x4 w = *(const u32x4*)p; v[0] = __uint_as_float(w.x << 16); v[1] = __uint_as_float(w.x & 0xffff0000u); v[2] = __uint_as_float(w.y << 16); v[3] = __uint_as_float(w.y & 0xffff0000u);
    v[4] = __uint_as_float(w.z << 16); v[5] = __uint_as_float(w.z & 0xffff0000u); v[6] = __uint_as_float(w.w << 16); v[7] = __uint_as_float(w.w & 0xffff0000u); }

struct EpiGateUp1 {
    static constexpr int PD = 1;
    struct Cols {}; struct Row {};
    bf16_t* hid;
    __device__ __forceinline__ void load_cols(Cols&, int, int, int) const {}
    __device__ __forceinline__ void load_row(Row&, int, int, int) const {}
    __device__ __forceinline__ float finish(int row, int pn, int c, const float (&v0)[8], const float (&v1)[8], const Cols&, const Row&) const {
        float o[8];
#pragma unroll
        for (int j = 0; j < 8; ++j) o[j] = siluf_(v0[j]) * v1[j];
        store_bf16x8(hid + (size_t)row * DFF + 128 * pn + c, o); return 0.f; }
};
struct EpiGateUp2 {
    static constexpr int PD = 8;
    struct Cols { float s0[8], s1[8]; }; struct Row { float rs; };
    bf16_t* hid; const float* rstd; const float* sw;
    __device__ __forceinline__ void load_cols(Cols& k, int pm, int pn, int c) const { const int b = pm >> 3; load_f32x8(sw + (size_t)b * NGU + 256 * pn + c, k.s0); load_f32x8(sw + (size_t)b * NGU + 256 * pn + 128 + c, k.s1); }
    __device__ __forceinline__ void load_row(Row& r, int row, int, int) const { r.rs = rstd[row]; }
    __device__ __forceinline__ float finish(int row, int pn, int c, const float (&v0)[8], const float (&v1)[8], const Cols& k, const Row& r) const {
        float o[8];
#pragma unroll
        for (int j = 0; j < 8; ++j) o[j] = siluf_(r.rs * v0[j] + k.s0[j]) * (r.rs * v1[j] + k.s1[j]);
        store_bf16x8(hid + (size_t)row * DFF + 128 * pn + c, o); return 0.f; }
};
struct EpiDown1 {
    static constexpr int PD = 2;
    struct Cols { float g0[8], g1[8], s0[8], s1[8]; }; struct Row { float b0[8], b1[8]; };
    const float *ctx, *modv; float* h; bf16_t* a2;
    __device__ __forceinline__ void load_cols(Cols& k, int pm, int pn, int c) const { const int b = pm < T / 256 ? (pm >> 3) : 16; const float* m = modv + (size_t)b * MODW + 256 * pn + c;
        load_f32x8(m + 2 * D, k.g0); load_f32x8(m + 2 * D + 128, k.g1); load_f32x8(m + 4 * D, k.s0); load_f32x8(m + 4 * D + 128, k.s1); }
    __device__ __forceinline__ void load_row(Row& r, int row, int pn, int c) const { const float* src = (row < T ? h + (size_t)row * D : ctx + (size_t)(row - T) * D) + 256 * pn + c; load_f32x8(src, r.b0); load_f32x8(src + 128, r.b1); }
    __device__ __forceinline__ float finish(int row, int pn, int c, const float (&v0)[8], const float (&v1)[8], const Cols& k, const Row& r) const {
        float h0[8], h1[8], a0[8], a1[8]; float s = 0.f;
#pragma unroll
        for (int j = 0; j < 8; ++j) { h0[j] = r.b0[j] + 0.5f * k.g0[j] * v0[j]; h1[j] = r.b1[j] + 0.5f * k.g1[j] * v1[j]; s += h0[j] * h0[j] + h1[j] * h1[j]; a0[j] = h0[j] * (1.0f + k.s0[j]); a1[j] = h1[j] * (1.0f + k.s1[j]); }
        const size_t o = (size_t)row * D + 256 * pn + c;
        if (row < T) { store_f32x8(h + o, h0); store_f32x8(h + o + 128, h1); }
        store_bf16x8(a2 + o, a0); store_bf16x8(a2 + o + 128, a1); return s; }
};
struct EpiWin {
    static constexpr int PD = 8;
    struct Cols { float s0[8], s1[8], l0[8], l1[8]; }; struct Row { float rs; };
    const float *rstd, *sw, *lbv; bf16_t *v, *q, *g, *hy, *gab; f16_t *lfw, *lbw;
    __device__ __forceinline__ void load_cols(Cols& k, int pm, int pn, int c) const { const int b = pm < T / 256 ? (pm >> 3) : 16; const int n = 256 * pn + c;
        load_f32x8(sw + (size_t)b * NIN + n, k.s0); load_f32x8(sw + (size_t)b * NIN + n + 128, k.s1);
        if (pn >= 2 && pn < 6) { load_f32x8(lbv + n - 512, k.l0); load_f32x8(lbv + n - 512 + 128, k.l1); } }
    __device__ __forceinline__ void load_row(Row& r, int row, int, int) const { r.rs = rstd[row]; }
    __device__ __forceinline__ void half_(int row, int n, float rs, const float (&a)[8], const float (&s)[8], const float (&lb)[8]) const {
        float p[8];
#pragma unroll
        for (int j = 0; j < 8; ++j) p[j] = rs * a[j] + s[j];
        const int grp = n >> 9;
        if (grp == 0) { store_bf16x8(v + (size_t)row * 512 + n, p); }
        else if (grp <= 2) { const int nn = n - 512 * grp; f16_t* dst = (grp == 1 ? lfw : lbw) + (size_t)row * 512 + nn; f16_t o[8];
#pragma unroll
            for (int j = 0; j < 8; ++j) { const float f = lb[j] + (1.0f - lb[j]) * sigmoidf_(p[j]); o[j] = (f16_t)(__builtin_amdgcn_logf(f) * 0.6931471805599453f); }
            *(u32x4*)dst = *(const u32x4*)o; }
        else if (grp == 3) {
#pragma unroll
            for (int j = 0; j < 8; ++j) p[j] = siluf_(p[j]);
            store_bf16x8(q + (size_t)row * 512 + (n - 1536), p); }
        else if (grp == 4) {
#pragma unroll
            for (int j = 0; j < 8; ++j) p[j] = siluf_(p[j]);
            store_bf16x8(g + (size_t)row * 512 + (n - 2048), p); }
        else if (grp <= 7) { const int ch = n - 2560, t = row & (SEQ - 1), b = row >> 11; store_bf16x8(hy + (((size_t)(ch >> 3) * NB + b) * SEQ + t) * 8, p); }
        else {
#pragma unroll
            for (int j = 0; j < 8; ++j) p[j] = sigmoidf_(p[j]);
            store_bf16x8(gab + (size_t)row * 2048 + (n - 4096), p); }
    }
    __device__ __forceinline__ float finish(int row, int pn, int c, const float (&v0)[8], const float (&v1)[8], const Cols& k, const Row& r) const {
        half_(row, 256 * pn + c, r.rs, v0, k.s0, k.l0); half_(row, 256 * pn + 128 + c, r.rs, v1, k.s1, k.l1); return 0.f; }
};
struct EpiProjA {
    static constexpr int PD = 4;
    struct Cols {}; struct Row { u32x4 g0, g1; };
    const bf16_t* gab; float* ytmp;
    __device__ __forceinline__ void load_cols(Cols&, int, int, int) const {}
    __device__ __forceinline__ void load_row(Row& r, int row, int pn, int c) const { const bf16_t* src = gab + (size_t)row * 2048 + 256 * pn + c; r.g0 = *(const u32x4*)src; r.g1 = *(const u32x4*)(src + 128); }
    __device__ __forceinline__ float finish(int row, int pn, int c, const float (&v0)[8], const float (&v1)[8], const Cols&, const Row& r) const {
        float g0[8], g1[8], o0[8], o1[8]; unpack_bf16x8(r.g0, g0); unpack_bf16x8(r.g1, g1);
#pragma unroll
        for (int j = 0; j < 8; ++j) { o0[j] = g0[j] * v0[j]; o1[j] = g1[j] * v1[j]; }
        float* dst = ytmp + (size_t)row * D + 256 * pn + c; store_f32x8(dst, o0); store_f32x8(dst + 128, o1); return 0.f; }
};
struct EpiProjB {
    static constexpr int PD = 2;
    struct Cols {}; struct Row { u32x4 g0, g1; float y0[8], y1[8]; };
    const bf16_t* gab; const float* ytmp; bf16_t* y;
    __device__ __forceinline__ void load_cols(Cols&, int, int, int) const {}
    __device__ __forceinline__ void load_row(Row& r, int row, int pn, int c) const { const bf16_t* src = gab + (size_t)row * 2048 + 1024 + 256 * pn + c; r.g0 = *(const u32x4*)src; r.g1 = *(const u32x4*)(src + 128);
        const float* ys = ytmp + (size_t)row * D + 256 * pn + c; load_f32x8(ys, r.y0); load_f32x8(ys + 128, r.y1); }
    __device__ __forceinline__ float finish(int row, int pn, int c, const float (&v0)[8], const float (&v1)[8], const Cols&, const Row& r) const {
        float g0[8], g1[8], o0[8], o1[8]; unpack_bf16x8(r.g0, g0); unpack_bf16x8(r.g1, g1);
#pragma unroll
        for (int j = 0; j < 8; ++j) { o0[j] = r.y0[j] + g0[j] * v0[j]; o1[j] = r.y1[j] + g1[j] * v1[j]; }
        bf16_t* dst = y + (size_t)row * D + 256 * pn + c; store_bf16x8(dst, o0); store_bf16x8(dst + 128, o1); return 0.f; }
};
struct EpiWout {
    static constexpr int PD = 2;
    struct Cols { float g0[8], g1[8], s0[8], s1[8]; }; struct Row { float b0[8], b1[8]; };
    const float* modv; float* h; bf16_t* a3;
    __device__ __forceinline__ void load_cols(Cols& k, int pm, int pn, int c) const { const float* m = modv + (size_t)(pm >> 3) * MODW + 256 * pn + c;
        load_f32x8(m + 5 * D, k.g0); load_f32x8(m + 5 * D + 128, k.g1); load_f32x8(m + 7 * D, k.s0); load_f32x8(m + 7 * D + 128, k.s1); }
    __device__ __forceinline__ void load_row(Row& r, int row, int pn, int c) const { const float* src = h + (size_t)row * D + 256 * pn + c; load_f32x8(src, r.b0); load_f32x8(src + 128, r.b1); }
    __device__ __forceinline__ float finish(int row, int pn, int c, const float (&v0)[8], const float (&v1)[8], const Cols& k, const Row& r) const {
        float h0[8], h1[8], a0[8], a1[8]; float s = 0.f;
#pragma unroll
        for (int j = 0; j < 8; ++j) { h0[j] = r.b0[j] + k.g0[j] * v0[j]; h1[j] = r.b1[j] + k.g1[j] * v1[j]; s += h0[j] * h0[j] + h1[j] * h1[j]; a0[j] = h0[j] * (1.0f + k.s0[j]); a1[j] = h1[j] * (1.0f + k.s1[j]); }
        const size_t o = (size_t)row * D + 256 * pn + c;
        store_f32x8(h + o, h0); store_f32x8(h + o + 128, h1); store_bf16x8(a3 + o, a0); store_bf16x8(a3 + o + 128, a1); return s; }
};
struct EpiDown2 {
    static constexpr int PD = 2;
    struct Cols { float g0[8], g1[8]; }; struct Row { float b0[8], b1[8]; };
    const float* modv; float* h;
    __device__ __forceinline__ void load_cols(Cols& k, int pm, int pn, int c) const { const float* m = modv + (size_t)(pm >> 3) * MODW + 8 * D + 256 * pn + c; load_f32x8(m, k.g0); load_f32x8(m + 128, k.g1); }
    __device__ __forceinline__ void load_row(Row& r, int row, int pn, int c) const { const float* src = h + (size_t)row * D + 256 * pn + c; load_f32x8(src, r.b0); load_f32x8(src + 128, r.b1); }
    __device__ __forceinline__ float finish(int row, int pn, int c, const float (&v0)[8], const float (&v1)[8], const Cols& k, const Row& r) const {
        float h0[8], h1[8]; float s = 0.f;
#pragma unroll
        for (int j = 0; j < 8; ++j) { h0[j] = r.b0[j] + 0.5f * k.g0[j] * v0[j]; h1[j] = r.b1[j] + 0.5f * k.g1[j] * v1[j]; s += h0[j] * h0[j] + h1[j] * h1[j]; }
        const size_t o = (size_t)row * D + 256 * pn + c; store_f32x8(h + o, h0); store_f32x8(h + o + 128, h1); return s; }
};

template <class Epi>
__device__ __forceinline__ void gemm_simple(LAS unsigned char* lds, const bf16_t* A, const bf16_t* Bt, int K, int row0, int nrows, int npn, const Epi& E, float* ssq) {
    LAS float* As = (LAS float*)lds;
    LAS float* Bs = (LAS float*)(lds + 8192);
    const int tid = threadIdx.x, c8 = tid & 15, rg = tid >> 4;
    const int nrt = nrows / 64, nunits = nrt * npn;
    for (int unit = blockIdx.x; unit < nunits; unit += gridDim.x) {
        const int rt = unit / npn, pn = unit % npn, r0 = row0 + rt * 64;
        float a0[2][8], a1[2][8];
#pragma unroll
        for (int r = 0; r < 2; ++r)
#pragma unroll
            for (int j = 0; j < 8; ++j) { a0[r][j] = 0.f; a1[r][j] = 0.f; }
        for (int k0 = 0; k0 < K; k0 += 32) {
            { const int row = tid >> 3, kq = tid & 7; const u32x2 w = *(const u32x2*)(A + (size_t)(r0 + row) * K + k0 + 4 * kq);
              As[(4 * kq + 0) * 64 + row] = __uint_as_float(w.x << 16); As[(4 * kq + 1) * 64 + row] = __uint_as_float(w.x & 0xffff0000u);
              As[(4 * kq + 2) * 64 + row] = __uint_as_float(w.y << 16); As[(4 * kq + 3) * 64 + row] = __uint_as_float(w.y & 0xffff0000u); }
            { const int n = tid >> 1, kh = tid & 1; const bf16_t* src = Bt + (size_t)(pn * 256 + n) * K + k0 + 16 * kh; float t8[8];
              load_bf16x8(src, t8);
#pragma unroll
              for (int i = 0; i < 8; ++i) Bs[(16 * kh + i) * 256 + n] = t8[i];
              load_bf16x8(src + 8, t8);
#pragma unroll
              for (int i = 0; i < 8; ++i) Bs[(16 * kh + 8 + i) * 256 + n] = t8[i]; }
            __syncthreads();
#pragma unroll 8
            for (int k = 0; k < 32; ++k) {
                const float x0 = As[k * 64 + 2 * rg], x1 = As[k * 64 + 2 * rg + 1];
                const f32x4 b00 = *(const LAS f32x4*)(Bs + k * 256 + 8 * c8), b01 = *(const LAS f32x4*)(Bs + k * 256 + 8 * c8 + 4);
                const f32x4 b10 = *(const LAS f32x4*)(Bs + k * 256 + 128 + 8 * c8), b11 = *(const LAS f32x4*)(Bs + k * 256 + 128 + 8 * c8 + 4);
#pragma unroll
                for (int j = 0; j < 4; ++j) { a0[0][j] += x0 * b00[j]; a0[0][4 + j] += x0 * b01[j]; a1[0][j] += x0 * b10[j]; a1[0][4 + j] += x0 * b11[j];
                                              a0[1][j] += x1 * b00[j]; a0[1][4 + j] += x1 * b01[j]; a1[1][j] += x1 * b10[j]; a1[1][4 + j] += x1 * b11[j]; }
            }
            __syncthreads();
        }
#pragma unroll
        for (int r = 0; r < 2; ++r) { const int row = r0 + 2 * rg + r; typename Epi::Cols kc; typename Epi::Row kr; E.load_cols(kc, row >> 8, pn, 8 * c8); E.load_row(kr, row, pn, 8 * c8); float s = E.finish(row, pn, 8 * c8, a0[r], a1[r], kc, kr);
            s += __shfl_xor(s, 1); s += __shfl_xor(s, 2); s += __shfl_xor(s, 4); s += __shfl_xor(s, 8);
            if (ssq && c8 == 0) *(f32x4*)(ssq + (size_t)row * 16 + pn * 4) = (f32x4){s, 0.f, 0.f, 0.f}; }
    }
}

namespace pg8 {
#define PG8_LAS __attribute__((address_space(3)))
typedef unsigned short bf16_t;
typedef short bf16x8 __attribute__((ext_vector_type(8)));
typedef float f32x4 __attribute__((ext_vector_type(4)));
typedef unsigned u32x4 __attribute__((ext_vector_type(4)));
constexpr int BM = 256, BK = 64, HALF = 128, HTB = HALF * BK * 2  , STAGE_BYTES = 8 * HTB, NXCD = 8, WGM = 8;

__host__ __device__ __forceinline__ int lds_byte(int r, int c) { const int st = (r >> 4) * 2 + (c >> 5), rr = r & 15, cc = c & 31, ob = rr * 64 + cc * 2; return st * 1024 + (ob ^ (((ob >> 9) & 1) << 5)); }
__host__ __device__ __forceinline__ void stage_rc(int b, int& R, int& C) { const int st = b / 1024, sb = b % 1024, swz = sb ^ (((sb >> 9) & 1) << 5); R = (st >> 1) * 16 + swz / 64; C = (st & 1) * 32 + (swz % 64) / 2; }
__host__ __device__ __forceinline__ int perm32(int rho) { const int n = rho >> 4, i = rho & 15; return 8 * (i >> 2) + 4 * n + (i & 3); }

struct Unit { int pm, pn; };
struct Gemm { const bf16_t* A; const bf16_t* Bt; int M, N, K; };

struct StaticOrder {
    int nM, nN, nwg, G, c;
    __host__ __device__ void init(int M, int N, int G_, int c_) { nM = M / BM; nN = N / BM; nwg = nM * nN; G = G_; c = c_; }
    __host__ __device__ bool next(int i, Unit& u) const {
        const long L = (long)i * G + c; if (L >= nwg) return false;
        int wgid = (int)L; { const int q = nwg / NXCD, r = nwg % NXCD, xcd = wgid % NXCD, off = wgid / NXCD; wgid = (xcd < r ? xcd * (q + 1) : r * (q + 1) + (xcd - r) * q) + off; }
        const int nig = WGM * nN, gid = wgid / nig, fm = gid * WGM, gsz = (nM - fm) < WGM ? (nM - fm) : WGM;
        u.pm = fm + ((wgid % nig) % gsz); u.pn = (wgid % nig) / gsz; return true;
    }
    __device__ __forceinline__ void a_ready(const Unit&) const {}
    __device__ __forceinline__ void done(const Unit&) const {}
};
template <class Epi, class Sched>
__device__ __forceinline__ void gemm_phase(PG8_LAS unsigned char* lds, const Gemm g, const Sched& S, const Epi& E) {
    const int tid = threadIdx.x, wid = __builtin_amdgcn_readfirstlane(tid >> 6), lane = tid & 63, wr = wid >> 2, wc = wid & 3, fr = lane & 15, fq = lane >> 4;
    const int K = g.K, nt = K / BK;
    unsigned voffA[2], voffB[2];
#pragma unroll
    for (int i = 0; i < 2; ++i) { int R, C; stage_rc(tid * 16 + i * 8192, R, C); const int Rb = Epi::PERM ? ((R & ~31) + perm32(R & 31)) : R;
        voffA[i] = (unsigned)(R * K + C) * 2u; voffB[i] = (unsigned)(Rb * K + C) * 2u; }
    const size_t kstep = (size_t)(BK * 2);
    const size_t hstep = (size_t)HALF * K * 2;
    const size_t tstep = 2 * hstep;
    const unsigned ldsw = (unsigned)wid * 1024u;
    const int aoff = lds_byte(wr * 64 + fr, fq * 8), boff = lds_byte(wc * 32 + fr, fq * 8);
#define PG8_SA(b, h) (((b) * 2 + (h)) * HTB)
#define PG8_SB(b, h) ((4 + (b) * 2 + (h)) * HTB)
#define PG8_STAGE(bufoff, gbase, voff) do { _Pragma("unroll") for (int _i = 0; _i < 2; ++_i) \
        __builtin_amdgcn_global_load_lds((const unsigned*)((const char*)(gbase) + (voff)[_i]), (PG8_LAS unsigned*)(lds + (bufoff) + ldsw + _i * 8192), 16, 0, 0); } while (0)
#define PG8_LDA(dst, b, h) do { _Pragma("unroll") for (int m = 0; m < 4; ++m) _Pragma("unroll") for (int k = 0; k < 2; ++k) dst[m][k] = *(const PG8_LAS bf16x8*)(lds + PG8_SA(b, h) + aoff + m * 2048 + k * 1024); } while (0)
#define PG8_LDB(dst, b, h) do { _Pragma("unroll") for (int n = 0; n < 2; ++n) _Pragma("unroll") for (int k = 0; k < 2; ++k) dst[n][k] = *(const PG8_LAS bf16x8*)(lds + PG8_SB(b, h) + boff + n * 2048 + k * 1024); } while (0)
#define PG8_MMA(ai, bj, At, Bt) do { __builtin_amdgcn_s_setprio(1); _Pragma("unroll") for (int m = 0; m < 4; ++m) _Pragma("unroll") for (int n = 0; n < 2; ++n) _Pragma("unroll") for (int k = 0; k < 2; ++k) \
        acc[ai][bj][m][n] = __builtin_amdgcn_mfma_f32_16x16x32_bf16(Bt[n][k], At[m][k], acc[ai][bj][m][n], 0, 0, 0); __builtin_amdgcn_s_setprio(0); } while (0)
#define PG8_WAIT_V(n) asm volatile("s_waitcnt vmcnt(" #n ")" ::: "memory")
#define PG8_WAIT_L(n) asm volatile("s_waitcnt lgkmcnt(" #n ")" ::: "memory")
#define PG8_BAR __builtin_amdgcn_s_barrier()
#define PG8_SCHED __builtin_amdgcn_sched_barrier(0)
    Unit cur, nxt; int ui = 0;
    if (!S.next(0, cur)) return;
    f32x4 acc[2][2][4][2];
#pragma unroll
    for (int a = 0; a < 2; ++a)
#pragma unroll
        for (int b = 0; b < 2; ++b)
#pragma unroll
            for (int m = 0; m < 4; ++m)
#pragma unroll
                for (int n = 0; n < 2; ++n) acc[a][b][m][n] = (f32x4){0.f, 0.f, 0.f, 0.f};
    bf16x8 At[4][2], B0[2][2], B1[2][2];
    const char* cA = (const char*)g.A + (size_t)cur.pm * tstep; const char* cB = (const char*)g.Bt + (size_t)cur.pn * tstep;
    S.a_ready(cur);
    PG8_STAGE(PG8_SB(0, 0), cB, voffB); PG8_STAGE(PG8_SA(0, 0), cA, voffA); PG8_STAGE(PG8_SB(0, 1), cB + hstep, voffB); PG8_STAGE(PG8_SA(0, 1), cA + hstep, voffA);
    if (wr == 1) PG8_BAR;
    PG8_WAIT_V(4); PG8_BAR;
    PG8_STAGE(PG8_SB(1, 0), cB + kstep, voffB); PG8_STAGE(PG8_SA(1, 0), cA + kstep, voffA); PG8_STAGE(PG8_SB(1, 1), cB + hstep + kstep, voffB);
    PG8_WAIT_V(6); PG8_BAR;
    for (;;) {
        const bool has_next = S.next(ui + 1, nxt);
        const char* nA = has_next ? (const char*)g.A + (size_t)nxt.pm * tstep : cA; const char* nB = has_next ? (const char*)g.Bt + (size_t)nxt.pn * tstep : cB;
        for (int t = 0; t < nt; t += 2) {
            const bool last = (t == nt - 2);
            const char* a1 = cA + (size_t)(t + 1) * kstep;
            const char* a2 = last ? nA : cA + (size_t)(t + 2) * kstep; const char* b2 = last ? nB : cB + (size_t)(t + 2) * kstep;
            const char* a3 = a2 + kstep; const char* b3 = b2 + kstep;
            if (last && has_next) S.a_ready(nxt);
            PG8_LDB(B0, 0, 0); PG8_SCHED; PG8_LDA(At, 0, 0); PG8_STAGE(PG8_SA(1, 1), a1 + hstep, voffA);
            PG8_WAIT_L(8); PG8_BAR; PG8_WAIT_L(0); PG8_MMA(0, 0, At, B0); PG8_BAR; PG8_SCHED;
            PG8_LDB(B1, 0, 1); PG8_STAGE(PG8_SB(0, 0), b2, voffB);
            PG8_BAR; PG8_WAIT_L(0); PG8_MMA(0, 1, At, B1); PG8_BAR;
            PG8_LDA(At, 0, 1); PG8_STAGE(PG8_SA(0, 0), a2, voffA);
            PG8_BAR; PG8_WAIT_L(0); PG8_MMA(1, 0, At, B0); PG8_BAR; PG8_SCHED;
            PG8_STAGE(PG8_SB(0, 1), b2 + hstep, voffB);
            PG8_WAIT_V(6); PG8_BAR; PG8_MMA(1, 1, At, B1); PG8_BAR;
            PG8_LDB(B0, 1, 0); PG8_SCHED; PG8_LDA(At, 1, 0); PG8_STAGE(PG8_SA(0, 1), a2 + hstep, voffA);
            PG8_WAIT_L(8); PG8_BAR; PG8_WAIT_L(0); PG8_MMA(0, 0, At, B0); PG8_BAR; PG8_SCHED;
            PG8_LDB(B1, 1, 1); PG8_STAGE(PG8_SB(1, 0), b3, voffB);
            PG8_BAR; PG8_WAIT_L(0); PG8_MMA(0, 1, At, B1); PG8_BAR;
            PG8_LDA(At, 1, 1); PG8_STAGE(PG8_SA(1, 0), a3, voffA);
            PG8_BAR; PG8_WAIT_L(0); PG8_MMA(1, 0, At, B0); PG8_BAR; PG8_SCHED;
            PG8_STAGE(PG8_SB(1, 1), b3 + hstep, voffB);
            PG8_WAIT_V(6); PG8_BAR; PG8_MMA(1, 1, At, B1); PG8_BAR;
        }
        if constexpr (!Epi::AFTER_DRAIN) { E(acc, cur, wr, wc, fr, fq); S.done(cur); }
        if (!has_next) break;
#pragma unroll
        for (int a = 0; a < 2; ++a)
#pragma unroll
            for (int b = 0; b < 2; ++b)
#pragma unroll
                for (int m = 0; m < 4; ++m)
#pragma unroll
                    for (int n = 0; n < 2; ++n) acc[a][b][m][n] = (f32x4){0.f, 0.f, 0.f, 0.f};
        cur = nxt; cA = nA; cB = nB; ++ui;
    }
    PG8_WAIT_V(0);
    if (wr == 0) PG8_BAR;
    PG8_BAR;
    if constexpr (Epi::AFTER_DRAIN) { E.fused(acc, cur, wr, wc, fr, fq, lds, wid, lane); S.done(cur); }
#undef PG8_SA
#undef PG8_SB
#undef PG8_STAGE
#undef PG8_LDA
#undef PG8_LDB
#undef PG8_MMA
#undef PG8_WAIT_V
#undef PG8_WAIT_L
#undef PG8_BAR
#undef PG8_SCHED
}
}

template <class F> struct EpiAd {
    static constexpr bool PERM = true, AFTER_DRAIN = false;
    F f; float* ssq;
    __device__ __forceinline__ void operator()(const pg8::f32x4 (&acc)[2][2][4][2], const pg8::Unit& u, int wr, int wc, int fr, int fq) const {
        constexpr int PD = F::PD;
        const int c = wc * 32 + 8 * fq, row0 = u.pm * 256 + wr * 64 + fr;
        typename F::Cols cols; f.load_cols(cols, u.pm, u.pn, c);
        typename F::Row rd[PD];
#pragma unroll
        for (int s = 0; s < PD; ++s) f.load_row(rd[s], row0 + (s >> 2) * 128 + (s & 3) * 16, u.pn, c);
#pragma unroll
        for (int s = 0; s < 8; ++s) { const int ai = s >> 2, m = s & 3, row = row0 + ai * 128 + m * 16;
            float v0[8], v1[8];
#pragma unroll
            for (int n = 0; n < 2; ++n)
#pragma unroll
                for (int e = 0; e < 4; ++e) { v0[4 * n + e] = acc[ai][0][m][n][e]; v1[4 * n + e] = acc[ai][1][m][n][e]; }
            float sq = f.finish(row, u.pn, c, v0, v1, cols, rd[s % PD]);
            if (ssq) { sq += __shfl_xor(sq, 16); sq += __shfl_xor(sq, 32); if (fq == 0) ssq[(size_t)row * 16 + u.pn * 4 + wc] = sq; }
            if (s + PD < 8) f.load_row(rd[s % PD], row0 + ((s + PD) >> 2) * 128 + ((s + PD) & 3) * 16, u.pn, c); }
    }
};
struct TwoPartOrder {
    pg8::StaticOrder s1; int n1, nM1, nM2, n2, G, c;
    __device__ void init(int nM1_, int nN1, int nM2_, int nN2, int G_, int c_) { s1.init(nM1_ * 256, nN1 * 256, G_, c_); n1 = nM1_ * nN1; nM1 = nM1_; nM2 = nM2_; n2 = nM2_ * nN2; G = G_; c = c_; }
    __device__ bool next(int i, pg8::Unit& u) const { long L = (long)i * G + c; if (L < n1) return s1.next(i, u); L -= n1; if (L >= n2) return false; u.pm = nM1 + (int)(L % nM2); u.pn = (int)(L / nM2); return true; }
    __device__ __forceinline__ void a_ready(const pg8::Unit&) const {}
    __device__ __forceinline__ void done(const pg8::Unit&) const {}
};
template <class F>
__device__ __forceinline__ void gemm_mfma(LAS unsigned char* lds, const bf16_t* A, const bf16_t* Bt, int K, int nrows1, int npn1, int nrows2, int npn2, const F& f, float* ssq) {
    __syncthreads();
    pg8::Gemm g{A, Bt, nrows1 + nrows2, npn1 * 256, K}; TwoPartOrder S; S.init(nrows1 / 256, npn1, nrows2 / 256, npn2, (int)gridDim.x, (int)blockIdx.x);
    EpiAd<F> E{f, ssq};
    pg8::gemm_phase(lds, g, S, E);
    __syncthreads();
}

struct Ctx { LAS unsigned char* lds; int tid, lane, wid, gw, ngw; };

__device__ __forceinline__ void phase_prep(const Params& p, const Ctx& c) {
    unsigned char* ws = p.ws;
    LAS float* scr = (LAS float*)(c.lds + c.wid * 8448);
    transpose_matrix(p.w_in, D, NIN, (bf16_t*)(ws + WS_WIN_T), scr, c.gw, c.ngw, c.lane);
    transpose_matrix(p.w_pa, 512, D, (bf16_t*)(ws + WS_WPA_T), scr, c.gw, c.ngw, c.lane);
    transpose_matrix(p.w_pb, 512, D, (bf16_t*)(ws + WS_WPB_T), scr, c.gw, c.ngw, c.lane);
    transpose_matrix(p.w_out, D, D, (bf16_t*)(ws + WS_WOUT_T), scr, c.gw, c.ngw, c.lane);
    transpose_gu(p.ffn_wg, 0, (bf16_t*)(ws + WS_WG1_T), scr, c.gw, c.ngw, c.lane);
    transpose_gu(p.ffn_wu, 1, (bf16_t*)(ws + WS_WG1_T), scr, c.gw, c.ngw, c.lane);
    transpose_matrix(p.ffn_wd, DFF, D, (bf16_t*)(ws + WS_WD1_T), scr, c.gw, c.ngw, c.lane);
    __syncthreads();
    if ((int)blockIdx.x < MODW / 64) {
        LAS float* xs = (LAS float*)c.lds; LAS float* part = (LAS float*)(c.lds + 17 * 1024 * 4);
        for (int i = c.tid; i < 17 * 1024; i += NTHR) { const int r = i >> 10, k = i & 1023; const float v = r < 16 ? p.c[r * D + k] : p.c_ctx[k]; xs[i] = v / (1.0f + expf(-v)); }
        __syncthreads();
        gemv17<false>(xs, part, p.mod_w, MODW, p.mod_b, (float*)(ws + WS_MODV), MODW, 0, blockIdx.x, gridDim.x);
    }
    { float* er = (float*)(ws + WS_ER); float* ec = (float*)(ws + WS_EC); float* lbv = (float*)(ws + WS_LBV);
      const int gt = blockIdx.x * NTHR + c.tid, ngt = gridDim.x * NTHR;
      for (int i = gt; i < 96 * 512; i += ngt) { const int r = i >> 9, j = i & 511, jj = j & 255; const float omega = 1.0f / powf(10000.0f, (float)jj / 256.0f);
          const int pos = r < 32 ? r : r - 32; const float a = (float)pos * omega; const float v = j < 256 ? sinf(a) : cosf(a);
          if (r < 32) er[r * 512 + j] = v; else ec[(r - 32) * 512 + j] = v; }
      for (int i = gt; i < 1024; i += ngt) { const float l0 = p.lb_logits[i], l1 = p.lb_logits[1024 + i]; lbv[i] = 1.0f / (1.0f + expf(l1 - l0)); } }
    { LAS float* zf = (LAS float*)c.lds; LAS float* h1 = zf + 8 * 40; float* h2o = (float*)(ws + WS_H2);
      for (int it = blockIdx.x; it < SEQ / 8; it += gridDim.x) {
          __syncthreads();
          if (c.tid < 8 * 33) { const int r = c.tid / 33, f = c.tid % 33; const int pp = it * 8 + r; float v;
              if (f == 0) v = (float)pp / (float)(SEQ - 1);
              else { const int i = (f - 1) & 15; const float w = 6.283185307179586f * (float)pp / (float)SEQ; const float fr = 1e-4f + (float)i * ((15.0f - 1e-4f) / 15.0f); const float ang = w * fr; v = f <= 16 ? cosf(ang) : -sinf(ang); }
              zf[r * 40 + f] = v; }
          __syncthreads();
          { const int r = c.tid >> 6, j = c.tid & 63; float s = p.hb1[j];
            for (int f = 0; f < 33; ++f) s += zf[r * 40 + f] * p.hw1[f * 64 + j];
            h1[r * 64 + j] = sinf(p.hfr1[j] * s); }
          __syncthreads();
          { const int r = c.tid >> 6, j = c.tid & 63; float s = p.hb2[j];
            for (int k = 0; k < 64; ++k) s += h1[r * 64 + k] * p.hw2[k * 64 + j];
            h2o[(size_t)(it * 8 + r) * 64 + j] = sinf(p.hfr2[j] * s); }
      } }
}

__device__ __forceinline__ void phase_n1(const Params& p, const Ctx& c) {
    unsigned char* ws = p.ws;
    const float* modv = (const float*)(ws + WS_MODV); const float* er = (const float*)(ws + WS_ER); const float* ec = (const float*)(ws + WS_EC);
    bf16_t* n1 = (bf16_t*)(ws + WS_N1);
    for (int row = c.gw; row < MT; row += c.ngw) {
        const bool lat = row < T; const int b = lat ? (row >> 11) : 16, t = row & (SEQ - 1);
        const float* src = lat ? p.x + (size_t)row * D : p.ctx + (size_t)(row - T) * D;
        f32x4 v[4]; float s = 0.f;
#pragma unroll
        for (int j = 0; j < 4; ++j) { const int col = 4 * c.lane + 256 * j; v[j] = *(const f32x4*)(src + col);
            if (lat) { const float* pe = col < 512 ? er + (t >> 6) * 512 + col : ec + (t & 63) * 512 + (col - 512); v[j] += *(const f32x4*)pe; }
            s += (v[j][0] * v[j][0] + v[j][1] * v[j][1]) + (v[j][2] * v[j][2] + v[j][3] * v[j][3]); }
        const float rs = 1.0f / sqrtf(wave_sum(s) * (1.0f / D) + RMS_EPS);
        if (lat) {
#pragma unroll
            for (int j = 0; j < 4; ++j) *(f32x4*)(p.out + (size_t)row * D + 4 * c.lane + 256 * j) = v[j]; }
#pragma unroll
        for (int j = 0; j < 4; ++j) { const int col = 4 * c.lane + 256 * j; const f32x4 sh = *(const f32x4*)(modv + (size_t)b * MODW + col), sc = *(const f32x4*)(modv + (size_t)b * MODW + D + col);
            const f32x4 o = v[j] * rs * (sc + 1.0f) + sh; u32x2 w; w.x = pk2(o[0], o[1]); w.y = pk2(o[2], o[3]); *(u32x2*)(n1 + (size_t)row * D + col) = w; }
    }
    { LAS float* xs = (LAS float*)c.lds; LAS float* part = (LAS float*)(c.lds + 17 * 1024 * 4);
      const int nb_in = NIN / 64, nb_g = DFF / 64;
      for (int bx = blockIdx.x; bx < nb_in + 2 * nb_g; bx += gridDim.x) {
          __syncthreads();
          if (bx < nb_in) {
              for (int i = c.tid; i < 17 * 1024; i += NTHR) xs[i] = modv[(size_t)(i >> 10) * MODW + 3 * D + (i & 1023)];
              __syncthreads();
              gemv17<false>(xs, part, p.w_in, NIN, nullptr, (float*)(ws + WS_SWIN), NIN, 0, bx, nb_in); }
          else { const int half = (bx - nb_in) / nb_g, blk = (bx - nb_in) % nb_g;
              for (int i = c.tid; i < 17 * 1024; i += NTHR) xs[i] = modv[(size_t)(i >> 10) * MODW + 6 * D + (i & 1023)];
              __syncthreads();
              const float* W = (half ? p.ffn_wu : p.ffn_wg) + (size_t)D * DFF;
              gemv17<true>(xs, part, W, DFF, nullptr, (float*)(ws + WS_SW2), NGU, half, blk, nb_g); }
      }
    }
    { LAS float* w3s = (LAS float*)c.lds;
      LAS float* hk = w3s + 512;
      LAS float* red = hk + 2048 * 8;
      const float* h2 = (const float*)(ws + WS_H2); bf16_t* krev = (bf16_t*)(ws + WS_KREV);
      for (int it = blockIdx.x; it < 256; it += gridDim.x) {
          const int c0 = 2 * it;
          __syncthreads();
          { const int k = c.tid >> 3, q = c.tid & 7; w3s[c.tid] = p.hw3[(size_t)k * 2048 + (q >> 2) * 1024 + ((q >> 1) & 1) * 512 + c0 + (q & 1)]; }
          __syncthreads();
          float l1[4] = {0.f, 0.f, 0.f, 0.f};
          for (int idx = c.tid; idx < 2048 * 8; idx += NTHR) { const int t = idx >> 3, q = idx & 7; float s = 0.f;
              const float* hr = h2 + (size_t)t * 64;
#pragma unroll 8
              for (int k = 0; k < 64; ++k) s += hr[k] * w3s[k * 8 + q];
              const int ch = c0 + (q & 1); const float delta = fabsf(-3.0701134573253945f + (float)ch * ((-15.350567286626973f + 3.0701134573253945f) / 511.0f));
              const float tn = (float)t / (float)(SEQ - 1); s *= expf(-tn * delta) + 0.05f;
              hk[idx] = s; l1[0] += fabsf(s); }
          { float s = l1[0]; s += __shfl_xor(s, 2); s += __shfl_xor(s, 8); s += __shfl_xor(s, 16); s += __shfl_xor(s, 32);
            if ((c.lane & ~5) == 0) red[c.wid * 4 + ((c.lane >> 2) & 1) * 2 + (c.lane & 1)] = s; }
          __syncthreads();
          for (int e = c.tid; e < 4 * KR_LEN; e += NTHR) { const int oc = e / KR_LEN, i = (e % KR_LEN) - KR_OFF, o = oc >> 1, cc = oc & 1;
              float tot = 0.f;
#pragma unroll
              for (int w = 0; w < 8; ++w) tot += red[w * 4 + oc];
              const int lag = -i; float v = 0.f;
              if (lag >= 0 && lag <= SEQ - 1) v = hk[lag * 8 + o * 4 + 0 + cc]; else if (lag < 0 && lag >= -(SEQ - 1)) v = hk[(-lag - 1) * 8 + o * 4 + 2 + cc];
              krev[((size_t)o * 512 + c0 + cc) * KR_LEN + (e % KR_LEN)] = f2bf(v / (tot + 1e-6f)); }
      } }
}

__device__ __forceinline__ void phase_hgrn_simple(const Params& p, const Ctx& c) {
    unsigned char* ws = p.ws;
    const bf16_t* vb = (const bf16_t*)(ws + WS_V); const bf16_t* qb = (const bf16_t*)(ws + WS_Q);
    LAS float* F = (LAS float*)c.lds; LAS float* Kk = F + 64 * 128; LAS float* Q = Kk + 64 * 128; LAS float* V = Q + 64 * 128;
    const int dg = c.tid & 3, e = c.tid >> 2;
    for (int it = blockIdx.x; it < NB * 4 * 2; it += gridDim.x) {
        const int dir = it & 1, h = (it >> 1) & 3, b = it >> 3;
        const f16_t* lf = (const f16_t*)(ws + (dir ? WS_LBW : WS_LFW)); float* outp = (float*)(ws + (dir ? WS_OBW : WS_OFW));
        float S[32];
#pragma unroll
        for (int i = 0; i < 32; ++i) S[i] = 0.f;
        for (int ci = 0; ci < 36; ++ci) {
            const bool lat = ci >= 4;
            __syncthreads();
            for (int idx = c.tid; idx < 64 * 128; idx += NTHR) { const int j = idx >> 7, d = idx & 127; const int pp = (lat ? ci - 4 : ci) * 64 + j;
                const int row = lat ? b * SEQ + (dir ? SEQ - 1 - pp : pp) : T + b * CL + (dir ? CL - 1 - pp : pp);
                const float f = __expf((float)lf[(size_t)row * 512 + h * 128 + d]);
                F[idx] = f; Kk[idx] = 1.0f - f; V[idx] = bf2f(vb[(size_t)row * 512 + h * 128 + d]); Q[idx] = lat ? bf2f(qb[(size_t)row * 512 + h * 128 + d]) : 0.f; }
            __syncthreads();
            for (int j = 0; j < 64; ++j) { const float ve = V[j * 128 + e]; float part = 0.f;
#pragma unroll
                for (int i = 0; i < 32; ++i) { const int d = dg * 32 + i; S[i] = F[j * 128 + d] * S[i] + Kk[j * 128 + d] * ve; part += S[i] * Q[j * 128 + d]; }
                part += __shfl_xor(part, 1); part += __shfl_xor(part, 2);
                if (lat && dg == 0) { const int pp = (ci - 4) * 64 + j; const int row = b * SEQ + (dir ? SEQ - 1 - pp : pp); outp[(size_t)row * 512 + h * 128 + e] = part; } }
        }
    }
}


typedef short bf16x8 __attribute__((ext_vector_type(8)));
constexpr int QROW = 136, TROW = 72;
__device__ __forceinline__ int hg_pos(int x) { return (x & ~31) + ((x >> 2) & 3) * 8 + ((x >> 4) & 1) * 4 + (x & 3); }
__device__ __forceinline__ pg8::f32x4 mfma16(bf16x8 a, bf16x8 b, pg8::f32x4 c) { return __builtin_amdgcn_mfma_f32_16x16x32_bf16(a, b, c, 0, 0, 0); }
__device__ __forceinline__ void phase_hgrn_mfma(const Params& p, const Ctx& c) {
    unsigned char* ws = p.ws;
    const bf16_t* vb = (const bf16_t*)(ws + WS_V); const bf16_t* qb = (const bf16_t*)(ws + WS_Q);
    LAS bf16_t* Qt = (LAS bf16_t*)c.lds;
    LAS bf16_t* Kt = Qt + 64 * QROW;
    LAS bf16_t* KhT = Kt + 64 * QROW;
    LAS bf16_t* VT = KhT + 128 * TROW;
    LAS bf16_t* ST0 = VT + 64 * TROW;
    LAS bf16_t* ST1 = ST0 + 64 * QROW;
    LAS float* qt = (LAS float*)(ST1 + 64 * QROW);
    LAS float* El = qt + 8 * 128;
    const int wid = c.wid, lane = c.lane, fr = lane & 15, fq = lane >> 4, dp = lane, ti = wid & 3, eh = wid >> 2;
    for (int it = blockIdx.x; it < 256; it += gridDim.x) {
        const int dvh = (it >> 3) & 1, idx = (it & 7) | ((it >> 4) << 3), dir = idx & 1, h = (idx >> 1) & 3, b = idx >> 3;
        const f16_t* lf = (const f16_t*)(ws + (dir ? WS_LBW : WS_LFW)); float* outp = (float*)(ws + (dir ? WS_OBW : WS_OFW));
        const int colq = h * 128 + 2 * dp, colv = h * 128 + dvh * 64 + (c.tid & 7) * 8, pv = c.tid >> 3;
        pg8::f32x4 S[4];
#pragma unroll
        for (int e = 0; e < 4; ++e) S[e] = (pg8::f32x4){0.f, 0.f, 0.f, 0.f};
#define HG_ROW(ci_, p_) (((ci_) >= 4) ? (b * SEQ + (dir ? SEQ - 1 - (((ci_) - 4) * 64 + (p_)) : (((ci_) - 4) * 64 + (p_)))) : (T + b * CL + (dir ? CL - 1 - ((ci_) * 64 + (p_)) : ((ci_) * 64 + (p_)))))
        unsigned lfr[8], qr[8]; u32x4 vr;
#pragma unroll
        for (int i = 0; i < 8; ++i) { const int row = HG_ROW(0, 8 * wid + i); lfr[i] = *(const unsigned*)(lf + (size_t)row * 512 + colq); qr[i] = 0u; }
        vr = *(const u32x4*)(vb + (size_t)HG_ROW(0, pv) * 512 + colv);
        __syncthreads();
        for (int ci = 0; ci < 36; ++ci) {
            const bool lat = ci >= 4;
            float l0[8], l1[8], c0[8], c1[8]; float run0 = 0.f, run1 = 0.f;
#pragma unroll
            for (int i = 0; i < 8; ++i) { const __fp16 a0 = __builtin_bit_cast(__fp16, (unsigned short)(lfr[i] & 0xffffu)), a1 = __builtin_bit_cast(__fp16, (unsigned short)(lfr[i] >> 16));
                l0[i] = (float)a0; l1[i] = (float)a1; run0 += l0[i]; run1 += l1[i]; c0[i] = run0; c1[i] = run1; }
            qt[wid * 128 + 2 * dp] = run0; qt[wid * 128 + 2 * dp + 1] = run1;
            __syncthreads();
            float off0 = 0.f, off1 = 0.f, tot0 = 0.f, tot1 = 0.f;
#pragma unroll
            for (int w = 0; w < 8; ++w) { const float a0 = qt[w * 128 + 2 * dp], a1 = qt[w * 128 + 2 * dp + 1]; tot0 += a0; tot1 += a1; if (w < wid) { off0 += a0; off1 += a1; } }
            const float E0 = __expf(tot0), E1 = __expf(tot1);
            if (wid == 0) { El[2 * dp] = E0; El[2 * dp + 1] = E1; }
            const int qpos = hg_pos(2 * dp);
            float kh0[8], kh1[8];
#pragma unroll
            for (int i = 0; i < 8; ++i) { const int pp = 8 * wid + i; const float cu0 = off0 + c0[i], cu1 = off1 + c1[i];
                const float e0 = __expf(cu0), e1 = __expf(cu1), r0 = __expf(-cu0), r1 = __expf(-cu1);
                const float k0 = (1.0f - __expf(l0[i])) * r0, k1 = (1.0f - __expf(l1[i])) * r1;
                *(LAS unsigned*)(Kt + pp * QROW + qpos) = pk2(k0, k1);
                if (lat) { const float q0 = __uint_as_float(qr[i] << 16), q1 = __uint_as_float(qr[i] & 0xffff0000u); *(LAS unsigned*)(Qt + pp * QROW + qpos) = pk2(q0 * e0, q1 * e1); }
                kh0[i] = k0 * E0; kh1[i] = k1 * E1; }
            { const int base0 = 32 * (wid >> 2) + 16 * (wid & 1) + 4 * ((wid >> 1) & 1);
              u32x2 w; w.x = pk2(kh0[0], kh0[1]); w.y = pk2(kh0[2], kh0[3]); *(LAS u32x2*)(KhT + (2 * dp) * TROW + base0) = w;
              w.x = pk2(kh0[4], kh0[5]); w.y = pk2(kh0[6], kh0[7]); *(LAS u32x2*)(KhT + (2 * dp) * TROW + base0 + 8) = w;
              w.x = pk2(kh1[0], kh1[1]); w.y = pk2(kh1[2], kh1[3]); *(LAS u32x2*)(KhT + (2 * dp + 1) * TROW + base0) = w;
              w.x = pk2(kh1[4], kh1[5]); w.y = pk2(kh1[6], kh1[7]); *(LAS u32x2*)(KhT + (2 * dp + 1) * TROW + base0 + 8) = w; }
            { const int e8 = (c.tid & 7) * 8, sp = hg_pos(pv); const unsigned wv[4] = {vr.x, vr.y, vr.z, vr.w};
#pragma unroll
              for (int j = 0; j < 4; ++j) { VT[(e8 + 2 * j) * TROW + sp] = (bf16_t)(wv[j] & 0xffffu); VT[(e8 + 2 * j + 1) * TROW + sp] = (bf16_t)(wv[j] >> 16); } }
            if (ci + 1 < 36) { const bool nlat = ci + 1 >= 4;
#pragma unroll
                for (int i = 0; i < 8; ++i) { const int row = HG_ROW(ci + 1, 8 * wid + i); lfr[i] = *(const unsigned*)(lf + (size_t)row * 512 + colq); if (nlat) qr[i] = *(const unsigned*)(qb + (size_t)row * 512 + colq); }
                vr = *(const u32x4*)(vb + (size_t)HG_ROW(ci + 1, pv) * 512 + colv); }
            __syncthreads();
            const LAS bf16_t* STr = (ci & 1) ? ST1 : ST0; LAS bf16_t* STw = (ci & 1) ? ST0 : ST1;
            bf16x8 VF[4][2];
#pragma unroll
            for (int ei = 0; ei < 4; ++ei)
#pragma unroll
                for (int a = 0; a < 2; ++a) VF[ei][a] = *(const LAS bf16x8*)(VT + (16 * ei + fr) * TROW + 32 * a + 8 * fq);
            if (lat) {
                bf16x8 QF[4];
#pragma unroll
                for (int k = 0; k < 4; ++k) QF[k] = *(const LAS bf16x8*)(Qt + (16 * ti + fr) * QROW + 32 * k + 8 * fq);
                pg8::f32x4 P[4];
#pragma unroll
                for (int si = 0; si < 4; ++si) { pg8::f32x4 acc = (pg8::f32x4){0.f, 0.f, 0.f, 0.f};
                    if (si <= ti) {
#pragma unroll
                        for (int k = 0; k < 4; ++k) acc = mfma16(*(const LAS bf16x8*)(Kt + (16 * si + fr) * QROW + 32 * k + 8 * fq), QF[k], acc);
                        if (si == ti) {
#pragma unroll
                            for (int r = 0; r < 4; ++r) acc[r] = (4 * fq + r <= fr) ? acc[r] : 0.f; } }
                    P[si] = acc; }
                bf16x8 PB[2];
#pragma unroll
                for (int a = 0; a < 2; ++a) { u32x4 w; w.x = pk2(P[2 * a][0], P[2 * a][1]); w.y = pk2(P[2 * a][2], P[2 * a][3]); w.z = pk2(P[2 * a + 1][0], P[2 * a + 1][1]); w.w = pk2(P[2 * a + 1][2], P[2 * a + 1][3]); PB[a] = __builtin_bit_cast(bf16x8, w); }
#pragma unroll
                for (int e2 = 0; e2 < 2; ++e2) { const int ei = 2 * eh + e2; pg8::f32x4 acc = (pg8::f32x4){0.f, 0.f, 0.f, 0.f};
#pragma unroll
                    for (int a = 0; a < 2; ++a) if (2 * a <= ti) acc = mfma16(*(const LAS bf16x8*)(VT + (16 * ei + fr) * TROW + 32 * a + 8 * fq), PB[a], acc);
#pragma unroll
                    for (int k = 0; k < 4; ++k) acc = mfma16(*(const LAS bf16x8*)(STr + (16 * ei + fr) * QROW + 32 * k + 8 * fq), QF[k], acc);
                    const int row = HG_ROW(ci, 16 * ti + fr);
                    *(pg8::f32x4*)(outp + (size_t)row * 512 + h * 128 + dvh * 64 + 16 * ei + 4 * fq) = acc; }
            }
            { const pg8::f32x4 dl = *(const LAS pg8::f32x4*)(El + 16 * wid + 4 * fq);
              bf16x8 KH[2];
#pragma unroll
              for (int a = 0; a < 2; ++a) KH[a] = *(const LAS bf16x8*)(KhT + (16 * wid + fr) * TROW + 32 * a + 8 * fq);
#pragma unroll
              for (int ei = 0; ei < 4; ++ei) { S[ei] = S[ei] * dl;
#pragma unroll
                  for (int a = 0; a < 2; ++a) S[ei] = mfma16(KH[a], VF[ei][a], S[ei]);
                  u32x2 w; w.x = pk2(S[ei][0], S[ei][1]); w.y = pk2(S[ei][2], S[ei][3]);
                  *(LAS u32x2*)(STw + (16 * ei + fr) * QROW + 32 * (wid >> 1) + 8 * fq + 4 * (wid & 1)) = w; } }
            __syncthreads();
        }
#undef HG_ROW
    }
}

__device__ __forceinline__ float hy_tap(const bf16_t* hy, const float* cw, const float* cb, int ch, int b, int t) {
    const bf16_t* src = hy + (((size_t)(ch >> 3) * NB + b) * SEQ) * 8 + (ch & 7); float s = cb[ch];
#pragma unroll
    for (int j = 0; j < 3; ++j) { const int tt = t + j - 1; if (tt >= 0 && tt < SEQ) s += cw[j * NHY + ch] * bf2f(src[(size_t)tt * 8]); }
    return s;
}
__device__ __forceinline__ void phase_hyena_simple(const Params& p, const Ctx& c) {
    unsigned char* ws = p.ws;
    const bf16_t* hy = (const bf16_t*)(ws + WS_HY); const bf16_t* krev = (const bf16_t*)(ws + WS_KREV); bf16_t* zb = (bf16_t*)(ws + WS_ZB);
    LAS float* zs = (LAS float*)c.lds;
    LAS float* kr = zs + 2048 * 16;
    for (int ch = blockIdx.x; ch < BW; ch += gridDim.x) {
        __syncthreads();
        for (int idx = c.tid; idx < NB * SEQ; idx += NTHR) { const int b = idx >> 11, t = idx & (SEQ - 1); zs[t * 16 + b] = bfround(hy_tap(hy, p.conv_w, p.conv_b, ch, b, t)); }
        for (int o = 0; o < 2; ++o) {
            for (int i = c.tid; i < KR_LEN; i += NTHR) kr[i] = bf2f(krev[((size_t)o * 512 + ch) * KR_LEN + i]);
            __syncthreads();
            const int t0 = 4 * c.tid;
            float acc[4][16];
#pragma unroll
            for (int r = 0; r < 4; ++r)
#pragma unroll
                for (int b = 0; b < 16; ++b) acc[r][b] = 0.f;
            float w0, w1 = kr[KR_OFF - t0 - 1], w2 = kr[KR_OFF - t0 - 2], w3 = kr[KR_OFF - t0 - 3];
            for (int s = 0; s < SEQ; ++s) {
                w0 = kr[KR_OFF + s - t0];
                const f32x4 z0 = *(const LAS f32x4*)(zs + s * 16), z1 = *(const LAS f32x4*)(zs + s * 16 + 4), z2 = *(const LAS f32x4*)(zs + s * 16 + 8), z3 = *(const LAS f32x4*)(zs + s * 16 + 12);
#pragma unroll
                for (int j = 0; j < 4; ++j) { acc[0][j] += w0 * z0[j]; acc[0][4 + j] += w0 * z1[j]; acc[0][8 + j] += w0 * z2[j]; acc[0][12 + j] += w0 * z3[j];
                                              acc[1][j] += w1 * z0[j]; acc[1][4 + j] += w1 * z1[j]; acc[1][8 + j] += w1 * z2[j]; acc[1][12 + j] += w1 * z3[j];
                                              acc[2][j] += w2 * z0[j]; acc[2][4 + j] += w2 * z1[j]; acc[2][8 + j] += w2 * z2[j]; acc[2][12 + j] += w2 * z3[j];
                                              acc[3][j] += w3 * z0[j]; acc[3][4 + j] += w3 * z1[j]; acc[3][8 + j] += w3 * z2[j]; acc[3][12 + j] += w3 * z3[j]; }
                w3 = w2; w2 = w1; w1 = w0;
            }
            const float bias = p.hy_bias[o * 512 + ch];
#pragma unroll
            for (int r = 0; r < 4; ++r)
#pragma unroll
                for (int b = 0; b < 16; ++b) acc[r][b] += bias * zs[(t0 + r) * 16 + b];
            __syncthreads();
#pragma unroll
            for (int r = 0; r < 4; ++r)
#pragma unroll
                for (int b4 = 0; b4 < 4; ++b4) *(LAS f32x4*)(zs + (t0 + r) * 16 + 4 * b4) = (f32x4){acc[r][4 * b4], acc[r][4 * b4 + 1], acc[r][4 * b4 + 2], acc[r][4 * b4 + 3]};
#pragma unroll 1
            for (int i = 0; i < 64; ++i) { const int r = i >> 4, b = i & 15, t = t0 + r; const float gate = hy_tap(hy, p.conv_w, p.conv_b, (o + 1) * 512 + ch, b, t);
                const float zn = gate * zs[t * 16 + b];
                if (o == 0) zs[t * 16 + b] = bfround(zn); else zb[((size_t)ch * NB + b) * SEQ + t] = f2bf(zn); }
            __syncthreads();
        }
    }
}


constexpr int ZROW = 2056;
__device__ __forceinline__ void hy_conv4(const bf16_t* src, int t, float w0, float w1, float w2, float cb, float (&o)[4]) {
    float x[6];
#pragma unroll
    for (int i = 0; i < 6; ++i) { const int tt = t - 1 + i; x[i] = (tt >= 0 && tt < SEQ) ? bf2f(src[(size_t)tt * 8]) : 0.f; }
#pragma unroll
    for (int r = 0; r < 4; ++r) o[r] = cb + w0 * x[r] + w1 * x[r + 1] + w2 * x[r + 2];
}
__device__ __forceinline__ void hy_fill(LAS bf16_t* dst, const bf16_t* hy, const float* cw, const float* cbv, int chx, int tid) {
    const float w0 = cw[chx], w1 = cw[NHY + chx], w2 = cw[2 * NHY + chx], cb = cbv[chx];
    for (int b = 0; b < NB; ++b) { const bf16_t* src = hy + (((size_t)(chx >> 3) * NB + b) * SEQ) * 8 + (chx & 7); float o[4];
        hy_conv4(src, 4 * tid, w0, w1, w2, cb, o);
        u32x2 w; w.x = pk2(o[0], o[1]); w.y = pk2(o[2], o[3]); *(LAS u32x2*)(dst + b * ZROW + 4 * tid) = w; }
}
template <int KIND>
__device__ __forceinline__ void hy_block(pg8::f32x4 (&acc)[16], bf16x8 (&Bw)[16], const LAS bf16_t* zl, const LAS bf16_t* krl, int ub, int i0, int lane) {
    const int fr = lane & 15, fq = lane >> 4;
    const LAS bf16_t* bbase = zl + fr * ZROW + 8 * fq;
    const int abase = KR_OFF - 16 * i0 - fr + 8 * fq;
    const unsigned sh = (unsigned)(fr & 1) * 16u;
#pragma unroll
    for (int uu = 0; uu < 16; ++uu) {
        const int u = ub + uu;
        const bool ldb = KIND == 0 ? (uu >= 1) : (KIND == 1 ? true : (uu == 0));
        if (ldb) Bw[(uu + 15) & 15] = *(const LAS bf16x8*)(bbase + 32 * (u + 15));
        const LAS unsigned* ap = (const LAS unsigned*)(krl + ((abase + 32 * u) & ~1));
        const unsigned d0 = ap[0], d1 = ap[1], d2 = ap[2], d3 = ap[3], d4 = ap[4];
        u32x4 aw; aw.x = __builtin_amdgcn_alignbit(d1, d0, sh); aw.y = __builtin_amdgcn_alignbit(d2, d1, sh); aw.z = __builtin_amdgcn_alignbit(d3, d2, sh); aw.w = __builtin_amdgcn_alignbit(d4, d3, sh);
        const bf16x8 A = __builtin_bit_cast(bf16x8, aw);
#pragma unroll
        for (int m = 0; m < 16; ++m) { const bool on = KIND == 0 ? (m >= 16 - uu) : (KIND == 1 ? true : (m <= 15 - uu));
            if (on) acc[m] = __builtin_amdgcn_mfma_f32_16x16x32_bf16(A, Bw[(uu + m) & 15], acc[m], 0, 0, 0); }
    }
}
__device__ __forceinline__ void phase_hyena_mfma(const Params& p, const Ctx& c) {
    unsigned char* ws = p.ws;
    const bf16_t* hy = (const bf16_t*)(ws + WS_HY); const bf16_t* krev = (const bf16_t*)(ws + WS_KREV); bf16_t* zb = (bf16_t*)(ws + WS_ZB);
    LAS bf16_t* zl = (LAS bf16_t*)c.lds;
    LAS bf16_t* gl = zl + NB * ZROW;
    LAS bf16_t* krl = gl + NB * ZROW;
    const int i0 = 32 * (c.wid >> 1) + (c.wid & 1), fr = c.lane & 15, fq = c.lane >> 4;
    for (int ch = blockIdx.x; ch < BW; ch += gridDim.x) {
        __syncthreads();
        hy_fill(zl, hy, p.conv_w, p.conv_b, ch, c.tid);
        for (int o = 0; o < 2; ++o) {
            hy_fill(gl, hy, p.conv_w, p.conv_b, (o + 1) * 512 + ch, c.tid);
            for (int i = c.tid; i < KR_LEN / 8; i += NTHR) *(LAS u32x4*)(krl + 8 * i) = *(const u32x4*)(krev + ((size_t)o * 512 + ch) * KR_LEN + 8 * i);
            __syncthreads();
            pg8::f32x4 acc[16]; bf16x8 Bw[16];
#pragma unroll
            for (int m = 0; m < 16; ++m) { acc[m] = (pg8::f32x4){0.f, 0.f, 0.f, 0.f}; Bw[m] = (bf16x8){0, 0, 0, 0, 0, 0, 0, 0}; }
            hy_block<0>(acc, Bw, zl, krl, -16, i0, c.lane);
            for (int ub = 0; ub < 48; ub += 16) hy_block<1>(acc, Bw, zl, krl, ub, i0, c.lane);
            hy_block<2>(acc, Bw, zl, krl, 48, i0, c.lane);
            const float bias = p.hy_bias[o * 512 + ch];
            u32x2 res[16];
#pragma unroll
            for (int m = 0; m < 16; ++m) { const int t = 16 * (i0 + 2 * m) + 4 * fq; const u32x2 zo = *(const LAS u32x2*)(zl + fr * ZROW + t), gg = *(const LAS u32x2*)(gl + fr * ZROW + t);
                const float z0 = __uint_as_float(zo.x << 16), z1 = __uint_as_float(zo.x & 0xffff0000u), z2 = __uint_as_float(zo.y << 16), z3 = __uint_as_float(zo.y & 0xffff0000u);
                const float g0 = __uint_as_float(gg.x << 16), g1 = __uint_as_float(gg.x & 0xffff0000u), g2 = __uint_as_float(gg.y << 16), g3 = __uint_as_float(gg.y & 0xffff0000u);
                res[m].x = pk2(g0 * (acc[m][0] + bias * z0), g1 * (acc[m][1] + bias * z1)); res[m].y = pk2(g2 * (acc[m][2] + bias * z2), g3 * (acc[m][3] + bias * z3)); }
            __syncthreads();
#pragma unroll
            for (int m = 0; m < 16; ++m) { const int t = 16 * (i0 + 2 * m) + 4 * fq;
                if (o == 0) *(LAS u32x2*)(zl + fr * ZROW + t) = res[m]; else *(u32x2*)(zb + ((size_t)ch * NB + fr) * SEQ + t) = res[m]; }
        }
    }
}

__device__ __forceinline__ void phase_combine(const Params& p, const Ctx& c) {
    unsigned char* ws = p.ws;
    const float* ofw = (const float*)(ws + WS_OFW); const float* obw = (const float*)(ws + WS_OBW); const bf16_t* g = (const bf16_t*)(ws + WS_G);
    bf16_t* oa = (bf16_t*)(ws + WS_OA); bf16_t* ob = (bf16_t*)(ws + WS_OB); const bf16_t* zb = (const bf16_t*)(ws + WS_ZB);
    for (int row = c.gw; row < T; row += c.ngw) { const int col = 8 * c.lane; float a[8], bq[8], gg[8], w[8], o[8];
        load_f32x8(ofw + (size_t)row * 512 + col, a); load_f32x8(obw + (size_t)row * 512 + col, bq); load_bf16x8(g + (size_t)row * 512 + col, gg); load_f32x8(p.a_norm_w + (col & 127), w);
        float s = 0.f;
#pragma unroll
        for (int j = 0; j < 8; ++j) { a[j] += bq[j]; s += a[j] * a[j]; }
        s += __shfl_xor(s, 1); s += __shfl_xor(s, 2); s += __shfl_xor(s, 4); s += __shfl_xor(s, 8);
        const float rs = 1.0f / sqrtf(s * (1.0f / 128.0f) + RMS_EPS);
#pragma unroll
        for (int j = 0; j < 8; ++j) o[j] = a[j] * rs * w[j] * gg[j];
        store_bf16x8(oa + (size_t)row * 512 + col, o); }
    LAS bf16_t* tile = (LAS bf16_t*)c.lds;
    for (int it = blockIdx.x; it < NB * 32 * 8; it += gridDim.x) { const int cb = it & 7, tb = (it >> 3) & 31, b = it >> 8;
        __syncthreads();
        { const int cl = c.tid >> 3, t8 = (c.tid & 7) * 8; const u32x4 w = *(const u32x4*)(zb + ((size_t)(cb * 64 + cl) * NB + b) * SEQ + tb * 64 + t8); *(LAS u32x4*)(tile + cl * 72 + t8) = w; }
        __syncthreads();
        { const int tl = c.tid >> 3, c8 = (c.tid & 7) * 8; bf16_t v[8];
#pragma unroll
          for (int i = 0; i < 8; ++i) v[i] = tile[(c8 + i) * 72 + tl];
          u32x4 w; w.x = v[0] | ((unsigned)v[1] << 16); w.y = v[2] | ((unsigned)v[3] << 16); w.z = v[4] | ((unsigned)v[5] << 16); w.w = v[6] | ((unsigned)v[7] << 16);
          *(u32x4*)(ob + ((size_t)b * SEQ + tb * 64 + tl) * 512 + cb * 64 + c8) = w; }
    }
}

__device__ __forceinline__ void phase_rstd(const float* ssq, float* rstd, int nrows, const Ctx& c) {
    for (int row = blockIdx.x * NTHR + c.tid; row < nrows; row += gridDim.x * NTHR) rstd[row] = rstd_from_ssq(ssq + (size_t)row * 16);
}
__device__ __forceinline__ void phase_final(const Params& p, const Ctx& c) {
    const float* ssq = (const float*)(p.ws + WS_SSQ3);
    for (int row = c.gw; row < T; row += c.ngw) { const float rs = rstd_from_ssq(ssq + (size_t)row * 16);
#pragma unroll
        for (int j = 0; j < 4; ++j) { const int col = 4 * c.lane + 256 * j; f32x4* ptr = (f32x4*)(p.out + (size_t)row * D + col); *ptr = *ptr * rs * *(const f32x4*)(p.fnw + col); } }
}


#define XB_TMO      128
#define XB_XCNT(j)  (256  + 64 * (j))
#define XB_XSUB(j)  (1280 + 64 * (j))
#define XB_XGEN(j)  (2304 + 64 * (j))
#define XB_TOP      3328
#define XB_TOPGEN   3392
#define XCD_BAR_WORDS 3456
#define XB_SPIN_CAP (1u << 18)
__device__ __forceinline__ unsigned xb_ld(unsigned* p)              { return __hip_atomic_load(p, __ATOMIC_RELAXED, __HIP_MEMORY_SCOPE_AGENT); }
__device__ __forceinline__ unsigned xb_add(unsigned* p, unsigned v) { return __hip_atomic_fetch_add(p, v, __ATOMIC_RELAXED, __HIP_MEMORY_SCOPE_AGENT); }
__device__ __forceinline__ unsigned xb_xcc_id() { return (unsigned)__builtin_amdgcn_s_getreg((3 << 11) | 20) & 0xFu; }
#define XB_SPIN(cond, bar) do { unsigned _sp = 0; while (cond) { __builtin_amdgcn_s_sleep(1); \
    if ((++_sp & 255u) == 0u) { if (xb_ld(&(bar)[XB_TMO])) break; if (_sp > XB_SPIN_CAP) { atomicAdd(&(bar)[XB_TMO], 1u); break; } } } } while (0)
struct XcdBarrier { unsigned* bar; unsigned x; volatile LAS unsigned* st; };
__device__ __forceinline__ XcdBarrier xcd_barrier_post(unsigned* bar, volatile LAS unsigned* st) {
    XcdBarrier b; b.bar = bar; b.x = xb_xcc_id(); b.st = st;
    if (threadIdx.x == 0) (void)xb_add(&bar[XB_XCNT(b.x)], 1u);
    return b;
}
__device__ __forceinline__ void xcd_barrier_complete(unsigned* bar, unsigned x, unsigned& nloc, unsigned& nx) {
    const unsigned G = gridDim.x * gridDim.y * gridDim.z;
    unsigned sum, cnt, mine, sp = 0u;
    for (;;) {
        sum = 0u; cnt = 0u; mine = 0u;
#pragma unroll
        for (unsigned j = 0; j < 16; ++j) { const unsigned c = xb_ld(&bar[XB_XCNT(j)]); sum += c; cnt += (c > 0u) ? 1u : 0u; mine = (j == x) ? c : mine; }
        if (sum == G) break;
        __builtin_amdgcn_s_sleep(1);
        if ((++sp & 255u) == 0u) { if (xb_ld(&bar[XB_TMO])) break; if (sp > XB_SPIN_CAP) { atomicAdd(&bar[XB_TMO], 1u); break; } }
    }
    nloc = mine > 0u ? mine : 1u; nx = cnt > 0u ? cnt : 1u;
}
__device__ __forceinline__ void xcd_barrier(const XcdBarrier& b) {
    asm volatile("s_waitcnt vmcnt(0)" ::: "memory");
    __syncthreads();
    if (threadIdx.x == 0) {
        unsigned* bar = b.bar;
        __builtin_amdgcn_s_waitcnt(0);
        unsigned nloc = b.st[0], nx = b.st[1];
        if (nloc == 0u) { xcd_barrier_complete(bar, b.x, nloc, nx); b.st[0] = nloc; b.st[1] = nx; }
        const unsigned old = xb_add(&bar[XB_XSUB(b.x)], 1u);
        const unsigned gen = old / nloc;
        if (old + 1u == (gen + 1u) * nloc) {
            __builtin_amdgcn_fence(__ATOMIC_RELEASE, "agent");
            asm volatile("s_waitcnt vmcnt(0)" ::: "memory");
            const unsigned og = xb_add(&bar[XB_TOP], 1u);
            const unsigned tg = og / nx;
            if (og + 1u == (tg + 1u) * nx) xb_add(&bar[XB_TOPGEN], 1u);
            else XB_SPIN(xb_ld(&bar[XB_TOPGEN]) == tg, bar);
            __builtin_amdgcn_fence(__ATOMIC_ACQUIRE, "agent");
            xb_add(&bar[XB_XGEN(b.x)], 1u);
            asm volatile("s_waitcnt vmcnt(0)" ::: "memory");
        } else {
            XB_SPIN(xb_ld(&bar[XB_XGEN(b.x)]) == gen, bar);
            __builtin_amdgcn_fence(__ATOMIC_ACQUIRE, "agent");
            asm volatile("s_waitcnt vmcnt(0)" ::: "memory");
        }
    }
    __syncthreads();
}

constexpr int N_PHASES = 15;
#ifndef REPEAT_MASK
#define REPEAT_MASK 0
#endif
#ifndef HOST_REPEAT_MASK
#define HOST_REPEAT_MASK 0
#endif
#ifndef USE_XCD_BARRIER
#define USE_XCD_BARRIER 1
#endif
__global__ void __launch_bounds__(NTHR, 2) fwd_kernel(Params p) {
    extern __shared__ __attribute__((aligned(16))) unsigned char lds_raw[];
    Ctx c; c.lds = (LAS unsigned char*)lds_raw; c.tid = threadIdx.x; c.lane = c.tid & 63; c.wid = __builtin_amdgcn_readfirstlane(c.tid >> 6);
    c.gw = blockIdx.x * NWAVES + c.wid; c.ngw = gridDim.x * NWAVES;
    unsigned char* ws = p.ws;
    const float* modv = (const float*)(ws + WS_MODV);
#if N_LAUNCH_MODE == 1
    cg::grid_group grid = cg::this_grid();
#if USE_XCD_BARRIER
    volatile LAS unsigned* xst = (volatile LAS unsigned*)(c.lds + LDS_BYTES - 16);
    if (c.tid < 4) xst[c.tid] = 0u;
    __syncthreads();
    XcdBarrier xbar = xcd_barrier_post((unsigned*)(ws + WS_CTL), xst);
    bool first_seam = true;
#define SEAM() do { if (first_seam) { grid.sync(); first_seam = false; } else xcd_barrier(xbar); } while (0)
#else
#define SEAM() grid.sync()
#endif
#else
#define SEAM() do { } while (0)
#endif
#ifdef ONLY_PHASE
#define IN(k) ((k) == ONLY_PHASE && p.ph_lo <= (k) && (k) < p.ph_hi)
#else
#define IN(k) (p.ph_lo <= (k) && (k) < p.ph_hi)
#endif
#define PHASE(k, ...) if (IN(k)) { for (int rep_ = 0; rep_ <= ((REPEAT_MASK >> (k)) & 1); ++rep_) { __VA_ARGS__; if (rep_ < ((REPEAT_MASK >> (k)) & 1)) SEAM(); } if (IN((k) + 1)) SEAM(); }
#if USE_PG8
#define GEMM2(A_, Bt_, K_, nrows1_, npn1_, nrows2_, npn2_, E_, ssq_) gemm_mfma(c.lds, A_, Bt_, K_, nrows1_, npn1_, nrows2_, npn2_, E_, ssq_)
#else
#define GEMM2(A_, Bt_, K_, nrows1_, npn1_, nrows2_, npn2_, E_, ssq_) do { gemm_simple(c.lds, A_, Bt_, K_, 0, nrows1_, npn1_, E_, ssq_); if ((nrows2_) > 0) gemm_simple(c.lds, A_, Bt_, K_, nrows1_, nrows2_, npn2_, E_, ssq_); } while (0)
#endif
#define GEMM(A_, Bt_, K_, nrows_, npn_, E_, ssq_) GEMM2(A_, Bt_, K_, nrows_, npn_, 0, 0, E_, ssq_)
    PHASE(0, phase_prep(p, c))
    PHASE(1, phase_n1(p, c))
    PHASE(2, { EpiGateUp1 E{(bf16_t*)(ws + WS_HID)};
        GEMM((const bf16_t*)(ws + WS_N1), (const bf16_t*)(ws + WS_WG1_T), D, MT, NGU / 256, E, nullptr); })
    PHASE(3, { EpiDown1 E{p.ctx, modv, p.out, (bf16_t*)(ws + WS_A2)};
        GEMM((const bf16_t*)(ws + WS_HID), (const bf16_t*)(ws + WS_WD1_T), DFF, MT, D / 256, E, (float*)(ws + WS_SSQ1)); })
    PHASE(4, phase_rstd((const float*)(ws + WS_SSQ1), (float*)(ws + WS_RSTD1), MT, c))
    PHASE(5, { EpiWin E{(const float*)(ws + WS_RSTD1), (const float*)(ws + WS_SWIN), (const float*)(ws + WS_LBV), (bf16_t*)(ws + WS_V), (bf16_t*)(ws + WS_Q), (bf16_t*)(ws + WS_G), (bf16_t*)(ws + WS_HY), (bf16_t*)(ws + WS_GAB), (f16_t*)(ws + WS_LFW), (f16_t*)(ws + WS_LBW)};
        GEMM2((const bf16_t*)(ws + WS_A2), (const bf16_t*)(ws + WS_WIN_T), D, T, NIN / 256, TC, 6, E, nullptr); })
    PHASE(6, {
        { LAS float* scr = (LAS float*)(c.lds + c.wid * 8448);
          transpose_gu(p.ffn_wg + (size_t)D * DFF, 0, (bf16_t*)(ws + WS_WG2_T), scr, c.gw, c.ngw, c.lane);
          transpose_gu(p.ffn_wu + (size_t)D * DFF, 1, (bf16_t*)(ws + WS_WG2_T), scr, c.gw, c.ngw, c.lane);
          transpose_matrix(p.ffn_wd + (size_t)DFF * D, DFF, D, (bf16_t*)(ws + WS_WD2_T), scr, c.gw, c.ngw, c.lane); }
        if (USE_MFMA_HYENA) phase_hyena_mfma(p, c); else phase_hyena_simple(p, c); })
    PHASE(7, { if (USE_MFMA_HGRN) phase_hgrn_mfma(p, c); else phase_hgrn_simple(p, c); })
    PHASE(8, phase_combine(p, c))
    PHASE(9, { EpiProjA EA{(const bf16_t*)(ws + WS_GAB), (float*)(ws + WS_YTMP)}; EpiProjB EB{(const bf16_t*)(ws + WS_GAB), (const float*)(ws + WS_YTMP), (bf16_t*)(ws + WS_Y)};
        GEMM((const bf16_t*)(ws + WS_OA), (const bf16_t*)(ws + WS_WPA_T), 512, T, D / 256, EA, nullptr);
        GEMM((const bf16_t*)(ws + WS_OB), (const bf16_t*)(ws + WS_WPB_T), 512, T, D / 256, EB, nullptr); })
    PHASE(10, { EpiWout E{modv, p.out, (bf16_t*)(ws + WS_A3)};
        GEMM((const bf16_t*)(ws + WS_Y), (const bf16_t*)(ws + WS_WOUT_T), D, T, D / 256, E, (float*)(ws + WS_SSQ2)); })
    PHASE(11, phase_rstd((const float*)(ws + WS_SSQ2), (float*)(ws + WS_RSTD2), T, c))
    PHASE(12, { EpiGateUp2 E{(bf16_t*)(ws + WS_HID2), (const float*)(ws + WS_RSTD2), (const float*)(ws + WS_SW2)};
        GEMM((const bf16_t*)(ws + WS_A3), (const bf16_t*)(ws + WS_WG2_T), D, T, NGU / 256, E, nullptr); })
    PHASE(13, { EpiDown2 E{modv, p.out};
        GEMM((const bf16_t*)(ws + WS_HID2), (const bf16_t*)(ws + WS_WD2_T), DFF, T, D / 256, E, (float*)(ws + WS_SSQ3)); })
    PHASE(14, phase_final(p, c))
}

extern "C" void kernel_launch(void* const* d_in, const int* in_sizes, int n_in, void* d_out, int out_size, void* d_ws, size_t ws_size, hipStream_t stream) {
    static int grid = 0;
    if (grid == 0) {
        if (n_in != 26 || in_sizes[0] != T * D || out_size != T * D || ws_size < WS_TOTAL) { fprintf(stderr, "kernel_launch: unexpected shapes (n_in %d, in0 %d, out %d, ws %zu < %zu)\n", n_in, n_in > 0 ? in_sizes[0] : -1, out_size, ws_size, (size_t)WS_TOTAL); grid = -1; return; }
        int dev = 0, cus = 0, per_cu = 0;
        (void)hipGetDevice(&dev); (void)hipDeviceGetAttribute(&cus, hipDeviceAttributeMultiprocessorCount, dev);
        if (hipFuncSetAttribute((const void*)fwd_kernel, hipFuncAttributeMaxDynamicSharedMemorySize, LDS_BYTES) != hipSuccess) { fprintf(stderr, "kernel_launch: hipFuncSetAttribute failed\n"); grid = -1; return; }
        (void)hipOccupancyMaxActiveBlocksPerMultiprocessor(&per_cu, (const void*)fwd_kernel, NTHR, LDS_BYTES);
        if (per_cu < 1) { fprintf(stderr, "kernel_launch: occupancy query says %d blocks per CU\n", per_cu); per_cu = 1; }
        (void)hipGetLastError();
        grid = cus;
    }
    if (grid < 0) return;
    Params p{};
    const float** f = (const float**)&p;
    for (int i = 0; i < 26; ++i) f[i] = (const float*)d_in[i];
    p.out = (float*)d_out; p.ws = (unsigned char*)d_ws;
#if N_LAUNCH_MODE == 1
    p.ph_lo = 0; p.ph_hi = N_PHASES;
#if USE_XCD_BARRIER
    (void)hipMemsetAsync((unsigned char*)d_ws + WS_CTL, 0, XCD_BAR_WORDS * 4, stream);
#endif
    void* args[] = {&p};
    hipError_t e = hipLaunchCooperativeKernel((const void*)fwd_kernel, dim3(grid), dim3(NTHR), args, LDS_BYTES, stream);
    if (e != hipSuccess) fprintf(stderr, "cooperative launch failed: %s (grid %d)\n", hipGetErrorString(e), grid);
#else
    for (int k = 0; k < N_PHASES; ++k) { p.ph_lo = k; p.ph_hi = k + 1; for (int r = 0; r <= ((HOST_REPEAT_MASK >> k) & 1); ++r) hipLaunchKernelGGL(fwd_kernel, dim3(grid), dim3(NTHR), LDS_BYTES, stream, p); }
#endif
}
```

```cpp
#include <hip/hip_runtime.h>
#include <hip/hip_cooperative_groups.h>
#include <cstdio>
namespace cg = cooperative_groups;

#ifndef N_LAUNCH_MODE
#define N_LAUNCH_MODE 1
#endif
#ifndef USE_MFMA_HYENA
#define USE_MFMA_HYENA 1
#endif
#ifndef USE_MFMA_HGRN
#define USE_MFMA_HGRN 1
#endif
#ifndef USE_PG8
#define USE_PG8 1
#endif

#define LAS __attribute__((address_space(3)))
typedef unsigned short bf16_t;
typedef _Float16 f16_t;
typedef float f32x4 __attribute__((ext_vector_type(4)));
typedef unsigned u32x4 __attribute__((ext_vector_type(4)));
typedef unsigned u32x2 __attribute__((ext_vector_type(2)));

constexpr int D = 1024, NB = 16, SEQ = 2048, T = NB * SEQ, CL = 256, TC = NB * CL, MT = T + TC;
constexpr int DFF = 2816, NGU = 2 * DFF, NIN = 6144, MODW = 9 * D;
constexpr int AKW = 512, AVW = 512, BW = 512, NHY = 3 * BW;
constexpr int KR_LEN = 4128, KR_OFF = 2056;
constexpr float RMS_EPS = 1e-6f;
constexpr int NTHR = 512, NWAVES = 8;
constexpr int LDS_BYTES = 152 * 1024;

constexpr size_t MiB = 1024 * 1024;
constexpr size_t al256(size_t x) { return (x + 255) & ~(size_t)255; }
constexpr size_t WS_CTL = 0;
constexpr size_t WS_MODV = WS_CTL + 65536;
constexpr size_t WS_SWIN = WS_MODV + al256((size_t)17 * MODW * 4);
constexpr size_t WS_SW2 = WS_SWIN + al256((size_t)17 * NIN * 4);
constexpr size_t WS_ER = WS_SW2 + al256((size_t)17 * NGU * 4);
constexpr size_t WS_EC = WS_ER + 32 * 512 * 4;
constexpr size_t WS_LBV = WS_EC + 64 * 512 * 4;
constexpr size_t WS_H2 = WS_LBV + 4096;
constexpr size_t WS_KREV = WS_H2 + 2048 * 64 * 4;
constexpr size_t WS_WIN_T = WS_KREV + al256((size_t)2 * 512 * KR_LEN * 2);
constexpr size_t WS_WPA_T = WS_WIN_T + (size_t)NIN * D * 2;
constexpr size_t WS_WPB_T = WS_WPA_T + (size_t)D * 512 * 2;
constexpr size_t WS_WOUT_T = WS_WPB_T + (size_t)D * 512 * 2;
constexpr size_t WS_RSTD1 = WS_WOUT_T + (size_t)D * D * 2;
constexpr size_t WS_RSTD2 = WS_RSTD1 + (size_t)MT * 4;
constexpr size_t WS_PERSIST_END = WS_RSTD2 + (size_t)T * 4;
constexpr size_t AR = 27 * MiB;
static_assert(WS_PERSIST_END <= AR, "persistent region");
constexpr size_t WS_HID = AR + 0 * MiB;
constexpr size_t WS_N1 = AR + 198 * MiB;
constexpr size_t WS_WG1_T = AR + 270 * MiB;
constexpr size_t WS_WD1_T = AR + 281 * MiB;
constexpr size_t WS_SSQ1 = AR + 410 * MiB;
constexpr size_t WS_A2 = AR + 413 * MiB;
constexpr size_t WS_GAB = AR + 0 * MiB;
constexpr size_t WS_V = AR + 128 * MiB;
constexpr size_t WS_LFW = AR + 164 * MiB;
constexpr size_t WS_LBW = AR + 200 * MiB;
constexpr size_t WS_Q = AR + 236 * MiB;
constexpr size_t WS_G = AR + 268 * MiB;
constexpr size_t WS_HY = AR + 300 * MiB;
constexpr size_t WS_WG2_T = AR + 436 * MiB;
constexpr size_t WS_WD2_T = AR + 447 * MiB;
constexpr size_t WS_ZB = AR + 453 * MiB;
constexpr size_t WS_OFW = AR + 300 * MiB;
constexpr size_t WS_OBW = AR + 364 * MiB;
constexpr size_t WS_OA = AR + 128 * MiB;
constexpr size_t WS_OB = AR + 160 * MiB;
constexpr size_t WS_YTMP = AR + 192 * MiB;
constexpr size_t WS_Y = AR + 320 * MiB;
constexpr size_t WS_A3 = AR + 0 * MiB;
constexpr size_t WS_SSQ2 = AR + 64 * MiB;
constexpr size_t WS_SSQ3 = AR + 66 * MiB;
constexpr size_t WS_HID2 = AR + 128 * MiB;
constexpr size_t WS_TOTAL = AR + 485 * MiB;

struct Params {
    const float *x, *c, *ctx, *c_ctx, *mod_w, *mod_b, *ffn_wg, *ffn_wu, *ffn_wd, *w_in, *lb_logits, *a_norm_w, *conv_w, *conv_b;
    const float *hw1, *hb1, *hfr1, *hw2, *hb2, *hfr2, *hw3, *hy_bias, *w_pa, *w_pb, *w_out, *fnw;
    float* out; unsigned char* ws;
    int ph_lo, ph_hi;
};

__device__ __forceinline__ float bf2f(bf16_t b) { return __uint_as_float(((unsigned)b) << 16); }
__device__ __forceinline__ bf16_t f2bf(float f) { unsigned u = __float_as_uint(f); u += 0x7FFFu + ((u >> 16) & 1u); return (bf16_t)(u >> 16); }
__device__ __forceinline__ unsigned pk2(float lo, float hi) { return (unsigned)f2bf(lo) | ((unsigned)f2bf(hi) << 16); }
__device__ __forceinline__ float bfround(float f) { return bf2f(f2bf(f)); }
__device__ __forceinline__ float sigmoidf_(float x) { return __builtin_amdgcn_rcpf(1.0f + __builtin_amdgcn_exp2f(x * -1.4426950408889634f)); }
__device__ __forceinline__ float siluf_(float x) { return x * sigmoidf_(x); }
__device__ __forceinline__ float wave_sum(float v) {
#pragma unroll
    for (int o = 1; o < 64; o <<= 1) v += __shfl_xor(v, o);
    return v;
}
__device__ __forceinline__ float pos_embed(const float* er, const float* ec, int t, int col) {
    return col < 512 ? er[(t >> 6) * 512 + col] : ec[(t & 63) * 512 + (col - 512)];
}
__device__ __forceinline__ float rstd_from_ssq(const float* ssq16) {
    const f32x4* s = (const f32x4*)ssq16; float tot = 0.f;
#pragma unroll
    for (int i = 0; i < 4; ++i) { const f32x4 v = s[i]; tot += (v[0] + v[1]) + (v[2] + v[3]); }
    return __builtin_amdgcn_rsqf(tot * (1.0f / D) + RMS_EPS);
}

__device__ __forceinline__ void transpose_item(const float* W, int K, int N, bf16_t* WT, int k0, int n0, int dst_row0, LAS float* scr, int lane) {
#pragma unroll 8
    for (int i = 0; i < 32; ++i) { const int kk = 2 * i + (lane >> 5); scr[kk * 33 + (lane & 31)] = W[(size_t)(k0 + kk) * N + n0 + (lane & 31)]; }
    asm volatile("s_waitcnt lgkmcnt(0)" ::: "memory");
    const int c = lane & 7;
#pragma unroll
    for (int j = 0; j < 4; ++j) { const int n = (lane >> 3) + 8 * j; const LAS float* s = scr + (8 * c) * 33 + n;
        u32x4 o; o.x = pk2(s[0 * 33], s[1 * 33]); o.y = pk2(s[2 * 33], s[3 * 33]); o.z = pk2(s[4 * 33], s[5 * 33]); o.w = pk2(s[6 * 33], s[7 * 33]);
        *(u32x4*)(WT + (size_t)(dst_row0 + n) * K + k0 + 8 * c) = o; }
    asm volatile("s_waitcnt lgkmcnt(0)" ::: "memory");
}
__device__ __forceinline__ void transpose_matrix(const float* W, int K, int N, bf16_t* WT, LAS float* scr, int gw, int ngw, int lane) {
    const int nblk = N / 32, items = (K / 64) * nblk;
    for (int it = gw; it < items; it += ngw) { const int kb = it / nblk, nb = it % nblk; transpose_item(W, K, N, WT, 64 * kb, 32 * nb, 32 * nb, scr, lane); }
}
__device__ __forceinline__ void transpose_gu(const float* W, int half, bf16_t* WT, LAS float* scr, int gw, int ngw, int lane) {
    const int nblk = DFF / 32, items = (D / 64) * nblk;
    for (int it = gw; it < items; it += ngw) { const int kb = it / nblk, nb = it % nblk, n0 = 32 * nb;
        transpose_item(W, D, DFF, WT, 64 * kb, n0, 256 * (n0 >> 7) + 128 * half + (n0 & 127), scr, lane); }
}

template <bool GU>
__device__ __forceinline__ void gemv17(const LAS float* xs, LAS float* part, const float* W, int N, const float* bias, float* out, int ldo, int half, int blk0, int nblk_stride) {
    const int tid = threadIdx.x, wid = tid >> 6, lane = tid & 63;
    for (int cb = blk0; cb < N / 64; cb += nblk_stride) {
        const int n = cb * 64 + lane;
        float acc[17];
#pragma unroll
        for (int r = 0; r < 17; ++r) acc[r] = 0.f;
        const float* wp = W + (size_t)(wid * 128) * N + n;
#pragma unroll 4
        for (int k = 0; k < 128; ++k) { const float w = wp[(size_t)k * N];
#pragma unroll
            for (int r = 0; r < 17; ++r) acc[r] += xs[r * 1024 + wid * 128 + k] * w; }
#pragma unroll
        for (int r = 0; r < 17; ++r) part[(wid * 17 + r) * 64 + lane] = acc[r];
        __syncthreads();
        for (int o = tid; o < 17 * 64; o += NTHR) { const int r = o >> 6, l = o & 63; float s = 0.f;
#pragma unroll
            for (int w = 0; w < 8; ++w) s += part[(w * 17 + r) * 64 + l];
            const int nn = cb * 64 + l; if (bias) s += bias[nn];
            const int on = GU ? (256 * (nn >> 7) + 128 * half + (nn & 127)) : nn;
            out[(size_t)r * ldo + on] = s; }
        __syncthreads();
    }
}

__device__ __forceinline__ void store_bf16x8(bf16_t* p, const float (&v)[8]) { u32x4 w; w.x = pk2(v[0], v[1]); w.y = pk2(v[2], v[3]); w.z = pk2(v[4], v[5]); w.w = pk2(v[6], v[7]); *(u32x4*)p = w; }
__device__ __forceinline__ void load_f32x8(const float* p, float (&v)[8]) { const f32x4 a = *(const f32x4*)p, b = *(const f32x4*)(p + 4); v[0] = a[0]; v[1] = a[1]; v[2] = a[2]; v[3] = a[3]; v[4] = b[0]; v[5] = b[1]; v[6] = b[2]; v[7] = b[3]; }
__device__ __forceinline__ void store_f32x8(float* p, const float (&v)[8]) { *(f32x4*)p = (f32x4){v[0], v[1], v[2], v[3]}; *(f32x4*)(p + 4) = (f32x4){v[4], v[5], v[6], v[7]}; }
__device__ __forceinline__ void unpack_bf16x8(const u32x4 w, float (&v)[8]) { v[0] = __uint_as_float(w.x << 16); v[1] = __uint_as_float(w.x & 0xffff0000u); v[2] = __uint_as_float(w.y << 16); v[3] = __uint_as_float(w.y & 0xffff0000u);
    v[4] = __uint_as_float(w.z << 16); v[5] = __uint_as_float(w.z & 0xffff0000u); v[6] = __uint_as_float(w.w << 16); v[7] = __uint_as_float(w.w & 0xffff0000u); }
__device__ __forceinline__ void load_bf16x8(const bf16_t* p, float (&v)[8]) { const u32x4 w = *(const u32x4*)p; v[0] = __uint_as_float(w.x << 16); v[1] = __uint_as_float(w.x & 0xffff0000u); v[2] = __uint_as_float(w.y << 16); v[3] = __uint_as_float(w.y & 0xffff0000u);
    v[4] = __uint_as_float(w.z << 16); v[5] = __uint_as_float(w.z & 0xffff0000u); v[6] = __uint_as_float(w.w << 16); v[7] = __uint_as_float(w.w & 0xffff0000u); }

struct EpiGateUp1 {
    static constexpr int PD = 1;
    struct Cols {}; struct Row {};
    bf16_t* hid;
    __device__ __forceinline__ void load_cols(Cols&, int, int, int) const {}
    __device__ __forceinline__ void load_row(Row&, int, int, int) const {}
    __device__ __forceinline__ float finish(int row, int pn, int c, const float (&v0)[8], const float (&v1)[8], const Cols&, const Row&) const {
        float o[8];
#pragma unroll
        for (int j = 0; j < 8; ++j) o[j] = siluf_(v0[j]) * v1[j];
        store_bf16x8(hid + (size_t)row * DFF + 128 * pn + c, o); return 0.f; }
};
struct EpiGateUp2 {
    static constexpr int PD = 8;
    struct Cols { float s0[8], s1[8]; }; struct Row { float rs; };
    bf16_t* hid; const float* rstd; const float* sw;
    __device__ __forceinline__ void load_cols(Cols& k, int pm, int pn, int c) const { const int b = pm >> 3; load_f32x8(sw + (size_t)b * NGU + 256 * pn + c, k.s0); load_f32x8(sw + (size_t)b * NGU + 256 * pn + 128 + c, k.s1); }
    __device__ __forceinline__ void load_row(Row& r, int row, int, int) const { r.rs = rstd[row]; }
    __device__ __forceinline__ float finish(int row, int pn, int c, const float (&v0)[8], const float (&v1)[8], const Cols& k, const Row& r) const {
        float o[8];
#pragma unroll
        for (int j = 0; j < 8; ++j) o[j] = siluf_(r.rs * v0[j] + k.s0[j]) * (r.rs * v1[j] + k.s1[j]);
        store_bf16x8(hid + (size_t)row * DFF + 128 * pn + c, o); return 0.f; }
};
struct EpiDown1 {
    static constexpr int PD = 2;
    struct Cols { float g0[8], g1[8], s0[8], s1[8]; }; struct Row { float b0[8], b1[8]; };
    const float *ctx, *modv; float* h; bf16_t* a2;
    __device__ __forceinline__ void load_cols(Cols& k, int pm, int pn, int c) const { const int b = pm < T / 256 ? (pm >> 3) : 16; const float* m = modv + (size_t)b * MODW + 256 * pn + c;
        load_f32x8(m + 2 * D, k.g0); load_f32x8(m + 2 * D + 128, k.g1); load_f32x8(m + 4 * D, k.s0); load_f32x8(m + 4 * D + 128, k.s1); }
    __device__ __forceinline__ void load_row(Row& r, int row, int pn, int c) const { const float* src = (row < T ? h + (size_t)row * D : ctx + (size_t)(row - T) * D) + 256 * pn + c; load_f32x8(src, r.b0); load_f32x8(src + 128, r.b1); }
    __device__ __forceinline__ float finish(int row, int pn, int c, const float (&v0)[8], const float (&v1)[8], const Cols& k, const Row& r) const {
        float h0[8], h1[8], a0[8], a1[8]; float s = 0.f;
#pragma unroll
        for (int j = 0; j < 8; ++j) { h0[j] = r.b0[j] + 0.5f * k.g0[j] * v0[j]; h1[j] = r.b1[j] + 0.5f * k.g1[j] * v1[j]; s += h0[j] * h0[j] + h1[j] * h1[j]; a0[j] = h0[j] * (1.0f + k.s0[j]); a1[j] = h1[j] * (1.0f + k.s1[j]); }
        const size_t o = (size_t)row * D + 256 * pn + c;
        if (row < T) { store_f32x8(h + o, h0); store_f32x8(h + o + 128, h1); }
        store_bf16x8(a2 + o, a0); store_bf16x8(a2 + o + 128, a1); return s; }
};
struct EpiWin {
    static constexpr int PD = 8;
    struct Cols { float s0[8], s1[8], l0[8], l1[8]; }; struct Row { float rs; };
    const float *rstd, *sw, *lbv; bf16_t *v, *q, *g, *hy, *gab; f16_t *lfw, *lbw;
    __device__ __forceinline__ void load_cols(Cols& k, int pm, int pn, int c) const { const int b = pm < T / 256 ? (pm >> 3) : 16; const int n = 256 * pn + c;
        load_f32x8(sw + (size_t)b * NIN + n, k.s0); load_f32x8(sw + (size_t)b * NIN + n + 128, k.s1);
        if (pn >= 2 && pn < 6) { load_f32x8(lbv + n - 512, k.l0); load_f32x8(lbv + n - 512 + 128, k.l1); } }
    __device__ __forceinline__ void load_row(Row& r, int row, int, int) const { r.rs = rstd[row]; }
    __device__ __forceinline__ void half_(int row, int n, float rs, const float (&a)[8], const float (&s)[8], const float (&lb)[8]) const {
        float p[8];
#pragma unroll
        for (int j = 0; j < 8; ++j) p[j] = rs * a[j] + s[j];
        const int grp = n >> 9;
        if (grp == 0) { store_bf16x8(v + (size_t)row * 512 + n, p); }
        else if (grp <= 2) { const int nn = n - 512 * grp; f16_t* dst = (grp == 1 ? lfw : lbw) + (size_t)row * 512 + nn; f16_t o[8];
#pragma unroll
            for (int j = 0; j < 8; ++j) { const float f = lb[j] + (1.0f - lb[j]) * sigmoidf_(p[j]); o[j] = (f16_t)(__builtin_amdgcn_logf(f) * 0.6931471805599453f); }
            *(u32x4*)dst = *(const u32x4*)o; }
        else if (grp == 3) {
#pragma unroll
            for (int j = 0; j < 8; ++j) p[j] = siluf_(p[j]);
            store_bf16x8(q + (size_t)row * 512 + (n - 1536), p); }
        else if (grp == 4) {
#pragma unroll
            for (int j = 0; j < 8; ++j) p[j] = siluf_(p[j]);
            store_bf16x8(g + (size_t)row * 512 + (n - 2048), p); }
        else if (grp <= 7) { const int ch = n - 2560, t = row & (SEQ - 1), b = row >> 11; store_bf16x8(hy + (((size_t)(ch >> 3) * NB + b) * SEQ + t) * 8, p); }
        else {
#pragma unroll
            for (int j = 0; j < 8; ++j) p[j] = sigmoidf_(p[j]);
            store_bf16x8(gab + (size_t)row * 2048 + (n - 4096), p); }
    }
    __device__ __forceinline__ float finish(int row, int pn, int c, const float (&v0)[8], const float (&v1)[8], const Cols& k, const Row& r) const {
        half_(row, 256 * pn + c, r.rs, v0, k.s0, k.l0); half_(row, 256 * pn + 128 + c, r.rs, v1, k.s1, k.l1); return 0.f; }
};
struct EpiProjA {
    static constexpr int PD = 4;
    struct Cols {}; struct Row { u32x4 g0, g1; };
    const bf16_t* gab; float* ytmp;
    __device__ __forceinline__ void load_cols(Cols&, int, int, int) const {}
    __device__ __forceinline__ void load_row(Row& r, int row, int pn, int c) const { const bf16_t* src = gab + (size_t)row * 2048 + 256 * pn + c; r.g0 = *(const u32x4*)src; r.g1 = *(const u32x4*)(src + 128); }
    __device__ __forceinline__ float finish(int row, int pn, int c, const float (&v0)[8], const float (&v1)[8], const Cols&, const Row& r) const {
        float g0[8], g1[8], o0[8], o1[8]; unpack_bf16x8(r.g0, g0); unpack_bf16x8(r.g1, g1);
#pragma unroll
        for (int j = 0; j < 8; ++j) { o0[j] = g0[j] * v0[j]; o1[j] = g1[j] * v1[j]; }
        float* dst = ytmp + (size_t)row * D + 256 * pn + c; store_f32x8(dst, o0); store_f32x8(dst + 128, o1); return 0.f; }
};
struct EpiProjB {
    static constexpr int PD = 2;
    struct Cols {}; struct Row { u32x4 g0, g1; float y0[8], y1[8]; };
    const bf16_t* gab; const float* ytmp; bf16_t* y;
    __device__ __forceinline__ void load_cols(Cols&, int, int, int) const {}
    __device__ __forceinline__ void load_row(Row& r, int row, int pn, int c) const { const bf16_t* src = gab + (size_t)row * 2048 + 1024 + 256 * pn + c; r.g0 = *(const u32x4*)src; r.g1 = *(const u32x4*)(src + 128);
        const float* ys = ytmp + (size_t)row * D + 256 * pn + c; load_f32x8(ys, r.y0); load_f32x8(ys + 128, r.y1); }
    __device__ __forceinline__ float finish(int row, int pn, int c, const float (&v0)[8], const float (&v1)[8], const Cols&, const Row& r) const {
        float g0[8], g1[8], o0[8], o1[8]; unpack_bf16x8(r.g0, g0); unpack_bf16x8(r.g1, g1);
#pragma unroll
        for (int j = 0; j < 8; ++j) { o0[j] = r.y0[j] + g0[j] * v0[j]; o1[j] = r.y1[j] + g1[j] * v1[j]; }
        bf16_t* dst = y + (size_t)row * D + 256 * pn + c; store_bf16x8(dst, o0); store_bf16x8(dst + 128, o1); return 0.f; }
};
struct EpiWout {
    static constexpr int PD = 2;
    struct Cols { float g0[8], g1[8], s0[8], s1[8]; }; struct Row { float b0[8], b1[8]; };
    const float* modv; float* h; bf16_t* a3;
    __device__ __forceinline__ void load_cols(Cols& k, int pm, int pn, int c) const { const float* m = modv + (size_t)(pm >> 3) * MODW + 256 * pn + c;
        load_f32x8(m + 5 * D, k.g0); load_f32x8(m + 5 * D + 128, k.g1); load_f32x8(m + 7 * D, k.s0); load_f32x8(m + 7 * D + 128, k.s1); }
    __device__ __forceinline__ void load_row(Row& r, int row, int pn, int c) const { const float* src = h + (size_t)row * D + 256 * pn + c; load_f32x8(src, r.b0); load_f32x8(src + 128, r.b1); }
    __device__ __forceinline__ float finish(int row, int pn, int c, const float (&v0)[8], const float (&v1)[8], const Cols& k, const Row& r) const {
        float h0[8], h1[8], a0[8], a1[8]; float s = 0.f;
#pragma unroll
        for (int j = 0; j < 8; ++j) { h0[j] = r.b0[j] + k.g0[j] * v0[j]; h1[j] = r.b1[j] + k.g1[j] * v1[j]; s += h0[j] * h0[j] + h1[j] * h1[j]; a0[j] = h0[j] * (1.0f + k.s0[j]); a1[j] = h1[j] * (1.0f + k.s1[j]); }
        const size_t o = (size_t)row * D + 256 * pn + c;
        store_f32x8(h + o, h0); store_f32x8(h + o + 128, h1); store_bf16x8(a3 + o, a0); store_bf16x8(a3 + o + 128, a1); return s; }
};
struct EpiDown2 {
    static constexpr int PD = 2;
    struct Cols { float g0[8], g1[8]; }; struct Row { float b0[8], b1[8]; };
    const float* modv; float* h;
    __device__ __forceinline__ void load_cols(Cols& k, int pm, int pn, int c) const { const float* m = modv + (size_t)(pm >> 3) * MODW + 8 * D + 256 * pn + c; load_f32x8(m, k.g0); load_f32x8(m + 128, k.g1); }
    __device__ __forceinline__ void load_row(Row& r, int row, int pn, int c) const { const float* src = h + (size_t)row * D + 256 * pn + c; load_f32x8(src, r.b0); load_f32x8(src + 128, r.b1); }
    __device__ __forceinline__ float finish(int row, int pn, int c, const float (&v0)[8], const float (&v1)[8], const Cols& k, const Row& r) const {
        float h0[8], h1[8]; float s = 0.f;
#pragma unroll
        for (int j = 0; j < 8; ++j) { h0[j] = r.b0[j] + 0.5f * k.g0[j] * v0[j]; h1[j] = r.b1[j] + 0.5f * k.g1[j] * v1[j]; s += h0[j] * h0[j] + h1[j] * h1[j]; }
        const size_t o = (size_t)row * D + 256 * pn + c; store_f32x8(h + o, h0); store_f32x8(h + o + 128, h1); return s; }
};

template <class Epi>
__device__ __forceinline__ void gemm_simple(LAS unsigned char* lds, const bf16_t* A, const bf16_t* Bt, int K, int row0, int nrows, int npn, const Epi& E, float* ssq) {
    LAS float* As = (LAS float*)lds;
    LAS float* Bs = (LAS float*)(lds + 8192);
    const int tid = threadIdx.x, c8 = tid & 15, rg = tid >> 4;
    const int nrt = nrows / 64, nunits = nrt * npn;
    for (int unit = blockIdx.x; unit < nunits; unit += gridDim.x) {
        const int rt = unit / npn, pn = unit % npn, r0 = row0 + rt * 64;
        float a0[2][8], a1[2][8];
#pragma unroll
        for (int r = 0; r < 2; ++r)
#pragma unroll
            for (int j = 0; j < 8; ++j) { a0[r][j] = 0.f; a1[r][j] = 0.f; }
        for (int k0 = 0; k0 < K; k0 += 32) {
            { const int row = tid >> 3, kq = tid & 7; const u32x2 w = *(const u32x2*)(A + (size_t)(r0 + row) * K + k0 + 4 * kq);
              As[(4 * kq + 0) * 64 + row] = __uint_as_float(w.x << 16); As[(4 * kq + 1) * 64 + row] = __uint_as_float(w.x & 0xffff0000u);
              As[(4 * kq + 2) * 64 + row] = __uint_as_float(w.y << 16); As[(4 * kq + 3) * 64 + row] = __uint_as_float(w.y & 0xffff0000u); }
            { const int n = tid >> 1, kh = tid & 1; const bf16_t* src = Bt + (size_t)(pn * 256 + n) * K + k0 + 16 * kh; float t8[8];
              load_bf16x8(src, t8);
#pragma unroll
              for (int i = 0; i < 8; ++i) Bs[(16 * kh + i) * 256 + n] = t8[i];
              load_bf16x8(src + 8, t8);
#pragma unroll
              for (int i = 0; i < 8; ++i) Bs[(16 * kh + 8 + i) * 256 + n] = t8[i]; }
            __syncthreads();
#pragma unroll 8
            for (int k = 0; k < 32; ++k) {
                const float x0 = As[k * 64 + 2 * rg], x1 = As[k * 64 + 2 * rg + 1];
                const f32x4 b00 = *(const LAS f32x4*)(Bs + k * 256 + 8 * c8), b01 = *(const LAS f32x4*)(Bs + k * 256 + 8 * c8 + 4);
                const f32x4 b10 = *(const LAS f32x4*)(Bs + k * 256 + 128 + 8 * c8), b11 = *(const LAS f32x4*)(Bs + k * 256 + 128 + 8 * c8 + 4);
#pragma unroll
                for (int j = 0; j < 4; ++j) { a0[0][j] += x0 * b00[j]; a0[0][4 + j] += x0 * b01[j]; a1[0][j] += x0 * b10[j]; a1[0][4 + j] += x0 * b11[j];
                                              a0[1][j] += x1 * b00[j]; a0[1][4 + j] += x1 * b01[j]; a1[1][j] += x1 * b10[j]; a1[1][4 + j] += x1 * b11[j]; }
            }
            __syncthreads();
        }
#pragma unroll
        for (int r = 0; r < 2; ++r) { const int row = r0 + 2 * rg + r; typename Epi::Cols kc; typename Epi::Row kr; E.load_cols(kc, row >> 8, pn, 8 * c8); E.load_row(kr, row, pn, 8 * c8); float s = E.finish(row, pn, 8 * c8, a0[r], a1[r], kc, kr);
            s += __shfl_xor(s, 1); s += __shfl_xor(s, 2); s += __shfl_xor(s, 4); s += __shfl_xor(s, 8);
            if (ssq && c8 == 0) *(f32x4*)(ssq + (size_t)row * 16 + pn * 4) = (f32x4){s, 0.f, 0.f, 0.f}; }
    }
}

namespace pg8 {
#define PG8_LAS __attribute__((address_space(3)))
typedef unsigned short bf16_t;
typedef short bf16x8 __attribute__((ext_vector_type(8)));
typedef float f32x4 __attribute__((ext_vector_type(4)));
typedef unsigned u32x4 __attribute__((ext_vector_type(4)));
constexpr int BM = 256, BK = 64, HALF = 128, HTB = HALF * BK * 2  , STAGE_BYTES = 8 * HTB, NXCD = 8, WGM = 8;

__host__ __device__ __forceinline__ int lds_byte(int r, int c) { const int st = (r >> 4) * 2 + (c >> 5), rr = r & 15, cc = c & 31, ob = rr * 64 + cc * 2; return st * 1024 + (ob ^ (((ob >> 9) & 1) << 5)); }
__host__ __device__ __forceinline__ void stage_rc(int b, int& R, int& C) { const int st = b / 1024, sb = b % 1024, swz = sb ^ (((sb >> 9) & 1) << 5); R = (st >> 1) * 16 + swz / 64; C = (st & 1) * 32 + (swz % 64) / 2; }
__host__ __device__ __forceinline__ int perm32(int rho) { const int n = rho >> 4, i = rho & 15; return 8 * (i >> 2) + 4 * n + (i & 3); }

struct Unit { int pm, pn; };
struct Gemm { const bf16_t* A; const bf16_t* Bt; int M, N, K; };

struct StaticOrder {
    int nM, nN, nwg, G, c;
    __host__ __device__ void init(int M, int N, int G_, int c_) { nM = M / BM; nN = N / BM; nwg = nM * nN; G = G_; c = c_; }
    __host__ __device__ bool next(int i, Unit& u) const {
        const long L = (long)i * G + c; if (L >= nwg) return false;
        int wgid = (int)L; { const int q = nwg / NXCD, r = nwg % NXCD, xcd = wgid % NXCD, off = wgid / NXCD; wgid = (xcd < r ? xcd * (q + 1) : r * (q + 1) + (xcd - r) * q) + off; }
        const int nig = WGM * nN, gid = wgid / nig, fm = gid * WGM, gsz = (nM - fm) < WGM ? (nM - fm) : WGM;
        u.pm = fm + ((wgid % nig) % gsz); u.pn = (wgid % nig) / gsz; return true;
    }
    __device__ __forceinline__ void a_ready(const Unit&) const {}
    __device__ __forceinline__ void done(const Unit&) const {}
};
template <class Epi, class Sched>
__device__ __forceinline__ void gemm_phase(PG8_LAS unsigned char* lds, const Gemm g, const Sched& S, const Epi& E) {
    const int tid = threadIdx.x, wid = __builtin_amdgcn_readfirstlane(tid >> 6), lane = tid & 63, wr = wid >> 2, wc = wid & 3, fr = lane & 15, fq = lane >> 4;
    const int K = g.K, nt = K / BK;
    unsigned voffA[2], voffB[2];
#pragma unroll
    for (int i = 0; i < 2; ++i) { int R, C; stage_rc(tid * 16 + i * 8192, R, C); const int Rb = Epi::PERM ? ((R & ~31) + perm32(R & 31)) : R;
        voffA[i] = (unsigned)(R * K + C) * 2u; voffB[i] = (unsigned)(Rb * K + C) * 2u; }
    const size_t kstep = (size_t)(BK * 2);
    const size_t hstep = (size_t)HALF * K * 2;
    const size_t tstep = 2 * hstep;
    const unsigned ldsw = (unsigned)wid * 1024u;
    const int aoff = lds_byte(wr * 64 + fr, fq * 8), boff = lds_byte(wc * 32 + fr, fq * 8);
#define PG8_SA(b, h) (((b) * 2 + (h)) * HTB)
#define PG8_SB(b, h) ((4 + (b) * 2 + (h)) * HTB)
#define PG8_STAGE(bufoff, gbase, voff) do { _Pragma("unroll") for (int _i = 0; _i < 2; ++_i) \
        __builtin_amdgcn_global_load_lds((const unsigned*)((const char*)(gbase) + (voff)[_i]), (PG8_LAS unsigned*)(lds + (bufoff) + ldsw + _i * 8192), 16, 0, 0); } while (0)
#define PG8_LDA(dst, b, h) do { _Pragma("unroll") for (int m = 0; m < 4; ++m) _Pragma("unroll") for (int k = 0; k < 2; ++k) dst[m][k] = *(const PG8_LAS bf16x8*)(lds + PG8_SA(b, h) + aoff + m * 2048 + k * 1024); } while (0)
#define PG8_LDB(dst, b, h) do { _Pragma("unroll") for (int n = 0; n < 2; ++n) _Pragma("unroll") for (int k = 0; k < 2; ++k) dst[n][k] = *(const PG8_LAS bf16x8*)(lds + PG8_SB(b, h) + boff + n * 2048 + k * 1024); } while (0)
#define PG8_MMA(ai, bj, At, Bt) do { __builtin_amdgcn_s_setprio(1); _Pragma("unroll") for (int m = 0; m < 4; ++m) _Pragma("unroll") for (int n = 0; n < 2; ++n) _Pragma("unroll") for (int k = 0; k < 2; ++k) \
        acc[ai][bj][m][n] = __builtin_amdgcn_mfma_f32_16x16x32_bf16(Bt[n][k], At[m][k], acc[ai][bj][m][n], 0, 0, 0); __builtin_amdgcn_s_setprio(0); } while (0)
#define PG8_WAIT_V(n) asm volatile("s_waitcnt vmcnt(" #n ")" ::: "memory")
#define PG8_WAIT_L(n) asm volatile("s_waitcnt lgkmcnt(" #n ")" ::: "memory")
#define PG8_BAR __builtin_amdgcn_s_barrier()
#define PG8_SCHED __builtin_amdgcn_sched_barrier(0)
    Unit cur, nxt; int ui = 0;
    if (!S.next(0, cur)) return;
    f32x4 acc[2][2][4][2];
#pragma unroll
    for (int a = 0; a < 2; ++a)
#pragma unroll
        for (int b = 0; b < 2; ++b)
#pragma unroll
            for (int m = 0; m < 4; ++m)
#pragma unroll
                for (int n = 0; n < 2; ++n) acc[a][b][m][n] = (f32x4){0.f, 0.f, 0.f, 0.f};
    bf16x8 At[4][2], B0[2][2], B1[2][2];
    const char* cA = (const char*)g.A + (size_t)cur.pm * tstep; const char* cB = (const char*)g.Bt + (size_t)cur.pn * tstep;
    S.a_ready(cur);
    PG8_STAGE(PG8_SB(0, 0), cB, voffB); PG8_STAGE(PG8_SA(0, 0), cA, voffA); PG8_STAGE(PG8_SB(0, 1), cB + hstep, voffB); PG8_STAGE(PG8_SA(0, 1), cA + hstep, voffA);
    if (wr == 1) PG8_BAR;
    PG8_WAIT_V(4); PG8_BAR;
    PG8_STAGE(PG8_SB(1, 0), cB + kstep, voffB); PG8_STAGE(PG8_SA(1, 0), cA + kstep, voffA); PG8_STAGE(PG8_SB(1, 1), cB + hstep + kstep, voffB);
    PG8_WAIT_V(6); PG8_BAR;
    for (;;) {
        const bool has_next = S.next(ui + 1, nxt);
        const char* nA = has_next ? (const char*)g.A + (size_t)nxt.pm * tstep : cA; const char* nB = has_next ? (const char*)g.Bt + (size_t)nxt.pn * tstep : cB;
        for (int t = 0; t < nt; t += 2) {
            const bool last = (t == nt - 2);
            const char* a1 = cA + (size_t)(t + 1) * kstep;
            const char* a2 = last ? nA : cA + (size_t)(t + 2) * kstep; const char* b2 = last ? nB : cB + (size_t)(t + 2) * kstep;
            const char* a3 = a2 + kstep; const char* b3 = b2 + kstep;
            if (last && has_next) S.a_ready(nxt);
            PG8_LDB(B0, 0, 0); PG8_SCHED; PG8_LDA(At, 0, 0); PG8_STAGE(PG8_SA(1, 1), a1 + hstep, voffA);
            PG8_WAIT_L(8); PG8_BAR; PG8_WAIT_L(0); PG8_MMA(0, 0, At, B0); PG8_BAR; PG8_SCHED;
            PG8_LDB(B1, 0, 1); PG8_STAGE(PG8_SB(0, 0), b2, voffB);
            PG8_BAR; PG8_WAIT_L(0); PG8_MMA(0, 1, At, B1); PG8_BAR;
            PG8_LDA(At, 0, 1); PG8_STAGE(PG8_SA(0, 0), a2, voffA);
            PG8_BAR; PG8_WAIT_L(0); PG8_MMA(1, 0, At, B0); PG8_BAR; PG8_SCHED;
            PG8_STAGE(PG8_SB(0, 1), b2 + hstep, voffB);
            PG8_WAIT_V(6); PG8_BAR; PG8_MMA(1, 1, At, B1); PG8_BAR;
            PG8_LDB(B0, 1, 0); PG8_SCHED; PG8_LDA(At, 1, 0); PG8_STAGE(PG8_SA(0, 1), a2 + hstep, voffA);
            PG8_WAIT_L(8); PG8_BAR; PG8_WAIT_L(0); PG8_MMA(0, 0, At, B0); PG8_BAR; PG8_SCHED;
            PG8_LDB(B1, 1, 1); PG8_STAGE(PG8_SB(1, 0), b3, voffB);
            PG8_BAR; PG8_WAIT_L(0); PG8_MMA(0, 1, At, B1); PG8_BAR;
            PG8_LDA(At, 1, 1); PG8_STAGE(PG8_SA(1, 0), a3, voffA);
            PG8_BAR; PG8_WAIT_L(0); PG8_MMA(1, 0, At, B0); PG8_BAR; PG8_SCHED;
            PG8_STAGE(PG8_SB(1, 1), b3 + hstep, voffB);
            PG8_WAIT_V(6); PG8_BAR; PG8_MMA(1, 1, At, B1); PG8_BAR;
        }
        if constexpr (!Epi::AFTER_DRAIN) { E(acc, cur, wr, wc, fr, fq); S.done(cur); }
        if (!has_next) break;
#pragma unroll
        for (int a = 0; a < 2; ++a)
#pragma unroll
            for (int b = 0; b < 2; ++b)
#pragma unroll
                for (int m = 0; m < 4; ++m)
#pragma unroll
                    for (int n = 0; n < 2; ++n) acc[a][b][m][n] = (f32x4){0.f, 0.f, 0.f, 0.f};
        cur = nxt; cA = nA; cB = nB; ++ui;
    }
    PG8_WAIT_V(0);
    if (wr == 0) PG8_BAR;
    PG8_BAR;
    if constexpr (Epi::AFTER_DRAIN) { E.fused(acc, cur, wr, wc, fr, fq, lds, wid, lane); S.done(cur); }
#undef PG8_SA
#undef PG8_SB
#undef PG8_STAGE
#undef PG8_LDA
#undef PG8_LDB
#undef PG8_MMA
#undef PG8_WAIT_V
#undef PG8_WAIT_L
#undef PG8_BAR
#undef PG8_SCHED
}
}

template <class F> struct EpiAd {
    static constexpr bool PERM = true, AFTER_DRAIN = false;
    F f; float* ssq;
    __device__ __forceinline__ void operator()(const pg8::f32x4 (&acc)[2][2][4][2], const pg8::Unit& u, int wr, int wc, int fr, int fq) const {
        constexpr int PD = F::PD;
        const int c = wc * 32 + 8 * fq, row0 = u.pm * 256 + wr * 64 + fr;
        typename F::Cols cols; f.load_cols(cols, u.pm, u.pn, c);
        typename F::Row rd[PD];
#pragma unroll
        for (int s = 0; s < PD; ++s) f.load_row(rd[s], row0 + (s >> 2) * 128 + (s & 3) * 16, u.pn, c);
#pragma unroll
        for (int s = 0; s < 8; ++s) { const int ai = s >> 2, m = s & 3, row = row0 + ai * 128 + m * 16;
            float v0[8], v1[8];
#pragma unroll
            for (int n = 0; n < 2; ++n)
#pragma unroll
                for (int e = 0; e < 4; ++e) { v0[4 * n + e] = acc[ai][0][m][n][e]; v1[4 * n + e] = acc[ai][1][m][n][e]; }
            float sq = f.finish(row, u.pn, c, v0, v1, cols, rd[s % PD]);
            if (ssq) { sq += __shfl_xor(sq, 16); sq += __shfl_xor(sq, 32); if (fq == 0) ssq[(size_t)row * 16 + u.pn * 4 + wc] = sq; }
            if (s + PD < 8) f.load_row(rd[s % PD], row0 + ((s + PD) >> 2) * 128 + ((s + PD) & 3) * 16, u.pn, c); }
    }
};
struct TwoPartOrder {
    pg8::StaticOrder s1; int n1, nM1, nM2, n2, G, c;
    __device__ void init(int nM1_, int nN1, int nM2_, int nN2, int G_, int c_) { s1.init(nM1_ * 256, nN1 * 256, G_, c_); n1 = nM1_ * nN1; nM1 = nM1_; nM2 = nM2_; n2 = nM2_ * nN2; G = G_; c = c_; }
    __device__ bool next(int i, pg8::Unit& u) const { long L = (long)i * G + c; if (L < n1) return s1.next(i, u); L -= n1; if (L >= n2) return false; u.pm = nM1 + (int)(L % nM2); u.pn = (int)(L / nM2); return true; }
    __device__ __forceinline__ void a_ready(const pg8::Unit&) const {}
    __device__ __forceinline__ void done(const pg8::Unit&) const {}
};
template <class F>
__device__ __forceinline__ void gemm_mfma(LAS unsigned char* lds, const bf16_t* A, const bf16_t* Bt, int K, int nrows1, int npn1, int nrows2, int npn2, const F& f, float* ssq) {
    __syncthreads();
    pg8::Gemm g{A, Bt, nrows1 + nrows2, npn1 * 256, K}; TwoPartOrder S; S.init(nrows1 / 256, npn1, nrows2 / 256, npn2, (int)gridDim.x, (int)blockIdx.x);
    EpiAd<F> E{f, ssq};
    pg8::gemm_phase(lds, g, S, E);
    __syncthreads();
}

struct Ctx { LAS unsigned char* lds; int tid, lane, wid, gw, ngw; };

__device__ __forceinline__ void phase_prep(const Params& p, const Ctx& c) {
    unsigned char* ws = p.ws;
    LAS float* scr = (LAS float*)(c.lds + c.wid * 8448);
    transpose_matrix(p.w_in, D, NIN, (bf16_t*)(ws + WS_WIN_T), scr, c.gw, c.ngw, c.lane);
    transpose_matrix(p.w_pa, 512, D, (bf16_t*)(ws + WS_WPA_T), scr, c.gw, c.ngw, c.lane);
    transpose_matrix(p.w_pb, 512, D, (bf16_t*)(ws + WS_WPB_T), scr, c.gw, c.ngw, c.lane);
    transpose_matrix(p.w_out, D, D, (bf16_t*)(ws + WS_WOUT_T), scr, c.gw, c.ngw, c.lane);
    transpose_gu(p.ffn_wg, 0, (bf16_t*)(ws + WS_WG1_T), scr, c.gw, c.ngw, c.lane);
    transpose_gu(p.ffn_wu, 1, (bf16_t*)(ws + WS_WG1_T), scr, c.gw, c.ngw, c.lane);
    transpose_matrix(p.ffn_wd, DFF, D, (bf16_t*)(ws + WS_WD1_T), scr, c.gw, c.ngw, c.lane);
    __syncthreads();
    if ((int)blockIdx.x < MODW / 64) {
        LAS float* xs = (LAS float*)c.lds; LAS float* part = (LAS float*)(c.lds + 17 * 1024 * 4);
        for (int i = c.tid; i < 17 * 1024; i += NTHR) { const int r = i >> 10, k = i & 1023; const float v = r < 16 ? p.c[r * D + k] : p.c_ctx[k]; xs[i] = v / (1.0f + expf(-v)); }
        __syncthreads();
        gemv17<false>(xs, part, p.mod_w, MODW, p.mod_b, (float*)(ws + WS_MODV), MODW, 0, blockIdx.x, gridDim.x);
    }
    { float* er = (float*)(ws + WS_ER); float* ec = (float*)(ws + WS_EC); float* lbv = (float*)(ws + WS_LBV);
      const int gt = blockIdx.x * NTHR + c.tid, ngt = gridDim.x * NTHR;
      for (int i = gt; i < 96 * 512; i += ngt) { const int r = i >> 9, j = i & 511, jj = j & 255; const float omega = 1.0f / powf(10000.0f, (float)jj / 256.0f);
          const int pos = r < 32 ? r : r - 32; const float a = (float)pos * omega; const float v = j < 256 ? sinf(a) : cosf(a);
          if (r < 32) er[r * 512 + j] = v; else ec[(r - 32) * 512 + j] = v; }
      for (int i = gt; i < 1024; i += ngt) { const float l0 = p.lb_logits[i], l1 = p.lb_logits[1024 + i]; lbv[i] = 1.0f / (1.0f + expf(l1 - l0)); } }
    { LAS float* zf = (LAS float*)c.lds; LAS float* h1 = zf + 8 * 40; float* h2o = (float*)(ws + WS_H2);
      for (int it = blockIdx.x; it < SEQ / 8; it += gridDim.x) {
          __syncthreads();
          if (c.tid < 8 * 33) { const int r = c.tid / 33, f = c.tid % 33; const int pp = it * 8 + r; float v;
              if (f == 0) v = (float)pp / (float)(SEQ - 1);
              else { const int i = (f - 1) & 15; const float w = 6.283185307179586f * (float)pp / (float)SEQ; const float fr = 1e-4f + (float)i * ((15.0f - 1e-4f) / 15.0f); const float ang = w * fr; v = f <= 16 ? cosf(ang) : -sinf(ang); }
              zf[r * 40 + f] = v; }
          __syncthreads();
          { const int r = c.tid >> 6, j = c.tid & 63; float s = p.hb1[j];
            for (int f = 0; f < 33; ++f) s += zf[r * 40 + f] * p.hw1[f * 64 + j];
            h1[r * 64 + j] = sinf(p.hfr1[j] * s); }
          __syncthreads();
          { const int r = c.tid >> 6, j = c.tid & 63; float s = p.hb2[j];
            for (int k = 0; k < 64; ++k) s += h1[r * 64 + k] * p.hw2[k * 64 + j];
            h2o[(size_t)(it * 8 + r) * 64 + j] = sinf(p.hfr2[j] * s); }
      } }
}

__device__ __forceinline__ void phase_n1(const Params& p, const Ctx& c) {
    unsigned char* ws = p.ws;
    const float* modv = (const float*)(ws + WS_MODV); const float* er = (const float*)(ws + WS_ER); const float* ec = (const float*)(ws + WS_EC);
    bf16_t* n1 = (bf16_t*)(ws + WS_N1);
    for (int row = c.gw; row < MT; row += c.ngw) {
        const bool lat = row < T; const int b = lat ? (row >> 11) : 16, t = row & (SEQ - 1);
        const float* src = lat ? p.x + (size_t)row * D : p.ctx + (size_t)(row - T) * D;
        f32x4 v[4]; float s = 0.f;
#pragma unroll
        for (int j = 0; j < 4; ++j) { const int col = 4 * c.lane + 256 * j; v[j] = *(const f32x4*)(src + col);
            if (lat) { const float* pe = col < 512 ? er + (t >> 6) * 512 + col : ec + (t & 63) * 512 + (col - 512); v[j] += *(const f32x4*)pe; }
            s += (v[j][0] * v[j][0] + v[j][1] * v[j][1]) + (v[j][2] * v[j][2] + v[j][3] * v[j][3]); }
        const float rs = 1.0f / sqrtf(wave_sum(s) * (1.0f / D) + RMS_EPS);
        if (lat) {
#pragma unroll
            for (int j = 0; j < 4; ++j) *(f32x4*)(p.out + (size_t)row * D + 4 * c.lane + 256 * j) = v[j]; }
#pragma unroll
        for (int j = 0; j < 4; ++j) { const int col = 4 * c.lane + 256 * j; const f32x4 sh = *(const f32x4*)(modv + (size_t)b * MODW + col), sc = *(const f32x4*)(modv + (size_t)b * MODW + D + col);
            const f32x4 o = v[j] * rs * (sc + 1.0f) + sh; u32x2 w; w.x = pk2(o[0], o[1]); w.y = pk2(o[2], o[3]); *(u32x2*)(n1 + (size_t)row * D + col) = w; }
    }
    { LAS float* xs = (LAS float*)c.lds; LAS float* part = (LAS float*)(c.lds + 17 * 1024 * 4);
      const int nb_in = NIN / 64, nb_g = DFF / 64;
      for (int bx = blockIdx.x; bx < nb_in + 2 * nb_g; bx += gridDim.x) {
          __syncthreads();
          if (bx < nb_in) {
              for (int i = c.tid; i < 17 * 1024; i += NTHR) xs[i] = modv[(size_t)(i >> 10) * MODW + 3 * D + (i & 1023)];
              __syncthreads();
              gemv17<false>(xs, part, p.w_in, NIN, nullptr, (float*)(ws + WS_SWIN), NIN, 0, bx, nb_in); }
          else { const int half = (bx - nb_in) / nb_g, blk = (bx - nb_in) % nb_g;
              for (int i = c.tid; i < 17 * 1024; i += NTHR) xs[i] = modv[(size_t)(i >> 10) * MODW + 6 * D + (i & 1023)];
              __syncthreads();
              const float* W = (half ? p.ffn_wu : p.ffn_wg) + (size_t)D * DFF;
              gemv17<true>(xs, part, W, DFF, nullptr, (float*)(ws + WS_SW2), NGU, half, blk, nb_g); }
      }
    }
    { LAS float* w3s = (LAS float*)c.lds;
      LAS float* hk = w3s + 512;
      LAS float* red = hk + 2048 * 8;
      const float* h2 = (const float*)(ws + WS_H2); bf16_t* krev = (bf16_t*)(ws + WS_KREV);
      for (int it = blockIdx.x; it < 256; it += gridDim.x) {
          const int c0 = 2 * it;
          __syncthreads();
          { const int k = c.tid >> 3, q = c.tid & 7; w3s[c.tid] = p.hw3[(size_t)k * 2048 + (q >> 2) * 1024 + ((q >> 1) & 1) * 512 + c0 + (q & 1)]; }
          __syncthreads();
          float l1[4] = {0.f, 0.f, 0.f, 0.f};
          for (int idx = c.tid; idx < 2048 * 8; idx += NTHR) { const int t = idx >> 3, q = idx & 7; float s = 0.f;
              const float* hr = h2 + (size_t)t * 64;
#pragma unroll 8
              for (int k = 0; k < 64; ++k) s += hr[k] * w3s[k * 8 + q];
              const int ch = c0 + (q & 1); const float delta = fabsf(-3.0701134573253945f + (float)ch * ((-15.350567286626973f + 3.0701134573253945f) / 511.0f));
              const float tn = (float)t / (float)(SEQ - 1); s *= expf(-tn * delta) + 0.05f;
              hk[idx] = s; l1[0] += fabsf(s); }
          { float s = l1[0]; s += __shfl_xor(s, 2); s += __shfl_xor(s, 8); s += __shfl_xor(s, 16); s += __shfl_xor(s, 32);
            if ((c.lane & ~5) == 0) red[c.wid * 4 + ((c.lane >> 2) & 1) * 2 + (c.lane & 1)] = s; }
          __syncthreads();
          for (int e = c.tid; e < 4 * KR_LEN; e += NTHR) { const int oc = e / KR_LEN, i = (e % KR_LEN) - KR_OFF, o = oc >> 1, cc = oc & 1;
              float tot = 0.f;
#pragma unroll
              for (int w = 0; w < 8; ++w) tot += red[w * 4 + oc];
              const int lag = -i; float v = 0.f;
              if (lag >= 0 && lag <= SEQ - 1) v = hk[lag * 8 + o * 4 + 0 + cc]; else if (lag < 0 && lag >= -(SEQ - 1)) v = hk[(-lag - 1) * 8 + o * 4 + 2 + cc];
              krev[((size_t)o * 512 + c0 + cc) * KR_LEN + (e % KR_LEN)] = f2bf(v / (tot + 1e-6f)); }
      } }
}

__device__ __forceinline__ void phase_hgrn_simple(const Params& p, const Ctx& c) {
    unsigned char* ws = p.ws;
    const bf16_t* vb = (const bf16_t*)(ws + WS_V); const bf16_t* qb = (const bf16_t*)(ws + WS_Q);
    LAS float* F = (LAS float*)c.lds; LAS float* Kk = F + 64 * 128; LAS float* Q = Kk + 64 * 128; LAS float* V = Q + 64 * 128;
    const int dg = c.tid & 3, e = c.tid >> 2;
    for (int it = blockIdx.x; it < NB * 4 * 2; it += gridDim.x) {
        const int dir = it & 1, h = (it >> 1) & 3, b = it >> 3;
        const f16_t* lf = (const f16_t*)(ws + (dir ? WS_LBW : WS_LFW)); float* outp = (float*)(ws + (dir ? WS_OBW : WS_OFW));
        float S[32];
#pragma unroll
        for (int i = 0; i < 32; ++i) S[i] = 0.f;
        for (int ci = 0; ci < 36; ++ci) {
            const bool lat = ci >= 4;
            __syncthreads();
            for (int idx = c.tid; idx < 64 * 128; idx += NTHR) { const int j = idx >> 7, d = idx & 127; const int pp = (lat ? ci - 4 : ci) * 64 + j;
                const int row = lat ? b * SEQ + (dir ? SEQ - 1 - pp : pp) : T + b * CL + (dir ? CL - 1 - pp : pp);
                const float f = __expf((float)lf[(size_t)row * 512 + h * 128 + d]);
                F[idx] = f; Kk[idx] = 1.0f - f; V[idx] = bf2f(vb[(size_t)row * 512 + h * 128 + d]); Q[idx] = lat ? bf2f(qb[(size_t)row * 512 + h * 128 + d]) : 0.f; }
            __syncthreads();
            for (int j = 0; j < 64; ++j) { const float ve = V[j * 128 + e]; float part = 0.f;
#pragma unroll
                for (int i = 0; i < 32; ++i) { const int d = dg * 32 + i; S[i] = F[j * 128 + d] * S[i] + Kk[j * 128 + d] * ve; part += S[i] * Q[j * 128 + d]; }
                part += __shfl_xor(part, 1); part += __shfl_xor(part, 2);
                if (lat && dg == 0) { const int pp = (ci - 4) * 64 + j; const int row = b * SEQ + (dir ? SEQ - 1 - pp : pp); outp[(size_t)row * 512 + h * 128 + e] = part; } }
        }
    }
}


typedef short bf16x8 __attribute__((ext_vector_type(8)));
constexpr int QROW = 136, TROW = 72;
__device__ __forceinline__ int hg_pos(int x) { return (x & ~31) + ((x >> 2) & 3) * 8 + ((x >> 4) & 1) * 4 + (x & 3); }
__device__ __forceinline__ pg8::f32x4 mfma16(bf16x8 a, bf16x8 b, pg8::f32x4 c) { return __builtin_amdgcn_mfma_f32_16x16x32_bf16(a, b, c, 0, 0, 0); }
__device__ __forceinline__ void phase_hgrn_mfma(const Params& p, const Ctx& c) {
    unsigned char* ws = p.ws;
    const bf16_t* vb = (const bf16_t*)(ws + WS_V); const bf16_t* qb = (const bf16_t*)(ws + WS_Q);
    LAS bf16_t* Qt = (LAS bf16_t*)c.lds;
    LAS bf16_t* Kt = Qt + 64 * QROW;
    LAS bf16_t* KhT = Kt + 64 * QROW;
    LAS bf16_t* VT = KhT + 128 * TROW;
    LAS bf16_t* ST0 = VT + 64 * TROW;
    LAS bf16_t* ST1 = ST0 + 64 * QROW;
    LAS float* qt = (LAS float*)(ST1 + 64 * QROW);
    LAS float* El = qt + 8 * 128;
    const int wid = c.wid, lane = c.lane, fr = lane & 15, fq = lane >> 4, dp = lane, ti = wid & 3, eh = wid >> 2;
    for (int it = blockIdx.x; it < 256; it += gridDim.x) {
        const int dvh = (it >> 3) & 1, idx = (it & 7) | ((it >> 4) << 3), dir = idx & 1, h = (idx >> 1) & 3, b = idx >> 3;
        const f16_t* lf = (const f16_t*)(ws + (dir ? WS_LBW : WS_LFW)); float* outp = (float*)(ws + (dir ? WS_OBW : WS_OFW));
        const int colq = h * 128 + 2 * dp, colv = h * 128 + dvh * 64 + (c.tid & 7) * 8, pv = c.tid >> 3;
        pg8::f32x4 S[4];
#pragma unroll
        for (int e = 0; e < 4; ++e) S[e] = (pg8::f32x4){0.f, 0.f, 0.f, 0.f};
#define HG_ROW(ci_, p_) (((ci_) >= 4) ? (b * SEQ + (dir ? SEQ - 1 - (((ci_) - 4) * 64 + (p_)) : (((ci_) - 4) * 64 + (p_)))) : (T + b * CL + (dir ? CL - 1 - ((ci_) * 64 + (p_)) : ((ci_) * 64 + (p_)))))
        unsigned lfr[8], qr[8]; u32x4 vr;
#pragma unroll
        for (int i = 0; i < 8; ++i) { const int row = HG_ROW(0, 8 * wid + i); lfr[i] = *(const unsigned*)(lf + (size_t)row * 512 + colq); qr[i] = 0u; }
        vr = *(const u32x4*)(vb + (size_t)HG_ROW(0, pv) * 512 + colv);
        __syncthreads();
        for (int ci = 0; ci < 36; ++ci) {
            const bool lat = ci >= 4;
            float l0[8], l1[8], c0[8], c1[8]; float run0 = 0.f, run1 = 0.f;
#pragma unroll
            for (int i = 0; i < 8; ++i) { const __fp16 a0 = __builtin_bit_cast(__fp16, (unsigned short)(lfr[i] & 0xffffu)), a1 = __builtin_bit_cast(__fp16, (unsigned short)(lfr[i] >> 16));
                l0[i] = (float)a0; l1[i] = (float)a1; run0 += l0[i]; run1 += l1[i]; c0[i] = run0; c1[i] = run1; }
            qt[wid * 128 + 2 * dp] = run0; qt[wid * 128 + 2 * dp + 1] = run1;
            __syncthreads();
            float off0 = 0.f, off1 = 0.f, tot0 = 0.f, tot1 = 0.f;
#pragma unroll
            for (int w = 0; w < 8; ++w) { const float a0 = qt[w * 128 + 2 * dp], a1 = qt[w * 128 + 2 * dp + 1]; tot0 += a0; tot1 += a1; if (w < wid) { off0 += a0; off1 += a1; } }
            const float E0 = __expf(tot0), E1 = __expf(tot1);
            if (wid == 0) { El[2 * dp] = E0; El[2 * dp + 1] = E1; }
            const int qpos = hg_pos(2 * dp);
            float kh0[8], kh1[8];
#pragma unroll
            for (int i = 0; i < 8; ++i) { const int pp = 8 * wid + i; const float cu0 = off0 + c0[i], cu1 = off1 + c1[i];
                const float e0 = __expf(cu0), e1 = __expf(cu1), r0 = __expf(-cu0), r1 = __expf(-cu1);
                const float k0 = (1.0f - __expf(l0[i])) * r0, k1 = (1.0f - __expf(l1[i])) * r1;
                *(LAS unsigned*)(Kt + pp * QROW + qpos) = pk2(k0, k1);
                if (lat) { const float q0 = __uint_as_float(qr[i] << 16), q1 = __uint_as_float(qr[i] & 0xffff0000u); *(LAS unsigned*)(Qt + pp * QROW + qpos) = pk2(q0 * e0, q1 * e1); }
                kh0[i] = k0 * E0; kh1[i] = k1 * E1; }
            { const int base0 = 32 * (wid >> 2) + 16 * (wid & 1) + 4 * ((wid >> 1) & 1);
              u32x2 w; w.x = pk2(kh0[0], kh0[1]); w.y = pk2(kh0[2], kh0[3]); *(LAS u32x2*)(KhT + (2 * dp) * TROW + base0) = w;
              w.x = pk2(kh0[4], kh0[5]); w.y = pk2(kh0[6], kh0[7]); *(LAS u32x2*)(KhT + (2 * dp) * TROW + base0 + 8) = w;
              w.x = pk2(kh1[0], kh1[1]); w.y = pk2(kh1[2], kh1[3]); *(LAS u32x2*)(KhT + (2 * dp + 1) * TROW + base0) = w;
              w.x = pk2(kh1[4], kh1[5]); w.y = pk2(kh1[6], kh1[7]); *(LAS u32x2*)(KhT + (2 * dp + 1) * TROW + base0 + 8) = w; }
            { const int e8 = (c.tid & 7) * 8, sp = hg_pos(pv); const unsigned wv[4] = {vr.x, vr.y, vr.z, vr.w};
#pragma unroll
              for (int j = 0; j < 4; ++j) { VT[(e8 + 2 * j) * TROW + sp] = (bf16_t)(wv[j] & 0xffffu); VT[(e8 + 2 * j + 1) * TROW + sp] = (bf16_t)(wv[j] >> 16); } }
            if (ci + 1 < 36) { const bool nlat = ci + 1 >= 4;
#pragma unroll
                for (int i = 0; i < 8; ++i) { const int row = HG_ROW(ci + 1, 8 * wid + i); lfr[i] = *(const unsigned*)(lf + (size_t)row * 512 + colq); if (nlat) qr[i] = *(const unsigned*)(qb + (size_t)row * 512 + colq); }
                vr = *(const u32x4*)(vb + (size_t)HG_ROW(ci + 1, pv) * 512 + colv); }
            __syncthreads();
            const LAS bf16_t* STr = (ci & 1) ? ST1 : ST0; LAS bf16_t* STw = (ci & 1) ? ST0 : ST1;
            bf16x8 VF[4][2];
#pragma unroll
            for (int ei = 0; ei < 4; ++ei)
#pragma unroll
                for (int a = 0; a < 2; ++a) VF[ei][a] = *(const LAS bf16x8*)(VT + (16 * ei + fr) * TROW + 32 * a + 8 * fq);
            if (lat) {
                bf16x8 QF[4];
#pragma unroll
                for (int k = 0; k < 4; ++k) QF[k] = *(const LAS bf16x8*)(Qt + (16 * ti + fr) * QROW + 32 * k + 8 * fq);
                pg8::f32x4 P[4];
#pragma unroll
                for (int si = 0; si < 4; ++si) { pg8::f32x4 acc = (pg8::f32x4){0.f, 0.f, 0.f, 0.f};
                    if (si <= ti) {
#pragma unroll
                        for (int k = 0; k < 4; ++k) acc = mfma16(*(const LAS bf16x8*)(Kt + (16 * si + fr) * QROW + 32 * k + 8 * fq), QF[k], acc);
                        if (si == ti) {
#pragma unroll
                            for (int r = 0; r < 4; ++r) acc[r] = (4 * fq + r <= fr) ? acc[r] : 0.f; } }
                    P[si] = acc; }
                bf16x8 PB[2];
#pragma unroll
                for (int a = 0; a < 2; ++a) { u32x4 w; w.x = pk2(P[2 * a][0], P[2 * a][1]); w.y = pk2(P[2 * a][2], P[2 * a][3]); w.z = pk2(P[2 * a + 1][0], P[2 * a + 1][1]); w.w = pk2(P[2 * a + 1][2], P[2 * a + 1][3]); PB[a] = __builtin_bit_cast(bf16x8, w); }
#pragma unroll
                for (int e2 = 0; e2 < 2; ++e2) { const int ei = 2 * eh + e2; pg8::f32x4 acc = (pg8::f32x4){0.f, 0.f, 0.f, 0.f};
#pragma unroll
                    for (int a = 0; a < 2; ++a) if (2 * a <= ti) acc = mfma16(*(const LAS bf16x8*)(VT + (16 * ei + fr) * TROW + 32 * a + 8 * fq), PB[a], acc);
#pragma unroll
                    for (int k = 0; k < 4; ++k) acc = mfma16(*(const LAS bf16x8*)(STr + (16 * ei + fr) * QROW + 32 * k + 8 * fq), QF[k], acc);
                    const int row = HG_ROW(ci, 16 * ti + fr);
                    *(pg8::f32x4*)(outp + (size_t)row * 512 + h * 128 + dvh * 64 + 16 * ei + 4 * fq) = acc; }
            }
            { const pg8::f32x4 dl = *(const LAS pg8::f32x4*)(El + 16 * wid + 4 * fq);
              bf16x8 KH[2];
#pragma unroll
              for (int a = 0; a < 2; ++a) KH[a] = *(const LAS bf16x8*)(KhT + (16 * wid + fr) * TROW + 32 * a + 8 * fq);
#pragma unroll
              for (int ei = 0; ei < 4; ++ei) { S[ei] = S[ei] * dl;
#pragma unroll
                  for (int a = 0; a < 2; ++a) S[ei] = mfma16(KH[a], VF[ei][a], S[ei]);
                  u32x2 w; w.x = pk2(S[ei][0], S[ei][1]); w.y = pk2(S[ei][2], S[ei][3]);
                  *(LAS u32x2*)(STw + (16 * ei + fr) * QROW + 32 * (wid >> 1) + 8 * fq + 4 * (wid & 1)) = w; } }
            __syncthreads();
        }
#undef HG_ROW
    }
}

constexpr int ZROW = 2056;
__device__ __forceinline__ void phase_hy_prepass(const Params& p, const Ctx& c) {
    bf16_t* hy = (bf16_t*)(p.ws + WS_HY);
    LAS bf16_t* raw = (LAS bf16_t*)c.lds;
    if (c.tid < 4) { ((LAS unsigned*)raw)[c.tid] = 0u; ((LAS unsigned*)(raw + 2049 * 8))[c.tid] = 0u; }
    for (int blk = blockIdx.x; blk < (NHY / 8) * NB; blk += gridDim.x) {
        bf16_t* base = hy + (size_t)blk * SEQ * 8; const int cg = blk / NB;
        u32x4 ch4[4];
#pragma unroll
        for (int i = 0; i < 4; ++i) ch4[i] = *(const u32x4*)(base + (size_t)(4 * c.tid + i) * 8);
        __syncthreads();
#pragma unroll
        for (int i = 0; i < 4; ++i) *(LAS u32x4*)(raw + (size_t)(1 + 4 * c.tid + i) * 8) = ch4[i];
        __syncthreads();
        const int ch = cg * 8 + c.wid; const float w0 = p.conv_w[ch], w1 = p.conv_w[NHY + ch], w2 = p.conv_w[2 * NHY + ch], cb = p.conv_b[ch];
#pragma unroll 4
        for (int k = 0; k < 16; ++k) { const int t = 2 * c.lane + 128 * k;
            const float x0 = bf2f(raw[(t + 0) * 8 + c.wid]), x1 = bf2f(raw[(t + 1) * 8 + c.wid]), x2 = bf2f(raw[(t + 2) * 8 + c.wid]), x3 = bf2f(raw[(t + 3) * 8 + c.wid]);
            *(unsigned*)(base + (size_t)c.wid * SEQ + t) = pk2(cb + w0 * x0 + w1 * x1 + w2 * x2, cb + w0 * x1 + w1 * x2 + w2 * x3); }
    }
}
__device__ __forceinline__ void hy_fill2(LAS bf16_t* dst, const bf16_t* hy, int chx, int tid) {
#pragma unroll
    for (int i = 0; i < 8; ++i) { const int idx = tid + NTHR * i, b = idx >> 8, t8 = (idx & 255) * 8;
        *(LAS u32x4*)(dst + b * ZROW + t8) = *(const u32x4*)(hy + ((((size_t)(chx >> 3) * NB + b) * 8 + (chx & 7)) * SEQ) + t8); }
}
template <int KIND>
__device__ __forceinline__ void hy_block(pg8::f32x4 (&acc)[16], bf16x8 (&Bw)[16], const LAS bf16_t* zl, const LAS bf16_t* krl, int ub, int i0, int lane) {
    const int fr = lane & 15, fq = lane >> 4;
    const LAS bf16_t* bbase = zl + fr * ZROW + 8 * fq;
    const int abase = KR_OFF - 16 * i0 - fr + 8 * fq;
    const unsigned sh = (unsigned)(fr & 1) * 16u;
#pragma unroll
    for (int uu = 0; uu < 16; ++uu) {
        const int u = ub + uu;
        const bool ldb = KIND == 0 ? (uu >= 1) : (KIND == 1 ? true : (uu == 0));
        if (ldb) Bw[(uu + 15) & 15] = *(const LAS bf16x8*)(bbase + 32 * (u + 15));
        const LAS unsigned* ap = (const LAS unsigned*)(krl + ((abase + 32 * u) & ~1));
        const unsigned d0 = ap[0], d1 = ap[1], d2 = ap[2], d3 = ap[3], d4 = ap[4];
        u32x4 aw; aw.x = __builtin_amdgcn_alignbit(d1, d0, sh); aw.y = __builtin_amdgcn_alignbit(d2, d1, sh); aw.z = __builtin_amdgcn_alignbit(d3, d2, sh); aw.w = __builtin_amdgcn_alignbit(d4, d3, sh);
        const bf16x8 A = __builtin_bit_cast(bf16x8, aw);
#pragma unroll
        for (int m = 0; m < 16; ++m) { const bool on = KIND == 0 ? (m >= 16 - uu) : (KIND == 1 ? true : (m <= 15 - uu));
            if (on) acc[m] = __builtin_amdgcn_mfma_f32_16x16x32_bf16(A, Bw[(uu + m) & 15], acc[m], 0, 0, 0); }
    }
}
__device__ __forceinline__ void phase_hyena_mfma(const Params& p, const Ctx& c) {
    unsigned char* ws = p.ws;
    const bf16_t* hy = (const bf16_t*)(ws + WS_HY); const bf16_t* krev = (const bf16_t*)(ws + WS_KREV); bf16_t* zb = (bf16_t*)(ws + WS_ZB);
    LAS bf16_t* zl = (LAS bf16_t*)c.lds;
    LAS bf16_t* gl = zl + NB * ZROW;
    LAS bf16_t* krl = gl + NB * ZROW;
    const int i0 = 32 * (c.wid >> 1) + (c.wid & 1), fr = c.lane & 15, fq = c.lane >> 4;
    for (int ch = blockIdx.x; ch < BW; ch += gridDim.x) {
        __syncthreads();
        hy_fill2(zl, hy, ch, c.tid);
        for (int o = 0; o < 2; ++o) {
            hy_fill2(gl, hy, (o + 1) * 512 + ch, c.tid);
            for (int i = c.tid; i < KR_LEN / 8; i += NTHR) *(LAS u32x4*)(krl + 8 * i) = *(const u32x4*)(krev + ((size_t)o * 512 + ch) * KR_LEN + 8 * i);
            __syncthreads();
            pg8::f32x4 acc[16]; bf16x8 Bw[16];
#pragma unroll
            for (int m = 0; m < 16; ++m) { acc[m] = (pg8::f32x4){0.f, 0.f, 0.f, 0.f}; Bw[m] = (bf16x8){0, 0, 0, 0, 0, 0, 0, 0}; }
            hy_block<0>(acc, Bw, zl, krl, -16, i0, c.lane);
            for (int ub = 0; ub < 48; ub += 16) hy_block<1>(acc, Bw, zl, krl, ub, i0, c.lane);
            hy_block<2>(acc, Bw, zl, krl, 48, i0, c.lane);
            const float bias = p.hy_bias[o * 512 + ch];
            u32x2 res[16];
#pragma unroll
            for (int m = 0; m < 16; ++m) { const int t = 16 * (i0 + 2 * m) + 4 * fq; const u32x2 zo = *(const LAS u32x2*)(zl + fr * ZROW + t), gg = *(const LAS u32x2*)(gl + fr * ZROW + t);
                const float z0 = __uint_as_float(zo.x << 16), z1 = __uint_as_float(zo.x & 0xffff0000u), z2 = __uint_as_float(zo.y << 16), z3 = __uint_as_float(zo.y & 0xffff0000u);
                const float g0 = __uint_as_float(gg.x << 16), g1 = __uint_as_float(gg.x & 0xffff0000u), g2 = __uint_as_float(gg.y << 16), g3 = __uint_as_float(gg.y & 0xffff0000u);
                res[m].x = pk2(g0 * (acc[m][0] + bias * z0), g1 * (acc[m][1] + bias * z1)); res[m].y = pk2(g2 * (acc[m][2] + bias * z2), g3 * (acc[m][3] + bias * z3)); }
            __syncthreads();
#pragma unroll
            for (int m = 0; m < 16; ++m) { const int t = 16 * (i0 + 2 * m) + 4 * fq;
                if (o == 0) *(LAS u32x2*)(zl + fr * ZROW + t) = res[m]; else *(u32x2*)(zb + ((size_t)ch * NB + fr) * SEQ + t) = res[m]; }
        }
    }
}

__device__ __forceinline__ void phase_combine(const Params& p, const Ctx& c) {
    unsigned char* ws = p.ws;
    const float* ofw = (const float*)(ws + WS_OFW); const float* obw = (const float*)(ws + WS_OBW); const bf16_t* g = (const bf16_t*)(ws + WS_G);
    bf16_t* oa = (bf16_t*)(ws + WS_OA); bf16_t* ob = (bf16_t*)(ws + WS_OB); const bf16_t* zb = (const bf16_t*)(ws + WS_ZB);
    for (int row = c.gw; row < T; row += c.ngw) { const int col = 8 * c.lane; float a[8], bq[8], gg[8], w[8], o[8];
        load_f32x8(ofw + (size_t)row * 512 + col, a); load_f32x8(obw + (size_t)row * 512 + col, bq); load_bf16x8(g + (size_t)row * 512 + col, gg); load_f32x8(p.a_norm_w + (col & 127), w);
        float s = 0.f;
#pragma unroll
        for (int j = 0; j < 8; ++j) { a[j] += bq[j]; s += a[j] * a[j]; }
        s += __shfl_xor(s, 1); s += __shfl_xor(s, 2); s += __shfl_xor(s, 4); s += __shfl_xor(s, 8);
        const float rs = 1.0f / sqrtf(s * (1.0f / 128.0f) + RMS_EPS);
#pragma unroll
        for (int j = 0; j < 8; ++j) o[j] = a[j] * rs * w[j] * gg[j];
        store_bf16x8(oa + (size_t)row * 512 + col, o); }
    LAS bf16_t* tile = (LAS bf16_t*)c.lds;
    for (int it = blockIdx.x; it < NB * 32 * 8; it += gridDim.x) { const int cb = it & 7, tb = (it >> 3) & 31, b = it >> 8;
        __syncthreads();
        { const int cl = c.tid >> 3, t8 = (c.tid & 7) * 8; const u32x4 w = *(const u32x4*)(zb + ((size_t)(cb * 64 + cl) * NB + b) * SEQ + tb * 64 + t8); *(LAS u32x4*)(tile + cl * 72 + t8) = w; }
        __syncthreads();
        { const int tl = c.tid >> 3, c8 = (c.tid & 7) * 8; bf16_t v[8];
#pragma unroll
          for (int i = 0; i < 8; ++i) v[i] = tile[(c8 + i) * 72 + tl];
          u32x4 w; w.x = v[0] | ((unsigned)v[1] << 16); w.y = v[2] | ((unsigned)v[3] << 16); w.z = v[4] | ((unsigned)v[5] << 16); w.w = v[6] | ((unsigned)v[7] << 16);
          *(u32x4*)(ob + ((size_t)b * SEQ + tb * 64 + tl) * 512 + cb * 64 + c8) = w; }
    }
}

__device__ __forceinline__ void phase_rstd(const float* ssq, float* rstd, int nrows, const Ctx& c) {
    for (int row = blockIdx.x * NTHR + c.tid; row < nrows; row += gridDim.x * NTHR) rstd[row] = rstd_from_ssq(ssq + (size_t)row * 16);
}
__device__ __forceinline__ void phase_final(const Params& p, const Ctx& c) {
    const float* ssq = (const float*)(p.ws + WS_SSQ3);
    for (int row = c.gw; row < T; row += c.ngw) { const float rs = rstd_from_ssq(ssq + (size_t)row * 16);
#pragma unroll
        for (int j = 0; j < 4; ++j) { const int col = 4 * c.lane + 256 * j; f32x4* ptr = (f32x4*)(p.out + (size_t)row * D + col); *ptr = *ptr * rs * *(const f32x4*)(p.fnw + col); } }
}


#define XB_TMO      128
#define XB_XCNT(j)  (256  + 64 * (j))
#define XB_XSUB(j)  (1280 + 64 * (j))
#define XB_XGEN(j)  (2304 + 64 * (j))
#define XB_TOP      3328
#define XB_TOPGEN   3392
#define XCD_BAR_WORDS 3456
#define XB_SPIN_CAP (1u << 18)
__device__ __forceinline__ unsigned xb_ld(unsigned* p)              { return __hip_atomic_load(p, __ATOMIC_RELAXED, __HIP_MEMORY_SCOPE_AGENT); }
__device__ __forceinline__ unsigned xb_add(unsigned* p, unsigned v) { return __hip_atomic_fetch_add(p, v, __ATOMIC_RELAXED, __HIP_MEMORY_SCOPE_AGENT); }
__device__ __forceinline__ unsigned xb_xcc_id() { return (unsigned)__builtin_amdgcn_s_getreg((3 << 11) | 20) & 0xFu; }
#define XB_SPIN(cond, bar) do { unsigned _sp = 0; while (cond) { __builtin_amdgcn_s_sleep(1); \
    if ((++_sp & 255u) == 0u) { if (xb_ld(&(bar)[XB_TMO])) break; if (_sp > XB_SPIN_CAP) { atomicAdd(&(bar)[XB_TMO], 1u); break; } } } } while (0)
struct XcdBarrier { unsigned* bar; unsigned x; volatile LAS unsigned* st; };
__device__ __forceinline__ XcdBarrier xcd_barrier_post(unsigned* bar, volatile LAS unsigned* st) {
    XcdBarrier b; b.bar = bar; b.x = xb_xcc_id(); b.st = st;
    if (threadIdx.x == 0) (void)xb_add(&bar[XB_XCNT(b.x)], 1u);
    return b;
}
__device__ __forceinline__ void xcd_barrier_complete(unsigned* bar, unsigned x, unsigned& nloc, unsigned& nx) {
    const unsigned G = gridDim.x * gridDim.y * gridDim.z;
    unsigned sum, cnt, mine, sp = 0u;
    for (;;) {
        sum = 0u; cnt = 0u; mine = 0u;
#pragma unroll
        for (unsigned j = 0; j < 16; ++j) { const unsigned c = xb_ld(&bar[XB_XCNT(j)]); sum += c; cnt += (c > 0u) ? 1u : 0u; mine = (j == x) ? c : mine; }
        if (sum == G) break;
        __builtin_amdgcn_s_sleep(1);
        if ((++sp & 255u) == 0u) { if (xb_ld(&bar[XB_TMO])) break; if (sp > XB_SPIN_CAP) { atomicAdd(&bar[XB_TMO], 1u); break; } }
    }
    nloc = mine > 0u ? mine : 1u; nx = cnt > 0u ? cnt : 1u;
}
__device__ __forceinline__ void xcd_barrier(const XcdBarrier& b) {
    asm volatile("s_waitcnt vmcnt(0)" ::: "memory");
    __syncthreads();
    if (threadIdx.x == 0) {
        unsigned* bar = b.bar;
        __builtin_amdgcn_s_waitcnt(0);
        unsigned nloc = b.st[0], nx = b.st[1];
        if (nloc == 0u) { xcd_barrier_complete(bar, b.x, nloc, nx); b.st[0] = nloc; b.st[1] = nx; }
        const unsigned old = xb_add(&bar[XB_XSUB(b.x)], 1u);
        const unsigned gen = old / nloc;
        if (old + 1u == (gen + 1u) * nloc) {
            __builtin_amdgcn_fence(__ATOMIC_RELEASE, "agent");
            asm volatile("s_waitcnt vmcnt(0)" ::: "memory");
            const unsigned og = xb_add(&bar[XB_TOP], 1u);
            const unsigned tg = og / nx;
            if (og + 1u == (tg + 1u) * nx) xb_add(&bar[XB_TOPGEN], 1u);
            else XB_SPIN(xb_ld(&bar[XB_TOPGEN]) == tg, bar);
            __builtin_amdgcn_fence(__ATOMIC_ACQUIRE, "agent");
            xb_add(&bar[XB_XGEN(b.x)], 1u);
            asm volatile("s_waitcnt vmcnt(0)" ::: "memory");
        } else {
            XB_SPIN(xb_ld(&bar[XB_XGEN(b.x)]) == gen, bar);
            __builtin_amdgcn_fence(__ATOMIC_ACQUIRE, "agent");
            asm volatile("s_waitcnt vmcnt(0)" ::: "memory");
        }
    }
    __syncthreads();
}

constexpr int N_PHASES = 16;
#ifndef REPEAT_MASK
#define REPEAT_MASK 0
#endif
#ifndef HOST_REPEAT_MASK
#define HOST_REPEAT_MASK 0
#endif
#ifndef USE_XCD_BARRIER
#define USE_XCD_BARRIER 1
#endif
__global__ void __launch_bounds__(NTHR, 2) fwd_kernel(Params p) {
    extern __shared__ __attribute__((aligned(16))) unsigned char lds_raw[];
    Ctx c; c.lds = (LAS unsigned char*)lds_raw; c.tid = threadIdx.x; c.lane = c.tid & 63; c.wid = __builtin_amdgcn_readfirstlane(c.tid >> 6);
    c.gw = blockIdx.x * NWAVES + c.wid; c.ngw = gridDim.x * NWAVES;
    unsigned char* ws = p.ws;
    const float* modv = (const float*)(ws + WS_MODV);
#if N_LAUNCH_MODE == 1
    cg::grid_group grid = cg::this_grid();
#if USE_XCD_BARRIER
    volatile LAS unsigned* xst = (volatile LAS unsigned*)(c.lds + LDS_BYTES - 16);
    if (c.tid < 4) xst[c.tid] = 0u;
    __syncthreads();
    XcdBarrier xbar = xcd_barrier_post((unsigned*)(ws + WS_CTL), xst);
    bool first_seam = true;
#define SEAM() do { if (first_seam) { grid.sync(); first_seam = false; } else xcd_barrier(xbar); } while (0)
#else
#define SEAM() grid.sync()
#endif
#else
#define SEAM() do { } while (0)
#endif
#ifdef ONLY_PHASE
#define IN(k) ((k) == ONLY_PHASE && p.ph_lo <= (k) && (k) < p.ph_hi)
#else
#define IN(k) (p.ph_lo <= (k) && (k) < p.ph_hi)
#endif
#define PHASE(k, ...) if (IN(k)) { for (int rep_ = 0; rep_ <= ((REPEAT_MASK >> (k)) & 1); ++rep_) { __VA_ARGS__; if (rep_ < ((REPEAT_MASK >> (k)) & 1)) SEAM(); } if (IN((k) + 1)) SEAM(); }
#if USE_PG8
#define GEMM2(A_, Bt_, K_, nrows1_, npn1_, nrows2_, npn2_, E_, ssq_) gemm_mfma(c.lds, A_, Bt_, K_, nrows1_, npn1_, nrows2_, npn2_, E_, ssq_)
#else
#define GEMM2(A_, Bt_, K_, nrows1_, npn1_, nrows2_, npn2_, E_, ssq_) do { gemm_simple(c.lds, A_, Bt_, K_, 0, nrows1_, npn1_, E_, ssq_); if ((nrows2_) > 0) gemm_simple(c.lds, A_, Bt_, K_, nrows1_, nrows2_, npn2_, E_, ssq_); } while (0)
#endif
#define GEMM(A_, Bt_, K_, nrows_, npn_, E_, ssq_) GEMM2(A_, Bt_, K_, nrows_, npn_, 0, 0, E_, ssq_)
    PHASE(0, phase_prep(p, c))
    PHASE(1, phase_n1(p, c))
    PHASE(2, { EpiGateUp1 E{(bf16_t*)(ws + WS_HID)};
        GEMM((const bf16_t*)(ws + WS_N1), (const bf16_t*)(ws + WS_WG1_T), D, MT, NGU / 256, E, nullptr); })
    PHASE(3, { EpiDown1 E{p.ctx, modv, p.out, (bf16_t*)(ws + WS_A2)};
        GEMM((const bf16_t*)(ws + WS_HID), (const bf16_t*)(ws + WS_WD1_T), DFF, MT, D / 256, E, (float*)(ws + WS_SSQ1)); })
    PHASE(4, phase_rstd((const float*)(ws + WS_SSQ1), (float*)(ws + WS_RSTD1), MT, c))
    PHASE(5, { EpiWin E{(const float*)(ws + WS_RSTD1), (const float*)(ws + WS_SWIN), (const float*)(ws + WS_LBV), (bf16_t*)(ws + WS_V), (bf16_t*)(ws + WS_Q), (bf16_t*)(ws + WS_G), (bf16_t*)(ws + WS_HY), (bf16_t*)(ws + WS_GAB), (f16_t*)(ws + WS_LFW), (f16_t*)(ws + WS_LBW)};
        GEMM2((const bf16_t*)(ws + WS_A2), (const bf16_t*)(ws + WS_WIN_T), D, T, NIN / 256, TC, 6, E, nullptr); })
    PHASE(6, {
        { LAS float* scr = (LAS float*)(c.lds + c.wid * 8448);
          transpose_gu(p.ffn_wg + (size_t)D * DFF, 0, (bf16_t*)(ws + WS_WG2_T), scr, c.gw, c.ngw, c.lane);
          transpose_gu(p.ffn_wu + (size_t)D * DFF, 1, (bf16_t*)(ws + WS_WG2_T), scr, c.gw, c.ngw, c.lane);
          transpose_matrix(p.ffn_wd + (size_t)DFF * D, DFF, D, (bf16_t*)(ws + WS_WD2_T), scr, c.gw, c.ngw, c.lane); }
        __syncthreads();
        phase_hy_prepass(p, c); })
    PHASE(7, phase_hyena_mfma(p, c))
    PHASE(8, { if (USE_MFMA_HGRN) phase_hgrn_mfma(p, c); else phase_hgrn_simple(p, c); })
    PHASE(9, phase_combine(p, c))
    PHASE(10, { EpiProjA EA{(const bf16_t*)(ws + WS_GAB), (float*)(ws + WS_YTMP)}; EpiProjB EB{(const bf16_t*)(ws + WS_GAB), (const float*)(ws + WS_YTMP), (bf16_t*)(ws + WS_Y)};
        GEMM((const bf16_t*)(ws + WS_OA), (const bf16_t*)(ws + WS_WPA_T), 512, T, D / 256, EA, nullptr);
        GEMM((const bf16_t*)(ws + WS_OB), (const bf16_t*)(ws + WS_WPB_T), 512, T, D / 256, EB, nullptr); })
    PHASE(11, { EpiWout E{modv, p.out, (bf16_t*)(ws + WS_A3)};
        GEMM((const bf16_t*)(ws + WS_Y), (const bf16_t*)(ws + WS_WOUT_T), D, T, D / 256, E, (float*)(ws + WS_SSQ2)); })
    PHASE(12, phase_rstd((const float*)(ws + WS_SSQ2), (float*)(ws + WS_RSTD2), T, c))
    PHASE(13, { EpiGateUp2 E{(bf16_t*)(ws + WS_HID2), (const float*)(ws + WS_RSTD2), (const float*)(ws + WS_SW2)};
        GEMM((const bf16_t*)(ws + WS_A3), (const bf16_t*)(ws + WS_WG2_T), D, T, NGU / 256, E, nullptr); })
    PHASE(14, { EpiDown2 E{modv, p.out};
        GEMM((const bf16_t*)(ws + WS_HID2), (const bf16_t*)(ws + WS_WD2_T), DFF, T, D / 256, E, (float*)(ws + WS_SSQ3)); })
    PHASE(15, phase_final(p, c))
}

extern "C" void kernel_launch(void* const* d_in, const int* in_sizes, int n_in, void* d_out, int out_size, void* d_ws, size_t ws_size, hipStream_t stream) {
    static int grid = 0;
    if (grid == 0) {
        if (n_in != 26 || in_sizes[0] != T * D || out_size != T * D || ws_size < WS_TOTAL) { fprintf(stderr, "kernel_launch: unexpected shapes (n_in %d, in0 %d, out %d, ws %zu < %zu)\n", n_in, n_in > 0 ? in_sizes[0] : -1, out_size, ws_size, (size_t)WS_TOTAL); grid = -1; return; }
        int dev = 0, cus = 0, per_cu = 0;
        (void)hipGetDevice(&dev); (void)hipDeviceGetAttribute(&cus, hipDeviceAttributeMultiprocessorCount, dev);
        if (hipFuncSetAttribute((const void*)fwd_kernel, hipFuncAttributeMaxDynamicSharedMemorySize, LDS_BYTES) != hipSuccess) { fprintf(stderr, "kernel_launch: hipFuncSetAttribute failed\n"); grid = -1; return; }
        (void)hipOccupancyMaxActiveBlocksPerMultiprocessor(&per_cu, (const void*)fwd_kernel, NTHR, LDS_BYTES);
        if (per_cu < 1) { fprintf(stderr, "kernel_launch: occupancy query says %d blocks per CU\n", per_cu); per_cu = 1; }
        (void)hipGetLastError();
        grid = cus;
    }
    if (grid < 0) return;
    Params p{};
    const float** f = (const float**)&p;
    for (int i = 0; i < 26; ++i) f[i] = (const float*)d_in[i];
    p.out = (float*)d_out; p.ws = (unsigned char*)d_ws;
#if N_LAUNCH_MODE == 1
    p.ph_lo = 0; p.ph_hi = N_PHASES;
#if USE_XCD_BARRIER
    (void)hipMemsetAsync((unsigned char*)d_ws + WS_CTL, 0, XCD_BAR_WORDS * 4, stream);
#endif
    void* args[] = {&p};
    hipError_t e = hipLaunchCooperativeKernel((const void*)fwd_kernel, dim3(grid), dim3(NTHR), args, LDS_BYTES, stream);
    if (e != hipSuccess) fprintf(stderr, "cooperative launch failed: %s (grid %d)\n", hipGetErrorString(e), grid);
#else
    for (int k = 0; k < N_PHASES; ++k) { p.ph_lo = k; p.ph_hi = k + 1; for (int r = 0; r <= ((HOST_REPEAT_MASK >> k) & 1); ++r) hipLaunchKernelGGL(fwd_kernel, dim3(grid), dim3(NTHR), LDS_BYTES, stream, p); }
#endif
}
```

```cpp
#include <hip/hip_runtime.h>
#include <hip/hip_cooperative_groups.h>
#include <cstdio>
namespace cg = cooperative_groups;

#ifndef N_LAUNCH_MODE
#define N_LAUNCH_MODE 1
#endif
#ifndef USE_MFMA_HYENA
#define USE_MFMA_HYENA 1
#endif
#ifndef USE_MFMA_HGRN
#define USE_MFMA_HGRN 1
#endif
#ifndef USE_PG8
#define USE_PG8 1
#endif

#define LAS __attribute__((address_space(3)))
typedef unsigned short bf16_t;
typedef _Float16 f16_t;
typedef float f32x4 __attribute__((ext_vector_type(4)));
typedef unsigned u32x4 __attribute__((ext_vector_type(4)));
typedef unsigned u32x2 __attribute__((ext_vector_type(2)));

constexpr int D = 1024, NB = 16, SEQ = 2048, T = NB * SEQ, CL = 256, TC = NB * CL, MT = T + TC;
constexpr int DFF = 2816, NGU = 2 * DFF, NIN = 6144, MODW = 9 * D;
constexpr int AKW = 512, AVW = 512, BW = 512, NHY = 3 * BW;
constexpr int KR_LEN = 4128, KR_OFF = 2056;
constexpr float RMS_EPS = 1e-6f;
constexpr int NTHR = 512, NWAVES = 8;
constexpr int LDS_BYTES = 152 * 1024;

constexpr size_t MiB = 1024 * 1024;
constexpr size_t al256(size_t x) { return (x + 255) & ~(size_t)255; }
constexpr size_t WS_CTL = 0;
constexpr size_t WS_MODV = WS_CTL + 65536;
constexpr size_t WS_SWIN = WS_MODV + al256((size_t)17 * MODW * 4);
constexpr size_t WS_SW2 = WS_SWIN + al256((size_t)17 * NIN * 4);
constexpr size_t WS_ER = WS_SW2 + al256((size_t)17 * NGU * 4);
constexpr size_t WS_EC = WS_ER + 32 * 512 * 4;
constexpr size_t WS_LBV = WS_EC + 64 * 512 * 4;
constexpr size_t WS_H2 = WS_LBV + 4096;
constexpr size_t WS_KREV = WS_H2 + 2048 * 64 * 4;
constexpr size_t WS_WIN_T = WS_KREV + al256((size_t)2 * 512 * KR_LEN * 2);
constexpr size_t WS_WPA_T = WS_WIN_T + (size_t)NIN * D * 2;
constexpr size_t WS_WPB_T = WS_WPA_T + (size_t)D * 512 * 2;
constexpr size_t WS_WOUT_T = WS_WPB_T + (size_t)D * 512 * 2;
constexpr size_t WS_RSTD1 = WS_WOUT_T + (size_t)D * D * 2;
constexpr size_t WS_RSTD2 = WS_RSTD1 + (size_t)MT * 4;
constexpr size_t WS_PERSIST_END = WS_RSTD2 + (size_t)T * 4;
constexpr size_t AR = 27 * MiB;
static_assert(WS_PERSIST_END <= AR, "persistent region");
constexpr size_t WS_HID = AR + 0 * MiB;
constexpr size_t WS_N1 = AR + 198 * MiB;
constexpr size_t WS_WG1_T = AR + 270 * MiB;
constexpr size_t WS_WD1_T = AR + 281 * MiB;
constexpr size_t WS_SSQ1 = AR + 410 * MiB;
constexpr size_t WS_A2 = AR + 413 * MiB;
constexpr size_t WS_GAB = AR + 0 * MiB;
constexpr size_t WS_V = AR + 128 * MiB;
constexpr size_t WS_LFW = AR + 164 * MiB;
constexpr size_t WS_LBW = AR + 200 * MiB;
constexpr size_t WS_Q = AR + 236 * MiB;
constexpr size_t WS_G = AR + 268 * MiB;
constexpr size_t WS_HY = AR + 300 * MiB;
constexpr size_t WS_WG2_T = AR + 436 * MiB;
constexpr size_t WS_WD2_T = AR + 447 * MiB;
constexpr size_t WS_ZB = AR + 453 * MiB;
constexpr size_t WS_OFW = AR + 300 * MiB;
constexpr size_t WS_OBW = AR + 364 * MiB;
constexpr size_t WS_OA = AR + 128 * MiB;
constexpr size_t WS_OB = AR + 160 * MiB;
constexpr size_t WS_YTMP = AR + 192 * MiB;
constexpr size_t WS_Y = AR + 320 * MiB;
constexpr size_t WS_A3 = AR + 0 * MiB;
constexpr size_t WS_SSQ2 = AR + 64 * MiB;
constexpr size_t WS_SSQ3 = AR + 66 * MiB;
constexpr size_t WS_HID2 = AR + 128 * MiB;
constexpr size_t WS_TOTAL = AR + 485 * MiB;

struct Params {
    const float *x, *c, *ctx, *c_ctx, *mod_w, *mod_b, *ffn_wg, *ffn_wu, *ffn_wd, *w_in, *lb_logits, *a_norm_w, *conv_w, *conv_b;
    const float *hw1, *hb1, *hfr1, *hw2, *hb2, *hfr2, *hw3, *hy_bias, *w_pa, *w_pb, *w_out, *fnw;
    float* out; unsigned char* ws;
    int ph_lo, ph_hi;
};

__device__ __forceinline__ float bf2f(bf16_t b) { return __uint_as_float(((unsigned)b) << 16); }
__device__ __forceinline__ bf16_t f2bf(float f) { unsigned u = __float_as_uint(f); u += 0x7FFFu + ((u >> 16) & 1u); return (bf16_t)(u >> 16); }
typedef float f32x2_t __attribute__((ext_vector_type(2)));
typedef __bf16 bf16x2_t __attribute__((ext_vector_type(2)));
__device__ __forceinline__ unsigned pk2(float lo, float hi) { const f32x2_t v = {lo, hi}; return __builtin_bit_cast(unsigned, __builtin_convertvector(v, bf16x2_t)); }
__device__ __forceinline__ float bfround(float f) { return bf2f(f2bf(f)); }
__device__ __forceinline__ float sigmoidf_(float x) { return __builtin_amdgcn_rcpf(1.0f + __builtin_amdgcn_exp2f(x * -1.4426950408889634f)); }
__device__ __forceinline__ float siluf_(float x) { return x * sigmoidf_(x); }
__device__ __forceinline__ float wave_sum(float v) {
#pragma unroll
    for (int o = 1; o < 64; o <<= 1) v += __shfl_xor(v, o);
    return v;
}
__device__ __forceinline__ float pos_embed(const float* er, const float* ec, int t, int col) {
    return col < 512 ? er[(t >> 6) * 512 + col] : ec[(t & 63) * 512 + (col - 512)];
}
__device__ __forceinline__ float rstd_from_ssq(const float* ssq16) {
    const f32x4* s = (const f32x4*)ssq16; float tot = 0.f;
#pragma unroll
    for (int i = 0; i < 4; ++i) { const f32x4 v = s[i]; tot += (v[0] + v[1]) + (v[2] + v[3]); }
    return __builtin_amdgcn_rsqf(tot * (1.0f / D) + RMS_EPS);
}

__device__ __forceinline__ void transpose_item(const float* W, int K, int N, bf16_t* WT, int k0, int n0, int dst_row0, LAS float* scr, int lane) {
#pragma unroll 8
    for (int i = 0; i < 32; ++i) { const int kk = 2 * i + (lane >> 5); scr[kk * 33 + (lane & 31)] = W[(size_t)(k0 + kk) * N + n0 + (lane & 31)]; }
    asm volatile("s_waitcnt lgkmcnt(0)" ::: "memory");
    const int c = lane & 7;
#pragma unroll
    for (int j = 0; j < 4; ++j) { const int n = (lane >> 3) + 8 * j; const LAS float* s = scr + (8 * c) * 33 + n;
        u32x4 o; o.x = pk2(s[0 * 33], s[1 * 33]); o.y = pk2(s[2 * 33], s[3 * 33]); o.z = pk2(s[4 * 33], s[5 * 33]); o.w = pk2(s[6 * 33], s[7 * 33]);
        *(u32x4*)(WT + (size_t)(dst_row0 + n) * K + k0 + 8 * c) = o; }
    asm volatile("s_waitcnt lgkmcnt(0)" ::: "memory");
}
__device__ __forceinline__ void transpose_matrix(const float* W, int K, int N, bf16_t* WT, LAS float* scr, int gw, int ngw, int lane) {
    const int nblk = N / 32, items = (K / 64) * nblk;
    for (int it = gw; it < items; it += ngw) { const int kb = it / nblk, nb = it % nblk; transpose_item(W, K, N, WT, 64 * kb, 32 * nb, 32 * nb, scr, lane); }
}
__device__ __forceinline__ void transpose_gu(const float* W, int half, bf16_t* WT, LAS float* scr, int gw, int ngw, int lane) {
    const int nblk = DFF / 32, items = (D / 64) * nblk;
    for (int it = gw; it < items; it += ngw) { const int kb = it / nblk, nb = it % nblk, n0 = 32 * nb;
        transpose_item(W, D, DFF, WT, 64 * kb, n0, 256 * (n0 >> 7) + 128 * half + (n0 & 127), scr, lane); }
}

template <bool GU>
__device__ __forceinline__ void gemv17(const LAS float* xs, LAS float* part, const float* W, int N, const float* bias, float* out, int ldo, int half, int blk0, int nblk_stride) {
    const int tid = threadIdx.x, wid = tid >> 6, lane = tid & 63;
    for (int cb = blk0; cb < N / 64; cb += nblk_stride) {
        const int n = cb * 64 + lane;
        float acc[17];
#pragma unroll
        for (int r = 0; r < 17; ++r) acc[r] = 0.f;
        const float* wp = W + (size_t)(wid * 128) * N + n;
#pragma unroll 4
        for (int k = 0; k < 128; ++k) { const float w = wp[(size_t)k * N];
#pragma unroll
            for (int r = 0; r < 17; ++r) acc[r] += xs[r * 1024 + wid * 128 + k] * w; }
#pragma unroll
        for (int r = 0; r < 17; ++r) part[(wid * 17 + r) * 64 + lane] = acc[r];
        __syncthreads();
        for (int o = tid; o < 17 * 64; o += NTHR) { const int r = o >> 6, l = o & 63; float s = 0.f;
#pragma unroll
            for (int w = 0; w < 8; ++w) s += part[(w * 17 + r) * 64 + l];
            const int nn = cb * 64 + l; if (bias) s += bias[nn];
            const int on = GU ? (256 * (nn >> 7) + 128 * half + (nn & 127)) : nn;
            out[(size_t)r * ldo + on] = s; }
        __syncthreads();
    }
}

__device__ __forceinline__ void store_bf16x8(bf16_t* p, const float (&v)[8]) { u32x4 w; w.x = pk2(v[0], v[1]); w.y = pk2(v[2], v[3]); w.z = pk2(v[4], v[5]); w.w = pk2(v[6], v[7]); *(u32x4*)p = w; }
__device__ __forceinline__ void load_f32x8(const float* p, float (&v)[8]) { const f32x4 a = *(const f32x4*)p, b = *(const f32x4*)(p + 4); v[0] = a[0]; v[1] = a[1]; v[2] = a[2]; v[3] = a[3]; v[4] = b[0]; v[5] = b[1]; v[6] = b[2]; v[7] = b[3]; }
__device__ __forceinline__ void store_f32x8(float* p, const float (&v)[8]) { *(f32x4*)p = (f32x4){v[0], v[1], v[2], v[3]}; *(f32x4*)(p + 4) = (f32x4){v[4], v[5], v[6], v[7]}; }
__device__ __forceinline__ void unpack_bf16x8(const u32x4 w, float (&v)[8]) { v[0] = __uint_as_float(w.x << 16); v[1] = __uint_as_float(w.x & 0xffff0000u); v[2] = __uint_as_float(w.y << 16); v[3] = __uint_as_float(w.y & 0xffff0000u);
    v[4] = __uint_as_float(w.z << 16); v[5] = __uint_as_float(w.z & 0xffff0000u); v[6] = __uint_as_float(w.w << 16); v[7] = __uint_as_float(w.w & 0xffff0000u); }
__device__ __forceinline__ void load_bf16x8(const bf16_t* p, float (&v)[8]) { const u32x4 w = *(const u32x4*)p; v[0] = __uint_as_float(w.x << 16); v[1] = __uint_as_float(w.x & 0xffff0000u); v[2] = __uint_as_float(w.y << 16); v[3] = __uint_as_float(w.y & 0xffff0000u);
    v[4] = __uint_as_float(w.z << 16); v[5] = __uint_as_float(w.z & 0xffff0000u); v[6] = __uint_as_float(w.w << 16); v[7] = __uint_as_float(w.w & 0xffff0000u); }

struct EpiGateUp1 {
    static constexpr int PD = 1;
    struct Cols {}; struct Row {};
    bf16_t* hid;
    __device__ __forceinline__ void load_cols(Cols&, int, int, int) const {}
    __device__ __forceinline__ void load_row(Row&, int, int, int) const {}
    __device__ __forceinline__ float finish(int row, int pn, int c, const float (&v0)[8], const float (&v1)[8], const Cols&, const Row&) const {
        float o[8];
#pragma unroll
        for (int j = 0; j < 8; ++j) o[j] = siluf_(v0[j]) * v1[j];
        store_bf16x8(hid + (size_t)row * DFF + 128 * pn + c, o); return 0.f; }
};
struct EpiGateUp2 {
    static constexpr int PD = 8;
    struct Cols { float s0[8], s1[8]; }; struct Row { float rs; };
    bf16_t* hid; const float* rstd; const float* sw;
    __device__ __forceinline__ void load_cols(Cols& k, int pm, int pn, int c) const { const int b = pm >> 3; load_f32x8(sw + (size_t)b * NGU + 256 * pn + c, k.s0); load_f32x8(sw + (size_t)b * NGU + 256 * pn + 128 + c, k.s1); }
    __device__ __forceinline__ void load_row(Row& r, int row, int, int) const { r.rs = rstd[row]; }
    __device__ __forceinline__ float finish(int row, int pn, int c, const float (&v0)[8], const float (&v1)[8], const Cols& k, const Row& r) const {
        float o[8];
#pragma unroll
        for (int j = 0; j < 8; ++j) o[j] = siluf_(r.rs * v0[j] + k.s0[j]) * (r.rs * v1[j] + k.s1[j]);
        store_bf16x8(hid + (size_t)row * DFF + 128 * pn + c, o); return 0.f; }
};
struct EpiDown1 {
    static constexpr int PD = 2;
    struct Cols { float g0[8], g1[8], s0[8], s1[8]; }; struct Row { float b0[8], b1[8]; };
    const float *ctx, *modv; float* h; bf16_t* a2;
    __device__ __forceinline__ void load_cols(Cols& k, int pm, int pn, int c) const { const int b = pm < T / 256 ? (pm >> 3) : 16; const float* m = modv + (size_t)b * MODW + 256 * pn + c;
        load_f32x8(m + 2 * D, k.g0); load_f32x8(m + 2 * D + 128, k.g1); load_f32x8(m + 4 * D, k.s0); load_f32x8(m + 4 * D + 128, k.s1); }
    __device__ __forceinline__ void load_row(Row& r, int row, int pn, int c) const { const float* src = (row < T ? h + (size_t)row * D : ctx + (size_t)(row - T) * D) + 256 * pn + c; load_f32x8(src, r.b0); load_f32x8(src + 128, r.b1); }
    __device__ __forceinline__ float finish(int row, int pn, int c, const float (&v0)[8], const float (&v1)[8], const Cols& k, const Row& r) const {
        float h0[8], h1[8], a0[8], a1[8]; float s = 0.f;
#pragma unroll
        for (int j = 0; j < 8; ++j) { h0[j] = r.b0[j] + 0.5f * k.g0[j] * v0[j]; h1[j] = r.b1[j] + 0.5f * k.g1[j] * v1[j]; s += h0[j] * h0[j] + h1[j] * h1[j]; a0[j] = h0[j] * (1.0f + k.s0[j]); a1[j] = h1[j] * (1.0f + k.s1[j]); }
        const size_t o = (size_t)row * D + 256 * pn + c;
        if (row < T) { store_f32x8(h + o, h0); store_f32x8(h + o + 128, h1); }
        store_bf16x8(a2 + o, a0); store_bf16x8(a2 + o + 128, a1); return s; }
};
struct EpiWin {
    static constexpr int PD = 8;
    struct Cols { float s0[8], s1[8], l0[8], l1[8]; }; struct Row { float rs; };
    const float *rstd, *sw, *lbv; bf16_t *v, *q, *g, *hy, *gab; f16_t *lfw, *lbw;
    __device__ __forceinline__ void load_cols(Cols& k, int pm, int pn, int c) const { const int b = pm < T / 256 ? (pm >> 3) : 16; const int n = 256 * pn + c;
        load_f32x8(sw + (size_t)b * NIN + n, k.s0); load_f32x8(sw + (size_t)b * NIN + n + 128, k.s1);
        if (pn >= 2 && pn < 6) { load_f32x8(lbv + n - 512, k.l0); load_f32x8(lbv + n - 512 + 128, k.l1); } }
    __device__ __forceinline__ void load_row(Row& r, int row, int, int) const { r.rs = rstd[row]; }
    __device__ __forceinline__ void half_(int row, int n, float rs, const float (&a)[8], const float (&s)[8], const float (&lb)[8]) const {
        float p[8];
#pragma unroll
        for (int j = 0; j < 8; ++j) p[j] = rs * a[j] + s[j];
        const int grp = n >> 9;
        if (grp == 0) { store_bf16x8(v + (size_t)row * 512 + n, p); }
        else if (grp <= 2) { const int nn = n - 512 * grp; f16_t* dst = (grp == 1 ? lfw : lbw) + (size_t)row * 512 + nn; f16_t o[8];
#pragma unroll
            for (int j = 0; j < 8; ++j) { const float f = lb[j] + (1.0f - lb[j]) * sigmoidf_(p[j]); o[j] = (f16_t)(__builtin_amdgcn_logf(f) * 0.6931471805599453f); }
            *(u32x4*)dst = *(const u32x4*)o; }
        else if (grp == 3) {
#pragma unroll
            for (int j = 0; j < 8; ++j) p[j] = siluf_(p[j]);
            store_bf16x8(q + (size_t)row * 512 + (n - 1536), p); }
        else if (grp == 4) {
#pragma unroll
            for (int j = 0; j < 8; ++j) p[j] = siluf_(p[j]);
            store_bf16x8(g + (size_t)row * 512 + (n - 2048), p); }
        else if (grp <= 7) { const int ch = n - 2560, t = row & (SEQ - 1), b = row >> 11; store_bf16x8(hy + (((size_t)(ch >> 3) * NB + b) * SEQ + t) * 8, p); }
        else {
#pragma unroll
            for (int j = 0; j < 8; ++j) p[j] = sigmoidf_(p[j]);
            store_bf16x8(gab + (size_t)row * 2048 + (n - 4096), p); }
    }
    __device__ __forceinline__ float finish(int row, int pn, int c, const float (&v0)[8], const float (&v1)[8], const Cols& k, const Row& r) const {
        half_(row, 256 * pn + c, r.rs, v0, k.s0, k.l0); half_(row, 256 * pn + 128 + c, r.rs, v1, k.s1, k.l1); return 0.f; }
};
struct EpiProjA {
    static constexpr int PD = 4;
    struct Cols {}; struct Row { u32x4 g0, g1; };
    const bf16_t* gab; float* ytmp;
    __device__ __forceinline__ void load_cols(Cols&, int, int, int) const {}
    __device__ __forceinline__ void load_row(Row& r, int row, int pn, int c) const { const bf16_t* src = gab + (size_t)row * 2048 + 256 * pn + c; r.g0 = *(const u32x4*)src; r.g1 = *(const u32x4*)(src + 128); }
    __device__ __forceinline__ float finish(int row, int pn, int c, const float (&v0)[8], const float (&v1)[8], const Cols&, const Row& r) const {
        float g0[8], g1[8], o0[8], o1[8]; unpack_bf16x8(r.g0, g0); unpack_bf16x8(r.g1, g1);
#pragma unroll
        for (int j = 0; j < 8; ++j) { o0[j] = g0[j] * v0[j]; o1[j] = g1[j] * v1[j]; }
        float* dst = ytmp + (size_t)row * D + 256 * pn + c; store_f32x8(dst, o0); store_f32x8(dst + 128, o1); return 0.f; }
};
struct EpiProjB {
    static constexpr int PD = 2;
    struct Cols {}; struct Row { u32x4 g0, g1; float y0[8], y1[8]; };
    const bf16_t* gab; const float* ytmp; bf16_t* y;
    __device__ __forceinline__ void load_cols(Cols&, int, int, int) const {}
    __device__ __forceinline__ void load_row(Row& r, int row, int pn, int c) const { const bf16_t* src = gab + (size_t)row * 2048 + 1024 + 256 * pn + c; r.g0 = *(const u32x4*)src; r.g1 = *(const u32x4*)(src + 128);
        const float* ys = ytmp + (size_t)row * D + 256 * pn + c; load_f32x8(ys, r.y0); load_f32x8(ys + 128, r.y1); }
    __device__ __forceinline__ float finish(int row, int pn, int c, const float (&v0)[8], const float (&v1)[8], const Cols&, const Row& r) const {
        float g0[8], g1[8], o0[8], o1[8]; unpack_bf16x8(r.g0, g0); unpack_bf16x8(r.g1, g1);
#pragma unroll
        for (int j = 0; j < 8; ++j) { o0[j] = r.y0[j] + g0[j] * v0[j]; o1[j] = r.y1[j] + g1[j] * v1[j]; }
        bf16_t* dst = y + (size_t)row * D + 256 * pn + c; store_bf16x8(dst, o0); store_bf16x8(dst + 128, o1); return 0.f; }
};
struct EpiWout {
    static constexpr int PD = 2;
    struct Cols { float g0[8], g1[8], s0[8], s1[8]; }; struct Row { float b0[8], b1[8]; };
    const float* modv; float* h; bf16_t* a3;
    __device__ __forceinline__ void load_cols(Cols& k, int pm, int pn, int c) const { const float* m = modv + (size_t)(pm >> 3) * MODW + 256 * pn + c;
        load_f32x8(m + 5 * D, k.g0); load_f32x8(m + 5 * D + 128, k.g1); load_f32x8(m + 7 * D, k.s0); load_f32x8(m + 7 * D + 128, k.s1); }
    __device__ __forceinline__ void load_row(Row& r, int row, int pn, int c) const { const float* src = h + (size_t)row * D + 256 * pn + c; load_f32x8(src, r.b0); load_f32x8(src + 128, r.b1); }
    __device__ __forceinline__ float finish(int row, int pn, int c, const float (&v0)[8], const float (&v1)[8], const Cols& k, const Row& r) const {
        float h0[8], h1[8], a0[8], a1[8]; float s = 0.f;
#pragma unroll
        for (int j = 0; j < 8; ++j) { h0[j] = r.b0[j] + k.g0[j] * v0[j]; h1[j] = r.b1[j] + k.g1[j] * v1[j]; s += h0[j] * h0[j] + h1[j] * h1[j]; a0[j] = h0[j] * (1.0f + k.s0[j]); a1[j] = h1[j] * (1.0f + k.s1[j]); }
        const size_t o = (size_t)row * D + 256 * pn + c;
        store_f32x8(h + o, h0); store_f32x8(h + o + 128, h1); store_bf16x8(a3 + o, a0); store_bf16x8(a3 + o + 128, a1); return s; }
};
struct EpiDown2 {
    static constexpr int PD = 2;
    struct Cols { float g0[8], g1[8]; }; struct Row { float b0[8], b1[8]; };
    const float* modv; float* h;
    __device__ __forceinline__ void load_cols(Cols& k, int pm, int pn, int c) const { const float* m = modv + (size_t)(pm >> 3) * MODW + 8 * D + 256 * pn + c; load_f32x8(m, k.g0); load_f32x8(m + 128, k.g1); }
    __device__ __forceinline__ void load_row(Row& r, int row, int pn, int c) const { const float* src = h + (size_t)row * D + 256 * pn + c; load_f32x8(src, r.b0); load_f32x8(src + 128, r.b1); }
    __device__ __forceinline__ float finish(int row, int pn, int c, const float (&v0)[8], const float (&v1)[8], const Cols& k, const Row& r) const {
        float h0[8], h1[8]; float s = 0.f;
#pragma unroll
        for (int j = 0; j < 8; ++j) { h0[j] = r.b0[j] + 0.5f * k.g0[j] * v0[j]; h1[j] = r.b1[j] + 0.5f * k.g1[j] * v1[j]; s += h0[j] * h0[j] + h1[j] * h1[j]; }
        const size_t o = (size_t)row * D + 256 * pn + c; store_f32x8(h + o, h0); store_f32x8(h + o + 128, h1); return s; }
};

template <class Epi>
__device__ __forceinline__ void gemm_simple(LAS unsigned char* lds, const bf16_t* A, const bf16_t* Bt, int K, int row0, int nrows, int npn, const Epi& E, float* ssq) {
    LAS float* As = (LAS float*)lds;
    LAS float* Bs = (LAS float*)(lds + 8192);
    const int tid = threadIdx.x, c8 = tid & 15, rg = tid >> 4;
    const int nrt = nrows / 64, nunits = nrt * npn;
    for (int unit = blockIdx.x; unit < nunits; unit += gridDim.x) {
        const int rt = unit / npn, pn = unit % npn, r0 = row0 + rt * 64;
        float a0[2][8], a1[2][8];
#pragma unroll
        for (int r = 0; r < 2; ++r)
#pragma unroll
            for (int j = 0; j < 8; ++j) { a0[r][j] = 0.f; a1[r][j] = 0.f; }
        for (int k0 = 0; k0 < K; k0 += 32) {
            { const int row = tid >> 3, kq = tid & 7; const u32x2 w = *(const u32x2*)(A + (size_t)(r0 + row) * K + k0 + 4 * kq);
              As[(4 * kq + 0) * 64 + row] = __uint_as_float(w.x << 16); As[(4 * kq + 1) * 64 + row] = __uint_as_float(w.x & 0xffff0000u);
              As[(4 * kq + 2) * 64 + row] = __uint_as_float(w.y << 16); As[(4 * kq + 3) * 64 + row] = __uint_as_float(w.y & 0xffff0000u); }
            { const int n = tid >> 1, kh = tid & 1; const bf16_t* src = Bt + (size_t)(pn * 256 + n) * K + k0 + 16 * kh; float t8[8];
              load_bf16x8(src, t8);
#pragma unroll
              for (int i = 0; i < 8; ++i) Bs[(16 * kh + i) * 256 + n] = t8[i];
              load_bf16x8(src + 8, t8);
#pragma unroll
              for (int i = 0; i < 8; ++i) Bs[(16 * kh + 8 + i) * 256 + n] = t8[i]; }
            __syncthreads();
#pragma unroll 8
            for (int k = 0; k < 32; ++k) {
                const float x0 = As[k * 64 + 2 * rg], x1 = As[k * 64 + 2 * rg + 1];
                const f32x4 b00 = *(const LAS f32x4*)(Bs + k * 256 + 8 * c8), b01 = *(const LAS f32x4*)(Bs + k * 256 + 8 * c8 + 4);
                const f32x4 b10 = *(const LAS f32x4*)(Bs + k * 256 + 128 + 8 * c8), b11 = *(const LAS f32x4*)(Bs + k * 256 + 128 + 8 * c8 + 4);
#pragma unroll
                for (int j = 0; j < 4; ++j) { a0[0][j] += x0 * b00[j]; a0[0][4 + j] += x0 * b01[j]; a1[0][j] += x0 * b10[j]; a1[0][4 + j] += x0 * b11[j];
                                              a0[1][j] += x1 * b00[j]; a0[1][4 + j] += x1 * b01[j]; a1[1][j] += x1 * b10[j]; a1[1][4 + j] += x1 * b11[j]; }
            }
            __syncthreads();
        }
#pragma unroll
        for (int r = 0; r < 2; ++r) { const int row = r0 + 2 * rg + r; typename Epi::Cols kc; typename Epi::Row kr; E.load_cols(kc, row >> 8, pn, 8 * c8); E.load_row(kr, row, pn, 8 * c8); float s = E.finish(row, pn, 8 * c8, a0[r], a1[r], kc, kr);
            s += __shfl_xor(s, 1); s += __shfl_xor(s, 2); s += __shfl_xor(s, 4); s += __shfl_xor(s, 8);
            if (ssq && c8 == 0) *(f32x4*)(ssq + (size_t)row * 16 + pn * 4) = (f32x4){s, 0.f, 0.f, 0.f}; }
    }
}

namespace pg8 {
#define PG8_LAS __attribute__((address_space(3)))
typedef unsigned short bf16_t;
typedef short bf16x8 __attribute__((ext_vector_type(8)));
typedef float f32x4 __attribute__((ext_vector_type(4)));
typedef unsigned u32x4 __attribute__((ext_vector_type(4)));
constexpr int BM = 256, BK = 64, HALF = 128, HTB = HALF * BK * 2  , STAGE_BYTES = 8 * HTB, NXCD = 8, WGM = 8;

__host__ __device__ __forceinline__ int lds_byte(int r, int c) { const int st = (r >> 4) * 2 + (c >> 5), rr = r & 15, cc = c & 31, ob = rr * 64 + cc * 2; return st * 1024 + (ob ^ (((ob >> 9) & 1) << 5)); }
__host__ __device__ __forceinline__ void stage_rc(int b, int& R, int& C) { const int st = b / 1024, sb = b % 1024, swz = sb ^ (((sb >> 9) & 1) << 5); R = (st >> 1) * 16 + swz / 64; C = (st & 1) * 32 + (swz % 64) / 2; }
__host__ __device__ __forceinline__ int perm32(int rho) { const int n = rho >> 4, i = rho & 15; return 8 * (i >> 2) + 4 * n + (i & 3); }

struct Unit { int pm, pn; };
struct Gemm { const bf16_t* A; const bf16_t* Bt; int M, N, K; };

struct StaticOrder {
    int nM, nN, nwg, G, c;
    __host__ __device__ void init(int M, int N, int G_, int c_) { nM = M / BM; nN = N / BM; nwg = nM * nN; G = G_; c = c_; }
    __host__ __device__ bool next(int i, Unit& u) const {
        const long L = (long)i * G + c; if (L >= nwg) return false;
        int wgid = (int)L; { const int q = nwg / NXCD, r = nwg % NXCD, xcd = wgid % NXCD, off = wgid / NXCD; wgid = (xcd < r ? xcd * (q + 1) : r * (q + 1) + (xcd - r) * q) + off; }
        const int nig = WGM * nN, gid = wgid / nig, fm = gid * WGM, gsz = (nM - fm) < WGM ? (nM - fm) : WGM;
        u.pm = fm + ((wgid % nig) % gsz); u.pn = (wgid % nig) / gsz; return true;
    }
    __device__ __forceinline__ void a_ready(const Unit&) const {}
    __device__ __forceinline__ void done(const Unit&) const {}
};
template <class Epi, class Sched>
__device__ __forceinline__ void gemm_phase(PG8_LAS unsigned char* lds, const Gemm g, const Sched& S, const Epi& E) {
    const int tid = threadIdx.x, wid = __builtin_amdgcn_readfirstlane(tid >> 6), lane = tid & 63, wr = wid >> 2, wc = wid & 3, fr = lane & 15, fq = lane >> 4;
    const int K = g.K, nt = K / BK;
    unsigned voffA[2], voffB[2];
#pragma unroll
    for (int i = 0; i < 2; ++i) { int R, C; stage_rc(tid * 16 + i * 8192, R, C); const int Rb = Epi::PERM ? ((R & ~31) + perm32(R & 31)) : R;
        voffA[i] = (unsigned)(R * K + C) * 2u; voffB[i] = (unsigned)(Rb * K + C) * 2u; }
    const size_t kstep = (size_t)(BK * 2);
    const size_t hstep = (size_t)HALF * K * 2;
    const size_t tstep = 2 * hstep;
    const unsigned ldsw = (unsigned)wid * 1024u;
    const int aoff = lds_byte(wr * 64 + fr, fq * 8), boff = lds_byte(wc * 32 + fr, fq * 8);
#define PG8_SA(b, h) (((b) * 2 + (h)) * HTB)
#define PG8_SB(b, h) ((4 + (b) * 2 + (h)) * HTB)
#define PG8_STAGE(bufoff, gbase, voff) do { _Pragma("unroll") for (int _i = 0; _i < 2; ++_i) \
        __builtin_amdgcn_global_load_lds((const unsigned*)((const char*)(gbase) + (voff)[_i]), (PG8_LAS unsigned*)(lds + (bufoff) + ldsw + _i * 8192), 16, 0, 0); } while (0)
#define PG8_LDA(dst, b, h) do { _Pragma("unroll") for (int m = 0; m < 4; ++m) _Pragma("unroll") for (int k = 0; k < 2; ++k) dst[m][k] = *(const PG8_LAS bf16x8*)(lds + PG8_SA(b, h) + aoff + m * 2048 + k * 1024); } while (0)
#define PG8_LDB(dst, b, h) do { _Pragma("unroll") for (int n = 0; n < 2; ++n) _Pragma("unroll") for (int k = 0; k < 2; ++k) dst[n][k] = *(const PG8_LAS bf16x8*)(lds + PG8_SB(b, h) + boff + n * 2048 + k * 1024); } while (0)
#define PG8_MMA(ai, bj, At, Bt) do { __builtin_amdgcn_s_setprio(1); _Pragma("unroll") for (int m = 0; m < 4; ++m) _Pragma("unroll") for (int n = 0; n < 2; ++n) _Pragma("unroll") for (int k = 0; k < 2; ++k) \
        acc[ai][bj][m][n] = __builtin_amdgcn_mfma_f32_16x16x32_bf16(Bt[n][k], At[m][k], acc[ai][bj][m][n], 0, 0, 0); __builtin_amdgcn_s_setprio(0); } while (0)
#define PG8_WAIT_V(n) asm volatile("s_waitcnt vmcnt(" #n ")" ::: "memory")
#define PG8_WAIT_L(n) asm volatile("s_waitcnt lgkmcnt(" #n ")" ::: "memory")
#define PG8_BAR __builtin_amdgcn_s_barrier()
#define PG8_SCHED __builtin_amdgcn_sched_barrier(0)
    Unit cur, nxt; int ui = 0;
    if (!S.next(0, cur)) return;
    f32x4 acc[2][2][4][2];
#pragma unroll
    for (int a = 0; a < 2; ++a)
#pragma unroll
        for (int b = 0; b < 2; ++b)
#pragma unroll
            for (int m = 0; m < 4; ++m)
#pragma unroll
                for (int n = 0; n < 2; ++n) acc[a][b][m][n] = (f32x4){0.f, 0.f, 0.f, 0.f};
    bf16x8 At[4][2], B0[2][2], B1[2][2];
    const char* cA = (const char*)g.A + (size_t)cur.pm * tstep; const char* cB = (const char*)g.Bt + (size_t)cur.pn * tstep;
    S.a_ready(cur);
    PG8_STAGE(PG8_SB(0, 0), cB, voffB); PG8_STAGE(PG8_SA(0, 0), cA, voffA); PG8_STAGE(PG8_SB(0, 1), cB + hstep, voffB); PG8_STAGE(PG8_SA(0, 1), cA + hstep, voffA);
    if (wr == 1) PG8_BAR;
    PG8_WAIT_V(4); PG8_BAR;
    PG8_STAGE(PG8_SB(1, 0), cB + kstep, voffB); PG8_STAGE(PG8_SA(1, 0), cA + kstep, voffA); PG8_STAGE(PG8_SB(1, 1), cB + hstep + kstep, voffB);
    PG8_WAIT_V(6); PG8_BAR;
    for (;;) {
        const bool has_next = S.next(ui + 1, nxt);
        const char* nA = has_next ? (const char*)g.A + (size_t)nxt.pm * tstep : cA; const char* nB = has_next ? (const char*)g.Bt + (size_t)nxt.pn * tstep : cB;
        for (int t = 0; t < nt; t += 2) {
            const bool last = (t == nt - 2);
            const char* a1 = cA + (size_t)(t + 1) * kstep;
            const char* a2 = last ? nA : cA + (size_t)(t + 2) * kstep; const char* b2 = last ? nB : cB + (size_t)(t + 2) * kstep;
            const char* a3 = a2 + kstep; const char* b3 = b2 + kstep;
            if (last && has_next) S.a_ready(nxt);
            PG8_LDB(B0, 0, 0); PG8_SCHED; PG8_LDA(At, 0, 0); PG8_STAGE(PG8_SA(1, 1), a1 + hstep, voffA);
            PG8_WAIT_L(8); PG8_BAR; PG8_WAIT_L(0); PG8_MMA(0, 0, At, B0); PG8_BAR; PG8_SCHED;
            PG8_LDB(B1, 0, 1); PG8_STAGE(PG8_SB(0, 0), b2, voffB);
            PG8_BAR; PG8_WAIT_L(0); PG8_MMA(0, 1, At, B1); PG8_BAR;
            PG8_LDA(At, 0, 1); PG8_STAGE(PG8_SA(0, 0), a2, voffA);
            PG8_BAR; PG8_WAIT_L(0); PG8_MMA(1, 0, At, B0); PG8_BAR; PG8_SCHED;
            PG8_STAGE(PG8_SB(0, 1), b2 + hstep, voffB);
            PG8_WAIT_V(6); PG8_BAR; PG8_MMA(1, 1, At, B1); PG8_BAR;
            PG8_LDB(B0, 1, 0); PG8_SCHED; PG8_LDA(At, 1, 0); PG8_STAGE(PG8_SA(0, 1), a2 + hstep, voffA);
            PG8_WAIT_L(8); PG8_BAR; PG8_WAIT_L(0); PG8_MMA(0, 0, At, B0); PG8_BAR; PG8_SCHED;
            PG8_LDB(B1, 1, 1); PG8_STAGE(PG8_SB(1, 0), b3, voffB);
            PG8_BAR; PG8_WAIT_L(0); PG8_MMA(0, 1, At, B1); PG8_BAR;
            PG8_LDA(At, 1, 1); PG8_STAGE(PG8_SA(1, 0), a3, voffA);
            PG8_BAR; PG8_WAIT_L(0); PG8_MMA(1, 0, At, B0); PG8_BAR; PG8_SCHED;
            PG8_STAGE(PG8_SB(1, 1), b3 + hstep, voffB);
            PG8_WAIT_V(6); PG8_BAR; PG8_MMA(1, 1, At, B1); PG8_BAR;
        }
        if constexpr (!Epi::AFTER_DRAIN) { E(acc, cur, wr, wc, fr, fq); S.done(cur); }
        if (!has_next) break;
#pragma unroll
        for (int a = 0; a < 2; ++a)
#pragma unroll
            for (int b = 0; b < 2; ++b)
#pragma unroll
                for (int m = 0; m < 4; ++m)
#pragma unroll
                    for (int n = 0; n < 2; ++n) acc[a][b][m][n] = (f32x4){0.f, 0.f, 0.f, 0.f};
        cur = nxt; cA = nA; cB = nB; ++ui;
    }
    PG8_WAIT_V(0);
    if (wr == 0) PG8_BAR;
    PG8_BAR;
    if constexpr (Epi::AFTER_DRAIN) { E.fused(acc, cur, wr, wc, fr, fq, lds, wid, lane); S.done(cur); }
#undef PG8_SA
#undef PG8_SB
#undef PG8_STAGE
#undef PG8_LDA
#undef PG8_LDB
#undef PG8_MMA
#undef PG8_WAIT_V
#undef PG8_WAIT_L
#undef PG8_BAR
#undef PG8_SCHED
}
}

template <class F> struct EpiAd {
    static constexpr bool PERM = true, AFTER_DRAIN = false;
    F f; float* ssq;
    __device__ __forceinline__ void operator()(const pg8::f32x4 (&acc)[2][2][4][2], const pg8::Unit& u, int wr, int wc, int fr, int fq) const {
        constexpr int PD = F::PD;
        const int c = wc * 32 + 8 * fq, row0 = u.pm * 256 + wr * 64 + fr;
        typename F::Cols cols; f.load_cols(cols, u.pm, u.pn, c);
        typename F::Row rd[PD];
#pragma unroll
        for (int s = 0; s < PD; ++s) f.load_row(rd[s], row0 + (s >> 2) * 128 + (s & 3) * 16, u.pn, c);
#pragma unroll
        for (int s = 0; s < 8; ++s) { const int ai = s >> 2, m = s & 3, row = row0 + ai * 128 + m * 16;
            float v0[8], v1[8];
#pragma unroll
            for (int n = 0; n < 2; ++n)
#pragma unroll
                for (int e = 0; e < 4; ++e) { v0[4 * n + e] = acc[ai][0][m][n][e]; v1[4 * n + e] = acc[ai][1][m][n][e]; }
            float sq = f.finish(row, u.pn, c, v0, v1, cols, rd[s % PD]);
            if (ssq) { sq += __shfl_xor(sq, 16); sq += __shfl_xor(sq, 32); if (fq == 0) ssq[(size_t)row * 16 + u.pn * 4 + wc] = sq; }
            if (s + PD < 8) f.load_row(rd[s % PD], row0 + ((s + PD) >> 2) * 128 + ((s + PD) & 3) * 16, u.pn, c); }
    }
};
struct TwoPartOrder {
    pg8::StaticOrder s1; int n1, nM1, nM2, n2, G, c;
    __device__ void init(int nM1_, int nN1, int nM2_, int nN2, int G_, int c_) { s1.init(nM1_ * 256, nN1 * 256, G_, c_); n1 = nM1_ * nN1; nM1 = nM1_; nM2 = nM2_; n2 = nM2_ * nN2; G = G_; c = c_; }
    __device__ bool next(int i, pg8::Unit& u) const { long L = (long)i * G + c; if (L < n1) return s1.next(i, u); L -= n1; if (L >= n2) return false; u.pm = nM1 + (int)(L % nM2); u.pn = (int)(L / nM2); return true; }
    __device__ __forceinline__ void a_ready(const pg8::Unit&) const {}
    __device__ __forceinline__ void done(const pg8::Unit&) const {}
};
template <class F>
__device__ __forceinline__ void gemm_mfma(LAS unsigned char* lds, const bf16_t* A, const bf16_t* Bt, int K, int nrows1, int npn1, int nrows2, int npn2, const F& f, float* ssq) {
    __syncthreads();
    pg8::Gemm g{A, Bt, nrows1 + nrows2, npn1 * 256, K}; TwoPartOrder S; S.init(nrows1 / 256, npn1, nrows2 / 256, npn2, (int)gridDim.x, (int)blockIdx.x);
    EpiAd<F> E{f, ssq};
    pg8::gemm_phase(lds, g, S, E);
    __syncthreads();
}

struct Ctx { LAS unsigned char* lds; int tid, lane, wid, gw, ngw; };

__device__ __forceinline__ void phase_prep(const Params& p, const Ctx& c) {
    unsigned char* ws = p.ws;
    LAS float* scr = (LAS float*)(c.lds + c.wid * 8448);
    transpose_matrix(p.w_in, D, NIN, (bf16_t*)(ws + WS_WIN_T), scr, c.gw, c.ngw, c.lane);
    transpose_matrix(p.w_pa, 512, D, (bf16_t*)(ws + WS_WPA_T), scr, c.gw, c.ngw, c.lane);
    transpose_matrix(p.w_pb, 512, D, (bf16_t*)(ws + WS_WPB_T), scr, c.gw, c.ngw, c.lane);
    transpose_matrix(p.w_out, D, D, (bf16_t*)(ws + WS_WOUT_T), scr, c.gw, c.ngw, c.lane);
    transpose_gu(p.ffn_wg, 0, (bf16_t*)(ws + WS_WG1_T), scr, c.gw, c.ngw, c.lane);
    transpose_gu(p.ffn_wu, 1, (bf16_t*)(ws + WS_WG1_T), scr, c.gw, c.ngw, c.lane);
    transpose_matrix(p.ffn_wd, DFF, D, (bf16_t*)(ws + WS_WD1_T), scr, c.gw, c.ngw, c.lane);
    __syncthreads();
    if ((int)blockIdx.x < MODW / 64) {
        LAS float* xs = (LAS float*)c.lds; LAS float* part = (LAS float*)(c.lds + 17 * 1024 * 4);
        for (int i = c.tid; i < 17 * 1024; i += NTHR) { const int r = i >> 10, k = i & 1023; const float v = r < 16 ? p.c[r * D + k] : p.c_ctx[k]; xs[i] = v / (1.0f + expf(-v)); }
        __syncthreads();
        gemv17<false>(xs, part, p.mod_w, MODW, p.mod_b, (float*)(ws + WS_MODV), MODW, 0, blockIdx.x, gridDim.x);
    }
    { float* er = (float*)(ws + WS_ER); float* ec = (float*)(ws + WS_EC); float* lbv = (float*)(ws + WS_LBV);
      const int gt = blockIdx.x * NTHR + c.tid, ngt = gridDim.x * NTHR;
      for (int i = gt; i < 96 * 512; i += ngt) { const int r = i >> 9, j = i & 511, jj = j & 255; const float omega = 1.0f / powf(10000.0f, (float)jj / 256.0f);
          const int pos = r < 32 ? r : r - 32; const float a = (float)pos * omega; const float v = j < 256 ? sinf(a) : cosf(a);
          if (r < 32) er[r * 512 + j] = v; else ec[(r - 32) * 512 + j] = v; }
      for (int i = gt; i < 1024; i += ngt) { const float l0 = p.lb_logits[i], l1 = p.lb_logits[1024 + i]; lbv[i] = 1.0f / (1.0f + expf(l1 - l0)); } }
    { LAS float* zf = (LAS float*)c.lds; LAS float* h1 = zf + 8 * 40; float* h2o = (float*)(ws + WS_H2);
      for (int it = blockIdx.x; it < SEQ / 8; it += gridDim.x) {
          __syncthreads();
          if (c.tid < 8 * 33) { const int r = c.tid / 33, f = c.tid % 33; const int pp = it * 8 + r; float v;
              if (f == 0) v = (float)pp / (float)(SEQ - 1);
              else { const int i = (f - 1) & 15; const float w = 6.283185307179586f * (float)pp / (float)SEQ; const float fr = 1e-4f + (float)i * ((15.0f - 1e-4f) / 15.0f); const float ang = w * fr; v = f <= 16 ? cosf(ang) : -sinf(ang); }
              zf[r * 40 + f] = v; }
          __syncthreads();
          { const int r = c.tid >> 6, j = c.tid & 63; float s = p.hb1[j];
            for (int f = 0; f < 33; ++f) s += zf[r * 40 + f] * p.hw1[f * 64 + j];
            h1[r * 64 + j] = sinf(p.hfr1[j] * s); }
          __syncthreads();
          { const int r = c.tid >> 6, j = c.tid & 63; float s = p.hb2[j];
            for (int k = 0; k < 64; ++k) s += h1[r * 64 + k] * p.hw2[k * 64 + j];
            h2o[(size_t)(it * 8 + r) * 64 + j] = sinf(p.hfr2[j] * s); }
      } }
}

__device__ __forceinline__ void phase_n1(const Params& p, const Ctx& c) {
    unsigned char* ws = p.ws;
    const float* modv = (const float*)(ws + WS_MODV); const float* er = (const float*)(ws + WS_ER); const float* ec = (const float*)(ws + WS_EC);
    bf16_t* n1 = (bf16_t*)(ws + WS_N1);
    for (int row = c.gw; row < MT; row += c.ngw) {
        const bool lat = row < T; const int b = lat ? (row >> 11) : 16, t = row & (SEQ - 1);
        const float* src = lat ? p.x + (size_t)row * D : p.ctx + (size_t)(row - T) * D;
        f32x4 v[4]; float s = 0.f;
#pragma unroll
        for (int j = 0; j < 4; ++j) { const int col = 4 * c.lane + 256 * j; v[j] = *(const f32x4*)(src + col);
            if (lat) { const float* pe = col < 512 ? er + (t >> 6) * 512 + col : ec + (t & 63) * 512 + (col - 512); v[j] += *(const f32x4*)pe; }
            s += (v[j][0] * v[j][0] + v[j][1] * v[j][1]) + (v[j][2] * v[j][2] + v[j][3] * v[j][3]); }
        const float rs = 1.0f / sqrtf(wave_sum(s) * (1.0f / D) + RMS_EPS);
        if (lat) {
#pragma unroll
            for (int j = 0; j < 4; ++j) *(f32x4*)(p.out + (size_t)row * D + 4 * c.lane + 256 * j) = v[j]; }
#pragma unroll
        for (int j = 0; j < 4; ++j) { const int col = 4 * c.lane + 256 * j; const f32x4 sh = *(const f32x4*)(modv + (size_t)b * MODW + col), sc = *(const f32x4*)(modv + (size_t)b * MODW + D + col);
            const f32x4 o = v[j] * rs * (sc + 1.0f) + sh; u32x2 w; w.x = pk2(o[0], o[1]); w.y = pk2(o[2], o[3]); *(u32x2*)(n1 + (size_t)row * D + col) = w; }
    }
    { LAS float* xs = (LAS float*)c.lds; LAS float* part = (LAS float*)(c.lds + 17 * 1024 * 4);
      const int nb_in = NIN / 64, nb_g = DFF / 64;
      for (int bx = blockIdx.x; bx < nb_in + 2 * nb_g; bx += gridDim.x) {
          __syncthreads();
          if (bx < nb_in) {
              for (int i = c.tid; i < 17 * 1024; i += NTHR) xs[i] = modv[(size_t)(i >> 10) * MODW + 3 * D + (i & 1023)];
              __syncthreads();
              gemv17<false>(xs, part, p.w_in, NIN, nullptr, (float*)(ws + WS_SWIN), NIN, 0, bx, nb_in); }
          else { const int half = (bx - nb_in) / nb_g, blk = (bx - nb_in) % nb_g;
              for (int i = c.tid; i < 17 * 1024; i += NTHR) xs[i] = modv[(size_t)(i >> 10) * MODW + 6 * D + (i & 1023)];
              __syncthreads();
              const float* W = (half ? p.ffn_wu : p.ffn_wg) + (size_t)D * DFF;
              gemv17<true>(xs, part, W, DFF, nullptr, (float*)(ws + WS_SW2), NGU, half, blk, nb_g); }
      }
    }
    { LAS float* w3s = (LAS float*)c.lds;
      LAS float* hk = w3s + 512;
      LAS float* red = hk + 2048 * 8;
      const float* h2 = (const float*)(ws + WS_H2); bf16_t* krev = (bf16_t*)(ws + WS_KREV);
      for (int it = blockIdx.x; it < 256; it += gridDim.x) {
          const int c0 = 2 * it;
          __syncthreads();
          { const int k = c.tid >> 3, q = c.tid & 7; w3s[c.tid] = p.hw3[(size_t)k * 2048 + (q >> 2) * 1024 + ((q >> 1) & 1) * 512 + c0 + (q & 1)]; }
          __syncthreads();
          float l1[4] = {0.f, 0.f, 0.f, 0.f};
          for (int idx = c.tid; idx < 2048 * 8; idx += NTHR) { const int t = idx >> 3, q = idx & 7; float s = 0.f;
              const float* hr = h2 + (size_t)t * 64;
#pragma unroll 8
              for (int k = 0; k < 64; ++k) s += hr[k] * w3s[k * 8 + q];
              const int ch = c0 + (q & 1); const float delta = fabsf(-3.0701134573253945f + (float)ch * ((-15.350567286626973f + 3.0701134573253945f) / 511.0f));
              const float tn = (float)t / (float)(SEQ - 1); s *= expf(-tn * delta) + 0.05f;
              hk[idx] = s; l1[0] += fabsf(s); }
          { float s = l1[0]; s += __shfl_xor(s, 2); s += __shfl_xor(s, 8); s += __shfl_xor(s, 16); s += __shfl_xor(s, 32);
            if ((c.lane & ~5) == 0) red[c.wid * 4 + ((c.lane >> 2) & 1) * 2 + (c.lane & 1)] = s; }
          __syncthreads();
          for (int e = c.tid; e < 4 * KR_LEN; e += NTHR) { const int oc = e / KR_LEN, i = (e % KR_LEN) - KR_OFF, o = oc >> 1, cc = oc & 1;
              float tot = 0.f;
#pragma unroll
              for (int w = 0; w < 8; ++w) tot += red[w * 4 + oc];
              const int lag = -i; float v = 0.f;
              if (lag >= 0 && lag <= SEQ - 1) v = hk[lag * 8 + o * 4 + 0 + cc]; else if (lag < 0 && lag >= -(SEQ - 1)) v = hk[(-lag - 1) * 8 + o * 4 + 2 + cc];
              krev[((size_t)o * 512 + c0 + cc) * KR_LEN + (e % KR_LEN)] = f2bf(v / (tot + 1e-6f)); }
      } }
}

__device__ __forceinline__ void phase_hgrn_simple(const Params& p, const Ctx& c) {
    unsigned char* ws = p.ws;
    const bf16_t* vb = (const bf16_t*)(ws + WS_V); const bf16_t* qb = (const bf16_t*)(ws + WS_Q);
    LAS float* F = (LAS float*)c.lds; LAS float* Kk = F + 64 * 128; LAS float* Q = Kk + 64 * 128; LAS float* V = Q + 64 * 128;
    const int dg = c.tid & 3, e = c.tid >> 2;
    for (int it = blockIdx.x; it < NB * 4 * 2; it += gridDim.x) {
        const int dir = it & 1, h = (it >> 1) & 3, b = it >> 3;
        const f16_t* lf = (const f16_t*)(ws + (dir ? WS_LBW : WS_LFW)); float* outp = (float*)(ws + (dir ? WS_OBW : WS_OFW));
        float S[32];
#pragma unroll
        for (int i = 0; i < 32; ++i) S[i] = 0.f;
        for (int ci = 0; ci < 36; ++ci) {
            const bool lat = ci >= 4;
            __syncthreads();
            for (int idx = c.tid; idx < 64 * 128; idx += NTHR) { const int j = idx >> 7, d = idx & 127; const int pp = (lat ? ci - 4 : ci) * 64 + j;
                const int row = lat ? b * SEQ + (dir ? SEQ - 1 - pp : pp) : T + b * CL + (dir ? CL - 1 - pp : pp);
                const float f = __expf((float)lf[(size_t)row * 512 + h * 128 + d]);
                F[idx] = f; Kk[idx] = 1.0f - f; V[idx] = bf2f(vb[(size_t)row * 512 + h * 128 + d]); Q[idx] = lat ? bf2f(qb[(size_t)row * 512 + h * 128 + d]) : 0.f; }
            __syncthreads();
            for (int j = 0; j < 64; ++j) { const float ve = V[j * 128 + e]; float part = 0.f;
#pragma unroll
                for (int i = 0; i < 32; ++i) { const int d = dg * 32 + i; S[i] = F[j * 128 + d] * S[i] + Kk[j * 128 + d] * ve; part += S[i] * Q[j * 128 + d]; }
                part += __shfl_xor(part, 1); part += __shfl_xor(part, 2);
                if (lat && dg == 0) { const int pp = (ci - 4) * 64 + j; const int row = b * SEQ + (dir ? SEQ - 1 - pp : pp); outp[(size_t)row * 512 + h * 128 + e] = part; } }
        }
    }
}


typedef short bf16x8 __attribute__((ext_vector_type(8)));
constexpr int QROW = 136, TROW = 72;
__device__ __forceinline__ int hg_pos(int x) { return (x & ~31) + ((x >> 2) & 3) * 8 + ((x >> 4) & 1) * 4 + (x & 3); }
__device__ __forceinline__ pg8::f32x4 mfma16(bf16x8 a, bf16x8 b, pg8::f32x4 c) { return __builtin_amdgcn_mfma_f32_16x16x32_bf16(a, b, c, 0, 0, 0); }
__device__ __forceinline__ void phase_hgrn_mfma(const Params& p, const Ctx& c) {
    unsigned char* ws = p.ws;
    const bf16_t* vb = (const bf16_t*)(ws + WS_V); const bf16_t* qb = (const bf16_t*)(ws + WS_Q);
    LAS bf16_t* Qt = (LAS bf16_t*)c.lds;
    LAS bf16_t* Kt = Qt + 64 * QROW;
    LAS bf16_t* KhT = Kt + 64 * QROW;
    LAS bf16_t* VT = KhT + 128 * TROW;
    LAS bf16_t* ST0 = VT + 64 * TROW;
    LAS bf16_t* ST1 = ST0 + 64 * QROW;
    LAS float* qt = (LAS float*)(ST1 + 64 * QROW);
    LAS float* El = qt + 8 * 128;
    const int wid = c.wid, lane = c.lane, fr = lane & 15, fq = lane >> 4, dp = lane, ti = wid & 3, eh = wid >> 2;
    for (int it = blockIdx.x; it < 256; it += gridDim.x) {
        const int dvh = (it >> 3) & 1, idx = (it & 7) | ((it >> 4) << 3), dir = idx & 1, h = (idx >> 1) & 3, b = idx >> 3;
        const f16_t* lf = (const f16_t*)(ws + (dir ? WS_LBW : WS_LFW)); float* outp = (float*)(ws + (dir ? WS_OBW : WS_OFW));
        const int colq = h * 128 + 2 * dp, colv = h * 128 + dvh * 64 + (c.tid & 7) * 8, pv = c.tid >> 3;
        pg8::f32x4 S[4];
#pragma unroll
        for (int e = 0; e < 4; ++e) S[e] = (pg8::f32x4){0.f, 0.f, 0.f, 0.f};
#define HG_ROW(ci_, p_) (((ci_) >= 4) ? (b * SEQ + (dir ? SEQ - 1 - (((ci_) - 4) * 64 + (p_)) : (((ci_) - 4) * 64 + (p_)))) : (T + b * CL + (dir ? CL - 1 - ((ci_) * 64 + (p_)) : ((ci_) * 64 + (p_)))))
        unsigned lfr[2][8], qr[2][8]; u32x4 vr[2];
#pragma unroll
        for (int s2 = 0; s2 < 2; ++s2) {
#pragma unroll
            for (int i = 0; i < 8; ++i) { const int row = HG_ROW(s2, 8 * wid + i); lfr[s2][i] = *(const unsigned*)(lf + (size_t)row * 512 + colq); qr[s2][i] = 0u; }
            vr[s2] = *(const u32x4*)(vb + (size_t)HG_ROW(s2, pv) * 512 + colv); }
        __syncthreads();
        for (int ci2 = 0; ci2 < 36; ci2 += 2) {
#pragma unroll
          for (int par = 0; par < 2; ++par) {
            const int ci = ci2 + par;
            const bool lat = ci >= 4;
            float l0[8], l1[8], c0[8], c1[8]; float run0 = 0.f, run1 = 0.f;
#pragma unroll
            for (int i = 0; i < 8; ++i) { const __fp16 a0 = __builtin_bit_cast(__fp16, (unsigned short)(lfr[par][i] & 0xffffu)), a1 = __builtin_bit_cast(__fp16, (unsigned short)(lfr[par][i] >> 16));
                l0[i] = (float)a0; l1[i] = (float)a1; run0 += l0[i]; run1 += l1[i]; c0[i] = run0; c1[i] = run1; }
            qt[wid * 128 + 2 * dp] = run0; qt[wid * 128 + 2 * dp + 1] = run1;
            __syncthreads();
            float off0 = 0.f, off1 = 0.f, tot0 = 0.f, tot1 = 0.f;
#pragma unroll
            for (int w = 0; w < 8; ++w) { const float a0 = qt[w * 128 + 2 * dp], a1 = qt[w * 128 + 2 * dp + 1]; tot0 += a0; tot1 += a1; if (w < wid) { off0 += a0; off1 += a1; } }
            const float E0 = __expf(tot0), E1 = __expf(tot1);
            if (wid == 0) { El[2 * dp] = E0; El[2 * dp + 1] = E1; }
            const int qpos = hg_pos(2 * dp);
            float kh0[8], kh1[8];
#pragma unroll
            for (int i = 0; i < 8; ++i) { const int pp = 8 * wid + i; const float cu0 = off0 + c0[i], cu1 = off1 + c1[i];
                const float e0 = __expf(cu0), e1 = __expf(cu1), r0 = __expf(-cu0), r1 = __expf(-cu1);
                const float k0 = (1.0f - __expf(l0[i])) * r0, k1 = (1.0f - __expf(l1[i])) * r1;
                *(LAS unsigned*)(Kt + pp * QROW + qpos) = pk2(k0, k1);
                if (lat) { const float q0 = __uint_as_float(qr[par][i] << 16), q1 = __uint_as_float(qr[par][i] & 0xffff0000u); *(LAS unsigned*)(Qt + pp * QROW + qpos) = pk2(q0 * e0, q1 * e1); }
                kh0[i] = k0 * E0; kh1[i] = k1 * E1; }
            { const int base0 = 32 * (wid >> 2) + 16 * (wid & 1) + 4 * ((wid >> 1) & 1);
              u32x2 w; w.x = pk2(kh0[0], kh0[1]); w.y = pk2(kh0[2], kh0[3]); *(LAS u32x2*)(KhT + (2 * dp) * TROW + base0) = w;
              w.x = pk2(kh0[4], kh0[5]); w.y = pk2(kh0[6], kh0[7]); *(LAS u32x2*)(KhT + (2 * dp) * TROW + base0 + 8) = w;
              w.x = pk2(kh1[0], kh1[1]); w.y = pk2(kh1[2], kh1[3]); *(LAS u32x2*)(KhT + (2 * dp + 1) * TROW + base0) = w;
              w.x = pk2(kh1[4], kh1[5]); w.y = pk2(kh1[6], kh1[7]); *(LAS u32x2*)(KhT + (2 * dp + 1) * TROW + base0 + 8) = w; }
            { const int e8 = (c.tid & 7) * 8, sp = hg_pos(pv); const unsigned wv[4] = {vr[par].x, vr[par].y, vr[par].z, vr[par].w};
#pragma unroll
              for (int j = 0; j < 4; ++j) { VT[(e8 + 2 * j) * TROW + sp] = (bf16_t)(wv[j] & 0xffffu); VT[(e8 + 2 * j + 1) * TROW + sp] = (bf16_t)(wv[j] >> 16); } }
            if (ci + 2 < 36) { const bool nlat = ci + 2 >= 4;
#pragma unroll
                for (int i = 0; i < 8; ++i) { const int row = HG_ROW(ci + 2, 8 * wid + i); lfr[par][i] = *(const unsigned*)(lf + (size_t)row * 512 + colq); if (nlat) qr[par][i] = *(const unsigned*)(qb + (size_t)row * 512 + colq); }
                vr[par] = *(const u32x4*)(vb + (size_t)HG_ROW(ci + 2, pv) * 512 + colv); }
            __syncthreads();
            const LAS bf16_t* STr = (ci & 1) ? ST1 : ST0; LAS bf16_t* STw = (ci & 1) ? ST0 : ST1;
            bf16x8 VF[4][2];
#pragma unroll
            for (int ei = 0; ei < 4; ++ei)
#pragma unroll
                for (int a = 0; a < 2; ++a) VF[ei][a] = *(const LAS bf16x8*)(VT + (16 * ei + fr) * TROW + 32 * a + 8 * fq);
            if (lat) {
                bf16x8 QF[4];
#pragma unroll
                for (int k = 0; k < 4; ++k) QF[k] = *(const LAS bf16x8*)(Qt + (16 * ti + fr) * QROW + 32 * k + 8 * fq);
                pg8::f32x4 P[4];
#pragma unroll
                for (int si = 0; si < 4; ++si) { pg8::f32x4 acc = (pg8::f32x4){0.f, 0.f, 0.f, 0.f};
                    if (si <= ti) {
#pragma unroll
                        for (int k = 0; k < 4; ++k) acc = mfma16(*(const LAS bf16x8*)(Kt + (16 * si + fr) * QROW + 32 * k + 8 * fq), QF[k], acc);
                        if (si == ti) {
#pragma unroll
                            for (int r = 0; r < 4; ++r) acc[r] = (4 * fq + r <= fr) ? acc[r] : 0.f; } }
                    P[si] = acc; }
                bf16x8 PB[2];
#pragma unroll
                for (int a = 0; a < 2; ++a) { u32x4 w; w.x = pk2(P[2 * a][0], P[2 * a][1]); w.y = pk2(P[2 * a][2], P[2 * a][3]); w.z = pk2(P[2 * a + 1][0], P[2 * a + 1][1]); w.w = pk2(P[2 * a + 1][2], P[2 * a + 1][3]); PB[a] = __builtin_bit_cast(bf16x8, w); }
#pragma unroll
                for (int e2 = 0; e2 < 2; ++e2) { const int ei = 2 * eh + e2; pg8::f32x4 acc = (pg8::f32x4){0.f, 0.f, 0.f, 0.f};
#pragma unroll
                    for (int a = 0; a < 2; ++a) if (2 * a <= ti) acc = mfma16(*(const LAS bf16x8*)(VT + (16 * ei + fr) * TROW + 32 * a + 8 * fq), PB[a], acc);
#pragma unroll
                    for (int k = 0; k < 4; ++k) acc = mfma16(*(const LAS bf16x8*)(STr + (16 * ei + fr) * QROW + 32 * k + 8 * fq), QF[k], acc);
                    const int row = HG_ROW(ci, 16 * ti + fr);
                    *(pg8::f32x4*)(outp + (size_t)row * 512 + h * 128 + dvh * 64 + 16 * ei + 4 * fq) = acc; }
            }
            { const pg8::f32x4 dl = *(const LAS pg8::f32x4*)(El + 16 * wid + 4 * fq);
              bf16x8 KH[2];
#pragma unroll
              for (int a = 0; a < 2; ++a) KH[a] = *(const LAS bf16x8*)(KhT + (16 * wid + fr) * TROW + 32 * a + 8 * fq);
#pragma unroll
              for (int ei = 0; ei < 4; ++ei) { S[ei] = S[ei] * dl;
#pragma unroll
                  for (int a = 0; a < 2; ++a) S[ei] = mfma16(KH[a], VF[ei][a], S[ei]);
                  u32x2 w; w.x = pk2(S[ei][0], S[ei][1]); w.y = pk2(S[ei][2], S[ei][3]);
                  *(LAS u32x2*)(STw + (16 * ei + fr) * QROW + 32 * (wid >> 1) + 8 * fq + 4 * (wid & 1)) = w; } }
            __syncthreads();
          }
        }
#undef HG_ROW
    }
}

constexpr int ZROW = 2056;
__device__ __forceinline__ void phase_hy_prepass(const Params& p, const Ctx& c) {
    bf16_t* hy = (bf16_t*)(p.ws + WS_HY);
    LAS bf16_t* raw = (LAS bf16_t*)c.lds;
    if (c.tid < 4) { ((LAS unsigned*)raw)[c.tid] = 0u; ((LAS unsigned*)(raw + 2049 * 8))[c.tid] = 0u; }
    for (int blk = blockIdx.x; blk < (NHY / 8) * NB; blk += gridDim.x) {
        bf16_t* base = hy + (size_t)blk * SEQ * 8; const int cg = blk / NB;
        u32x4 ch4[4];
#pragma unroll
        for (int i = 0; i < 4; ++i) ch4[i] = *(const u32x4*)(base + (size_t)(4 * c.tid + i) * 8);
        __syncthreads();
#pragma unroll
        for (int i = 0; i < 4; ++i) *(LAS u32x4*)(raw + (size_t)(1 + 4 * c.tid + i) * 8) = ch4[i];
        __syncthreads();
        const int ch = cg * 8 + c.wid; const float w0 = p.conv_w[ch], w1 = p.conv_w[NHY + ch], w2 = p.conv_w[2 * NHY + ch], cb = p.conv_b[ch];
#pragma unroll 4
        for (int k = 0; k < 16; ++k) { const int t = 2 * c.lane + 128 * k;
            const float x0 = bf2f(raw[(t + 0) * 8 + c.wid]), x1 = bf2f(raw[(t + 1) * 8 + c.wid]), x2 = bf2f(raw[(t + 2) * 8 + c.wid]), x3 = bf2f(raw[(t + 3) * 8 + c.wid]);
            *(unsigned*)(base + (size_t)c.wid * SEQ + t) = pk2(cb + w0 * x0 + w1 * x1 + w2 * x2, cb + w0 * x1 + w1 * x2 + w2 * x3); }
    }
}
__device__ __forceinline__ void hy_fill2(LAS bf16_t* dst, const bf16_t* hy, int chx, int tid) {
#pragma unroll
    for (int i = 0; i < 8; ++i) { const int idx = tid + NTHR * i, b = idx >> 8, t8 = (idx & 255) * 8;
        *(LAS u32x4*)(dst + b * ZROW + t8) = *(const u32x4*)(hy + ((((size_t)(chx >> 3) * NB + b) * 8 + (chx & 7)) * SEQ) + t8); }
}
template <int KIND>
__device__ __forceinline__ void hy_block(pg8::f32x4 (&acc)[16], bf16x8 (&Bw)[16], const LAS bf16_t* zl, const LAS bf16_t* krl, int ub, int i0, int lane) {
    const int fr = lane & 15, fq = lane >> 4;
    const LAS bf16_t* bbase = zl + fr * ZROW + 8 * fq;
    const int abase = KR_OFF - 16 * i0 - fr + 8 * fq;
    const unsigned sh = (unsigned)(fr & 1) * 16u;
#pragma unroll
    for (int uu = 0; uu < 16; ++uu) {
        const int u = ub + uu;
        const bool ldb = KIND == 0 ? (uu >= 1) : (KIND == 1 ? true : (uu == 0));
        if (ldb) Bw[(uu + 15) & 15] = *(const LAS bf16x8*)(bbase + 32 * (u + 15));
        const LAS unsigned* ap = (const LAS unsigned*)(krl + ((abase + 32 * u) & ~1));
        const unsigned d0 = ap[0], d1 = ap[1], d2 = ap[2], d3 = ap[3], d4 = ap[4];
        u32x4 aw; aw.x = __builtin_amdgcn_alignbit(d1, d0, sh); aw.y = __builtin_amdgcn_alignbit(d2, d1, sh); aw.z = __builtin_amdgcn_alignbit(d3, d2, sh); aw.w = __builtin_amdgcn_alignbit(d4, d3, sh);
        const bf16x8 A = __builtin_bit_cast(bf16x8, aw);
#pragma unroll
        for (int m = 0; m < 16; ++m) { const bool on = KIND == 0 ? (m >= 16 - uu) : (KIND == 1 ? true : (m <= 15 - uu));
            if (on) acc[m] = __builtin_amdgcn_mfma_f32_16x16x32_bf16(A, Bw[(uu + m) & 15], acc[m], 0, 0, 0); }
    }
}
__device__ __forceinline__ void phase_hyena_mfma(const Params& p, const Ctx& c) {
    unsigned char* ws = p.ws;
    const bf16_t* hy = (const bf16_t*)(ws + WS_HY); const bf16_t* krev = (const bf16_t*)(ws + WS_KREV); bf16_t* zb = (bf16_t*)(ws + WS_ZB);
    LAS bf16_t* zl = (LAS bf16_t*)c.lds;
    LAS bf16_t* gl = zl + NB * ZROW;
    LAS bf16_t* krl = gl + NB * ZROW;
    const int i0 = 32 * (c.wid >> 1) + (c.wid & 1), fr = c.lane & 15, fq = c.lane >> 4;
    for (int ch = blockIdx.x; ch < BW; ch += gridDim.x) {
        __syncthreads();
        hy_fill2(zl, hy, ch, c.tid);
        for (int o = 0; o < 2; ++o) {
            hy_fill2(gl, hy, (o + 1) * 512 + ch, c.tid);
            for (int i = c.tid; i < KR_LEN / 8; i += NTHR) *(LAS u32x4*)(krl + 8 * i) = *(const u32x4*)(krev + ((size_t)o * 512 + ch) * KR_LEN + 8 * i);
            __syncthreads();
            pg8::f32x4 acc[16]; bf16x8 Bw[16];
#pragma unroll
            for (int m = 0; m < 16; ++m) { acc[m] = (pg8::f32x4){0.f, 0.f, 0.f, 0.f}; Bw[m] = (bf16x8){0, 0, 0, 0, 0, 0, 0, 0}; }
            hy_block<0>(acc, Bw, zl, krl, -16, i0, c.lane);
            for (int ub = 0; ub < 48; ub += 16) hy_block<1>(acc, Bw, zl, krl, ub, i0, c.lane);
            hy_block<2>(acc, Bw, zl, krl, 48, i0, c.lane);
            const float bias = p.hy_bias[o * 512 + ch];
            u32x2 res[16];
#pragma unroll
            for (int m = 0; m < 16; ++m) { const int t = 16 * (i0 + 2 * m) + 4 * fq; const u32x2 zo = *(const LAS u32x2*)(zl + fr * ZROW + t), gg = *(const LAS u32x2*)(gl + fr * ZROW + t);
                const float z0 = __uint_as_float(zo.x << 16), z1 = __uint_as_float(zo.x & 0xffff0000u), z2 = __uint_as_float(zo.y << 16), z3 = __uint_as_float(zo.y & 0xffff0000u);
                const float g0 = __uint_as_float(gg.x << 16), g1 = __uint_as_float(gg.x & 0xffff0000u), g2 = __uint_as_float(gg.y << 16), g3 = __uint_as_float(gg.y & 0xffff0000u);
                res[m].x = pk2(g0 * (acc[m][0] + bias * z0), g1 * (acc[m][1] + bias * z1)); res[m].y = pk2(g2 * (acc[m][2] + bias * z2), g3 * (acc[m][3] + bias * z3)); }
            __syncthreads();
#pragma unroll
            for (int m = 0; m < 16; ++m) { const int t = 16 * (i0 + 2 * m) + 4 * fq;
                if (o == 0) *(LAS u32x2*)(zl + fr * ZROW + t) = res[m]; else *(u32x2*)(zb + ((size_t)ch * NB + fr) * SEQ + t) = res[m]; }
        }
    }
}

__device__ __forceinline__ void phase_combine(const Params& p, const Ctx& c) {
    unsigned char* ws = p.ws;
    const float* ofw = (const float*)(ws + WS_OFW); const float* obw = (const float*)(ws + WS_OBW); const bf16_t* g = (const bf16_t*)(ws + WS_G);
    bf16_t* oa = (bf16_t*)(ws + WS_OA); bf16_t* ob = (bf16_t*)(ws + WS_OB); const bf16_t* zb = (const bf16_t*)(ws + WS_ZB);
    for (int row = c.gw; row < T; row += c.ngw) { const int col = 8 * c.lane; float a[8], bq[8], gg[8], w[8], o[8];
        load_f32x8(ofw + (size_t)row * 512 + col, a); load_f32x8(obw + (size_t)row * 512 + col, bq); load_bf16x8(g + (size_t)row * 512 + col, gg); load_f32x8(p.a_norm_w + (col & 127), w);
        float s = 0.f;
#pragma unroll
        for (int j = 0; j < 8; ++j) { a[j] += bq[j]; s += a[j] * a[j]; }
        s += __shfl_xor(s, 1); s += __shfl_xor(s, 2); s += __shfl_xor(s, 4); s += __shfl_xor(s, 8);
        const float rs = 1.0f / sqrtf(s * (1.0f / 128.0f) + RMS_EPS);
#pragma unroll
        for (int j = 0; j < 8; ++j) o[j] = a[j] * rs * w[j] * gg[j];
        store_bf16x8(oa + (size_t)row * 512 + col, o); }
    LAS bf16_t* tile = (LAS bf16_t*)c.lds;
    for (int it = blockIdx.x; it < NB * 32 * 8; it += gridDim.x) { const int cb = it & 7, tb = (it >> 3) & 31, b = it >> 8;
        __syncthreads();
        { const int cl = c.tid >> 3, t8 = (c.tid & 7) * 8; const u32x4 w = *(const u32x4*)(zb + ((size_t)(cb * 64 + cl) * NB + b) * SEQ + tb * 64 + t8); *(LAS u32x4*)(tile + cl * 72 + t8) = w; }
        __syncthreads();
        { const int tl = c.tid >> 3, c8 = (c.tid & 7) * 8; bf16_t v[8];
#pragma unroll
          for (int i = 0; i < 8; ++i) v[i] = tile[(c8 + i) * 72 + tl];
          u32x4 w; w.x = v[0] | ((unsigned)v[1] << 16); w.y = v[2] | ((unsigned)v[3] << 16); w.z = v[4] | ((unsigned)v[5] << 16); w.w = v[6] | ((unsigned)v[7] << 16);
          *(u32x4*)(ob + ((size_t)b * SEQ + tb * 64 + tl) * 512 + cb * 64 + c8) = w; }
    }
}

__device__ __forceinline__ void phase_rstd(const float* ssq, float* rstd, int nrows, const Ctx& c) {
    for (int row = blockIdx.x * NTHR + c.tid; row < nrows; row += gridDim.x * NTHR) rstd[row] = rstd_from_ssq(ssq + (size_t)row * 16);
}
__device__ __forceinline__ void phase_final(const Params& p, const Ctx& c) {
    const float* ssq = (const float*)(p.ws + WS_SSQ3);
    for (int row = c.gw; row < T; row += c.ngw) { const float rs = rstd_from_ssq(ssq + (size_t)row * 16);
#pragma unroll
        for (int j = 0; j < 4; ++j) { const int col = 4 * c.lane + 256 * j; f32x4* ptr = (f32x4*)(p.out + (size_t)row * D + col); *ptr = *ptr * rs * *(const f32x4*)(p.fnw + col); } }
}


#define XB_TMO      128
#define XB_XCNT(j)  (256  + 64 * (j))
#define XB_XSUB(j)  (1280 + 64 * (j))
#define XB_XGEN(j)  (2304 + 64 * (j))
#define XB_TOP      3328
#define XB_TOPGEN   3392
#define XCD_BAR_WORDS 3456
#define XB_SPIN_CAP (1u << 18)
__device__ __forceinline__ unsigned xb_ld(unsigned* p)              { return __hip_atomic_load(p, __ATOMIC_RELAXED, __HIP_MEMORY_SCOPE_AGENT); }
__device__ __forceinline__ unsigned xb_add(unsigned* p, unsigned v) { return __hip_atomic_fetch_add(p, v, __ATOMIC_RELAXED, __HIP_MEMORY_SCOPE_AGENT); }
__device__ __forceinline__ unsigned xb_xcc_id() { return (unsigned)__builtin_amdgcn_s_getreg((3 << 11) | 20) & 0xFu; }
#define XB_SPIN(cond, bar) do { unsigned _sp = 0; while (cond) { __builtin_amdgcn_s_sleep(1); \
    if ((++_sp & 255u) == 0u) { if (xb_ld(&(bar)[XB_TMO])) break; if (_sp > XB_SPIN_CAP) { atomicAdd(&(bar)[XB_TMO], 1u); break; } } } } while (0)
struct XcdBarrier { unsigned* bar; unsigned x; volatile LAS unsigned* st; };
__device__ __forceinline__ XcdBarrier xcd_barrier_post(unsigned* bar, volatile LAS unsigned* st) {
    XcdBarrier b; b.bar = bar; b.x = xb_xcc_id(); b.st = st;
    if (threadIdx.x == 0) (void)xb_add(&bar[XB_XCNT(b.x)], 1u);
    return b;
}
__device__ __forceinline__ void xcd_barrier_complete(unsigned* bar, unsigned x, unsigned& nloc, unsigned& nx) {
    const unsigned G = gridDim.x * gridDim.y * gridDim.z;
    unsigned sum, cnt, mine, sp = 0u;
    for (;;) {
        sum = 0u; cnt = 0u; mine = 0u;
#pragma unroll
        for (unsigned j = 0; j < 16; ++j) { const unsigned c = xb_ld(&bar[XB_XCNT(j)]); sum += c; cnt += (c > 0u) ? 1u : 0u; mine = (j == x) ? c : mine; }
        if (sum == G) break;
        __builtin_amdgcn_s_sleep(1);
        if ((++sp & 255u) == 0u) { if (xb_ld(&bar[XB_TMO])) break; if (sp > XB_SPIN_CAP) { atomicAdd(&bar[XB_TMO], 1u); break; } }
    }
    nloc = mine > 0u ? mine : 1u; nx = cnt > 0u ? cnt : 1u;
}
__device__ __forceinline__ void xcd_barrier(const XcdBarrier& b) {
    asm volatile("s_waitcnt vmcnt(0)" ::: "memory");
    __syncthreads();
    if (threadIdx.x == 0) {
        unsigned* bar = b.bar;
        __builtin_amdgcn_s_waitcnt(0);
        unsigned nloc = b.st[0], nx = b.st[1];
        if (nloc == 0u) { xcd_barrier_complete(bar, b.x, nloc, nx); b.st[0] = nloc; b.st[1] = nx; }
        const unsigned old = xb_add(&bar[XB_XSUB(b.x)], 1u);
        const unsigned gen = old / nloc;
        if (old + 1u == (gen + 1u) * nloc) {
            __builtin_amdgcn_fence(__ATOMIC_RELEASE, "agent");
            asm volatile("s_waitcnt vmcnt(0)" ::: "memory");
            const unsigned og = xb_add(&bar[XB_TOP], 1u);
            const unsigned tg = og / nx;
            if (og + 1u == (tg + 1u) * nx) xb_add(&bar[XB_TOPGEN], 1u);
            else XB_SPIN(xb_ld(&bar[XB_TOPGEN]) == tg, bar);
            __builtin_amdgcn_fence(__ATOMIC_ACQUIRE, "agent");
            xb_add(&bar[XB_XGEN(b.x)], 1u);
            asm volatile("s_waitcnt vmcnt(0)" ::: "memory");
        } else {
            XB_SPIN(xb_ld(&bar[XB_XGEN(b.x)]) == gen, bar);
            __builtin_amdgcn_fence(__ATOMIC_ACQUIRE, "agent");
            asm volatile("s_waitcnt vmcnt(0)" ::: "memory");
        }
    }
    __syncthreads();
}

constexpr int N_PHASES = 16;
#ifndef REPEAT_MASK
#define REPEAT_MASK 0
#endif
#ifndef HOST_REPEAT_MASK
#define HOST_REPEAT_MASK 0
#endif
#ifndef USE_XCD_BARRIER
#define USE_XCD_BARRIER 1
#endif
__global__ void __launch_bounds__(NTHR, 2) fwd_kernel(Params p) {
    extern __shared__ __attribute__((aligned(16))) unsigned char lds_raw[];
    Ctx c; c.lds = (LAS unsigned char*)lds_raw; c.tid = threadIdx.x; c.lane = c.tid & 63; c.wid = __builtin_amdgcn_readfirstlane(c.tid >> 6);
    c.gw = blockIdx.x * NWAVES + c.wid; c.ngw = gridDim.x * NWAVES;
    unsigned char* ws = p.ws;
    const float* modv = (const float*)(ws + WS_MODV);
#if N_LAUNCH_MODE == 1
    cg::grid_group grid = cg::this_grid();
#if USE_XCD_BARRIER
    volatile LAS unsigned* xst = (volatile LAS unsigned*)(c.lds + LDS_BYTES - 16);
    if (c.tid < 4) xst[c.tid] = 0u;
    __syncthreads();
    XcdBarrier xbar = xcd_barrier_post((unsigned*)(ws + WS_CTL), xst);
    bool first_seam = true;
#define SEAM() do { if (first_seam) { grid.sync(); first_seam = false; } else xcd_barrier(xbar); } while (0)
#else
#define SEAM() grid.sync()
#endif
#else
#define SEAM() do { } while (0)
#endif
#ifdef ONLY_PHASE
#define IN(k) ((k) == ONLY_PHASE && p.ph_lo <= (k) && (k) < p.ph_hi)
#else
#define IN(k) (p.ph_lo <= (k) && (k) < p.ph_hi)
#endif
#define PHASE(k, ...) if (IN(k)) { for (int rep_ = 0; rep_ <= ((REPEAT_MASK >> (k)) & 1); ++rep_) { __VA_ARGS__; if (rep_ < ((REPEAT_MASK >> (k)) & 1)) SEAM(); } if (IN((k) + 1)) SEAM(); }
#if USE_PG8
#define GEMM2(A_, Bt_, K_, nrows1_, npn1_, nrows2_, npn2_, E_, ssq_) gemm_mfma(c.lds, A_, Bt_, K_, nrows1_, npn1_, nrows2_, npn2_, E_, ssq_)
#else
#define GEMM2(A_, Bt_, K_, nrows1_, npn1_, nrows2_, npn2_, E_, ssq_) do { gemm_simple(c.lds, A_, Bt_, K_, 0, nrows1_, npn1_, E_, ssq_); if ((nrows2_) > 0) gemm_simple(c.lds, A_, Bt_, K_, nrows1_, nrows2_, npn2_, E_, ssq_); } while (0)
#endif
#define GEMM(A_, Bt_, K_, nrows_, npn_, E_, ssq_) GEMM2(A_, Bt_, K_, nrows_, npn_, 0, 0, E_, ssq_)
    PHASE(0, phase_prep(p, c))
    PHASE(1, phase_n1(p, c))
    PHASE(2, { EpiGateUp1 E{(bf16_t*)(ws + WS_HID)};
        GEMM((const bf16_t*)(ws + WS_N1), (const bf16_t*)(ws + WS_WG1_T), D, MT, NGU / 256, E, nullptr); })
    PHASE(3, { EpiDown1 E{p.ctx, modv, p.out, (bf16_t*)(ws + WS_A2)};
        GEMM((const bf16_t*)(ws + WS_HID), (const bf16_t*)(ws + WS_WD1_T), DFF, MT, D / 256, E, (float*)(ws + WS_SSQ1)); })
    PHASE(4, phase_rstd((const float*)(ws + WS_SSQ1), (float*)(ws + WS_RSTD1), MT, c))
    PHASE(5, { EpiWin E{(const float*)(ws + WS_RSTD1), (const float*)(ws + WS_SWIN), (const float*)(ws + WS_LBV), (bf16_t*)(ws + WS_V), (bf16_t*)(ws + WS_Q), (bf16_t*)(ws + WS_G), (bf16_t*)(ws + WS_HY), (bf16_t*)(ws + WS_GAB), (f16_t*)(ws + WS_LFW), (f16_t*)(ws + WS_LBW)};
        GEMM2((const bf16_t*)(ws + WS_A2), (const bf16_t*)(ws + WS_WIN_T), D, T, NIN / 256, TC, 6, E, nullptr); })
    PHASE(6, {
        { LAS float* scr = (LAS float*)(c.lds + c.wid * 8448);
          transpose_gu(p.ffn_wg + (size_t)D * DFF, 0, (bf16_t*)(ws + WS_WG2_T), scr, c.gw, c.ngw, c.lane);
          transpose_gu(p.ffn_wu + (size_t)D * DFF, 1, (bf16_t*)(ws + WS_WG2_T), scr, c.gw, c.ngw, c.lane);
          transpose_matrix(p.ffn_wd + (size_t)DFF * D, DFF, D, (bf16_t*)(ws + WS_WD2_T), scr, c.gw, c.ngw, c.lane); }
        __syncthreads();
        phase_hy_prepass(p, c); })
    PHASE(7, phase_hyena_mfma(p, c))
    PHASE(8, { if (USE_MFMA_HGRN) phase_hgrn_mfma(p, c); else phase_hgrn_simple(p, c); })
    PHASE(9, phase_combine(p, c))
    PHASE(10, { EpiProjA EA{(const bf16_t*)(ws + WS_GAB), (float*)(ws + WS_YTMP)}; EpiProjB EB{(const bf16_t*)(ws + WS_GAB), (const float*)(ws + WS_YTMP), (bf16_t*)(ws + WS_Y)};
        GEMM((const bf16_t*)(ws + WS_OA), (const bf16_t*)(ws + WS_WPA_T), 512, T, D / 256, EA, nullptr);
        GEMM((const bf16_t*)(ws + WS_OB), (const bf16_t*)(ws + WS_WPB_T), 512, T, D / 256, EB, nullptr); })
    PHASE(11, { EpiWout E{modv, p.out, (bf16_t*)(ws + WS_A3)};
        GEMM((const bf16_t*)(ws + WS_Y), (const bf16_t*)(ws + WS_WOUT_T), D, T, D / 256, E, (float*)(ws + WS_SSQ2)); })
    PHASE(12, phase_rstd((const float*)(ws + WS_SSQ2), (float*)(ws + WS_RSTD2), T, c))
    PHASE(13, { EpiGateUp2 E{(bf16_t*)(ws + WS_HID2), (const float*)(ws + WS_RSTD2), (const float*)(ws + WS_SW2)};
        GEMM((const bf16_t*)(ws + WS_A3), (const bf16_t*)(ws + WS_WG2_T), D, T, NGU / 256, E, nullptr); })
    PHASE(14, { EpiDown2 E{modv, p.out};
        GEMM((const bf16_t*)(ws + WS_HID2), (const bf16_t*)(ws + WS_WD2_T), DFF, T, D / 256, E, (float*)(ws + WS_SSQ3)); })
    PHASE(15, phase_final(p, c))
}

extern "C" void kernel_launch(void* const* d_in, const int* in_sizes, int n_in, void* d_out, int out_size, void* d_ws, size_t ws_size, hipStream_t stream) {
    static int grid = 0;
    if (grid == 0) {
        if (n_in != 26 || in_sizes[0] != T * D || out_size != T * D || ws_size < WS_TOTAL) { fprintf(stderr, "kernel_launch: unexpected shapes (n_in %d, in0 %d, out %d, ws %zu < %zu)\n", n_in, n_in > 0 ? in_sizes[0] : -1, out_size, ws_size, (size_t)WS_TOTAL); grid = -1; return; }
        int dev = 0, cus = 0, per_cu = 0;
        (void)hipGetDevice(&dev); (void)hipDeviceGetAttribute(&cus, hipDeviceAttributeMultiprocessorCount, dev);
        if (hipFuncSetAttribute((const void*)fwd_kernel, hipFuncAttributeMaxDynamicSharedMemorySize, LDS_BYTES) != hipSuccess) { fprintf(stderr, "kernel_launch: hipFuncSetAttribute failed\n"); grid = -1; return; }
        (void)hipOccupancyMaxActiveBlocksPerMultiprocessor(&per_cu, (const void*)fwd_kernel, NTHR, LDS_BYTES);
        if (per_cu < 1) { fprintf(stderr, "kernel_launch: occupancy query says %d blocks per CU\n", per_cu); per_cu = 1; }
        (void)hipGetLastError();
        grid = cus;
    }
    if (grid < 0) return;
    Params p{};
    const float** f = (const float**)&p;
    for (int i = 0; i < 26; ++i) f[i] = (const float*)d_in[i];
    p.out = (float*)d_out; p.ws = (unsigned char*)d_ws;
#if N_LAUNCH_MODE == 1
    p.ph_lo = 0; p.ph_hi = N_PHASES;
#if USE_XCD_BARRIER
    (void)hipMemsetAsync((unsigned char*)d_ws + WS_CTL, 0, XCD_BAR_WORDS * 4, stream);
#endif
    void* args[] = {&p};
    hipError_t e = hipLaunchCooperativeKernel((const void*)fwd_kernel, dim3(grid), dim3(NTHR), args, LDS_BYTES, stream);
    if (e != hipSuccess) fprintf(stderr, "cooperative launch failed: %s (grid %d)\n", hipGetErrorString(e), grid);
#else
    for (int k = 0; k < N_PHASES; ++k) { p.ph_lo = k; p.ph_hi = k + 1; for (int r = 0; r <= ((HOST_REPEAT_MASK >> k) & 1); ++r) hipLaunchKernelGGL(fwd_kernel, dim3(grid), dim3(NTHR), LDS_BYTES, stream, p); }
#endif
}
```

```cpp
#include <hip/hip_runtime.h>
#include <hip/hip_cooperative_groups.h>
#include <cstdio>
namespace cg = cooperative_groups;

#ifndef N_LAUNCH_MODE
#define N_LAUNCH_MODE 1
#endif
#ifndef USE_MFMA_HYENA
#define USE_MFMA_HYENA 1
#endif
#ifndef USE_MFMA_HGRN
#define USE_MFMA_HGRN 1
#endif
#ifndef USE_PG8
#define USE_PG8 1
#endif

#define LAS __attribute__((address_space(3)))
typedef unsigned short bf16_t;
typedef _Float16 f16_t;
typedef float f32x4 __attribute__((ext_vector_type(4)));
typedef unsigned u32x4 __attribute__((ext_vector_type(4)));
typedef unsigned u32x2 __attribute__((ext_vector_type(2)));

constexpr int D = 1024, NB = 16, SEQ = 2048, T = NB * SEQ, CL = 256, TC = NB * CL, MT = T + TC;
constexpr int DFF = 2816, NGU = 2 * DFF, NIN = 6144, MODW = 9 * D;
constexpr int AKW = 512, AVW = 512, BW = 512, NHY = 3 * BW;
constexpr int KR_LEN = 4128, KR_OFF = 2056;
constexpr float RMS_EPS = 1e-6f;
constexpr int NTHR = 512, NWAVES = 8;
constexpr int LDS_BYTES = 152 * 1024;

constexpr size_t MiB = 1024 * 1024;
constexpr size_t al256(size_t x) { return (x + 255) & ~(size_t)255; }
constexpr size_t WS_CTL = 0;
constexpr size_t WS_MODV = WS_CTL + 65536;
constexpr size_t WS_SWIN = WS_MODV + al256((size_t)17 * MODW * 4);
constexpr size_t WS_SW2 = WS_SWIN + al256((size_t)17 * NIN * 4);
constexpr size_t WS_ER = WS_SW2 + al256((size_t)17 * NGU * 4);
constexpr size_t WS_EC = WS_ER + 32 * 512 * 4;
constexpr size_t WS_LBV = WS_EC + 64 * 512 * 4;
constexpr size_t WS_H2 = WS_LBV + 4096;
constexpr size_t WS_KREV = WS_H2 + 2048 * 64 * 4;
constexpr size_t WS_WIN_T = WS_KREV + al256((size_t)2 * 512 * KR_LEN * 2);
constexpr size_t WS_WPA_T = WS_WIN_T + (size_t)NIN * D * 2;
constexpr size_t WS_WPB_T = WS_WPA_T + (size_t)D * 512 * 2;
constexpr size_t WS_WOUT_T = WS_WPB_T + (size_t)D * 512 * 2;
constexpr size_t WS_RSTD1 = WS_WOUT_T + (size_t)D * D * 2;
constexpr size_t WS_RSTD2 = WS_RSTD1 + (size_t)MT * 4;
constexpr size_t WS_PERSIST_END = WS_RSTD2 + (size_t)T * 4;
constexpr size_t AR = 27 * MiB;
static_assert(WS_PERSIST_END <= AR, "persistent region");
constexpr size_t WS_HID = AR + 0 * MiB;
constexpr size_t WS_N1 = AR + 198 * MiB;
constexpr size_t WS_WG1_T = AR + 270 * MiB;
constexpr size_t WS_WD1_T = AR + 281 * MiB;
constexpr size_t WS_SSQ1 = AR + 410 * MiB;
constexpr size_t WS_A2 = AR + 413 * MiB;
constexpr size_t WS_GAB = AR + 0 * MiB;
constexpr size_t WS_V = AR + 128 * MiB;
constexpr size_t WS_LFW = AR + 164 * MiB;
constexpr size_t WS_LBW = AR + 200 * MiB;
constexpr size_t WS_Q = AR + 236 * MiB;
constexpr size_t WS_G = AR + 268 * MiB;
constexpr size_t WS_HY = AR + 300 * MiB;
constexpr size_t WS_WG2_T = AR + 436 * MiB;
constexpr size_t WS_WD2_T = AR + 447 * MiB;
constexpr size_t WS_ZB = AR + 453 * MiB;
constexpr size_t WS_OFW = AR + 300 * MiB;
constexpr size_t WS_OBW = AR + 364 * MiB;
constexpr size_t WS_OA = AR + 128 * MiB;
constexpr size_t WS_OB = AR + 160 * MiB;
constexpr size_t WS_YTMP = AR + 192 * MiB;
constexpr size_t WS_Y = AR + 320 * MiB;
constexpr size_t WS_A3 = AR + 0 * MiB;
constexpr size_t WS_SSQ2 = AR + 64 * MiB;
constexpr size_t WS_SSQ3 = AR + 66 * MiB;
constexpr size_t WS_HID2 = AR + 128 * MiB;
constexpr size_t WS_TOTAL = AR + 485 * MiB;

struct Params {
    const float *x, *c, *ctx, *c_ctx, *mod_w, *mod_b, *ffn_wg, *ffn_wu, *ffn_wd, *w_in, *lb_logits, *a_norm_w, *conv_w, *conv_b;
    const float *hw1, *hb1, *hfr1, *hw2, *hb2, *hfr2, *hw3, *hy_bias, *w_pa, *w_pb, *w_out, *fnw;
    float* out; unsigned char* ws;
    int ph_lo, ph_hi;
};

__device__ __forceinline__ float bf2f(bf16_t b) { return __uint_as_float(((unsigned)b) << 16); }
__device__ __forceinline__ bf16_t f2bf(float f) { unsigned u = __float_as_uint(f); u += 0x7FFFu + ((u >> 16) & 1u); return (bf16_t)(u >> 16); }
typedef float f32x2_t __attribute__((ext_vector_type(2)));
typedef __bf16 bf16x2_t __attribute__((ext_vector_type(2)));
__device__ __forceinline__ unsigned pk2(float lo, float hi) { const f32x2_t v = {lo, hi}; return __builtin_bit_cast(unsigned, __builtin_convertvector(v, bf16x2_t)); }
__device__ __forceinline__ float bfround(float f) { return bf2f(f2bf(f)); }
__device__ __forceinline__ float sigmoidf_(float x) { return __builtin_amdgcn_rcpf(1.0f + __builtin_amdgcn_exp2f(x * -1.4426950408889634f)); }
__device__ __forceinline__ float siluf_(float x) { return x * sigmoidf_(x); }
__device__ __forceinline__ float wave_sum(float v) {
#pragma unroll
    for (int o = 1; o < 64; o <<= 1) v += __shfl_xor(v, o);
    return v;
}
__device__ __forceinline__ float pos_embed(const float* er, const float* ec, int t, int col) {
    return col < 512 ? er[(t >> 6) * 512 + col] : ec[(t & 63) * 512 + (col - 512)];
}
__device__ __forceinline__ float rstd_from_ssq(const float* ssq16) {
    const f32x4* s = (const f32x4*)ssq16; float tot = 0.f;
#pragma unroll
    for (int i = 0; i < 4; ++i) { const f32x4 v = s[i]; tot += (v[0] + v[1]) + (v[2] + v[3]); }
    return __builtin_amdgcn_rsqf(tot * (1.0f / D) + RMS_EPS);
}

__device__ __forceinline__ void transpose_item(const float* W, int K, int N, bf16_t* WT, int k0, int n0, int dst_row0, LAS float* scr, int lane) {
#pragma unroll 8
    for (int i = 0; i < 32; ++i) { const int kk = 2 * i + (lane >> 5); scr[kk * 33 + (lane & 31)] = W[(size_t)(k0 + kk) * N + n0 + (lane & 31)]; }
    asm volatile("s_waitcnt lgkmcnt(0)" ::: "memory");
    const int c = lane & 7;
#pragma unroll
    for (int j = 0; j < 4; ++j) { const int n = (lane >> 3) + 8 * j; const LAS float* s = scr + (8 * c) * 33 + n;
        u32x4 o; o.x = pk2(s[0 * 33], s[1 * 33]); o.y = pk2(s[2 * 33], s[3 * 33]); o.z = pk2(s[4 * 33], s[5 * 33]); o.w = pk2(s[6 * 33], s[7 * 33]);
        *(u32x4*)(WT + (size_t)(dst_row0 + n) * K + k0 + 8 * c) = o; }
    asm volatile("s_waitcnt lgkmcnt(0)" ::: "memory");
}
__device__ __forceinline__ void transpose_matrix(const float* W, int K, int N, bf16_t* WT, LAS float* scr, int gw, int ngw, int lane) {
    const int nblk = N / 32, items = (K / 64) * nblk;
    for (int it = gw; it < items; it += ngw) { const int kb = it / nblk, nb = it % nblk; transpose_item(W, K, N, WT, 64 * kb, 32 * nb, 32 * nb, scr, lane); }
}
__device__ __forceinline__ void transpose_gu(const float* W, int half, bf16_t* WT, LAS float* scr, int gw, int ngw, int lane) {
    const int nblk = DFF / 32, items = (D / 64) * nblk;
    for (int it = gw; it < items; it += ngw) { const int kb = it / nblk, nb = it % nblk, n0 = 32 * nb;
        transpose_item(W, D, DFF, WT, 64 * kb, n0, 256 * (n0 >> 7) + 128 * half + (n0 & 127), scr, lane); }
}

template <bool GU>
__device__ __forceinline__ void gemv17(const LAS float* xs, LAS float* part, const float* W, int N, const float* bias, float* out, int ldo, int half, int blk0, int nblk_stride) {
    const int tid = threadIdx.x, wid = tid >> 6, lane = tid & 63;
    for (int cb = blk0; cb < N / 64; cb += nblk_stride) {
        const int n = cb * 64 + lane;
        float acc[17];
#pragma unroll
        for (int r = 0; r < 17; ++r) acc[r] = 0.f;
        const float* wp = W + (size_t)(wid * 128) * N + n;
#pragma unroll 4
        for (int k = 0; k < 128; ++k) { const float w = wp[(size_t)k * N];
#pragma unroll
            for (int r = 0; r < 17; ++r) acc[r] += xs[r * 1024 + wid * 128 + k] * w; }
#pragma unroll
        for (int r = 0; r < 17; ++r) part[(wid * 17 + r) * 64 + lane] = acc[r];
        __syncthreads();
        for (int o = tid; o < 17 * 64; o += NTHR) { const int r = o >> 6, l = o & 63; float s = 0.f;
#pragma unroll
            for (int w = 0; w < 8; ++w) s += part[(w * 17 + r) * 64 + l];
            const int nn = cb * 64 + l; if (bias) s += bias[nn];
            const int on = GU ? (256 * (nn >> 7) + 128 * half + (nn & 127)) : nn;
            out[(size_t)r * ldo + on] = s; }
        __syncthreads();
    }
}

__device__ __forceinline__ void store_bf16x8(bf16_t* p, const float (&v)[8]) { u32x4 w; w.x = pk2(v[0], v[1]); w.y = pk2(v[2], v[3]); w.z = pk2(v[4], v[5]); w.w = pk2(v[6], v[7]); *(u32x4*)p = w; }
__device__ __forceinline__ void load_f32x8(const float* p, float (&v)[8]) { const f32x4 a = *(const f32x4*)p, b = *(const f32x4*)(p + 4); v[0] = a[0]; v[1] = a[1]; v[2] = a[2]; v[3] = a[3]; v[4] = b[0]; v[5] = b[1]; v[6] = b[2]; v[7] = b[3]; }
__device__ __forceinline__ void store_f32x8(float* p, const float (&v)[8]) { *(f32x4*)p = (f32x4){v[0], v[1], v[2], v[3]}; *(f32x4*)(p + 4) = (f32x4){v[4], v[5], v[6], v[7]}; }
__device__ __forceinline__ void unpack_bf16x8(const u32x4 w, float (&v)[8]) { v[0] = __uint_as_float(w.x << 16); v[1] = __uint_as_float(w.x & 0xffff0000u); v[2] = __uint_as_float(w.y << 16); v[3] = __uint_as_float(w.y & 0xffff0000u);
    v[4] = __uint_as_float(w.z << 16); v[5] = __uint_as_float(w.z & 0xffff0000u); v[6] = __uint_as_float(w.w << 16); v[7] = __uint_as_float(w.w & 0xffff0000u); }
__device__ __forceinline__ void load_bf16x8(const bf16_t* p, float (&v)[8]) { const u32x4 w = *(const u32x4*)p; v[0] = __uint_as_float(w.x << 16); v[1] = __uint_as_float(w.x & 0xffff0000u); v[2] = __uint_as_float(w.y << 16); v[3] = __uint_as_float(w.y & 0xffff0000u);
    v[4] = __uint_as_float(w.z << 16); v[5] = __uint_as_float(w.z & 0xffff0000u); v[6] = __uint_as_float(w.w << 16); v[7] = __uint_as_float(w.w & 0xffff0000u); }

struct EpiGateUp1 {
    static constexpr int PD = 1;
    struct Cols {}; struct Row {};
    bf16_t* hid;
    __device__ __forceinline__ void load_cols(Cols&, int, int, int) const {}
    __device__ __forceinline__ void load_row(Row&, int, int, int) const {}
    __device__ __forceinline__ float finish(int row, int pn, int c, const float (&v0)[8], const float (&v1)[8], const Cols&, const Row&) const {
        float o[8];
#pragma unroll
        for (int j = 0; j < 8; ++j) o[j] = siluf_(v0[j]) * v1[j];
        store_bf16x8(hid + (size_t)row * DFF + 128 * pn + c, o); return 0.f; }
};
struct EpiGateUp2 {
    static constexpr int PD = 8;
    struct Cols { float s0[8], s1[8]; }; struct Row { float rs; };
    bf16_t* hid; const float* rstd; const float* sw;
    __device__ __forceinline__ void load_cols(Cols& k, int pm, int pn, int c) const { const int b = pm >> 3; load_f32x8(sw + (size_t)b * NGU + 256 * pn + c, k.s0); load_f32x8(sw + (size_t)b * NGU + 256 * pn + 128 + c, k.s1); }
    __device__ __forceinline__ void load_row(Row& r, int row, int, int) const { r.rs = rstd[row]; }
    __device__ __forceinline__ float finish(int row, int pn, int c, const float (&v0)[8], const float (&v1)[8], const Cols& k, const Row& r) const {
        float o[8];
#pragma unroll
        for (int j = 0; j < 8; ++j) o[j] = siluf_(r.rs * v0[j] + k.s0[j]) * (r.rs * v1[j] + k.s1[j]);
        store_bf16x8(hid + (size_t)row * DFF + 128 * pn + c, o); return 0.f; }
};
struct EpiDown1 {
    static constexpr int PD = 2;
    struct Cols { float g0[8], g1[8], s0[8], s1[8]; }; struct Row { float b0[8], b1[8]; };
    const float *ctx, *modv; float* h; bf16_t* a2;
    __device__ __forceinline__ void load_cols(Cols& k, int pm, int pn, int c) const { const int b = pm < T / 256 ? (pm >> 3) : 16; const float* m = modv + (size_t)b * MODW + 256 * pn + c;
        load_f32x8(m + 2 * D, k.g0); load_f32x8(m + 2 * D + 128, k.g1); load_f32x8(m + 4 * D, k.s0); load_f32x8(m + 4 * D + 128, k.s1); }
    __device__ __forceinline__ void load_row(Row& r, int row, int pn, int c) const { const float* src = (row < T ? h + (size_t)row * D : ctx + (size_t)(row - T) * D) + 256 * pn + c; load_f32x8(src, r.b0); load_f32x8(src + 128, r.b1); }
    __device__ __forceinline__ float finish(int row, int pn, int c, const float (&v0)[8], const float (&v1)[8], const Cols& k, const Row& r) const {
        float h0[8], h1[8], a0[8], a1[8]; float s = 0.f;
#pragma unroll
        for (int j = 0; j < 8; ++j) { h0[j] = r.b0[j] + 0.5f * k.g0[j] * v0[j]; h1[j] = r.b1[j] + 0.5f * k.g1[j] * v1[j]; s += h0[j] * h0[j] + h1[j] * h1[j]; a0[j] = h0[j] * (1.0f + k.s0[j]); a1[j] = h1[j] * (1.0f + k.s1[j]); }
        const size_t o = (size_t)row * D + 256 * pn + c;
        if (row < T) { store_f32x8(h + o, h0); store_f32x8(h + o + 128, h1); }
        store_bf16x8(a2 + o, a0); store_bf16x8(a2 + o + 128, a1); return s; }
};
struct EpiWin {
    static constexpr int PD = 8;
    struct Cols { float s0[8], s1[8], l0[8], l1[8]; }; struct Row { float rs; };
    const float *rstd, *sw, *lbv; bf16_t *v, *q, *g, *hy, *gab; f16_t *lfw, *lbw;
    __device__ __forceinline__ void load_cols(Cols& k, int pm, int pn, int c) const { const int b = pm < T / 256 ? (pm >> 3) : 16; const int n = 256 * pn + c;
        load_f32x8(sw + (size_t)b * NIN + n, k.s0); load_f32x8(sw + (size_t)b * NIN + n + 128, k.s1);
        if (pn >= 2 && pn < 6) { load_f32x8(lbv + n - 512, k.l0); load_f32x8(lbv + n - 512 + 128, k.l1); } }
    __device__ __forceinline__ void load_row(Row& r, int row, int, int) const { r.rs = rstd[row]; }
    __device__ __forceinline__ void half_(int row, int n, float rs, const float (&a)[8], const float (&s)[8], const float (&lb)[8]) const {
        float p[8];
#pragma unroll
        for (int j = 0; j < 8; ++j) p[j] = rs * a[j] + s[j];
        const int grp = n >> 9;
        if (grp == 0) { store_bf16x8(v + (size_t)row * 512 + n, p); }
        else if (grp <= 2) { const int nn = n - 512 * grp; f16_t* dst = (grp == 1 ? lfw : lbw) + (size_t)row * 512 + nn; f16_t o[8];
#pragma unroll
            for (int j = 0; j < 8; ++j) { const float f = lb[j] + (1.0f - lb[j]) * sigmoidf_(p[j]); o[j] = (f16_t)(__builtin_amdgcn_logf(f) * 0.6931471805599453f); }
            *(u32x4*)dst = *(const u32x4*)o; }
        else if (grp == 3) {
#pragma unroll
            for (int j = 0; j < 8; ++j) p[j] = siluf_(p[j]);
            store_bf16x8(q + (size_t)row * 512 + (n - 1536), p); }
        else if (grp == 4) {
#pragma unroll
            for (int j = 0; j < 8; ++j) p[j] = siluf_(p[j]);
            store_bf16x8(g + (size_t)row * 512 + (n - 2048), p); }
        else if (grp <= 7) { const int ch = n - 2560, t = row & (SEQ - 1), b = row >> 11; store_bf16x8(hy + (((size_t)(ch >> 3) * NB + b) * SEQ + t) * 8, p); }
        else {
#pragma unroll
            for (int j = 0; j < 8; ++j) p[j] = sigmoidf_(p[j]);
            store_bf16x8(gab + (size_t)row * 2048 + (n - 4096), p); }
    }
    __device__ __forceinline__ float finish(int row, int pn, int c, const float (&v0)[8], const float (&v1)[8], const Cols& k, const Row& r) const {
        half_(row, 256 * pn + c, r.rs, v0, k.s0, k.l0); half_(row, 256 * pn + 128 + c, r.rs, v1, k.s1, k.l1); return 0.f; }
};
struct EpiProjA {
    static constexpr int PD = 4;
    struct Cols {}; struct Row { u32x4 g0, g1; };
    const bf16_t* gab; bf16_t* ytmp;
    __device__ __forceinline__ void load_cols(Cols&, int, int, int) const {}
    __device__ __forceinline__ void load_row(Row& r, int row, int pn, int c) const { const bf16_t* src = gab + (size_t)row * 2048 + 256 * pn + c; r.g0 = *(const u32x4*)src; r.g1 = *(const u32x4*)(src + 128); }
    __device__ __forceinline__ float finish(int row, int pn, int c, const float (&v0)[8], const float (&v1)[8], const Cols&, const Row& r) const {
        float g0[8], g1[8], o0[8], o1[8]; unpack_bf16x8(r.g0, g0); unpack_bf16x8(r.g1, g1);
#pragma unroll
        for (int j = 0; j < 8; ++j) { o0[j] = g0[j] * v0[j]; o1[j] = g1[j] * v1[j]; }
        bf16_t* dst = ytmp + (size_t)row * D + 256 * pn + c; store_bf16x8(dst, o0); store_bf16x8(dst + 128, o1); return 0.f; }
};
struct EpiProjB {
    static constexpr int PD = 4;
    struct Cols {}; struct Row { u32x4 g0, g1, y0, y1; };
    const bf16_t* gab; const bf16_t* ytmp; bf16_t* y;
    __device__ __forceinline__ void load_cols(Cols&, int, int, int) const {}
    __device__ __forceinline__ void load_row(Row& r, int row, int pn, int c) const { const bf16_t* src = gab + (size_t)row * 2048 + 1024 + 256 * pn + c; r.g0 = *(const u32x4*)src; r.g1 = *(const u32x4*)(src + 128);
        const bf16_t* ys = ytmp + (size_t)row * D + 256 * pn + c; r.y0 = *(const u32x4*)ys; r.y1 = *(const u32x4*)(ys + 128); }
    __device__ __forceinline__ float finish(int row, int pn, int c, const float (&v0)[8], const float (&v1)[8], const Cols&, const Row& r) const {
        float g0[8], g1[8], y0[8], y1[8], o0[8], o1[8]; unpack_bf16x8(r.g0, g0); unpack_bf16x8(r.g1, g1); unpack_bf16x8(r.y0, y0); unpack_bf16x8(r.y1, y1);
#pragma unroll
        for (int j = 0; j < 8; ++j) { o0[j] = y0[j] + g0[j] * v0[j]; o1[j] = y1[j] + g1[j] * v1[j]; }
        bf16_t* dst = y + (size_t)row * D + 256 * pn + c; store_bf16x8(dst, o0); store_bf16x8(dst + 128, o1); return 0.f; }
};
struct EpiWout {
    static constexpr int PD = 2;
    struct Cols { float g0[8], g1[8], s0[8], s1[8]; }; struct Row { float b0[8], b1[8]; };
    const float* modv; float* h; bf16_t* a3;
    __device__ __forceinline__ void load_cols(Cols& k, int pm, int pn, int c) const { const float* m = modv + (size_t)(pm >> 3) * MODW + 256 * pn + c;
        load_f32x8(m + 5 * D, k.g0); load_f32x8(m + 5 * D + 128, k.g1); load_f32x8(m + 7 * D, k.s0); load_f32x8(m + 7 * D + 128, k.s1); }
    __device__ __forceinline__ void load_row(Row& r, int row, int pn, int c) const { const float* src = h + (size_t)row * D + 256 * pn + c; load_f32x8(src, r.b0); load_f32x8(src + 128, r.b1); }
    __device__ __forceinline__ float finish(int row, int pn, int c, const float (&v0)[8], const float (&v1)[8], const Cols& k, const Row& r) const {
        float h0[8], h1[8], a0[8], a1[8]; float s = 0.f;
#pragma unroll
        for (int j = 0; j < 8; ++j) { h0[j] = r.b0[j] + k.g0[j] * v0[j]; h1[j] = r.b1[j] + k.g1[j] * v1[j]; s += h0[j] * h0[j] + h1[j] * h1[j]; a0[j] = h0[j] * (1.0f + k.s0[j]); a1[j] = h1[j] * (1.0f + k.s1[j]); }
        const size_t o = (size_t)row * D + 256 * pn + c;
        store_f32x8(h + o, h0); store_f32x8(h + o + 128, h1); store_bf16x8(a3 + o, a0); store_bf16x8(a3 + o + 128, a1); return s; }
};
struct EpiDown2 {
    static constexpr int PD = 2;
    struct Cols { float g0[8], g1[8]; }; struct Row { float b0[8], b1[8]; };
    const float* modv; float* h;
    __device__ __forceinline__ void load_cols(Cols& k, int pm, int pn, int c) const { const float* m = modv + (size_t)(pm >> 3) * MODW + 8 * D + 256 * pn + c; load_f32x8(m, k.g0); load_f32x8(m + 128, k.g1); }
    __device__ __forceinline__ void load_row(Row& r, int row, int pn, int c) const { const float* src = h + (size_t)row * D + 256 * pn + c; load_f32x8(src, r.b0); load_f32x8(src + 128, r.b1); }
    __device__ __forceinline__ float finish(int row, int pn, int c, const float (&v0)[8], const float (&v1)[8], const Cols& k, const Row& r) const {
        float h0[8], h1[8]; float s = 0.f;
#pragma unroll
        for (int j = 0; j < 8; ++j) { h0[j] = r.b0[j] + 0.5f * k.g0[j] * v0[j]; h1[j] = r.b1[j] + 0.5f * k.g1[j] * v1[j]; s += h0[j] * h0[j] + h1[j] * h1[j]; }
        const size_t o = (size_t)row * D + 256 * pn + c; store_f32x8(h + o, h0); store_f32x8(h + o + 128, h1); return s; }
};

template <class Epi>
__device__ __forceinline__ void gemm_simple(LAS unsigned char* lds, const bf16_t* A, const bf16_t* Bt, int K, int row0, int nrows, int npn, const Epi& E, float* ssq) {
    LAS float* As = (LAS float*)lds;
    LAS float* Bs = (LAS float*)(lds + 8192);
    const int tid = threadIdx.x, c8 = tid & 15, rg = tid >> 4;
    const int nrt = nrows / 64, nunits = nrt * npn;
    for (int unit = blockIdx.x; unit < nunits; unit += gridDim.x) {
        const int rt = unit / npn, pn = unit % npn, r0 = row0 + rt * 64;
        float a0[2][8], a1[2][8];
#pragma unroll
        for (int r = 0; r < 2; ++r)
#pragma unroll
            for (int j = 0; j < 8; ++j) { a0[r][j] = 0.f; a1[r][j] = 0.f; }
        for (int k0 = 0; k0 < K; k0 += 32) {
            { const int row = tid >> 3, kq = tid & 7; const u32x2 w = *(const u32x2*)(A + (size_t)(r0 + row) * K + k0 + 4 * kq);
              As[(4 * kq + 0) * 64 + row] = __uint_as_float(w.x << 16); As[(4 * kq + 1) * 64 + row] = __uint_as_float(w.x & 0xffff0000u);
              As[(4 * kq + 2) * 64 + row] = __uint_as_float(w.y << 16); As[(4 * kq + 3) * 64 + row] = __uint_as_float(w.y & 0xffff0000u); }
            { const int n = tid >> 1, kh = tid & 1; const bf16_t* src = Bt + (size_t)(pn * 256 + n) * K + k0 + 16 * kh; float t8[8];
              load_bf16x8(src, t8);
#pragma unroll
              for (int i = 0; i < 8; ++i) Bs[(16 * kh + i) * 256 + n] = t8[i];
              load_bf16x8(src + 8, t8);
#pragma unroll
              for (int i = 0; i < 8; ++i) Bs[(16 * kh + 8 + i) * 256 + n] = t8[i]; }
            __syncthreads();
#pragma unroll 8
            for (int k = 0; k < 32; ++k) {
                const float x0 = As[k * 64 + 2 * rg], x1 = As[k * 64 + 2 * rg + 1];
                const f32x4 b00 = *(const LAS f32x4*)(Bs + k * 256 + 8 * c8), b01 = *(const LAS f32x4*)(Bs + k * 256 + 8 * c8 + 4);
                const f32x4 b10 = *(const LAS f32x4*)(Bs + k * 256 + 128 + 8 * c8), b11 = *(const LAS f32x4*)(Bs + k * 256 + 128 + 8 * c8 + 4);
#pragma unroll
                for (int j = 0; j < 4; ++j) { a0[0][j] += x0 * b00[j]; a0[0][4 + j] += x0 * b01[j]; a1[0][j] += x0 * b10[j]; a1[0][4 + j] += x0 * b11[j];
                                              a0[1][j] += x1 * b00[j]; a0[1][4 + j] += x1 * b01[j]; a1[1][j] += x1 * b10[j]; a1[1][4 + j] += x1 * b11[j]; }
            }
            __syncthreads();
        }
#pragma unroll
        for (int r = 0; r < 2; ++r) { const int row = r0 + 2 * rg + r; typename Epi::Cols kc; typename Epi::Row kr; E.load_cols(kc, row >> 8, pn, 8 * c8); E.load_row(kr, row, pn, 8 * c8); float s = E.finish(row, pn, 8 * c8, a0[r], a1[r], kc, kr);
            s += __shfl_xor(s, 1); s += __shfl_xor(s, 2); s += __shfl_xor(s, 4); s += __shfl_xor(s, 8);
            if (ssq && c8 == 0) *(f32x4*)(ssq + (size_t)row * 16 + pn * 4) = (f32x4){s, 0.f, 0.f, 0.f}; }
    }
}

namespace pg8 {
#define PG8_LAS __attribute__((address_space(3)))
typedef unsigned short bf16_t;
typedef short bf16x8 __attribute__((ext_vector_type(8)));
typedef float f32x4 __attribute__((ext_vector_type(4)));
typedef unsigned u32x4 __attribute__((ext_vector_type(4)));
constexpr int BM = 256, BK = 64, HALF = 128, HTB = HALF * BK * 2  , STAGE_BYTES = 8 * HTB, NXCD = 8, WGM = 8;

__host__ __device__ __forceinline__ int lds_byte(int r, int c) { const int st = (r >> 4) * 2 + (c >> 5), rr = r & 15, cc = c & 31, ob = rr * 64 + cc * 2; return st * 1024 + (ob ^ (((ob >> 9) & 1) << 5)); }
__host__ __device__ __forceinline__ void stage_rc(int b, int& R, int& C) { const int st = b / 1024, sb = b % 1024, swz = sb ^ (((sb >> 9) & 1) << 5); R = (st >> 1) * 16 + swz / 64; C = (st & 1) * 32 + (swz % 64) / 2; }
__host__ __device__ __forceinline__ int perm32(int rho) { const int n = rho >> 4, i = rho & 15; return 8 * (i >> 2) + 4 * n + (i & 3); }

struct Unit { int pm, pn; };
struct Gemm { const bf16_t* A; const bf16_t* Bt; int M, N, K; };

struct StaticOrder {
    int nM, nN, nwg, G, c;
    __host__ __device__ void init(int M, int N, int G_, int c_) { nM = M / BM; nN = N / BM; nwg = nM * nN; G = G_; c = c_; }
    __host__ __device__ bool next(int i, Unit& u) const {
        const long L = (long)i * G + c; if (L >= nwg) return false;
        int wgid = (int)L; { const int q = nwg / NXCD, r = nwg % NXCD, xcd = wgid % NXCD, off = wgid / NXCD; wgid = (xcd < r ? xcd * (q + 1) : r * (q + 1) + (xcd - r) * q) + off; }
        const int nig = WGM * nN, gid = wgid / nig, fm = gid * WGM, gsz = (nM - fm) < WGM ? (nM - fm) : WGM;
        u.pm = fm + ((wgid % nig) % gsz); u.pn = (wgid % nig) / gsz; return true;
    }
    __device__ __forceinline__ void a_ready(const Unit&) const {}
    __device__ __forceinline__ void done(const Unit&) const {}
};
template <class Epi, class Sched>
__device__ __forceinline__ void gemm_phase(PG8_LAS unsigned char* lds, const Gemm g, const Sched& S, const Epi& E) {
    const int tid = threadIdx.x, wid = __builtin_amdgcn_readfirstlane(tid >> 6), lane = tid & 63, wr = wid >> 2, wc = wid & 3, fr = lane & 15, fq = lane >> 4;
    const int K = g.K, nt = K / BK;
    unsigned voffA[2], voffB[2];
#pragma unroll
    for (int i = 0; i < 2; ++i) { int R, C; stage_rc(tid * 16 + i * 8192, R, C); const int Rb = Epi::PERM ? ((R & ~31) + perm32(R & 31)) : R;
        voffA[i] = (unsigned)(R * K + C) * 2u; voffB[i] = (unsigned)(Rb * K + C) * 2u; }
    const size_t kstep = (size_t)(BK * 2);
    const size_t hstep = (size_t)HALF * K * 2;
    const size_t tstep = 2 * hstep;
    const unsigned ldsw = (unsigned)wid * 1024u;
    const int aoff = lds_byte(wr * 64 + fr, fq * 8), boff = lds_byte(wc * 32 + fr, fq * 8);
#define PG8_SA(b, h) (((b) * 2 + (h)) * HTB)
#define PG8_SB(b, h) ((4 + (b) * 2 + (h)) * HTB)
#define PG8_STAGE(bufoff, gbase, voff) do { _Pragma("unroll") for (int _i = 0; _i < 2; ++_i) \
        __builtin_amdgcn_global_load_lds((const unsigned*)((const char*)(gbase) + (voff)[_i]), (PG8_LAS unsigned*)(lds + (bufoff) + ldsw + _i * 8192), 16, 0, 0); } while (0)
#define PG8_LDA(dst, b, h) do { _Pragma("unroll") for (int m = 0; m < 4; ++m) _Pragma("unroll") for (int k = 0; k < 2; ++k) dst[m][k] = *(const PG8_LAS bf16x8*)(lds + PG8_SA(b, h) + aoff + m * 2048 + k * 1024); } while (0)
#define PG8_LDB(dst, b, h) do { _Pragma("unroll") for (int n = 0; n < 2; ++n) _Pragma("unroll") for (int k = 0; k < 2; ++k) dst[n][k] = *(const PG8_LAS bf16x8*)(lds + PG8_SB(b, h) + boff + n * 2048 + k * 1024); } while (0)
#define PG8_MMA(ai, bj, At, Bt) do { __builtin_amdgcn_s_setprio(1); _Pragma("unroll") for (int m = 0; m < 4; ++m) _Pragma("unroll") for (int n = 0; n < 2; ++n) _Pragma("unroll") for (int k = 0; k < 2; ++k) \
        acc[ai][bj][m][n] = __builtin_amdgcn_mfma_f32_16x16x32_bf16(Bt[n][k], At[m][k], acc[ai][bj][m][n], 0, 0, 0); __builtin_amdgcn_s_setprio(0); } while (0)
#define PG8_WAIT_V(n) asm volatile("s_waitcnt vmcnt(" #n ")" ::: "memory")
#define PG8_WAIT_L(n) asm volatile("s_waitcnt lgkmcnt(" #n ")" ::: "memory")
#define PG8_BAR __builtin_amdgcn_s_barrier()
#define PG8_SCHED __builtin_amdgcn_sched_barrier(0)
    Unit cur, nxt; int ui = 0;
    if (!S.next(0, cur)) return;
    f32x4 acc[2][2][4][2];
#pragma unroll
    for (int a = 0; a < 2; ++a)
#pragma unroll
        for (int b = 0; b < 2; ++b)
#pragma unroll
            for (int m = 0; m < 4; ++m)
#pragma unroll
                for (int n = 0; n < 2; ++n) acc[a][b][m][n] = (f32x4){0.f, 0.f, 0.f, 0.f};
    bf16x8 At[4][2], B0[2][2], B1[2][2];
    const char* cA = (const char*)g.A + (size_t)cur.pm * tstep; const char* cB = (const char*)g.Bt + (size_t)cur.pn * tstep;
    S.a_ready(cur);
    PG8_STAGE(PG8_SB(0, 0), cB, voffB); PG8_STAGE(PG8_SA(0, 0), cA, voffA); PG8_STAGE(PG8_SB(0, 1), cB + hstep, voffB); PG8_STAGE(PG8_SA(0, 1), cA + hstep, voffA);
    if (wr == 1) PG8_BAR;
    PG8_WAIT_V(4); PG8_BAR;
    PG8_STAGE(PG8_SB(1, 0), cB + kstep, voffB); PG8_STAGE(PG8_SA(1, 0), cA + kstep, voffA); PG8_STAGE(PG8_SB(1, 1), cB + hstep + kstep, voffB);
    PG8_WAIT_V(6); PG8_BAR;
    for (;;) {
        const bool has_next = S.next(ui + 1, nxt);
        const char* nA = has_next ? (const char*)g.A + (size_t)nxt.pm * tstep : cA; const char* nB = has_next ? (const char*)g.Bt + (size_t)nxt.pn * tstep : cB;
        for (int t = 0; t < nt; t += 2) {
            const bool last = (t == nt - 2);
            const char* a1 = cA + (size_t)(t + 1) * kstep;
            const char* a2 = last ? nA : cA + (size_t)(t + 2) * kstep; const char* b2 = last ? nB : cB + (size_t)(t + 2) * kstep;
            const char* a3 = a2 + kstep; const char* b3 = b2 + kstep;
            if (last && has_next) S.a_ready(nxt);
            PG8_LDB(B0, 0, 0); PG8_SCHED; PG8_LDA(At, 0, 0); PG8_STAGE(PG8_SA(1, 1), a1 + hstep, voffA);
            PG8_WAIT_L(8); PG8_BAR; PG8_WAIT_L(0); PG8_MMA(0, 0, At, B0); PG8_BAR; PG8_SCHED;
            PG8_LDB(B1, 0, 1); PG8_STAGE(PG8_SB(0, 0), b2, voffB);
            PG8_BAR; PG8_WAIT_L(0); PG8_MMA(0, 1, At, B1); PG8_BAR;
            PG8_LDA(At, 0, 1); PG8_STAGE(PG8_SA(0, 0), a2, voffA);
            PG8_BAR; PG8_WAIT_L(0); PG8_MMA(1, 0, At, B0); PG8_BAR; PG8_SCHED;
            PG8_STAGE(PG8_SB(0, 1), b2 + hstep, voffB);
            PG8_WAIT_V(6); PG8_BAR; PG8_MMA(1, 1, At, B1); PG8_BAR;
            PG8_LDB(B0, 1, 0); PG8_SCHED; PG8_LDA(At, 1, 0); PG8_STAGE(PG8_SA(0, 1), a2 + hstep, voffA);
            PG8_WAIT_L(8); PG8_BAR; PG8_WAIT_L(0); PG8_MMA(0, 0, At, B0); PG8_BAR; PG8_SCHED;
            PG8_LDB(B1, 1, 1); PG8_STAGE(PG8_SB(1, 0), b3, voffB);
            PG8_BAR; PG8_WAIT_L(0); PG8_MMA(0, 1, At, B1); PG8_BAR;
            PG8_LDA(At, 1, 1); PG8_STAGE(PG8_SA(1, 0), a3, voffA);
            PG8_BAR; PG8_WAIT_L(0); PG8_MMA(1, 0, At, B0); PG8_BAR; PG8_SCHED;
            PG8_STAGE(PG8_SB(1, 1), b3 + hstep, voffB);
            PG8_WAIT_V(6); PG8_BAR; PG8_MMA(1, 1, At, B1); PG8_BAR;
        }
        if constexpr (!Epi::AFTER_DRAIN) { E(acc, cur, wr, wc, fr, fq); S.done(cur); }
        if (!has_next) break;
#pragma unroll
        for (int a = 0; a < 2; ++a)
#pragma unroll
            for (int b = 0; b < 2; ++b)
#pragma unroll
                for (int m = 0; m < 4; ++m)
#pragma unroll
                    for (int n = 0; n < 2; ++n) acc[a][b][m][n] = (f32x4){0.f, 0.f, 0.f, 0.f};
        cur = nxt; cA = nA; cB = nB; ++ui;
    }
    PG8_WAIT_V(0);
    if (wr == 0) PG8_BAR;
    PG8_BAR;
    if constexpr (Epi::AFTER_DRAIN) { E.fused(acc, cur, wr, wc, fr, fq, lds, wid, lane); S.done(cur); }
#undef PG8_SA
#undef PG8_SB
#undef PG8_STAGE
#undef PG8_LDA
#undef PG8_LDB
#undef PG8_MMA
#undef PG8_WAIT_V
#undef PG8_WAIT_L
#undef PG8_BAR
#undef PG8_SCHED
}
}

template <class F> struct EpiAd {
    static constexpr bool PERM = true, AFTER_DRAIN = false;
    F f; float* ssq;
    __device__ __forceinline__ void operator()(const pg8::f32x4 (&acc)[2][2][4][2], const pg8::Unit& u, int wr, int wc, int fr, int fq) const {
        constexpr int PD = F::PD;
        const int c = wc * 32 + 8 * fq, row0 = u.pm * 256 + wr * 64 + fr;
        typename F::Cols cols; f.load_cols(cols, u.pm, u.pn, c);
        typename F::Row rd[PD];
#pragma unroll
        for (int s = 0; s < PD; ++s) f.load_row(rd[s], row0 + (s >> 2) * 128 + (s & 3) * 16, u.pn, c);
#pragma unroll
        for (int s = 0; s < 8; ++s) { const int ai = s >> 2, m = s & 3, row = row0 + ai * 128 + m * 16;
            float v0[8], v1[8];
#pragma unroll
            for (int n = 0; n < 2; ++n)
#pragma unroll
                for (int e = 0; e < 4; ++e) { v0[4 * n + e] = acc[ai][0][m][n][e]; v1[4 * n + e] = acc[ai][1][m][n][e]; }
            float sq = f.finish(row, u.pn, c, v0, v1, cols, rd[s % PD]);
            if (ssq) { sq += __shfl_xor(sq, 16); sq += __shfl_xor(sq, 32); if (fq == 0) ssq[(size_t)row * 16 + u.pn * 4 + wc] = sq; }
            if (s + PD < 8) f.load_row(rd[s % PD], row0 + ((s + PD) >> 2) * 128 + ((s + PD) & 3) * 16, u.pn, c); }
    }
};
struct TwoPartOrder {
    pg8::StaticOrder s1; int n1, nM1, nM2, n2, G, c;
    __device__ void init(int nM1_, int nN1, int nM2_, int nN2, int G_, int c_) { s1.init(nM1_ * 256, nN1 * 256, G_, c_); n1 = nM1_ * nN1; nM1 = nM1_; nM2 = nM2_; n2 = nM2_ * nN2; G = G_; c = c_; }
    __device__ bool next(int i, pg8::Unit& u) const { long L = (long)i * G + c; if (L < n1) return s1.next(i, u); L -= n1; if (L >= n2) return false; u.pm = nM1 + (int)(L % nM2); u.pn = (int)(L / nM2); return true; }
    __device__ __forceinline__ void a_ready(const pg8::Unit&) const {}
    __device__ __forceinline__ void done(const pg8::Unit&) const {}
};
template <class F>
__device__ __forceinline__ void gemm_mfma(LAS unsigned char* lds, int vc, const bf16_t* A, const bf16_t* Bt, int K, int nrows1, int npn1, int nrows2, int npn2, const F& f, float* ssq) {
    __syncthreads();
    pg8::Gemm g{A, Bt, nrows1 + nrows2, npn1 * 256, K}; TwoPartOrder S; S.init(nrows1 / 256, npn1, nrows2 / 256, npn2, (int)gridDim.x, vc);
    EpiAd<F> E{f, ssq};
    pg8::gemm_phase(lds, g, S, E);
    __syncthreads();
}

struct Ctx { LAS unsigned char* lds; int tid, lane, wid, gw, ngw, vc; };

struct VGrid { int vb, nvb; };
__device__ __forceinline__ void task_transposes_a(const Params& p, const Ctx& c, VGrid g) {
    LAS float* scr = (LAS float*)(c.lds + c.wid * 8448); const int gw = g.vb * NWAVES + c.wid, ngw = g.nvb * NWAVES;
    transpose_gu(p.ffn_wg, 0, (bf16_t*)(p.ws + WS_WG1_T), scr, gw, ngw, c.lane);
    transpose_gu(p.ffn_wu, 1, (bf16_t*)(p.ws + WS_WG1_T), scr, gw, ngw, c.lane);
}
__device__ __forceinline__ void task_transposes_b(const Params& p, const Ctx& c, VGrid g) {
    LAS float* scr = (LAS float*)(c.lds + c.wid * 8448); const int gw = g.vb * NWAVES + c.wid, ngw = g.nvb * NWAVES;
    transpose_matrix(p.ffn_wd, DFF, D, (bf16_t*)(p.ws + WS_WD1_T), scr, gw, ngw, c.lane);
    transpose_matrix(p.w_in, D, NIN, (bf16_t*)(p.ws + WS_WIN_T), scr, gw, ngw, c.lane);
}
__device__ __forceinline__ void task_transposes_c(const Params& p, const Ctx& c, VGrid g) {
    LAS float* scr = (LAS float*)(c.lds + c.wid * 8448); const int gw = g.vb * NWAVES + c.wid, ngw = g.nvb * NWAVES;
    transpose_matrix(p.w_pa, 512, D, (bf16_t*)(p.ws + WS_WPA_T), scr, gw, ngw, c.lane);
    transpose_matrix(p.w_pb, 512, D, (bf16_t*)(p.ws + WS_WPB_T), scr, gw, ngw, c.lane);
    transpose_matrix(p.w_out, D, D, (bf16_t*)(p.ws + WS_WOUT_T), scr, gw, ngw, c.lane);
}
__device__ __forceinline__ void task_modv(const Params& p, const Ctx& c, VGrid g) {
    if (g.vb < MODW / 64) {
        LAS float* xs = (LAS float*)c.lds; LAS float* part = (LAS float*)(c.lds + 17 * 1024 * 4);
        __syncthreads();
        for (int i = c.tid; i < 17 * 1024; i += NTHR) { const int r = i >> 10, k = i & 1023; const float v = r < 16 ? p.c[r * D + k] : p.c_ctx[k]; xs[i] = v / (1.0f + expf(-v)); }
        __syncthreads();
        gemv17<false>(xs, part, p.mod_w, MODW, p.mod_b, (float*)(p.ws + WS_MODV), MODW, 0, g.vb, g.nvb);
    }
}
__device__ __forceinline__ void task_tables(const Params& p, const Ctx& c, VGrid g) {
    float* er = (float*)(p.ws + WS_ER); float* ec = (float*)(p.ws + WS_EC); float* lbv = (float*)(p.ws + WS_LBV);
    const int gt = g.vb * NTHR + c.tid, ngt = g.nvb * NTHR;
    for (int i = gt; i < 96 * 512; i += ngt) { const int r = i >> 9, j = i & 511, jj = j & 255; const float omega = 1.0f / powf(10000.0f, (float)jj / 256.0f);
        const int pos = r < 32 ? r : r - 32; const float a = (float)pos * omega; const float v = j < 256 ? sinf(a) : cosf(a);
        if (r < 32) er[r * 512 + j] = v; else ec[(r - 32) * 512 + j] = v; }
    for (int i = gt; i < 1024; i += ngt) { const float l0 = p.lb_logits[i], l1 = p.lb_logits[1024 + i]; lbv[i] = 1.0f / (1.0f + expf(l1 - l0)); }
}
__device__ __forceinline__ void task_h2(const Params& p, const Ctx& c, VGrid g) {
    LAS float* zf = (LAS float*)c.lds; LAS float* h1 = zf + 8 * 40; float* h2o = (float*)(p.ws + WS_H2);
    for (int it = g.vb; it < SEQ / 8; it += g.nvb) {
        __syncthreads();
        if (c.tid < 8 * 33) { const int r = c.tid / 33, f = c.tid % 33; const int pp = it * 8 + r; float v;
            if (f == 0) v = (float)pp / (float)(SEQ - 1);
            else { const int i = (f - 1) & 15; const float w = 6.283185307179586f * (float)pp / (float)SEQ; const float fr = 1e-4f + (float)i * ((15.0f - 1e-4f) / 15.0f); const float ang = w * fr; v = f <= 16 ? cosf(ang) : -sinf(ang); }
            zf[r * 40 + f] = v; }
        __syncthreads();
        { const int r = c.tid >> 6, j = c.tid & 63; float s = p.hb1[j];
          for (int f = 0; f < 33; ++f) s += zf[r * 40 + f] * p.hw1[f * 64 + j];
          h1[r * 64 + j] = sinf(p.hfr1[j] * s); }
        __syncthreads();
        { const int r = c.tid >> 6, j = c.tid & 63; float s = p.hb2[j];
          for (int k = 0; k < 64; ++k) s += h1[r * 64 + k] * p.hw2[k * 64 + j];
          h2o[(size_t)(it * 8 + r) * 64 + j] = sinf(p.hfr2[j] * s); }
    }
}
__device__ __forceinline__ void task_shift_gemv(const Params& p, const Ctx& c, VGrid g, int which) {
    const float* modv = (const float*)(p.ws + WS_MODV);
    LAS float* xs = (LAS float*)c.lds; LAS float* part = (LAS float*)(c.lds + 17 * 1024 * 4);
    const int nb_in = NIN / 64, nb_g = DFF / 64, nblk = which == 0 ? nb_in : 2 * nb_g;
    if (g.vb >= nblk) return;
    __syncthreads();
    for (int i = c.tid; i < 17 * 1024; i += NTHR) xs[i] = modv[(size_t)(i >> 10) * MODW + (which == 0 ? 3 : 6) * D + (i & 1023)];
    __syncthreads();
    for (int bx = g.vb; bx < nblk; bx += g.nvb) {
        if (which == 0) gemv17<false>(xs, part, p.w_in, NIN, nullptr, (float*)(p.ws + WS_SWIN), NIN, 0, bx, nb_in);
        else { const int half = bx / nb_g, blk = bx % nb_g; const float* W = (half ? p.ffn_wu : p.ffn_wg) + (size_t)D * DFF;
            gemv17<true>(xs, part, W, DFF, nullptr, (float*)(p.ws + WS_SW2), NGU, half, blk, nb_g); }
    }
}
__device__ __forceinline__ void task_filters(const Params& p, const Ctx& c, VGrid g, int item0, int item1) {
    LAS float* w3s = (LAS float*)c.lds;
    LAS float* hk = w3s + 512;
    LAS float* red = hk + 2048 * 8;
    const float* h2 = (const float*)(p.ws + WS_H2); bf16_t* krev = (bf16_t*)(p.ws + WS_KREV);
    for (int it = item0 + g.vb; it < item1; it += g.nvb) {
        const int c0 = 2 * it;
        __syncthreads();
        { const int k = c.tid >> 3, q = c.tid & 7; w3s[c.tid] = p.hw3[(size_t)k * 2048 + (q >> 2) * 1024 + ((q >> 1) & 1) * 512 + c0 + (q & 1)]; }
        __syncthreads();
        float l1 = 0.f;
        for (int idx = c.tid; idx < 2048 * 8; idx += NTHR) { const int t = idx >> 3, q = idx & 7; float s = 0.f;
            const float* hr = h2 + (size_t)t * 64;
#pragma unroll 8
            for (int k = 0; k < 64; ++k) s += hr[k] * w3s[k * 8 + q];
            const int ch = c0 + (q & 1); const float delta = fabsf(-3.0701134573253945f + (float)ch * ((-15.350567286626973f + 3.0701134573253945f) / 511.0f));
            const float tn = (float)t / (float)(SEQ - 1); s *= expf(-tn * delta) + 0.05f;
            hk[idx] = s; l1 += fabsf(s); }
        { float s = l1; s += __shfl_xor(s, 2); s += __shfl_xor(s, 8); s += __shfl_xor(s, 16); s += __shfl_xor(s, 32);
          if ((c.lane & ~5) == 0) red[c.wid * 4 + ((c.lane >> 2) & 1) * 2 + (c.lane & 1)] = s; }
        __syncthreads();
        for (int e = c.tid; e < 4 * KR_LEN; e += NTHR) { const int oc = e / KR_LEN, i = (e % KR_LEN) - KR_OFF, o = oc >> 1, cc = oc & 1;
            float tot = 0.f;
#pragma unroll
            for (int w = 0; w < 8; ++w) tot += red[w * 4 + oc];
            const int lag = -i; float v = 0.f;
            if (lag >= 0 && lag <= SEQ - 1) v = hk[lag * 8 + o * 4 + 0 + cc]; else if (lag < 0 && lag >= -(SEQ - 1)) v = hk[(-lag - 1) * 8 + o * 4 + 2 + cc];
            krev[((size_t)o * 512 + c0 + cc) * KR_LEN + (e % KR_LEN)] = f2bf(v / (tot + 1e-6f)); }
    }
}
__device__ __forceinline__ void phase_prep(const Params& p, const Ctx& c) {
    const int G = (int)gridDim.x, nmod = MODW / 64;
    if (G >= nmod + 32) {
        if ((int)blockIdx.x < nmod) task_modv(p, c, VGrid{(int)blockIdx.x, nmod});
        else { const VGrid g{(int)blockIdx.x - nmod, G - nmod}; task_transposes_a(p, c, g); task_tables(p, c, g); task_h2(p, c, g); }
    } else { const VGrid g{(int)blockIdx.x, G}; task_transposes_a(p, c, g); task_modv(p, c, g); task_tables(p, c, g); task_h2(p, c, g); }
}
__device__ __forceinline__ void phase_n1(const Params& p, const Ctx& c) {
    unsigned char* ws = p.ws;
    const float* modv = (const float*)(ws + WS_MODV); const float* er = (const float*)(ws + WS_ER); const float* ec = (const float*)(ws + WS_EC);
    bf16_t* n1 = (bf16_t*)(ws + WS_N1);
    for (int row0 = 2 * c.gw; row0 < MT; row0 += 2 * c.ngw) {
        f32x4 v[2][4]; float s[2];
#pragma unroll
        for (int r = 0; r < 2; ++r) { const int row = row0 + r; const bool lat = row < T; const int t = row & (SEQ - 1);
            const float* src = lat ? p.x + (size_t)row * D : p.ctx + (size_t)(row - T) * D;
#pragma unroll
            for (int j = 0; j < 4; ++j) { const int col = 4 * c.lane + 256 * j; v[r][j] = *(const f32x4*)(src + col);
                if (lat) { const float* pe = col < 512 ? er + (t >> 6) * 512 + col : ec + (t & 63) * 512 + (col - 512); v[r][j] += *(const f32x4*)pe; } } }
#pragma unroll
        for (int r = 0; r < 2; ++r) { const int row = row0 + r; const bool lat = row < T; const int b = lat ? (row >> 11) : 16;
            float ss = 0.f;
#pragma unroll
            for (int j = 0; j < 4; ++j) ss += (v[r][j][0] * v[r][j][0] + v[r][j][1] * v[r][j][1]) + (v[r][j][2] * v[r][j][2] + v[r][j][3] * v[r][j][3]);
            s[r] = ss;
            const float rs = 1.0f / sqrtf(wave_sum(s[r]) * (1.0f / D) + RMS_EPS);
            if (lat) {
#pragma unroll
                for (int j = 0; j < 4; ++j) *(f32x4*)(p.out + (size_t)row * D + 4 * c.lane + 256 * j) = v[r][j]; }
#pragma unroll
            for (int j = 0; j < 4; ++j) { const int col = 4 * c.lane + 256 * j; const f32x4 sh = *(const f32x4*)(modv + (size_t)b * MODW + col), sc = *(const f32x4*)(modv + (size_t)b * MODW + D + col);
                const f32x4 o = v[r][j] * rs * (sc + 1.0f) + sh; u32x2 w; w.x = pk2(o[0], o[1]); w.y = pk2(o[2], o[3]); *(u32x2*)(n1 + (size_t)row * D + col) = w; } }
    }
}
__device__ __forceinline__ bool filler_grid(VGrid& g, int vc, int nunits) {
    const int G = (int)gridDim.x, rem = nunits % G;
    if (rem == 0) { g.vb = vc; g.nvb = G; return true; }
    if (vc < rem) return false;
    g.vb = vc - rem; g.nvb = G - rem; return true;
}

__device__ __forceinline__ void phase_hgrn_simple(const Params& p, const Ctx& c) {
    unsigned char* ws = p.ws;
    const bf16_t* vb = (const bf16_t*)(ws + WS_V); const bf16_t* qb = (const bf16_t*)(ws + WS_Q);
    LAS float* F = (LAS float*)c.lds; LAS float* Kk = F + 64 * 128; LAS float* Q = Kk + 64 * 128; LAS float* V = Q + 64 * 128;
    const int dg = c.tid & 3, e = c.tid >> 2;
    for (int it = blockIdx.x; it < NB * 4 * 2; it += gridDim.x) {
        const int dir = it & 1, h = (it >> 1) & 3, b = it >> 3;
        const f16_t* lf = (const f16_t*)(ws + (dir ? WS_LBW : WS_LFW)); bf16_t* outp = (bf16_t*)(ws + (dir ? WS_OBW : WS_OFW));
        float S[32];
#pragma unroll
        for (int i = 0; i < 32; ++i) S[i] = 0.f;
        for (int ci = 0; ci < 36; ++ci) {
            const bool lat = ci >= 4;
            __syncthreads();
            for (int idx = c.tid; idx < 64 * 128; idx += NTHR) { const int j = idx >> 7, d = idx & 127; const int pp = (lat ? ci - 4 : ci) * 64 + j;
                const int row = lat ? b * SEQ + (dir ? SEQ - 1 - pp : pp) : T + b * CL + (dir ? CL - 1 - pp : pp);
                const float f = __expf((float)lf[(size_t)row * 512 + h * 128 + d]);
                F[idx] = f; Kk[idx] = 1.0f - f; V[idx] = bf2f(vb[(size_t)row * 512 + h * 128 + d]); Q[idx] = lat ? bf2f(qb[(size_t)row * 512 + h * 128 + d]) : 0.f; }
            __syncthreads();
            for (int j = 0; j < 64; ++j) { const float ve = V[j * 128 + e]; float part = 0.f;
#pragma unroll
                for (int i = 0; i < 32; ++i) { const int d = dg * 32 + i; S[i] = F[j * 128 + d] * S[i] + Kk[j * 128 + d] * ve; part += S[i] * Q[j * 128 + d]; }
                part += __shfl_xor(part, 1); part += __shfl_xor(part, 2);
                if (lat && dg == 0) { const int pp = (ci - 4) * 64 + j; const int row = b * SEQ + (dir ? SEQ - 1 - pp : pp); outp[(size_t)row * 512 + h * 128 + e] = f2bf(part); } }
        }
    }
}


typedef short bf16x8 __attribute__((ext_vector_type(8)));
constexpr int QROW = 136, TROW = 72;
__device__ __forceinline__ int hg_pos(int x) { return (x & ~31) + ((x >> 2) & 3) * 8 + ((x >> 4) & 1) * 4 + (x & 3); }
__device__ __forceinline__ pg8::f32x4 mfma16(bf16x8 a, bf16x8 b, pg8::f32x4 c) { return __builtin_amdgcn_mfma_f32_16x16x32_bf16(a, b, c, 0, 0, 0); }
__device__ __forceinline__ void phase_hgrn_mfma(const Params& p, const Ctx& c) {
    unsigned char* ws = p.ws;
    const bf16_t* vb = (const bf16_t*)(ws + WS_V); const bf16_t* qb = (const bf16_t*)(ws + WS_Q);
    LAS bf16_t* Qt = (LAS bf16_t*)c.lds;
    LAS bf16_t* Kt = Qt + 64 * QROW;
    LAS bf16_t* KhT = Kt + 64 * QROW;
    LAS bf16_t* VT = KhT + 128 * TROW;
    LAS bf16_t* ST0 = VT + 64 * TROW;
    LAS bf16_t* ST1 = ST0 + 64 * QROW;
    LAS float* qt = (LAS float*)(ST1 + 64 * QROW);
    LAS float* El = qt + 8 * 128;
    const int wid = c.wid, lane = c.lane, fr = lane & 15, fq = lane >> 4, dp = lane, ti = wid & 3, eh = wid >> 2;
    for (int it = c.vc; it < 256; it += gridDim.x) {
        const int dvh = (it >> 3) & 1, idx = (it & 7) | ((it >> 4) << 3), dir = idx & 1, h = (idx >> 1) & 3, b = idx >> 3;
        const f16_t* lf = (const f16_t*)(ws + (dir ? WS_LBW : WS_LFW)); bf16_t* outp = (bf16_t*)(ws + (dir ? WS_OBW : WS_OFW));
        const int colq = h * 128 + 2 * dp, colv = h * 128 + dvh * 64 + (c.tid & 7) * 8, pv = c.tid >> 3;
        pg8::f32x4 S[4];
#pragma unroll
        for (int e = 0; e < 4; ++e) S[e] = (pg8::f32x4){0.f, 0.f, 0.f, 0.f};
#define HG_ROW(ci_, p_) (((ci_) >= 4) ? (b * SEQ + (dir ? SEQ - 1 - (((ci_) - 4) * 64 + (p_)) : (((ci_) - 4) * 64 + (p_)))) : (T + b * CL + (dir ? CL - 1 - ((ci_) * 64 + (p_)) : ((ci_) * 64 + (p_)))))
        unsigned lfr[2][8], qr[2][8]; u32x4 vr[2];
#pragma unroll
        for (int s2 = 0; s2 < 2; ++s2) {
#pragma unroll
            for (int i = 0; i < 8; ++i) { const int row = HG_ROW(s2, 8 * wid + i); lfr[s2][i] = *(const unsigned*)(lf + (size_t)row * 512 + colq); qr[s2][i] = 0u; }
            vr[s2] = *(const u32x4*)(vb + (size_t)HG_ROW(s2, pv) * 512 + colv); }
        __syncthreads();
        for (int ci2 = 0; ci2 < 36; ci2 += 2) {
#pragma unroll
          for (int par = 0; par < 2; ++par) {
            const int ci = ci2 + par;
            const bool lat = ci >= 4;
            float l0[8], l1[8], c0[8], c1[8]; float run0 = 0.f, run1 = 0.f;
#pragma unroll
            for (int i = 0; i < 8; ++i) { const __fp16 a0 = __builtin_bit_cast(__fp16, (unsigned short)(lfr[par][i] & 0xffffu)), a1 = __builtin_bit_cast(__fp16, (unsigned short)(lfr[par][i] >> 16));
                l0[i] = (float)a0; l1[i] = (float)a1; run0 += l0[i]; run1 += l1[i]; c0[i] = run0; c1[i] = run1; }
            qt[wid * 128 + 2 * dp] = run0; qt[wid * 128 + 2 * dp + 1] = run1;
            __syncthreads();
            float off0 = 0.f, off1 = 0.f, tot0 = 0.f, tot1 = 0.f;
#pragma unroll
            for (int w = 0; w < 8; ++w) { const float a0 = qt[w * 128 + 2 * dp], a1 = qt[w * 128 + 2 * dp + 1]; tot0 += a0; tot1 += a1; if (w < wid) { off0 += a0; off1 += a1; } }
            const float E0 = __expf(tot0), E1 = __expf(tot1);
            if (wid == 0) { El[2 * dp] = E0; El[2 * dp + 1] = E1; }
            const int qpos = hg_pos(2 * dp);
            float kh0[8], kh1[8];
#pragma unroll
            for (int i = 0; i < 8; ++i) { const int pp = 8 * wid + i; const float cu0 = off0 + c0[i], cu1 = off1 + c1[i];
                const float e0 = __expf(cu0), e1 = __expf(cu1), r0 = __expf(-cu0), r1 = __expf(-cu1);
                const float k0 = (1.0f - __expf(l0[i])) * r0, k1 = (1.0f - __expf(l1[i])) * r1;
                *(LAS unsigned*)(Kt + pp * QROW + qpos) = pk2(k0, k1);
                if (lat) { const float q0 = __uint_as_float(qr[par][i] << 16), q1 = __uint_as_float(qr[par][i] & 0xffff0000u); *(LAS unsigned*)(Qt + pp * QROW + qpos) = pk2(q0 * e0, q1 * e1); }
                kh0[i] = k0 * E0; kh1[i] = k1 * E1; }
            { const int base0 = 32 * (wid >> 2) + 16 * (wid & 1) + 4 * ((wid >> 1) & 1);
              u32x2 w; w.x = pk2(kh0[0], kh0[1]); w.y = pk2(kh0[2], kh0[3]); *(LAS u32x2*)(KhT + (2 * dp) * TROW + base0) = w;
              w.x = pk2(kh0[4], kh0[5]); w.y = pk2(kh0[6], kh0[7]); *(LAS u32x2*)(KhT + (2 * dp) * TROW + base0 + 8) = w;
              w.x = pk2(kh1[0], kh1[1]); w.y = pk2(kh1[2], kh1[3]); *(LAS u32x2*)(KhT + (2 * dp + 1) * TROW + base0) = w;
              w.x = pk2(kh1[4], kh1[5]); w.y = pk2(kh1[6], kh1[7]); *(LAS u32x2*)(KhT + (2 * dp + 1) * TROW + base0 + 8) = w; }
            { const int e8 = (c.tid & 7) * 8, sp = hg_pos(pv); const unsigned wv[4] = {vr[par].x, vr[par].y, vr[par].z, vr[par].w};
#pragma unroll
              for (int j = 0; j < 4; ++j) { VT[(e8 + 2 * j) * TROW + sp] = (bf16_t)(wv[j] & 0xffffu); VT[(e8 + 2 * j + 1) * TROW + sp] = (bf16_t)(wv[j] >> 16); } }
            if (ci + 2 < 36) { const bool nlat = ci + 2 >= 4;
#pragma unroll
                for (int i = 0; i < 8; ++i) { const int row = HG_ROW(ci + 2, 8 * wid + i); lfr[par][i] = *(const unsigned*)(lf + (size_t)row * 512 + colq); if (nlat) qr[par][i] = *(const unsigned*)(qb + (size_t)row * 512 + colq); }
                vr[par] = *(const u32x4*)(vb + (size_t)HG_ROW(ci + 2, pv) * 512 + colv); }
            __syncthreads();
            const LAS bf16_t* STr = (ci & 1) ? ST1 : ST0; LAS bf16_t* STw = (ci & 1) ? ST0 : ST1;
            bf16x8 VF[4][2];
#pragma unroll
            for (int ei = 0; ei < 4; ++ei)
#pragma unroll
                for (int a = 0; a < 2; ++a) VF[ei][a] = *(const LAS bf16x8*)(VT + (16 * ei + fr) * TROW + 32 * a + 8 * fq);
            if (lat) {
                bf16x8 QF[4];
#pragma unroll
                for (int k = 0; k < 4; ++k) QF[k] = *(const LAS bf16x8*)(Qt + (16 * ti + fr) * QROW + 32 * k + 8 * fq);
                pg8::f32x4 P[4];
#pragma unroll
                for (int si = 0; si < 4; ++si) { pg8::f32x4 acc = (pg8::f32x4){0.f, 0.f, 0.f, 0.f};
                    if (si <= ti) {
#pragma unroll
                        for (int k = 0; k < 4; ++k) acc = mfma16(*(const LAS bf16x8*)(Kt + (16 * si + fr) * QROW + 32 * k + 8 * fq), QF[k], acc);
                        if (si == ti) {
#pragma unroll
                            for (int r = 0; r < 4; ++r) acc[r] = (4 * fq + r <= fr) ? acc[r] : 0.f; } }
                    P[si] = acc; }
                bf16x8 PB[2];
#pragma unroll
                for (int a = 0; a < 2; ++a) { u32x4 w; w.x = pk2(P[2 * a][0], P[2 * a][1]); w.y = pk2(P[2 * a][2], P[2 * a][3]); w.z = pk2(P[2 * a + 1][0], P[2 * a + 1][1]); w.w = pk2(P[2 * a + 1][2], P[2 * a + 1][3]); PB[a] = __builtin_bit_cast(bf16x8, w); }
#pragma unroll
                for (int e2 = 0; e2 < 2; ++e2) { const int ei = 2 * eh + e2; pg8::f32x4 acc = (pg8::f32x4){0.f, 0.f, 0.f, 0.f};
#pragma unroll
                    for (int a = 0; a < 2; ++a) if (2 * a <= ti) acc = mfma16(*(const LAS bf16x8*)(VT + (16 * ei + fr) * TROW + 32 * a + 8 * fq), PB[a], acc);
#pragma unroll
                    for (int k = 0; k < 4; ++k) acc = mfma16(*(const LAS bf16x8*)(STr + (16 * ei + fr) * QROW + 32 * k + 8 * fq), QF[k], acc);
                    const int row = HG_ROW(ci, 16 * ti + fr);
                    u32x2 ow; ow.x = pk2(acc[0], acc[1]); ow.y = pk2(acc[2], acc[3]); *(u32x2*)(outp + (size_t)row * 512 + h * 128 + dvh * 64 + 16 * ei + 4 * fq) = ow; }
            }
            { const pg8::f32x4 dl = *(const LAS pg8::f32x4*)(El + 16 * wid + 4 * fq);
              bf16x8 KH[2];
#pragma unroll
              for (int a = 0; a < 2; ++a) KH[a] = *(const LAS bf16x8*)(KhT + (16 * wid + fr) * TROW + 32 * a + 8 * fq);
#pragma unroll
              for (int ei = 0; ei < 4; ++ei) { S[ei] = S[ei] * dl;
#pragma unroll
                  for (int a = 0; a < 2; ++a) S[ei] = mfma16(KH[a], VF[ei][a], S[ei]);
                  u32x2 w; w.x = pk2(S[ei][0], S[ei][1]); w.y = pk2(S[ei][2], S[ei][3]);
                  *(LAS u32x2*)(STw + (16 * ei + fr) * QROW + 32 * (wid >> 1) + 8 * fq + 4 * (wid & 1)) = w; } }
            __syncthreads();
          }
        }
#undef HG_ROW
    }
}

constexpr int ZROW = 2056;
__device__ __forceinline__ void phase_hy_prepass(const Params& p, const Ctx& c) {
    bf16_t* hy = (bf16_t*)(p.ws + WS_HY);
    LAS bf16_t* raw = (LAS bf16_t*)c.lds;
    if (c.tid < 4) { ((LAS unsigned*)raw)[c.tid] = 0u; ((LAS unsigned*)(raw + 2049 * 8))[c.tid] = 0u; }
    for (int blk = blockIdx.x; blk < (NHY / 8) * NB; blk += gridDim.x) {
        bf16_t* base = hy + (size_t)blk * SEQ * 8; const int cg = blk / NB;
        u32x4 ch4[4];
#pragma unroll
        for (int i = 0; i < 4; ++i) ch4[i] = *(const u32x4*)(base + (size_t)(4 * c.tid + i) * 8);
        __syncthreads();
#pragma unroll
        for (int i = 0; i < 4; ++i) *(LAS u32x4*)(raw + (size_t)(1 + 4 * c.tid + i) * 8) = ch4[i];
        __syncthreads();
        const int ch = cg * 8 + c.wid; const float w0 = p.conv_w[ch], w1 = p.conv_w[NHY + ch], w2 = p.conv_w[2 * NHY + ch], cb = p.conv_b[ch];
#pragma unroll 4
        for (int k = 0; k < 16; ++k) { const int t = 2 * c.lane + 128 * k;
            const float x0 = bf2f(raw[(t + 0) * 8 + c.wid]), x1 = bf2f(raw[(t + 1) * 8 + c.wid]), x2 = bf2f(raw[(t + 2) * 8 + c.wid]), x3 = bf2f(raw[(t + 3) * 8 + c.wid]);
            *(unsigned*)(base + (size_t)c.wid * SEQ + t) = pk2(cb + w0 * x0 + w1 * x1 + w2 * x2, cb + w0 * x1 + w1 * x2 + w2 * x3); }
    }
}
__device__ __forceinline__ void hy_fill2(LAS bf16_t* dst, const bf16_t* hy, int chx, int tid) {
#pragma unroll
    for (int i = 0; i < 8; ++i) { const int idx = tid + NTHR * i, b = idx >> 8, t8 = (idx & 255) * 8;
        *(LAS u32x4*)(dst + b * ZROW + t8) = *(const u32x4*)(hy + ((((size_t)(chx >> 3) * NB + b) * 8 + (chx & 7)) * SEQ) + t8); }
}
template <int KIND>
__device__ __forceinline__ void hy_block(pg8::f32x4 (&acc)[16], bf16x8 (&Bw)[16], const LAS bf16_t* zl, const LAS bf16_t* krl, int ub, int i0, int lane) {
    const int fr = lane & 15, fq = lane >> 4;
    const LAS bf16_t* bbase = zl + fr * ZROW + 8 * fq;
    const int abase = KR_OFF - 16 * i0 - fr + 8 * fq;
    const unsigned sh = (unsigned)(fr & 1) * 16u;
#pragma unroll
    for (int uu = 0; uu < 16; ++uu) {
        const int u = ub + uu;
        const bool ldb = KIND == 0 ? (uu >= 1) : (KIND == 1 ? true : (uu == 0));
        if (ldb) Bw[(uu + 15) & 15] = *(const LAS bf16x8*)(bbase + 32 * (u + 15));
        const LAS unsigned* ap = (const LAS unsigned*)(krl + ((abase + 32 * u) & ~1));
        const unsigned d0 = ap[0], d1 = ap[1], d2 = ap[2], d3 = ap[3], d4 = ap[4];
        u32x4 aw; aw.x = __builtin_amdgcn_alignbit(d1, d0, sh); aw.y = __builtin_amdgcn_alignbit(d2, d1, sh); aw.z = __builtin_amdgcn_alignbit(d3, d2, sh); aw.w = __builtin_amdgcn_alignbit(d4, d3, sh);
        const bf16x8 A = __builtin_bit_cast(bf16x8, aw);
#pragma unroll
        for (int m = 0; m < 16; ++m) { const bool on = KIND == 0 ? (m >= 16 - uu) : (KIND == 1 ? true : (m <= 15 - uu));
            if (on) acc[m] = __builtin_amdgcn_mfma_f32_16x16x32_bf16(A, Bw[(uu + m) & 15], acc[m], 0, 0, 0); }
    }
}
__device__ __forceinline__ void phase_hyena_mfma(const Params& p, const Ctx& c) {
    unsigned char* ws = p.ws;
    const bf16_t* hy = (const bf16_t*)(ws + WS_HY); const bf16_t* krev = (const bf16_t*)(ws + WS_KREV); bf16_t* zb = (bf16_t*)(ws + WS_ZB);
    LAS bf16_t* zl = (LAS bf16_t*)c.lds;
    LAS bf16_t* gl = zl + NB * ZROW;
    LAS bf16_t* krl = gl + NB * ZROW;
    const int i0 = 32 * (c.wid >> 1) + (c.wid & 1), fr = c.lane & 15, fq = c.lane >> 4;
    for (int ch = blockIdx.x; ch < BW; ch += gridDim.x) {
        __syncthreads();
        hy_fill2(zl, hy, ch, c.tid);
        for (int o = 0; o < 2; ++o) {
            hy_fill2(gl, hy, (o + 1) * 512 + ch, c.tid);
            for (int i = c.tid; i < KR_LEN / 8; i += NTHR) *(LAS u32x4*)(krl + 8 * i) = *(const u32x4*)(krev + ((size_t)o * 512 + ch) * KR_LEN + 8 * i);
            __syncthreads();
            pg8::f32x4 acc[16]; bf16x8 Bw[16];
#pragma unroll
            for (int m = 0; m < 16; ++m) { acc[m] = (pg8::f32x4){0.f, 0.f, 0.f, 0.f}; Bw[m] = (bf16x8){0, 0, 0, 0, 0, 0, 0, 0}; }
            hy_block<0>(acc, Bw, zl, krl, -16, i0, c.lane);
            for (int ub = 0; ub < 48; ub += 16) hy_block<1>(acc, Bw, zl, krl, ub, i0, c.lane);
            hy_block<2>(acc, Bw, zl, krl, 48, i0, c.lane);
            const float bias = p.hy_bias[o * 512 + ch];
            u32x2 res[16];
#pragma unroll
            for (int m = 0; m < 16; ++m) { const int t = 16 * (i0 + 2 * m) + 4 * fq; const u32x2 zo = *(const LAS u32x2*)(zl + fr * ZROW + t), gg = *(const LAS u32x2*)(gl + fr * ZROW + t);
                const float z0 = __uint_as_float(zo.x << 16), z1 = __uint_as_float(zo.x & 0xffff0000u), z2 = __uint_as_float(zo.y << 16), z3 = __uint_as_float(zo.y & 0xffff0000u);
                const float g0 = __uint_as_float(gg.x << 16), g1 = __uint_as_float(gg.x & 0xffff0000u), g2 = __uint_as_float(gg.y << 16), g3 = __uint_as_float(gg.y & 0xffff0000u);
                res[m].x = pk2(g0 * (acc[m][0] + bias * z0), g1 * (acc[m][1] + bias * z1)); res[m].y = pk2(g2 * (acc[m][2] + bias * z2), g3 * (acc[m][3] + bias * z3)); }
            __syncthreads();
#pragma unroll
            for (int m = 0; m < 16; ++m) { const int t = 16 * (i0 + 2 * m) + 4 * fq;
                if (o == 0) *(LAS u32x2*)(zl + fr * ZROW + t) = res[m]; else *(u32x2*)(zb + ((size_t)ch * NB + fr) * SEQ + t) = res[m]; }
        }
    }
}

__device__ __forceinline__ void phase_combine(const Params& p, const Ctx& c) {
    unsigned char* ws = p.ws;
    const bf16_t* ofw = (const bf16_t*)(ws + WS_OFW); const bf16_t* obw = (const bf16_t*)(ws + WS_OBW); const bf16_t* g = (const bf16_t*)(ws + WS_G);
    bf16_t* oa = (bf16_t*)(ws + WS_OA); bf16_t* ob = (bf16_t*)(ws + WS_OB); const bf16_t* zb = (const bf16_t*)(ws + WS_ZB);
    for (int row = c.gw; row < T; row += c.ngw) { const int col = 8 * c.lane; float a[8], bq[8], gg[8], w[8], o[8];
        load_bf16x8(ofw + (size_t)row * 512 + col, a); load_bf16x8(obw + (size_t)row * 512 + col, bq); load_bf16x8(g + (size_t)row * 512 + col, gg); load_f32x8(p.a_norm_w + (col & 127), w);
        float s = 0.f;
#pragma unroll
        for (int j = 0; j < 8; ++j) { a[j] += bq[j]; s += a[j] * a[j]; }
        s += __shfl_xor(s, 1); s += __shfl_xor(s, 2); s += __shfl_xor(s, 4); s += __shfl_xor(s, 8);
        const float rs = 1.0f / sqrtf(s * (1.0f / 128.0f) + RMS_EPS);
#pragma unroll
        for (int j = 0; j < 8; ++j) o[j] = a[j] * rs * w[j] * gg[j];
        store_bf16x8(oa + (size_t)row * 512 + col, o); }
    LAS bf16_t* tile = (LAS bf16_t*)c.lds;
    for (int it = blockIdx.x; it < NB * 32 * 8; it += gridDim.x) { const int cb = it & 7, tb = (it >> 3) & 31, b = it >> 8;
        __syncthreads();
        { const int cl = c.tid >> 3, t8 = (c.tid & 7) * 8; const u32x4 w = *(const u32x4*)(zb + ((size_t)(cb * 64 + cl) * NB + b) * SEQ + tb * 64 + t8); *(LAS u32x4*)(tile + cl * 72 + t8) = w; }
        __syncthreads();
        { const int tl = c.tid >> 3, c8 = (c.tid & 7) * 8; bf16_t v[8];
#pragma unroll
          for (int i = 0; i < 8; ++i) v[i] = tile[(c8 + i) * 72 + tl];
          u32x4 w; w.x = v[0] | ((unsigned)v[1] << 16); w.y = v[2] | ((unsigned)v[3] << 16); w.z = v[4] | ((unsigned)v[5] << 16); w.w = v[6] | ((unsigned)v[7] << 16);
          *(u32x4*)(ob + ((size_t)b * SEQ + tb * 64 + tl) * 512 + cb * 64 + c8) = w; }
    }
}

__device__ __forceinline__ void phase_rstd(const float* ssq, float* rstd, int nrows, const Ctx& c) {
    for (int row = blockIdx.x * NTHR + c.tid; row < nrows; row += gridDim.x * NTHR) rstd[row] = rstd_from_ssq(ssq + (size_t)row * 16);
}
__device__ __forceinline__ void phase_final(const Params& p, const Ctx& c) {
    const float* ssq = (const float*)(p.ws + WS_SSQ3);
    for (int row = c.gw; row < T; row += c.ngw) { const float rs = rstd_from_ssq(ssq + (size_t)row * 16);
#pragma unroll
        for (int j = 0; j < 4; ++j) { const int col = 4 * c.lane + 256 * j; f32x4* ptr = (f32x4*)(p.out + (size_t)row * D + col); *ptr = *ptr * rs * *(const f32x4*)(p.fnw + col); } }
}


#define XB_TMO      128
#define XB_XCNT(j)  (256  + 64 * (j))
#define XB_XSUB(j)  (1280 + 64 * (j))
#define XB_XGEN(j)  (2304 + 64 * (j))
#define XB_TOP      3328
#define XB_TOPGEN   3392
#define XCD_BAR_WORDS 3456
#define XB_SPIN_CAP (1u << 18)
__device__ __forceinline__ unsigned xb_ld(unsigned* p)              { return __hip_atomic_load(p, __ATOMIC_RELAXED, __HIP_MEMORY_SCOPE_AGENT); }
__device__ __forceinline__ unsigned xb_add(unsigned* p, unsigned v) { return __hip_atomic_fetch_add(p, v, __ATOMIC_RELAXED, __HIP_MEMORY_SCOPE_AGENT); }
__device__ __forceinline__ unsigned xb_xcc_id() { return (unsigned)__builtin_amdgcn_s_getreg((3 << 11) | 20) & 0xFu; }
#define XB_SPIN(cond, bar) do { unsigned _sp = 0; while (cond) { __builtin_amdgcn_s_sleep(1); \
    if ((++_sp & 255u) == 0u) { if (xb_ld(&(bar)[XB_TMO])) break; if (_sp > XB_SPIN_CAP) { atomicAdd(&(bar)[XB_TMO], 1u); break; } } } } while (0)
struct XcdBarrier { unsigned* bar; unsigned x; volatile LAS unsigned* st; };
__device__ __forceinline__ XcdBarrier xcd_barrier_post(unsigned* bar, volatile LAS unsigned* st) {
    XcdBarrier b; b.bar = bar; b.x = xb_xcc_id(); b.st = st;
    if (threadIdx.x == 0) st[2] = xb_add(&bar[XB_XCNT(b.x)], 1u);
    return b;
}
__device__ __forceinline__ void xcd_barrier_complete(unsigned* bar, unsigned x, unsigned& nloc, unsigned& nx) {
    const unsigned G = gridDim.x * gridDim.y * gridDim.z;
    unsigned sum, cnt, mine, sp = 0u;
    for (;;) {
        sum = 0u; cnt = 0u; mine = 0u;
#pragma unroll
        for (unsigned j = 0; j < 16; ++j) { const unsigned c = xb_ld(&bar[XB_XCNT(j)]); sum += c; cnt += (c > 0u) ? 1u : 0u; mine = (j == x) ? c : mine; }
        if (sum == G) break;
        __builtin_amdgcn_s_sleep(1);
        if ((++sp & 255u) == 0u) { if (xb_ld(&bar[XB_TMO])) break; if (sp > XB_SPIN_CAP) { atomicAdd(&bar[XB_TMO], 1u); break; } }
    }
    nloc = mine > 0u ? mine : 1u; nx = cnt > 0u ? cnt : 1u;
}
__device__ __forceinline__ void xcd_barrier(const XcdBarrier& b) {
    asm volatile("s_waitcnt vmcnt(0)" ::: "memory");
    __syncthreads();
    if (threadIdx.x == 0) {
        unsigned* bar = b.bar;
        __builtin_amdgcn_s_waitcnt(0);
        unsigned nloc = b.st[0], nx = b.st[1];
        if (nloc == 0u) { xcd_barrier_complete(bar, b.x, nloc, nx); b.st[0] = nloc; b.st[1] = nx; }
        const unsigned old = xb_add(&bar[XB_XSUB(b.x)], 1u);
        const unsigned gen = old / nloc;
        if (old + 1u == (gen + 1u) * nloc) {
            __builtin_amdgcn_fence(__ATOMIC_RELEASE, "agent");
            asm volatile("s_waitcnt vmcnt(0)" ::: "memory");
            const unsigned og = xb_add(&bar[XB_TOP], 1u);
            const unsigned tg = og / nx;
            if (og + 1u == (tg + 1u) * nx) xb_add(&bar[XB_TOPGEN], 1u);
            else XB_SPIN(xb_ld(&bar[XB_TOPGEN]) == tg, bar);
            __builtin_amdgcn_fence(__ATOMIC_ACQUIRE, "agent");
            xb_add(&bar[XB_XGEN(b.x)], 1u);
            asm volatile("s_waitcnt vmcnt(0)" ::: "memory");
        } else {
            XB_SPIN(xb_ld(&bar[XB_XGEN(b.x)]) == gen, bar);
            __builtin_amdgcn_fence(__ATOMIC_ACQUIRE, "agent");
            asm volatile("s_waitcnt vmcnt(0)" ::: "memory");
        }
    }
    __syncthreads();
}

constexpr int N_PHASES = 16;
#ifndef REPEAT_MASK
#define REPEAT_MASK 0
#endif
#ifndef HOST_REPEAT_MASK
#define HOST_REPEAT_MASK 0
#endif
#ifndef USE_XCD_BARRIER
#define USE_XCD_BARRIER 1
#endif
__global__ void __launch_bounds__(NTHR, 2) fwd_kernel(Params p) {
    extern __shared__ __attribute__((aligned(16))) unsigned char lds_raw[];
    Ctx c; c.lds = (LAS unsigned char*)lds_raw; c.tid = threadIdx.x; c.lane = c.tid & 63; c.wid = __builtin_amdgcn_readfirstlane(c.tid >> 6);
    c.gw = blockIdx.x * NWAVES + c.wid; c.ngw = gridDim.x * NWAVES; c.vc = blockIdx.x;
    unsigned char* ws = p.ws;
    const float* modv = (const float*)(ws + WS_MODV);
#if N_LAUNCH_MODE == 1
    cg::grid_group grid = cg::this_grid();
#if USE_XCD_BARRIER
    volatile LAS unsigned* xst = (volatile LAS unsigned*)(c.lds + LDS_BYTES - 16);
    if (c.tid < 4) xst[c.tid] = 0u;
    __syncthreads();
    XcdBarrier xbar = xcd_barrier_post((unsigned*)(ws + WS_CTL), xst);
    bool first_seam = true;
#define SEAM() do { if (first_seam) { grid.sync(); first_seam = false; \
        if (c.tid == 0) { unsigned* bar_ = (unsigned*)(ws + WS_CTL); bool ok_ = (gridDim.x % 8u) == 0u; for (unsigned j_ = 0; j_ < 16; ++j_) { const unsigned n_ = xb_ld(&bar_[XB_XCNT(j_)]); ok_ = ok_ && (j_ < 8 ? n_ == gridDim.x / 8u : n_ == 0u); } \
            xst[3] = ok_ ? (xst[2] * 8u + xbar.x) : blockIdx.x; } \
        __syncthreads(); c.vc = (int)xst[3]; } else xcd_barrier(xbar); } while (0)
#else
#define SEAM() grid.sync()
#endif
#else
#define SEAM() do { } while (0)
#endif
#ifdef ONLY_PHASE
#define IN(k) ((k) == ONLY_PHASE && p.ph_lo <= (k) && (k) < p.ph_hi)
#else
#define IN(k) (p.ph_lo <= (k) && (k) < p.ph_hi)
#endif
#define PHASE(k, ...) if (IN(k)) { for (int rep_ = 0; rep_ <= ((REPEAT_MASK >> (k)) & 1); ++rep_) { __VA_ARGS__; if (rep_ < ((REPEAT_MASK >> (k)) & 1)) SEAM(); } if (IN((k) + 1)) SEAM(); }
#if USE_PG8
#define GEMM2(A_, Bt_, K_, nrows1_, npn1_, nrows2_, npn2_, E_, ssq_) gemm_mfma(c.lds, c.vc, A_, Bt_, K_, nrows1_, npn1_, nrows2_, npn2_, E_, ssq_)
#else
#define GEMM2(A_, Bt_, K_, nrows1_, npn1_, nrows2_, npn2_, E_, ssq_) do { gemm_simple(c.lds, A_, Bt_, K_, 0, nrows1_, npn1_, E_, ssq_); if ((nrows2_) > 0) gemm_simple(c.lds, A_, Bt_, K_, nrows1_, nrows2_, npn2_, E_, ssq_); } while (0)
#endif
#define GEMM(A_, Bt_, K_, nrows_, npn_, E_, ssq_) GEMM2(A_, Bt_, K_, nrows_, npn_, 0, 0, E_, ssq_)
    PHASE(0, phase_prep(p, c))
    PHASE(1, phase_n1(p, c))
    PHASE(2, { EpiGateUp1 E{(bf16_t*)(ws + WS_HID)};
        GEMM((const bf16_t*)(ws + WS_N1), (const bf16_t*)(ws + WS_WG1_T), D, MT, NGU / 256, E, nullptr);
        VGrid g; if (filler_grid(g, c.vc, (MT / 256) * (NGU / 256))) { task_transposes_b(p, c, g); task_shift_gemv(p, c, g, 0); } })
    PHASE(3, { EpiDown1 E{p.ctx, modv, p.out, (bf16_t*)(ws + WS_A2)};
        GEMM((const bf16_t*)(ws + WS_HID), (const bf16_t*)(ws + WS_WD1_T), DFF, MT, D / 256, E, (float*)(ws + WS_SSQ1));
        VGrid g; if (filler_grid(g, c.vc, (MT / 256) * (D / 256))) { task_transposes_c(p, c, g); task_shift_gemv(p, c, g, 1); task_filters(p, c, g, 0, 192); } })
    PHASE(4, phase_rstd((const float*)(ws + WS_SSQ1), (float*)(ws + WS_RSTD1), MT, c))
    PHASE(5, { EpiWin E{(const float*)(ws + WS_RSTD1), (const float*)(ws + WS_SWIN), (const float*)(ws + WS_LBV), (bf16_t*)(ws + WS_V), (bf16_t*)(ws + WS_Q), (bf16_t*)(ws + WS_G), (bf16_t*)(ws + WS_HY), (bf16_t*)(ws + WS_GAB), (f16_t*)(ws + WS_LFW), (f16_t*)(ws + WS_LBW)};
        GEMM2((const bf16_t*)(ws + WS_A2), (const bf16_t*)(ws + WS_WIN_T), D, T, NIN / 256, TC, 6, E, nullptr);
        VGrid g; if (filler_grid(g, c.vc, (T / 256) * (NIN / 256) + (TC / 256) * 6)) task_filters(p, c, g, 192, 256); })
    PHASE(6, {
        { LAS float* scr = (LAS float*)(c.lds + c.wid * 8448);
          transpose_gu(p.ffn_wg + (size_t)D * DFF, 0, (bf16_t*)(ws + WS_WG2_T), scr, c.gw, c.ngw, c.lane);
          transpose_gu(p.ffn_wu + (size_t)D * DFF, 1, (bf16_t*)(ws + WS_WG2_T), scr, c.gw, c.ngw, c.lane);
          transpose_matrix(p.ffn_wd + (size_t)DFF * D, DFF, D, (bf16_t*)(ws + WS_WD2_T), scr, c.gw, c.ngw, c.lane); }
        __syncthreads();
        phase_hy_prepass(p, c); })
    PHASE(7, phase_hyena_mfma(p, c))
    PHASE(8, { if (USE_MFMA_HGRN) phase_hgrn_mfma(p, c); else phase_hgrn_simple(p, c); })
    PHASE(9, phase_combine(p, c))
    PHASE(10, { EpiProjA EA{(const bf16_t*)(ws + WS_GAB), (bf16_t*)(ws + WS_YTMP)}; EpiProjB EB{(const bf16_t*)(ws + WS_GAB), (const bf16_t*)(ws + WS_YTMP), (bf16_t*)(ws + WS_Y)};
        GEMM((const bf16_t*)(ws + WS_OA), (const bf16_t*)(ws + WS_WPA_T), 512, T, D / 256, EA, nullptr);
        GEMM((const bf16_t*)(ws + WS_OB), (const bf16_t*)(ws + WS_WPB_T), 512, T, D / 256, EB, nullptr); })
    PHASE(11, { EpiWout E{modv, p.out, (bf16_t*)(ws + WS_A3)};
        GEMM((const bf16_t*)(ws + WS_Y), (const bf16_t*)(ws + WS_WOUT_T), D, T, D / 256, E, (float*)(ws + WS_SSQ2)); })
    PHASE(12, phase_rstd((const float*)(ws + WS_SSQ2), (float*)(ws + WS_RSTD2), T, c))
    PHASE(13, { EpiGateUp2 E{(bf16_t*)(ws + WS_HID2), (const float*)(ws + WS_RSTD2), (const float*)(ws + WS_SW2)};
        GEMM((const bf16_t*)(ws + WS_A3), (const bf16_t*)(ws + WS_WG2_T), D, T, NGU / 256, E, nullptr); })
    PHASE(14, { EpiDown2 E{modv, p.out};
        GEMM((const bf16_t*)(ws + WS_HID2), (const bf16_t*)(ws + WS_WD2_T), DFF, T, D / 256, E, (float*)(ws + WS_SSQ3)); })
    PHASE(15, phase_final(p, c))
}

extern "C" void kernel_launch(void* const* d_in, const int* in_sizes, int n_in, void* d_out, int out_size, void* d_ws, size_t ws_size, hipStream_t stream) {
    static int grid = 0;
    if (grid == 0) {
        if (n_in != 26 || in_sizes[0] != T * D || out_size != T * D || ws_size < WS_TOTAL) { fprintf(stderr, "kernel_launch: unexpected shapes (n_in %d, in0 %d, out %d, ws %zu < %zu)\n", n_in, n_in > 0 ? in_sizes[0] : -1, out_size, ws_size, (size_t)WS_TOTAL); grid = -1; return; }
        int dev = 0, cus = 0, per_cu = 0;
        (void)hipGetDevice(&dev); (void)hipDeviceGetAttribute(&cus, hipDeviceAttributeMultiprocessorCount, dev);
        if (hipFuncSetAttribute((const void*)fwd_kernel, hipFuncAttributeMaxDynamicSharedMemorySize, LDS_BYTES) != hipSuccess) { fprintf(stderr, "kernel_launch: hipFuncSetAttribute failed\n"); grid = -1; return; }
        (void)hipOccupancyMaxActiveBlocksPerMultiprocessor(&per_cu, (const void*)fwd_kernel, NTHR, LDS_BYTES);
        if (per_cu < 1) { fprintf(stderr, "kernel_launch: occupancy query says %d blocks per CU\n", per_cu); per_cu = 1; }
        (void)hipGetLastError();
        grid = cus;
    }
    if (grid < 0) return;
    Params p{};
    const float** f = (const float**)&p;
    for (int i = 0; i < 26; ++i) f[i] = (const float*)d_in[i];
    p.out = (float*)d_out; p.ws = (unsigned char*)d_ws;
#if N_LAUNCH_MODE == 1
    p.ph_lo = 0; p.ph_hi = N_PHASES;
#if USE_XCD_BARRIER
    (void)hipMemsetAsync((unsigned char*)d_ws + WS_CTL, 0, XCD_BAR_WORDS * 4, stream);
#endif
    void* args[] = {&p};
    hipError_t e = hipLaunchCooperativeKernel((const void*)fwd_kernel, dim3(grid), dim3(NTHR), args, LDS_BYTES, stream);
    if (e != hipSuccess) fprintf(stderr, "cooperative launch failed: %s (grid %d)\n", hipGetErrorString(e), grid);
#else
    for (int k = 0; k < N_PHASES; ++k) { p.ph_lo = k; p.ph_hi = k + 1; for (int r = 0; r <= ((HOST_REPEAT_MASK >> k) & 1); ++r) hipLaunchKernelGGL(fwd_kernel, dim3(grid), dim3(NTHR), LDS_BYTES, stream, p); }
#endif
}
```

```cpp
#include <hip/hip_runtime.h>
#include <hip/hip_cooperative_groups.h>
#include <cstdio>
namespace cg = cooperative_groups;

#ifndef N_LAUNCH_MODE
#define N_LAUNCH_MODE 1
#endif
#ifndef USE_MFMA_HYENA
#define USE_MFMA_HYENA 1
#endif
#ifndef USE_MFMA_HGRN
#define USE_MFMA_HGRN 1
#endif
#ifndef USE_PG8
#define USE_PG8 1
#endif

#define LAS __attribute__((address_space(3)))
typedef unsigned short bf16_t;
typedef _Float16 f16_t;
typedef float f32x4 __attribute__((ext_vector_type(4)));
typedef unsigned u32x4 __attribute__((ext_vector_type(4)));
typedef unsigned u32x2 __attribute__((ext_vector_type(2)));

constexpr int D = 1024, NB = 16, SEQ = 2048, T = NB * SEQ, CL = 256, TC = NB * CL, MT = T + TC;
constexpr int DFF = 2816, NGU = 2 * DFF, NIN = 6144, MODW = 9 * D;
constexpr int AKW = 512, AVW = 512, BW = 512, NHY = 3 * BW;
constexpr int KR_LEN = 4128, KR_OFF = 2056;
constexpr float RMS_EPS = 1e-6f;
constexpr int NTHR = 512, NWAVES = 8;
constexpr int LDS_BYTES = 152 * 1024;

constexpr size_t MiB = 1024 * 1024;
constexpr size_t al256(size_t x) { return (x + 255) & ~(size_t)255; }
constexpr size_t WS_CTL = 0;
constexpr size_t WS_MODV = WS_CTL + 65536;
constexpr size_t WS_SWIN = WS_MODV + al256((size_t)17 * MODW * 4);
constexpr size_t WS_SW2 = WS_SWIN + al256((size_t)17 * NIN * 4);
constexpr size_t WS_ER = WS_SW2 + al256((size_t)17 * NGU * 4);
constexpr size_t WS_EC = WS_ER + 32 * 512 * 4;
constexpr size_t WS_LBV = WS_EC + 64 * 512 * 4;
constexpr size_t WS_H2 = WS_LBV + 4096;
constexpr size_t WS_KREV = WS_H2 + 2048 * 64 * 4;
constexpr size_t WS_WIN_T = WS_KREV + al256((size_t)2 * 512 * KR_LEN * 2);
constexpr size_t WS_WPA_T = WS_WIN_T + (size_t)NIN * D * 2;
constexpr size_t WS_WPB_T = WS_WPA_T + (size_t)D * 512 * 2;
constexpr size_t WS_WOUT_T = WS_WPB_T + (size_t)D * 512 * 2;
constexpr size_t WS_RSTD1 = WS_WOUT_T + (size_t)D * D * 2;
constexpr size_t WS_RSTD2 = WS_RSTD1 + (size_t)MT * 4;
constexpr size_t WS_PERSIST_END = WS_RSTD2 + (size_t)T * 4;
constexpr size_t AR = 27 * MiB;
static_assert(WS_PERSIST_END <= AR, "persistent region");
constexpr size_t WS_HID = AR + 0 * MiB;
constexpr size_t WS_N1 = AR + 198 * MiB;
constexpr size_t WS_WG1_T = AR + 270 * MiB;
constexpr size_t WS_WD1_T = AR + 281 * MiB;
constexpr size_t WS_HCB = AR + 290 * MiB;
constexpr size_t WS_SSQ1 = AR + 410 * MiB;
constexpr size_t WS_A2 = AR + 413 * MiB;
constexpr size_t WS_GAB = AR + 0 * MiB;
constexpr size_t WS_V = AR + 128 * MiB;
constexpr size_t WS_LFW = AR + 164 * MiB;
constexpr size_t WS_LBW = AR + 200 * MiB;
constexpr size_t WS_Q = AR + 236 * MiB;
constexpr size_t WS_G = AR + 268 * MiB;
constexpr size_t WS_HY = AR + 300 * MiB;
constexpr size_t WS_WG2_T = AR + 436 * MiB;
constexpr size_t WS_WD2_T = AR + 447 * MiB;
constexpr size_t WS_ZB = AR + 453 * MiB;
constexpr size_t WS_OFW = AR + 300 * MiB;
constexpr size_t WS_OBW = AR + 364 * MiB;
constexpr size_t WS_OA = AR + 128 * MiB;
constexpr size_t WS_OB = AR + 160 * MiB;
constexpr size_t WS_YTMP = AR + 192 * MiB;
constexpr size_t WS_Y = AR + 320 * MiB;
constexpr size_t WS_A3 = AR + 0 * MiB;
constexpr size_t WS_SSQ2 = AR + 64 * MiB;
constexpr size_t WS_H3 = AR + 0 * MiB;
constexpr size_t WS_SSQ3 = AR + 66 * MiB;
constexpr size_t WS_HID2 = AR + 128 * MiB;
constexpr size_t WS_TOTAL = AR + 485 * MiB;

struct Params {
    const float *x, *c, *ctx, *c_ctx, *mod_w, *mod_b, *ffn_wg, *ffn_wu, *ffn_wd, *w_in, *lb_logits, *a_norm_w, *conv_w, *conv_b;
    const float *hw1, *hb1, *hfr1, *hw2, *hb2, *hfr2, *hw3, *hy_bias, *w_pa, *w_pb, *w_out, *fnw;
    float* out; unsigned char* ws;
    int ph_lo, ph_hi;
};

__device__ __forceinline__ float bf2f(bf16_t b) { return __uint_as_float(((unsigned)b) << 16); }
__device__ __forceinline__ bf16_t f2bf(float f) { unsigned u = __float_as_uint(f); u += 0x7FFFu + ((u >> 16) & 1u); return (bf16_t)(u >> 16); }
typedef float f32x2_t __attribute__((ext_vector_type(2)));
typedef __bf16 bf16x2_t __attribute__((ext_vector_type(2)));
__device__ __forceinline__ unsigned pk2(float lo, float hi) { const f32x2_t v = {lo, hi}; return __builtin_bit_cast(unsigned, __builtin_convertvector(v, bf16x2_t)); }
__device__ __forceinline__ float bfround(float f) { return bf2f(f2bf(f)); }
__device__ __forceinline__ float sigmoidf_(float x) { return __builtin_amdgcn_rcpf(1.0f + __builtin_amdgcn_exp2f(x * -1.4426950408889634f)); }
__device__ __forceinline__ float siluf_(float x) { return x * sigmoidf_(x); }
__device__ __forceinline__ float wave_sum(float v) {
#pragma unroll
    for (int o = 1; o < 64; o <<= 1) v += __shfl_xor(v, o);
    return v;
}
__device__ __forceinline__ float pos_embed(const float* er, const float* ec, int t, int col) {
    return col < 512 ? er[(t >> 6) * 512 + col] : ec[(t & 63) * 512 + (col - 512)];
}
__device__ __forceinline__ float rstd_from_ssq(const float* ssq16) {
    const f32x4* s = (const f32x4*)ssq16; float tot = 0.f;
#pragma unroll
    for (int i = 0; i < 4; ++i) { const f32x4 v = s[i]; tot += (v[0] + v[1]) + (v[2] + v[3]); }
    return __builtin_amdgcn_rsqf(tot * (1.0f / D) + RMS_EPS);
}

__device__ __forceinline__ void transpose_item(const float* W, int K, int N, bf16_t* WT, int k0, int n0, int dst_row0, LAS float* scr, int lane) {
#pragma unroll 8
    for (int i = 0; i < 32; ++i) { const int kk = 2 * i + (lane >> 5); scr[kk * 33 + (lane & 31)] = W[(size_t)(k0 + kk) * N + n0 + (lane & 31)]; }
    asm volatile("s_waitcnt lgkmcnt(0)" ::: "memory");
    const int c = lane & 7;
#pragma unroll
    for (int j = 0; j < 4; ++j) { const int n = (lane >> 3) + 8 * j; const LAS float* s = scr + (8 * c) * 33 + n;
        u32x4 o; o.x = pk2(s[0 * 33], s[1 * 33]); o.y = pk2(s[2 * 33], s[3 * 33]); o.z = pk2(s[4 * 33], s[5 * 33]); o.w = pk2(s[6 * 33], s[7 * 33]);
        *(u32x4*)(WT + (size_t)(dst_row0 + n) * K + k0 + 8 * c) = o; }
    asm volatile("s_waitcnt lgkmcnt(0)" ::: "memory");
}
__device__ __forceinline__ void transpose_matrix(const float* W, int K, int N, bf16_t* WT, LAS float* scr, int gw, int ngw, int lane) {
    const int nblk = N / 32, items = (K / 64) * nblk;
    for (int it = gw; it < items; it += ngw) { const int kb = it / nblk, nb = it % nblk; transpose_item(W, K, N, WT, 64 * kb, 32 * nb, 32 * nb, scr, lane); }
}
__device__ __forceinline__ void transpose_gu(const float* W, int half, bf16_t* WT, LAS float* scr, int gw, int ngw, int lane) {
    const int nblk = DFF / 32, items = (D / 64) * nblk;
    for (int it = gw; it < items; it += ngw) { const int kb = it / nblk, nb = it % nblk, n0 = 32 * nb;
        transpose_item(W, D, DFF, WT, 64 * kb, n0, 256 * (n0 >> 7) + 128 * half + (n0 & 127), scr, lane); }
}

template <bool GU>
__device__ __forceinline__ void gemv17(const LAS float* xs, LAS float* part, const float* W, int N, const float* bias, float* out, int ldo, int half, int blk0, int nblk_stride) {
    const int tid = threadIdx.x, wid = tid >> 6, lane = tid & 63;
    for (int cb = blk0; cb < N / 64; cb += nblk_stride) {
        const int n = cb * 64 + lane;
        float acc[17];
#pragma unroll
        for (int r = 0; r < 17; ++r) acc[r] = 0.f;
        const float* wp = W + (size_t)(wid * 128) * N + n;
#pragma unroll 4
        for (int k = 0; k < 128; ++k) { const float w = wp[(size_t)k * N];
#pragma unroll
            for (int r = 0; r < 17; ++r) acc[r] += xs[r * 1024 + wid * 128 + k] * w; }
#pragma unroll
        for (int r = 0; r < 17; ++r) part[(wid * 17 + r) * 64 + lane] = acc[r];
        __syncthreads();
        for (int o = tid; o < 17 * 64; o += NTHR) { const int r = o >> 6, l = o & 63; float s = 0.f;
#pragma unroll
            for (int w = 0; w < 8; ++w) s += part[(w * 17 + r) * 64 + l];
            const int nn = cb * 64 + l; if (bias) s += bias[nn];
            const int on = GU ? (256 * (nn >> 7) + 128 * half + (nn & 127)) : nn;
            out[(size_t)r * ldo + on] = s; }
        __syncthreads();
    }
}

__device__ __forceinline__ void store_bf16x8(bf16_t* p, const float (&v)[8]) { u32x4 w; w.x = pk2(v[0], v[1]); w.y = pk2(v[2], v[3]); w.z = pk2(v[4], v[5]); w.w = pk2(v[6], v[7]); *(u32x4*)p = w; }
__device__ __forceinline__ void load_f32x8(const float* p, float (&v)[8]) { const f32x4 a = *(const f32x4*)p, b = *(const f32x4*)(p + 4); v[0] = a[0]; v[1] = a[1]; v[2] = a[2]; v[3] = a[3]; v[4] = b[0]; v[5] = b[1]; v[6] = b[2]; v[7] = b[3]; }
__device__ __forceinline__ void store_f32x8(float* p, const float (&v)[8]) { *(f32x4*)p = (f32x4){v[0], v[1], v[2], v[3]}; *(f32x4*)(p + 4) = (f32x4){v[4], v[5], v[6], v[7]}; }
__device__ __forceinline__ void unpack_bf16x8(const u32x4 w, float (&v)[8]) { v[0] = __uint_as_float(w.x << 16); v[1] = __uint_as_float(w.x & 0xffff0000u); v[2] = __uint_as_float(w.y << 16); v[3] = __uint_as_float(w.y & 0xffff0000u);
    v[4] = __uint_as_float(w.z << 16); v[5] = __uint_as_float(w.z & 0xffff0000u); v[6] = __uint_as_float(w.w << 16); v[7] = __uint_as_float(w.w & 0xffff0000u); }
__device__ __forceinline__ void load_bf16x8(const bf16_t* p, float (&v)[8]) { const u32x4 w = *(const u32x4*)p; v[0] = __uint_as_float(w.x << 16); v[1] = __uint_as_float(w.x & 0xffff0000u); v[2] = __uint_as_float(w.y << 16); v[3] = __uint_as_float(w.y & 0xffff0000u);
    v[4] = __uint_as_float(w.z << 16); v[5] = __uint_as_float(w.z & 0xffff0000u); v[6] = __uint_as_float(w.w << 16); v[7] = __uint_as_float(w.w & 0xffff0000u); }

struct EpiGateUp1 {
    static constexpr int PD = 1;
    struct Cols {}; struct Row {};
    bf16_t* hid;
    __device__ __forceinline__ void load_cols(Cols&, int, int, int) const {}
    __device__ __forceinline__ void load_row(Row&, int, int, int) const {}
    __device__ __forceinline__ float finish(int row, int pn, int c, const float (&v0)[8], const float (&v1)[8], const Cols&, const Row&) const {
        float o[8];
#pragma unroll
        for (int j = 0; j < 8; ++j) o[j] = siluf_(v0[j]) * v1[j];
        store_bf16x8(hid + (size_t)row * DFF + 128 * pn + c, o); return 0.f; }
};
struct EpiGateUp2 {
    static constexpr int PD = 8;
    struct Cols { float s0[8], s1[8]; }; struct Row { float rs; };
    bf16_t* hid; const float* rstd; const float* sw;
    __device__ __forceinline__ void load_cols(Cols& k, int pm, int pn, int c) const { const int b = pm >> 3; load_f32x8(sw + (size_t)b * NGU + 256 * pn + c, k.s0); load_f32x8(sw + (size_t)b * NGU + 256 * pn + 128 + c, k.s1); }
    __device__ __forceinline__ void load_row(Row& r, int row, int, int) const { r.rs = rstd[row]; }
    __device__ __forceinline__ float finish(int row, int pn, int c, const float (&v0)[8], const float (&v1)[8], const Cols& k, const Row& r) const {
        float o[8];
#pragma unroll
        for (int j = 0; j < 8; ++j) o[j] = siluf_(r.rs * v0[j] + k.s0[j]) * (r.rs * v1[j] + k.s1[j]);
        store_bf16x8(hid + (size_t)row * DFF + 128 * pn + c, o); return 0.f; }
};
struct EpiDown1 {
    static constexpr int PD = 4;
    struct Cols { float g0[8], g1[8], s0[8], s1[8]; }; struct Row { u32x4 b0, b1; };
    const bf16_t* hcb; const float* modv; bf16_t* hb; bf16_t* a2;
    __device__ __forceinline__ void load_cols(Cols& k, int pm, int pn, int c) const { const int b = pm < T / 256 ? (pm >> 3) : 16; const float* m = modv + (size_t)b * MODW + 256 * pn + c;
        load_f32x8(m + 2 * D, k.g0); load_f32x8(m + 2 * D + 128, k.g1); load_f32x8(m + 4 * D, k.s0); load_f32x8(m + 4 * D + 128, k.s1); }
    __device__ __forceinline__ void load_row(Row& r, int row, int pn, int c) const { const bf16_t* src = (row < T ? hb + (size_t)row * D : hcb + (size_t)(row - T) * D) + 256 * pn + c; r.b0 = *(const u32x4*)src; r.b1 = *(const u32x4*)(src + 128); }
    __device__ __forceinline__ float finish(int row, int pn, int c, const float (&v0)[8], const float (&v1)[8], const Cols& k, const Row& r) const {
        float b0[8], b1[8], h0[8], h1[8], a0[8], a1[8]; float s = 0.f; unpack_bf16x8(r.b0, b0); unpack_bf16x8(r.b1, b1);
#pragma unroll
        for (int j = 0; j < 8; ++j) { h0[j] = b0[j] + 0.5f * k.g0[j] * v0[j]; h1[j] = b1[j] + 0.5f * k.g1[j] * v1[j]; s += h0[j] * h0[j] + h1[j] * h1[j]; a0[j] = h0[j] * (1.0f + k.s0[j]); a1[j] = h1[j] * (1.0f + k.s1[j]); }
        const size_t o = (size_t)row * D + 256 * pn + c;
        if (row < T) { store_bf16x8(hb + o, h0); store_bf16x8(hb + o + 128, h1); }
        store_bf16x8(a2 + o, a0); store_bf16x8(a2 + o + 128, a1); return s; }
};
struct EpiWin {
    static constexpr int PD = 8;
    struct Cols { float s0[8], s1[8], l0[8], l1[8]; }; struct Row { float rs; };
    const float *rstd, *sw, *lbv; bf16_t *v, *q, *g, *hy, *gab; f16_t *lfw, *lbw;
    __device__ __forceinline__ void load_cols(Cols& k, int pm, int pn, int c) const { const int b = pm < T / 256 ? (pm >> 3) : 16; const int n = 256 * pn + c;
        load_f32x8(sw + (size_t)b * NIN + n, k.s0); load_f32x8(sw + (size_t)b * NIN + n + 128, k.s1);
        if (pn >= 2 && pn < 6) { load_f32x8(lbv + n - 512, k.l0); load_f32x8(lbv + n - 512 + 128, k.l1); } }
    __device__ __forceinline__ void load_row(Row& r, int row, int, int) const { r.rs = rstd[row]; }
    __device__ __forceinline__ void half_(int row, int n, float rs, const float (&a)[8], const float (&s)[8], const float (&lb)[8]) const {
        float p[8];
#pragma unroll
        for (int j = 0; j < 8; ++j) p[j] = rs * a[j] + s[j];
        const int grp = n >> 9;
        if (grp == 0) { store_bf16x8(v + (size_t)row * 512 + n, p); }
        else if (grp <= 2) { const int nn = n - 512 * grp; f16_t* dst = (grp == 1 ? lfw : lbw) + (size_t)row * 512 + nn; f16_t o[8];
#pragma unroll
            for (int j = 0; j < 8; ++j) { const float f = lb[j] + (1.0f - lb[j]) * sigmoidf_(p[j]); o[j] = (f16_t)(__builtin_amdgcn_logf(f) * 0.6931471805599453f); }
            *(u32x4*)dst = *(const u32x4*)o; }
        else if (grp == 3) {
#pragma unroll
            for (int j = 0; j < 8; ++j) p[j] = siluf_(p[j]);
            store_bf16x8(q + (size_t)row * 512 + (n - 1536), p); }
        else if (grp == 4) {
#pragma unroll
            for (int j = 0; j < 8; ++j) p[j] = siluf_(p[j]);
            store_bf16x8(g + (size_t)row * 512 + (n - 2048), p); }
        else if (grp <= 7) { const int ch = n - 2560, t = row & (SEQ - 1), b = row >> 11; store_bf16x8(hy + (((size_t)(ch >> 3) * NB + b) * SEQ + t) * 8, p); }
        else {
#pragma unroll
            for (int j = 0; j < 8; ++j) p[j] = sigmoidf_(p[j]);
            store_bf16x8(gab + (size_t)row * 2048 + (n - 4096), p); }
    }
    __device__ __forceinline__ float finish(int row, int pn, int c, const float (&v0)[8], const float (&v1)[8], const Cols& k, const Row& r) const {
        half_(row, 256 * pn + c, r.rs, v0, k.s0, k.l0); half_(row, 256 * pn + 128 + c, r.rs, v1, k.s1, k.l1); return 0.f; }
};
struct EpiProjA {
    static constexpr int PD = 4;
    struct Cols {}; struct Row { u32x4 g0, g1; };
    const bf16_t* gab; bf16_t* ytmp;
    __device__ __forceinline__ void load_cols(Cols&, int, int, int) const {}
    __device__ __forceinline__ void load_row(Row& r, int row, int pn, int c) const { const bf16_t* src = gab + (size_t)row * 2048 + 256 * pn + c; r.g0 = *(const u32x4*)src; r.g1 = *(const u32x4*)(src + 128); }
    __device__ __forceinline__ float finish(int row, int pn, int c, const float (&v0)[8], const float (&v1)[8], const Cols&, const Row& r) const {
        float g0[8], g1[8], o0[8], o1[8]; unpack_bf16x8(r.g0, g0); unpack_bf16x8(r.g1, g1);
#pragma unroll
        for (int j = 0; j < 8; ++j) { o0[j] = g0[j] * v0[j]; o1[j] = g1[j] * v1[j]; }
        bf16_t* dst = ytmp + (size_t)row * D + 256 * pn + c; store_bf16x8(dst, o0); store_bf16x8(dst + 128, o1); return 0.f; }
};
struct EpiProjB {
    static constexpr int PD = 4;
    struct Cols {}; struct Row { u32x4 g0, g1, y0, y1; };
    const bf16_t* gab; const bf16_t* ytmp; bf16_t* y;
    __device__ __forceinline__ void load_cols(Cols&, int, int, int) const {}
    __device__ __forceinline__ void load_row(Row& r, int row, int pn, int c) const { const bf16_t* src = gab + (size_t)row * 2048 + 1024 + 256 * pn + c; r.g0 = *(const u32x4*)src; r.g1 = *(const u32x4*)(src + 128);
        const bf16_t* ys = ytmp + (size_t)row * D + 256 * pn + c; r.y0 = *(const u32x4*)ys; r.y1 = *(const u32x4*)(ys + 128); }
    __device__ __forceinline__ float finish(int row, int pn, int c, const float (&v0)[8], const float (&v1)[8], const Cols&, const Row& r) const {
        float g0[8], g1[8], y0[8], y1[8], o0[8], o1[8]; unpack_bf16x8(r.g0, g0); unpack_bf16x8(r.g1, g1); unpack_bf16x8(r.y0, y0); unpack_bf16x8(r.y1, y1);
#pragma unroll
        for (int j = 0; j < 8; ++j) { o0[j] = y0[j] + g0[j] * v0[j]; o1[j] = y1[j] + g1[j] * v1[j]; }
        bf16_t* dst = y + (size_t)row * D + 256 * pn + c; store_bf16x8(dst, o0); store_bf16x8(dst + 128, o1); return 0.f; }
};
struct EpiWout {
    static constexpr int PD = 4;
    struct Cols { float g0[8], g1[8], s0[8], s1[8]; }; struct Row { u32x4 b0, b1; };
    const float* modv; bf16_t* hb; bf16_t* a3;
    __device__ __forceinline__ void load_cols(Cols& k, int pm, int pn, int c) const { const float* m = modv + (size_t)(pm >> 3) * MODW + 256 * pn + c;
        load_f32x8(m + 5 * D, k.g0); load_f32x8(m + 5 * D + 128, k.g1); load_f32x8(m + 7 * D, k.s0); load_f32x8(m + 7 * D + 128, k.s1); }
    __device__ __forceinline__ void load_row(Row& r, int row, int pn, int c) const { const bf16_t* src = hb + (size_t)row * D + 256 * pn + c; r.b0 = *(const u32x4*)src; r.b1 = *(const u32x4*)(src + 128); }
    __device__ __forceinline__ float finish(int row, int pn, int c, const float (&v0)[8], const float (&v1)[8], const Cols& k, const Row& r) const {
        float b0[8], b1[8], h0[8], h1[8], a0[8], a1[8]; float s = 0.f; unpack_bf16x8(r.b0, b0); unpack_bf16x8(r.b1, b1);
#pragma unroll
        for (int j = 0; j < 8; ++j) { h0[j] = b0[j] + k.g0[j] * v0[j]; h1[j] = b1[j] + k.g1[j] * v1[j]; s += h0[j] * h0[j] + h1[j] * h1[j]; a0[j] = h0[j] * (1.0f + k.s0[j]); a1[j] = h1[j] * (1.0f + k.s1[j]); }
        const size_t o = (size_t)row * D + 256 * pn + c;
        store_bf16x8(hb + o, h0); store_bf16x8(hb + o + 128, h1); store_bf16x8(a3 + o, a0); store_bf16x8(a3 + o + 128, a1); return s; }
};
struct EpiDown2 {
    static constexpr int PD = 4;
    struct Cols { float g0[8], g1[8]; }; struct Row { u32x4 b0, b1; };
    const float* modv; const bf16_t* hb; bf16_t* h3;
    __device__ __forceinline__ void load_cols(Cols& k, int pm, int pn, int c) const { const float* m = modv + (size_t)(pm >> 3) * MODW + 8 * D + 256 * pn + c; load_f32x8(m, k.g0); load_f32x8(m + 128, k.g1); }
    __device__ __forceinline__ void load_row(Row& r, int row, int pn, int c) const { const bf16_t* src = hb + (size_t)row * D + 256 * pn + c; r.b0 = *(const u32x4*)src; r.b1 = *(const u32x4*)(src + 128); }
    __device__ __forceinline__ float finish(int row, int pn, int c, const float (&v0)[8], const float (&v1)[8], const Cols& k, const Row& r) const {
        float b0[8], b1[8], h0[8], h1[8]; float s = 0.f; unpack_bf16x8(r.b0, b0); unpack_bf16x8(r.b1, b1);
#pragma unroll
        for (int j = 0; j < 8; ++j) { h0[j] = b0[j] + 0.5f * k.g0[j] * v0[j]; h1[j] = b1[j] + 0.5f * k.g1[j] * v1[j]; s += h0[j] * h0[j] + h1[j] * h1[j]; }
        const size_t o = (size_t)row * D + 256 * pn + c; store_bf16x8(h3 + o, h0); store_bf16x8(h3 + o + 128, h1); return s; }
};

template <class Epi>
__device__ __forceinline__ void gemm_simple(LAS unsigned char* lds, const bf16_t* A, const bf16_t* Bt, int K, int row0, int nrows, int npn, const Epi& E, float* ssq) {
    LAS float* As = (LAS float*)lds;
    LAS float* Bs = (LAS float*)(lds + 8192);
    const int tid = threadIdx.x, c8 = tid & 15, rg = tid >> 4;
    const int nrt = nrows / 64, nunits = nrt * npn;
    for (int unit = blockIdx.x; unit < nunits; unit += gridDim.x) {
        const int rt = unit / npn, pn = unit % npn, r0 = row0 + rt * 64;
        float a0[2][8], a1[2][8];
#pragma unroll
        for (int r = 0; r < 2; ++r)
#pragma unroll
            for (int j = 0; j < 8; ++j) { a0[r][j] = 0.f; a1[r][j] = 0.f; }
        for (int k0 = 0; k0 < K; k0 += 32) {
            { const int row = tid >> 3, kq = tid & 7; const u32x2 w = *(const u32x2*)(A + (size_t)(r0 + row) * K + k0 + 4 * kq);
              As[(4 * kq + 0) * 64 + row] = __uint_as_float(w.x << 16); As[(4 * kq + 1) * 64 + row] = __uint_as_float(w.x & 0xffff0000u);
              As[(4 * kq + 2) * 64 + row] = __uint_as_float(w.y << 16); As[(4 * kq + 3) * 64 + row] = __uint_as_float(w.y & 0xffff0000u); }
            { const int n = tid >> 1, kh = tid & 1; const bf16_t* src = Bt + (size_t)(pn * 256 + n) * K + k0 + 16 * kh; float t8[8];
              load_bf16x8(src, t8);
#pragma unroll
              for (int i = 0; i < 8; ++i) Bs[(16 * kh + i) * 256 + n] = t8[i];
              load_bf16x8(src + 8, t8);
#pragma unroll
              for (int i = 0; i < 8; ++i) Bs[(16 * kh + 8 + i) * 256 + n] = t8[i]; }
            __syncthreads();
#pragma unroll 8
            for (int k = 0; k < 32; ++k) {
                const float x0 = As[k * 64 + 2 * rg], x1 = As[k * 64 + 2 * rg + 1];
                const f32x4 b00 = *(const LAS f32x4*)(Bs + k * 256 + 8 * c8), b01 = *(const LAS f32x4*)(Bs + k * 256 + 8 * c8 + 4);
                const f32x4 b10 = *(const LAS f32x4*)(Bs + k * 256 + 128 + 8 * c8), b11 = *(const LAS f32x4*)(Bs + k * 256 + 128 + 8 * c8 + 4);
#pragma unroll
                for (int j = 0; j < 4; ++j) { a0[0][j] += x0 * b00[j]; a0[0][4 + j] += x0 * b01[j]; a1[0][j] += x0 * b10[j]; a1[0][4 + j] += x0 * b11[j];
                                              a0[1][j] += x1 * b00[j]; a0[1][4 + j] += x1 * b01[j]; a1[1][j] += x1 * b10[j]; a1[1][4 + j] += x1 * b11[j]; }
            }
            __syncthreads();
        }
#pragma unroll
        for (int r = 0; r < 2; ++r) { const int row = r0 + 2 * rg + r; typename Epi::Cols kc; typename Epi::Row kr; E.load_cols(kc, row >> 8, pn, 8 * c8); E.load_row(kr, row, pn, 8 * c8); float s = E.finish(row, pn, 8 * c8, a0[r], a1[r], kc, kr);
            s += __shfl_xor(s, 1); s += __shfl_xor(s, 2); s += __shfl_xor(s, 4); s += __shfl_xor(s, 8);
            if (ssq && c8 == 0) *(f32x4*)(ssq + (size_t)row * 16 + pn * 4) = (f32x4){s, 0.f, 0.f, 0.f}; }
    }
}

namespace pg8 {
#define PG8_LAS __attribute__((address_space(3)))
typedef unsigned short bf16_t;
typedef short bf16x8 __attribute__((ext_vector_type(8)));
typedef float f32x4 __attribute__((ext_vector_type(4)));
typedef unsigned u32x4 __attribute__((ext_vector_type(4)));
constexpr int BM = 256, BK = 64, HALF = 128, HTB = HALF * BK * 2  , STAGE_BYTES = 8 * HTB, NXCD = 8, WGM = 8;

__host__ __device__ __forceinline__ int lds_byte(int r, int c) { const int st = (r >> 4) * 2 + (c >> 5), rr = r & 15, cc = c & 31, ob = rr * 64 + cc * 2; return st * 1024 + (ob ^ (((ob >> 9) & 1) << 5)); }
__host__ __device__ __forceinline__ void stage_rc(int b, int& R, int& C) { const int st = b / 1024, sb = b % 1024, swz = sb ^ (((sb >> 9) & 1) << 5); R = (st >> 1) * 16 + swz / 64; C = (st & 1) * 32 + (swz % 64) / 2; }
__host__ __device__ __forceinline__ int perm32(int rho) { const int n = rho >> 4, i = rho & 15; return 8 * (i >> 2) + 4 * n + (i & 3); }

struct Unit { int pm, pn; };
struct Gemm { const bf16_t* A; const bf16_t* Bt; int M, N, K; };

struct StaticOrder {
    int nM, nN, nwg, G, c;
    __host__ __device__ void init(int M, int N, int G_, int c_) { nM = M / BM; nN = N / BM; nwg = nM * nN; G = G_; c = c_; }
    __host__ __device__ bool next(int i, Unit& u) const {
        const long L = (long)i * G + c; if (L >= nwg) return false;
        int wgid = (int)L; { const int q = nwg / NXCD, r = nwg % NXCD, xcd = wgid % NXCD, off = wgid / NXCD; wgid = (xcd < r ? xcd * (q + 1) : r * (q + 1) + (xcd - r) * q) + off; }
        const int nig = WGM * nN, gid = wgid / nig, fm = gid * WGM, gsz = (nM - fm) < WGM ? (nM - fm) : WGM;
        u.pm = fm + ((wgid % nig) % gsz); u.pn = (wgid % nig) / gsz; return true;
    }
    __device__ __forceinline__ void a_ready(const Unit&) const {}
    __device__ __forceinline__ void done(const Unit&) const {}
};
template <class Epi, class Sched>
__device__ __forceinline__ void gemm_phase(PG8_LAS unsigned char* lds, const Gemm g, const Sched& S, const Epi& E) {
    const int tid = threadIdx.x, wid = __builtin_amdgcn_readfirstlane(tid >> 6), lane = tid & 63, wr = wid >> 2, wc = wid & 3, fr = lane & 15, fq = lane >> 4;
    const int K = g.K, nt = K / BK;
    unsigned voffA[2], voffB[2];
#pragma unroll
    for (int i = 0; i < 2; ++i) { int R, C; stage_rc(tid * 16 + i * 8192, R, C); const int Rb = Epi::PERM ? ((R & ~31) + perm32(R & 31)) : R;
        voffA[i] = (unsigned)(R * K + C) * 2u; voffB[i] = (unsigned)(Rb * K + C) * 2u; }
    const size_t kstep = (size_t)(BK * 2);
    const size_t hstep = (size_t)HALF * K * 2;
    const size_t tstep = 2 * hstep;
    const unsigned ldsw = (unsigned)wid * 1024u;
    const int aoff = lds_byte(wr * 64 + fr, fq * 8), boff = lds_byte(wc * 32 + fr, fq * 8);
#define PG8_SA(b, h) (((b) * 2 + (h)) * HTB)
#define PG8_SB(b, h) ((4 + (b) * 2 + (h)) * HTB)
#define PG8_STAGE(bufoff, gbase, voff) do { _Pragma("unroll") for (int _i = 0; _i < 2; ++_i) \
        __builtin_amdgcn_global_load_lds((const unsigned*)((const char*)(gbase) + (voff)[_i]), (PG8_LAS unsigned*)(lds + (bufoff) + ldsw + _i * 8192), 16, 0, 0); } while (0)
#define PG8_LDA(dst, b, h) do { _Pragma("unroll") for (int m = 0; m < 4; ++m) _Pragma("unroll") for (int k = 0; k < 2; ++k) dst[m][k] = *(const PG8_LAS bf16x8*)(lds + PG8_SA(b, h) + aoff + m * 2048 + k * 1024); } while (0)
#define PG8_LDB(dst, b, h) do { _Pragma("unroll") for (int n = 0; n < 2; ++n) _Pragma("unroll") for (int k = 0; k < 2; ++k) dst[n][k] = *(const PG8_LAS bf16x8*)(lds + PG8_SB(b, h) + boff + n * 2048 + k * 1024); } while (0)
#define PG8_MMA(ai, bj, At, Bt) do { __builtin_amdgcn_s_setprio(1); _Pragma("unroll") for (int m = 0; m < 4; ++m) _Pragma("unroll") for (int n = 0; n < 2; ++n) _Pragma("unroll") for (int k = 0; k < 2; ++k) \
        acc[ai][bj][m][n] = __builtin_amdgcn_mfma_f32_16x16x32_bf16(Bt[n][k], At[m][k], acc[ai][bj][m][n], 0, 0, 0); __builtin_amdgcn_s_setprio(0); } while (0)
#define PG8_WAIT_V(n) asm volatile("s_waitcnt vmcnt(" #n ")" ::: "memory")
#define PG8_WAIT_L(n) asm volatile("s_waitcnt lgkmcnt(" #n ")" ::: "memory")
#define PG8_BAR __builtin_amdgcn_s_barrier()
#define PG8_SCHED __builtin_amdgcn_sched_barrier(0)
    Unit cur, nxt; int ui = 0;
    if (!S.next(0, cur)) return;
    f32x4 acc[2][2][4][2];
#pragma unroll
    for (int a = 0; a < 2; ++a)
#pragma unroll
        for (int b = 0; b < 2; ++b)
#pragma unroll
            for (int m = 0; m < 4; ++m)
#pragma unroll
                for (int n = 0; n < 2; ++n) acc[a][b][m][n] = (f32x4){0.f, 0.f, 0.f, 0.f};
    bf16x8 At[4][2], B0[2][2], B1[2][2];
    const char* cA = (const char*)g.A + (size_t)cur.pm * tstep; const char* cB = (const char*)g.Bt + (size_t)cur.pn * tstep;
    S.a_ready(cur);
    PG8_STAGE(PG8_SB(0, 0), cB, voffB); PG8_STAGE(PG8_SA(0, 0), cA, voffA); PG8_STAGE(PG8_SB(0, 1), cB + hstep, voffB); PG8_STAGE(PG8_SA(0, 1), cA + hstep, voffA);
    if (wr == 1) PG8_BAR;
    PG8_WAIT_V(4); PG8_BAR;
    PG8_STAGE(PG8_SB(1, 0), cB + kstep, voffB); PG8_STAGE(PG8_SA(1, 0), cA + kstep, voffA); PG8_STAGE(PG8_SB(1, 1), cB + hstep + kstep, voffB);
    PG8_WAIT_V(6); PG8_BAR;
    for (;;) {
        const bool has_next = S.next(ui + 1, nxt);
        const char* nA = has_next ? (const char*)g.A + (size_t)nxt.pm * tstep : cA; const char* nB = has_next ? (const char*)g.Bt + (size_t)nxt.pn * tstep : cB;
        for (int t = 0; t < nt; t += 2) {
            const bool last = (t == nt - 2);
            const char* a1 = cA + (size_t)(t + 1) * kstep;
            const char* a2 = last ? nA : cA + (size_t)(t + 2) * kstep; const char* b2 = last ? nB : cB + (size_t)(t + 2) * kstep;
            const char* a3 = a2 + kstep; const char* b3 = b2 + kstep;
            if (last && has_next) S.a_ready(nxt);
            PG8_LDB(B0, 0, 0); PG8_SCHED; PG8_LDA(At, 0, 0); PG8_STAGE(PG8_SA(1, 1), a1 + hstep, voffA);
            PG8_WAIT_L(8); PG8_BAR; PG8_WAIT_L(0); PG8_MMA(0, 0, At, B0); PG8_BAR; PG8_SCHED;
            PG8_LDB(B1, 0, 1); PG8_STAGE(PG8_SB(0, 0), b2, voffB);
            PG8_BAR; PG8_WAIT_L(0); PG8_MMA(0, 1, At, B1); PG8_BAR;
            PG8_LDA(At, 0, 1); PG8_STAGE(PG8_SA(0, 0), a2, voffA);
            PG8_BAR; PG8_WAIT_L(0); PG8_MMA(1, 0, At, B0); PG8_BAR; PG8_SCHED;
            PG8_STAGE(PG8_SB(0, 1), b2 + hstep, voffB);
            PG8_WAIT_V(6); PG8_BAR; PG8_MMA(1, 1, At, B1); PG8_BAR;
            PG8_LDB(B0, 1, 0); PG8_SCHED; PG8_LDA(At, 1, 0); PG8_STAGE(PG8_SA(0, 1), a2 + hstep, voffA);
            PG8_WAIT_L(8); PG8_BAR; PG8_WAIT_L(0); PG8_MMA(0, 0, At, B0); PG8_BAR; PG8_SCHED;
            PG8_LDB(B1, 1, 1); PG8_STAGE(PG8_SB(1, 0), b3, voffB);
            PG8_BAR; PG8_WAIT_L(0); PG8_MMA(0, 1, At, B1); PG8_BAR;
            PG8_LDA(At, 1, 1); PG8_STAGE(PG8_SA(1, 0), a3, voffA);
            PG8_BAR; PG8_WAIT_L(0); PG8_MMA(1, 0, At, B0); PG8_BAR; PG8_SCHED;
            PG8_STAGE(PG8_SB(1, 1), b3 + hstep, voffB);
            PG8_WAIT_V(6); PG8_BAR; PG8_MMA(1, 1, At, B1); PG8_BAR;
        }
        if constexpr (!Epi::AFTER_DRAIN) { E(acc, cur, wr, wc, fr, fq); S.done(cur); }
        if (!has_next) break;
#pragma unroll
        for (int a = 0; a < 2; ++a)
#pragma unroll
            for (int b = 0; b < 2; ++b)
#pragma unroll
                for (int m = 0; m < 4; ++m)
#pragma unroll
                    for (int n = 0; n < 2; ++n) acc[a][b][m][n] = (f32x4){0.f, 0.f, 0.f, 0.f};
        cur = nxt; cA = nA; cB = nB; ++ui;
    }
    PG8_WAIT_V(0);
    if (wr == 0) PG8_BAR;
    PG8_BAR;
    if constexpr (Epi::AFTER_DRAIN) { E.fused(acc, cur, wr, wc, fr, fq, lds, wid, lane); S.done(cur); }
#undef PG8_SA
#undef PG8_SB
#undef PG8_STAGE
#undef PG8_LDA
#undef PG8_LDB
#undef PG8_MMA
#undef PG8_WAIT_V
#undef PG8_WAIT_L
#undef PG8_BAR
#undef PG8_SCHED
}
}

template <class F> struct EpiAd {
    static constexpr bool PERM = true, AFTER_DRAIN = false;
    F f; float* ssq;
    __device__ __forceinline__ void operator()(const pg8::f32x4 (&acc)[2][2][4][2], const pg8::Unit& u, int wr, int wc, int fr, int fq) const {
        constexpr int PD = F::PD;
        const int c = wc * 32 + 8 * fq, row0 = u.pm * 256 + wr * 64 + fr;
        typename F::Cols cols; f.load_cols(cols, u.pm, u.pn, c);
        typename F::Row rd[PD];
#pragma unroll
        for (int s = 0; s < PD; ++s) f.load_row(rd[s], row0 + (s >> 2) * 128 + (s & 3) * 16, u.pn, c);
#pragma unroll
        for (int s = 0; s < 8; ++s) { const int ai = s >> 2, m = s & 3, row = row0 + ai * 128 + m * 16;
            float v0[8], v1[8];
#pragma unroll
            for (int n = 0; n < 2; ++n)
#pragma unroll
                for (int e = 0; e < 4; ++e) { v0[4 * n + e] = acc[ai][0][m][n][e]; v1[4 * n + e] = acc[ai][1][m][n][e]; }
            float sq = f.finish(row, u.pn, c, v0, v1, cols, rd[s % PD]);
            if (ssq) { sq += __shfl_xor(sq, 16); sq += __shfl_xor(sq, 32); if (fq == 0) ssq[(size_t)row * 16 + u.pn * 4 + wc] = sq; }
            if (s + PD < 8) f.load_row(rd[s % PD], row0 + ((s + PD) >> 2) * 128 + ((s + PD) & 3) * 16, u.pn, c); }
    }
};
struct TwoPartOrder {
    pg8::StaticOrder s1; int n1, nM1, nM2, n2, G, c;
    __device__ void init(int nM1_, int nN1, int nM2_, int nN2, int G_, int c_) { s1.init(nM1_ * 256, nN1 * 256, G_, c_); n1 = nM1_ * nN1; nM1 = nM1_; nM2 = nM2_; n2 = nM2_ * nN2; G = G_; c = c_; }
    __device__ bool next(int i, pg8::Unit& u) const { long L = (long)i * G + c; if (L < n1) return s1.next(i, u); L -= n1; if (L >= n2) return false; u.pm = nM1 + (int)(L % nM2); u.pn = (int)(L / nM2); return true; }
    __device__ __forceinline__ void a_ready(const pg8::Unit&) const {}
    __device__ __forceinline__ void done(const pg8::Unit&) const {}
};
template <class F>
__device__ __forceinline__ void gemm_mfma(LAS unsigned char* lds, int vc, const bf16_t* A, const bf16_t* Bt, int K, int nrows1, int npn1, int nrows2, int npn2, const F& f, float* ssq) {
    __syncthreads();
    pg8::Gemm g{A, Bt, nrows1 + nrows2, npn1 * 256, K}; TwoPartOrder S; S.init(nrows1 / 256, npn1, nrows2 / 256, npn2, (int)gridDim.x, vc);
    EpiAd<F> E{f, ssq};
    pg8::gemm_phase(lds, g, S, E);
    __syncthreads();
}

struct Ctx { LAS unsigned char* lds; int tid, lane, wid, gw, ngw, vc; };

struct VGrid { int vb, nvb; };
__device__ __forceinline__ void task_transposes_a(const Params& p, const Ctx& c, VGrid g) {
    LAS float* scr = (LAS float*)(c.lds + c.wid * 8448); const int gw = g.vb * NWAVES + c.wid, ngw = g.nvb * NWAVES;
    transpose_gu(p.ffn_wg, 0, (bf16_t*)(p.ws + WS_WG1_T), scr, gw, ngw, c.lane);
    transpose_gu(p.ffn_wu, 1, (bf16_t*)(p.ws + WS_WG1_T), scr, gw, ngw, c.lane);
}
__device__ __forceinline__ void task_transposes_b(const Params& p, const Ctx& c, VGrid g) {
    LAS float* scr = (LAS float*)(c.lds + c.wid * 8448); const int gw = g.vb * NWAVES + c.wid, ngw = g.nvb * NWAVES;
    transpose_matrix(p.ffn_wd, DFF, D, (bf16_t*)(p.ws + WS_WD1_T), scr, gw, ngw, c.lane);
    transpose_matrix(p.w_in, D, NIN, (bf16_t*)(p.ws + WS_WIN_T), scr, gw, ngw, c.lane);
}
__device__ __forceinline__ void task_transposes_c(const Params& p, const Ctx& c, VGrid g) {
    LAS float* scr = (LAS float*)(c.lds + c.wid * 8448); const int gw = g.vb * NWAVES + c.wid, ngw = g.nvb * NWAVES;
    transpose_matrix(p.w_pa, 512, D, (bf16_t*)(p.ws + WS_WPA_T), scr, gw, ngw, c.lane);
    transpose_matrix(p.w_pb, 512, D, (bf16_t*)(p.ws + WS_WPB_T), scr, gw, ngw, c.lane);
    transpose_matrix(p.w_out, D, D, (bf16_t*)(p.ws + WS_WOUT_T), scr, gw, ngw, c.lane);
}
__device__ __forceinline__ void task_modv(const Params& p, const Ctx& c, VGrid g) {
    if (g.vb < MODW / 64) {
        LAS float* xs = (LAS float*)c.lds; LAS float* part = (LAS float*)(c.lds + 17 * 1024 * 4);
        __syncthreads();
        for (int i = c.tid; i < 17 * 1024; i += NTHR) { const int r = i >> 10, k = i & 1023; const float v = r < 16 ? p.c[r * D + k] : p.c_ctx[k]; xs[i] = v / (1.0f + expf(-v)); }
        __syncthreads();
        gemv17<false>(xs, part, p.mod_w, MODW, p.mod_b, (float*)(p.ws + WS_MODV), MODW, 0, g.vb, g.nvb);
    }
}
__device__ __forceinline__ void task_tables(const Params& p, const Ctx& c, VGrid g) {
    float* er = (float*)(p.ws + WS_ER); float* ec = (float*)(p.ws + WS_EC); float* lbv = (float*)(p.ws + WS_LBV);
    const int gt = g.vb * NTHR + c.tid, ngt = g.nvb * NTHR;
    for (int i = gt; i < 96 * 512; i += ngt) { const int r = i >> 9, j = i & 511, jj = j & 255; const float omega = 1.0f / powf(10000.0f, (float)jj / 256.0f);
        const int pos = r < 32 ? r : r - 32; const float a = (float)pos * omega; const float v = j < 256 ? sinf(a) : cosf(a);
        if (r < 32) er[r * 512 + j] = v; else ec[(r - 32) * 512 + j] = v; }
    for (int i = gt; i < 1024; i += ngt) { const float l0 = p.lb_logits[i], l1 = p.lb_logits[1024 + i]; lbv[i] = 1.0f / (1.0f + expf(l1 - l0)); }
}
__device__ __forceinline__ void task_h2(const Params& p, const Ctx& c, VGrid g) {
    LAS float* zf = (LAS float*)c.lds; LAS float* h1 = zf + 8 * 40; float* h2o = (float*)(p.ws + WS_H2);
    for (int it = g.vb; it < SEQ / 8; it += g.nvb) {
        __syncthreads();
        if (c.tid < 8 * 33) { const int r = c.tid / 33, f = c.tid % 33; const int pp = it * 8 + r; float v;
            if (f == 0) v = (float)pp / (float)(SEQ - 1);
            else { const int i = (f - 1) & 15; const float w = 6.283185307179586f * (float)pp / (float)SEQ; const float fr = 1e-4f + (float)i * ((15.0f - 1e-4f) / 15.0f); const float ang = w * fr; v = f <= 16 ? cosf(ang) : -sinf(ang); }
            zf[r * 40 + f] = v; }
        __syncthreads();
        { const int r = c.tid >> 6, j = c.tid & 63; float s = p.hb1[j];
          for (int f = 0; f < 33; ++f) s += zf[r * 40 + f] * p.hw1[f * 64 + j];
          h1[r * 64 + j] = sinf(p.hfr1[j] * s); }
        __syncthreads();
        { const int r = c.tid >> 6, j = c.tid & 63; float s = p.hb2[j];
          for (int k = 0; k < 64; ++k) s += h1[r * 64 + k] * p.hw2[k * 64 + j];
          h2o[(size_t)(it * 8 + r) * 64 + j] = sinf(p.hfr2[j] * s); }
    }
}
__device__ __forceinline__ void task_shift_gemv(const Params& p, const Ctx& c, VGrid g, int which) {
    const float* modv = (const float*)(p.ws + WS_MODV);
    LAS float* xs = (LAS float*)c.lds; LAS float* part = (LAS float*)(c.lds + 17 * 1024 * 4);
    const int nb_in = NIN / 64, nb_g = DFF / 64, nblk = which == 0 ? nb_in : 2 * nb_g;
    if (g.vb >= nblk) return;
    __syncthreads();
    for (int i = c.tid; i < 17 * 1024; i += NTHR) xs[i] = modv[(size_t)(i >> 10) * MODW + (which == 0 ? 3 : 6) * D + (i & 1023)];
    __syncthreads();
    for (int bx = g.vb; bx < nblk; bx += g.nvb) {
        if (which == 0) gemv17<false>(xs, part, p.w_in, NIN, nullptr, (float*)(p.ws + WS_SWIN), NIN, 0, bx, nb_in);
        else { const int half = bx / nb_g, blk = bx % nb_g; const float* W = (half ? p.ffn_wu : p.ffn_wg) + (size_t)D * DFF;
            gemv17<true>(xs, part, W, DFF, nullptr, (float*)(p.ws + WS_SW2), NGU, half, blk, nb_g); }
    }
}
__device__ __forceinline__ void task_filters(const Params& p, const Ctx& c, VGrid g, int item0, int item1) {
    LAS float* w3s = (LAS float*)c.lds;
    LAS float* hk = w3s + 512;
    LAS float* red = hk + 2048 * 8;
    const float* h2 = (const float*)(p.ws + WS_H2); bf16_t* krev = (bf16_t*)(p.ws + WS_KREV);
    for (int it = item0 + g.vb; it < item1; it += g.nvb) {
        const int c0 = 2 * it;
        __syncthreads();
        { const int k = c.tid >> 3, q = c.tid & 7; w3s[c.tid] = p.hw3[(size_t)k * 2048 + (q >> 2) * 1024 + ((q >> 1) & 1) * 512 + c0 + (q & 1)]; }
        __syncthreads();
        float l1 = 0.f;
        for (int idx = c.tid; idx < 2048 * 8; idx += NTHR) { const int t = idx >> 3, q = idx & 7; float s = 0.f;
            const float* hr = h2 + (size_t)t * 64;
#pragma unroll 8
            for (int k = 0; k < 64; ++k) s += hr[k] * w3s[k * 8 + q];
            const int ch = c0 + (q & 1); const float delta = fabsf(-3.0701134573253945f + (float)ch * ((-15.350567286626973f + 3.0701134573253945f) / 511.0f));
            const float tn = (float)t / (float)(SEQ - 1); s *= expf(-tn * delta) + 0.05f;
            hk[idx] = s; l1 += fabsf(s); }
        { float s = l1; s += __shfl_xor(s, 2); s += __shfl_xor(s, 8); s += __shfl_xor(s, 16); s += __shfl_xor(s, 32);
          if ((c.lane & ~5) == 0) red[c.wid * 4 + ((c.lane >> 2) & 1) * 2 + (c.lane & 1)] = s; }
        __syncthreads();
        for (int e = c.tid; e < 4 * KR_LEN; e += NTHR) { const int oc = e / KR_LEN, i = (e % KR_LEN) - KR_OFF, o = oc >> 1, cc = oc & 1;
            float tot = 0.f;
#pragma unroll
            for (int w = 0; w < 8; ++w) tot += red[w * 4 + oc];
            const int lag = -i; float v = 0.f;
            if (lag >= 0 && lag <= SEQ - 1) v = hk[lag * 8 + o * 4 + 0 + cc]; else if (lag < 0 && lag >= -(SEQ - 1)) v = hk[(-lag - 1) * 8 + o * 4 + 2 + cc];
            krev[((size_t)o * 512 + c0 + cc) * KR_LEN + (e % KR_LEN)] = f2bf(v / (tot + 1e-6f)); }
    }
}
__device__ __forceinline__ void phase_prep(const Params& p, const Ctx& c) {
    const int G = (int)gridDim.x, nmod = MODW / 64;
    if (G >= nmod + 32) {
        if ((int)blockIdx.x < nmod) task_modv(p, c, VGrid{(int)blockIdx.x, nmod});
        else { const VGrid g{(int)blockIdx.x - nmod, G - nmod}; task_transposes_a(p, c, g); task_tables(p, c, g); task_h2(p, c, g); }
    } else { const VGrid g{(int)blockIdx.x, G}; task_transposes_a(p, c, g); task_modv(p, c, g); task_tables(p, c, g); task_h2(p, c, g); }
}
__device__ __forceinline__ void phase_n1(const Params& p, const Ctx& c) {
    unsigned char* ws = p.ws;
    const float* modv = (const float*)(ws + WS_MODV); const float* er = (const float*)(ws + WS_ER); const float* ec = (const float*)(ws + WS_EC);
    bf16_t* n1 = (bf16_t*)(ws + WS_N1);
    for (int row0 = 2 * c.gw; row0 < MT; row0 += 2 * c.ngw) {
        f32x4 v[2][4]; float s[2];
#pragma unroll
        for (int r = 0; r < 2; ++r) { const int row = row0 + r; const bool lat = row < T; const int t = row & (SEQ - 1);
            const float* src = lat ? p.x + (size_t)row * D : p.ctx + (size_t)(row - T) * D;
#pragma unroll
            for (int j = 0; j < 4; ++j) { const int col = 4 * c.lane + 256 * j; v[r][j] = *(const f32x4*)(src + col);
                if (lat) { const float* pe = col < 512 ? er + (t >> 6) * 512 + col : ec + (t & 63) * 512 + (col - 512); v[r][j] += *(const f32x4*)pe; } } }
#pragma unroll
        for (int r = 0; r < 2; ++r) { const int row = row0 + r; const bool lat = row < T; const int b = lat ? (row >> 11) : 16;
            float ss = 0.f;
#pragma unroll
            for (int j = 0; j < 4; ++j) ss += (v[r][j][0] * v[r][j][0] + v[r][j][1] * v[r][j][1]) + (v[r][j][2] * v[r][j][2] + v[r][j][3] * v[r][j][3]);
            s[r] = ss;
            const float rs = 1.0f / sqrtf(wave_sum(s[r]) * (1.0f / D) + RMS_EPS);
            { bf16_t* hdst = lat ? (bf16_t*)p.out + (size_t)row * D : (bf16_t*)(ws + WS_HCB) + (size_t)(row - T) * D;
#pragma unroll
              for (int j = 0; j < 4; ++j) { u32x2 w; w.x = pk2(v[r][j][0], v[r][j][1]); w.y = pk2(v[r][j][2], v[r][j][3]); *(u32x2*)(hdst + 4 * c.lane + 256 * j) = w; } }
#pragma unroll
            for (int j = 0; j < 4; ++j) { const int col = 4 * c.lane + 256 * j; const f32x4 sh = *(const f32x4*)(modv + (size_t)b * MODW + col), sc = *(const f32x4*)(modv + (size_t)b * MODW + D + col);
                const f32x4 o = v[r][j] * rs * (sc + 1.0f) + sh; u32x2 w; w.x = pk2(o[0], o[1]); w.y = pk2(o[2], o[3]); *(u32x2*)(n1 + (size_t)row * D + col) = w; } }
    }
}
__device__ __forceinline__ bool filler_grid(VGrid& g, int vc, int nunits) {
    const int G = (int)gridDim.x, rem = nunits % G;
    if (rem == 0) { g.vb = vc; g.nvb = G; return true; }
    if (vc < rem) return false;
    g.vb = vc - rem; g.nvb = G - rem; return true;
}

__device__ __forceinline__ void phase_hgrn_simple(const Params& p, const Ctx& c) {
    unsigned char* ws = p.ws;
    const bf16_t* vb = (const bf16_t*)(ws + WS_V); const bf16_t* qb = (const bf16_t*)(ws + WS_Q);
    LAS float* F = (LAS float*)c.lds; LAS float* Kk = F + 64 * 128; LAS float* Q = Kk + 64 * 128; LAS float* V = Q + 64 * 128;
    const int dg = c.tid & 3, e = c.tid >> 2;
    for (int it = blockIdx.x; it < NB * 4 * 2; it += gridDim.x) {
        const int dir = it & 1, h = (it >> 1) & 3, b = it >> 3;
        const f16_t* lf = (const f16_t*)(ws + (dir ? WS_LBW : WS_LFW)); bf16_t* outp = (bf16_t*)(ws + (dir ? WS_OBW : WS_OFW));
        float S[32];
#pragma unroll
        for (int i = 0; i < 32; ++i) S[i] = 0.f;
        for (int ci = 0; ci < 36; ++ci) {
            const bool lat = ci >= 4;
            __syncthreads();
            for (int idx = c.tid; idx < 64 * 128; idx += NTHR) { const int j = idx >> 7, d = idx & 127; const int pp = (lat ? ci - 4 : ci) * 64 + j;
                const int row = lat ? b * SEQ + (dir ? SEQ - 1 - pp : pp) : T + b * CL + (dir ? CL - 1 - pp : pp);
                const float f = __expf((float)lf[(size_t)row * 512 + h * 128 + d]);
                F[idx] = f; Kk[idx] = 1.0f - f; V[idx] = bf2f(vb[(size_t)row * 512 + h * 128 + d]); Q[idx] = lat ? bf2f(qb[(size_t)row * 512 + h * 128 + d]) : 0.f; }
            __syncthreads();
            for (int j = 0; j < 64; ++j) { const float ve = V[j * 128 + e]; float part = 0.f;
#pragma unroll
                for (int i = 0; i < 32; ++i) { const int d = dg * 32 + i; S[i] = F[j * 128 + d] * S[i] + Kk[j * 128 + d] * ve; part += S[i] * Q[j * 128 + d]; }
                part += __shfl_xor(part, 1); part += __shfl_xor(part, 2);
                if (lat && dg == 0) { const int pp = (ci - 4) * 64 + j; const int row = b * SEQ + (dir ? SEQ - 1 - pp : pp); outp[(size_t)row * 512 + h * 128 + e] = f2bf(part); } }
        }
    }
}


typedef short bf16x8 __attribute__((ext_vector_type(8)));
constexpr int QROW = 136, TROW = 72;
__device__ __forceinline__ int hg_pos(int x) { return (x & ~31) + ((x >> 2) & 3) * 8 + ((x >> 4) & 1) * 4 + (x & 3); }
__device__ __forceinline__ pg8::f32x4 mfma16(bf16x8 a, bf16x8 b, pg8::f32x4 c) { return __builtin_amdgcn_mfma_f32_16x16x32_bf16(a, b, c, 0, 0, 0); }
__device__ __forceinline__ void phase_hgrn_mfma(const Params& p, const Ctx& c) {
    unsigned char* ws = p.ws;
    const bf16_t* vb = (const bf16_t*)(ws + WS_V); const bf16_t* qb = (const bf16_t*)(ws + WS_Q);
    LAS bf16_t* Qt = (LAS bf16_t*)c.lds;
    LAS bf16_t* Kt = Qt + 64 * QROW;
    LAS bf16_t* KhT = Kt + 64 * QROW;
    LAS bf16_t* VT = KhT + 128 * TROW;
    LAS bf16_t* ST0 = VT + 64 * TROW;
    LAS bf16_t* ST1 = ST0 + 64 * QROW;
    LAS float* qt = (LAS float*)(ST1 + 64 * QROW);
    LAS float* El = qt + 8 * 128;
    const int wid = c.wid, lane = c.lane, fr = lane & 15, fq = lane >> 4, dp = lane, ti = wid & 3, eh = wid >> 2;
    for (int it = c.vc; it < 256; it += gridDim.x) {
        const int dvh = (it >> 3) & 1, idx = (it & 7) | ((it >> 4) << 3), dir = idx & 1, h = (idx >> 1) & 3, b = idx >> 3;
        const f16_t* lf = (const f16_t*)(ws + (dir ? WS_LBW : WS_LFW)); bf16_t* outp = (bf16_t*)(ws + (dir ? WS_OBW : WS_OFW));
        const int colq = h * 128 + 2 * dp, colv = h * 128 + dvh * 64 + (c.tid & 7) * 8, pv = c.tid >> 3;
        pg8::f32x4 S[4];
#pragma unroll
        for (int e = 0; e < 4; ++e) S[e] = (pg8::f32x4){0.f, 0.f, 0.f, 0.f};
#define HG_ROW(ci_, p_) (((ci_) >= 4) ? (b * SEQ + (dir ? SEQ - 1 - (((ci_) - 4) * 64 + (p_)) : (((ci_) - 4) * 64 + (p_)))) : (T + b * CL + (dir ? CL - 1 - ((ci_) * 64 + (p_)) : ((ci_) * 64 + (p_)))))
        unsigned lfr[2][8], qr[2][8]; u32x4 vr[2];
#pragma unroll
        for (int s2 = 0; s2 < 2; ++s2) {
#pragma unroll
            for (int i = 0; i < 8; ++i) { const int row = HG_ROW(s2, 8 * wid + i); lfr[s2][i] = *(const unsigned*)(lf + (size_t)row * 512 + colq); qr[s2][i] = 0u; }
            vr[s2] = *(const u32x4*)(vb + (size_t)HG_ROW(s2, pv) * 512 + colv); }
        __syncthreads();
        for (int ci2 = 0; ci2 < 36; ci2 += 2) {
#pragma unroll
          for (int par = 0; par < 2; ++par) {
            const int ci = ci2 + par;
            const bool lat = ci >= 4;
            float l0[8], l1[8], c0[8], c1[8]; float run0 = 0.f, run1 = 0.f;
#pragma unroll
            for (int i = 0; i < 8; ++i) { const __fp16 a0 = __builtin_bit_cast(__fp16, (unsigned short)(lfr[par][i] & 0xffffu)), a1 = __builtin_bit_cast(__fp16, (unsigned short)(lfr[par][i] >> 16));
                l0[i] = (float)a0; l1[i] = (float)a1; run0 += l0[i]; run1 += l1[i]; c0[i] = run0; c1[i] = run1; }
            qt[wid * 128 + 2 * dp] = run0; qt[wid * 128 + 2 * dp + 1] = run1;
            __syncthreads();
            float off0 = 0.f, off1 = 0.f, tot0 = 0.f, tot1 = 0.f;
#pragma unroll
            for (int w = 0; w < 8; ++w) { const float a0 = qt[w * 128 + 2 * dp], a1 = qt[w * 128 + 2 * dp + 1]; tot0 += a0; tot1 += a1; if (w < wid) { off0 += a0; off1 += a1; } }
            const float E0 = __expf(tot0), E1 = __expf(tot1);
            if (wid == 0) { El[2 * dp] = E0; El[2 * dp + 1] = E1; }
            const int qpos = hg_pos(2 * dp);
            float kh0[8], kh1[8];
#pragma unroll
            for (int i = 0; i < 8; ++i) { const int pp = 8 * wid + i; const float cu0 = off0 + c0[i], cu1 = off1 + c1[i];
                const float e0 = __expf(cu0), e1 = __expf(cu1), r0 = __expf(-cu0), r1 = __expf(-cu1);
                const float k0 = (1.0f - __expf(l0[i])) * r0, k1 = (1.0f - __expf(l1[i])) * r1;
                *(LAS unsigned*)(Kt + pp * QROW + qpos) = pk2(k0, k1);
                if (lat) { const float q0 = __uint_as_float(qr[par][i] << 16), q1 = __uint_as_float(qr[par][i] & 0xffff0000u); *(LAS unsigned*)(Qt + pp * QROW + qpos) = pk2(q0 * e0, q1 * e1); }
                kh0[i] = k0 * E0; kh1[i] = k1 * E1; }
            { const int base0 = 32 * (wid >> 2) + 16 * (wid & 1) + 4 * ((wid >> 1) & 1);
              u32x2 w; w.x = pk2(kh0[0], kh0[1]); w.y = pk2(kh0[2], kh0[3]); *(LAS u32x2*)(KhT + (2 * dp) * TROW + base0) = w;
              w.x = pk2(kh0[4], kh0[5]); w.y = pk2(kh0[6], kh0[7]); *(LAS u32x2*)(KhT + (2 * dp) * TROW + base0 + 8) = w;
              w.x = pk2(kh1[0], kh1[1]); w.y = pk2(kh1[2], kh1[3]); *(LAS u32x2*)(KhT + (2 * dp + 1) * TROW + base0) = w;
              w.x = pk2(kh1[4], kh1[5]); w.y = pk2(kh1[6], kh1[7]); *(LAS u32x2*)(KhT + (2 * dp + 1) * TROW + base0 + 8) = w; }
            { const int e8 = (c.tid & 7) * 8, sp = hg_pos(pv); const unsigned wv[4] = {vr[par].x, vr[par].y, vr[par].z, vr[par].w};
#pragma unroll
              for (int j = 0; j < 4; ++j) { VT[(e8 + 2 * j) * TROW + sp] = (bf16_t)(wv[j] & 0xffffu); VT[(e8 + 2 * j + 1) * TROW + sp] = (bf16_t)(wv[j] >> 16); } }
            if (ci + 2 < 36) { const bool nlat = ci + 2 >= 4;
#pragma unroll
                for (int i = 0; i < 8; ++i) { const int row = HG_ROW(ci + 2, 8 * wid + i); lfr[par][i] = *(const unsigned*)(lf + (size_t)row * 512 + colq); if (nlat) qr[par][i] = *(const unsigned*)(qb + (size_t)row * 512 + colq); }
                vr[par] = *(const u32x4*)(vb + (size_t)HG_ROW(ci + 2, pv) * 512 + colv); }
            __syncthreads();
            const LAS bf16_t* STr = (ci & 1) ? ST1 : ST0; LAS bf16_t* STw = (ci & 1) ? ST0 : ST1;
            bf16x8 VF[4][2];
#pragma unroll
            for (int ei = 0; ei < 4; ++ei)
#pragma unroll
                for (int a = 0; a < 2; ++a) VF[ei][a] = *(const LAS bf16x8*)(VT + (16 * ei + fr) * TROW + 32 * a + 8 * fq);
            if (lat) {
                bf16x8 QF[4];
#pragma unroll
                for (int k = 0; k < 4; ++k) QF[k] = *(const LAS bf16x8*)(Qt + (16 * ti + fr) * QROW + 32 * k + 8 * fq);
                pg8::f32x4 P[4];
#pragma unroll
                for (int si = 0; si < 4; ++si) { pg8::f32x4 acc = (pg8::f32x4){0.f, 0.f, 0.f, 0.f};
                    if (si <= ti) {
#pragma unroll
                        for (int k = 0; k < 4; ++k) acc = mfma16(*(const LAS bf16x8*)(Kt + (16 * si + fr) * QROW + 32 * k + 8 * fq), QF[k], acc);
                        if (si == ti) {
#pragma unroll
                            for (int r = 0; r < 4; ++r) acc[r] = (4 * fq + r <= fr) ? acc[r] : 0.f; } }
                    P[si] = acc; }
                bf16x8 PB[2];
#pragma unroll
                for (int a = 0; a < 2; ++a) { u32x4 w; w.x = pk2(P[2 * a][0], P[2 * a][1]); w.y = pk2(P[2 * a][2], P[2 * a][3]); w.z = pk2(P[2 * a + 1][0], P[2 * a + 1][1]); w.w = pk2(P[2 * a + 1][2], P[2 * a + 1][3]); PB[a] = __builtin_bit_cast(bf16x8, w); }
#pragma unroll
                for (int e2 = 0; e2 < 2; ++e2) { const int ei = 2 * eh + e2; pg8::f32x4 acc = (pg8::f32x4){0.f, 0.f, 0.f, 0.f};
#pragma unroll
                    for (int a = 0; a < 2; ++a) if (2 * a <= ti) acc = mfma16(*(const LAS bf16x8*)(VT + (16 * ei + fr) * TROW + 32 * a + 8 * fq), PB[a], acc);
#pragma unroll
                    for (int k = 0; k < 4; ++k) acc = mfma16(*(const LAS bf16x8*)(STr + (16 * ei + fr) * QROW + 32 * k + 8 * fq), QF[k], acc);
                    const int row = HG_ROW(ci, 16 * ti + fr);
                    u32x2 ow; ow.x = pk2(acc[0], acc[1]); ow.y = pk2(acc[2], acc[3]); *(u32x2*)(outp + (size_t)row * 512 + h * 128 + dvh * 64 + 16 * ei + 4 * fq) = ow; }
            }
            { const pg8::f32x4 dl = *(const LAS pg8::f32x4*)(El + 16 * wid + 4 * fq);
              bf16x8 KH[2];
#pragma unroll
              for (int a = 0; a < 2; ++a) KH[a] = *(const LAS bf16x8*)(KhT + (16 * wid + fr) * TROW + 32 * a + 8 * fq);
#pragma unroll
              for (int ei = 0; ei < 4; ++ei) { S[ei] = S[ei] * dl;
#pragma unroll
                  for (int a = 0; a < 2; ++a) S[ei] = mfma16(KH[a], VF[ei][a], S[ei]);
                  u32x2 w; w.x = pk2(S[ei][0], S[ei][1]); w.y = pk2(S[ei][2], S[ei][3]);
                  *(LAS u32x2*)(STw + (16 * ei + fr) * QROW + 32 * (wid >> 1) + 8 * fq + 4 * (wid & 1)) = w; } }
            __syncthreads();
          }
        }
#undef HG_ROW
    }
}

constexpr int ZROW = 2056;
__device__ __forceinline__ void phase_hy_prepass(const Params& p, const Ctx& c) {
    bf16_t* hy = (bf16_t*)(p.ws + WS_HY);
    LAS bf16_t* raw = (LAS bf16_t*)c.lds;
    if (c.tid < 4) { ((LAS unsigned*)raw)[c.tid] = 0u; ((LAS unsigned*)(raw + 2049 * 8))[c.tid] = 0u; }
    for (int blk = blockIdx.x; blk < (NHY / 8) * NB; blk += gridDim.x) {
        bf16_t* base = hy + (size_t)blk * SEQ * 8; const int cg = blk / NB;
        u32x4 ch4[4];
#pragma unroll
        for (int i = 0; i < 4; ++i) ch4[i] = *(const u32x4*)(base + (size_t)(4 * c.tid + i) * 8);
        __syncthreads();
#pragma unroll
        for (int i = 0; i < 4; ++i) *(LAS u32x4*)(raw + (size_t)(1 + 4 * c.tid + i) * 8) = ch4[i];
        __syncthreads();
        const int ch = cg * 8 + c.wid; const float w0 = p.conv_w[ch], w1 = p.conv_w[NHY + ch], w2 = p.conv_w[2 * NHY + ch], cb = p.conv_b[ch];
#pragma unroll 4
        for (int k = 0; k < 16; ++k) { const int t = 2 * c.lane + 128 * k;
            const float x0 = bf2f(raw[(t + 0) * 8 + c.wid]), x1 = bf2f(raw[(t + 1) * 8 + c.wid]), x2 = bf2f(raw[(t + 2) * 8 + c.wid]), x3 = bf2f(raw[(t + 3) * 8 + c.wid]);
            *(unsigned*)(base + (size_t)c.wid * SEQ + t) = pk2(cb + w0 * x0 + w1 * x1 + w2 * x2, cb + w0 * x1 + w1 * x2 + w2 * x3); }
    }
}
__device__ __forceinline__ void hy_fill2(LAS bf16_t* dst, const bf16_t* hy, int chx, int tid) {
#pragma unroll
    for (int i = 0; i < 8; ++i) { const int idx = tid + NTHR * i, b = idx >> 8, t8 = (idx & 255) * 8;
        *(LAS u32x4*)(dst + b * ZROW + t8) = *(const u32x4*)(hy + ((((size_t)(chx >> 3) * NB + b) * 8 + (chx & 7)) * SEQ) + t8); }
}
template <int KIND>
__device__ __forceinline__ void hy_block(pg8::f32x4 (&acc)[16], bf16x8 (&Bw)[16], const LAS bf16_t* zl, const LAS bf16_t* krl, int ub, int i0, int lane) {
    const int fr = lane & 15, fq = lane >> 4;
    const LAS bf16_t* bbase = zl + fr * ZROW + 8 * fq;
    const int abase = KR_OFF - 16 * i0 - fr + 8 * fq;
    const unsigned sh = (unsigned)(fr & 1) * 16u;
#pragma unroll
    for (int uu = 0; uu < 16; ++uu) {
        const int u = ub + uu;
        const bool ldb = KIND == 0 ? (uu >= 1) : (KIND == 1 ? true : (uu == 0));
        if (ldb) Bw[(uu + 15) & 15] = *(const LAS bf16x8*)(bbase + 32 * (u + 15));
        const LAS unsigned* ap = (const LAS unsigned*)(krl + ((abase + 32 * u) & ~1));
        const unsigned d0 = ap[0], d1 = ap[1], d2 = ap[2], d3 = ap[3], d4 = ap[4];
        u32x4 aw; aw.x = __builtin_amdgcn_alignbit(d1, d0, sh); aw.y = __builtin_amdgcn_alignbit(d2, d1, sh); aw.z = __builtin_amdgcn_alignbit(d3, d2, sh); aw.w = __builtin_amdgcn_alignbit(d4, d3, sh);
        const bf16x8 A = __builtin_bit_cast(bf16x8, aw);
#pragma unroll
        for (int m = 0; m < 16; ++m) { const bool on = KIND == 0 ? (m >= 16 - uu) : (KIND == 1 ? true : (m <= 15 - uu));
            if (on) acc[m] = __builtin_amdgcn_mfma_f32_16x16x32_bf16(A, Bw[(uu + m) & 15], acc[m], 0, 0, 0); }
    }
}
__device__ __forceinline__ void phase_hyena_mfma(const Params& p, const Ctx& c) {
    unsigned char* ws = p.ws;
    const bf16_t* hy = (const bf16_t*)(ws + WS_HY); const bf16_t* krev = (const bf16_t*)(ws + WS_KREV); bf16_t* zb = (bf16_t*)(ws + WS_ZB);
    LAS bf16_t* zl = (LAS bf16_t*)c.lds;
    LAS bf16_t* gl = zl + NB * ZROW;
    LAS bf16_t* krl = gl + NB * ZROW;
    const int i0 = 32 * (c.wid >> 1) + (c.wid & 1), fr = c.lane & 15, fq = c.lane >> 4;
    for (int ch = blockIdx.x; ch < BW; ch += gridDim.x) {
        __syncthreads();
        hy_fill2(zl, hy, ch, c.tid);
        for (int o = 0; o < 2; ++o) {
            hy_fill2(gl, hy, (o + 1) * 512 + ch, c.tid);
            for (int i = c.tid; i < KR_LEN / 8; i += NTHR) *(LAS u32x4*)(krl + 8 * i) = *(const u32x4*)(krev + ((size_t)o * 512 + ch) * KR_LEN + 8 * i);
            __syncthreads();
            pg8::f32x4 acc[16]; bf16x8 Bw[16];
#pragma unroll
            for (int m = 0; m < 16; ++m) { acc[m] = (pg8::f32x4){0.f, 0.f, 0.f, 0.f}; Bw[m] = (bf16x8){0, 0, 0, 0, 0, 0, 0, 0}; }
            hy_block<0>(acc, Bw, zl, krl, -16, i0, c.lane);
            for (int ub = 0; ub < 48; ub += 16) hy_block<1>(acc, Bw, zl, krl, ub, i0, c.lane);
            hy_block<2>(acc, Bw, zl, krl, 48, i0, c.lane);
            const float bias = p.hy_bias[o * 512 + ch];
            u32x2 res[16];
#pragma unroll
            for (int m = 0; m < 16; ++m) { const int t = 16 * (i0 + 2 * m) + 4 * fq; const u32x2 zo = *(const LAS u32x2*)(zl + fr * ZROW + t), gg = *(const LAS u32x2*)(gl + fr * ZROW + t);
                const float z0 = __uint_as_float(zo.x << 16), z1 = __uint_as_float(zo.x & 0xffff0000u), z2 = __uint_as_float(zo.y << 16), z3 = __uint_as_float(zo.y & 0xffff0000u);
                const float g0 = __uint_as_float(gg.x << 16), g1 = __uint_as_float(gg.x & 0xffff0000u), g2 = __uint_as_float(gg.y << 16), g3 = __uint_as_float(gg.y & 0xffff0000u);
                res[m].x = pk2(g0 * (acc[m][0] + bias * z0), g1 * (acc[m][1] + bias * z1)); res[m].y = pk2(g2 * (acc[m][2] + bias * z2), g3 * (acc[m][3] + bias * z3)); }
            __syncthreads();
#pragma unroll
            for (int m = 0; m < 16; ++m) { const int t = 16 * (i0 + 2 * m) + 4 * fq;
                if (o == 0) *(LAS u32x2*)(zl + fr * ZROW + t) = res[m]; else *(u32x2*)(zb + ((size_t)ch * NB + fr) * SEQ + t) = res[m]; }
        }
    }
}

__device__ __forceinline__ void phase_combine(const Params& p, const Ctx& c) {
    unsigned char* ws = p.ws;
    const bf16_t* ofw = (const bf16_t*)(ws + WS_OFW); const bf16_t* obw = (const bf16_t*)(ws + WS_OBW); const bf16_t* g = (const bf16_t*)(ws + WS_G);
    bf16_t* oa = (bf16_t*)(ws + WS_OA); bf16_t* ob = (bf16_t*)(ws + WS_OB); const bf16_t* zb = (const bf16_t*)(ws + WS_ZB);
    for (int row = c.gw; row < T; row += c.ngw) { const int col = 8 * c.lane; float a[8], bq[8], gg[8], w[8], o[8];
        load_bf16x8(ofw + (size_t)row * 512 + col, a); load_bf16x8(obw + (size_t)row * 512 + col, bq); load_bf16x8(g + (size_t)row * 512 + col, gg); load_f32x8(p.a_norm_w + (col & 127), w);
        float s = 0.f;
#pragma unroll
        for (int j = 0; j < 8; ++j) { a[j] += bq[j]; s += a[j] * a[j]; }
        s += __shfl_xor(s, 1); s += __shfl_xor(s, 2); s += __shfl_xor(s, 4); s += __shfl_xor(s, 8);
        const float rs = 1.0f / sqrtf(s * (1.0f / 128.0f) + RMS_EPS);
#pragma unroll
        for (int j = 0; j < 8; ++j) o[j] = a[j] * rs * w[j] * gg[j];
        store_bf16x8(oa + (size_t)row * 512 + col, o); }
    LAS bf16_t* tile = (LAS bf16_t*)c.lds;
    for (int it = blockIdx.x; it < NB * 32 * 8; it += gridDim.x) { const int cb = it & 7, tb = (it >> 3) & 31, b = it >> 8;
        __syncthreads();
        { const int cl = c.tid >> 3, t8 = (c.tid & 7) * 8; const u32x4 w = *(const u32x4*)(zb + ((size_t)(cb * 64 + cl) * NB + b) * SEQ + tb * 64 + t8); *(LAS u32x4*)(tile + cl * 72 + t8) = w; }
        __syncthreads();
        { const int tl = c.tid >> 3, c8 = (c.tid & 7) * 8; bf16_t v[8];
#pragma unroll
          for (int i = 0; i < 8; ++i) v[i] = tile[(c8 + i) * 72 + tl];
          u32x4 w; w.x = v[0] | ((unsigned)v[1] << 16); w.y = v[2] | ((unsigned)v[3] << 16); w.z = v[4] | ((unsigned)v[5] << 16); w.w = v[6] | ((unsigned)v[7] << 16);
          *(u32x4*)(ob + ((size_t)b * SEQ + tb * 64 + tl) * 512 + cb * 64 + c8) = w; }
    }
}

__device__ __forceinline__ void phase_rstd(const float* ssq, float* rstd, int nrows, const Ctx& c) {
    for (int row = blockIdx.x * NTHR + c.tid; row < nrows; row += gridDim.x * NTHR) rstd[row] = rstd_from_ssq(ssq + (size_t)row * 16);
}
__device__ __forceinline__ void phase_final(const Params& p, const Ctx& c) {
    const float* ssq = (const float*)(p.ws + WS_SSQ3); const bf16_t* h3 = (const bf16_t*)(p.ws + WS_H3);
    for (int row = c.gw; row < T; row += c.ngw) { const float rs = rstd_from_ssq(ssq + (size_t)row * 16);
#pragma unroll
        for (int j = 0; j < 2; ++j) { const int col = 8 * c.lane + 512 * j; float h[8], w[8], o[8]; load_bf16x8(h3 + (size_t)row * D + col, h); load_f32x8(p.fnw + col, w);
#pragma unroll
            for (int i = 0; i < 8; ++i) o[i] = h[i] * rs * w[i];
            store_f32x8(p.out + (size_t)row * D + col, o); } }
}


#define XB_TMO      128
#define XB_XCNT(j)  (256  + 64 * (j))
#define XB_XSUB(j)  (1280 + 64 * (j))
#define XB_XGEN(j)  (2304 + 64 * (j))
#define XB_TOP      3328
#define XB_TOPGEN   3392
#define XCD_BAR_WORDS 3456
#define XB_SPIN_CAP (1u << 18)
__device__ __forceinline__ unsigned xb_ld(unsigned* p)              { return __hip_atomic_load(p, __ATOMIC_RELAXED, __HIP_MEMORY_SCOPE_AGENT); }
__device__ __forceinline__ unsigned xb_add(unsigned* p, unsigned v) { return __hip_atomic_fetch_add(p, v, __ATOMIC_RELAXED, __HIP_MEMORY_SCOPE_AGENT); }
__device__ __forceinline__ unsigned xb_xcc_id() { return (unsigned)__builtin_amdgcn_s_getreg((3 << 11) | 20) & 0xFu; }
#define XB_SPIN(cond, bar) do { unsigned _sp = 0; while (cond) { __builtin_amdgcn_s_sleep(1); \
    if ((++_sp & 255u) == 0u) { if (xb_ld(&(bar)[XB_TMO])) break; if (_sp > XB_SPIN_CAP) { atomicAdd(&(bar)[XB_TMO], 1u); break; } } } } while (0)
struct XcdBarrier { unsigned* bar; unsigned x; volatile LAS unsigned* st; };
__device__ __forceinline__ XcdBarrier xcd_barrier_post(unsigned* bar, volatile LAS unsigned* st) {
    XcdBarrier b; b.bar = bar; b.x = xb_xcc_id(); b.st = st;
    if (threadIdx.x == 0) st[2] = xb_add(&bar[XB_XCNT(b.x)], 1u);
    return b;
}
__device__ __forceinline__ void xcd_barrier_complete(unsigned* bar, unsigned x, unsigned& nloc, unsigned& nx) {
    const unsigned G = gridDim.x * gridDim.y * gridDim.z;
    unsigned sum, cnt, mine, sp = 0u;
    for (;;) {
        sum = 0u; cnt = 0u; mine = 0u;
#pragma unroll
        for (unsigned j = 0; j < 16; ++j) { const unsigned c = xb_ld(&bar[XB_XCNT(j)]); sum += c; cnt += (c > 0u) ? 1u : 0u; mine = (j == x) ? c : mine; }
        if (sum == G) break;
        __builtin_amdgcn_s_sleep(1);
        if ((++sp & 255u) == 0u) { if (xb_ld(&bar[XB_TMO])) break; if (sp > XB_SPIN_CAP) { atomicAdd(&bar[XB_TMO], 1u); break; } }
    }
    nloc = mine > 0u ? mine : 1u; nx = cnt > 0u ? cnt : 1u;
}
__device__ __forceinline__ void xcd_barrier(const XcdBarrier& b) {
    asm volatile("s_waitcnt vmcnt(0)" ::: "memory");
    __syncthreads();
    if (threadIdx.x == 0) {
        unsigned* bar = b.bar;
        __builtin_amdgcn_s_waitcnt(0);
        unsigned nloc = b.st[0], nx = b.st[1];
        if (nloc == 0u) { xcd_barrier_complete(bar, b.x, nloc, nx); b.st[0] = nloc; b.st[1] = nx; }
        const unsigned old = xb_add(&bar[XB_XSUB(b.x)], 1u);
        const unsigned gen = old / nloc;
        if (old + 1u == (gen + 1u) * nloc) {
            __builtin_amdgcn_fence(__ATOMIC_RELEASE, "agent");
            asm volatile("s_waitcnt vmcnt(0)" ::: "memory");
            const unsigned og = xb_add(&bar[XB_TOP], 1u);
            const unsigned tg = og / nx;
            if (og + 1u == (tg + 1u) * nx) xb_add(&bar[XB_TOPGEN], 1u);
            else XB_SPIN(xb_ld(&bar[XB_TOPGEN]) == tg, bar);
            __builtin_amdgcn_fence(__ATOMIC_ACQUIRE, "agent");
            xb_add(&bar[XB_XGEN(b.x)], 1u);
            asm volatile("s_waitcnt vmcnt(0)" ::: "memory");
        } else {
            XB_SPIN(xb_ld(&bar[XB_XGEN(b.x)]) == gen, bar);
            __builtin_amdgcn_fence(__ATOMIC_ACQUIRE, "agent");
            asm volatile("s_waitcnt vmcnt(0)" ::: "memory");
        }
    }
    __syncthreads();
}

constexpr int N_PHASES = 16;
#ifndef REPEAT_MASK
#define REPEAT_MASK 0
#endif
#ifndef HOST_REPEAT_MASK
#define HOST_REPEAT_MASK 0
#endif
#ifndef USE_XCD_BARRIER
#define USE_XCD_BARRIER 1
#endif
__global__ void __launch_bounds__(NTHR, 2) fwd_kernel(Params p) {
    extern __shared__ __attribute__((aligned(16))) unsigned char lds_raw[];
    Ctx c; c.lds = (LAS unsigned char*)lds_raw; c.tid = threadIdx.x; c.lane = c.tid & 63; c.wid = __builtin_amdgcn_readfirstlane(c.tid >> 6);
    c.gw = blockIdx.x * NWAVES + c.wid; c.ngw = gridDim.x * NWAVES; c.vc = blockIdx.x;
    unsigned char* ws = p.ws;
    const float* modv = (const float*)(ws + WS_MODV);
#if N_LAUNCH_MODE == 1
    cg::grid_group grid = cg::this_grid();
#if USE_XCD_BARRIER
    volatile LAS unsigned* xst = (volatile LAS unsigned*)(c.lds + LDS_BYTES - 16);
    if (c.tid < 4) xst[c.tid] = 0u;
    __syncthreads();
    XcdBarrier xbar = xcd_barrier_post((unsigned*)(ws + WS_CTL), xst);
    bool first_seam = true;
#define SEAM() do { if (first_seam) { grid.sync(); first_seam = false; \
        if (c.tid == 0) { unsigned* bar_ = (unsigned*)(ws + WS_CTL); bool ok_ = (gridDim.x % 8u) == 0u; for (unsigned j_ = 0; j_ < 16; ++j_) { const unsigned n_ = xb_ld(&bar_[XB_XCNT(j_)]); ok_ = ok_ && (j_ < 8 ? n_ == gridDim.x / 8u : n_ == 0u); } \
            xst[3] = ok_ ? (xst[2] * 8u + xbar.x) : blockIdx.x; } \
        __syncthreads(); c.vc = (int)xst[3]; } else xcd_barrier(xbar); } while (0)
#else
#define SEAM() grid.sync()
#endif
#else
#define SEAM() do { } while (0)
#endif
#ifdef ONLY_PHASE
#define IN(k) ((k) == ONLY_PHASE && p.ph_lo <= (k) && (k) < p.ph_hi)
#else
#define IN(k) (p.ph_lo <= (k) && (k) < p.ph_hi)
#endif
#define PHASE(k, ...) if (IN(k)) { for (int rep_ = 0; rep_ <= ((REPEAT_MASK >> (k)) & 1); ++rep_) { __VA_ARGS__; if (rep_ < ((REPEAT_MASK >> (k)) & 1)) SEAM(); } if (IN((k) + 1)) SEAM(); }
#if USE_PG8
#define GEMM2(A_, Bt_, K_, nrows1_, npn1_, nrows2_, npn2_, E_, ssq_) gemm_mfma(c.lds, c.vc, A_, Bt_, K_, nrows1_, npn1_, nrows2_, npn2_, E_, ssq_)
#else
#define GEMM2(A_, Bt_, K_, nrows1_, npn1_, nrows2_, npn2_, E_, ssq_) do { gemm_simple(c.lds, A_, Bt_, K_, 0, nrows1_, npn1_, E_, ssq_); if ((nrows2_) > 0) gemm_simple(c.lds, A_, Bt_, K_, nrows1_, nrows2_, npn2_, E_, ssq_); } while (0)
#endif
#define GEMM(A_, Bt_, K_, nrows_, npn_, E_, ssq_) GEMM2(A_, Bt_, K_, nrows_, npn_, 0, 0, E_, ssq_)
    PHASE(0, phase_prep(p, c))
    PHASE(1, phase_n1(p, c))
    PHASE(2, { EpiGateUp1 E{(bf16_t*)(ws + WS_HID)};
        GEMM((const bf16_t*)(ws + WS_N1), (const bf16_t*)(ws + WS_WG1_T), D, MT, NGU / 256, E, nullptr);
        VGrid g; if (filler_grid(g, c.vc, (MT / 256) * (NGU / 256))) { task_transposes_b(p, c, g); task_shift_gemv(p, c, g, 0); } })
    PHASE(3, { EpiDown1 E{(const bf16_t*)(ws + WS_HCB), modv, (bf16_t*)p.out, (bf16_t*)(ws + WS_A2)};
        GEMM((const bf16_t*)(ws + WS_HID), (const bf16_t*)(ws + WS_WD1_T), DFF, MT, D / 256, E, (float*)(ws + WS_SSQ1));
        VGrid g; if (filler_grid(g, c.vc, (MT / 256) * (D / 256))) { task_transposes_c(p, c, g); task_shift_gemv(p, c, g, 1); task_filters(p, c, g, 0, 192); } })
    PHASE(4, phase_rstd((const float*)(ws + WS_SSQ1), (float*)(ws + WS_RSTD1), MT, c))
    PHASE(5, { EpiWin E{(const float*)(ws + WS_RSTD1), (const float*)(ws + WS_SWIN), (const float*)(ws + WS_LBV), (bf16_t*)(ws + WS_V), (bf16_t*)(ws + WS_Q), (bf16_t*)(ws + WS_G), (bf16_t*)(ws + WS_HY), (bf16_t*)(ws + WS_GAB), (f16_t*)(ws + WS_LFW), (f16_t*)(ws + WS_LBW)};
        GEMM2((const bf16_t*)(ws + WS_A2), (const bf16_t*)(ws + WS_WIN_T), D, T, NIN / 256, TC, 6, E, nullptr);
        VGrid g; if (filler_grid(g, c.vc, (T / 256) * (NIN / 256) + (TC / 256) * 6)) task_filters(p, c, g, 192, 256); })
    PHASE(6, {
        { LAS float* scr = (LAS float*)(c.lds + c.wid * 8448);
          transpose_gu(p.ffn_wg + (size_t)D * DFF, 0, (bf16_t*)(ws + WS_WG2_T), scr, c.gw, c.ngw, c.lane);
          transpose_gu(p.ffn_wu + (size_t)D * DFF, 1, (bf16_t*)(ws + WS_WG2_T), scr, c.gw, c.ngw, c.lane);
          transpose_matrix(p.ffn_wd + (size_t)DFF * D, DFF, D, (bf16_t*)(ws + WS_WD2_T), scr, c.gw, c.ngw, c.lane); }
        __syncthreads();
        phase_hy_prepass(p, c); })
    PHASE(7, phase_hyena_mfma(p, c))
    PHASE(8, { if (USE_MFMA_HGRN) phase_hgrn_mfma(p, c); else phase_hgrn_simple(p, c); })
    PHASE(9, phase_combine(p, c))
    PHASE(10, { EpiProjA EA{(const bf16_t*)(ws + WS_GAB), (bf16_t*)(ws + WS_YTMP)}; EpiProjB EB{(const bf16_t*)(ws + WS_GAB), (const bf16_t*)(ws + WS_YTMP), (bf16_t*)(ws + WS_Y)};
        GEMM((const bf16_t*)(ws + WS_OA), (const bf16_t*)(ws + WS_WPA_T), 512, T, D / 256, EA, nullptr);
        GEMM((const bf16_t*)(ws + WS_OB), (const bf16_t*)(ws + WS_WPB_T), 512, T, D / 256, EB, nullptr); })
    PHASE(11, { EpiWout E{modv, (bf16_t*)p.out, (bf16_t*)(ws + WS_A3)};
        GEMM((const bf16_t*)(ws + WS_Y), (const bf16_t*)(ws + WS_WOUT_T), D, T, D / 256, E, (float*)(ws + WS_SSQ2)); })
    PHASE(12, phase_rstd((const float*)(ws + WS_SSQ2), (float*)(ws + WS_RSTD2), T, c))
    PHASE(13, { EpiGateUp2 E{(bf16_t*)(ws + WS_HID2), (const float*)(ws + WS_RSTD2), (const float*)(ws + WS_SW2)};
        GEMM((const bf16_t*)(ws + WS_A3), (const bf16_t*)(ws + WS_WG2_T), D, T, NGU / 256, E, nullptr); })
    PHASE(14, { EpiDown2 E{modv, (const bf16_t*)p.out, (bf16_t*)(ws + WS_H3)};
        GEMM((const bf16_t*)(ws + WS_HID2), (const bf16_t*)(ws + WS_WD2_T), DFF, T, D / 256, E, (float*)(ws + WS_SSQ3)); })
    PHASE(15, phase_final(p, c))
}

extern "C" void kernel_launch(void* const* d_in, const int* in_sizes, int n_in, void* d_out, int out_size, void* d_ws, size_t ws_size, hipStream_t stream) {
    static int grid = 0;
    if (grid == 0) {
        if (n_in != 26 || in_sizes[0] != T * D || out_size != T * D || ws_size < WS_TOTAL) { fprintf(stderr, "kernel_launch: unexpected shapes (n_in %d, in0 %d, out %d, ws %zu < %zu)\n", n_in, n_in > 0 ? in_sizes[0] : -1, out_size, ws_size, (size_t)WS_TOTAL); grid = -1; return; }
        int dev = 0, cus = 0, per_cu = 0;
        (void)hipGetDevice(&dev); (void)hipDeviceGetAttribute(&cus, hipDeviceAttributeMultiprocessorCount, dev);
        if (hipFuncSetAttribute((const void*)fwd_kernel, hipFuncAttributeMaxDynamicSharedMemorySize, LDS_BYTES) != hipSuccess) { fprintf(stderr, "kernel_launch: hipFuncSetAttribute failed\n"); grid = -1; return; }
        (void)hipOccupancyMaxActiveBlocksPerMultiprocessor(&per_cu, (const void*)fwd_kernel, NTHR, LDS_BYTES);
        if (per_cu < 1) { fprintf(stderr, "kernel_launch: occupancy query says %d blocks per CU\n", per_cu); per_cu = 1; }
        (void)hipGetLastError();
        grid = cus;
    }
    if (grid < 0) return;
    Params p{};
    const float** f = (const float**)&p;
    for (int i = 0; i < 26; ++i) f[i] = (const float*)d_in[i];
    p.out = (float*)d_out; p.ws = (unsigned char*)d_ws;
#if N_LAUNCH_MODE == 1
    p.ph_lo = 0; p.ph_hi = N_PHASES;
#if USE_XCD_BARRIER
    (void)hipMemsetAsync((unsigned char*)d_ws + WS_CTL, 0, XCD_BAR_WORDS * 4, stream);
#endif
    void* args[] = {&p};
    hipError_t e = hipLaunchCooperativeKernel((const void*)fwd_kernel, dim3(grid), dim3(NTHR), args, LDS_BYTES, stream);
    if (e != hipSuccess) fprintf(stderr, "cooperative launch failed: %s (grid %d)\n", hipGetErrorString(e), grid);
#else
    for (int k = 0; k < N_PHASES; ++k) { p.ph_lo = k; p.ph_hi = k + 1; for (int r = 0; r <= ((HOST_REPEAT_MASK >> k) & 1); ++r) hipLaunchKernelGGL(fwd_kernel, dim3(grid), dim3(NTHR), LDS_BYTES, stream, p); }
#endif
}
```

```cpp
#include <hip/hip_runtime.h>
#include <hip/hip_cooperative_groups.h>
#include <cstdio>
namespace cg = cooperative_groups;

#ifndef N_LAUNCH_MODE
#define N_LAUNCH_MODE 1
#endif
#ifndef USE_MFMA_HYENA
#define USE_MFMA_HYENA 1
#endif
#ifndef USE_MFMA_HGRN
#define USE_MFMA_HGRN 1
#endif
#ifndef PROBE_TS_MASK
#define PROBE_TS_MASK 0
#endif
#ifndef USE_PG8
#define USE_PG8 1
#endif

#define LAS __attribute__((address_space(3)))
typedef unsigned short bf16_t;
typedef _Float16 f16_t;
typedef float f32x4 __attribute__((ext_vector_type(4)));
typedef unsigned u32x4 __attribute__((ext_vector_type(4)));
typedef unsigned u32x2 __attribute__((ext_vector_type(2)));

constexpr int D = 1024, NB = 16, SEQ = 2048, T = NB * SEQ, CL = 256, TC = NB * CL, MT = T + TC;
constexpr int DFF = 2816, NGU = 2 * DFF, NIN = 6144, MODW = 9 * D;
constexpr int AKW = 512, AVW = 512, BW = 512, NHY = 3 * BW;
constexpr int KR_LEN = 4128, KR_OFF = 2056;
constexpr float RMS_EPS = 1e-6f;
constexpr int NTHR = 512, NWAVES = 8;
constexpr int LDS_BYTES = 152 * 1024;

constexpr size_t MiB = 1024 * 1024;
constexpr size_t al256(size_t x) { return (x + 255) & ~(size_t)255; }
constexpr size_t WS_CTL = 0;
constexpr size_t WS_MODV = WS_CTL + 65536;
constexpr size_t WS_SWIN = WS_MODV + al256((size_t)17 * MODW * 4);
constexpr size_t WS_SW2 = WS_SWIN + al256((size_t)17 * NIN * 4);
constexpr size_t WS_ER = WS_SW2 + al256((size_t)17 * NGU * 4);
constexpr size_t WS_EC = WS_ER + 32 * 512 * 4;
constexpr size_t WS_LBV = WS_EC + 64 * 512 * 4;
constexpr size_t WS_H2 = WS_LBV + 4096;
constexpr size_t WS_KREV = WS_H2 + 2048 * 64 * 4;
constexpr size_t WS_WIN_T = WS_KREV + al256((size_t)2 * 512 * KR_LEN * 2);
constexpr size_t WS_WPA_T = WS_WIN_T + (size_t)NIN * D * 2;
constexpr size_t WS_WPB_T = WS_WPA_T + (size_t)D * 512 * 2;
constexpr size_t WS_WOUT_T = WS_WPB_T + (size_t)D * 512 * 2;
constexpr size_t WS_RSTD1 = WS_WOUT_T + (size_t)D * D * 2;
constexpr size_t WS_RSTD2 = WS_RSTD1 + (size_t)MT * 4;
constexpr size_t WS_PERSIST_END = WS_RSTD2 + (size_t)T * 4;
constexpr size_t AR = 27 * MiB;
static_assert(WS_PERSIST_END <= AR, "persistent region");
constexpr size_t WS_HID = AR + 0 * MiB;
constexpr size_t WS_N1 = AR + 198 * MiB;
constexpr size_t WS_WG1_T = AR + 270 * MiB;
constexpr size_t WS_WD1_T = AR + 281 * MiB;
constexpr size_t WS_HCB = AR + 290 * MiB;
constexpr size_t WS_SSQ1 = AR + 286 * MiB + 512 * 1024;
constexpr size_t WS_A2 = AR + 413 * MiB;
constexpr size_t WS_GAB = AR + 0 * MiB;
constexpr size_t WS_V = AR + 128 * MiB;
constexpr size_t WS_LFW = AR + 164 * MiB;
constexpr size_t WS_LBW = AR + 200 * MiB;
constexpr size_t WS_Q = AR + 236 * MiB;
constexpr size_t WS_G = AR + 268 * MiB;
constexpr size_t WS_HY = AR + 300 * MiB;
constexpr size_t WS_WG2_T = AR + 396 * MiB;
constexpr size_t WS_WD2_T = AR + 407 * MiB;
constexpr size_t WS_ZB = AR + 453 * MiB;
constexpr size_t WS_OA = AR + 128 * MiB;
constexpr size_t WS_Y = AR + 320 * MiB;
constexpr size_t WS_A3 = AR + 0 * MiB;
constexpr size_t WS_SSQ2 = AR + 64 * MiB;
constexpr size_t WS_H3 = AR + 0 * MiB;
constexpr size_t WS_SSQ3 = AR + 66 * MiB;
constexpr size_t WS_HID2 = AR + 128 * MiB;
constexpr size_t WS_TOTAL = AR + 485 * MiB;

struct Params {
    const float *x, *c, *ctx, *c_ctx, *mod_w, *mod_b, *ffn_wg, *ffn_wu, *ffn_wd, *w_in, *lb_logits, *a_norm_w, *conv_w, *conv_b;
    const float *hw1, *hb1, *hfr1, *hw2, *hb2, *hfr2, *hw3, *hy_bias, *w_pa, *w_pb, *w_out, *fnw;
    float* out; unsigned char* ws;
    int ph_lo, ph_hi;
};

__device__ __forceinline__ float bf2f(bf16_t b) { return __uint_as_float(((unsigned)b) << 16); }
__device__ __forceinline__ bf16_t f2bf(float f) { unsigned u = __float_as_uint(f); u += 0x7FFFu + ((u >> 16) & 1u); return (bf16_t)(u >> 16); }
typedef float f32x2_t __attribute__((ext_vector_type(2)));
typedef __bf16 bf16x2_t __attribute__((ext_vector_type(2)));
__device__ __forceinline__ unsigned pk2(float lo, float hi) { const f32x2_t v = {lo, hi}; return __builtin_bit_cast(unsigned, __builtin_convertvector(v, bf16x2_t)); }
__device__ __forceinline__ float bfround(float f) { return bf2f(f2bf(f)); }
__device__ __forceinline__ float sigmoidf_(float x) { return __builtin_amdgcn_rcpf(1.0f + __builtin_amdgcn_exp2f(x * -1.4426950408889634f)); }
__device__ __forceinline__ float siluf_(float x) { return x * sigmoidf_(x); }
__device__ __forceinline__ float wave_sum(float v) {
#pragma unroll
    for (int o = 1; o < 64; o <<= 1) v += __shfl_xor(v, o);
    return v;
}
__device__ __forceinline__ float pos_embed(const float* er, const float* ec, int t, int col) {
    return col < 512 ? er[(t >> 6) * 512 + col] : ec[(t & 63) * 512 + (col - 512)];
}
__device__ __forceinline__ float rstd_from_ssq(const float* ssq16) {
    const f32x4* s = (const f32x4*)ssq16; float tot = 0.f;
#pragma unroll
    for (int i = 0; i < 4; ++i) { const f32x4 v = s[i]; tot += (v[0] + v[1]) + (v[2] + v[3]); }
    return __builtin_amdgcn_rsqf(tot * (1.0f / D) + RMS_EPS);
}

__device__ __forceinline__ void transpose_item(const float* W, int K, int N, bf16_t* WT, int k0, int n0, int dst_row0, LAS float* scr, int lane, int ldk = 0, int koff = 0) {
    if (ldk == 0) ldk = K;
#pragma unroll 8
    for (int i = 0; i < 32; ++i) { const int kk = 2 * i + (lane >> 5); scr[kk * 33 + (lane & 31)] = W[(size_t)(k0 + kk) * N + n0 + (lane & 31)]; }
    asm volatile("s_waitcnt lgkmcnt(0)" ::: "memory");
    const int c = lane & 7;
#pragma unroll
    for (int j = 0; j < 4; ++j) { const int n = (lane >> 3) + 8 * j; const LAS float* s = scr + (8 * c) * 33 + n;
        u32x4 o; o.x = pk2(s[0 * 33], s[1 * 33]); o.y = pk2(s[2 * 33], s[3 * 33]); o.z = pk2(s[4 * 33], s[5 * 33]); o.w = pk2(s[6 * 33], s[7 * 33]);
        *(u32x4*)(WT + (size_t)(dst_row0 + n) * ldk + koff + k0 + 8 * c) = o; }
    asm volatile("s_waitcnt lgkmcnt(0)" ::: "memory");
}
__device__ __forceinline__ void transpose_matrix(const float* W, int K, int N, bf16_t* WT, LAS float* scr, int gw, int ngw, int lane, int ldk = 0, int koff = 0) {
    const int nblk = N / 32, items = (K / 64) * nblk;
    for (int it = gw; it < items; it += ngw) { const int kb = it / nblk, nb = it % nblk; transpose_item(W, K, N, WT, 64 * kb, 32 * nb, 32 * nb, scr, lane, ldk, koff); }
}
__device__ __forceinline__ void transpose_gu(const float* W, int half, bf16_t* WT, LAS float* scr, int gw, int ngw, int lane) {
    const int nblk = DFF / 32, items = (D / 64) * nblk;
    for (int it = gw; it < items; it += ngw) { const int kb = it / nblk, nb = it % nblk, n0 = 32 * nb;
        transpose_item(W, D, DFF, WT, 64 * kb, n0, 256 * (n0 >> 7) + 128 * half + (n0 & 127), scr, lane); }
}

template <bool GU, bool DEEP = false>
__device__ __forceinline__ void gemv17(const LAS float* xs, LAS float* part, const float* W, int N, const float* bias, float* out, int ldo, int half, int blk0, int nblk_stride) {
    const int tid = threadIdx.x, wid = tid >> 6, lane = tid & 63;
    for (int cb = blk0; cb < N / 64; cb += nblk_stride) {
        const int n = cb * 64 + lane;
        float acc[17];
#pragma unroll
        for (int r = 0; r < 17; ++r) acc[r] = 0.f;
        const float* wp = W + (size_t)(wid * 128) * N + n;
        if constexpr (DEEP) {
#pragma unroll 1
            for (int k0 = 0; k0 < 128; k0 += 16) { float w[16];
#pragma unroll
                for (int j = 0; j < 16; ++j) w[j] = wp[(size_t)(k0 + j) * N];
#pragma unroll
                for (int j = 0; j < 16; ++j) {
#pragma unroll
                    for (int r = 0; r < 17; ++r) acc[r] += xs[r * 1024 + wid * 128 + k0 + j] * w[j];
                    asm volatile("" ::: "memory"); } }
        } else {
#pragma unroll 4
        for (int k = 0; k < 128; ++k) { const float w = wp[(size_t)k * N];
#pragma unroll
            for (int r = 0; r < 17; ++r) acc[r] += xs[r * 1024 + wid * 128 + k] * w; } }
#pragma unroll
        for (int r = 0; r < 17; ++r) part[(wid * 17 + r) * 64 + lane] = acc[r];
        __syncthreads();
        for (int o = tid; o < 17 * 64; o += NTHR) { const int r = o >> 6, l = o & 63; float s = 0.f;
#pragma unroll
            for (int w = 0; w < 8; ++w) s += part[(w * 17 + r) * 64 + l];
            const int nn = cb * 64 + l; if (bias) s += bias[nn];
            const int on = GU ? (256 * (nn >> 7) + 128 * half + (nn & 127)) : nn;
            out[(size_t)r * ldo + on] = s; }
        __syncthreads();
    }
}

__device__ __forceinline__ void store_bf16x8(bf16_t* p, const float (&v)[8]) { u32x4 w; w.x = pk2(v[0], v[1]); w.y = pk2(v[2], v[3]); w.z = pk2(v[4], v[5]); w.w = pk2(v[6], v[7]); __builtin_nontemporal_store(w, (u32x4*)p); }
__device__ __forceinline__ void load_f32x8(const float* p, float (&v)[8]) { const f32x4 a = *(const f32x4*)p, b = *(const f32x4*)(p + 4); v[0] = a[0]; v[1] = a[1]; v[2] = a[2]; v[3] = a[3]; v[4] = b[0]; v[5] = b[1]; v[6] = b[2]; v[7] = b[3]; }
__device__ __forceinline__ void store_f32x8(float* p, const float (&v)[8]) { *(f32x4*)p = (f32x4){v[0], v[1], v[2], v[3]}; *(f32x4*)(p + 4) = (f32x4){v[4], v[5], v[6], v[7]}; }
__device__ __forceinline__ void unpack_bf16x8(const u32x4 w, float (&v)[8]) { v[0] = __uint_as_float(w.x << 16); v[1] = __uint_as_float(w.x & 0xffff0000u); v[2] = __uint_as_float(w.y << 16); v[3] = __uint_as_float(w.y & 0xffff0000u);
    v[4] = __uint_as_float(w.z << 16); v[5] = __uint_as_float(w.z & 0xffff0000u); v[6] = __uint_as_float(w.w << 16); v[7] = __uint_as_float(w.w & 0xffff0000u); }
__device__ __forceinline__ void load_bf16x8(const bf16_t* p, float (&v)[8]) { const u32x4 w = *(const u32x4*)p; v[0] = __uint_as_float(w.x << 16); v[1] = __uint_as_float(w.x & 0xffff0000u); v[2] = __uint_as_float(w.y << 16); v[3] = __uint_as_float(w.y & 0xffff0000u);
    v[4] = __uint_as_float(w.z << 16); v[5] = __uint_as_float(w.z & 0xffff0000u); v[6] = __uint_as_float(w.w << 16); v[7] = __uint_as_float(w.w & 0xffff0000u); }

struct EpiGateUp1 {
    static constexpr int PD = 1;
    struct Cols {}; struct Row {};
    bf16_t* hid;
    __device__ __forceinline__ void load_cols(Cols&, int, int, int) const {}
    __device__ __forceinline__ void load_row(Row&, int, int, int) const {}
    __device__ __forceinline__ float finish(int row, int pn, int c, const float (&v0)[8], const float (&v1)[8], const Cols&, const Row&) const {
        float o[8];
#pragma unroll
        for (int j = 0; j < 8; ++j) o[j] = siluf_(v0[j]) * v1[j];
        store_bf16x8(hid + (size_t)row * DFF + 128 * pn + c, o); return 0.f; }
};
struct EpiGateUp2 {
    static constexpr int PD = 8;
    struct Cols { float s0[8], s1[8]; }; struct Row { float rs; };
    bf16_t* hid; const float* rstd; const float* sw;
    __device__ __forceinline__ void load_cols(Cols& k, int pm, int pn, int c) const { const int b = pm >> 3; load_f32x8(sw + (size_t)b * NGU + 256 * pn + c, k.s0); load_f32x8(sw + (size_t)b * NGU + 256 * pn + 128 + c, k.s1); }
    __device__ __forceinline__ void load_row(Row& r, int row, int, int) const { r.rs = rstd[row]; }
    static constexpr bool LDSPF = true;
    __device__ __forceinline__ void prefetch(LAS float* buf, int pm, int pn, int wr, int wc, int lane) const { const int b = pm >> 3, r0 = pm * 256 + wr * 64 + lane;
        __builtin_amdgcn_global_load_lds((const unsigned*)(rstd + r0), (LAS unsigned*)buf, 4, 0, 0);
        __builtin_amdgcn_global_load_lds((const unsigned*)(rstd + r0 + 128), (LAS unsigned*)(buf + 64), 4, 0, 0);
        __builtin_amdgcn_global_load_lds((const unsigned*)(sw + (size_t)b * NGU + 256 * pn + 128 * (lane >> 5) + 32 * wc + (lane & 31)), (LAS unsigned*)(buf + 128), 4, 0, 0); }
    __device__ __forceinline__ void lds_cols(Cols& k, const LAS float* buf, int fq) const {
#pragma unroll
        for (int j = 0; j < 8; ++j) { k.s0[j] = buf[128 + 8 * fq + j]; k.s1[j] = buf[160 + 8 * fq + j]; } }
    __device__ __forceinline__ float finish(int row, int pn, int c, const float (&v0)[8], const float (&v1)[8], const Cols& k, const Row& r) const {
        float o[8];
#pragma unroll
        for (int j = 0; j < 8; ++j) o[j] = siluf_(r.rs * v0[j] + k.s0[j]) * (r.rs * v1[j] + k.s1[j]);
        store_bf16x8(hid + (size_t)row * DFF + 128 * pn + c, o); return 0.f; }
};
struct EpiDown1 {
    static constexpr int PD = 4;
    struct Cols { float g0[8], g1[8], s0[8], s1[8]; }; struct Row { u32x4 b0, b1; };
    const bf16_t* hcb; const float* modv; bf16_t* hb; bf16_t* a2;
    __device__ __forceinline__ void load_cols(Cols& k, int pm, int pn, int c) const { const int b = pm < T / 256 ? (pm >> 3) : 16; const float* m = modv + (size_t)b * MODW + 256 * pn + c;
        load_f32x8(m + 2 * D, k.g0); load_f32x8(m + 2 * D + 128, k.g1); load_f32x8(m + 4 * D, k.s0); load_f32x8(m + 4 * D + 128, k.s1); }
    __device__ __forceinline__ void load_row(Row& r, int row, int pn, int c) const { const bf16_t* src = (row < T ? hb + (size_t)row * D : hcb + (size_t)(row - T) * D) + 256 * pn + c; r.b0 = *(const u32x4*)src; r.b1 = *(const u32x4*)(src + 128); }
    __device__ __forceinline__ float finish(int row, int pn, int c, const float (&v0)[8], const float (&v1)[8], const Cols& k, const Row& r) const {
        float b0[8], b1[8], h0[8], h1[8], a0[8], a1[8]; float s = 0.f; unpack_bf16x8(r.b0, b0); unpack_bf16x8(r.b1, b1);
#pragma unroll
        for (int j = 0; j < 8; ++j) { h0[j] = b0[j] + 0.5f * k.g0[j] * v0[j]; h1[j] = b1[j] + 0.5f * k.g1[j] * v1[j]; s += h0[j] * h0[j] + h1[j] * h1[j]; a0[j] = h0[j] * (1.0f + k.s0[j]); a1[j] = h1[j] * (1.0f + k.s1[j]); }
        const size_t o = (size_t)row * D + 256 * pn + c;
        if (row < T) { store_bf16x8(hb + o, h0); store_bf16x8(hb + o + 128, h1); }
        store_bf16x8(a2 + o, a0); store_bf16x8(a2 + o + 128, a1); return s; }
};
struct EpiWin {
    static constexpr int PD = 8;
    struct Cols { float s0[8], s1[8], l0[8], l1[8]; }; struct Row { float rs; };
    const float *rstd, *sw, *lbv; bf16_t *v, *q, *g, *hy, *gab; f16_t *lfw, *lbw;
    __device__ __forceinline__ void load_cols(Cols& k, int pm, int pn, int c) const { const int b = pm < T / 256 ? (pm >> 3) : 16; const int n = 256 * pn + c;
        load_f32x8(sw + (size_t)b * NIN + n, k.s0); load_f32x8(sw + (size_t)b * NIN + n + 128, k.s1);
        if (pn >= 2 && pn < 6) { load_f32x8(lbv + n - 512, k.l0); load_f32x8(lbv + n - 512 + 128, k.l1); } }
    __device__ __forceinline__ void load_row(Row& r, int row, int, int) const { r.rs = rstd[row]; }
    static constexpr bool LDSPF = true;
    __device__ __forceinline__ void prefetch(LAS float* buf, int pm, int pn, int wr, int wc, int lane) const { const int b = pm < T / 256 ? (pm >> 3) : 16, r0 = pm * 256 + wr * 64 + lane, n = 256 * pn + 128 * (lane >> 5) + 32 * wc + (lane & 31);
        __builtin_amdgcn_global_load_lds((const unsigned*)(rstd + r0), (LAS unsigned*)buf, 4, 0, 0);
        __builtin_amdgcn_global_load_lds((const unsigned*)(rstd + r0 + 128), (LAS unsigned*)(buf + 64), 4, 0, 0);
        __builtin_amdgcn_global_load_lds((const unsigned*)(sw + (size_t)b * NIN + n), (LAS unsigned*)(buf + 128), 4, 0, 0);
        if (pn >= 2 && pn < 6) __builtin_amdgcn_global_load_lds((const unsigned*)(lbv + n - 512), (LAS unsigned*)(buf + 192), 4, 0, 0); }
    __device__ __forceinline__ void lds_cols(Cols& k, const LAS float* buf, int fq) const {
#pragma unroll
        for (int j = 0; j < 8; ++j) { k.s0[j] = buf[128 + 8 * fq + j]; k.s1[j] = buf[160 + 8 * fq + j]; k.l0[j] = buf[192 + 8 * fq + j]; k.l1[j] = buf[224 + 8 * fq + j]; } }
    __device__ __forceinline__ void half_(int row, int n, float rs, const float (&a)[8], const float (&s)[8], const float (&lb)[8]) const {
        float p[8];
#pragma unroll
        for (int j = 0; j < 8; ++j) p[j] = rs * a[j] + s[j];
        const int grp = n >> 9;
        if (grp == 0) { store_bf16x8(v + (size_t)row * 512 + n, p); }
        else if (grp <= 2) { const int nn = n - 512 * grp; f16_t* dst = (grp == 1 ? lfw : lbw) + (size_t)row * 512 + nn; f16_t o[8];
#pragma unroll
            for (int j = 0; j < 8; ++j) { const float f = lb[j] + (1.0f - lb[j]) * sigmoidf_(p[j]); o[j] = (f16_t)(__builtin_amdgcn_logf(f) * 0.6931471805599453f); }
            *(u32x4*)dst = *(const u32x4*)o; }
        else if (grp == 3) {
#pragma unroll
            for (int j = 0; j < 8; ++j) p[j] = siluf_(p[j]);
            store_bf16x8(q + (size_t)row * 512 + (n - 1536), p); }
        else if (grp == 4) {
#pragma unroll
            for (int j = 0; j < 8; ++j) p[j] = siluf_(p[j]);
            store_bf16x8(g + (size_t)row * 512 + (n - 2048), p); }
        else if (grp <= 7) { const int ch = n - 2560, t = row & (SEQ - 1), b = row >> 11; store_bf16x8(hy + (((size_t)(ch >> 3) * NB + b) * SEQ + t) * 8, p); }
        else {
#pragma unroll
            for (int j = 0; j < 8; ++j) p[j] = fmaxf(sigmoidf_(p[j]), 1e-18f);
            store_bf16x8(gab + (size_t)row * 2048 + (n - 4096), p); }
    }
    __device__ __forceinline__ float finish(int row, int pn, int c, const float (&v0)[8], const float (&v1)[8], const Cols& k, const Row& r) const {
        half_(row, 256 * pn + c, r.rs, v0, k.s0, k.l0); half_(row, 256 * pn + 128 + c, r.rs, v1, k.s1, k.l1); return 0.f; }
};
struct EpiProj {
    static constexpr int PD = 4; static constexpr bool TWOSTAGE = true;
    struct Cols {}; struct Row { u32x4 g0, g1; };
    const bf16_t* gab; bf16_t* y;
    __device__ __forceinline__ void load_cols(Cols&, int, int, int) const {}
    __device__ __forceinline__ void load_row(Row& r, int row, int pn, int c) const { const bf16_t* src = gab + (size_t)row * 2048 + 1024 + 256 * pn + c; r.g0 = *(const u32x4*)src; r.g1 = *(const u32x4*)(src + 128); }
    __device__ __forceinline__ float finish(int row, int pn, int c, const float (&v0)[8], const float (&v1)[8], const Cols&, const Row& r) const {
        float g0[8], g1[8], o0[8], o1[8]; unpack_bf16x8(r.g0, g0); unpack_bf16x8(r.g1, g1);
#pragma unroll
        for (int j = 0; j < 8; ++j) { o0[j] = g0[j] * v0[j]; o1[j] = g1[j] * v1[j]; }
        bf16_t* dst = y + (size_t)row * D + 256 * pn + c; store_bf16x8(dst, o0); store_bf16x8(dst + 128, o1); return 0.f; }
    struct MRow { u32x4 a0, a1, b0, b1; };
    __device__ __forceinline__ void load_mid(MRow& r, int row, int pn, int c) const { const bf16_t* src = gab + (size_t)row * 2048 + 256 * pn + c; r.a0 = *(const u32x4*)src; r.a1 = *(const u32x4*)(src + 128); r.b0 = *(const u32x4*)(src + 1024); r.b1 = *(const u32x4*)(src + 1024 + 128); }
    __device__ __forceinline__ void scale_mid(float (&v0)[8], float (&v1)[8], const MRow& r) const { float a[8], bq[8];
        unpack_bf16x8(r.a0, a); unpack_bf16x8(r.b0, bq);
#pragma unroll
        for (int j = 0; j < 8; ++j) v0[j] *= a[j] * __builtin_amdgcn_rcpf(bq[j]);
        unpack_bf16x8(r.a1, a); unpack_bf16x8(r.b1, bq);
#pragma unroll
        for (int j = 0; j < 8; ++j) v1[j] *= a[j] * __builtin_amdgcn_rcpf(bq[j]); }
};
struct EpiWout {
    static constexpr int PD = 4;
    struct Cols { float g0[8], g1[8], s0[8], s1[8]; }; struct Row { u32x4 b0, b1; };
    const float* modv; bf16_t* hb; bf16_t* a3;
    __device__ __forceinline__ void load_cols(Cols& k, int pm, int pn, int c) const { const float* m = modv + (size_t)(pm >> 3) * MODW + 256 * pn + c;
        load_f32x8(m + 5 * D, k.g0); load_f32x8(m + 5 * D + 128, k.g1); load_f32x8(m + 7 * D, k.s0); load_f32x8(m + 7 * D + 128, k.s1); }
    __device__ __forceinline__ void load_row(Row& r, int row, int pn, int c) const { const bf16_t* src = hb + (size_t)row * D + 256 * pn + c; r.b0 = *(const u32x4*)src; r.b1 = *(const u32x4*)(src + 128); }
    __device__ __forceinline__ float finish(int row, int pn, int c, const float (&v0)[8], const float (&v1)[8], const Cols& k, const Row& r) const {
        float b0[8], b1[8], h0[8], h1[8], a0[8], a1[8]; float s = 0.f; unpack_bf16x8(r.b0, b0); unpack_bf16x8(r.b1, b1);
#pragma unroll
        for (int j = 0; j < 8; ++j) { h0[j] = b0[j] + k.g0[j] * v0[j]; h1[j] = b1[j] + k.g1[j] * v1[j]; s += h0[j] * h0[j] + h1[j] * h1[j]; a0[j] = h0[j] * (1.0f + k.s0[j]); a1[j] = h1[j] * (1.0f + k.s1[j]); }
        const size_t o = (size_t)row * D + 256 * pn + c;
        store_bf16x8(hb + o, h0); store_bf16x8(hb + o + 128, h1); store_bf16x8(a3 + o, a0); store_bf16x8(a3 + o + 128, a1); return s; }
};
struct EpiDown2 {
    static constexpr int PD = 4;
    struct Cols { float g0[8], g1[8]; }; struct Row { u32x4 b0, b1; };
    const float* modv; const bf16_t* hb; bf16_t* h3;
    __device__ __forceinline__ void load_cols(Cols& k, int pm, int pn, int c) const { const float* m = modv + (size_t)(pm >> 3) * MODW + 8 * D + 256 * pn + c; load_f32x8(m, k.g0); load_f32x8(m + 128, k.g1); }
    __device__ __forceinline__ void load_row(Row& r, int row, int pn, int c) const { const bf16_t* src = hb + (size_t)row * D + 256 * pn + c; r.b0 = *(const u32x4*)src; r.b1 = *(const u32x4*)(src + 128); }
    __device__ __forceinline__ float finish(int row, int pn, int c, const float (&v0)[8], const float (&v1)[8], const Cols& k, const Row& r) const {
        float b0[8], b1[8], h0[8], h1[8]; float s = 0.f; unpack_bf16x8(r.b0, b0); unpack_bf16x8(r.b1, b1);
#pragma unroll
        for (int j = 0; j < 8; ++j) { h0[j] = b0[j] + 0.5f * k.g0[j] * v0[j]; h1[j] = b1[j] + 0.5f * k.g1[j] * v1[j]; s += h0[j] * h0[j] + h1[j] * h1[j]; }
        const size_t o = (size_t)row * D + 256 * pn + c; store_bf16x8(h3 + o, h0); store_bf16x8(h3 + o + 128, h1); return s; }
};

template <class Epi>
__device__ __forceinline__ void gemm_simple(LAS unsigned char* lds, const bf16_t* A, const bf16_t* Bt, int K, int row0, int nrows, int npn, const Epi& E, float* ssq) {
    LAS float* As = (LAS float*)lds;
    LAS float* Bs = (LAS float*)(lds + 8192);
    const int tid = threadIdx.x, c8 = tid & 15, rg = tid >> 4;
    const int nrt = nrows / 64, nunits = nrt * npn;
    for (int unit = blockIdx.x; unit < nunits; unit += gridDim.x) {
        const int rt = unit / npn, pn = unit % npn, r0 = row0 + rt * 64;
        float a0[2][8], a1[2][8];
#pragma unroll
        for (int r = 0; r < 2; ++r)
#pragma unroll
            for (int j = 0; j < 8; ++j) { a0[r][j] = 0.f; a1[r][j] = 0.f; }
        for (int k0 = 0; k0 < K; k0 += 32) {
            { const int row = tid >> 3, kq = tid & 7; const u32x2 w = *(const u32x2*)(A + (size_t)(r0 + row) * K + k0 + 4 * kq);
              As[(4 * kq + 0) * 64 + row] = __uint_as_float(w.x << 16); As[(4 * kq + 1) * 64 + row] = __uint_as_float(w.x & 0xffff0000u);
              As[(4 * kq + 2) * 64 + row] = __uint_as_float(w.y << 16); As[(4 * kq + 3) * 64 + row] = __uint_as_float(w.y & 0xffff0000u); }
            { const int n = tid >> 1, kh = tid & 1; const bf16_t* src = Bt + (size_t)(pn * 256 + n) * K + k0 + 16 * kh; float t8[8];
              load_bf16x8(src, t8);
#pragma unroll
              for (int i = 0; i < 8; ++i) Bs[(16 * kh + i) * 256 + n] = t8[i];
              load_bf16x8(src + 8, t8);
#pragma unroll
              for (int i = 0; i < 8; ++i) Bs[(16 * kh + 8 + i) * 256 + n] = t8[i]; }
            __syncthreads();
#pragma unroll 8
            for (int k = 0; k < 32; ++k) {
                const float x0 = As[k * 64 + 2 * rg], x1 = As[k * 64 + 2 * rg + 1];
                const f32x4 b00 = *(const LAS f32x4*)(Bs + k * 256 + 8 * c8), b01 = *(const LAS f32x4*)(Bs + k * 256 + 8 * c8 + 4);
                const f32x4 b10 = *(const LAS f32x4*)(Bs + k * 256 + 128 + 8 * c8), b11 = *(const LAS f32x4*)(Bs + k * 256 + 128 + 8 * c8 + 4);
#pragma unroll
                for (int j = 0; j < 4; ++j) { a0[0][j] += x0 * b00[j]; a0[0][4 + j] += x0 * b01[j]; a1[0][j] += x0 * b10[j]; a1[0][4 + j] += x0 * b11[j];
                                              a0[1][j] += x1 * b00[j]; a0[1][4 + j] += x1 * b01[j]; a1[1][j] += x1 * b10[j]; a1[1][4 + j] += x1 * b11[j]; }
            }
            __syncthreads();
        }
#pragma unroll
        for (int r = 0; r < 2; ++r) { const int row = r0 + 2 * rg + r; typename Epi::Cols kc; typename Epi::Row kr; E.load_cols(kc, row >> 8, pn, 8 * c8); E.load_row(kr, row, pn, 8 * c8); float s = E.finish(row, pn, 8 * c8, a0[r], a1[r], kc, kr);
            s += __shfl_xor(s, 1); s += __shfl_xor(s, 2); s += __shfl_xor(s, 4); s += __shfl_xor(s, 8);
            if (ssq && c8 == 0) *(f32x4*)(ssq + (size_t)row * 16 + pn * 4) = (f32x4){s, 0.f, 0.f, 0.f}; }
    }
}

namespace pg8 {
#define PG8_LAS __attribute__((address_space(3)))
typedef unsigned short bf16_t;
typedef short bf16x8 __attribute__((ext_vector_type(8)));
typedef float f32x4 __attribute__((ext_vector_type(4)));
typedef unsigned u32x4 __attribute__((ext_vector_type(4)));
constexpr int BM = 256, BK = 64, HALF = 128, HTB = HALF * BK * 2  , STAGE_BYTES = 8 * HTB, NXCD = 8, WGM = 8;

__host__ __device__ __forceinline__ int lds_byte(int r, int c) { const int st = (r >> 4) * 2 + (c >> 5), rr = r & 15, cc = c & 31, ob = rr * 64 + cc * 2; return st * 1024 + (ob ^ (((ob >> 9) & 1) << 5)); }
__host__ __device__ __forceinline__ void stage_rc(int b, int& R, int& C) { const int st = b / 1024, sb = b % 1024, swz = sb ^ (((sb >> 9) & 1) << 5); R = (st >> 1) * 16 + swz / 64; C = (st & 1) * 32 + (swz % 64) / 2; }
__host__ __device__ __forceinline__ int perm32(int rho) { const int n = rho >> 4, i = rho & 15; return 8 * (i >> 2) + 4 * n + (i & 3); }

struct Unit { int pm, pn, ko, stage; };
struct Gemm { const bf16_t* A; const bf16_t* Bt; int M, N, K, ld; };

struct StaticOrder {
    int nM, nN, nwg, G, c;
    __host__ __device__ void init(int M, int N, int G_, int c_) { nM = M / BM; nN = N / BM; nwg = nM * nN; G = G_; c = c_; }
    __host__ __device__ bool next(int i, Unit& u) const {
        const long L = (long)i * G + c; if (L >= nwg) return false;
        int wgid = (int)L; { const int q = nwg / NXCD, r = nwg % NXCD, xcd = wgid % NXCD, off = wgid / NXCD; wgid = (xcd < r ? xcd * (q + 1) : r * (q + 1) + (xcd - r) * q) + off; }
        const int nig = WGM * nN, gid = wgid / nig, fm = gid * WGM, gsz = (nM - fm) < WGM ? (nM - fm) : WGM;
        u.pm = fm + ((wgid % nig) % gsz); u.pn = (wgid % nig) / gsz; u.ko = 0; u.stage = 0; return true;
    }
    __device__ __forceinline__ void a_ready(const Unit&) const {}
    __device__ __forceinline__ void done(const Unit&) const {}
};
template <class Epi, class Sched>
__device__ __forceinline__ void gemm_phase(PG8_LAS unsigned char* lds, const Gemm g, const Sched& S, const Epi& E) {
    const int tid = threadIdx.x, wid = __builtin_amdgcn_readfirstlane(tid >> 6), lane = tid & 63, wr = wid >> 2, wc = wid & 3, fr = lane & 15, fq = lane >> 4;
    const int K = g.K, nt = K / BK, ld = g.ld ? g.ld : g.K;
    unsigned voffA[2], voffB[2];
#pragma unroll
    for (int i = 0; i < 2; ++i) { int R, C; stage_rc(tid * 16 + i * 8192, R, C); const int Rb = Epi::PERM ? ((R & ~31) + perm32(R & 31)) : R;
        voffA[i] = (unsigned)(R * ld + C) * 2u; voffB[i] = (unsigned)(Rb * ld + C) * 2u; }
    const size_t kstep = (size_t)(BK * 2);
    const size_t hstep = (size_t)HALF * ld * 2;
    const size_t tstep = 2 * hstep;
    const unsigned ldsw = (unsigned)wid * 1024u;
    const int aoff = lds_byte(wr * 64 + fr, fq * 8), boff = lds_byte(wc * 32 + fr, fq * 8);
#define PG8_SA(b, h) (((b) * 2 + (h)) * HTB)
#define PG8_SB(b, h) ((4 + (b) * 2 + (h)) * HTB)
#define PG8_STAGE(bufoff, gbase, voff) do { _Pragma("unroll") for (int _i = 0; _i < 2; ++_i) \
        __builtin_amdgcn_global_load_lds((const unsigned*)((const char*)(gbase) + (voff)[_i]), (PG8_LAS unsigned*)(lds + (bufoff) + ldsw + _i * 8192), 16, 0, 0); } while (0)
#define PG8_LDA(dst, b, h) do { _Pragma("unroll") for (int m = 0; m < 4; ++m) _Pragma("unroll") for (int k = 0; k < 2; ++k) dst[m][k] = *(const PG8_LAS bf16x8*)(lds + PG8_SA(b, h) + aoff + m * 2048 + k * 1024); } while (0)
#define PG8_LDB(dst, b, h) do { _Pragma("unroll") for (int n = 0; n < 2; ++n) _Pragma("unroll") for (int k = 0; k < 2; ++k) dst[n][k] = *(const PG8_LAS bf16x8*)(lds + PG8_SB(b, h) + boff + n * 2048 + k * 1024); } while (0)
#define PG8_MMA(ai, bj, At, Bt) do { __builtin_amdgcn_s_setprio(1); _Pragma("unroll") for (int m = 0; m < 4; ++m) _Pragma("unroll") for (int n = 0; n < 2; ++n) _Pragma("unroll") for (int k = 0; k < 2; ++k) \
        acc[ai][bj][m][n] = __builtin_amdgcn_mfma_f32_16x16x32_bf16(Bt[n][k], At[m][k], acc[ai][bj][m][n], 0, 0, 0); __builtin_amdgcn_s_setprio(0); } while (0)
#define PG8_WAIT_V(n) asm volatile("s_waitcnt vmcnt(" #n ")" ::: "memory")
#define PG8_WAIT_L(n) asm volatile("s_waitcnt lgkmcnt(" #n ")" ::: "memory")
#define PG8_BAR __builtin_amdgcn_s_barrier()
#define PG8_SCHED __builtin_amdgcn_sched_barrier(0)
    Unit cur, nxt; int ui = 0;
    if (!S.next(0, cur)) return;
    f32x4 acc[2][2][4][2];
#pragma unroll
    for (int a = 0; a < 2; ++a)
#pragma unroll
        for (int b = 0; b < 2; ++b)
#pragma unroll
            for (int m = 0; m < 4; ++m)
#pragma unroll
                for (int n = 0; n < 2; ++n) acc[a][b][m][n] = (f32x4){0.f, 0.f, 0.f, 0.f};
    bf16x8 At[4][2], B0[2][2], B1[2][2];
    const char* cA = (const char*)g.A + (size_t)cur.pm * tstep + cur.ko; const char* cB = (const char*)g.Bt + (size_t)cur.pn * tstep + cur.ko;
    S.a_ready(cur);
    PG8_STAGE(PG8_SB(0, 0), cB, voffB); PG8_STAGE(PG8_SA(0, 0), cA, voffA); PG8_STAGE(PG8_SB(0, 1), cB + hstep, voffB); PG8_STAGE(PG8_SA(0, 1), cA + hstep, voffA);
    if (wr == 1) PG8_BAR;
    PG8_WAIT_V(4); PG8_BAR;
    PG8_STAGE(PG8_SB(1, 0), cB + kstep, voffB); PG8_STAGE(PG8_SA(1, 0), cA + kstep, voffA); PG8_STAGE(PG8_SB(1, 1), cB + hstep + kstep, voffB);
    PG8_WAIT_V(6); PG8_BAR;
    for (;;) {
        const bool has_next = S.next(ui + 1, nxt);
        const char* nA = has_next ? (const char*)g.A + (size_t)nxt.pm * tstep + nxt.ko : cA; const char* nB = has_next ? (const char*)g.Bt + (size_t)nxt.pn * tstep + nxt.ko : cB;
        for (int t = 0; t < nt; t += 2) {
            const bool last = (t == nt - 2);
            const char* a1 = cA + (size_t)(t + 1) * kstep;
            const char* a2 = last ? nA : cA + (size_t)(t + 2) * kstep; const char* b2 = last ? nB : cB + (size_t)(t + 2) * kstep;
            const char* a3 = a2 + kstep; const char* b3 = b2 + kstep;
            if constexpr (Epi::LDSPF) { if (last) E.prefetch(cur, wr, wc, lane); }
            if (last && has_next) S.a_ready(nxt);
            PG8_LDB(B0, 0, 0); PG8_SCHED; PG8_LDA(At, 0, 0); PG8_STAGE(PG8_SA(1, 1), a1 + hstep, voffA);
            PG8_WAIT_L(8); PG8_BAR; PG8_WAIT_L(0); PG8_MMA(0, 0, At, B0); PG8_BAR; PG8_SCHED;
            PG8_LDB(B1, 0, 1); PG8_STAGE(PG8_SB(0, 0), b2, voffB);
            PG8_BAR; PG8_WAIT_L(0); PG8_MMA(0, 1, At, B1); PG8_BAR;
            PG8_LDA(At, 0, 1); PG8_STAGE(PG8_SA(0, 0), a2, voffA);
            PG8_BAR; PG8_WAIT_L(0); PG8_MMA(1, 0, At, B0); PG8_BAR; PG8_SCHED;
            PG8_STAGE(PG8_SB(0, 1), b2 + hstep, voffB);
            PG8_WAIT_V(6); PG8_BAR; PG8_MMA(1, 1, At, B1); PG8_BAR;
            PG8_LDB(B0, 1, 0); PG8_SCHED; PG8_LDA(At, 1, 0); PG8_STAGE(PG8_SA(0, 1), a2 + hstep, voffA);
            PG8_WAIT_L(8); PG8_BAR; PG8_WAIT_L(0); PG8_MMA(0, 0, At, B0); PG8_BAR; PG8_SCHED;
            PG8_LDB(B1, 1, 1); PG8_STAGE(PG8_SB(1, 0), b3, voffB);
            PG8_BAR; PG8_WAIT_L(0); PG8_MMA(0, 1, At, B1); PG8_BAR;
            PG8_LDA(At, 1, 1); PG8_STAGE(PG8_SA(1, 0), a3, voffA);
            PG8_BAR; PG8_WAIT_L(0); PG8_MMA(1, 0, At, B0); PG8_BAR; PG8_SCHED;
            PG8_STAGE(PG8_SB(1, 1), b3 + hstep, voffB);
            PG8_WAIT_V(6); PG8_BAR; PG8_MMA(1, 1, At, B1); PG8_BAR;
        }
        const bool keep = Epi::TWOSTAGE && cur.stage == 1;
        if constexpr (!Epi::AFTER_DRAIN) { if (keep) E.mid(acc, cur, wr, wc, fr, fq); else E(acc, cur, wr, wc, fr, fq); S.done(cur); }
        if (!has_next) break;
        if (!keep)
#pragma unroll
        for (int a = 0; a < 2; ++a)
#pragma unroll
            for (int b = 0; b < 2; ++b)
#pragma unroll
                for (int m = 0; m < 4; ++m)
#pragma unroll
                    for (int n = 0; n < 2; ++n) acc[a][b][m][n] = (f32x4){0.f, 0.f, 0.f, 0.f};
        cur = nxt; cA = nA; cB = nB; ++ui;
    }
    PG8_WAIT_V(0);
    if (wr == 0) PG8_BAR;
    PG8_BAR;
    if constexpr (Epi::AFTER_DRAIN) { E.fused(acc, cur, wr, wc, fr, fq, lds, wid, lane); S.done(cur); }
#undef PG8_SA
#undef PG8_SB
#undef PG8_STAGE
#undef PG8_LDA
#undef PG8_LDB
#undef PG8_MMA
#undef PG8_WAIT_V
#undef PG8_WAIT_L
#undef PG8_BAR
#undef PG8_SCHED
}
}

template <class F, class = void> struct has_twostage { static constexpr bool value = false; };
template <class F> struct has_twostage<F, decltype((void)F::TWOSTAGE)> { static constexpr bool value = F::TWOSTAGE; };
template <class F, class = void> struct has_ldspf { static constexpr bool value = false; };
template <class F> struct has_ldspf<F, decltype((void)F::LDSPF)> { static constexpr bool value = F::LDSPF; };
template <class F> struct EpiAd {
    static constexpr bool PERM = true, AFTER_DRAIN = false, TWOSTAGE = has_twostage<F>::value, LDSPF = has_ldspf<F>::value;
    __device__ __forceinline__ void prefetch(const pg8::Unit& u, int wr, int wc, int lane) const { if constexpr (LDSPF) f.prefetch(pfbuf, u.pm, u.pn, wr, wc, lane); }
    __device__ __forceinline__ void mid(pg8::f32x4 (&acc)[2][2][4][2], const pg8::Unit& u, int wr, int wc, int fr, int fq) const {
        if constexpr (TWOSTAGE) { constexpr int PD = 2;
            const int c = wc * 32 + 8 * fq, row0 = u.pm * 256 + wr * 64 + fr;
            typename F::MRow rd[PD];
#pragma unroll
            for (int s = 0; s < PD; ++s) f.load_mid(rd[s], row0 + (s >> 2) * 128 + (s & 3) * 16, u.pn, c);
#pragma unroll
            for (int s = 0; s < 8; ++s) { const int ai = s >> 2, m = s & 3; float v0[8], v1[8];
#pragma unroll
                for (int n = 0; n < 2; ++n)
#pragma unroll
                    for (int e = 0; e < 4; ++e) { v0[4 * n + e] = acc[ai][0][m][n][e]; v1[4 * n + e] = acc[ai][1][m][n][e]; }
                f.scale_mid(v0, v1, rd[s % PD]);
#pragma unroll
                for (int n = 0; n < 2; ++n)
#pragma unroll
                    for (int e = 0; e < 4; ++e) { acc[ai][0][m][n][e] = v0[4 * n + e]; acc[ai][1][m][n][e] = v1[4 * n + e]; }
                if (s + PD < 8) f.load_mid(rd[s % PD], row0 + ((s + PD) >> 2) * 128 + ((s + PD) & 3) * 16, u.pn, c); } } }
    F f; float* ssq;
    LAS float* pfbuf = nullptr;
    __device__ __forceinline__ void operator()(const pg8::f32x4 (&acc)[2][2][4][2], const pg8::Unit& u, int wr, int wc, int fr, int fq) const {
        constexpr int PD = F::PD;
        const int c = wc * 32 + 8 * fq, row0 = u.pm * 256 + wr * 64 + fr;
        typename F::Cols cols; typename F::Row rd[PD];
        if constexpr (LDSPF) { f.lds_cols(cols, pfbuf, fq);
#pragma unroll
            for (int s = 0; s < 8; ++s) rd[s].rs = pfbuf[64 * (s >> 2) + 16 * (s & 3) + fr]; }
        else { f.load_cols(cols, u.pm, u.pn, c);
#pragma unroll
            for (int s = 0; s < PD; ++s) f.load_row(rd[s], row0 + (s >> 2) * 128 + (s & 3) * 16, u.pn, c); }
#pragma unroll
        for (int s = 0; s < 8; ++s) { const int ai = s >> 2, m = s & 3, row = row0 + ai * 128 + m * 16;
            float v0[8], v1[8];
#pragma unroll
            for (int n = 0; n < 2; ++n)
#pragma unroll
                for (int e = 0; e < 4; ++e) { v0[4 * n + e] = acc[ai][0][m][n][e]; v1[4 * n + e] = acc[ai][1][m][n][e]; }
            float sq = f.finish(row, u.pn, c, v0, v1, cols, rd[s % PD]);
            if (ssq) { sq += __shfl_xor(sq, 16); sq += __shfl_xor(sq, 32); if (fq == 0) ssq[(size_t)row * 16 + u.pn * 4 + wc] = sq; }
            if constexpr (!LDSPF) { if (s + PD < 8) f.load_row(rd[s % PD], row0 + ((s + PD) >> 2) * 128 + ((s + PD) & 3) * 16, u.pn, c); } }
    }
};
struct TwoPartOrder {
    pg8::StaticOrder s1; int n1, nM1, nM2, n2, G, c;
    __device__ void init(int nM1_, int nN1, int nM2_, int nN2, int G_, int c_) { s1.init(nM1_ * 256, nN1 * 256, G_, c_); n1 = nM1_ * nN1; nM1 = nM1_; nM2 = nM2_; n2 = nM2_ * nN2; G = G_; c = c_; }
    __device__ bool next(int i, pg8::Unit& u) const { long L = (long)i * G + c; if (L < n1) return s1.next(i, u); L -= n1; if (L >= n2) return false; u.pm = nM1 + (int)(L % nM2); u.pn = (int)(L / nM2); u.ko = 0; u.stage = 0; return true; }
    __device__ __forceinline__ void a_ready(const pg8::Unit&) const {}
    __device__ __forceinline__ void done(const pg8::Unit&) const {}
};
struct PairOrder {
    pg8::StaticOrder s1; int kbytes;
    __device__ void init(int M, int N, int G_, int c_, int kbytes_) { s1.init(M, N, G_, c_); kbytes = kbytes_; }
    __device__ bool next(int i, pg8::Unit& u) const { if (!s1.next(i >> 1, u)) return false; u.stage = (i & 1) ? 0 : 1; u.ko = (i & 1) ? kbytes : 0; return true; }
    __device__ __forceinline__ void a_ready(const pg8::Unit&) const {}
    __device__ __forceinline__ void done(const pg8::Unit&) const {}
};
template <class F>
__device__ __forceinline__ void gemm_pair(LAS unsigned char* lds, int vc, const bf16_t* A, const bf16_t* Bt, int Khalf, int nrows, int npn, const F& f) {
    __syncthreads();
    pg8::Gemm g{A, Bt, nrows, npn * 256, Khalf, 2 * Khalf}; PairOrder S; S.init(nrows, npn * 256, (int)gridDim.x, vc, Khalf * 2);
    EpiAd<F> E{f, nullptr}; E.pfbuf = (LAS float*)(lds + pg8::STAGE_BYTES) + 256 * __builtin_amdgcn_readfirstlane(threadIdx.x >> 6);
    pg8::gemm_phase(lds, g, S, E);
    __syncthreads();
}
template <class F>
__device__ __forceinline__ void gemm_mfma(LAS unsigned char* lds, int vc, const bf16_t* A, const bf16_t* Bt, int K, int nrows1, int npn1, int nrows2, int npn2, const F& f, float* ssq) {
    __syncthreads();
    pg8::Gemm g{A, Bt, nrows1 + nrows2, npn1 * 256, K, 0}; TwoPartOrder S; S.init(nrows1 / 256, npn1, nrows2 / 256, npn2, (int)gridDim.x, vc);
    EpiAd<F> E{f, ssq}; E.pfbuf = (LAS float*)(lds + pg8::STAGE_BYTES) + 256 * __builtin_amdgcn_readfirstlane(threadIdx.x >> 6);
    pg8::gemm_phase(lds, g, S, E);
    __syncthreads();
}

struct Ctx { LAS unsigned char* lds; int tid, lane, wid, gw, ngw, vc; };

struct VGrid { int vb, nvb; };
__device__ __forceinline__ void task_transposes_a(const Params& p, const Ctx& c, VGrid g) {
    LAS float* scr = (LAS float*)(c.lds + c.wid * 8448); const int gw = g.vb * NWAVES + c.wid, ngw = g.nvb * NWAVES;
    transpose_gu(p.ffn_wg, 0, (bf16_t*)(p.ws + WS_WG1_T), scr, gw, ngw, c.lane);
    transpose_gu(p.ffn_wu, 1, (bf16_t*)(p.ws + WS_WG1_T), scr, gw, ngw, c.lane);
}
__device__ __forceinline__ void task_transposes_b(const Params& p, const Ctx& c, VGrid g) {
    LAS float* scr = (LAS float*)(c.lds + c.wid * 8448); const int gw = g.vb * NWAVES + c.wid, ngw = g.nvb * NWAVES;
    transpose_matrix(p.ffn_wd, DFF, D, (bf16_t*)(p.ws + WS_WD1_T), scr, gw, ngw, c.lane);
    transpose_matrix(p.w_in, D, NIN, (bf16_t*)(p.ws + WS_WIN_T), scr, gw, ngw, c.lane);
}
__device__ __forceinline__ void task_transposes_c(const Params& p, const Ctx& c, VGrid g) {
    LAS float* scr = (LAS float*)(c.lds + c.wid * 8448); const int gw = g.vb * NWAVES + c.wid, ngw = g.nvb * NWAVES;
    transpose_matrix(p.w_pa, 512, D, (bf16_t*)(p.ws + WS_WPA_T), scr, gw, ngw, c.lane, 1024, 0);
    transpose_matrix(p.w_pb, 512, D, (bf16_t*)(p.ws + WS_WPA_T), scr, gw, ngw, c.lane, 1024, 512);
    transpose_matrix(p.w_out, D, D, (bf16_t*)(p.ws + WS_WOUT_T), scr, gw, ngw, c.lane);
}
__device__ __forceinline__ void task_transposes_d(const Params& p, const Ctx& c, VGrid g) {
    LAS float* scr = (LAS float*)(c.lds + c.wid * 8448); const int gw = g.vb * NWAVES + c.wid, ngw = g.nvb * NWAVES;
    transpose_gu(p.ffn_wg + (size_t)D * DFF, 0, (bf16_t*)(p.ws + WS_WG2_T), scr, gw, ngw, c.lane);
    transpose_gu(p.ffn_wu + (size_t)D * DFF, 1, (bf16_t*)(p.ws + WS_WG2_T), scr, gw, ngw, c.lane);
    transpose_matrix(p.ffn_wd + (size_t)DFF * D, DFF, D, (bf16_t*)(p.ws + WS_WD2_T), scr, gw, ngw, c.lane);
}
__device__ __forceinline__ void task_modv(const Params& p, const Ctx& c, VGrid g) {
    if (g.vb < MODW / 64) {
        LAS float* xs = (LAS float*)c.lds; LAS float* part = (LAS float*)(c.lds + 17 * 1024 * 4);
        __syncthreads();
        for (int i = c.tid; i < 17 * 1024; i += NTHR) { const int r = i >> 10, k = i & 1023; const float v = r < 16 ? p.c[r * D + k] : p.c_ctx[k]; xs[i] = v / (1.0f + expf(-v)); }
        __syncthreads();
        gemv17<false, true>(xs, part, p.mod_w, MODW, p.mod_b, (float*)(p.ws + WS_MODV), MODW, 0, g.vb, g.nvb);
    }
}
__device__ __forceinline__ void task_tables(const Params& p, const Ctx& c, VGrid g) {
    float* er = (float*)(p.ws + WS_ER); float* ec = (float*)(p.ws + WS_EC); float* lbv = (float*)(p.ws + WS_LBV);
    const int gt = g.vb * NTHR + c.tid, ngt = g.nvb * NTHR;
    for (int i = gt; i < 96 * 512; i += ngt) { const int r = i >> 9, j = i & 511, jj = j & 255; const float omega = 1.0f / powf(10000.0f, (float)jj / 256.0f);
        const int pos = r < 32 ? r : r - 32; const float a = (float)pos * omega; const float v = j < 256 ? sinf(a) : cosf(a);
        if (r < 32) er[r * 512 + j] = v; else ec[(r - 32) * 512 + j] = v; }
    for (int i = gt; i < 1024; i += ngt) { const float l0 = p.lb_logits[i], l1 = p.lb_logits[1024 + i]; lbv[i] = 1.0f / (1.0f + expf(l1 - l0)); }
}
__device__ __forceinline__ void task_h2(const Params& p, const Ctx& c, VGrid g) {
    LAS float* zf = (LAS float*)c.lds; LAS float* h1 = zf + 8 * 40; float* h2o = (float*)(p.ws + WS_H2);
    for (int it = g.vb; it < SEQ / 8; it += g.nvb) {
        __syncthreads();
        if (c.tid < 8 * 33) { const int r = c.tid / 33, f = c.tid % 33; const int pp = it * 8 + r; float v;
            if (f == 0) v = (float)pp / (float)(SEQ - 1);
            else { const int i = (f - 1) & 15; const float w = 6.283185307179586f * (float)pp / (float)SEQ; const float fr = 1e-4f + (float)i * ((15.0f - 1e-4f) / 15.0f); const float ang = w * fr; v = f <= 16 ? cosf(ang) : -sinf(ang); }
            zf[r * 40 + f] = v; }
        __syncthreads();
        { const int r = c.tid >> 6, j = c.tid & 63; float s = p.hb1[j];
#pragma unroll 3
          for (int f = 0; f < 33; ++f) s += zf[r * 40 + f] * p.hw1[f * 64 + j];
          h1[r * 64 + j] = sinf(p.hfr1[j] * s); }
        __syncthreads();
        { const int r = c.tid >> 6, j = c.tid & 63; float s = p.hb2[j];
#pragma unroll 4
          for (int k = 0; k < 64; ++k) s += h1[r * 64 + k] * p.hw2[k * 64 + j];
          h2o[(size_t)(it * 8 + r) * 64 + j] = sinf(p.hfr2[j] * s); }
    }
}
__device__ __forceinline__ void task_shift_gemv(const Params& p, const Ctx& c, VGrid g, int which) {
    const float* modv = (const float*)(p.ws + WS_MODV);
    LAS float* xs = (LAS float*)c.lds; LAS float* part = (LAS float*)(c.lds + 17 * 1024 * 4);
    const int nb_in = NIN / 64, nb_g = DFF / 64, nblk = which == 0 ? nb_in : 2 * nb_g;
    if (g.vb >= nblk) return;
    __syncthreads();
    for (int i = c.tid; i < 17 * 1024; i += NTHR) xs[i] = modv[(size_t)(i >> 10) * MODW + (which == 0 ? 3 : 6) * D + (i & 1023)];
    __syncthreads();
    for (int bx = g.vb; bx < nblk; bx += g.nvb) {
        if (which == 0) gemv17<false>(xs, part, p.w_in, NIN, nullptr, (float*)(p.ws + WS_SWIN), NIN, 0, bx, nb_in);
        else { const int half = bx / nb_g, blk = bx % nb_g; const float* W = (half ? p.ffn_wu : p.ffn_wg) + (size_t)D * DFF;
            gemv17<true>(xs, part, W, DFF, nullptr, (float*)(p.ws + WS_SW2), NGU, half, blk, nb_g); }
    }
}
__device__ __forceinline__ void task_filters(const Params& p, const Ctx& c, VGrid g, int item0, int item1) {
    LAS float* w3s = (LAS float*)c.lds;
    LAS float* hk = w3s + 512;
    LAS float* red = hk + 2048 * 8;
    const float* h2 = (const float*)(p.ws + WS_H2); bf16_t* krev = (bf16_t*)(p.ws + WS_KREV);
    for (int it = item0 + g.vb; it < item1; it += g.nvb) {
        const int c0 = 2 * it;
        __syncthreads();
        { const int k = c.tid >> 3, q = c.tid & 7; w3s[c.tid] = p.hw3[(size_t)k * 2048 + (q >> 2) * 1024 + ((q >> 1) & 1) * 512 + c0 + (q & 1)]; }
        __syncthreads();
        float l1 = 0.f;
        for (int idx = c.tid; idx < 2048 * 8; idx += NTHR) { const int t = idx >> 3, q = idx & 7; float s = 0.f;
            const float* hr = h2 + (size_t)t * 64;
#pragma unroll 8
            for (int k = 0; k < 64; ++k) s += hr[k] * w3s[k * 8 + q];
            const int ch = c0 + (q & 1); const float delta = fabsf(-3.0701134573253945f + (float)ch * ((-15.350567286626973f + 3.0701134573253945f) / 511.0f));
            const float tn = (float)t / (float)(SEQ - 1); s *= expf(-tn * delta) + 0.05f;
            hk[idx] = s; l1 += fabsf(s); }
        { float s = l1; s += __shfl_xor(s, 2); s += __shfl_xor(s, 8); s += __shfl_xor(s, 16); s += __shfl_xor(s, 32);
          if ((c.lane & ~5) == 0) red[c.wid * 4 + ((c.lane >> 2) & 1) * 2 + (c.lane & 1)] = s; }
        __syncthreads();
        for (int e = c.tid; e < 4 * KR_LEN; e += NTHR) { const int oc = e / KR_LEN, i = (e % KR_LEN) - KR_OFF, o = oc >> 1, cc = oc & 1;
            float tot = 0.f;
#pragma unroll
            for (int w = 0; w < 8; ++w) tot += red[w * 4 + oc];
            const int lag = -i; float v = 0.f;
            if (lag >= 0 && lag <= SEQ - 1) v = hk[lag * 8 + o * 4 + 0 + cc]; else if (lag < 0 && lag >= -(SEQ - 1)) v = hk[(-lag - 1) * 8 + o * 4 + 2 + cc];
            krev[((size_t)o * 512 + c0 + cc) * KR_LEN + (e % KR_LEN)] = f2bf(v / (tot + 1e-6f)); }
    }
}
__device__ __forceinline__ void phase_prep(const Params& p, const Ctx& c) {
    const int G = (int)gridDim.x, nmod = MODW / 64;
    if (G >= nmod + 32) {
        if ((int)blockIdx.x < nmod) task_modv(p, c, VGrid{(int)blockIdx.x, nmod});
        else { const VGrid g{(int)blockIdx.x - nmod, G - nmod}; task_transposes_a(p, c, g); task_tables(p, c, g); task_h2(p, c, g); }
    } else { const VGrid g{(int)blockIdx.x, G}; task_transposes_a(p, c, g); task_modv(p, c, g); task_tables(p, c, g); task_h2(p, c, g); }
}
__device__ __forceinline__ void phase_n1(const Params& p, const Ctx& c) {
    unsigned char* ws = p.ws;
    const float* modv = (const float*)(ws + WS_MODV); const float* er = (const float*)(ws + WS_ER); const float* ec = (const float*)(ws + WS_EC);
    bf16_t* n1 = (bf16_t*)(ws + WS_N1);
    constexpr int NR = 4;
    for (int row0 = NR * c.gw; row0 < MT; row0 += NR * c.ngw) {
        f32x4 v[NR][4]; const bool lat = row0 < T; const int b = lat ? (row0 >> 11) : 16;
#pragma unroll
        for (int r = 0; r < NR; ++r) { const int row = row0 + r; const int t = row & (SEQ - 1);
            const float* src = lat ? p.x + (size_t)row * D : p.ctx + (size_t)(row - T) * D;
#pragma unroll
            for (int j = 0; j < 4; ++j) { const int col = 4 * c.lane + 256 * j; v[r][j] = __builtin_nontemporal_load((const f32x4*)(src + col));
                if (lat) { const float* pe = col < 512 ? er + (t >> 6) * 512 + col : ec + (t & 63) * 512 + (col - 512); v[r][j] += *(const f32x4*)pe; } } }
        f32x4 sh[4], sc[4];
#pragma unroll
        for (int j = 0; j < 4; ++j) { const int col = 4 * c.lane + 256 * j; sh[j] = *(const f32x4*)(modv + (size_t)b * MODW + col); sc[j] = *(const f32x4*)(modv + (size_t)b * MODW + D + col) + 1.0f; }
#pragma unroll
        for (int r = 0; r < NR; ++r) { const int row = row0 + r;
            float ss = 0.f;
#pragma unroll
            for (int j = 0; j < 4; ++j) ss += (v[r][j][0] * v[r][j][0] + v[r][j][1] * v[r][j][1]) + (v[r][j][2] * v[r][j][2] + v[r][j][3] * v[r][j][3]);
            const float rs = __builtin_amdgcn_rsqf(wave_sum(ss) * (1.0f / D) + RMS_EPS);
            bf16_t* hdst = lat ? (bf16_t*)p.out + (size_t)row * D : (bf16_t*)(ws + WS_HCB) + (size_t)(row - T) * D;
#pragma unroll
            for (int j = 0; j < 4; ++j) { const int col = 4 * c.lane + 256 * j; u32x2 w; w.x = pk2(v[r][j][0], v[r][j][1]); w.y = pk2(v[r][j][2], v[r][j][3]); *(u32x2*)(hdst + col) = w;
                const f32x4 o = v[r][j] * rs * sc[j] + sh[j]; u32x2 w2; w2.x = pk2(o[0], o[1]); w2.y = pk2(o[2], o[3]); *(u32x2*)(n1 + (size_t)row * D + col) = w2; } }
    }
}
__device__ __forceinline__ bool filler_grid(VGrid& g, int vc, int nunits) {
    const int G = (int)gridDim.x, rem = nunits % G;
    if (rem == 0) { g.vb = vc; g.nvb = G; return true; }
    if (vc < rem) return false;
    g.vb = vc - rem; g.nvb = G - rem; return true;
}

__device__ __forceinline__ void phase_hgrn_simple(const Params& p, const Ctx& c) {
    unsigned char* ws = p.ws;
    const bf16_t* vb = (const bf16_t*)(ws + WS_V); const bf16_t* qb = (const bf16_t*)(ws + WS_Q);
    LAS float* F = (LAS float*)c.lds; LAS float* Kk = F + 64 * 128; LAS float* Q = Kk + 64 * 128; LAS float* V = Q + 64 * 128;
    const int dg = c.tid & 3, e = c.tid >> 2;
    for (int it = blockIdx.x; it < NB * 4 * 2; it += gridDim.x) {
        const int dir = it & 1, h = (it >> 1) & 3, b = it >> 3;
        const f16_t* lf = (const f16_t*)(ws + (dir ? WS_LBW : WS_LFW)); bf16_t* outp = ((bf16_t*)p.out + (size_t)T * D + (dir ? (size_t)T * 512 : 0));
        float S[32];
#pragma unroll
        for (int i = 0; i < 32; ++i) S[i] = 0.f;
        for (int ci = 0; ci < 36; ++ci) {
            const bool lat = ci >= 4;
            __syncthreads();
            for (int idx = c.tid; idx < 64 * 128; idx += NTHR) { const int j = idx >> 7, d = idx & 127; const int pp = (lat ? ci - 4 : ci) * 64 + j;
                const int row = lat ? b * SEQ + (dir ? SEQ - 1 - pp : pp) : T + b * CL + (dir ? CL - 1 - pp : pp);
                const float f = __expf((float)lf[(size_t)row * 512 + h * 128 + d]);
                F[idx] = f; Kk[idx] = 1.0f - f; V[idx] = bf2f(vb[(size_t)row * 512 + h * 128 + d]); Q[idx] = lat ? bf2f(qb[(size_t)row * 512 + h * 128 + d]) : 0.f; }
            __syncthreads();
            for (int j = 0; j < 64; ++j) { const float ve = V[j * 128 + e]; float part = 0.f;
#pragma unroll
                for (int i = 0; i < 32; ++i) { const int d = dg * 32 + i; S[i] = F[j * 128 + d] * S[i] + Kk[j * 128 + d] * ve; part += S[i] * Q[j * 128 + d]; }
                part += __shfl_xor(part, 1); part += __shfl_xor(part, 2);
                if (lat && dg == 0) { const int pp = (ci - 4) * 64 + j; const int row = b * SEQ + (dir ? SEQ - 1 - pp : pp); outp[(size_t)row * 512 + h * 128 + e] = f2bf(part); } }
        }
    }
}


typedef short bf16x8 __attribute__((ext_vector_type(8)));
constexpr int QROW = 136, TROW = 72;
__device__ __forceinline__ int hg_pos(int x) { return (x & ~31) + ((x >> 2) & 3) * 8 + ((x >> 4) & 1) * 4 + (x & 3); }
__device__ __forceinline__ pg8::f32x4 mfma16(bf16x8 a, bf16x8 b, pg8::f32x4 c) { return __builtin_amdgcn_mfma_f32_16x16x32_bf16(a, b, c, 0, 0, 0); }
__device__ __forceinline__ void phase_hgrn_mfma(const Params& p, const Ctx& c) {
    unsigned char* ws = p.ws;
    const bf16_t* vb = (const bf16_t*)(ws + WS_V); const bf16_t* qb = (const bf16_t*)(ws + WS_Q);
    constexpr int SET = 64 * QROW * 2 + 128 * TROW + 64 * TROW;
    LAS bf16_t* img = (LAS bf16_t*)c.lds;
    LAS float* Elb = (LAS float*)(img + 2 * SET);
    const int wid = c.wid, lane = c.lane, fr = lane & 15, fq = lane >> 4;
    const bool prep = wid < 4; const int aw = wid & 3;
    for (int it = c.vc; it < 256; it += gridDim.x) {
        const int dvh = (it >> 3) & 1, idx = (it & 7) | ((it >> 4) << 3), dir = idx & 1, h = (idx >> 1) & 3, b = idx >> 3;
        const f16_t* lf = (const f16_t*)(ws + (dir ? WS_LBW : WS_LFW)); bf16_t* outp = ((bf16_t*)p.out + (size_t)T * D + (dir ? (size_t)T * 512 : 0));
#define HG_ROW(ci_, p_) (((ci_) >= 4) ? (b * SEQ + (dir ? SEQ - 1 - (((ci_) - 4) * 64 + (p_)) : (((ci_) - 4) * 64 + (p_)))) : (T + b * CL + (dir ? CL - 1 - ((ci_) * 64 + (p_)) : ((ci_) * 64 + (p_)))))
        const int d0 = 2 * lane, colq = h * 128 + d0;
        const int pv = 16 * aw + (lane >> 2), e16 = (lane & 3) * 16, colv = h * 128 + dvh * 64 + e16;
        LAS float* qtb = Elb + 256;
        unsigned lfr[3][16], qr[3][16]; u32x4 vr[3][2];
        pg8::f32x4 S[8];
#pragma unroll
        for (int i = 0; i < 8; ++i) S[i] = (pg8::f32x4){0.f, 0.f, 0.f, 0.f};
        __syncthreads();
#define HG_LOAD(set_, ci_) do { if ((ci_) < 36) { _Pragma("unroll") for (int i = 0; i < 16; ++i) { const int row = HG_ROW(ci_, 16 * aw + i); lfr[set_][i] = *(const unsigned*)(lf + (size_t)row * 512 + colq); \
            if ((ci_) >= 4) qr[set_][i] = *(const unsigned*)(qb + (size_t)row * 512 + colq); } \
            const bf16_t* vs_ = vb + (size_t)HG_ROW(ci_, pv) * 512 + colv; vr[set_][0] = *(const u32x4*)vs_; vr[set_][1] = *(const u32x4*)(vs_ + 8); } } while (0)
#define HG_TOT(set_, ci_) do { if ((ci_) < 36) { float t0 = 0.f, t1 = 0.f; \
            _Pragma("unroll") for (int i = 0; i < 16; ++i) { t0 += (float)__builtin_bit_cast(__fp16, (unsigned short)(lfr[set_][i] & 0xffffu)); t1 += (float)__builtin_bit_cast(__fp16, (unsigned short)(lfr[set_][i] >> 16)); } \
            qtb[(((ci_) & 1) * 4 + aw) * 128 + d0] = t0; qtb[(((ci_) & 1) * 4 + aw) * 128 + d0 + 1] = t1; } } while (0)
#define HG_PREP(set_, nset_, ci_) do { \
            LAS bf16_t* Qt = img + ((ci_) & 1) * SET; LAS bf16_t* Kt = Qt + 64 * QROW; LAS bf16_t* KhT = Kt + 64 * QROW; LAS bf16_t* VT = KhT + 128 * TROW; LAS float* El = Elb + ((ci_) & 1) * 128; \
            const bool lat_ = (ci_) >= 4; \
            HG_TOT(nset_, (ci_) + 1); \
            float off0 = 0.f, off1 = 0.f, tot0 = 0.f, tot1 = 0.f; \
            _Pragma("unroll") for (int s_ = 0; s_ < 4; ++s_) { const float a0 = qtb[(((ci_) & 1) * 4 + s_) * 128 + d0], a1 = qtb[(((ci_) & 1) * 4 + s_) * 128 + d0 + 1]; tot0 += a0; tot1 += a1; if (s_ < aw) { off0 += a0; off1 += a1; } } \
            const float E0 = __expf(tot0), E1 = __expf(tot1); \
            if (aw == 0) { El[d0] = E0; El[d0 + 1] = E1; } \
            const int qpos = hg_pos(d0), base0 = 32 * (aw >> 1) + 4 * (aw & 1); float cu0 = off0, cu1 = off1; \
            _Pragma("unroll") for (int q_ = 0; q_ < 4; ++q_) { float kh0[4], kh1[4]; \
                _Pragma("unroll") for (int r_ = 0; r_ < 4; ++r_) { const int i = 4 * q_ + r_, pp = 16 * aw + i; \
                    const float l0 = (float)__builtin_bit_cast(__fp16, (unsigned short)(lfr[set_][i] & 0xffffu)), l1 = (float)__builtin_bit_cast(__fp16, (unsigned short)(lfr[set_][i] >> 16)); \
                    cu0 += l0; cu1 += l1; \
                    const float e0 = __expf(cu0), e1 = __expf(cu1), r0 = __expf(-cu0), r1 = __expf(-cu1); \
                    const float k0 = (1.0f - __expf(l0)) * r0, k1 = (1.0f - __expf(l1)) * r1; \
                    *(LAS unsigned*)(Kt + pp * QROW + qpos) = pk2(k0, k1); \
                    if (lat_) { const float q0 = __uint_as_float(qr[set_][i] << 16), q1 = __uint_as_float(qr[set_][i] & 0xffff0000u); *(LAS unsigned*)(Qt + pp * QROW + qpos) = pk2(q0 * e0, q1 * e1); } \
                    kh0[r_] = k0 * E0; kh1[r_] = k1 * E1; } \
                u32x2 w; w.x = pk2(kh0[0], kh0[1]); w.y = pk2(kh0[2], kh0[3]); *(LAS u32x2*)(KhT + d0 * TROW + base0 + 8 * q_) = w; \
                w.x = pk2(kh1[0], kh1[1]); w.y = pk2(kh1[2], kh1[3]); *(LAS u32x2*)(KhT + (d0 + 1) * TROW + base0 + 8 * q_) = w; } \
            { const int sp = hg_pos(pv); const unsigned wv[8] = {vr[set_][0].x, vr[set_][0].y, vr[set_][0].z, vr[set_][0].w, vr[set_][1].x, vr[set_][1].y, vr[set_][1].z, vr[set_][1].w}; \
              _Pragma("unroll") for (int j = 0; j < 8; ++j) { VT[(e16 + 2 * j) * TROW + sp] = (bf16_t)(wv[j] & 0xffffu); VT[(e16 + 2 * j + 1) * TROW + sp] = (bf16_t)(wv[j] >> 16); } } \
            HG_LOAD(set_, (ci_) + 3); } while (0)
#define HG_BAR() do { asm volatile("s_waitcnt lgkmcnt(0)" ::: "memory"); __builtin_amdgcn_s_barrier(); asm volatile("" ::: "memory"); } while (0)
        if (prep) {
            HG_LOAD(0, 0); HG_LOAD(1, 1); HG_LOAD(2, 2); HG_TOT(0, 0);
            HG_BAR();
            HG_PREP(0, 1, 0);
            HG_BAR();
            for (int ci3 = 0; ci3 < 36; ci3 += 3) {
                HG_PREP(1, 2, ci3 + 1);
                HG_BAR();
                HG_PREP(2, 0, ci3 + 2);
                HG_BAR();
                if (ci3 + 3 < 36) HG_PREP(0, 1, ci3 + 3);
                HG_BAR();
            }
        } else {
            HG_BAR(); HG_BAR();
            for (int ci = 0; ci < 36; ++ci) {
                const bool lat = ci >= 4;
                const LAS bf16_t* Qt = img + (ci & 1) * SET; const LAS bf16_t* Kt = Qt + 64 * QROW; const LAS bf16_t* KhT = Kt + 64 * QROW; const LAS bf16_t* VT = KhT + 128 * TROW; const LAS float* El = Elb + (ci & 1) * 128;
                bf16x8 VF[2];
#pragma unroll
                for (int a2 = 0; a2 < 2; ++a2) VF[a2] = *(const LAS bf16x8*)(VT + (16 * aw + fr) * TROW + 32 * a2 + 8 * fq);
                if (lat) {
                    bf16x8 SF[4];
#pragma unroll
                    for (int k = 0; k < 4; ++k) { u32x4 w; w.x = pk2(S[2 * k][0], S[2 * k][1]); w.y = pk2(S[2 * k][2], S[2 * k][3]); w.z = pk2(S[2 * k + 1][0], S[2 * k + 1][1]); w.w = pk2(S[2 * k + 1][2], S[2 * k + 1][3]); SF[k] = __builtin_bit_cast(bf16x8, w); }
#pragma unroll
                    for (int ti = 0; ti < 4; ++ti) {
                        bf16x8 QF[4];
#pragma unroll
                        for (int k = 0; k < 4; ++k) QF[k] = *(const LAS bf16x8*)(Qt + (16 * ti + fr) * QROW + 32 * k + 8 * fq);
                        pg8::f32x4 P[4];
#pragma unroll
                        for (int si = 0; si < 4; ++si) { pg8::f32x4 acc = (pg8::f32x4){0.f, 0.f, 0.f, 0.f};
                            if (si <= ti) {
#pragma unroll
                                for (int k = 0; k < 4; ++k) acc = mfma16(*(const LAS bf16x8*)(Kt + (16 * si + fr) * QROW + 32 * k + 8 * fq), QF[k], acc);
                                if (si == ti) {
#pragma unroll
                                    for (int r = 0; r < 4; ++r) acc[r] = (4 * fq + r <= fr) ? acc[r] : 0.f; } }
                            P[si] = acc; }
                        pg8::f32x4 o = (pg8::f32x4){0.f, 0.f, 0.f, 0.f};
#pragma unroll
                        for (int a2 = 0; a2 < 2; ++a2) if (2 * a2 <= ti) { u32x4 w; w.x = pk2(P[2 * a2][0], P[2 * a2][1]); w.y = pk2(P[2 * a2][2], P[2 * a2][3]); w.z = pk2(P[2 * a2 + 1][0], P[2 * a2 + 1][1]); w.w = pk2(P[2 * a2 + 1][2], P[2 * a2 + 1][3]);
                            o = mfma16(VF[a2], __builtin_bit_cast(bf16x8, w), o); }
#pragma unroll
                        for (int k = 0; k < 4; ++k) o = mfma16(SF[k], QF[k], o);
                        const int row = HG_ROW(ci, 16 * ti + fr);
                        u32x2 ow; ow.x = pk2(o[0], o[1]); ow.y = pk2(o[2], o[3]); *(u32x2*)(outp + (size_t)row * 512 + h * 128 + dvh * 64 + 16 * aw + 4 * fq) = ow;
                    }
                }
#pragma unroll
                for (int db = 0; db < 8; ++db) { const pg8::f32x4 dl = *(const LAS pg8::f32x4*)(El + 16 * db + 4 * fq);
                    S[db] = S[db] * dl;
#pragma unroll
                    for (int a2 = 0; a2 < 2; ++a2) S[db] = mfma16(*(const LAS bf16x8*)(KhT + (16 * db + fr) * TROW + 32 * a2 + 8 * fq), VF[a2], S[db]); }
                HG_BAR();
            }
        }
#undef HG_BAR
#undef HG_LOAD
#undef HG_TOT
#undef HG_PREP
#undef HG_ROW
    }
}

constexpr int ZROW = 2056;
__device__ __forceinline__ void phase_hy_prepass(const Params& p, const Ctx& c) {
    bf16_t* hy = (bf16_t*)(p.ws + WS_HY);
    LAS bf16_t* raw = (LAS bf16_t*)c.lds;
    if (c.tid < 4) { ((LAS unsigned*)raw)[c.tid] = 0u; ((LAS unsigned*)(raw + 2049 * 8))[c.tid] = 0u; }
    for (int blk = blockIdx.x; blk < (NHY / 8) * NB; blk += gridDim.x) {
        bf16_t* base = hy + (size_t)blk * SEQ * 8; const int cg = blk / NB;
        u32x4 ch4[4];
#pragma unroll
        for (int i = 0; i < 4; ++i) ch4[i] = *(const u32x4*)(base + (size_t)(4 * c.tid + i) * 8);
        __syncthreads();
#pragma unroll
        for (int i = 0; i < 4; ++i) *(LAS u32x4*)(raw + (size_t)(1 + 4 * c.tid + i) * 8) = ch4[i];
        __syncthreads();
        const int ch = cg * 8 + c.wid; const float w0 = p.conv_w[ch], w1 = p.conv_w[NHY + ch], w2 = p.conv_w[2 * NHY + ch], cb = p.conv_b[ch];
#pragma unroll 4
        for (int k = 0; k < 16; ++k) { const int t = 2 * c.lane + 128 * k;
            const float x0 = bf2f(raw[(t + 0) * 8 + c.wid]), x1 = bf2f(raw[(t + 1) * 8 + c.wid]), x2 = bf2f(raw[(t + 2) * 8 + c.wid]), x3 = bf2f(raw[(t + 3) * 8 + c.wid]);
            *(unsigned*)(base + (size_t)c.wid * SEQ + t) = pk2(cb + w0 * x0 + w1 * x1 + w2 * x2, cb + w0 * x1 + w1 * x2 + w2 * x3); }
    }
}
template <int KIND>
__device__ __forceinline__ void hy_block(pg8::f32x4 (&acc)[16], bf16x8 (&Bw)[16], const LAS bf16_t* zl, const LAS bf16_t* krl, int ub, int i0, int lane) {
    const int fr = lane & 15, fq = lane >> 4;
    const LAS bf16_t* bbase = zl + fr * ZROW + 8 * fq;
    const int abase = KR_OFF - 16 * i0 - fr + 8 * fq;
    const unsigned sh = (unsigned)(fr & 1) * 16u;
#pragma unroll
    for (int uu = 0; uu < 16; ++uu) {
        const int u = ub + uu;
        const bool ldb = KIND == 0 ? (uu >= 1) : (KIND == 1 ? true : (uu == 0));
        if (ldb) Bw[(uu + 15) & 15] = *(const LAS bf16x8*)(bbase + 32 * (u + 15));
        const LAS unsigned* ap = (const LAS unsigned*)(krl + ((abase + 32 * u) & ~1));
        const unsigned d0 = ap[0], d1 = ap[1], d2 = ap[2], d3 = ap[3], d4 = ap[4];
        u32x4 aw; aw.x = __builtin_amdgcn_alignbit(d1, d0, sh); aw.y = __builtin_amdgcn_alignbit(d2, d1, sh); aw.z = __builtin_amdgcn_alignbit(d3, d2, sh); aw.w = __builtin_amdgcn_alignbit(d4, d3, sh);
        const bf16x8 A = __builtin_bit_cast(bf16x8, aw);
#pragma unroll
        for (int m = 0; m < 16; ++m) { const bool on = KIND == 0 ? (m >= 16 - uu) : (KIND == 1 ? true : (m <= 15 - uu));
            if (on) acc[m] = __builtin_amdgcn_mfma_f32_16x16x32_bf16(A, Bw[(uu + m) & 15], acc[m], 0, 0, 0); }
    }
}
__device__ __forceinline__ void hy_dma_img(LAS bf16_t* dst, const bf16_t* hy, int chx, int wid, int lane) {
#pragma unroll
    for (int i = 0; i < 8; ++i) { const int pc = wid + 8 * i, b = pc >> 2, k = pc & 3;
        __builtin_amdgcn_global_load_lds((const unsigned*)(hy + ((((size_t)(chx >> 3) * NB + b) * 8 + (chx & 7)) * SEQ) + 512 * k + 8 * lane), (LAS unsigned*)(dst + b * ZROW + 512 * k), 16, 0, 0); }
}
__device__ __forceinline__ void hy_dma_kr(LAS bf16_t* dst, const bf16_t* src, int wid, int lane) {
    __builtin_amdgcn_global_load_lds((const unsigned*)(src + 512 * wid + 8 * lane), (LAS unsigned*)(dst + 512 * wid), 16, 0, 0);
    if (wid == 0 && lane < (KR_LEN - 4096) / 8) __builtin_amdgcn_global_load_lds((const unsigned*)(src + 4096 + 8 * lane), (LAS unsigned*)(dst + 4096), 16, 0, 0);
}
__device__ __forceinline__ void hy_conv(pg8::f32x4 (&acc)[16], const LAS bf16_t* zl, const LAS bf16_t* krl, int i0, int lane) {
    bf16x8 Bw[16];
#pragma unroll
    for (int m = 0; m < 16; ++m) { acc[m] = (pg8::f32x4){0.f, 0.f, 0.f, 0.f}; Bw[m] = (bf16x8){0, 0, 0, 0, 0, 0, 0, 0}; }
    hy_block<0>(acc, Bw, zl, krl, -16, i0, lane);
    for (int ub = 0; ub < 48; ub += 16) hy_block<1>(acc, Bw, zl, krl, ub, i0, lane);
    hy_block<2>(acc, Bw, zl, krl, 48, i0, lane);
}
__device__ __forceinline__ void hy_gate(u32x2 (&res)[16], const pg8::f32x4 (&acc)[16], const LAS bf16_t* zl, const bf16_t* grow, float bias, int i0, int fr, int fq) {
    u32x2 gg[16];
#pragma unroll
    for (int m = 0; m < 16; ++m) gg[m] = *(const u32x2*)(grow + 16 * (i0 + 2 * m) + 4 * fq);
#pragma unroll
    for (int m = 0; m < 16; ++m) { const int t = 16 * (i0 + 2 * m) + 4 * fq; const u32x2 zo = *(const LAS u32x2*)(zl + fr * ZROW + t);
        const float z0 = __uint_as_float(zo.x << 16), z1 = __uint_as_float(zo.x & 0xffff0000u), z2 = __uint_as_float(zo.y << 16), z3 = __uint_as_float(zo.y & 0xffff0000u);
        const float g0 = __uint_as_float(gg[m].x << 16), g1 = __uint_as_float(gg[m].x & 0xffff0000u), g2 = __uint_as_float(gg[m].y << 16), g3 = __uint_as_float(gg[m].y & 0xffff0000u);
        res[m].x = pk2(g0 * (acc[m][0] + bias * z0), g1 * (acc[m][1] + bias * z1)); res[m].y = pk2(g2 * (acc[m][2] + bias * z2), g3 * (acc[m][3] + bias * z3)); }
}
__device__ __forceinline__ void phase_hyena_mfma(const Params& p, const Ctx& c) {
    unsigned char* ws = p.ws;
    const bf16_t* hy = (const bf16_t*)(ws + WS_HY); const bf16_t* krev = (const bf16_t*)(ws + WS_KREV); bf16_t* zb = (bf16_t*)(ws + WS_ZB);
    LAS bf16_t* zA = (LAS bf16_t*)c.lds;
    LAS bf16_t* zB = zA + NB * ZROW;
    LAS bf16_t* krA = zB + NB * ZROW;
    LAS bf16_t* krB = krA + KR_LEN;
    const int i0 = 32 * (c.wid >> 1) + (c.wid & 1), fr = c.lane & 15, fq = c.lane >> 4;
    __syncthreads();
    if ((int)blockIdx.x < BW) { hy_dma_img(zA, hy, blockIdx.x, c.wid, c.lane); hy_dma_kr(krA, krev + (size_t)blockIdx.x * KR_LEN, c.wid, c.lane); }
    asm volatile("s_waitcnt vmcnt(0)" ::: "memory"); __syncthreads();
    for (int ch = blockIdx.x; ch < BW; ch += gridDim.x) {
        const int nch = ch + gridDim.x;
        pg8::f32x4 acc[16]; u32x2 res[16];
        hy_dma_kr(krB, krev + ((size_t)512 + ch) * KR_LEN, c.wid, c.lane);
        hy_conv(acc, zA, krA, i0, c.lane);
        { const int chx = 512 + ch; hy_gate(res, acc, zA, hy + ((((size_t)(chx >> 3) * NB + fr) * 8 + (chx & 7)) * SEQ), p.hy_bias[ch], i0, fr, fq); }
#pragma unroll
        for (int m = 0; m < 16; ++m) *(LAS u32x2*)(zB + fr * ZROW + 16 * (i0 + 2 * m) + 4 * fq) = res[m];
        asm volatile("s_waitcnt vmcnt(0)" ::: "memory"); __syncthreads();
        if (nch < BW) { hy_dma_img(zA, hy, nch, c.wid, c.lane); hy_dma_kr(krA, krev + (size_t)nch * KR_LEN, c.wid, c.lane); }
        hy_conv(acc, zB, krB, i0, c.lane);
        { const int chx = 1024 + ch; hy_gate(res, acc, zB, hy + ((((size_t)(chx >> 3) * NB + fr) * 8 + (chx & 7)) * SEQ), p.hy_bias[512 + ch], i0, fr, fq); }
#pragma unroll
        for (int m = 0; m < 16; ++m) *(u32x2*)(zb + ((size_t)ch * NB + fr) * SEQ + 16 * (i0 + 2 * m) + 4 * fq) = res[m];
        asm volatile("s_waitcnt vmcnt(0)" ::: "memory"); __syncthreads();
    }
}

__device__ __forceinline__ void phase_combine(const Params& p, const Ctx& c) {
    unsigned char* ws = p.ws;
    const bf16_t* ofw = ((const bf16_t*)p.out + (size_t)T * D); const bf16_t* obw = ((const bf16_t*)p.out + (size_t)T * D + (size_t)T * 512); const bf16_t* g = (const bf16_t*)(ws + WS_G);
    bf16_t* oab = (bf16_t*)(ws + WS_OA); const bf16_t* zb = (const bf16_t*)(ws + WS_ZB);
    { const int col = 8 * c.lane; float w[8]; load_f32x8(p.a_norm_w + (col & 127), w);
      for (int row0 = 4 * c.gw; row0 < T; row0 += 4 * c.ngw) { u32x4 ra[4], rb[4], rg[4];
#pragma unroll
        for (int r = 0; r < 4; ++r) { const size_t o = (size_t)(row0 + r) * 512 + col; ra[r] = *(const u32x4*)(ofw + o); rb[r] = *(const u32x4*)(obw + o); rg[r] = *(const u32x4*)(g + o); }
#pragma unroll
        for (int r = 0; r < 4; ++r) { float a[8], bq[8], gg[8], o[8]; unpack_bf16x8(ra[r], a); unpack_bf16x8(rb[r], bq); unpack_bf16x8(rg[r], gg);
            float s = 0.f;
#pragma unroll
            for (int j = 0; j < 8; ++j) { a[j] += bq[j]; s += a[j] * a[j]; }
            s += __shfl_xor(s, 1); s += __shfl_xor(s, 2); s += __shfl_xor(s, 4); s += __shfl_xor(s, 8);
            const float rs = __builtin_amdgcn_rsqf(s * (1.0f / 128.0f) + RMS_EPS);
#pragma unroll
            for (int j = 0; j < 8; ++j) o[j] = a[j] * rs * w[j] * gg[j];
            store_bf16x8(oab + (size_t)(row0 + r) * 1024 + col, o); } } }
    LAS bf16_t* tile = (LAS bf16_t*)c.lds;
    for (int it = blockIdx.x; it < NB * 32 * 8; it += gridDim.x) { const int cb = it & 7, tb = (it >> 3) & 31, b = it >> 8;
        __syncthreads();
        { const int cl = c.tid >> 3, t8 = (c.tid & 7) * 8; const u32x4 w = *(const u32x4*)(zb + ((size_t)(cb * 64 + cl) * NB + b) * SEQ + tb * 64 + t8); *(LAS u32x4*)(tile + cl * 72 + t8) = w; }
        __syncthreads();
        { const int tl = c.tid >> 3, c8 = (c.tid & 7) * 8; bf16_t v[8];
#pragma unroll
          for (int i = 0; i < 8; ++i) v[i] = tile[(c8 + i) * 72 + tl];
          u32x4 w; w.x = v[0] | ((unsigned)v[1] << 16); w.y = v[2] | ((unsigned)v[3] << 16); w.z = v[4] | ((unsigned)v[5] << 16); w.w = v[6] | ((unsigned)v[7] << 16);
          *(u32x4*)(oab + ((size_t)b * SEQ + tb * 64 + tl) * 1024 + 512 + cb * 64 + c8) = w; }
    }
}

__device__ __forceinline__ void phase_rstd(const float* ssq, float* rstd, int nrows, const Ctx& c) {
    for (int row = blockIdx.x * NTHR + c.tid; row < nrows; row += gridDim.x * NTHR) rstd[row] = rstd_from_ssq(ssq + (size_t)row * 16);
}
__device__ __forceinline__ void phase_final(const Params& p, const Ctx& c) {
    const float* ssq = (const float*)(p.ws + WS_SSQ3); const bf16_t* h3 = (const bf16_t*)(p.ws + WS_H3);
    float w[2][8]; load_f32x8(p.fnw + 8 * c.lane, w[0]); load_f32x8(p.fnw + 8 * c.lane + 512, w[1]);
    for (int row0 = 4 * c.gw; row0 < T; row0 += 4 * c.ngw) { u32x4 hr[4][2]; float rs[4];
#pragma unroll
        for (int r = 0; r < 4; ++r) { rs[r] = rstd_from_ssq(ssq + (size_t)(row0 + r) * 16); hr[r][0] = *(const u32x4*)(h3 + (size_t)(row0 + r) * D + 8 * c.lane); hr[r][1] = *(const u32x4*)(h3 + (size_t)(row0 + r) * D + 8 * c.lane + 512); }
#pragma unroll
        for (int r = 0; r < 4; ++r)
#pragma unroll
            for (int j = 0; j < 2; ++j) { float h[8], o[8]; unpack_bf16x8(hr[r][j], h);
#pragma unroll
                for (int i = 0; i < 8; ++i) o[i] = h[i] * rs[r] * w[j][i];
                { float* dst = p.out + (size_t)(row0 + r) * D + 8 * c.lane + 512 * j; __builtin_nontemporal_store((f32x4){o[0], o[1], o[2], o[3]}, (f32x4*)dst); __builtin_nontemporal_store((f32x4){o[4], o[5], o[6], o[7]}, (f32x4*)(dst + 4)); } } }
}


#define XB_TMO      128
#define XB_XCNT(j)  (256  + 64 * (j))
#define XB_XSUB(j)  (1280 + 64 * (j))
#define XB_XGEN(j)  (2304 + 64 * (j))
#define XB_TOP      3328
#define XB_TOPGEN   3392
#define XCD_BAR_WORDS 3456
#define XB_SPIN_CAP (1u << 18)
__device__ __forceinline__ unsigned xb_ld(unsigned* p)              { return __hip_atomic_load(p, __ATOMIC_RELAXED, __HIP_MEMORY_SCOPE_AGENT); }
__device__ __forceinline__ unsigned xb_add(unsigned* p, unsigned v) { return __hip_atomic_fetch_add(p, v, __ATOMIC_RELAXED, __HIP_MEMORY_SCOPE_AGENT); }
__device__ __forceinline__ unsigned xb_xcc_id() { return (unsigned)__builtin_amdgcn_s_getreg((3 << 11) | 20) & 0xFu; }
#define XB_SPIN(cond, bar) do { unsigned _sp = 0; while (cond) { __builtin_amdgcn_s_sleep(1); \
    if ((++_sp & 255u) == 0u) { if (xb_ld(&(bar)[XB_TMO])) break; if (_sp > XB_SPIN_CAP) { atomicAdd(&(bar)[XB_TMO], 1u); break; } } } } while (0)
struct XcdBarrier { unsigned* bar; unsigned x; volatile LAS unsigned* st; };
__device__ __forceinline__ XcdBarrier xcd_barrier_post(unsigned* bar, volatile LAS unsigned* st) {
    XcdBarrier b; b.bar = bar; b.x = xb_xcc_id(); b.st = st;
    if (threadIdx.x == 0) st[2] = xb_add(&bar[XB_XCNT(b.x)], 1u);
    return b;
}
__device__ __forceinline__ void xcd_barrier_complete(unsigned* bar, unsigned x, unsigned& nloc, unsigned& nx) {
    const unsigned G = gridDim.x * gridDim.y * gridDim.z;
    unsigned sum, cnt, mine, sp = 0u;
    for (;;) {
        sum = 0u; cnt = 0u; mine = 0u;
#pragma unroll
        for (unsigned j = 0; j < 16; ++j) { const unsigned c = xb_ld(&bar[XB_XCNT(j)]); sum += c; cnt += (c > 0u) ? 1u : 0u; mine = (j == x) ? c : mine; }
        if (sum == G) break;
        __builtin_amdgcn_s_sleep(1);
        if ((++sp & 255u) == 0u) { if (xb_ld(&bar[XB_TMO])) break; if (sp > XB_SPIN_CAP) { atomicAdd(&bar[XB_TMO], 1u); break; } }
    }
    nloc = mine > 0u ? mine : 1u; nx = cnt > 0u ? cnt : 1u;
}
__device__ __forceinline__ void xcd_barrier(const XcdBarrier& b) {
    asm volatile("s_waitcnt vmcnt(0)" ::: "memory");
    __syncthreads();
    if (threadIdx.x == 0) {
        unsigned* bar = b.bar;
        __builtin_amdgcn_s_waitcnt(0);
        unsigned nloc = b.st[0], nx = b.st[1];
        if (nloc == 0u) { xcd_barrier_complete(bar, b.x, nloc, nx); b.st[0] = nloc; b.st[1] = nx; }
        const unsigned old = xb_add(&bar[XB_XSUB(b.x)], 1u);
        const unsigned gen = old / nloc;
        if (old + 1u == (gen + 1u) * nloc) {
            __builtin_amdgcn_fence(__ATOMIC_RELEASE, "agent");
            asm volatile("s_waitcnt vmcnt(0)" ::: "memory");
            const unsigned og = xb_add(&bar[XB_TOP], 1u);
            const unsigned tg = og / nx;
            if (og + 1u == (tg + 1u) * nx) xb_add(&bar[XB_TOPGEN], 1u);
            else XB_SPIN(xb_ld(&bar[XB_TOPGEN]) == tg, bar);
            __builtin_amdgcn_fence(__ATOMIC_ACQUIRE, "agent");
            xb_add(&bar[XB_XGEN(b.x)], 1u);
            asm volatile("s_waitcnt vmcnt(0)" ::: "memory");
        } else {
            XB_SPIN(xb_ld(&bar[XB_XGEN(b.x)]) == gen, bar);
            __builtin_amdgcn_fence(__ATOMIC_ACQUIRE, "agent");
            asm volatile("s_waitcnt vmcnt(0)" ::: "memory");
        }
    }
    __syncthreads();
}

constexpr int N_PHASES = 15;
#ifndef REPEAT_MASK
#define REPEAT_MASK 0
#endif
#ifndef HOST_REPEAT_MASK
#define HOST_REPEAT_MASK 0
#endif
#ifndef USE_XCD_BARRIER
#define USE_XCD_BARRIER 1
#endif
__global__ void __launch_bounds__(NTHR, 2) fwd_kernel(Params p) {
    extern __shared__ __attribute__((aligned(16))) unsigned char lds_raw[];
    Ctx c; c.lds = (LAS unsigned char*)lds_raw; c.tid = threadIdx.x; c.lane = c.tid & 63; c.wid = __builtin_amdgcn_readfirstlane(c.tid >> 6);
    c.gw = blockIdx.x * NWAVES + c.wid; c.ngw = gridDim.x * NWAVES; c.vc = blockIdx.x;
    unsigned char* ws = p.ws;
    const float* modv = (const float*)(ws + WS_MODV);
#if N_LAUNCH_MODE == 1
    cg::grid_group grid = cg::this_grid();
#if USE_XCD_BARRIER
    volatile LAS unsigned* xst = (volatile LAS unsigned*)(c.lds + LDS_BYTES - 16);
    if (c.tid < 4) xst[c.tid] = 0u;
    __syncthreads();
    XcdBarrier xbar = xcd_barrier_post((unsigned*)(ws + WS_CTL), xst);
    bool first_seam = true;
#define SEAM() do { if (first_seam) { if (p.ph_lo < 0) grid.sync();   xcd_barrier(xbar); first_seam = false; \
        if (c.tid == 0) { unsigned* bar_ = (unsigned*)(ws + WS_CTL); bool ok_ = (gridDim.x % 8u) == 0u; for (unsigned j_ = 0; j_ < 16; ++j_) { const unsigned n_ = xb_ld(&bar_[XB_XCNT(j_)]); ok_ = ok_ && (j_ < 8 ? n_ == gridDim.x / 8u : n_ == 0u); } \
            xst[3] = ok_ ? (xst[2] * 8u + xbar.x) : blockIdx.x; } \
        __syncthreads(); c.vc = (int)xst[3]; } else xcd_barrier(xbar); } while (0)
#else
#define SEAM() grid.sync()
#endif
#else
#define SEAM() do { } while (0)
#endif
#ifdef ONLY_PHASE
#define IN(k) ((k) == ONLY_PHASE && p.ph_lo <= (k) && (k) < p.ph_hi)
#else
#define IN(k) (p.ph_lo <= (k) && (k) < p.ph_hi)
#endif
#if PROBE_TS_MASK
#define TS_STAMP(k) do { if (c.tid == 0) ((unsigned long long*)(ws + WS_CTL + 16384))[(k) * 256 + blockIdx.x] = __builtin_amdgcn_s_memrealtime(); } while (0)
#else
#define TS_STAMP(k) do { } while (0)
#endif
#define PHASE(k, ...) if (IN(k)) { for (int rep_ = 0; rep_ <= ((REPEAT_MASK >> (k)) & 1); ++rep_) { __VA_ARGS__; if (rep_ < ((REPEAT_MASK >> (k)) & 1)) SEAM(); } TS_STAMP(k); if (IN((k) + 1)) SEAM(); }
    TS_STAMP(16);
#if USE_PG8
#define GEMM2(A_, Bt_, K_, nrows1_, npn1_, nrows2_, npn2_, E_, ssq_) gemm_mfma(c.lds, c.vc, A_, Bt_, K_, nrows1_, npn1_, nrows2_, npn2_, E_, ssq_)
#else
#define GEMM2(A_, Bt_, K_, nrows1_, npn1_, nrows2_, npn2_, E_, ssq_) do { gemm_simple(c.lds, A_, Bt_, K_, 0, nrows1_, npn1_, E_, ssq_); if ((nrows2_) > 0) gemm_simple(c.lds, A_, Bt_, K_, nrows1_, nrows2_, npn2_, E_, ssq_); } while (0)
#endif
#define GEMM(A_, Bt_, K_, nrows_, npn_, E_, ssq_) GEMM2(A_, Bt_, K_, nrows_, npn_, 0, 0, E_, ssq_)
    PHASE(0, phase_prep(p, c))
    PHASE(1, phase_n1(p, c))
    PHASE(2, { EpiGateUp1 E{(bf16_t*)(ws + WS_HID)};
        GEMM((const bf16_t*)(ws + WS_N1), (const bf16_t*)(ws + WS_WG1_T), D, MT, NGU / 256, E, nullptr);
        VGrid g; if (filler_grid(g, c.vc, (MT / 256) * (NGU / 256))) { task_transposes_b(p, c, g); task_shift_gemv(p, c, g, 0); } })
    PHASE(3, { EpiDown1 E{(const bf16_t*)(ws + WS_HCB), modv, (bf16_t*)p.out, (bf16_t*)(ws + WS_A2)};
        GEMM((const bf16_t*)(ws + WS_HID), (const bf16_t*)(ws + WS_WD1_T), DFF, MT, D / 256, E, (float*)(ws + WS_SSQ1));
        VGrid g; if (filler_grid(g, c.vc, (MT / 256) * (D / 256))) { task_transposes_c(p, c, g); task_shift_gemv(p, c, g, 1); task_filters(p, c, g, 0, 192); __syncthreads(); task_transposes_d(p, c, g); } })
    PHASE(4, phase_rstd((const float*)(ws + WS_SSQ1), (float*)(ws + WS_RSTD1), MT, c))
    PHASE(5, { EpiWin E{(const float*)(ws + WS_RSTD1), (const float*)(ws + WS_SWIN), (const float*)(ws + WS_LBV), (bf16_t*)(ws + WS_V), (bf16_t*)(ws + WS_Q), (bf16_t*)(ws + WS_G), (bf16_t*)(ws + WS_HY), (bf16_t*)(ws + WS_GAB), (f16_t*)(ws + WS_LFW), (f16_t*)(ws + WS_LBW)};
        GEMM2((const bf16_t*)(ws + WS_A2), (const bf16_t*)(ws + WS_WIN_T), D, T, NIN / 256, TC, 6, E, nullptr);
        VGrid g; if (filler_grid(g, c.vc, (T / 256) * (NIN / 256) + (TC / 256) * 6)) task_filters(p, c, g, 192, 256); })
    PHASE(6, { if (USE_MFMA_HGRN) phase_hgrn_mfma(p, c); else phase_hgrn_simple(p, c);
        __syncthreads(); phase_hy_prepass(p, c); })
    PHASE(7, phase_hyena_mfma(p, c))
    PHASE(8, phase_combine(p, c))
    PHASE(9, { EpiProj E{(const bf16_t*)(ws + WS_GAB), (bf16_t*)(ws + WS_Y)};
        gemm_pair(c.lds, c.vc, (const bf16_t*)(ws + WS_OA), (const bf16_t*)(ws + WS_WPA_T), 512, T, D / 256, E); })
    PHASE(10, { EpiWout E{modv, (bf16_t*)p.out, (bf16_t*)(ws + WS_A3)};
        GEMM((const bf16_t*)(ws + WS_Y), (const bf16_t*)(ws + WS_WOUT_T), D, T, D / 256, E, (float*)(ws + WS_SSQ2)); })
    PHASE(11, phase_rstd((const float*)(ws + WS_SSQ2), (float*)(ws + WS_RSTD2), T, c))
    PHASE(12, { EpiGateUp2 E{(bf16_t*)(ws + WS_HID2), (const float*)(ws + WS_RSTD2), (const float*)(ws + WS_SW2)};
        GEMM((const bf16_t*)(ws + WS_A3), (const bf16_t*)(ws + WS_WG2_T), D, T, NGU / 256, E, nullptr); })
    PHASE(13, { EpiDown2 E{modv, (const bf16_t*)p.out, (bf16_t*)(ws + WS_H3)};
        GEMM((const bf16_t*)(ws + WS_HID2), (const bf16_t*)(ws + WS_WD2_T), DFF, T, D / 256, E, (float*)(ws + WS_SSQ3)); })
    PHASE(14, phase_final(p, c))
#if PROBE_TS_MASK
    SEAM();
    if (blockIdx.x == 0 && c.tid == 0) {
        const unsigned long long* ts = (const unsigned long long*)(ws + WS_CTL + 16384); unsigned long long tot = 0;
        for (int k = 0; k < N_PHASES; ++k) if ((PROBE_TS_MASK >> k) & 1) { unsigned long long a = 0, b = 0; const int kp = k == 0 ? 16 : k - 1;
            for (int w = 0; w < (int)gridDim.x; ++w) { const unsigned long long x = __hip_atomic_load(ts + k * 256 + w, __ATOMIC_RELAXED, __HIP_MEMORY_SCOPE_AGENT), y = __hip_atomic_load(ts + kp * 256 + w, __ATOMIC_RELAXED, __HIP_MEMORY_SCOPE_AGENT); a = x > a ? x : a; b = y > b ? y : b; }
            tot += a - b; }
        const unsigned long long t0 = __builtin_amdgcn_s_memrealtime();
        while (__builtin_amdgcn_s_memrealtime() - t0 < tot * 8ull) __builtin_amdgcn_s_sleep(8);
    }
#endif
}

extern "C" void kernel_launch(void* const* d_in, const int* in_sizes, int n_in, void* d_out, int out_size, void* d_ws, size_t ws_size, hipStream_t stream) {
    static int grid = 0;
    if (grid == 0) {
        if (n_in != 26 || in_sizes[0] != T * D || out_size != T * D || ws_size < WS_TOTAL) { fprintf(stderr, "kernel_launch: unexpected shapes (n_in %d, in0 %d, out %d, ws %zu < %zu)\n", n_in, n_in > 0 ? in_sizes[0] : -1, out_size, ws_size, (size_t)WS_TOTAL); grid = -1; return; }
        int dev = 0, cus = 0, per_cu = 0;
        (void)hipGetDevice(&dev); (void)hipDeviceGetAttribute(&cus, hipDeviceAttributeMultiprocessorCount, dev);
        if (hipFuncSetAttribute((const void*)fwd_kernel, hipFuncAttributeMaxDynamicSharedMemorySize, LDS_BYTES) != hipSuccess) { fprintf(stderr, "kernel_launch: hipFuncSetAttribute failed\n"); grid = -1; return; }
        (void)hipOccupancyMaxActiveBlocksPerMultiprocessor(&per_cu, (const void*)fwd_kernel, NTHR, LDS_BYTES);
        if (per_cu < 1) { fprintf(stderr, "kernel_launch: occupancy query says %d blocks per CU\n", per_cu); per_cu = 1; }
        (void)hipGetLastError();
        grid = cus;
    }
    if (grid < 0) return;
    Params p{};
    const float** f = (const float**)&p;
    for (int i = 0; i < 26; ++i) f[i] = (const float*)d_in[i];
    p.out = (float*)d_out; p.ws = (unsigned char*)d_ws;
#if N_LAUNCH_MODE == 1
    p.ph_lo = 0; p.ph_hi = N_PHASES;
#if USE_XCD_BARRIER
    (void)hipMemsetAsync((unsigned char*)d_ws + WS_CTL, 0, XCD_BAR_WORDS * 4, stream);
#endif
    void* args[] = {&p};
    hipError_t e = hipLaunchCooperativeKernel((const void*)fwd_kernel, dim3(grid), dim3(NTHR), args, LDS_BYTES, stream);
    if (e != hipSuccess) fprintf(stderr, "cooperative launch failed: %s (grid %d)\n", hipGetErrorString(e), grid);
#else
    for (int k = 0; k < N_PHASES; ++k) { p.ph_lo = k; p.ph_hi = k + 1; for (int r = 0; r <= ((HOST_REPEAT_MASK >> k) & 1); ++r) hipLaunchKernelGGL(fwd_kernel, dim3(grid), dim3(NTHR), LDS_BYTES, stream, p); }
#endif
}
```

```cpp
#include <hip/hip_runtime.h>
#include <hip/hip_cooperative_groups.h>
#include <cstdio>
namespace cg = cooperative_groups;

#ifndef N_LAUNCH_MODE
#define N_LAUNCH_MODE 1
#endif
#ifndef USE_MFMA_HYENA
#define USE_MFMA_HYENA 1
#endif
#ifndef USE_MFMA_HGRN
#define USE_MFMA_HGRN 1
#endif
#ifndef PROBE_TS_MASK
#define PROBE_HG_ROLE 0
#define PROBE_TS_MASK 0
#endif
#ifndef USE_PG8
#define USE_PG8 1
#endif

#define LAS __attribute__((address_space(3)))
typedef unsigned short bf16_t;
typedef _Float16 f16_t;
typedef float f32x4 __attribute__((ext_vector_type(4)));
typedef unsigned u32x4 __attribute__((ext_vector_type(4)));
typedef unsigned u32x2 __attribute__((ext_vector_type(2)));

constexpr int D = 1024, NB = 16, SEQ = 2048, T = NB * SEQ, CL = 256, TC = NB * CL, MT = T + TC;
constexpr int DFF = 2816, NGU = 2 * DFF, NIN = 6144, MODW = 9 * D;
constexpr int AKW = 512, AVW = 512, BW = 512, NHY = 3 * BW;
constexpr int KR_LEN = 4128, KR_OFF = 2056;
constexpr float RMS_EPS = 1e-6f;
constexpr int NTHR = 512, NWAVES = 8;
constexpr int LDS_BYTES = 152 * 1024;

constexpr size_t MiB = 1024 * 1024;
constexpr size_t al256(size_t x) { return (x + 255) & ~(size_t)255; }
constexpr size_t WS_CTL = 0;
constexpr size_t WS_MODV = WS_CTL + 65536;
constexpr size_t WS_SWIN = WS_MODV + al256((size_t)17 * MODW * 4);
constexpr size_t WS_SW2 = WS_SWIN + al256((size_t)17 * NIN * 4);
constexpr size_t WS_ER = WS_SW2 + al256((size_t)17 * NGU * 4);
constexpr size_t WS_EC = WS_ER + 32 * 512 * 4;
constexpr size_t WS_LBV = WS_EC + 64 * 512 * 4;
constexpr size_t WS_H2 = WS_LBV + 4096;
constexpr size_t WS_KREV = WS_H2 + 2048 * 64 * 4;
constexpr size_t WS_WIN_T = WS_KREV + al256((size_t)2 * 512 * KR_LEN * 2);
constexpr size_t WS_WPA_T = WS_WIN_T + (size_t)NIN * D * 2;
constexpr size_t WS_WPB_T = WS_WPA_T + (size_t)D * 512 * 2;
constexpr size_t WS_WOUT_T = WS_WPB_T + (size_t)D * 512 * 2;
constexpr size_t WS_RSTD1 = WS_WOUT_T + (size_t)D * D * 2;
constexpr size_t WS_RSTD2 = WS_RSTD1 + (size_t)MT * 4;
constexpr size_t WS_PERSIST_END = WS_RSTD2 + (size_t)T * 4;
constexpr size_t AR = 27 * MiB;
static_assert(WS_PERSIST_END <= AR, "persistent region");
constexpr size_t WS_HID = AR + 0 * MiB;
constexpr size_t WS_N1 = AR + 198 * MiB;
constexpr size_t WS_WG1_T = AR + 270 * MiB;
constexpr size_t WS_WD1_T = AR + 281 * MiB;
constexpr size_t WS_HCB = AR + 290 * MiB;
constexpr size_t WS_SSQ1 = AR + 286 * MiB + 512 * 1024;
constexpr size_t WS_A2 = AR + 413 * MiB;
constexpr size_t WS_GAB = AR + 0 * MiB;
constexpr size_t WS_V = AR + 128 * MiB;
constexpr size_t WS_LFW = AR + 164 * MiB;
constexpr size_t WS_LBW = AR + 200 * MiB;
constexpr size_t WS_Q = AR + 236 * MiB;
constexpr size_t WS_G = AR + 268 * MiB;
constexpr size_t WS_HY = AR + 300 * MiB;
constexpr size_t WS_WG2_T = AR + 396 * MiB;
constexpr size_t WS_WD2_T = AR + 407 * MiB;
constexpr size_t WS_ZB = AR + 453 * MiB;
constexpr size_t WS_OA = AR + 128 * MiB;
constexpr size_t WS_Y = AR + 320 * MiB;
constexpr size_t WS_A3 = AR + 0 * MiB;
constexpr size_t WS_SSQ2 = AR + 64 * MiB;
constexpr size_t WS_H3 = AR + 0 * MiB;
constexpr size_t WS_SSQ3 = AR + 66 * MiB;
constexpr size_t WS_HID2 = AR + 128 * MiB;
constexpr size_t WS_TOTAL = AR + 485 * MiB;

struct Params {
    const float *x, *c, *ctx, *c_ctx, *mod_w, *mod_b, *ffn_wg, *ffn_wu, *ffn_wd, *w_in, *lb_logits, *a_norm_w, *conv_w, *conv_b;
    const float *hw1, *hb1, *hfr1, *hw2, *hb2, *hfr2, *hw3, *hy_bias, *w_pa, *w_pb, *w_out, *fnw;
    float* out; unsigned char* ws;
    int ph_lo, ph_hi;
};

__device__ __forceinline__ float bf2f(bf16_t b) { return __uint_as_float(((unsigned)b) << 16); }
__device__ __forceinline__ bf16_t f2bf(float f) { unsigned u = __float_as_uint(f); u += 0x7FFFu + ((u >> 16) & 1u); return (bf16_t)(u >> 16); }
typedef float f32x2_t __attribute__((ext_vector_type(2)));
typedef __bf16 bf16x2_t __attribute__((ext_vector_type(2)));
__device__ __forceinline__ unsigned pk2(float lo, float hi) { const f32x2_t v = {lo, hi}; return __builtin_bit_cast(unsigned, __builtin_convertvector(v, bf16x2_t)); }
__device__ __forceinline__ float bfround(float f) { return bf2f(f2bf(f)); }
__device__ __forceinline__ float sigmoidf_(float x) { return __builtin_amdgcn_rcpf(1.0f + __builtin_amdgcn_exp2f(x * -1.4426950408889634f)); }
__device__ __forceinline__ float siluf_(float x) { return x * sigmoidf_(x); }
__device__ __forceinline__ float wave_sum(float v) {
#pragma unroll
    for (int o = 1; o < 64; o <<= 1) v += __shfl_xor(v, o);
    return v;
}
__device__ __forceinline__ float pos_embed(const float* er, const float* ec, int t, int col) {
    return col < 512 ? er[(t >> 6) * 512 + col] : ec[(t & 63) * 512 + (col - 512)];
}
__device__ __forceinline__ float rstd_from_ssq(const float* ssq16) {
    const f32x4* s = (const f32x4*)ssq16; float tot = 0.f;
#pragma unroll
    for (int i = 0; i < 4; ++i) { const f32x4 v = s[i]; tot += (v[0] + v[1]) + (v[2] + v[3]); }
    return __builtin_amdgcn_rsqf(tot * (1.0f / D) + RMS_EPS);
}

__device__ __forceinline__ void transpose_item(const float* W, int K, int N, bf16_t* WT, int k0, int n0, int dst_row0, LAS float* scr, int lane, int ldk = 0, int koff = 0) {
    if (ldk == 0) ldk = K;
#pragma unroll 8
    for (int i = 0; i < 32; ++i) { const int kk = 2 * i + (lane >> 5); scr[kk * 33 + (lane & 31)] = W[(size_t)(k0 + kk) * N + n0 + (lane & 31)]; }
    asm volatile("s_waitcnt lgkmcnt(0)" ::: "memory");
    const int c = lane & 7;
#pragma unroll
    for (int j = 0; j < 4; ++j) { const int n = (lane >> 3) + 8 * j; const LAS float* s = scr + (8 * c) * 33 + n;
        u32x4 o; o.x = pk2(s[0 * 33], s[1 * 33]); o.y = pk2(s[2 * 33], s[3 * 33]); o.z = pk2(s[4 * 33], s[5 * 33]); o.w = pk2(s[6 * 33], s[7 * 33]);
        *(u32x4*)(WT + (size_t)(dst_row0 + n) * ldk + koff + k0 + 8 * c) = o; }
    asm volatile("s_waitcnt lgkmcnt(0)" ::: "memory");
}
__device__ __forceinline__ void transpose_matrix(const float* W, int K, int N, bf16_t* WT, LAS float* scr, int gw, int ngw, int lane, int ldk = 0, int koff = 0) {
    const int nblk = N / 32, items = (K / 64) * nblk;
    for (int it = gw; it < items; it += ngw) { const int kb = it / nblk, nb = it % nblk; transpose_item(W, K, N, WT, 64 * kb, 32 * nb, 32 * nb, scr, lane, ldk, koff); }
}
__device__ __forceinline__ void transpose_gu(const float* W, int half, bf16_t* WT, LAS float* scr, int gw, int ngw, int lane) {
    const int nblk = DFF / 32, items = (D / 64) * nblk;
    for (int it = gw; it < items; it += ngw) { const int kb = it / nblk, nb = it % nblk, n0 = 32 * nb;
        transpose_item(W, D, DFF, WT, 64 * kb, n0, 256 * (n0 >> 7) + 128 * half + (n0 & 127), scr, lane); }
}

template <bool GU, bool DEEP = false>
__device__ __forceinline__ void gemv17(const LAS float* xs, LAS float* part, const float* W, int N, const float* bias, float* out, int ldo, int half, int blk0, int nblk_stride) {
    const int tid = threadIdx.x, wid = tid >> 6, lane = tid & 63;
    for (int cb = blk0; cb < N / 64; cb += nblk_stride) {
        const int n = cb * 64 + lane;
        float acc[17];
#pragma unroll
        for (int r = 0; r < 17; ++r) acc[r] = 0.f;
        const float* wp = W + (size_t)(wid * 128) * N + n;
        if constexpr (DEEP) {
#pragma unroll 1
            for (int k0 = 0; k0 < 128; k0 += 16) { float w[16];
#pragma unroll
                for (int j = 0; j < 16; ++j) w[j] = wp[(size_t)(k0 + j) * N];
#pragma unroll
                for (int j = 0; j < 16; ++j) {
#pragma unroll
                    for (int r = 0; r < 17; ++r) acc[r] += xs[r * 1024 + wid * 128 + k0 + j] * w[j];
                    asm volatile("" ::: "memory"); } }
        } else {
#pragma unroll 4
        for (int k = 0; k < 128; ++k) { const float w = wp[(size_t)k * N];
#pragma unroll
            for (int r = 0; r < 17; ++r) acc[r] += xs[r * 1024 + wid * 128 + k] * w; } }
#pragma unroll
        for (int r = 0; r < 17; ++r) part[(wid * 17 + r) * 64 + lane] = acc[r];
        __syncthreads();
        for (int o = tid; o < 17 * 64; o += NTHR) { const int r = o >> 6, l = o & 63; float s = 0.f;
#pragma unroll
            for (int w = 0; w < 8; ++w) s += part[(w * 17 + r) * 64 + l];
            const int nn = cb * 64 + l; if (bias) s += bias[nn];
            const int on = GU ? (256 * (nn >> 7) + 128 * half + (nn & 127)) : nn;
            out[(size_t)r * ldo + on] = s; }
        __syncthreads();
    }
}

__device__ __forceinline__ void store_bf16x8(bf16_t* p, const float (&v)[8]) { u32x4 w; w.x = pk2(v[0], v[1]); w.y = pk2(v[2], v[3]); w.z = pk2(v[4], v[5]); w.w = pk2(v[6], v[7]); __builtin_nontemporal_store(w, (u32x4*)p); }
__device__ __forceinline__ void load_f32x8(const float* p, float (&v)[8]) { const f32x4 a = *(const f32x4*)p, b = *(const f32x4*)(p + 4); v[0] = a[0]; v[1] = a[1]; v[2] = a[2]; v[3] = a[3]; v[4] = b[0]; v[5] = b[1]; v[6] = b[2]; v[7] = b[3]; }
__device__ __forceinline__ void store_f32x8(float* p, const float (&v)[8]) { *(f32x4*)p = (f32x4){v[0], v[1], v[2], v[3]}; *(f32x4*)(p + 4) = (f32x4){v[4], v[5], v[6], v[7]}; }
__device__ __forceinline__ void unpack_bf16x8(const u32x4 w, float (&v)[8]) { v[0] = __uint_as_float(w.x << 16); v[1] = __uint_as_float(w.x & 0xffff0000u); v[2] = __uint_as_float(w.y << 16); v[3] = __uint_as_float(w.y & 0xffff0000u);
    v[4] = __uint_as_float(w.z << 16); v[5] = __uint_as_float(w.z & 0xffff0000u); v[6] = __uint_as_float(w.w << 16); v[7] = __uint_as_float(w.w & 0xffff0000u); }
__device__ __forceinline__ void load_bf16x8(const bf16_t* p, float (&v)[8]) { const u32x4 w = *(const u32x4*)p; v[0] = __uint_as_float(w.x << 16); v[1] = __uint_as_float(w.x & 0xffff0000u); v[2] = __uint_as_float(w.y << 16); v[3] = __uint_as_float(w.y & 0xffff0000u);
    v[4] = __uint_as_float(w.z << 16); v[5] = __uint_as_float(w.z & 0xffff0000u); v[6] = __uint_as_float(w.w << 16); v[7] = __uint_as_float(w.w & 0xffff0000u); }

struct EpiGateUp1 {
    static constexpr int PD = 1;
    struct Cols {}; struct Row {};
    bf16_t* hid;
    __device__ __forceinline__ void load_cols(Cols&, int, int, int) const {}
    __device__ __forceinline__ void load_row(Row&, int, int, int) const {}
    __device__ __forceinline__ float finish(int row, int pn, int c, const float (&v0)[8], const float (&v1)[8], const Cols&, const Row&) const {
        float o[8];
#pragma unroll
        for (int j = 0; j < 8; ++j) o[j] = siluf_(v0[j]) * v1[j];
        store_bf16x8(hid + (size_t)row * DFF + 128 * pn + c, o); return 0.f; }
};
struct EpiGateUp2 {
    static constexpr int PD = 8;
    struct Cols { float s0[8], s1[8]; }; struct Row { float rs; };
    bf16_t* hid; const float* rstd; const float* sw;
    __device__ __forceinline__ void load_cols(Cols& k, int pm, int pn, int c) const { const int b = pm >> 3; load_f32x8(sw + (size_t)b * NGU + 256 * pn + c, k.s0); load_f32x8(sw + (size_t)b * NGU + 256 * pn + 128 + c, k.s1); }
    __device__ __forceinline__ void load_row(Row& r, int row, int, int) const { r.rs = rstd[row]; }
    __device__ __forceinline__ float finish(int row, int pn, int c, const float (&v0)[8], const float (&v1)[8], const Cols& k, const Row& r) const {
        float o[8];
#pragma unroll
        for (int j = 0; j < 8; ++j) o[j] = siluf_(r.rs * v0[j] + k.s0[j]) * (r.rs * v1[j] + k.s1[j]);
        store_bf16x8(hid + (size_t)row * DFF + 128 * pn + c, o); return 0.f; }
};
struct EpiDown1 {
    static constexpr int PD = 4;
    struct Cols { float g0[8], g1[8], s0[8], s1[8]; }; struct Row { u32x4 b0, b1; };
    const bf16_t* hcb; const float* modv; bf16_t* hb; bf16_t* a2;
    __device__ __forceinline__ void load_cols(Cols& k, int pm, int pn, int c) const { const int b = pm < T / 256 ? (pm >> 3) : 16; const float* m = modv + (size_t)b * MODW + 256 * pn + c;
        load_f32x8(m + 2 * D, k.g0); load_f32x8(m + 2 * D + 128, k.g1); load_f32x8(m + 4 * D, k.s0); load_f32x8(m + 4 * D + 128, k.s1); }
    __device__ __forceinline__ void load_row(Row& r, int row, int pn, int c) const { const bf16_t* src = (row < T ? hb + (size_t)row * D : hcb + (size_t)(row - T) * D) + 256 * pn + c; r.b0 = *(const u32x4*)src; r.b1 = *(const u32x4*)(src + 128); }
    __device__ __forceinline__ float finish(int row, int pn, int c, const float (&v0)[8], const float (&v1)[8], const Cols& k, const Row& r) const {
        float b0[8], b1[8], h0[8], h1[8], a0[8], a1[8]; float s = 0.f; unpack_bf16x8(r.b0, b0); unpack_bf16x8(r.b1, b1);
#pragma unroll
        for (int j = 0; j < 8; ++j) { h0[j] = b0[j] + 0.5f * k.g0[j] * v0[j]; h1[j] = b1[j] + 0.5f * k.g1[j] * v1[j]; s += h0[j] * h0[j] + h1[j] * h1[j]; a0[j] = h0[j] * (1.0f + k.s0[j]); a1[j] = h1[j] * (1.0f + k.s1[j]); }
        const size_t o = (size_t)row * D + 256 * pn + c;
        if (row < T) { store_bf16x8(hb + o, h0); store_bf16x8(hb + o + 128, h1); }
        store_bf16x8(a2 + o, a0); store_bf16x8(a2 + o + 128, a1); return s; }
};
struct EpiWin {
    static constexpr int PD = 8;
    struct Cols { float s0[8], s1[8], l0[8], l1[8]; }; struct Row { float rs; };
    const float *rstd, *sw, *lbv; bf16_t *v, *q, *g, *hy, *gab; f16_t *lfw, *lbw;
    __device__ __forceinline__ void load_cols(Cols& k, int pm, int pn, int c) const { const int b = pm < T / 256 ? (pm >> 3) : 16; const int n = 256 * pn + c;
        load_f32x8(sw + (size_t)b * NIN + n, k.s0); load_f32x8(sw + (size_t)b * NIN + n + 128, k.s1);
        if (pn >= 2 && pn < 6) { load_f32x8(lbv + n - 512, k.l0); load_f32x8(lbv + n - 512 + 128, k.l1); } }
    __device__ __forceinline__ void load_row(Row& r, int row, int, int) const { r.rs = rstd[row]; }
    __device__ __forceinline__ void half_(int row, int n, float rs, const float (&a)[8], const float (&s)[8], const float (&lb)[8]) const {
        float p[8];
#pragma unroll
        for (int j = 0; j < 8; ++j) p[j] = rs * a[j] + s[j];
        const int grp = n >> 9;
        if (grp == 0) { store_bf16x8(v + (size_t)row * 512 + n, p); }
        else if (grp <= 2) { const int nn = n - 512 * grp; f16_t* dst = (grp == 1 ? lfw : lbw) + (size_t)row * 512 + nn; f16_t o[8];
#pragma unroll
            for (int j = 0; j < 8; ++j) { const float f = lb[j] + (1.0f - lb[j]) * sigmoidf_(p[j]); o[j] = (f16_t)__builtin_amdgcn_logf(f); }
            *(u32x4*)dst = *(const u32x4*)o; }
        else if (grp == 3) {
#pragma unroll
            for (int j = 0; j < 8; ++j) p[j] = siluf_(p[j]);
            store_bf16x8(q + (size_t)row * 512 + (n - 1536), p); }
        else if (grp == 4) {
#pragma unroll
            for (int j = 0; j < 8; ++j) p[j] = siluf_(p[j]);
            store_bf16x8(g + (size_t)row * 512 + (n - 2048), p); }
        else if (grp <= 7) { const int ch = n - 2560, t = row & (SEQ - 1), b = row >> 11; store_bf16x8(hy + (((size_t)(ch >> 3) * NB + b) * SEQ + t) * 8, p); }
        else {
#pragma unroll
            for (int j = 0; j < 8; ++j) p[j] = fmaxf(sigmoidf_(p[j]), 1e-18f);
            store_bf16x8(gab + (size_t)row * 2048 + (n - 4096), p); }
    }
    __device__ __forceinline__ float finish(int row, int pn, int c, const float (&v0)[8], const float (&v1)[8], const Cols& k, const Row& r) const {
        half_(row, 256 * pn + c, r.rs, v0, k.s0, k.l0); half_(row, 256 * pn + 128 + c, r.rs, v1, k.s1, k.l1); return 0.f; }
};
struct EpiProj {
    static constexpr int PD = 4; static constexpr bool TWOSTAGE = true;
    struct Cols {}; struct Row { u32x4 g0, g1; };
    const bf16_t* gab; bf16_t* y;
    __device__ __forceinline__ void load_cols(Cols&, int, int, int) const {}
    __device__ __forceinline__ void load_row(Row& r, int row, int pn, int c) const { const bf16_t* src = gab + (size_t)row * 2048 + 1024 + 256 * pn + c; r.g0 = *(const u32x4*)src; r.g1 = *(const u32x4*)(src + 128); }
    __device__ __forceinline__ float finish(int row, int pn, int c, const float (&v0)[8], const float (&v1)[8], const Cols&, const Row& r) const {
        float g0[8], g1[8], o0[8], o1[8]; unpack_bf16x8(r.g0, g0); unpack_bf16x8(r.g1, g1);
#pragma unroll
        for (int j = 0; j < 8; ++j) { o0[j] = g0[j] * v0[j]; o1[j] = g1[j] * v1[j]; }
        bf16_t* dst = y + (size_t)row * D + 256 * pn + c; store_bf16x8(dst, o0); store_bf16x8(dst + 128, o1); return 0.f; }
    struct MRow { u32x4 a0, a1, b0, b1; };
    __device__ __forceinline__ void load_mid(MRow& r, int row, int pn, int c) const { const bf16_t* src = gab + (size_t)row * 2048 + 256 * pn + c; r.a0 = *(const u32x4*)src; r.a1 = *(const u32x4*)(src + 128); r.b0 = *(const u32x4*)(src + 1024); r.b1 = *(const u32x4*)(src + 1024 + 128); }
    __device__ __forceinline__ void scale_mid(float (&v0)[8], float (&v1)[8], const MRow& r) const { float a[8], bq[8];
        unpack_bf16x8(r.a0, a); unpack_bf16x8(r.b0, bq);
#pragma unroll
        for (int j = 0; j < 8; ++j) v0[j] *= a[j] * __builtin_amdgcn_rcpf(bq[j]);
        unpack_bf16x8(r.a1, a); unpack_bf16x8(r.b1, bq);
#pragma unroll
        for (int j = 0; j < 8; ++j) v1[j] *= a[j] * __builtin_amdgcn_rcpf(bq[j]); }
};
struct EpiWout {
    static constexpr int PD = 4;
    struct Cols { float g0[8], g1[8], s0[8], s1[8]; }; struct Row { u32x4 b0, b1; };
    const float* modv; bf16_t* hb; bf16_t* a3;
    __device__ __forceinline__ void load_cols(Cols& k, int pm, int pn, int c) const { const float* m = modv + (size_t)(pm >> 3) * MODW + 256 * pn + c;
        load_f32x8(m + 5 * D, k.g0); load_f32x8(m + 5 * D + 128, k.g1); load_f32x8(m + 7 * D, k.s0); load_f32x8(m + 7 * D + 128, k.s1); }
    __device__ __forceinline__ void load_row(Row& r, int row, int pn, int c) const { const bf16_t* src = hb + (size_t)row * D + 256 * pn + c; r.b0 = *(const u32x4*)src; r.b1 = *(const u32x4*)(src + 128); }
    __device__ __forceinline__ float finish(int row, int pn, int c, const float (&v0)[8], const float (&v1)[8], const Cols& k, const Row& r) const {
        float b0[8], b1[8], h0[8], h1[8], a0[8], a1[8]; float s = 0.f; unpack_bf16x8(r.b0, b0); unpack_bf16x8(r.b1, b1);
#pragma unroll
        for (int j = 0; j < 8; ++j) { h0[j] = b0[j] + k.g0[j] * v0[j]; h1[j] = b1[j] + k.g1[j] * v1[j]; s += h0[j] * h0[j] + h1[j] * h1[j]; a0[j] = h0[j] * (1.0f + k.s0[j]); a1[j] = h1[j] * (1.0f + k.s1[j]); }
        const size_t o = (size_t)row * D + 256 * pn + c;
        store_bf16x8(hb + o, h0); store_bf16x8(hb + o + 128, h1); store_bf16x8(a3 + o, a0); store_bf16x8(a3 + o + 128, a1); return s; }
};
struct EpiDown2 {
    static constexpr int PD = 4;
    struct Cols { float g0[8], g1[8]; }; struct Row { u32x4 b0, b1; };
    const float* modv; const bf16_t* hb; bf16_t* h3;
    __device__ __forceinline__ void load_cols(Cols& k, int pm, int pn, int c) const { const float* m = modv + (size_t)(pm >> 3) * MODW + 8 * D + 256 * pn + c; load_f32x8(m, k.g0); load_f32x8(m + 128, k.g1); }
    __device__ __forceinline__ void load_row(Row& r, int row, int pn, int c) const { const bf16_t* src = hb + (size_t)row * D + 256 * pn + c; r.b0 = *(const u32x4*)src; r.b1 = *(const u32x4*)(src + 128); }
    __device__ __forceinline__ float finish(int row, int pn, int c, const float (&v0)[8], const float (&v1)[8], const Cols& k, const Row& r) const {
        float b0[8], b1[8], h0[8], h1[8]; float s = 0.f; unpack_bf16x8(r.b0, b0); unpack_bf16x8(r.b1, b1);
#pragma unroll
        for (int j = 0; j < 8; ++j) { h0[j] = b0[j] + 0.5f * k.g0[j] * v0[j]; h1[j] = b1[j] + 0.5f * k.g1[j] * v1[j]; s += h0[j] * h0[j] + h1[j] * h1[j]; }
        const size_t o = (size_t)row * D + 256 * pn + c; store_bf16x8(h3 + o, h0); store_bf16x8(h3 + o + 128, h1); return s; }
};

template <class Epi>
__device__ __forceinline__ void gemm_simple(LAS unsigned char* lds, const bf16_t* A, const bf16_t* Bt, int K, int row0, int nrows, int npn, const Epi& E, float* ssq) {
    LAS float* As = (LAS float*)lds;
    LAS float* Bs = (LAS float*)(lds + 8192);
    const int tid = threadIdx.x, c8 = tid & 15, rg = tid >> 4;
    const int nrt = nrows / 64, nunits = nrt * npn;
    for (int unit = blockIdx.x; unit < nunits; unit += gridDim.x) {
        const int rt = unit / npn, pn = unit % npn, r0 = row0 + rt * 64;
        float a0[2][8], a1[2][8];
#pragma unroll
        for (int r = 0; r < 2; ++r)
#pragma unroll
            for (int j = 0; j < 8; ++j) { a0[r][j] = 0.f; a1[r][j] = 0.f; }
        for (int k0 = 0; k0 < K; k0 += 32) {
            { const int row = tid >> 3, kq = tid & 7; const u32x2 w = *(const u32x2*)(A + (size_t)(r0 + row) * K + k0 + 4 * kq);
              As[(4 * kq + 0) * 64 + row] = __uint_as_float(w.x << 16); As[(4 * kq + 1) * 64 + row] = __uint_as_float(w.x & 0xffff0000u);
              As[(4 * kq + 2) * 64 + row] = __uint_as_float(w.y << 16); As[(4 * kq + 3) * 64 + row] = __uint_as_float(w.y & 0xffff0000u); }
            { const int n = tid >> 1, kh = tid & 1; const bf16_t* src = Bt + (size_t)(pn * 256 + n) * K + k0 + 16 * kh; float t8[8];
              load_bf16x8(src, t8);
#pragma unroll
              for (int i = 0; i < 8; ++i) Bs[(16 * kh + i) * 256 + n] = t8[i];
              load_bf16x8(src + 8, t8);
#pragma unroll
              for (int i = 0; i < 8; ++i) Bs[(16 * kh + 8 + i) * 256 + n] = t8[i]; }
            __syncthreads();
#pragma unroll 8
            for (int k = 0; k < 32; ++k) {
                const float x0 = As[k * 64 + 2 * rg], x1 = As[k * 64 + 2 * rg + 1];
                const f32x4 b00 = *(const LAS f32x4*)(Bs + k * 256 + 8 * c8), b01 = *(const LAS f32x4*)(Bs + k * 256 + 8 * c8 + 4);
                const f32x4 b10 = *(const LAS f32x4*)(Bs + k * 256 + 128 + 8 * c8), b11 = *(const LAS f32x4*)(Bs + k * 256 + 128 + 8 * c8 + 4);
#pragma unroll
                for (int j = 0; j < 4; ++j) { a0[0][j] += x0 * b00[j]; a0[0][4 + j] += x0 * b01[j]; a1[0][j] += x0 * b10[j]; a1[0][4 + j] += x0 * b11[j];
                                              a0[1][j] += x1 * b00[j]; a0[1][4 + j] += x1 * b01[j]; a1[1][j] += x1 * b10[j]; a1[1][4 + j] += x1 * b11[j]; }
            }
            __syncthreads();
        }
#pragma unroll
        for (int r = 0; r < 2; ++r) { const int row = r0 + 2 * rg + r; typename Epi::Cols kc; typename Epi::Row kr; E.load_cols(kc, row >> 8, pn, 8 * c8); E.load_row(kr, row, pn, 8 * c8); float s = E.finish(row, pn, 8 * c8, a0[r], a1[r], kc, kr);
            s += __shfl_xor(s, 1); s += __shfl_xor(s, 2); s += __shfl_xor(s, 4); s += __shfl_xor(s, 8);
            if (ssq && c8 == 0) *(f32x4*)(ssq + (size_t)row * 16 + pn * 4) = (f32x4){s, 0.f, 0.f, 0.f}; }
    }
}

namespace pg8 {
#define PG8_LAS __attribute__((address_space(3)))
typedef unsigned short bf16_t;
typedef short bf16x8 __attribute__((ext_vector_type(8)));
typedef float f32x4 __attribute__((ext_vector_type(4)));
typedef unsigned u32x4 __attribute__((ext_vector_type(4)));
constexpr int BM = 256, BK = 64, HALF = 128, HTB = HALF * BK * 2  , STAGE_BYTES = 8 * HTB, NXCD = 8, WGM = 8;

__host__ __device__ __forceinline__ int lds_byte(int r, int c) { const int st = (r >> 4) * 2 + (c >> 5), rr = r & 15, cc = c & 31, ob = rr * 64 + cc * 2; return st * 1024 + (ob ^ (((ob >> 9) & 1) << 5)); }
__host__ __device__ __forceinline__ void stage_rc(int b, int& R, int& C) { const int st = b / 1024, sb = b % 1024, swz = sb ^ (((sb >> 9) & 1) << 5); R = (st >> 1) * 16 + swz / 64; C = (st & 1) * 32 + (swz % 64) / 2; }
__host__ __device__ __forceinline__ int perm32(int rho) { const int n = rho >> 4, i = rho & 15; return 8 * (i >> 2) + 4 * n + (i & 3); }

struct Unit { int pm, pn, ko, stage; };
struct Gemm { const bf16_t* A; const bf16_t* Bt; int M, N, K, ld; };

struct StaticOrder {
    int nM, nN, nwg, G, c;
    __host__ __device__ void init(int M, int N, int G_, int c_) { nM = M / BM; nN = N / BM; nwg = nM * nN; G = G_; c = c_; }
    __host__ __device__ bool next(int i, Unit& u) const {
        const long L = (long)i * G + c; if (L >= nwg) return false;
        int wgid = (int)L; { const int q = nwg / NXCD, r = nwg % NXCD, xcd = wgid % NXCD, off = wgid / NXCD; wgid = (xcd < r ? xcd * (q + 1) : r * (q + 1) + (xcd - r) * q) + off; }
        const int nig = WGM * nN, gid = wgid / nig, fm = gid * WGM, gsz = (nM - fm) < WGM ? (nM - fm) : WGM;
        u.pm = fm + ((wgid % nig) % gsz); u.pn = (wgid % nig) / gsz; u.ko = 0; u.stage = 0; return true;
    }
    __device__ __forceinline__ void a_ready(const Unit&) const {}
    __device__ __forceinline__ void done(const Unit&) const {}
};
template <class Epi, class Sched>
__device__ __forceinline__ void gemm_phase(PG8_LAS unsigned char* lds, const Gemm g, const Sched& S, const Epi& E) {
    const int tid = threadIdx.x, wid = __builtin_amdgcn_readfirstlane(tid >> 6), lane = tid & 63, wr = wid >> 2, wc = wid & 3, fr = lane & 15, fq = lane >> 4;
    const int K = g.K, nt = K / BK, ld = g.ld ? g.ld : g.K;
    unsigned voffA[2], voffB[2];
#pragma unroll
    for (int i = 0; i < 2; ++i) { int R, C; stage_rc(tid * 16 + i * 8192, R, C); const int Rb = Epi::PERM ? ((R & ~31) + perm32(R & 31)) : R;
        voffA[i] = (unsigned)(R * ld + C) * 2u; voffB[i] = (unsigned)(Rb * ld + C) * 2u; }
    const size_t kstep = (size_t)(BK * 2);
    const size_t hstep = (size_t)HALF * ld * 2;
    const size_t tstep = 2 * hstep;
    const unsigned ldsw = (unsigned)wid * 1024u;
    const int aoff = lds_byte(wr * 64 + fr, fq * 8), boff = lds_byte(wc * 32 + fr, fq * 8);
#define PG8_SA(b, h) (((b) * 2 + (h)) * HTB)
#define PG8_SB(b, h) ((4 + (b) * 2 + (h)) * HTB)
#define PG8_STAGE(bufoff, gbase, voff) do { _Pragma("unroll") for (int _i = 0; _i < 2; ++_i) \
        __builtin_amdgcn_global_load_lds((const unsigned*)((const char*)(gbase) + (voff)[_i]), (PG8_LAS unsigned*)(lds + (bufoff) + ldsw + _i * 8192), 16, 0, 0); } while (0)
#define PG8_LDA(dst, b, h) do { _Pragma("unroll") for (int m = 0; m < 4; ++m) _Pragma("unroll") for (int k = 0; k < 2; ++k) dst[m][k] = *(const PG8_LAS bf16x8*)(lds + PG8_SA(b, h) + aoff + m * 2048 + k * 1024); } while (0)
#define PG8_LDB(dst, b, h) do { _Pragma("unroll") for (int n = 0; n < 2; ++n) _Pragma("unroll") for (int k = 0; k < 2; ++k) dst[n][k] = *(const PG8_LAS bf16x8*)(lds + PG8_SB(b, h) + boff + n * 2048 + k * 1024); } while (0)
#define PG8_MMA(ai, bj, At, Bt) do { __builtin_amdgcn_s_setprio(1); _Pragma("unroll") for (int m = 0; m < 4; ++m) _Pragma("unroll") for (int n = 0; n < 2; ++n) _Pragma("unroll") for (int k = 0; k < 2; ++k) \
        acc[ai][bj][m][n] = __builtin_amdgcn_mfma_f32_16x16x32_bf16(Bt[n][k], At[m][k], acc[ai][bj][m][n], 0, 0, 0); __builtin_amdgcn_s_setprio(0); } while (0)
#define PG8_WAIT_V(n) asm volatile("s_waitcnt vmcnt(" #n ")" ::: "memory")
#define PG8_WAIT_L(n) asm volatile("s_waitcnt lgkmcnt(" #n ")" ::: "memory")
#define PG8_BAR __builtin_amdgcn_s_barrier()
#define PG8_SCHED __builtin_amdgcn_sched_barrier(0)
    Unit cur, nxt; int ui = 0;
    if (!S.next(0, cur)) return;
    f32x4 acc[2][2][4][2];
#pragma unroll
    for (int a = 0; a < 2; ++a)
#pragma unroll
        for (int b = 0; b < 2; ++b)
#pragma unroll
            for (int m = 0; m < 4; ++m)
#pragma unroll
                for (int n = 0; n < 2; ++n) acc[a][b][m][n] = (f32x4){0.f, 0.f, 0.f, 0.f};
    bf16x8 At[4][2], B0[2][2], B1[2][2];
    const char* cA = (const char*)g.A + (size_t)cur.pm * tstep + cur.ko; const char* cB = (const char*)g.Bt + (size_t)cur.pn * tstep + cur.ko;
    S.a_ready(cur);
    PG8_STAGE(PG8_SB(0, 0), cB, voffB); PG8_STAGE(PG8_SA(0, 0), cA, voffA); PG8_STAGE(PG8_SB(0, 1), cB + hstep, voffB); PG8_STAGE(PG8_SA(0, 1), cA + hstep, voffA);
    if (wr == 1) PG8_BAR;
    PG8_WAIT_V(4); PG8_BAR;
    PG8_STAGE(PG8_SB(1, 0), cB + kstep, voffB); PG8_STAGE(PG8_SA(1, 0), cA + kstep, voffA); PG8_STAGE(PG8_SB(1, 1), cB + hstep + kstep, voffB);
    PG8_WAIT_V(6); PG8_BAR;
    for (;;) {
        const bool has_next = S.next(ui + 1, nxt);
        const char* nA = has_next ? (const char*)g.A + (size_t)nxt.pm * tstep + nxt.ko : cA; const char* nB = has_next ? (const char*)g.Bt + (size_t)nxt.pn * tstep + nxt.ko : cB;
        for (int t = 0; t < nt; t += 2) {
            const bool last = (t == nt - 2);
            const char* a1 = cA + (size_t)(t + 1) * kstep;
            const char* a2 = last ? nA : cA + (size_t)(t + 2) * kstep; const char* b2 = last ? nB : cB + (size_t)(t + 2) * kstep;
            const char* a3 = a2 + kstep; const char* b3 = b2 + kstep;
            if (last && has_next) S.a_ready(nxt);
            PG8_LDB(B0, 0, 0); PG8_SCHED; PG8_LDA(At, 0, 0); PG8_STAGE(PG8_SA(1, 1), a1 + hstep, voffA);
            PG8_WAIT_L(8); PG8_BAR; PG8_WAIT_L(0); PG8_MMA(0, 0, At, B0); PG8_BAR; PG8_SCHED;
            PG8_LDB(B1, 0, 1); PG8_STAGE(PG8_SB(0, 0), b2, voffB);
            PG8_BAR; PG8_WAIT_L(0); PG8_MMA(0, 1, At, B1); PG8_BAR;
            PG8_LDA(At, 0, 1); PG8_STAGE(PG8_SA(0, 0), a2, voffA);
            PG8_BAR; PG8_WAIT_L(0); PG8_MMA(1, 0, At, B0); PG8_BAR; PG8_SCHED;
            PG8_STAGE(PG8_SB(0, 1), b2 + hstep, voffB);
            PG8_WAIT_V(6); PG8_BAR; PG8_MMA(1, 1, At, B1); PG8_BAR;
            PG8_LDB(B0, 1, 0); PG8_SCHED; PG8_LDA(At, 1, 0); PG8_STAGE(PG8_SA(0, 1), a2 + hstep, voffA);
            PG8_WAIT_L(8); PG8_BAR; PG8_WAIT_L(0); PG8_MMA(0, 0, At, B0); PG8_BAR; PG8_SCHED;
            PG8_LDB(B1, 1, 1); PG8_STAGE(PG8_SB(1, 0), b3, voffB);
            PG8_BAR; PG8_WAIT_L(0); PG8_MMA(0, 1, At, B1); PG8_BAR;
            PG8_LDA(At, 1, 1); PG8_STAGE(PG8_SA(1, 0), a3, voffA);
            PG8_BAR; PG8_WAIT_L(0); PG8_MMA(1, 0, At, B0); PG8_BAR; PG8_SCHED;
            PG8_STAGE(PG8_SB(1, 1), b3 + hstep, voffB);
            PG8_WAIT_V(6); PG8_BAR; PG8_MMA(1, 1, At, B1); PG8_BAR;
        }
        const bool keep = Epi::TWOSTAGE && cur.stage == 1;
        if constexpr (!Epi::AFTER_DRAIN) { if (keep) E.mid(acc, cur, wr, wc, fr, fq); else E(acc, cur, wr, wc, fr, fq); S.done(cur); }
        if (!has_next) break;
        if (!keep)
#pragma unroll
        for (int a = 0; a < 2; ++a)
#pragma unroll
            for (int b = 0; b < 2; ++b)
#pragma unroll
                for (int m = 0; m < 4; ++m)
#pragma unroll
                    for (int n = 0; n < 2; ++n) acc[a][b][m][n] = (f32x4){0.f, 0.f, 0.f, 0.f};
        cur = nxt; cA = nA; cB = nB; ++ui;
    }
    PG8_WAIT_V(0);
    if (wr == 0) PG8_BAR;
    PG8_BAR;
    if constexpr (Epi::AFTER_DRAIN) { E.fused(acc, cur, wr, wc, fr, fq, lds, wid, lane); S.done(cur); }
#undef PG8_SA
#undef PG8_SB
#undef PG8_STAGE
#undef PG8_LDA
#undef PG8_LDB
#undef PG8_MMA
#undef PG8_WAIT_V
#undef PG8_WAIT_L
#undef PG8_BAR
#undef PG8_SCHED
}
}

template <class F, class = void> struct has_twostage { static constexpr bool value = false; };
template <class F> struct has_twostage<F, decltype((void)F::TWOSTAGE)> { static constexpr bool value = F::TWOSTAGE; };
template <class F> struct EpiAd {
    static constexpr bool PERM = true, AFTER_DRAIN = false, TWOSTAGE = has_twostage<F>::value;
    __device__ __forceinline__ void mid(pg8::f32x4 (&acc)[2][2][4][2], const pg8::Unit& u, int wr, int wc, int fr, int fq) const {
        if constexpr (TWOSTAGE) { constexpr int PD = 2;
            const int c = wc * 32 + 8 * fq, row0 = u.pm * 256 + wr * 64 + fr;
            typename F::MRow rd[PD];
#pragma unroll
            for (int s = 0; s < PD; ++s) f.load_mid(rd[s], row0 + (s >> 2) * 128 + (s & 3) * 16, u.pn, c);
#pragma unroll
            for (int s = 0; s < 8; ++s) { const int ai = s >> 2, m = s & 3; float v0[8], v1[8];
#pragma unroll
                for (int n = 0; n < 2; ++n)
#pragma unroll
                    for (int e = 0; e < 4; ++e) { v0[4 * n + e] = acc[ai][0][m][n][e]; v1[4 * n + e] = acc[ai][1][m][n][e]; }
                f.scale_mid(v0, v1, rd[s % PD]);
#pragma unroll
                for (int n = 0; n < 2; ++n)
#pragma unroll
                    for (int e = 0; e < 4; ++e) { acc[ai][0][m][n][e] = v0[4 * n + e]; acc[ai][1][m][n][e] = v1[4 * n + e]; }
                if (s + PD < 8) f.load_mid(rd[s % PD], row0 + ((s + PD) >> 2) * 128 + ((s + PD) & 3) * 16, u.pn, c); } } }
    F f; float* ssq;
    __device__ __forceinline__ void operator()(const pg8::f32x4 (&acc)[2][2][4][2], const pg8::Unit& u, int wr, int wc, int fr, int fq) const {
        constexpr int PD = F::PD;
        const int c = wc * 32 + 8 * fq, row0 = u.pm * 256 + wr * 64 + fr;
        typename F::Cols cols; f.load_cols(cols, u.pm, u.pn, c);
        typename F::Row rd[PD];
#pragma unroll
        for (int s = 0; s < PD; ++s) f.load_row(rd[s], row0 + (s >> 2) * 128 + (s & 3) * 16, u.pn, c);
#pragma unroll
        for (int s = 0; s < 8; ++s) { const int ai = s >> 2, m = s & 3, row = row0 + ai * 128 + m * 16;
            float v0[8], v1[8];
#pragma unroll
            for (int n = 0; n < 2; ++n)
#pragma unroll
                for (int e = 0; e < 4; ++e) { v0[4 * n + e] = acc[ai][0][m][n][e]; v1[4 * n + e] = acc[ai][1][m][n][e]; }
            float sq = f.finish(row, u.pn, c, v0, v1, cols, rd[s % PD]);
            if (ssq) { sq += __shfl_xor(sq, 16); sq += __shfl_xor(sq, 32); if (fq == 0) ssq[(size_t)row * 16 + u.pn * 4 + wc] = sq; }
            if (s + PD < 8) f.load_row(rd[s % PD], row0 + ((s + PD) >> 2) * 128 + ((s + PD) & 3) * 16, u.pn, c); }
    }
};
struct TwoPartOrder {
    pg8::StaticOrder s1; int n1, nM1, nM2, n2, G, c;
    __device__ void init(int nM1_, int nN1, int nM2_, int nN2, int G_, int c_) { s1.init(nM1_ * 256, nN1 * 256, G_, c_); n1 = nM1_ * nN1; nM1 = nM1_; nM2 = nM2_; n2 = nM2_ * nN2; G = G_; c = c_; }
    __device__ bool next(int i, pg8::Unit& u) const { long L = (long)i * G + c; if (L < n1) return s1.next(i, u); L -= n1; if (L >= n2) return false; u.pm = nM1 + (int)(L % nM2); u.pn = (int)(L / nM2); u.ko = 0; u.stage = 0; return true; }
    __device__ __forceinline__ void a_ready(const pg8::Unit&) const {}
    __device__ __forceinline__ void done(const pg8::Unit&) const {}
};
struct PairOrder {
    pg8::StaticOrder s1; int kbytes;
    __device__ void init(int M, int N, int G_, int c_, int kbytes_) { s1.init(M, N, G_, c_); kbytes = kbytes_; }
    __device__ bool next(int i, pg8::Unit& u) const { if (!s1.next(i >> 1, u)) return false; u.stage = (i & 1) ? 0 : 1; u.ko = (i & 1) ? kbytes : 0; return true; }
    __device__ __forceinline__ void a_ready(const pg8::Unit&) const {}
    __device__ __forceinline__ void done(const pg8::Unit&) const {}
};
template <class F>
__device__ __forceinline__ void gemm_pair(LAS unsigned char* lds, int vc, const bf16_t* A, const bf16_t* Bt, int Khalf, int nrows, int npn, const F& f) {
    __syncthreads();
    pg8::Gemm g{A, Bt, nrows, npn * 256, Khalf, 2 * Khalf}; PairOrder S; S.init(nrows, npn * 256, (int)gridDim.x, vc, Khalf * 2);
    EpiAd<F> E{f, nullptr};
    pg8::gemm_phase(lds, g, S, E);
    __syncthreads();
}
template <class F>
__device__ __forceinline__ void gemm_mfma(LAS unsigned char* lds, int vc, const bf16_t* A, const bf16_t* Bt, int K, int nrows1, int npn1, int nrows2, int npn2, const F& f, float* ssq) {
    __syncthreads();
    pg8::Gemm g{A, Bt, nrows1 + nrows2, npn1 * 256, K, 0}; TwoPartOrder S; S.init(nrows1 / 256, npn1, nrows2 / 256, npn2, (int)gridDim.x, vc);
    EpiAd<F> E{f, ssq};
    pg8::gemm_phase(lds, g, S, E);
    __syncthreads();
}

struct Ctx { LAS unsigned char* lds; int tid, lane, wid, gw, ngw, vc; };

struct VGrid { int vb, nvb; };
__device__ __forceinline__ void task_transposes_a(const Params& p, const Ctx& c, VGrid g) {
    LAS float* scr = (LAS float*)(c.lds + c.wid * 8448); const int gw = g.vb * NWAVES + c.wid, ngw = g.nvb * NWAVES;
    transpose_gu(p.ffn_wg, 0, (bf16_t*)(p.ws + WS_WG1_T), scr, gw, ngw, c.lane);
    transpose_gu(p.ffn_wu, 1, (bf16_t*)(p.ws + WS_WG1_T), scr, gw, ngw, c.lane);
}
__device__ __forceinline__ void task_transposes_b(const Params& p, const Ctx& c, VGrid g) {
    LAS float* scr = (LAS float*)(c.lds + c.wid * 8448); const int gw = g.vb * NWAVES + c.wid, ngw = g.nvb * NWAVES;
    transpose_matrix(p.ffn_wd, DFF, D, (bf16_t*)(p.ws + WS_WD1_T), scr, gw, ngw, c.lane);
    transpose_matrix(p.w_in, D, NIN, (bf16_t*)(p.ws + WS_WIN_T), scr, gw, ngw, c.lane);
}
__device__ __forceinline__ void task_transposes_c(const Params& p, const Ctx& c, VGrid g) {
    LAS float* scr = (LAS float*)(c.lds + c.wid * 8448); const int gw = g.vb * NWAVES + c.wid, ngw = g.nvb * NWAVES;
    transpose_matrix(p.w_pa, 512, D, (bf16_t*)(p.ws + WS_WPA_T), scr, gw, ngw, c.lane, 1024, 0);
    transpose_matrix(p.w_pb, 512, D, (bf16_t*)(p.ws + WS_WPA_T), scr, gw, ngw, c.lane, 1024, 512);
    transpose_matrix(p.w_out, D, D, (bf16_t*)(p.ws + WS_WOUT_T), scr, gw, ngw, c.lane);
}
__device__ __forceinline__ void task_transposes_d(const Params& p, const Ctx& c, VGrid g) {
    LAS float* scr = (LAS float*)(c.lds + c.wid * 8448); const int gw = g.vb * NWAVES + c.wid, ngw = g.nvb * NWAVES;
    transpose_gu(p.ffn_wg + (size_t)D * DFF, 0, (bf16_t*)(p.ws + WS_WG2_T), scr, gw, ngw, c.lane);
    transpose_gu(p.ffn_wu + (size_t)D * DFF, 1, (bf16_t*)(p.ws + WS_WG2_T), scr, gw, ngw, c.lane);
    transpose_matrix(p.ffn_wd + (size_t)DFF * D, DFF, D, (bf16_t*)(p.ws + WS_WD2_T), scr, gw, ngw, c.lane);
}
__device__ __forceinline__ void task_modv(const Params& p, const Ctx& c, VGrid g) {
    if (g.vb < MODW / 64) {
        LAS float* xs = (LAS float*)c.lds; LAS float* part = (LAS float*)(c.lds + 17 * 1024 * 4);
        __syncthreads();
        for (int i = c.tid; i < 17 * 1024; i += NTHR) { const int r = i >> 10, k = i & 1023; const float v = r < 16 ? p.c[r * D + k] : p.c_ctx[k]; xs[i] = v / (1.0f + expf(-v)); }
        __syncthreads();
        gemv17<false, true>(xs, part, p.mod_w, MODW, p.mod_b, (float*)(p.ws + WS_MODV), MODW, 0, g.vb, g.nvb);
    }
}
__device__ __forceinline__ void task_tables(const Params& p, const Ctx& c, VGrid g) {
    float* er = (float*)(p.ws + WS_ER); float* ec = (float*)(p.ws + WS_EC); float* lbv = (float*)(p.ws + WS_LBV);
    const int gt = g.vb * NTHR + c.tid, ngt = g.nvb * NTHR;
    for (int i = gt; i < 96 * 512; i += ngt) { const int r = i >> 9, j = i & 511, jj = j & 255; const float omega = 1.0f / powf(10000.0f, (float)jj / 256.0f);
        const int pos = r < 32 ? r : r - 32; const float a = (float)pos * omega; const float v = j < 256 ? sinf(a) : cosf(a);
        if (r < 32) er[r * 512 + j] = v; else ec[(r - 32) * 512 + j] = v; }
    for (int i = gt; i < 1024; i += ngt) { const float l0 = p.lb_logits[i], l1 = p.lb_logits[1024 + i]; lbv[i] = 1.0f / (1.0f + expf(l1 - l0)); }
}
__device__ __forceinline__ void task_h2(const Params& p, const Ctx& c, VGrid g) {
    LAS float* zf = (LAS float*)c.lds; LAS float* h1 = zf + 8 * 40; float* h2o = (float*)(p.ws + WS_H2);
    for (int it = g.vb; it < SEQ / 8; it += g.nvb) {
        __syncthreads();
        if (c.tid < 8 * 33) { const int r = c.tid / 33, f = c.tid % 33; const int pp = it * 8 + r; float v;
            if (f == 0) v = (float)pp / (float)(SEQ - 1);
            else { const int i = (f - 1) & 15; const float w = 6.283185307179586f * (float)pp / (float)SEQ; const float fr = 1e-4f + (float)i * ((15.0f - 1e-4f) / 15.0f); const float ang = w * fr; v = f <= 16 ? cosf(ang) : -sinf(ang); }
            zf[r * 40 + f] = v; }
        __syncthreads();
        { const int r = c.tid >> 6, j = c.tid & 63; float s = p.hb1[j];
#pragma unroll 3
          for (int f = 0; f < 33; ++f) s += zf[r * 40 + f] * p.hw1[f * 64 + j];
          h1[r * 64 + j] = sinf(p.hfr1[j] * s); }
        __syncthreads();
        { const int r = c.tid >> 6, j = c.tid & 63; float s = p.hb2[j];
#pragma unroll 4
          for (int k = 0; k < 64; ++k) s += h1[r * 64 + k] * p.hw2[k * 64 + j];
          h2o[(size_t)(it * 8 + r) * 64 + j] = sinf(p.hfr2[j] * s); }
    }
}
__device__ __forceinline__ void task_shift_gemv(const Params& p, const Ctx& c, VGrid g, int which) {
    const float* modv = (const float*)(p.ws + WS_MODV);
    LAS float* xs = (LAS float*)c.lds; LAS float* part = (LAS float*)(c.lds + 17 * 1024 * 4);
    const int nb_in = NIN / 64, nb_g = DFF / 64, nblk = which == 0 ? nb_in : 2 * nb_g;
    if (g.vb >= nblk) return;
    __syncthreads();
    for (int i = c.tid; i < 17 * 1024; i += NTHR) xs[i] = modv[(size_t)(i >> 10) * MODW + (which == 0 ? 3 : 6) * D + (i & 1023)];
    __syncthreads();
    for (int bx = g.vb; bx < nblk; bx += g.nvb) {
        if (which == 0) gemv17<false>(xs, part, p.w_in, NIN, nullptr, (float*)(p.ws + WS_SWIN), NIN, 0, bx, nb_in);
        else { const int half = bx / nb_g, blk = bx % nb_g; const float* W = (half ? p.ffn_wu : p.ffn_wg) + (size_t)D * DFF;
            gemv17<true>(xs, part, W, DFF, nullptr, (float*)(p.ws + WS_SW2), NGU, half, blk, nb_g); }
    }
}
__device__ __forceinline__ void task_filters(const Params& p, const Ctx& c, VGrid g, int item0, int item1) {
    LAS float* w3s = (LAS float*)c.lds;
    LAS float* hk = w3s + 512;
    LAS float* red = hk + 2048 * 8;
    const float* h2 = (const float*)(p.ws + WS_H2); bf16_t* krev = (bf16_t*)(p.ws + WS_KREV);
    for (int it = item0 + g.vb; it < item1; it += g.nvb) {
        const int c0 = 2 * it;
        __syncthreads();
        { const int k = c.tid >> 3, q = c.tid & 7; w3s[c.tid] = p.hw3[(size_t)k * 2048 + (q >> 2) * 1024 + ((q >> 1) & 1) * 512 + c0 + (q & 1)]; }
        __syncthreads();
        float l1 = 0.f;
        for (int idx = c.tid; idx < 2048 * 8; idx += NTHR) { const int t = idx >> 3, q = idx & 7; float s = 0.f;
            const float* hr = h2 + (size_t)t * 64;
#pragma unroll 8
            for (int k = 0; k < 64; ++k) s += hr[k] * w3s[k * 8 + q];
            const int ch = c0 + (q & 1); const float delta = fabsf(-3.0701134573253945f + (float)ch * ((-15.350567286626973f + 3.0701134573253945f) / 511.0f));
            const float tn = (float)t / (float)(SEQ - 1); s *= expf(-tn * delta) + 0.05f;
            hk[idx] = s; l1 += fabsf(s); }
        { float s = l1; s += __shfl_xor(s, 2); s += __shfl_xor(s, 8); s += __shfl_xor(s, 16); s += __shfl_xor(s, 32);
          if ((c.lane & ~5) == 0) red[c.wid * 4 + ((c.lane >> 2) & 1) * 2 + (c.lane & 1)] = s; }
        __syncthreads();
        for (int e = c.tid; e < 4 * KR_LEN; e += NTHR) { const int oc = e / KR_LEN, i = (e % KR_LEN) - KR_OFF, o = oc >> 1, cc = oc & 1;
            float tot = 0.f;
#pragma unroll
            for (int w = 0; w < 8; ++w) tot += red[w * 4 + oc];
            const int lag = -i; float v = 0.f;
            if (lag >= 0 && lag <= SEQ - 1) v = hk[lag * 8 + o * 4 + 0 + cc]; else if (lag < 0 && lag >= -(SEQ - 1)) v = hk[(-lag - 1) * 8 + o * 4 + 2 + cc];
            krev[((size_t)o * 512 + c0 + cc) * KR_LEN + (e % KR_LEN)] = f2bf(v / (tot + 1e-6f)); }
    }
}
__device__ __forceinline__ void phase_prep(const Params& p, const Ctx& c) {
    const int G = (int)gridDim.x, nmod = MODW / 64;
    if (G >= nmod + 32) {
        if ((int)blockIdx.x < nmod) task_modv(p, c, VGrid{(int)blockIdx.x, nmod});
        else { const VGrid g{(int)blockIdx.x - nmod, G - nmod}; task_transposes_a(p, c, g); task_tables(p, c, g); task_h2(p, c, g); }
    } else { const VGrid g{(int)blockIdx.x, G}; task_transposes_a(p, c, g); task_modv(p, c, g); task_tables(p, c, g); task_h2(p, c, g); }
}
__device__ __forceinline__ void phase_n1(const Params& p, const Ctx& c) {
    unsigned char* ws = p.ws;
    const float* modv = (const float*)(ws + WS_MODV); const float* er = (const float*)(ws + WS_ER); const float* ec = (const float*)(ws + WS_EC);
    bf16_t* n1 = (bf16_t*)(ws + WS_N1);
    constexpr int NR = 4;
    for (int row0 = NR * c.gw; row0 < MT; row0 += NR * c.ngw) {
        f32x4 v[NR][4]; const bool lat = row0 < T; const int b = lat ? (row0 >> 11) : 16;
#pragma unroll
        for (int r = 0; r < NR; ++r) { const int row = row0 + r; const int t = row & (SEQ - 1);
            const float* src = lat ? p.x + (size_t)row * D : p.ctx + (size_t)(row - T) * D;
#pragma unroll
            for (int j = 0; j < 4; ++j) { const int col = 4 * c.lane + 256 * j; v[r][j] = __builtin_nontemporal_load((const f32x4*)(src + col));
                if (lat) { const float* pe = col < 512 ? er + (t >> 6) * 512 + col : ec + (t & 63) * 512 + (col - 512); v[r][j] += *(const f32x4*)pe; } } }
        f32x4 sh[4], sc[4];
#pragma unroll
        for (int j = 0; j < 4; ++j) { const int col = 4 * c.lane + 256 * j; sh[j] = *(const f32x4*)(modv + (size_t)b * MODW + col); sc[j] = *(const f32x4*)(modv + (size_t)b * MODW + D + col) + 1.0f; }
#pragma unroll
        for (int r = 0; r < NR; ++r) { const int row = row0 + r;
            float ss = 0.f;
#pragma unroll
            for (int j = 0; j < 4; ++j) ss += (v[r][j][0] * v[r][j][0] + v[r][j][1] * v[r][j][1]) + (v[r][j][2] * v[r][j][2] + v[r][j][3] * v[r][j][3]);
            const float rs = __builtin_amdgcn_rsqf(wave_sum(ss) * (1.0f / D) + RMS_EPS);
            bf16_t* hdst = lat ? (bf16_t*)p.out + (size_t)row * D : (bf16_t*)(ws + WS_HCB) + (size_t)(row - T) * D;
#pragma unroll
            for (int j = 0; j < 4; ++j) { const int col = 4 * c.lane + 256 * j; u32x2 w; w.x = pk2(v[r][j][0], v[r][j][1]); w.y = pk2(v[r][j][2], v[r][j][3]); *(u32x2*)(hdst + col) = w;
                const f32x4 o = v[r][j] * rs * sc[j] + sh[j]; u32x2 w2; w2.x = pk2(o[0], o[1]); w2.y = pk2(o[2], o[3]); *(u32x2*)(n1 + (size_t)row * D + col) = w2; } }
    }
}
__device__ __forceinline__ bool filler_grid(VGrid& g, int vc, int nunits) {
    const int G = (int)gridDim.x, rem = nunits % G;
    if (rem == 0) { g.vb = vc; g.nvb = G; return true; }
    if (vc < rem) return false;
    g.vb = vc - rem; g.nvb = G - rem; return true;
}

__device__ __forceinline__ void phase_hgrn_simple(const Params& p, const Ctx& c) {
    unsigned char* ws = p.ws;
    const bf16_t* vb = (const bf16_t*)(ws + WS_V); const bf16_t* qb = (const bf16_t*)(ws + WS_Q);
    LAS float* F = (LAS float*)c.lds; LAS float* Kk = F + 64 * 128; LAS float* Q = Kk + 64 * 128; LAS float* V = Q + 64 * 128;
    const int dg = c.tid & 3, e = c.tid >> 2;
    for (int it = blockIdx.x; it < NB * 4 * 2; it += gridDim.x) {
        const int dir = it & 1, h = (it >> 1) & 3, b = it >> 3;
        const f16_t* lf = (const f16_t*)(ws + (dir ? WS_LBW : WS_LFW)); bf16_t* outp = ((bf16_t*)p.out + (size_t)T * D + (dir ? (size_t)T * 512 : 0));
        float S[32];
#pragma unroll
        for (int i = 0; i < 32; ++i) S[i] = 0.f;
        for (int ci = 0; ci < 36; ++ci) {
            const bool lat = ci >= 4;
            __syncthreads();
            for (int idx = c.tid; idx < 64 * 128; idx += NTHR) { const int j = idx >> 7, d = idx & 127; const int pp = (lat ? ci - 4 : ci) * 64 + j;
                const int row = lat ? b * SEQ + (dir ? SEQ - 1 - pp : pp) : T + b * CL + (dir ? CL - 1 - pp : pp);
                const float f = __builtin_amdgcn_exp2f((float)lf[(size_t)row * 512 + h * 128 + d]);
                F[idx] = f; Kk[idx] = 1.0f - f; V[idx] = bf2f(vb[(size_t)row * 512 + h * 128 + d]); Q[idx] = lat ? bf2f(qb[(size_t)row * 512 + h * 128 + d]) : 0.f; }
            __syncthreads();
            for (int j = 0; j < 64; ++j) { const float ve = V[j * 128 + e]; float part = 0.f;
#pragma unroll
                for (int i = 0; i < 32; ++i) { const int d = dg * 32 + i; S[i] = F[j * 128 + d] * S[i] + Kk[j * 128 + d] * ve; part += S[i] * Q[j * 128 + d]; }
                part += __shfl_xor(part, 1); part += __shfl_xor(part, 2);
                if (lat && dg == 0) { const int pp = (ci - 4) * 64 + j; const int row = b * SEQ + (dir ? SEQ - 1 - pp : pp); outp[(size_t)row * 512 + h * 128 + e] = f2bf(part); } }
        }
    }
}


typedef short bf16x8 __attribute__((ext_vector_type(8)));
constexpr int QROW = 136, TROW = 72;
__device__ __forceinline__ int hg_pos(int x) { return (x & ~31) + ((x >> 2) & 3) * 8 + ((x >> 4) & 1) * 4 + (x & 3); }
__device__ __forceinline__ pg8::f32x4 mfma16(bf16x8 a, bf16x8 b, pg8::f32x4 c) { return __builtin_amdgcn_mfma_f32_16x16x32_bf16(a, b, c, 0, 0, 0); }
__device__ __forceinline__ void phase_hgrn_mfma(const Params& p, const Ctx& c) {
    unsigned char* ws = p.ws;
    const bf16_t* vb = (const bf16_t*)(ws + WS_V); const bf16_t* qb = (const bf16_t*)(ws + WS_Q);
    constexpr int SET = 64 * QROW * 2 + 128 * TROW + 64 * TROW;
    LAS bf16_t* img = (LAS bf16_t*)c.lds;
    LAS float* Elb = (LAS float*)(img + 2 * SET);
    const int wid = c.wid, lane = c.lane, fr = lane & 15, fq = lane >> 4;
    const bool prep = wid < 4; const int aw = wid & 3;
    for (int it = c.vc; it < 256; it += gridDim.x) {
        const int dvh = (it >> 3) & 1, idx = (it & 7) | ((it >> 4) << 3), dir = idx & 1, h = (idx >> 1) & 3, b = idx >> 3;
        const f16_t* lf = (const f16_t*)(ws + (dir ? WS_LBW : WS_LFW)); bf16_t* outp = ((bf16_t*)p.out + (size_t)T * D + (dir ? (size_t)T * 512 : 0));
#define HG_ROW(ci_, p_) (((ci_) >= 4) ? (b * SEQ + (dir ? SEQ - 1 - (((ci_) - 4) * 64 + (p_)) : (((ci_) - 4) * 64 + (p_)))) : (T + b * CL + (dir ? CL - 1 - ((ci_) * 64 + (p_)) : ((ci_) * 64 + (p_)))))
        LAS float* qtb = Elb + 256;
        unsigned lfr[3][16], qr[3][16]; u32x4 vr[3][2];
        pg8::f32x4 S[8];
#pragma unroll
        for (int i = 0; i < 8; ++i) S[i] = (pg8::f32x4){0.f, 0.f, 0.f, 0.f};
        __syncthreads();
#define HG_LOAD(set_, ci_) do { const int cl_ = (ci_) < 36 ? (ci_) : 35;     \
            const int r0_ = HG_ROW(cl_, 16 * aw), q0_ = r0_ >= T ? r0_ - T : r0_;     \
            const char* pl_ = (const char*)(lf + (size_t)r0_ * 512 + colq); const char* pq_ = (const char*)(qb + (size_t)q0_ * 512 + colq); \
            if (dir) { asm volatile("; rows descending" ::: "memory"); _Pragma("unroll") for (int i = 0; i < 16; ++i) { lfr[set_][i] = *(const unsigned*)(pl_ - i * 1024); qr[set_][i] = *(const unsigned*)(pq_ - i * 1024); } } \
            else { asm volatile("; rows ascending" ::: "memory"); _Pragma("unroll") for (int i = 0; i < 16; ++i) { lfr[set_][i] = *(const unsigned*)(pl_ + i * 1024); qr[set_][i] = *(const unsigned*)(pq_ + i * 1024); } }     \
            const bf16_t* vs_ = vb + (size_t)(dir ? r0_ - (lanep >> 2) : r0_ + (lanep >> 2)) * 512 + colv; vr[set_][0] = *(const u32x4*)vs_; vr[set_][1] = *(const u32x4*)(vs_ + 8); } while (0)
#define HG_TOT(set_, ci_) do { { float t0 = 0.f, t1 = 0.f; \
            _Pragma("unroll") for (int i = 0; i < 16; ++i) { t0 += (float)__builtin_bit_cast(__fp16, (unsigned short)(lfr[set_][i] & 0xffffu)); t1 += (float)__builtin_bit_cast(__fp16, (unsigned short)(lfr[set_][i] >> 16)); } \
            qtb[(((ci_) & 1) * 4 + aw) * 128 + d0] = t0; qtb[(((ci_) & 1) * 4 + aw) * 128 + d0 + 1] = t1; } } while (0)
#define HG_EX2(x_) __builtin_amdgcn_exp2f(x_)
#define HG_PREP(set_, nset_, ci_, ld_) do { \
            LAS bf16_t* Qt = img + ((ci_) & 1) * SET; LAS bf16_t* Kt = Qt + 64 * QROW; LAS bf16_t* KhT = Kt + 64 * QROW; LAS bf16_t* VT = KhT + 128 * TROW; LAS float* El = Elb + ((ci_) & 1) * 128; \
            HG_TOT(nset_, (ci_) + 1); \
            float off0 = 0.f, off1 = 0.f, tot0 = 0.f, tot1 = 0.f; \
            _Pragma("unroll") for (int s_ = 0; s_ < 4; ++s_) { const float a0 = qtb[(((ci_) & 1) * 4 + s_) * 128 + d0], a1 = qtb[(((ci_) & 1) * 4 + s_) * 128 + d0 + 1]; tot0 += a0; tot1 += a1; if (s_ < aw) { off0 += a0; off1 += a1; } } \
            const float E0 = HG_EX2(tot0), E1 = HG_EX2(tot1); \
            if (aw == 0) { El[d0] = E0; El[d0 + 1] = E1; } \
            const int qpos = hg_pos(d0), base0 = 32 * (aw >> 1) + 4 * (aw & 1); float cu0 = off0, cu1 = off1, rp0 = HG_EX2(-off0), rp1 = HG_EX2(-off1);     \
            _Pragma("unroll") for (int q_ = 0; q_ < 4; ++q_) { float kh0[4], kh1[4]; \
                _Pragma("unroll") for (int r_ = 0; r_ < 4; ++r_) { const int i = 4 * q_ + r_, pp = 16 * aw + i; \
                    const float l0 = (float)__builtin_bit_cast(__fp16, (unsigned short)(lfr[set_][i] & 0xffffu)), l1 = (float)__builtin_bit_cast(__fp16, (unsigned short)(lfr[set_][i] >> 16)); \
                    cu0 += l0; cu1 += l1; \
                    const float e0 = HG_EX2(cu0), e1 = HG_EX2(cu1), r0 = HG_EX2(-cu0), r1 = HG_EX2(-cu1); \
                    const float k0 = (1.0f - e0 * rp0) * r0, k1 = (1.0f - e1 * rp1) * r1;     \
                    rp0 = r0; rp1 = r1; \
                    *(LAS unsigned*)(Kt + pp * QROW + qpos) = pk2(k0, k1); \
                    { const float q0 = __uint_as_float(qr[set_][i] << 16), q1 = __uint_as_float(qr[set_][i] & 0xffff0000u); *(LAS unsigned*)(Qt + pp * QROW + qpos) = pk2(q0 * e0, q1 * e1); }     \
                    kh0[r_] = k0 * E0; kh1[r_] = k1 * E1; } \
                u32x2 w; w.x = pk2(kh0[0], kh0[1]); w.y = pk2(kh0[2], kh0[3]); *(LAS u32x2*)(KhT + d0 * TROW + base0 + 8 * q_) = w; \
                w.x = pk2(kh1[0], kh1[1]); w.y = pk2(kh1[2], kh1[3]); *(LAS u32x2*)(KhT + (d0 + 1) * TROW + base0 + 8 * q_) = w; } \
            { const int sp = hg_pos(pv); const unsigned wv[8] = {vr[set_][0].x, vr[set_][0].y, vr[set_][0].z, vr[set_][0].w, vr[set_][1].x, vr[set_][1].y, vr[set_][1].z, vr[set_][1].w}; \
              _Pragma("unroll") for (int j = 0; j < 8; ++j) { VT[(e16 + 2 * j) * TROW + sp] = (bf16_t)(wv[j] & 0xffffu); VT[(e16 + 2 * j + 1) * TROW + sp] = (bf16_t)(wv[j] >> 16); } } \
            if (ld_) HG_LOAD(set_, (ci_) + 3); } while (0)
#if PROBE_HG_ROLE
        unsigned long long hgw = 0;
#define HG_BAR() do { asm volatile("s_waitcnt lgkmcnt(0)" ::: "memory"); const unsigned long long t0_ = __builtin_amdgcn_s_memrealtime(); __builtin_amdgcn_s_barrier(); asm volatile("" ::: "memory"); hgw += __builtin_amdgcn_s_memrealtime() - t0_; } while (0)
#else
#define HG_BAR() do { asm volatile("s_waitcnt lgkmcnt(0)" ::: "memory"); __builtin_amdgcn_s_barrier(); asm volatile("" ::: "memory"); } while (0)
#endif
        if (prep) {
            int lanep = lane; asm volatile("" : "+v"(lanep));
            const int d0 = 2 * lanep, colq = h * 128 + d0;
            const int pv = 16 * aw + (lanep >> 2), e16 = (lanep & 3) * 16, colv = h * 128 + dvh * 64 + e16;
            HG_LOAD(0, 0); HG_LOAD(1, 1); HG_LOAD(2, 2); HG_TOT(0, 0);
            HG_BAR();
            HG_PREP(0, 1, 0, 1);
            HG_BAR();
            for (int ci3 = 0; ci3 < 33; ci3 += 3) {
                HG_PREP(1, 2, ci3 + 1, 1);
                HG_BAR();
                HG_PREP(2, 0, ci3 + 2, 1);
                HG_BAR();
                HG_PREP(0, 1, ci3 + 3, 1);
                HG_BAR();
            }
            HG_PREP(1, 2, 34, 0);
            HG_BAR();
            HG_PREP(2, 0, 35, 0);
            HG_BAR();
            HG_BAR();
        } else {
            int frp = lane & 15, fqp = lane >> 4; asm volatile("" : "+v"(frp), "+v"(fqp)); const int fr = frp, fq = fqp;
            __builtin_amdgcn_s_waitcnt(0x0F70);
            HG_BAR(); HG_BAR();
#define HG_SB() __builtin_amdgcn_sched_barrier(0)
#define HG_KH(db_, a2_) (*(const LAS bf16x8*)(KhT + (16 * (db_) + fr) * TROW + 32 * (a2_) + 8 * fq))
#define HG_SUPD(db_) do { S[db_] = S[db_] * EL[db_]; S[db_] = mfma16(KH[2 * (db_)], VF[0], S[db_]); S[db_] = mfma16(KH[2 * (db_) + 1], VF[1], S[db_]); } while (0)
            for (int ci = 0; ci < 36; ++ci) {
                const bool lat = ci >= 4;
                const LAS bf16_t* Qt = img + (ci & 1) * SET; const LAS bf16_t* Kt = Qt + 64 * QROW; const LAS bf16_t* KhT = Kt + 64 * QROW; const LAS bf16_t* VT = KhT + 128 * TROW; const LAS float* El = Elb + (ci & 1) * 128;
                bf16x8 VF[2], KH[16]; pg8::f32x4 EL[8];
#pragma unroll
                for (int a2 = 0; a2 < 2; ++a2) VF[a2] = *(const LAS bf16x8*)(VT + (16 * aw + fr) * TROW + 32 * a2 + 8 * fq);
#pragma unroll
                for (int db = 0; db < 4; ++db) { EL[db] = *(const LAS pg8::f32x4*)(El + 16 * db + 4 * fq); KH[2 * db] = HG_KH(db, 0); KH[2 * db + 1] = HG_KH(db, 1); }
                HG_SB();
                bf16x8 SF[4];
#pragma unroll
                for (int k = 0; k < 4; ++k) { u32x4 w; w.x = pk2(S[2 * k][0], S[2 * k][1]); w.y = pk2(S[2 * k][2], S[2 * k][3]); w.z = pk2(S[2 * k + 1][0], S[2 * k + 1][1]); w.w = pk2(S[2 * k + 1][2], S[2 * k + 1][3]); SF[k] = __builtin_bit_cast(bf16x8, w); }
#pragma unroll
                for (int db = 4; db < 8; ++db) { EL[db] = *(const LAS pg8::f32x4*)(El + 16 * db + 4 * fq); KH[2 * db] = HG_KH(db, 0); KH[2 * db + 1] = HG_KH(db, 1); }
                HG_SB();
                HG_SUPD(0); HG_SUPD(1); HG_SUPD(2); HG_SUPD(3);
                if (lat) {
                    bf16x8 KF[16], QF[2][4];
#define HG_KQ(ti_) do { _Pragma("unroll") for (int k = 0; k < 4; ++k) { KF[4 * (ti_) + k] = *(const LAS bf16x8*)(Kt + (16 * (ti_) + fr) * QROW + 32 * k + 8 * fq); \
                        QF[(ti_) & 1][k] = *(const LAS bf16x8*)(Qt + (16 * (ti_) + fr) * QROW + 32 * k + 8 * fq); } } while (0)
                    HG_KQ(0);
                    HG_SB();
                    HG_SUPD(4); HG_SUPD(5); HG_SUPD(6); HG_SUPD(7);
#pragma unroll
                    for (int ti = 0; ti < 4; ++ti) {
                        if (ti < 3) HG_KQ(ti + 1);
                        HG_SB();
                        pg8::f32x4 o = (pg8::f32x4){0.f, 0.f, 0.f, 0.f};
#pragma unroll
                        for (int k = 0; k < 4; ++k) o = mfma16(SF[k], QF[ti & 1][k], o);
#pragma unroll
                        for (int a2 = 0; a2 < 2; ++a2) if (2 * a2 <= ti) {
                            pg8::f32x4 P[2];
#pragma unroll
                            for (int s2 = 0; s2 < 2; ++s2) { const int si = 2 * a2 + s2; pg8::f32x4 acc = (pg8::f32x4){0.f, 0.f, 0.f, 0.f};
                                if (si <= ti) {
#pragma unroll
                                    for (int k = 0; k < 4; ++k) acc = mfma16(KF[4 * si + k], QF[ti & 1][k], acc);
                                    if (si == ti) {
#pragma unroll
                                        for (int r = 0; r < 4; ++r) acc[r] = (4 * fq + r <= fr) ? acc[r] : 0.f; } }
                                P[s2] = acc; }
                            u32x4 w; w.x = pk2(P[0][0], P[0][1]); w.y = pk2(P[0][2], P[0][3]); w.z = pk2(P[1][0], P[1][1]); w.w = pk2(P[1][2], P[1][3]);
                            o = mfma16(VF[a2], __builtin_bit_cast(bf16x8, w), o); }
                        const int row = HG_ROW(ci, 16 * ti + fr);
                        u32x2 ow; ow.x = pk2(o[0], o[1]); ow.y = pk2(o[2], o[3]); *(u32x2*)(outp + (size_t)row * 512 + h * 128 + dvh * 64 + 16 * aw + 4 * fq) = ow;
                    }
#undef HG_KQ
                } else { HG_SUPD(4); HG_SUPD(5); HG_SUPD(6); HG_SUPD(7); }
                HG_BAR();
            }
#undef HG_SB
#undef HG_KH
#undef HG_SUPD
        }
#if PROBE_HG_ROLE
        if (blockIdx.x == 0 && wid == (PROBE_HG_ROLE == 1 ? 0 : 4) && lane == 0) ((unsigned long long*)(ws + WS_CTL + 16384))[17 * 256] = hgw;
#endif
#undef HG_BAR
#undef HG_LOAD
#undef HG_TOT
#undef HG_PREP
#undef HG_EX2
#undef HG_ROW
    }
}

constexpr int ZROW = 2056;
__device__ __forceinline__ void phase_hy_prepass(const Params& p, const Ctx& c) {
    bf16_t* hy = (bf16_t*)(p.ws + WS_HY);
    LAS bf16_t* raw = (LAS bf16_t*)c.lds;
    if (c.tid < 4) { ((LAS unsigned*)raw)[c.tid] = 0u; ((LAS unsigned*)(raw + 2049 * 8))[c.tid] = 0u; }
    for (int blk = blockIdx.x; blk < (NHY / 8) * NB; blk += gridDim.x) {
        bf16_t* base = hy + (size_t)blk * SEQ * 8; const int cg = blk / NB;
        u32x4 ch4[4];
#pragma unroll
        for (int i = 0; i < 4; ++i) ch4[i] = *(const u32x4*)(base + (size_t)(4 * c.tid + i) * 8);
        __syncthreads();
#pragma unroll
        for (int i = 0; i < 4; ++i) *(LAS u32x4*)(raw + (size_t)(1 + 4 * c.tid + i) * 8) = ch4[i];
        __syncthreads();
        const int ch = cg * 8 + c.wid; const float w0 = p.conv_w[ch], w1 = p.conv_w[NHY + ch], w2 = p.conv_w[2 * NHY + ch], cb = p.conv_b[ch];
#pragma unroll 4
        for (int k = 0; k < 16; ++k) { const int t = 2 * c.lane + 128 * k;
            const float x0 = bf2f(raw[(t + 0) * 8 + c.wid]), x1 = bf2f(raw[(t + 1) * 8 + c.wid]), x2 = bf2f(raw[(t + 2) * 8 + c.wid]), x3 = bf2f(raw[(t + 3) * 8 + c.wid]);
            *(unsigned*)(base + (size_t)c.wid * SEQ + t) = pk2(cb + w0 * x0 + w1 * x1 + w2 * x2, cb + w0 * x1 + w1 * x2 + w2 * x3); }
    }
}
template <int KIND>
__device__ __forceinline__ void hy_block(pg8::f32x4 (&acc)[16], bf16x8 (&Bw)[16], const LAS bf16_t* zl, const LAS bf16_t* krl, int ub, int i0, int lane) {
    const int fr = lane & 15, fq = lane >> 4;
    const LAS bf16_t* bbase = zl + fr * ZROW + 8 * fq;
    const int abase = KR_OFF - 16 * i0 - fr + 8 * fq;
    const unsigned sh = (unsigned)(fr & 1) * 16u;
#pragma unroll
    for (int uu = 0; uu < 16; ++uu) {
        const int u = ub + uu;
        const bool ldb = KIND == 0 ? (uu >= 1) : (KIND == 1 ? true : (uu == 0));
        if (ldb) Bw[(uu + 15) & 15] = *(const LAS bf16x8*)(bbase + 32 * (u + 15));
        const LAS unsigned* ap = (const LAS unsigned*)(krl + ((abase + 32 * u) & ~1));
        const unsigned d0 = ap[0], d1 = ap[1], d2 = ap[2], d3 = ap[3], d4 = ap[4];
        u32x4 aw; aw.x = __builtin_amdgcn_alignbit(d1, d0, sh); aw.y = __builtin_amdgcn_alignbit(d2, d1, sh); aw.z = __builtin_amdgcn_alignbit(d3, d2, sh); aw.w = __builtin_amdgcn_alignbit(d4, d3, sh);
        const bf16x8 A = __builtin_bit_cast(bf16x8, aw);
#pragma unroll
        for (int m = 0; m < 16; ++m) { const bool on = KIND == 0 ? (m >= 16 - uu) : (KIND == 1 ? true : (m <= 15 - uu));
            if (on) acc[m] = __builtin_amdgcn_mfma_f32_16x16x32_bf16(A, Bw[(uu + m) & 15], acc[m], 0, 0, 0); }
    }
}
__device__ __forceinline__ void hy_dma_img(LAS bf16_t* dst, const bf16_t* hy, int chx, int wid, int lane) {
#pragma unroll
    for (int i = 0; i < 8; ++i) { const int pc = wid + 8 * i, b = pc >> 2, k = pc & 3;
        __builtin_amdgcn_global_load_lds((const unsigned*)(hy + ((((size_t)(chx >> 3) * NB + b) * 8 + (chx & 7)) * SEQ) + 512 * k + 8 * lane), (LAS unsigned*)(dst + b * ZROW + 512 * k), 16, 0, 0); }
}
__device__ __forceinline__ void hy_dma_kr(LAS bf16_t* dst, const bf16_t* src, int wid, int lane) {
    __builtin_amdgcn_global_load_lds((const unsigned*)(src + 512 * wid + 8 * lane), (LAS unsigned*)(dst + 512 * wid), 16, 0, 0);
    if (wid == 0 && lane < (KR_LEN - 4096) / 8) __builtin_amdgcn_global_load_lds((const unsigned*)(src + 4096 + 8 * lane), (LAS unsigned*)(dst + 4096), 16, 0, 0);
}
__device__ __forceinline__ void hy_conv(pg8::f32x4 (&acc)[16], const LAS bf16_t* zl, const LAS bf16_t* krl, int i0, int lane) {
    bf16x8 Bw[16];
#pragma unroll
    for (int m = 0; m < 16; ++m) { acc[m] = (pg8::f32x4){0.f, 0.f, 0.f, 0.f}; Bw[m] = (bf16x8){0, 0, 0, 0, 0, 0, 0, 0}; }
    hy_block<0>(acc, Bw, zl, krl, -16, i0, lane);
    for (int ub = 0; ub < 48; ub += 16) hy_block<1>(acc, Bw, zl, krl, ub, i0, lane);
    hy_block<2>(acc, Bw, zl, krl, 48, i0, lane);
}
__device__ __forceinline__ void hy_gate(u32x2 (&res)[16], const pg8::f32x4 (&acc)[16], const LAS bf16_t* zl, const bf16_t* grow, float bias, int i0, int fr, int fq) {
    u32x2 gg[16];
#pragma unroll
    for (int m = 0; m < 16; ++m) gg[m] = *(const u32x2*)(grow + 16 * (i0 + 2 * m) + 4 * fq);
#pragma unroll
    for (int m = 0; m < 16; ++m) { const int t = 16 * (i0 + 2 * m) + 4 * fq; const u32x2 zo = *(const LAS u32x2*)(zl + fr * ZROW + t);
        const float z0 = __uint_as_float(zo.x << 16), z1 = __uint_as_float(zo.x & 0xffff0000u), z2 = __uint_as_float(zo.y << 16), z3 = __uint_as_float(zo.y & 0xffff0000u);
        const float g0 = __uint_as_float(gg[m].x << 16), g1 = __uint_as_float(gg[m].x & 0xffff0000u), g2 = __uint_as_float(gg[m].y << 16), g3 = __uint_as_float(gg[m].y & 0xffff0000u);
        res[m].x = pk2(g0 * (acc[m][0] + bias * z0), g1 * (acc[m][1] + bias * z1)); res[m].y = pk2(g2 * (acc[m][2] + bias * z2), g3 * (acc[m][3] + bias * z3)); }
}
__device__ __forceinline__ void phase_hyena_mfma(const Params& p, const Ctx& c) {
    unsigned char* ws = p.ws;
    const bf16_t* hy = (const bf16_t*)(ws + WS_HY); const bf16_t* krev = (const bf16_t*)(ws + WS_KREV); bf16_t* zb = (bf16_t*)(ws + WS_ZB);
    LAS bf16_t* zA = (LAS bf16_t*)c.lds;
    LAS bf16_t* zB = zA + NB * ZROW;
    LAS bf16_t* krA = zB + NB * ZROW;
    LAS bf16_t* krB = krA + KR_LEN;
    const int i0 = 32 * (c.wid >> 1) + (c.wid & 1), fr = c.lane & 15, fq = c.lane >> 4;
    __syncthreads();
    if ((int)blockIdx.x < BW) { hy_dma_img(zA, hy, blockIdx.x, c.wid, c.lane); hy_dma_kr(krA, krev + (size_t)blockIdx.x * KR_LEN, c.wid, c.lane); }
    asm volatile("s_waitcnt vmcnt(0)" ::: "memory"); __syncthreads();
    for (int ch = blockIdx.x; ch < BW; ch += gridDim.x) {
        const int nch = ch + gridDim.x;
        pg8::f32x4 acc[16]; u32x2 res[16];
        hy_dma_kr(krB, krev + ((size_t)512 + ch) * KR_LEN, c.wid, c.lane);
        hy_conv(acc, zA, krA, i0, c.lane);
        { const int chx = 512 + ch; hy_gate(res, acc, zA, hy + ((((size_t)(chx >> 3) * NB + fr) * 8 + (chx & 7)) * SEQ), p.hy_bias[ch], i0, fr, fq); }
#pragma unroll
        for (int m = 0; m < 16; ++m) *(LAS u32x2*)(zB + fr * ZROW + 16 * (i0 + 2 * m) + 4 * fq) = res[m];
        asm volatile("s_waitcnt vmcnt(0)" ::: "memory"); __syncthreads();
        if (nch < BW) { hy_dma_img(zA, hy, nch, c.wid, c.lane); hy_dma_kr(krA, krev + (size_t)nch * KR_LEN, c.wid, c.lane); }
        hy_conv(acc, zB, krB, i0, c.lane);
        { const int chx = 1024 + ch; hy_gate(res, acc, zB, hy + ((((size_t)(chx >> 3) * NB + fr) * 8 + (chx & 7)) * SEQ), p.hy_bias[512 + ch], i0, fr, fq); }
#pragma unroll
        for (int m = 0; m < 16; ++m) *(u32x2*)(zb + ((size_t)ch * NB + fr) * SEQ + 16 * (i0 + 2 * m) + 4 * fq) = res[m];
        asm volatile("s_waitcnt vmcnt(0)" ::: "memory"); __syncthreads();
    }
}

__device__ __forceinline__ void phase_combine(const Params& p, const Ctx& c) {
    unsigned char* ws = p.ws;
    const bf16_t* ofw = ((const bf16_t*)p.out + (size_t)T * D); const bf16_t* obw = ((const bf16_t*)p.out + (size_t)T * D + (size_t)T * 512); const bf16_t* g = (const bf16_t*)(ws + WS_G);
    bf16_t* oab = (bf16_t*)(ws + WS_OA); const bf16_t* zb = (const bf16_t*)(ws + WS_ZB);
    { const int col = 8 * c.lane; float w[8]; load_f32x8(p.a_norm_w + (col & 127), w);
      for (int row0 = 4 * c.gw; row0 < T; row0 += 4 * c.ngw) { u32x4 ra[4], rb[4], rg[4];
#pragma unroll
        for (int r = 0; r < 4; ++r) { const size_t o = (size_t)(row0 + r) * 512 + col; ra[r] = *(const u32x4*)(ofw + o); rb[r] = *(const u32x4*)(obw + o); rg[r] = *(const u32x4*)(g + o); }
#pragma unroll
        for (int r = 0; r < 4; ++r) { float a[8], bq[8], gg[8], o[8]; unpack_bf16x8(ra[r], a); unpack_bf16x8(rb[r], bq); unpack_bf16x8(rg[r], gg);
            float s = 0.f;
#pragma unroll
            for (int j = 0; j < 8; ++j) { a[j] += bq[j]; s += a[j] * a[j]; }
            s += __shfl_xor(s, 1); s += __shfl_xor(s, 2); s += __shfl_xor(s, 4); s += __shfl_xor(s, 8);
            const float rs = __builtin_amdgcn_rsqf(s * (1.0f / 128.0f) + RMS_EPS);
#pragma unroll
            for (int j = 0; j < 8; ++j) o[j] = a[j] * rs * w[j] * gg[j];
            store_bf16x8(oab + (size_t)(row0 + r) * 1024 + col, o); } } }
    LAS bf16_t* tile = (LAS bf16_t*)c.lds;
    for (int it = blockIdx.x; it < NB * 32 * 8; it += gridDim.x) { const int cb = it & 7, tb = (it >> 3) & 31, b = it >> 8;
        __syncthreads();
        { const int cl = c.tid >> 3, t8 = (c.tid & 7) * 8; const u32x4 w = *(const u32x4*)(zb + ((size_t)(cb * 64 + cl) * NB + b) * SEQ + tb * 64 + t8); *(LAS u32x4*)(tile + cl * 72 + t8) = w; }
        __syncthreads();
        { const int tl = c.tid >> 3, c8 = (c.tid & 7) * 8; bf16_t v[8];
#pragma unroll
          for (int i = 0; i < 8; ++i) v[i] = tile[(c8 + i) * 72 + tl];
          u32x4 w; w.x = v[0] | ((unsigned)v[1] << 16); w.y = v[2] | ((unsigned)v[3] << 16); w.z = v[4] | ((unsigned)v[5] << 16); w.w = v[6] | ((unsigned)v[7] << 16);
          *(u32x4*)(oab + ((size_t)b * SEQ + tb * 64 + tl) * 1024 + 512 + cb * 64 + c8) = w; }
    }
}

__device__ __forceinline__ void phase_rstd(const float* ssq, float* rstd, int nrows, const Ctx& c) {
    for (int row = blockIdx.x * NTHR + c.tid; row < nrows; row += gridDim.x * NTHR) rstd[row] = rstd_from_ssq(ssq + (size_t)row * 16);
}
__device__ __forceinline__ void phase_final(const Params& p, const Ctx& c) {
    const float* ssq = (const float*)(p.ws + WS_SSQ3); const bf16_t* h3 = (const bf16_t*)(p.ws + WS_H3);
    float w[2][8]; load_f32x8(p.fnw + 8 * c.lane, w[0]); load_f32x8(p.fnw + 8 * c.lane + 512, w[1]);
    for (int row0 = 4 * c.gw; row0 < T; row0 += 4 * c.ngw) { u32x4 hr[4][2]; float rs[4];
#pragma unroll
        for (int r = 0; r < 4; ++r) { rs[r] = rstd_from_ssq(ssq + (size_t)(row0 + r) * 16); hr[r][0] = *(const u32x4*)(h3 + (size_t)(row0 + r) * D + 8 * c.lane); hr[r][1] = *(const u32x4*)(h3 + (size_t)(row0 + r) * D + 8 * c.lane + 512); }
#pragma unroll
        for (int r = 0; r < 4; ++r)
#pragma unroll
            for (int j = 0; j < 2; ++j) { float h[8], o[8]; unpack_bf16x8(hr[r][j], h);
#pragma unroll
                for (int i = 0; i < 8; ++i) o[i] = h[i] * rs[r] * w[j][i];
                { float* dst = p.out + (size_t)(row0 + r) * D + 8 * c.lane + 512 * j; __builtin_nontemporal_store((f32x4){o[0], o[1], o[2], o[3]}, (f32x4*)dst); __builtin_nontemporal_store((f32x4){o[4], o[5], o[6], o[7]}, (f32x4*)(dst + 4)); } } }
}


#define XB_TMO      128
#define XB_XCNT(j)  (256  + 64 * (j))
#define XB_XSUB(j)  (1280 + 64 * (j))
#define XB_XGEN(j)  (2304 + 64 * (j))
#define XB_TOP      3328
#define XB_TOPGEN   3392
#define XCD_BAR_WORDS 3456
#define XB_SPIN_CAP (1u << 18)
__device__ __forceinline__ unsigned xb_ld(unsigned* p)              { return __hip_atomic_load(p, __ATOMIC_RELAXED, __HIP_MEMORY_SCOPE_AGENT); }
__device__ __forceinline__ unsigned xb_add(unsigned* p, unsigned v) { return __hip_atomic_fetch_add(p, v, __ATOMIC_RELAXED, __HIP_MEMORY_SCOPE_AGENT); }
__device__ __forceinline__ unsigned xb_xcc_id() { return (unsigned)__builtin_amdgcn_s_getreg((3 << 11) | 20) & 0xFu; }
#define XB_SPIN(cond, bar) do { unsigned _sp = 0; while (cond) { __builtin_amdgcn_s_sleep(1); \
    if ((++_sp & 255u) == 0u) { if (xb_ld(&(bar)[XB_TMO])) break; if (_sp > XB_SPIN_CAP) { atomicAdd(&(bar)[XB_TMO], 1u); break; } } } } while (0)
struct XcdBarrier { unsigned* bar; unsigned x; volatile LAS unsigned* st; };
__device__ __forceinline__ XcdBarrier xcd_barrier_post(unsigned* bar, volatile LAS unsigned* st) {
    XcdBarrier b; b.bar = bar; b.x = xb_xcc_id(); b.st = st;
    if (threadIdx.x == 0) st[2] = xb_add(&bar[XB_XCNT(b.x)], 1u);
    return b;
}
__device__ __forceinline__ void xcd_barrier_complete(unsigned* bar, unsigned x, unsigned& nloc, unsigned& nx) {
    const unsigned G = gridDim.x * gridDim.y * gridDim.z;
    unsigned sum, cnt, mine, sp = 0u;
    for (;;) {
        sum = 0u; cnt = 0u; mine = 0u;
#pragma unroll
        for (unsigned j = 0; j < 16; ++j) { const unsigned c = xb_ld(&bar[XB_XCNT(j)]); sum += c; cnt += (c > 0u) ? 1u : 0u; mine = (j == x) ? c : mine; }
        if (sum == G) break;
        __builtin_amdgcn_s_sleep(1);
        if ((++sp & 255u) == 0u) { if (xb_ld(&bar[XB_TMO])) break; if (sp > XB_SPIN_CAP) { atomicAdd(&bar[XB_TMO], 1u); break; } }
    }
    nloc = mine > 0u ? mine : 1u; nx = cnt > 0u ? cnt : 1u;
}
__device__ __forceinline__ void xcd_barrier(const XcdBarrier& b) {
    asm volatile("s_waitcnt vmcnt(0)" ::: "memory");
    __syncthreads();
    if (threadIdx.x == 0) {
        unsigned* bar = b.bar;
        __builtin_amdgcn_s_waitcnt(0);
        unsigned nloc = b.st[0], nx = b.st[1];
        if (nloc == 0u) { xcd_barrier_complete(bar, b.x, nloc, nx); b.st[0] = nloc; b.st[1] = nx; }
        const unsigned old = xb_add(&bar[XB_XSUB(b.x)], 1u);
        const unsigned gen = old / nloc;
        if (old + 1u == (gen + 1u) * nloc) {
            __builtin_amdgcn_fence(__ATOMIC_RELEASE, "agent");
            asm volatile("s_waitcnt vmcnt(0)" ::: "memory");
            const unsigned og = xb_add(&bar[XB_TOP], 1u);
            const unsigned tg = og / nx;
            if (og + 1u == (tg + 1u) * nx) xb_add(&bar[XB_TOPGEN], 1u);
            else XB_SPIN(xb_ld(&bar[XB_TOPGEN]) == tg, bar);
            __builtin_amdgcn_fence(__ATOMIC_ACQUIRE, "agent");
            xb_add(&bar[XB_XGEN(b.x)], 1u);
            asm volatile("s_waitcnt vmcnt(0)" ::: "memory");
        } else {
            XB_SPIN(xb_ld(&bar[XB_XGEN(b.x)]) == gen, bar);
            __builtin_amdgcn_fence(__ATOMIC_ACQUIRE, "agent");
            asm volatile("s_waitcnt vmcnt(0)" ::: "memory");
        }
    }
    __syncthreads();
}

constexpr int N_PHASES = 15;
#ifndef REPEAT_MASK
#define REPEAT_MASK 0
#endif
#ifndef HOST_REPEAT_MASK
#define HOST_REPEAT_MASK 0
#endif
#ifndef USE_XCD_BARRIER
#define USE_XCD_BARRIER 1
#endif
__global__ void __launch_bounds__(NTHR, 2) fwd_kernel(Params p) {
    extern __shared__ __attribute__((aligned(16))) unsigned char lds_raw[];
    Ctx c; c.lds = (LAS unsigned char*)lds_raw; c.tid = threadIdx.x; c.lane = c.tid & 63; c.wid = __builtin_amdgcn_readfirstlane(c.tid >> 6);
    c.gw = blockIdx.x * NWAVES + c.wid; c.ngw = gridDim.x * NWAVES; c.vc = blockIdx.x;
    unsigned char* ws = p.ws;
    const float* modv = (const float*)(ws + WS_MODV);
#if N_LAUNCH_MODE == 1
    cg::grid_group grid = cg::this_grid();
#if USE_XCD_BARRIER
    volatile LAS unsigned* xst = (volatile LAS unsigned*)(c.lds + LDS_BYTES - 16);
    if (c.tid < 4) xst[c.tid] = 0u;
    __syncthreads();
    XcdBarrier xbar = xcd_barrier_post((unsigned*)(ws + WS_CTL), xst);
    bool first_seam = true;
#define SEAM() do { if (first_seam) { if (p.ph_lo < 0) grid.sync();   xcd_barrier(xbar); first_seam = false; \
        if (c.tid == 0) { unsigned* bar_ = (unsigned*)(ws + WS_CTL); bool ok_ = (gridDim.x % 8u) == 0u; for (unsigned j_ = 0; j_ < 16; ++j_) { const unsigned n_ = xb_ld(&bar_[XB_XCNT(j_)]); ok_ = ok_ && (j_ < 8 ? n_ == gridDim.x / 8u : n_ == 0u); } \
            xst[3] = ok_ ? (xst[2] * 8u + xbar.x) : blockIdx.x; } \
        __syncthreads(); c.vc = (int)xst[3]; } else xcd_barrier(xbar); } while (0)
#else
#define SEAM() grid.sync()
#endif
#else
#define SEAM() do { } while (0)
#endif
#ifdef ONLY_PHASE
#define IN(k) ((k) == ONLY_PHASE && p.ph_lo <= (k) && (k) < p.ph_hi)
#else
#define IN(k) (p.ph_lo <= (k) && (k) < p.ph_hi)
#endif
#if PROBE_TS_MASK
#define TS_STAMP(k) do { if (c.tid == 0) ((unsigned long long*)(ws + WS_CTL + 16384))[(k) * 256 + blockIdx.x] = __builtin_amdgcn_s_memrealtime(); } while (0)
#else
#define TS_STAMP(k) do { } while (0)
#endif
#define PHASE(k, ...) if (IN(k)) { for (int rep_ = 0; rep_ <= ((REPEAT_MASK >> (k)) & 1); ++rep_) { __VA_ARGS__; if (rep_ < ((REPEAT_MASK >> (k)) & 1)) SEAM(); } TS_STAMP(k); if (IN((k) + 1)) SEAM(); }
    TS_STAMP(16);
#if USE_PG8
#define GEMM2(A_, Bt_, K_, nrows1_, npn1_, nrows2_, npn2_, E_, ssq_) gemm_mfma(c.lds, c.vc, A_, Bt_, K_, nrows1_, npn1_, nrows2_, npn2_, E_, ssq_)
#else
#define GEMM2(A_, Bt_, K_, nrows1_, npn1_, nrows2_, npn2_, E_, ssq_) do { gemm_simple(c.lds, A_, Bt_, K_, 0, nrows1_, npn1_, E_, ssq_); if ((nrows2_) > 0) gemm_simple(c.lds, A_, Bt_, K_, nrows1_, nrows2_, npn2_, E_, ssq_); } while (0)
#endif
#define GEMM(A_, Bt_, K_, nrows_, npn_, E_, ssq_) GEMM2(A_, Bt_, K_, nrows_, npn_, 0, 0, E_, ssq_)
    PHASE(0, phase_prep(p, c))
    PHASE(1, phase_n1(p, c))
    PHASE(2, { EpiGateUp1 E{(bf16_t*)(ws + WS_HID)};
        GEMM((const bf16_t*)(ws + WS_N1), (const bf16_t*)(ws + WS_WG1_T), D, MT, NGU / 256, E, nullptr);
        VGrid g; if (filler_grid(g, c.vc, (MT / 256) * (NGU / 256))) { task_transposes_b(p, c, g); task_shift_gemv(p, c, g, 0); } })
    PHASE(3, { EpiDown1 E{(const bf16_t*)(ws + WS_HCB), modv, (bf16_t*)p.out, (bf16_t*)(ws + WS_A2)};
        GEMM((const bf16_t*)(ws + WS_HID), (const bf16_t*)(ws + WS_WD1_T), DFF, MT, D / 256, E, (float*)(ws + WS_SSQ1));
        VGrid g; if (filler_grid(g, c.vc, (MT / 256) * (D / 256))) { task_transposes_c(p, c, g); task_shift_gemv(p, c, g, 1); task_filters(p, c, g, 0, 192); __syncthreads(); task_transposes_d(p, c, g); } })
    PHASE(4, phase_rstd((const float*)(ws + WS_SSQ1), (float*)(ws + WS_RSTD1), MT, c))
    PHASE(5, { EpiWin E{(const float*)(ws + WS_RSTD1), (const float*)(ws + WS_SWIN), (const float*)(ws + WS_LBV), (bf16_t*)(ws + WS_V), (bf16_t*)(ws + WS_Q), (bf16_t*)(ws + WS_G), (bf16_t*)(ws + WS_HY), (bf16_t*)(ws + WS_GAB), (f16_t*)(ws + WS_LFW), (f16_t*)(ws + WS_LBW)};
        GEMM2((const bf16_t*)(ws + WS_A2), (const bf16_t*)(ws + WS_WIN_T), D, T, NIN / 256, TC, 6, E, nullptr);
        VGrid g; if (filler_grid(g, c.vc, (T / 256) * (NIN / 256) + (TC / 256) * 6)) task_filters(p, c, g, 192, 256); })
    PHASE(6, { if (USE_MFMA_HGRN) phase_hgrn_mfma(p, c); else phase_hgrn_simple(p, c);
        TS_STAMP(15); __syncthreads(); phase_hy_prepass(p, c); })
    PHASE(7, phase_hyena_mfma(p, c))
    PHASE(8, phase_combine(p, c))
    PHASE(9, { EpiProj E{(const bf16_t*)(ws + WS_GAB), (bf16_t*)(ws + WS_Y)};
        gemm_pair(c.lds, c.vc, (const bf16_t*)(ws + WS_OA), (const bf16_t*)(ws + WS_WPA_T), 512, T, D / 256, E); })
    PHASE(10, { EpiWout E{modv, (bf16_t*)p.out, (bf16_t*)(ws + WS_A3)};
        GEMM((const bf16_t*)(ws + WS_Y), (const bf16_t*)(ws + WS_WOUT_T), D, T, D / 256, E, (float*)(ws + WS_SSQ2)); })
    PHASE(11, phase_rstd((const float*)(ws + WS_SSQ2), (float*)(ws + WS_RSTD2), T, c))
    PHASE(12, { EpiGateUp2 E{(bf16_t*)(ws + WS_HID2), (const float*)(ws + WS_RSTD2), (const float*)(ws + WS_SW2)};
        GEMM((const bf16_t*)(ws + WS_A3), (const bf16_t*)(ws + WS_WG2_T), D, T, NGU / 256, E, nullptr); })
    PHASE(13, { EpiDown2 E{modv, (const bf16_t*)p.out, (bf16_t*)(ws + WS_H3)};
        GEMM((const bf16_t*)(ws + WS_HID2), (const bf16_t*)(ws + WS_WD2_T), DFF, T, D / 256, E, (float*)(ws + WS_SSQ3)); })
    PHASE(14, phase_final(p, c))
#if PROBE_TS_MASK
    SEAM();
    if (blockIdx.x == 0 && c.tid == 0) {
        const unsigned long long* ts = (const unsigned long long*)(ws + WS_CTL + 16384); unsigned long long tot = 0;
        for (int k = 0; k < 16; ++k) if ((PROBE_TS_MASK >> k) & 1) { unsigned long long a = 0, b = 0; const int kp = k == 0 ? 16 : (k == 15 ? 5 : k - 1);
            for (int w = 0; w < (int)gridDim.x; ++w) { const unsigned long long x = __hip_atomic_load(ts + k * 256 + w, __ATOMIC_RELAXED, __HIP_MEMORY_SCOPE_AGENT), y = __hip_atomic_load(ts + kp * 256 + w, __ATOMIC_RELAXED, __HIP_MEMORY_SCOPE_AGENT); a = x > a ? x : a; b = y > b ? y : b; }
            tot += a - b; }
#if PROBE_HG_ROLE
        tot = __hip_atomic_load(ts + 17 * 256, __ATOMIC_RELAXED, __HIP_MEMORY_SCOPE_AGENT);
#endif
        const unsigned long long t0 = __builtin_amdgcn_s_memrealtime();
        while (__builtin_amdgcn_s_memrealtime() - t0 < tot * 8ull) __builtin_amdgcn_s_sleep(8);
    }
#endif
}

extern "C" void kernel_launch(void* const* d_in, const int* in_sizes, int n_in, void* d_out, int out_size, void* d_ws, size_t ws_size, hipStream_t stream) {
    static int grid = 0;
    if (grid == 0) {
        if (n_in != 26 || in_sizes[0] != T * D || out_size != T * D || ws_size < WS_TOTAL) { fprintf(stderr, "kernel_launch: unexpected shapes (n_in %d, in0 %d, out %d, ws %zu < %zu)\n", n_in, n_in > 0 ? in_sizes[0] : -1, out_size, ws_size, (size_t)WS_TOTAL); grid = -1; return; }
        int dev = 0, cus = 0, per_cu = 0;
        (void)hipGetDevice(&dev); (void)hipDeviceGetAttribute(&cus, hipDeviceAttributeMultiprocessorCount, dev);
        if (hipFuncSetAttribute((const void*)fwd_kernel, hipFuncAttributeMaxDynamicSharedMemorySize, LDS_BYTES) != hipSuccess) { fprintf(stderr, "kernel_launch: hipFuncSetAttribute failed\n"); grid = -1; return; }
        (void)hipOccupancyMaxActiveBlocksPerMultiprocessor(&per_cu, (const void*)fwd_kernel, NTHR, LDS_BYTES);
        if (per_cu < 1) { fprintf(stderr, "kernel_launch: occupancy query says %d blocks per CU\n", per_cu); per_cu = 1; }
        (void)hipGetLastError();
        grid = cus;
    }
    if (grid < 0) return;
    Params p{};
    const float** f = (const float**)&p;
    for (int i = 0; i < 26; ++i) f[i] = (const float*)d_in[i];
    p.out = (float*)d_out; p.ws = (unsigned char*)d_ws;
#if N_LAUNCH_MODE == 1
    p.ph_lo = 0; p.ph_hi = N_PHASES;
#if USE_XCD_BARRIER
    (void)hipMemsetAsync((unsigned char*)d_ws + WS_CTL, 0, XCD_BAR_WORDS * 4, stream);
#endif
    void* args[] = {&p};
    hipError_t e = hipLaunchCooperativeKernel((const void*)fwd_kernel, dim3(grid), dim3(NTHR), args, LDS_BYTES, stream);
    if (e != hipSuccess) fprintf(stderr, "cooperative launch failed: %s (grid %d)\n", hipGetErrorString(e), grid);
#else
    for (int k = 0; k < N_PHASES; ++k) { p.ph_lo = k; p.ph_hi = k + 1; for (int r = 0; r <= ((HOST_REPEAT_MASK >> k) & 1); ++r) hipLaunchKernelGGL(fwd_kernel, dim3(grid), dim3(NTHR), LDS_BYTES, stream, p); }
#endif
}
```

```cpp
#include <hip/hip_runtime.h>
#include <hip/hip_cooperative_groups.h>
#include <cstdio>
namespace cg = cooperative_groups;

#ifndef N_LAUNCH_MODE
#define N_LAUNCH_MODE 1
#endif
#ifndef USE_MFMA_HYENA
#define USE_MFMA_HYENA 1
#endif
#ifndef USE_MFMA_HGRN
#define USE_MFMA_HGRN 1
#endif
#ifndef PROBE_TS_MASK
#define PROBE_HG_ROLE 0
#define PROBE_P3_CUT 0
#define PROBE_P0_CUT 1
#define PROBE_TS_MASK 0
#if PROBE_TS_MASK
#define TS_SUB(p_, slot_) do { if (threadIdx.x == 0) ((unsigned long long*)((p_).ws + WS_CTL + 16384))[(slot_) * 256 + blockIdx.x] = __builtin_amdgcn_s_memrealtime(); } while (0)
#else
#define TS_SUB(p_, slot_) do { } while (0)
#endif
#endif
#ifndef USE_PG8
#define USE_PG8 1
#endif

#define LAS __attribute__((address_space(3)))
typedef unsigned short bf16_t;
typedef _Float16 f16_t;
typedef float f32x4 __attribute__((ext_vector_type(4)));
typedef unsigned u32x4 __attribute__((ext_vector_type(4)));
typedef unsigned u32x2 __attribute__((ext_vector_type(2)));

constexpr int D = 1024, NB = 16, SEQ = 2048, T = NB * SEQ, CL = 256, TC = NB * CL, MT = T + TC;
constexpr int DFF = 2816, NGU = 2 * DFF, NIN = 6144, MODW = 9 * D;
constexpr int AKW = 512, AVW = 512, BW = 512, NHY = 3 * BW;
constexpr int KR_LEN = 4128, KR_OFF = 2056;
constexpr float RMS_EPS = 1e-6f;
constexpr int NTHR = 512, NWAVES = 8;
constexpr int LDS_BYTES = 152 * 1024;

constexpr size_t MiB = 1024 * 1024;
constexpr size_t al256(size_t x) { return (x + 255) & ~(size_t)255; }
constexpr size_t WS_CTL = 0;
constexpr size_t WS_MODV = WS_CTL + 65536;
constexpr size_t WS_SWIN = WS_MODV + al256((size_t)17 * MODW * 4);
constexpr size_t WS_SW2 = WS_SWIN + al256((size_t)17 * NIN * 4);
constexpr size_t WS_ER = WS_SW2 + al256((size_t)17 * NGU * 4);
constexpr size_t WS_EC = WS_ER + 32 * 512 * 4;
constexpr size_t WS_LBV = WS_EC + 64 * 512 * 4;
constexpr size_t WS_H2 = WS_LBV + 4096;
constexpr size_t WS_KREV = WS_H2 + 2048 * 64 * 4;
constexpr size_t WS_WIN_T = WS_KREV + al256((size_t)2 * 512 * KR_LEN * 2);
constexpr size_t WS_WPA_T = WS_WIN_T + (size_t)NIN * D * 2;
constexpr size_t WS_WPB_T = WS_WPA_T + (size_t)D * 512 * 2;
constexpr size_t WS_WOUT_T = WS_WPB_T + (size_t)D * 512 * 2;
constexpr size_t WS_RSTD1 = WS_WOUT_T + (size_t)D * D * 2;
constexpr size_t WS_RSTD2 = WS_RSTD1 + (size_t)MT * 4;
constexpr size_t WS_PERSIST_END = WS_RSTD2 + (size_t)T * 4;
constexpr size_t AR = 27 * MiB;
static_assert(WS_PERSIST_END <= AR, "persistent region");
constexpr size_t WS_HID = AR + 0 * MiB;
constexpr size_t WS_N1 = AR + 198 * MiB;
constexpr size_t WS_PART = AR + 198 * MiB;
constexpr size_t WS_WG1_T = AR + 270 * MiB;
constexpr size_t WS_WD1_T = AR + 281 * MiB;
constexpr size_t WS_HCB = AR + 290 * MiB;
constexpr size_t WS_SSQ1 = AR + 286 * MiB + 512 * 1024;
constexpr size_t WS_A2 = AR + 413 * MiB;
constexpr size_t WS_GAB = AR + 0 * MiB;
constexpr size_t WS_V = AR + 128 * MiB;
constexpr size_t WS_LFW = AR + 164 * MiB;
constexpr size_t WS_LBW = AR + 200 * MiB;
constexpr size_t WS_Q = AR + 236 * MiB;
constexpr size_t WS_G = AR + 268 * MiB;
constexpr size_t WS_HY = AR + 300 * MiB;
constexpr size_t WS_WG2_T = AR + 396 * MiB;
constexpr size_t WS_WD2_T = AR + 407 * MiB;
constexpr size_t WS_ZB = AR + 453 * MiB;
constexpr size_t WS_OA = AR + 128 * MiB;
constexpr size_t WS_Y = AR + 320 * MiB;
constexpr size_t WS_A3 = AR + 0 * MiB;
constexpr size_t WS_SSQ2 = AR + 64 * MiB;
constexpr size_t WS_H3 = AR + 0 * MiB;
constexpr size_t WS_SSQ3 = AR + 66 * MiB;
constexpr size_t WS_HID2 = AR + 128 * MiB;
constexpr size_t WS_TOTAL = AR + 485 * MiB;

struct Params {
    const float *x, *c, *ctx, *c_ctx, *mod_w, *mod_b, *ffn_wg, *ffn_wu, *ffn_wd, *w_in, *lb_logits, *a_norm_w, *conv_w, *conv_b;
    const float *hw1, *hb1, *hfr1, *hw2, *hb2, *hfr2, *hw3, *hy_bias, *w_pa, *w_pb, *w_out, *fnw;
    float* out; unsigned char* ws;
    int ph_lo, ph_hi;
};

__device__ __forceinline__ float bf2f(bf16_t b) { return __uint_as_float(((unsigned)b) << 16); }
__device__ __forceinline__ bf16_t f2bf(float f) { unsigned u = __float_as_uint(f); u += 0x7FFFu + ((u >> 16) & 1u); return (bf16_t)(u >> 16); }
typedef float f32x2_t __attribute__((ext_vector_type(2)));
typedef __bf16 bf16x2_t __attribute__((ext_vector_type(2)));
__device__ __forceinline__ unsigned pk2(float lo, float hi) { const f32x2_t v = {lo, hi}; return __builtin_bit_cast(unsigned, __builtin_convertvector(v, bf16x2_t)); }
__device__ __forceinline__ float bfround(float f) { return bf2f(f2bf(f)); }
__device__ __forceinline__ float sigmoidf_(float x) { return __builtin_amdgcn_rcpf(1.0f + __builtin_amdgcn_exp2f(x * -1.4426950408889634f)); }
__device__ __forceinline__ float siluf_(float x) { return x * sigmoidf_(x); }
__device__ __forceinline__ float wave_sum(float v) {
#pragma unroll
    for (int o = 1; o < 64; o <<= 1) v += __shfl_xor(v, o);
    return v;
}
__device__ __forceinline__ float pos_embed(const float* er, const float* ec, int t, int col) {
    return col < 512 ? er[(t >> 6) * 512 + col] : ec[(t & 63) * 512 + (col - 512)];
}
__device__ __forceinline__ float rstd_from_ssq(const float* ssq16) {
    const f32x4* s = (const f32x4*)ssq16; float tot = 0.f;
#pragma unroll
    for (int i = 0; i < 4; ++i) { const f32x4 v = s[i]; tot += (v[0] + v[1]) + (v[2] + v[3]); }
    return __builtin_amdgcn_rsqf(tot * (1.0f / D) + RMS_EPS);
}

__device__ __forceinline__ void transpose_item(const float* W, int K, int N, bf16_t* WT, int k0, int n0, int dst_row0, LAS float* scr, int lane, int ldk = 0, int koff = 0) {
    if (ldk == 0) ldk = K;
    float wv[32];
#pragma unroll
    for (int i = 0; i < 32; ++i) wv[i] = W[(size_t)(k0 + 2 * i + (lane >> 5)) * N + n0 + (lane & 31)];
#pragma unroll
    for (int i = 0; i < 32; ++i) scr[(2 * i + (lane >> 5)) * 33 + (lane & 31)] = wv[i];
    asm volatile("s_waitcnt lgkmcnt(0)" ::: "memory");
    const int c = lane & 7;
#pragma unroll
    for (int j = 0; j < 4; ++j) { const int n = (lane >> 3) + 8 * j; const LAS float* s = scr + (8 * c) * 33 + n;
        u32x4 o; o.x = pk2(s[0 * 33], s[1 * 33]); o.y = pk2(s[2 * 33], s[3 * 33]); o.z = pk2(s[4 * 33], s[5 * 33]); o.w = pk2(s[6 * 33], s[7 * 33]);
        *(u32x4*)(WT + (size_t)(dst_row0 + n) * ldk + koff + k0 + 8 * c) = o; }
    asm volatile("s_waitcnt lgkmcnt(0)" ::: "memory");
}
__device__ __forceinline__ void transpose_matrix(const float* W, int K, int N, bf16_t* WT, LAS float* scr, int gw, int ngw, int lane, int ldk = 0, int koff = 0) {
    const int nblk = N / 32, items = (K / 64) * nblk;
    for (int it = gw; it < items; it += ngw) { const int kb = it / nblk, nb = it % nblk; transpose_item(W, K, N, WT, 64 * kb, 32 * nb, 32 * nb, scr, lane, ldk, koff); }
}
__device__ __forceinline__ void transpose_gu(const float* W, int half, bf16_t* WT, LAS float* scr, int gw, int ngw, int lane) {
    const int nblk = DFF / 32, items = (D / 64) * nblk;
    for (int it = gw; it < items; it += ngw) { const int kb = it / nblk, nb = it % nblk, n0 = 32 * nb;
        transpose_item(W, D, DFF, WT, 64 * kb, n0, 256 * (n0 >> 7) + 128 * half + (n0 & 127), scr, lane); }
}

template <bool GU, bool DEEP = false>
__device__ __forceinline__ void gemv17(const LAS float* xs, LAS float* part, const float* W, int N, const float* bias, float* out, int ldo, int half, int blk0, int nblk_stride) {
    const int tid = threadIdx.x, wid = tid >> 6, lane = tid & 63;
    for (int cb = blk0; cb < N / 64; cb += nblk_stride) {
        const int n = cb * 64 + lane;
        float acc[17];
#pragma unroll
        for (int r = 0; r < 17; ++r) acc[r] = 0.f;
        const float* wp = W + (size_t)(wid * 128) * N + n;
        if constexpr (DEEP) {
#pragma unroll 1
            for (int k0 = 0; k0 < 128; k0 += 16) { float w[16];
#pragma unroll
                for (int j = 0; j < 16; ++j) w[j] = wp[(size_t)(k0 + j) * N];
#pragma unroll
                for (int j = 0; j < 16; ++j) {
#pragma unroll
                    for (int r = 0; r < 17; ++r) acc[r] += xs[r * 1024 + wid * 128 + k0 + j] * w[j];
                    asm volatile("" ::: "memory"); } }
        } else {
#pragma unroll 4
        for (int k = 0; k < 128; ++k) { const float w = wp[(size_t)k * N];
#pragma unroll
            for (int r = 0; r < 17; ++r) acc[r] += xs[r * 1024 + wid * 128 + k] * w; } }
#pragma unroll
        for (int r = 0; r < 17; ++r) part[(wid * 17 + r) * 64 + lane] = acc[r];
        __syncthreads();
        for (int o = tid; o < 17 * 64; o += NTHR) { const int r = o >> 6, l = o & 63; float s = 0.f;
#pragma unroll
            for (int w = 0; w < 8; ++w) s += part[(w * 17 + r) * 64 + l];
            const int nn = cb * 64 + l; if (bias) s += bias[nn];
            const int on = GU ? (256 * (nn >> 7) + 128 * half + (nn & 127)) : nn;
            out[(size_t)r * ldo + on] = s; }
        __syncthreads();
    }
}

constexpr int XS_LD = 1028;
typedef float f32x4g __attribute__((ext_vector_type(4)));
template <bool GU = false>
__device__ __forceinline__ void gemv17_mfma(const LAS float* xs, LAS float* part, const float* W, int N, const float* bias, float* out, int ldo, int half, int blk0, int nblk_stride) {
    const int tid = threadIdx.x, wid = tid >> 6, lane = tid & 63, fr = lane & 15, fq = lane >> 4;
    for (int cb = blk0; cb < N / 64; cb += nblk_stride) {
        f32x4g acc[4]; float pc[4];
#pragma unroll
        for (int j = 0; j < 4; ++j) { acc[j] = (f32x4g){0.f, 0.f, 0.f, 0.f}; pc[j] = 0.f; }
        const float* wp = W + (size_t)(wid * 128 + fq) * N + cb * 64 + fr;
        const LAS float* xa = xs + fr * XS_LD + wid * 128 + fq; const LAS float* xc = xs + 16 * XS_LD + wid * 128 + fq;
#pragma unroll 1
        for (int q0 = 0; q0 < 32; q0 += 8) { float w[8][4];
#pragma unroll
            for (int qq = 0; qq < 8; ++qq)
#pragma unroll
                for (int j = 0; j < 4; ++j) w[qq][j] = wp[(size_t)(4 * (q0 + qq)) * N + 16 * j];
#pragma unroll
            for (int qq = 0; qq < 8; ++qq) { const float a = xa[4 * (q0 + qq)], x16 = xc[4 * (q0 + qq)];
#pragma unroll
                for (int j = 0; j < 4; ++j) { acc[j] = __builtin_amdgcn_mfma_f32_16x16x4f32(a, w[qq][j], acc[j], 0, 0, 0); pc[j] += x16 * w[qq][j]; } }
        }
#pragma unroll
        for (int j = 0; j < 4; ++j) { pc[j] += __shfl_xor(pc[j], 16); pc[j] += __shfl_xor(pc[j], 32);
#pragma unroll
            for (int r = 0; r < 4; ++r) part[(wid * 17 + 4 * fq + r) * 64 + 16 * j + fr] = acc[j][r];
            if (fq == 0) part[(wid * 17 + 16) * 64 + 16 * j + fr] = pc[j]; }
        __syncthreads();
        for (int o = tid; o < 17 * 64; o += NTHR) { const int r = o >> 6, l = o & 63; float s = 0.f;
#pragma unroll
            for (int w = 0; w < 8; ++w) s += part[(w * 17 + r) * 64 + l];
            const int nn = cb * 64 + l; if (bias) s += bias[nn];
            const int on = GU ? (256 * (nn >> 7) + 128 * half + (nn & 127)) : nn;
            out[(size_t)r * ldo + on] = s; }
        __syncthreads();
    }
}

__device__ __forceinline__ void store_bf16x8(bf16_t* p, const float (&v)[8]) { u32x4 w; w.x = pk2(v[0], v[1]); w.y = pk2(v[2], v[3]); w.z = pk2(v[4], v[5]); w.w = pk2(v[6], v[7]); __builtin_nontemporal_store(w, (u32x4*)p); }
__device__ __forceinline__ void load_f32x8(const float* p, float (&v)[8]) { const f32x4 a = *(const f32x4*)p, b = *(const f32x4*)(p + 4); v[0] = a[0]; v[1] = a[1]; v[2] = a[2]; v[3] = a[3]; v[4] = b[0]; v[5] = b[1]; v[6] = b[2]; v[7] = b[3]; }
__device__ __forceinline__ void store_f32x8(float* p, const float (&v)[8]) { *(f32x4*)p = (f32x4){v[0], v[1], v[2], v[3]}; *(f32x4*)(p + 4) = (f32x4){v[4], v[5], v[6], v[7]}; }
__device__ __forceinline__ void unpack_bf16x8(const u32x4 w, float (&v)[8]) { v[0] = __uint_as_float(w.x << 16); v[1] = __uint_as_float(w.x & 0xffff0000u); v[2] = __uint_as_float(w.y << 16); v[3] = __uint_as_float(w.y & 0xffff0000u);
    v[4] = __uint_as_float(w.z << 16); v[5] = __uint_as_float(w.z & 0xffff0000u); v[6] = __uint_as_float(w.w << 16); v[7] = __uint_as_float(w.w & 0xffff0000u); }
__device__ __forceinline__ void load_bf16x8(const bf16_t* p, float (&v)[8]) { const u32x4 w = *(const u32x4*)p; v[0] = __uint_as_float(w.x << 16); v[1] = __uint_as_float(w.x & 0xffff0000u); v[2] = __uint_as_float(w.y << 16); v[3] = __uint_as_float(w.y & 0xffff0000u);
    v[4] = __uint_as_float(w.z << 16); v[5] = __uint_as_float(w.z & 0xffff0000u); v[6] = __uint_as_float(w.w << 16); v[7] = __uint_as_float(w.w & 0xffff0000u); }

struct EpiGateUp1 {
    static constexpr int PD = 1;
    struct Cols {}; struct Row {};
    bf16_t* hid;
    __device__ __forceinline__ void load_cols(Cols&, int, int, int) const {}
    __device__ __forceinline__ void load_row(Row&, int, int, int) const {}
    __device__ __forceinline__ float finish(int row, int pn, int c, const float (&v0)[8], const float (&v1)[8], const Cols&, const Row&) const {
        float o[8];
#pragma unroll
        for (int j = 0; j < 8; ++j) o[j] = siluf_(v0[j]) * v1[j];
        store_bf16x8(hid + (size_t)row * DFF + 128 * pn + c, o); return 0.f; }
};
struct EpiGateUp2 {
    static constexpr int PD = 8;
    struct Cols { float s0[8], s1[8]; }; struct Row { float rs; };
    bf16_t* hid; const float* rstd; const float* sw;
    __device__ __forceinline__ void load_cols(Cols& k, int pm, int pn, int c) const { const int b = pm >> 3; load_f32x8(sw + (size_t)b * NGU + 256 * pn + c, k.s0); load_f32x8(sw + (size_t)b * NGU + 256 * pn + 128 + c, k.s1); }
    __device__ __forceinline__ void load_row(Row& r, int row, int, int) const { r.rs = rstd[row]; }
    __device__ __forceinline__ float finish(int row, int pn, int c, const float (&v0)[8], const float (&v1)[8], const Cols& k, const Row& r) const {
        float o[8];
#pragma unroll
        for (int j = 0; j < 8; ++j) o[j] = siluf_(r.rs * v0[j] + k.s0[j]) * (r.rs * v1[j] + k.s1[j]);
        store_bf16x8(hid + (size_t)row * DFF + 128 * pn + c, o); return 0.f; }
};
struct EpiDown1 {
    static constexpr int PD = 4;
    struct Cols { float g0[8], g1[8], s0[8], s1[8]; }; struct Row { u32x4 b0, b1; };
    const bf16_t* hcb; const float* modv; bf16_t* hb; bf16_t* a2;
    __device__ __forceinline__ void load_cols(Cols& k, int pm, int pn, int c) const { const int b = pm < T / 256 ? (pm >> 3) : 16; const float* m = modv + (size_t)b * MODW + 256 * pn + c;
        load_f32x8(m + 2 * D, k.g0); load_f32x8(m + 2 * D + 128, k.g1); load_f32x8(m + 4 * D, k.s0); load_f32x8(m + 4 * D + 128, k.s1); }
    __device__ __forceinline__ void load_row(Row& r, int row, int pn, int c) const { const bf16_t* src = (row < T ? hb + (size_t)row * D : hcb + (size_t)(row - T) * D) + 256 * pn + c; r.b0 = *(const u32x4*)src; r.b1 = *(const u32x4*)(src + 128); }
    __device__ __forceinline__ float finish(int row, int pn, int c, const float (&v0)[8], const float (&v1)[8], const Cols& k, const Row& r) const {
        float b0[8], b1[8], h0[8], h1[8], a0[8], a1[8]; float s = 0.f; unpack_bf16x8(r.b0, b0); unpack_bf16x8(r.b1, b1);
#pragma unroll
        for (int j = 0; j < 8; ++j) { h0[j] = b0[j] + 0.5f * k.g0[j] * v0[j]; h1[j] = b1[j] + 0.5f * k.g1[j] * v1[j]; s += h0[j] * h0[j] + h1[j] * h1[j]; a0[j] = h0[j] * (1.0f + k.s0[j]); a1[j] = h1[j] * (1.0f + k.s1[j]); }
        const size_t o = (size_t)row * D + 256 * pn + c;
        if (row < T) { store_bf16x8(hb + o, h0); store_bf16x8(hb + o + 128, h1); }
        store_bf16x8(a2 + o, a0); store_bf16x8(a2 + o + 128, a1); return s; }
};
struct EpiWin {
    static constexpr int PD = 8;
    struct Cols { float s0[8], s1[8], l0[8], l1[8]; }; struct Row { float rs; };
    const float *rstd, *sw, *lbv; bf16_t *v, *q, *g, *hy, *gab; f16_t *lfw, *lbw;
    __device__ __forceinline__ void load_cols(Cols& k, int pm, int pn, int c) const { const int b = pm < T / 256 ? (pm >> 3) : 16; const int n = 256 * pn + c;
        load_f32x8(sw + (size_t)b * NIN + n, k.s0); load_f32x8(sw + (size_t)b * NIN + n + 128, k.s1);
        if (pn >= 2 && pn < 6) { load_f32x8(lbv + n - 512, k.l0); load_f32x8(lbv + n - 512 + 128, k.l1); } }
    __device__ __forceinline__ void load_row(Row& r, int row, int, int) const { r.rs = rstd[row]; }
    __device__ __forceinline__ void half_(int row, int n, float rs, const float (&a)[8], const float (&s)[8], const float (&lb)[8]) const {
        float p[8];
#pragma unroll
        for (int j = 0; j < 8; ++j) p[j] = rs * a[j] + s[j];
        const int grp = n >> 9;
        if (grp == 0) { store_bf16x8(v + (size_t)row * 512 + n, p); }
        else if (grp <= 2) { const int nn = n - 512 * grp; f16_t* dst = (grp == 1 ? lfw : lbw) + (size_t)row * 512 + nn; f16_t o[8];
#pragma unroll
            for (int j = 0; j < 8; ++j) { const float f = lb[j] + (1.0f - lb[j]) * sigmoidf_(p[j]); o[j] = (f16_t)__builtin_amdgcn_logf(f); }
            *(u32x4*)dst = *(const u32x4*)o; }
        else if (grp == 3) {
#pragma unroll
            for (int j = 0; j < 8; ++j) p[j] = siluf_(p[j]);
            store_bf16x8(q + (size_t)row * 512 + (n - 1536), p); }
        else if (grp == 4) {
#pragma unroll
            for (int j = 0; j < 8; ++j) p[j] = siluf_(p[j]);
            store_bf16x8(g + (size_t)row * 512 + (n - 2048), p); }
        else if (grp <= 7) { const int ch = n - 2560, t = row & (SEQ - 1), b = row >> 11; store_bf16x8(hy + (((size_t)(ch >> 3) * NB + b) * SEQ + t) * 8, p); }
        else {
#pragma unroll
            for (int j = 0; j < 8; ++j) p[j] = fmaxf(sigmoidf_(p[j]), 1e-18f);
            store_bf16x8(gab + (size_t)row * 2048 + (n - 4096), p); }
    }
    __device__ __forceinline__ float finish(int row, int pn, int c, const float (&v0)[8], const float (&v1)[8], const Cols& k, const Row& r) const {
        half_(row, 256 * pn + c, r.rs, v0, k.s0, k.l0); half_(row, 256 * pn + 128 + c, r.rs, v1, k.s1, k.l1); return 0.f; }
};
struct EpiProj {
    static constexpr int PD = 4; static constexpr bool TWOSTAGE = true;
    struct Cols {}; struct Row { u32x4 g0, g1; };
    const bf16_t* gab; bf16_t* y;
    __device__ __forceinline__ void load_cols(Cols&, int, int, int) const {}
    __device__ __forceinline__ void load_row(Row& r, int row, int pn, int c) const { const bf16_t* src = gab + (size_t)row * 2048 + 1024 + 256 * pn + c; r.g0 = *(const u32x4*)src; r.g1 = *(const u32x4*)(src + 128); }
    __device__ __forceinline__ float finish(int row, int pn, int c, const float (&v0)[8], const float (&v1)[8], const Cols&, const Row& r) const {
        float g0[8], g1[8], o0[8], o1[8]; unpack_bf16x8(r.g0, g0); unpack_bf16x8(r.g1, g1);
#pragma unroll
        for (int j = 0; j < 8; ++j) { o0[j] = g0[j] * v0[j]; o1[j] = g1[j] * v1[j]; }
        bf16_t* dst = y + (size_t)row * D + 256 * pn + c; store_bf16x8(dst, o0); store_bf16x8(dst + 128, o1); return 0.f; }
    struct MRow { u32x4 a0, a1, b0, b1; };
    __device__ __forceinline__ void load_mid(MRow& r, int row, int pn, int c) const { const bf16_t* src = gab + (size_t)row * 2048 + 256 * pn + c; r.a0 = *(const u32x4*)src; r.a1 = *(const u32x4*)(src + 128); r.b0 = *(const u32x4*)(src + 1024); r.b1 = *(const u32x4*)(src + 1024 + 128); }
    __device__ __forceinline__ void scale_mid(float (&v0)[8], float (&v1)[8], const MRow& r) const { float a[8], bq[8];
        unpack_bf16x8(r.a0, a); unpack_bf16x8(r.b0, bq);
#pragma unroll
        for (int j = 0; j < 8; ++j) v0[j] *= a[j] * __builtin_amdgcn_rcpf(bq[j]);
        unpack_bf16x8(r.a1, a); unpack_bf16x8(r.b1, bq);
#pragma unroll
        for (int j = 0; j < 8; ++j) v1[j] *= a[j] * __builtin_amdgcn_rcpf(bq[j]); }
};
struct EpiWout {
    static constexpr int PD = 4;
    struct Cols { float g0[8], g1[8], s0[8], s1[8]; }; struct Row { u32x4 b0, b1; };
    const float* modv; bf16_t* hb; bf16_t* a3;
    __device__ __forceinline__ void load_cols(Cols& k, int pm, int pn, int c) const { const float* m = modv + (size_t)(pm >> 3) * MODW + 256 * pn + c;
        load_f32x8(m + 5 * D, k.g0); load_f32x8(m + 5 * D + 128, k.g1); load_f32x8(m + 7 * D, k.s0); load_f32x8(m + 7 * D + 128, k.s1); }
    __device__ __forceinline__ void load_row(Row& r, int row, int pn, int c) const { const bf16_t* src = hb + (size_t)row * D + 256 * pn + c; r.b0 = *(const u32x4*)src; r.b1 = *(const u32x4*)(src + 128); }
    __device__ __forceinline__ float finish(int row, int pn, int c, const float (&v0)[8], const float (&v1)[8], const Cols& k, const Row& r) const {
        float b0[8], b1[8], h0[8], h1[8], a0[8], a1[8]; float s = 0.f; unpack_bf16x8(r.b0, b0); unpack_bf16x8(r.b1, b1);
#pragma unroll
        for (int j = 0; j < 8; ++j) { h0[j] = b0[j] + k.g0[j] * v0[j]; h1[j] = b1[j] + k.g1[j] * v1[j]; s += h0[j] * h0[j] + h1[j] * h1[j]; a0[j] = h0[j] * (1.0f + k.s0[j]); a1[j] = h1[j] * (1.0f + k.s1[j]); }
        const size_t o = (size_t)row * D + 256 * pn + c;
        store_bf16x8(hb + o, h0); store_bf16x8(hb + o + 128, h1); store_bf16x8(a3 + o, a0); store_bf16x8(a3 + o + 128, a1); return s; }
};
struct EpiDown2 {
    static constexpr int PD = 4;
    struct Cols { float g0[8], g1[8]; }; struct Row { u32x4 b0, b1; };
    const float* modv; const bf16_t* hb; bf16_t* h3;
    __device__ __forceinline__ void load_cols(Cols& k, int pm, int pn, int c) const { const float* m = modv + (size_t)(pm >> 3) * MODW + 8 * D + 256 * pn + c; load_f32x8(m, k.g0); load_f32x8(m + 128, k.g1); }
    __device__ __forceinline__ void load_row(Row& r, int row, int pn, int c) const { const bf16_t* src = hb + (size_t)row * D + 256 * pn + c; r.b0 = *(const u32x4*)src; r.b1 = *(const u32x4*)(src + 128); }
    __device__ __forceinline__ float finish(int row, int pn, int c, const float (&v0)[8], const float (&v1)[8], const Cols& k, const Row& r) const {
        float b0[8], b1[8], h0[8], h1[8]; float s = 0.f; unpack_bf16x8(r.b0, b0); unpack_bf16x8(r.b1, b1);
#pragma unroll
        for (int j = 0; j < 8; ++j) { h0[j] = b0[j] + 0.5f * k.g0[j] * v0[j]; h1[j] = b1[j] + 0.5f * k.g1[j] * v1[j]; s += h0[j] * h0[j] + h1[j] * h1[j]; }
        const size_t o = (size_t)row * D + 256 * pn + c; store_bf16x8(h3 + o, h0); store_bf16x8(h3 + o + 128, h1); return s; }
};

template <class Epi>
__device__ __forceinline__ void gemm_simple(LAS unsigned char* lds, const bf16_t* A, const bf16_t* Bt, int K, int row0, int nrows, int npn, const Epi& E, float* ssq) {
    LAS float* As = (LAS float*)lds;
    LAS float* Bs = (LAS float*)(lds + 8192);
    const int tid = threadIdx.x, c8 = tid & 15, rg = tid >> 4;
    const int nrt = nrows / 64, nunits = nrt * npn;
    for (int unit = blockIdx.x; unit < nunits; unit += gridDim.x) {
        const int rt = unit / npn, pn = unit % npn, r0 = row0 + rt * 64;
        float a0[2][8], a1[2][8];
#pragma unroll
        for (int r = 0; r < 2; ++r)
#pragma unroll
            for (int j = 0; j < 8; ++j) { a0[r][j] = 0.f; a1[r][j] = 0.f; }
        for (int k0 = 0; k0 < K; k0 += 32) {
            { const int row = tid >> 3, kq = tid & 7; const u32x2 w = *(const u32x2*)(A + (size_t)(r0 + row) * K + k0 + 4 * kq);
              As[(4 * kq + 0) * 64 + row] = __uint_as_float(w.x << 16); As[(4 * kq + 1) * 64 + row] = __uint_as_float(w.x & 0xffff0000u);
              As[(4 * kq + 2) * 64 + row] = __uint_as_float(w.y << 16); As[(4 * kq + 3) * 64 + row] = __uint_as_float(w.y & 0xffff0000u); }
            { const int n = tid >> 1, kh = tid & 1; const bf16_t* src = Bt + (size_t)(pn * 256 + n) * K + k0 + 16 * kh; float t8[8];
              load_bf16x8(src, t8);
#pragma unroll
              for (int i = 0; i < 8; ++i) Bs[(16 * kh + i) * 256 + n] = t8[i];
              load_bf16x8(src + 8, t8);
#pragma unroll
              for (int i = 0; i < 8; ++i) Bs[(16 * kh + 8 + i) * 256 + n] = t8[i]; }
            __syncthreads();
#pragma unroll 8
            for (int k = 0; k < 32; ++k) {
                const float x0 = As[k * 64 + 2 * rg], x1 = As[k * 64 + 2 * rg + 1];
                const f32x4 b00 = *(const LAS f32x4*)(Bs + k * 256 + 8 * c8), b01 = *(const LAS f32x4*)(Bs + k * 256 + 8 * c8 + 4);
                const f32x4 b10 = *(const LAS f32x4*)(Bs + k * 256 + 128 + 8 * c8), b11 = *(const LAS f32x4*)(Bs + k * 256 + 128 + 8 * c8 + 4);
#pragma unroll
                for (int j = 0; j < 4; ++j) { a0[0][j] += x0 * b00[j]; a0[0][4 + j] += x0 * b01[j]; a1[0][j] += x0 * b10[j]; a1[0][4 + j] += x0 * b11[j];
                                              a0[1][j] += x1 * b00[j]; a0[1][4 + j] += x1 * b01[j]; a1[1][j] += x1 * b10[j]; a1[1][4 + j] += x1 * b11[j]; }
            }
            __syncthreads();
        }
#pragma unroll
        for (int r = 0; r < 2; ++r) { const int row = r0 + 2 * rg + r; typename Epi::Cols kc; typename Epi::Row kr; E.load_cols(kc, row >> 8, pn, 8 * c8); E.load_row(kr, row, pn, 8 * c8); float s = E.finish(row, pn, 8 * c8, a0[r], a1[r], kc, kr);
            s += __shfl_xor(s, 1); s += __shfl_xor(s, 2); s += __shfl_xor(s, 4); s += __shfl_xor(s, 8);
            if (ssq && c8 == 0) *(f32x4*)(ssq + (size_t)row * 16 + pn * 4) = (f32x4){s, 0.f, 0.f, 0.f}; }
    }
}

namespace pg8 {
#define PG8_LAS __attribute__((address_space(3)))
typedef unsigned short bf16_t;
typedef short bf16x8 __attribute__((ext_vector_type(8)));
typedef float f32x4 __attribute__((ext_vector_type(4)));
typedef unsigned u32x4 __attribute__((ext_vector_type(4)));
constexpr int BM = 256, BK = 64, HALF = 128, HTB = HALF * BK * 2  , STAGE_BYTES = 8 * HTB, NXCD = 8, WGM = 8;

__host__ __device__ __forceinline__ int lds_byte(int r, int c) { const int st = (r >> 4) * 2 + (c >> 5), rr = r & 15, cc = c & 31, ob = rr * 64 + cc * 2; return st * 1024 + (ob ^ (((ob >> 9) & 1) << 5)); }
__host__ __device__ __forceinline__ void stage_rc(int b, int& R, int& C) { const int st = b / 1024, sb = b % 1024, swz = sb ^ (((sb >> 9) & 1) << 5); R = (st >> 1) * 16 + swz / 64; C = (st & 1) * 32 + (swz % 64) / 2; }
__host__ __device__ __forceinline__ int perm32(int rho) { const int n = rho >> 4, i = rho & 15; return 8 * (i >> 2) + 4 * n + (i & 3); }

struct Unit { int pm, pn, ko, stage; };
struct Gemm { const bf16_t* A; const bf16_t* Bt; int M, N, K, ld; };

struct StaticOrder {
    int nM, nN, nwg, G, c;
    __host__ __device__ void init(int M, int N, int G_, int c_) { nM = M / BM; nN = N / BM; nwg = nM * nN; G = G_; c = c_; }
    __host__ __device__ bool next(int i, Unit& u) const {
        const long L = (long)i * G + c; if (L >= nwg) return false;
        int wgid = (int)L; { const int q = nwg / NXCD, r = nwg % NXCD, xcd = wgid % NXCD, off = wgid / NXCD; wgid = (xcd < r ? xcd * (q + 1) : r * (q + 1) + (xcd - r) * q) + off; }
        const int nig = WGM * nN, gid = wgid / nig, fm = gid * WGM, gsz = (nM - fm) < WGM ? (nM - fm) : WGM;
        u.pm = fm + ((wgid % nig) % gsz); u.pn = (wgid % nig) / gsz; u.ko = 0; u.stage = 0; return true;
    }
    __device__ __forceinline__ void a_ready(const Unit&) const {}
    __device__ __forceinline__ void done(const Unit&) const {}
};
template <class Epi, class Sched>
__device__ __forceinline__ void gemm_phase(PG8_LAS unsigned char* lds, const Gemm g, const Sched& S, const Epi& E) {
    const int tid = threadIdx.x, wid = __builtin_amdgcn_readfirstlane(tid >> 6), lane = tid & 63, wr = wid >> 2, wc = wid & 3, fr = lane & 15, fq = lane >> 4;
    const int K = g.K, nt = K / BK, ld = g.ld ? g.ld : g.K;
    unsigned voffA[2], voffB[2];
#pragma unroll
    for (int i = 0; i < 2; ++i) { int R, C; stage_rc(tid * 16 + i * 8192, R, C); const int Rb = Epi::PERM ? ((R & ~31) + perm32(R & 31)) : R;
        voffA[i] = (unsigned)(R * ld + C) * 2u; voffB[i] = (unsigned)(Rb * ld + C) * 2u; }
    const size_t kstep = (size_t)(BK * 2);
    const size_t hstep = (size_t)HALF * ld * 2;
    const size_t tstep = 2 * hstep;
    const unsigned ldsw = (unsigned)wid * 1024u;
    const int aoff = lds_byte(wr * 64 + fr, fq * 8), boff = lds_byte(wc * 32 + fr, fq * 8);
#define PG8_SA(b, h) (((b) * 2 + (h)) * HTB)
#define PG8_SB(b, h) ((4 + (b) * 2 + (h)) * HTB)
#define PG8_STAGE(bufoff, gbase, voff) do { _Pragma("unroll") for (int _i = 0; _i < 2; ++_i) \
        __builtin_amdgcn_global_load_lds((const unsigned*)((const char*)(gbase) + (voff)[_i]), (PG8_LAS unsigned*)(lds + (bufoff) + ldsw + _i * 8192), 16, 0, 0); } while (0)
#define PG8_LDA(dst, b, h) do { _Pragma("unroll") for (int m = 0; m < 4; ++m) _Pragma("unroll") for (int k = 0; k < 2; ++k) dst[m][k] = *(const PG8_LAS bf16x8*)(lds + PG8_SA(b, h) + aoff + m * 2048 + k * 1024); } while (0)
#define PG8_LDB(dst, b, h) do { _Pragma("unroll") for (int n = 0; n < 2; ++n) _Pragma("unroll") for (int k = 0; k < 2; ++k) dst[n][k] = *(const PG8_LAS bf16x8*)(lds + PG8_SB(b, h) + boff + n * 2048 + k * 1024); } while (0)
#define PG8_MMA(ai, bj, At, Bt) do { __builtin_amdgcn_s_setprio(1); _Pragma("unroll") for (int m = 0; m < 4; ++m) _Pragma("unroll") for (int n = 0; n < 2; ++n) _Pragma("unroll") for (int k = 0; k < 2; ++k) \
        acc[ai][bj][m][n] = __builtin_amdgcn_mfma_f32_16x16x32_bf16(Bt[n][k], At[m][k], acc[ai][bj][m][n], 0, 0, 0); __builtin_amdgcn_s_setprio(0); } while (0)
#define PG8_WAIT_V(n) asm volatile("s_waitcnt vmcnt(" #n ")" ::: "memory")
#define PG8_WAIT_L(n) asm volatile("s_waitcnt lgkmcnt(" #n ")" ::: "memory")
#define PG8_BAR __builtin_amdgcn_s_barrier()
#define PG8_SCHED __builtin_amdgcn_sched_barrier(0)
    Unit cur, nxt; int ui = 0;
    if (!S.next(0, cur)) return;
    f32x4 acc[2][2][4][2];
#pragma unroll
    for (int a = 0; a < 2; ++a)
#pragma unroll
        for (int b = 0; b < 2; ++b)
#pragma unroll
            for (int m = 0; m < 4; ++m)
#pragma unroll
                for (int n = 0; n < 2; ++n) acc[a][b][m][n] = (f32x4){0.f, 0.f, 0.f, 0.f};
    bf16x8 At[4][2], B0[2][2], B1[2][2];
    const char* cA = (const char*)g.A + (size_t)cur.pm * tstep + cur.ko; const char* cB = (const char*)g.Bt + (size_t)cur.pn * tstep + cur.ko;
    S.a_ready(cur);
    PG8_STAGE(PG8_SB(0, 0), cB, voffB); PG8_STAGE(PG8_SA(0, 0), cA, voffA); PG8_STAGE(PG8_SB(0, 1), cB + hstep, voffB); PG8_STAGE(PG8_SA(0, 1), cA + hstep, voffA);
    if (wr == 1) PG8_BAR;
    PG8_WAIT_V(4); PG8_BAR;
    PG8_STAGE(PG8_SB(1, 0), cB + kstep, voffB); PG8_STAGE(PG8_SA(1, 0), cA + kstep, voffA); PG8_STAGE(PG8_SB(1, 1), cB + hstep + kstep, voffB);
    PG8_WAIT_V(6); PG8_BAR;
    for (;;) {
        const bool has_next = S.next(ui + 1, nxt);
        const char* nA = has_next ? (const char*)g.A + (size_t)nxt.pm * tstep + nxt.ko : cA; const char* nB = has_next ? (const char*)g.Bt + (size_t)nxt.pn * tstep + nxt.ko : cB;
        for (int t = 0; t < nt; t += 2) {
            const bool last = (t == nt - 2);
            const char* a1 = cA + (size_t)(t + 1) * kstep;
            const char* a2 = last ? nA : cA + (size_t)(t + 2) * kstep; const char* b2 = last ? nB : cB + (size_t)(t + 2) * kstep;
            const char* a3 = a2 + kstep; const char* b3 = b2 + kstep;
            if (last && has_next) S.a_ready(nxt);
            PG8_LDB(B0, 0, 0); PG8_SCHED; PG8_LDA(At, 0, 0); PG8_STAGE(PG8_SA(1, 1), a1 + hstep, voffA);
            PG8_WAIT_L(8); PG8_BAR; PG8_WAIT_L(0); PG8_MMA(0, 0, At, B0); PG8_BAR; PG8_SCHED;
            PG8_LDB(B1, 0, 1); PG8_STAGE(PG8_SB(0, 0), b2, voffB);
            PG8_BAR; PG8_WAIT_L(0); PG8_MMA(0, 1, At, B1); PG8_BAR;
            PG8_LDA(At, 0, 1); PG8_STAGE(PG8_SA(0, 0), a2, voffA);
            PG8_BAR; PG8_WAIT_L(0); PG8_MMA(1, 0, At, B0); PG8_BAR; PG8_SCHED;
            PG8_STAGE(PG8_SB(0, 1), b2 + hstep, voffB);
            PG8_WAIT_V(6); PG8_BAR; PG8_MMA(1, 1, At, B1); PG8_BAR;
            PG8_LDB(B0, 1, 0); PG8_SCHED; PG8_LDA(At, 1, 0); PG8_STAGE(PG8_SA(0, 1), a2 + hstep, voffA);
            PG8_WAIT_L(8); PG8_BAR; PG8_WAIT_L(0); PG8_MMA(0, 0, At, B0); PG8_BAR; PG8_SCHED;
            PG8_LDB(B1, 1, 1); PG8_STAGE(PG8_SB(1, 0), b3, voffB);
            PG8_BAR; PG8_WAIT_L(0); PG8_MMA(0, 1, At, B1); PG8_BAR;
            PG8_LDA(At, 1, 1); PG8_STAGE(PG8_SA(1, 0), a3, voffA);
            PG8_BAR; PG8_WAIT_L(0); PG8_MMA(1, 0, At, B0); PG8_BAR; PG8_SCHED;
            PG8_STAGE(PG8_SB(1, 1), b3 + hstep, voffB);
            PG8_WAIT_V(6); PG8_BAR; PG8_MMA(1, 1, At, B1); PG8_BAR;
        }
        const bool keep = Epi::TWOSTAGE && cur.stage == 1;
        if constexpr (!Epi::AFTER_DRAIN) { if (keep) E.mid(acc, cur, wr, wc, fr, fq); else E(acc, cur, wr, wc, fr, fq); S.done(cur); }
        if (!has_next) break;
        if (!keep)
#pragma unroll
        for (int a = 0; a < 2; ++a)
#pragma unroll
            for (int b = 0; b < 2; ++b)
#pragma unroll
                for (int m = 0; m < 4; ++m)
#pragma unroll
                    for (int n = 0; n < 2; ++n) acc[a][b][m][n] = (f32x4){0.f, 0.f, 0.f, 0.f};
        cur = nxt; cA = nA; cB = nB; ++ui;
    }
    PG8_WAIT_V(0);
    if (wr == 0) PG8_BAR;
    PG8_BAR;
    if constexpr (Epi::AFTER_DRAIN) { E.fused(acc, cur, wr, wc, fr, fq, lds, wid, lane); S.done(cur); }
#undef PG8_SA
#undef PG8_SB
#undef PG8_STAGE
#undef PG8_LDA
#undef PG8_LDB
#undef PG8_MMA
#undef PG8_WAIT_V
#undef PG8_WAIT_L
#undef PG8_BAR
#undef PG8_SCHED
}
}

template <class F, class = void> struct has_twostage { static constexpr bool value = false; };
template <class F> struct has_twostage<F, decltype((void)F::TWOSTAGE)> { static constexpr bool value = F::TWOSTAGE; };
template <class F> struct EpiAd {
    static constexpr bool PERM = true, AFTER_DRAIN = false, TWOSTAGE = has_twostage<F>::value;
    __device__ __forceinline__ void mid(pg8::f32x4 (&acc)[2][2][4][2], const pg8::Unit& u, int wr, int wc, int fr, int fq) const {
        if constexpr (TWOSTAGE) { constexpr int PD = 2;
            const int c = wc * 32 + 8 * fq, row0 = u.pm * 256 + wr * 64 + fr;
            typename F::MRow rd[PD];
#pragma unroll
            for (int s = 0; s < PD; ++s) f.load_mid(rd[s], row0 + (s >> 2) * 128 + (s & 3) * 16, u.pn, c);
#pragma unroll
            for (int s = 0; s < 8; ++s) { const int ai = s >> 2, m = s & 3; float v0[8], v1[8];
#pragma unroll
                for (int n = 0; n < 2; ++n)
#pragma unroll
                    for (int e = 0; e < 4; ++e) { v0[4 * n + e] = acc[ai][0][m][n][e]; v1[4 * n + e] = acc[ai][1][m][n][e]; }
                f.scale_mid(v0, v1, rd[s % PD]);
#pragma unroll
                for (int n = 0; n < 2; ++n)
#pragma unroll
                    for (int e = 0; e < 4; ++e) { acc[ai][0][m][n][e] = v0[4 * n + e]; acc[ai][1][m][n][e] = v1[4 * n + e]; }
                if (s + PD < 8) f.load_mid(rd[s % PD], row0 + ((s + PD) >> 2) * 128 + ((s + PD) & 3) * 16, u.pn, c); } } }
    F f; float* ssq;
    __device__ __forceinline__ void operator()(const pg8::f32x4 (&acc)[2][2][4][2], const pg8::Unit& u, int wr, int wc, int fr, int fq) const {
        constexpr int PD = F::PD;
        const int c = wc * 32 + 8 * fq, row0 = u.pm * 256 + wr * 64 + fr;
        typename F::Cols cols; f.load_cols(cols, u.pm, u.pn, c);
        typename F::Row rd[PD];
#pragma unroll
        for (int s = 0; s < PD; ++s) f.load_row(rd[s], row0 + (s >> 2) * 128 + (s & 3) * 16, u.pn, c);
#pragma unroll
        for (int s = 0; s < 8; ++s) { const int ai = s >> 2, m = s & 3, row = row0 + ai * 128 + m * 16;
            float v0[8], v1[8];
#pragma unroll
            for (int n = 0; n < 2; ++n)
#pragma unroll
                for (int e = 0; e < 4; ++e) { v0[4 * n + e] = acc[ai][0][m][n][e]; v1[4 * n + e] = acc[ai][1][m][n][e]; }
            float sq = f.finish(row, u.pn, c, v0, v1, cols, rd[s % PD]);
            if (ssq) { sq += __shfl_xor(sq, 16); sq += __shfl_xor(sq, 32); if (fq == 0) ssq[(size_t)row * 16 + u.pn * 4 + wc] = sq; }
            if (s + PD < 8) f.load_row(rd[s % PD], row0 + ((s + PD) >> 2) * 128 + ((s + PD) & 3) * 16, u.pn, c); }
    }
};
struct TwoPartOrder {
    pg8::StaticOrder s1; int n1, nM1, nM2, n2, G, c;
    __device__ void init(int nM1_, int nN1, int nM2_, int nN2, int G_, int c_) { s1.init(nM1_ * 256, nN1 * 256, G_, c_); n1 = nM1_ * nN1; nM1 = nM1_; nM2 = nM2_; n2 = nM2_ * nN2; G = G_; c = c_; }
    __device__ bool next(int i, pg8::Unit& u) const { long L = (long)i * G + c; if (L < n1) return s1.next(i, u); L -= n1; if (L >= n2) return false; u.pm = nM1 + (int)(L % nM2); u.pn = (int)(L / nM2); u.ko = 0; u.stage = 0; return true; }
    __device__ __forceinline__ void a_ready(const pg8::Unit&) const {}
    __device__ __forceinline__ void done(const pg8::Unit&) const {}
};
struct PairOrder {
    pg8::StaticOrder s1; int kbytes;
    __device__ void init(int M, int N, int G_, int c_, int kbytes_) { s1.init(M, N, G_, c_); kbytes = kbytes_; }
    __device__ bool next(int i, pg8::Unit& u) const { if (!s1.next(i >> 1, u)) return false; u.stage = (i & 1) ? 0 : 1; u.ko = (i & 1) ? kbytes : 0; return true; }
    __device__ __forceinline__ void a_ready(const pg8::Unit&) const {}
    __device__ __forceinline__ void done(const pg8::Unit&) const {}
};
template <class F>
__device__ __forceinline__ void gemm_pair(LAS unsigned char* lds, int vc, const bf16_t* A, const bf16_t* Bt, int Khalf, int nrows, int npn, const F& f) {
    __syncthreads();
    pg8::Gemm g{A, Bt, nrows, npn * 256, Khalf, 2 * Khalf}; PairOrder S; S.init(nrows, npn * 256, (int)gridDim.x, vc, Khalf * 2);
    EpiAd<F> E{f, nullptr};
    pg8::gemm_phase(lds, g, S, E);
    __syncthreads();
}
template <class F>
__device__ __forceinline__ void gemm_mfma(LAS unsigned char* lds, int vc, const bf16_t* A, const bf16_t* Bt, int K, int nrows1, int npn1, int nrows2, int npn2, const F& f, float* ssq) {
    __syncthreads();
    pg8::Gemm g{A, Bt, nrows1 + nrows2, npn1 * 256, K, 0}; TwoPartOrder S; S.init(nrows1 / 256, npn1, nrows2 / 256, npn2, (int)gridDim.x, vc);
    EpiAd<F> E{f, ssq};
    pg8::gemm_phase(lds, g, S, E);
    __syncthreads();
}

struct SplitKOrder {
    int G, c, nM, ntile, kbytes;
    __device__ bool next(int i, pg8::Unit& u) const { const long L = (long)i * G + c; if (L >= 2 * ntile) return false; const int half = (int)(L / ntile), t = (int)(L % ntile); u.pm = t % nM; u.pn = t / nM; u.ko = half * kbytes; u.stage = 0; return true; }
    __device__ __forceinline__ void a_ready(const pg8::Unit&) const {}
    __device__ __forceinline__ void done(const pg8::Unit&) const {}
};
struct EpiPartial {
    static constexpr bool PERM = true, AFTER_DRAIN = false, TWOSTAGE = false;
    bf16_t* part; int nrows;
    __device__ __forceinline__ void mid(pg8::f32x4 (&)[2][2][4][2], const pg8::Unit&, int, int, int, int) const {}
    __device__ __forceinline__ void operator()(const pg8::f32x4 (&acc)[2][2][4][2], const pg8::Unit& u, int wr, int wc, int fr, int fq) const {
        const int c = wc * 32 + 8 * fq, row0 = u.pm * 256 + wr * 64 + fr; bf16_t* dst = part + (u.ko ? (size_t)nrows * D : 0) + 256 * u.pn + c;
#pragma unroll
        for (int s = 0; s < 8; ++s) { const int ai = s >> 2, m = s & 3, row = row0 + ai * 128 + m * 16; float v0[8], v1[8];
#pragma unroll
            for (int n = 0; n < 2; ++n)
#pragma unroll
                for (int e = 0; e < 4; ++e) { v0[4 * n + e] = acc[ai][0][m][n][e]; v1[4 * n + e] = acc[ai][1][m][n][e]; }
            store_bf16x8(dst + (size_t)row * D, v0); store_bf16x8(dst + (size_t)row * D + 128, v1); }
    }
};
__device__ __forceinline__ void gemm_splitk(LAS unsigned char* lds, int vc, const bf16_t* A, const bf16_t* Bt, int K, int nrows, int npn, bf16_t* part) {
    __syncthreads();
    pg8::Gemm g{A, Bt, nrows, npn * 256, K / 2, K}; SplitKOrder S{(int)gridDim.x, vc, nrows / 256, (nrows / 256) * npn, K};
    EpiPartial E{part, nrows};
    pg8::gemm_phase(lds, g, S, E);
    __syncthreads();
}

struct Ctx { LAS unsigned char* lds; int tid, lane, wid, gw, ngw, vc; };

struct VGrid { int vb, nvb; };
__device__ __forceinline__ void task_transposes_a(const Params& p, const Ctx& c, VGrid g) {
    LAS float* scr = (LAS float*)(c.lds + c.wid * 8448); const int gw = g.vb * NWAVES + c.wid, ngw = g.nvb * NWAVES;
    transpose_gu(p.ffn_wg, 0, (bf16_t*)(p.ws + WS_WG1_T), scr, gw, ngw, c.lane);
    transpose_gu(p.ffn_wu, 1, (bf16_t*)(p.ws + WS_WG1_T), scr, gw, ngw, c.lane);
}
__device__ __forceinline__ void task_transposes_b(const Params& p, const Ctx& c, VGrid g) {
    LAS float* scr = (LAS float*)(c.lds + c.wid * 8448); const int gw = g.vb * NWAVES + c.wid, ngw = g.nvb * NWAVES;
    transpose_matrix(p.ffn_wd, DFF, D, (bf16_t*)(p.ws + WS_WD1_T), scr, gw, ngw, c.lane);
    transpose_matrix(p.w_in, D, NIN, (bf16_t*)(p.ws + WS_WIN_T), scr, gw, ngw, c.lane);
}
__device__ __forceinline__ void task_transposes_c(const Params& p, const Ctx& c, VGrid g) {
    LAS float* scr = (LAS float*)(c.lds + c.wid * 8448); const int gw = g.vb * NWAVES + c.wid, ngw = g.nvb * NWAVES;
    transpose_matrix(p.w_pa, 512, D, (bf16_t*)(p.ws + WS_WPA_T), scr, gw, ngw, c.lane, 1024, 0);
    transpose_matrix(p.w_pb, 512, D, (bf16_t*)(p.ws + WS_WPA_T), scr, gw, ngw, c.lane, 1024, 512);
    transpose_matrix(p.w_out, D, D, (bf16_t*)(p.ws + WS_WOUT_T), scr, gw, ngw, c.lane);
}
__device__ __forceinline__ void task_transposes_d(const Params& p, const Ctx& c, VGrid g) {
    LAS float* scr = (LAS float*)(c.lds + c.wid * 8448); const int gw = g.vb * NWAVES + c.wid, ngw = g.nvb * NWAVES;
    transpose_gu(p.ffn_wg + (size_t)D * DFF, 0, (bf16_t*)(p.ws + WS_WG2_T), scr, gw, ngw, c.lane);
    transpose_gu(p.ffn_wu + (size_t)D * DFF, 1, (bf16_t*)(p.ws + WS_WG2_T), scr, gw, ngw, c.lane);
    transpose_matrix(p.ffn_wd + (size_t)DFF * D, DFF, D, (bf16_t*)(p.ws + WS_WD2_T), scr, gw, ngw, c.lane);
}
__device__ __forceinline__ void task_modv(const Params& p, const Ctx& c, VGrid g) {
    if (g.vb < MODW / 64) {
        LAS float* xs = (LAS float*)c.lds; LAS float* part = (LAS float*)(c.lds + 17 * XS_LD * 4);
        __syncthreads();
        for (int i = c.tid; i < 17 * 1024; i += NTHR) { const int r = i >> 10, k = i & 1023; const float v = r < 16 ? p.c[r * D + k] : p.c_ctx[k]; xs[r * XS_LD + k] = v / (1.0f + expf(-v)); }
        __syncthreads();
        gemv17_mfma(xs, part, p.mod_w, MODW, p.mod_b, (float*)(p.ws + WS_MODV), MODW, 0, g.vb, g.nvb);
    }
}
__device__ __forceinline__ void task_tables(const Params& p, const Ctx& c, VGrid g) {
    float* er = (float*)(p.ws + WS_ER); float* ec = (float*)(p.ws + WS_EC); float* lbv = (float*)(p.ws + WS_LBV);
    const int gt = g.vb * NTHR + c.tid, ngt = g.nvb * NTHR;
    for (int i = gt; i < 96 * 512; i += ngt) { const int r = i >> 9, j = i & 511, jj = j & 255; const float omega = 1.0f / powf(10000.0f, (float)jj / 256.0f);
        const int pos = r < 32 ? r : r - 32; const float a = (float)pos * omega; const float v = j < 256 ? sinf(a) : cosf(a);
        if (r < 32) er[r * 512 + j] = v; else ec[(r - 32) * 512 + j] = v; }
    for (int i = gt; i < 1024; i += ngt) { const float l0 = p.lb_logits[i], l1 = p.lb_logits[1024 + i]; lbv[i] = 1.0f / (1.0f + expf(l1 - l0)); }
}
__device__ __forceinline__ void task_h2(const Params& p, const Ctx& c, VGrid g) {
    LAS float* zf = (LAS float*)c.lds; LAS float* h1 = zf + 8 * 40; float* h2o = (float*)(p.ws + WS_H2);
    for (int it = g.vb; it < SEQ / 8; it += g.nvb) {
        __syncthreads();
        if (c.tid < 8 * 33) { const int r = c.tid / 33, f = c.tid % 33; const int pp = it * 8 + r; float v;
            if (f == 0) v = (float)pp / (float)(SEQ - 1);
            else { const int i = (f - 1) & 15; const float w = 6.283185307179586f * (float)pp / (float)SEQ; const float fr = 1e-4f + (float)i * ((15.0f - 1e-4f) / 15.0f); const float ang = w * fr; v = f <= 16 ? cosf(ang) : -sinf(ang); }
            zf[r * 40 + f] = v; }
        __syncthreads();
        { const int r = c.tid >> 6, j = c.tid & 63; float s = p.hb1[j];
#pragma unroll 3
          for (int f = 0; f < 33; ++f) s += zf[r * 40 + f] * p.hw1[f * 64 + j];
          h1[r * 64 + j] = sinf(p.hfr1[j] * s); }
        __syncthreads();
        { const int r = c.tid >> 6, j = c.tid & 63; float s = p.hb2[j];
#pragma unroll 4
          for (int k = 0; k < 64; ++k) s += h1[r * 64 + k] * p.hw2[k * 64 + j];
          h2o[(size_t)(it * 8 + r) * 64 + j] = sinf(p.hfr2[j] * s); }
    }
}
__device__ __forceinline__ void task_shift_gemv(const Params& p, const Ctx& c, VGrid g, int which) {
    const float* modv = (const float*)(p.ws + WS_MODV);
    LAS float* xs = (LAS float*)c.lds; LAS float* part = (LAS float*)(c.lds + 17 * XS_LD * 4);
    const int nb_in = NIN / 64, nb_g = DFF / 64, nblk = which == 0 ? nb_in : 2 * nb_g;
    if (g.vb >= nblk) return;
    __syncthreads();
    for (int i = c.tid; i < 17 * 1024; i += NTHR) xs[(i >> 10) * XS_LD + (i & 1023)] = modv[(size_t)(i >> 10) * MODW + (which == 0 ? 3 : 6) * D + (i & 1023)];
    __syncthreads();
    for (int bx = g.vb; bx < nblk; bx += g.nvb) {
        if (which == 0) gemv17_mfma<false>(xs, part, p.w_in, NIN, nullptr, (float*)(p.ws + WS_SWIN), NIN, 0, bx, nb_in);
        else { const int half = bx / nb_g, blk = bx % nb_g; const float* W = (half ? p.ffn_wu : p.ffn_wg) + (size_t)D * DFF;
            gemv17_mfma<true>(xs, part, W, DFF, nullptr, (float*)(p.ws + WS_SW2), NGU, half, blk, nb_g); }
    }
}
__device__ __forceinline__ void task_filters(const Params& p, const Ctx& c, VGrid g, int item0, int item1) {
    LAS float* w3s = (LAS float*)c.lds;
    LAS float* hk = w3s + 512;
    LAS float* red = hk + 2048 * 8;
    const float* h2 = (const float*)(p.ws + WS_H2); bf16_t* krev = (bf16_t*)(p.ws + WS_KREV);
    for (int it = item0 + g.vb; it < item1; it += g.nvb) {
        const int c0 = 2 * it;
        __syncthreads();
        { const int k = c.tid >> 3, q = c.tid & 7; w3s[c.tid] = p.hw3[(size_t)k * 2048 + (q >> 2) * 1024 + ((q >> 1) & 1) * 512 + c0 + (q & 1)]; }
        __syncthreads();
        float l1 = 0.f;
        { const int q = c.tid & 7, tl = c.tid >> 3;
          const int n = c.lane & 15, g = c.lane >> 4;
          float bw[16];
#pragma unroll
          for (int kk = 0; kk < 16; ++kk) bw[kk] = n < 8 ? w3s[(16 * g + kk) * 8 + n] : 0.f;
          const int ch = c0 + (n & 1); const float delta = fabsf(-3.0701134573253945f + (float)ch * ((-15.350567286626973f + 3.0701134573253945f) / 511.0f));
          LAS float* tile = red + 64;
          const float* src = h2 + (size_t)tl * 64 + q * 8; f32x4 pa[4], pb[4];
#pragma unroll
          for (int r = 0; r < 4; ++r) { pa[r] = *(const f32x4*)(src + (size_t)r * 64 * 64); pb[r] = *(const f32x4*)(src + (size_t)r * 64 * 64 + 4); }
#pragma unroll 1
          for (int st = 0; st < 8; ++st) {
            __syncthreads();
#pragma unroll
            for (int r = 0; r < 4; ++r) { *(LAS f32x4*)(tile + (r * 64 + tl) * 68 + q * 8) = pa[r]; *(LAS f32x4*)(tile + (r * 64 + tl) * 68 + q * 8 + 4) = pb[r]; }
            __syncthreads();
            if (st + 1 < 8) {
#pragma unroll
                for (int r = 0; r < 4; ++r) { const float* sn = src + (size_t)((st + 1) * 256 + r * 64) * 64; pa[r] = *(const f32x4*)sn; pb[r] = *(const f32x4*)(sn + 4); } }
#pragma unroll
            for (int u = 0; u < 2; ++u) { const int tb = 2 * c.wid + u;
                const LAS float* ar = tile + (16 * tb + n) * 68 + 16 * g; f32x4 a4[4];
#pragma unroll
                for (int i = 0; i < 4; ++i) a4[i] = *(const LAS f32x4*)(ar + 4 * i);
                f32x4g acc = (f32x4g){0.f, 0.f, 0.f, 0.f};
#pragma unroll
                for (int kk = 0; kk < 16; ++kk) acc = __builtin_amdgcn_mfma_f32_16x16x4f32(a4[kk >> 2][kk & 3], bw[kk], acc, 0, 0, 0);
                if (n < 8) {
#pragma unroll
                    for (int r = 0; r < 4; ++r) { const int t = st * 256 + 16 * tb + 4 * g + r; const float tn = (float)t / (float)(SEQ - 1); const float v = acc[r] * (expf(-tn * delta) + 0.05f);
                        hk[t * 8 + n] = v; l1 += fabsf(v); } } } } }
        { float s = l1; s += __shfl_xor(s, 2); s += __shfl_xor(s, 8); s += __shfl_xor(s, 16); s += __shfl_xor(s, 32);
          if ((c.lane & ~5) == 0) red[c.wid * 4 + ((c.lane >> 2) & 1) * 2 + (c.lane & 1)] = s; }
        __syncthreads();
        for (int e = c.tid; e < 4 * KR_LEN; e += NTHR) { const int oc = e / KR_LEN, i = (e % KR_LEN) - KR_OFF, o = oc >> 1, cc = oc & 1;
            float tot = 0.f;
#pragma unroll
            for (int w = 0; w < 8; ++w) tot += red[w * 4 + oc];
            const int lag = -i; float v = 0.f;
            if (lag >= 0 && lag <= SEQ - 1) v = hk[lag * 8 + o * 4 + 0 + cc]; else if (lag < 0 && lag >= -(SEQ - 1)) v = hk[(-lag - 1) * 8 + o * 4 + 2 + cc];
            krev[((size_t)o * 512 + c0 + cc) * KR_LEN + (e % KR_LEN)] = f2bf(v / (tot + 1e-6f)); }
    }
}
__device__ __forceinline__ void phase_prep(const Params& p, const Ctx& c) {
    const int G = (int)gridDim.x, nmod = MODW / 64;
    if (G >= nmod + 32) {
        if ((int)blockIdx.x < nmod) { if (PROBE_P0_CUT >= 5) TS_SUB(p, 18); task_modv(p, c, VGrid{(int)blockIdx.x, nmod}); if (PROBE_P0_CUT < 5) TS_SUB(p, 18); }
        else { const VGrid g{(int)blockIdx.x - nmod, G - nmod}; if (PROBE_P0_CUT == 4) TS_SUB(p, 18); task_transposes_a(p, c, g); if (PROBE_P0_CUT == 1 || PROBE_P0_CUT == 5) TS_SUB(p, 18); task_tables(p, c, g); if (PROBE_P0_CUT == 2) TS_SUB(p, 18); }
        task_h2(p, c, VGrid{(int)blockIdx.x, G});
    } else { const VGrid g{(int)blockIdx.x, G}; task_transposes_a(p, c, g); task_modv(p, c, g); task_tables(p, c, g); task_h2(p, c, g); }
}
__device__ __forceinline__ void phase_n1(const Params& p, const Ctx& c) {
    unsigned char* ws = p.ws;
    const float* modv = (const float*)(ws + WS_MODV); const float* er = (const float*)(ws + WS_ER); const float* ec = (const float*)(ws + WS_EC);
    bf16_t* n1 = (bf16_t*)(ws + WS_N1);
    constexpr int NR = 4;
    f32x4 nx[NR][4];
#define N1_FETCH(row0_) do { _Pragma("unroll") for (int r = 0; r < NR; ++r) { const int row = (row0_) + r; const float* src = (row0_) < T ? p.x + (size_t)row * D : p.ctx + (size_t)(row - T) * D; \
        _Pragma("unroll") for (int j = 0; j < 4; ++j) nx[r][j] = __builtin_nontemporal_load((const f32x4*)(src + 4 * c.lane + 256 * j)); } } while (0)
    if (NR * c.gw < MT) N1_FETCH(NR * c.gw);
    for (int row0 = NR * c.gw; row0 < MT; row0 += NR * c.ngw) {
        f32x4 v[NR][4]; const bool lat = row0 < T; const int b = lat ? (row0 >> 11) : 16;
#pragma unroll
        for (int r = 0; r < NR; ++r) { const int row = row0 + r; const int t = row & (SEQ - 1);
#pragma unroll
            for (int j = 0; j < 4; ++j) { const int col = 4 * c.lane + 256 * j; v[r][j] = nx[r][j];
                if (lat) { const float* pe = col < 512 ? er + (t >> 6) * 512 + col : ec + (t & 63) * 512 + (col - 512); v[r][j] += *(const f32x4*)pe; } } }
        if (row0 + NR * c.ngw < MT) N1_FETCH(row0 + NR * c.ngw);
        f32x4 sh[4], sc[4];
#pragma unroll
        for (int j = 0; j < 4; ++j) { const int col = 4 * c.lane + 256 * j; sh[j] = *(const f32x4*)(modv + (size_t)b * MODW + col); sc[j] = *(const f32x4*)(modv + (size_t)b * MODW + D + col) + 1.0f; }
#pragma unroll
        for (int r = 0; r < NR; ++r) { const int row = row0 + r;
            float ss = 0.f;
#pragma unroll
            for (int j = 0; j < 4; ++j) ss += (v[r][j][0] * v[r][j][0] + v[r][j][1] * v[r][j][1]) + (v[r][j][2] * v[r][j][2] + v[r][j][3] * v[r][j][3]);
            const float rs = __builtin_amdgcn_rsqf(wave_sum(ss) * (1.0f / D) + RMS_EPS);
            bf16_t* hdst = lat ? (bf16_t*)p.out + (size_t)row * D : (bf16_t*)(ws + WS_HCB) + (size_t)(row - T) * D;
#pragma unroll
            for (int j = 0; j < 4; ++j) { const int col = 4 * c.lane + 256 * j; u32x2 w; w.x = pk2(v[r][j][0], v[r][j][1]); w.y = pk2(v[r][j][2], v[r][j][3]); __builtin_nontemporal_store(w, (u32x2*)(hdst + col));
                const f32x4 o = v[r][j] * rs * sc[j] + sh[j]; u32x2 w2; w2.x = pk2(o[0], o[1]); w2.y = pk2(o[2], o[3]); *(u32x2*)(n1 + (size_t)row * D + col) = w2; } }
    }
}
#undef N1_FETCH
__device__ __forceinline__ bool filler_grid(VGrid& g, int vc, int nunits) {
    const int G = (int)gridDim.x, rem = nunits % G;
    if (rem == 0) { g.vb = vc; g.nvb = G; return true; }
    if (vc < rem) return false;
    g.vb = vc - rem; g.nvb = G - rem; return true;
}

__device__ __forceinline__ void phase_hgrn_simple(const Params& p, const Ctx& c) {
    unsigned char* ws = p.ws;
    const bf16_t* vb = (const bf16_t*)(ws + WS_V); const bf16_t* qb = (const bf16_t*)(ws + WS_Q);
    LAS float* F = (LAS float*)c.lds; LAS float* Kk = F + 64 * 128; LAS float* Q = Kk + 64 * 128; LAS float* V = Q + 64 * 128;
    const int dg = c.tid & 3, e = c.tid >> 2;
    for (int it = blockIdx.x; it < NB * 4 * 2; it += gridDim.x) {
        const int dir = it & 1, h = (it >> 1) & 3, b = it >> 3;
        const f16_t* lf = (const f16_t*)(ws + (dir ? WS_LBW : WS_LFW)); bf16_t* outp = ((bf16_t*)p.out + (size_t)T * D + (dir ? (size_t)T * 512 : 0));
        float S[32];
#pragma unroll
        for (int i = 0; i < 32; ++i) S[i] = 0.f;
        for (int ci = 0; ci < 36; ++ci) {
            const bool lat = ci >= 4;
            __syncthreads();
            for (int idx = c.tid; idx < 64 * 128; idx += NTHR) { const int j = idx >> 7, d = idx & 127; const int pp = (lat ? ci - 4 : ci) * 64 + j;
                const int row = lat ? b * SEQ + (dir ? SEQ - 1 - pp : pp) : T + b * CL + (dir ? CL - 1 - pp : pp);
                const float f = __builtin_amdgcn_exp2f((float)lf[(size_t)row * 512 + h * 128 + d]);
                F[idx] = f; Kk[idx] = 1.0f - f; V[idx] = bf2f(vb[(size_t)row * 512 + h * 128 + d]); Q[idx] = lat ? bf2f(qb[(size_t)row * 512 + h * 128 + d]) : 0.f; }
            __syncthreads();
            for (int j = 0; j < 64; ++j) { const float ve = V[j * 128 + e]; float part = 0.f;
#pragma unroll
                for (int i = 0; i < 32; ++i) { const int d = dg * 32 + i; S[i] = F[j * 128 + d] * S[i] + Kk[j * 128 + d] * ve; part += S[i] * Q[j * 128 + d]; }
                part += __shfl_xor(part, 1); part += __shfl_xor(part, 2);
                if (lat && dg == 0) { const int pp = (ci - 4) * 64 + j; const int row = b * SEQ + (dir ? SEQ - 1 - pp : pp); outp[(size_t)row * 512 + h * 128 + e] = f2bf(part); } }
        }
    }
}


typedef short bf16x8 __attribute__((ext_vector_type(8)));
constexpr int QROW = 136, TROW = 72;
__device__ __forceinline__ int hg_pos(int x) { return (x & ~31) + ((x >> 2) & 3) * 8 + ((x >> 4) & 1) * 4 + (x & 3); }
__device__ __forceinline__ pg8::f32x4 mfma16(bf16x8 a, bf16x8 b, pg8::f32x4 c) { return __builtin_amdgcn_mfma_f32_16x16x32_bf16(a, b, c, 0, 0, 0); }
__device__ __forceinline__ void phase_hgrn_mfma(const Params& p, const Ctx& c) {
    unsigned char* ws = p.ws;
    const bf16_t* vb = (const bf16_t*)(ws + WS_V); const bf16_t* qb = (const bf16_t*)(ws + WS_Q);
    constexpr int SET = 64 * QROW * 2 + 128 * TROW + 64 * TROW;
    LAS bf16_t* img = (LAS bf16_t*)c.lds;
    LAS float* Elb = (LAS float*)(img + 2 * SET);
    const int wid = c.wid, lane = c.lane, fr = lane & 15, fq = lane >> 4;
    const bool prep = wid < 4; const int aw = wid & 3;
    for (int it = c.vc; it < 256; it += gridDim.x) {
        const int dvh = (it >> 3) & 1, idx = (it & 7) | ((it >> 4) << 3), dir = idx & 1, h = (idx >> 1) & 3, b = idx >> 3;
        const f16_t* lf = (const f16_t*)(ws + (dir ? WS_LBW : WS_LFW)); bf16_t* outp = ((bf16_t*)p.out + (size_t)T * D + (dir ? (size_t)T * 512 : 0));
#define HG_ROW(ci_, p_) (((ci_) >= 4) ? (b * SEQ + (dir ? SEQ - 1 - (((ci_) - 4) * 64 + (p_)) : (((ci_) - 4) * 64 + (p_)))) : (T + b * CL + (dir ? CL - 1 - ((ci_) * 64 + (p_)) : ((ci_) * 64 + (p_)))))
        LAS float* qtb = Elb + 256;
        unsigned lfr[3][16], qr[3][16]; u32x4 vr[3][2];
        pg8::f32x4 S[8];
#pragma unroll
        for (int i = 0; i < 8; ++i) S[i] = (pg8::f32x4){0.f, 0.f, 0.f, 0.f};
        __syncthreads();
#define HG_LOAD(set_, ci_) do { const int cl_ = (ci_) < 36 ? (ci_) : 35;     \
            const int r0_ = HG_ROW(cl_, 16 * aw), q0_ = r0_ >= T ? r0_ - T : r0_;     \
            const char* pl_ = (const char*)(lf + (size_t)r0_ * 512 + colq); const char* pq_ = (const char*)(qb + (size_t)q0_ * 512 + colq); \
            const int st_ = dir ? -1024 : 1024;     \
            _Pragma("unroll") for (int i = 0; i < 16; ++i) { lfr[set_][i] = *(const unsigned*)(pl_ + i * st_); qr[set_][i] = *(const unsigned*)(pq_ + i * st_); } \
            const bf16_t* vs_ = vb + (size_t)(dir ? r0_ - (lanep >> 2) : r0_ + (lanep >> 2)) * 512 + colv; vr[set_][0] = *(const u32x4*)vs_; vr[set_][1] = *(const u32x4*)(vs_ + 8); } while (0)
#define HG_TOT(set_, ci_) do { { float t0 = 0.f, t1 = 0.f; \
            _Pragma("unroll") for (int i = 0; i < 16; ++i) { t0 += (float)__builtin_bit_cast(__fp16, (unsigned short)(lfr[set_][i] & 0xffffu)); t1 += (float)__builtin_bit_cast(__fp16, (unsigned short)(lfr[set_][i] >> 16)); } \
            qtb[(((ci_) & 1) * 4 + aw) * 128 + d0] = t0; qtb[(((ci_) & 1) * 4 + aw) * 128 + d0 + 1] = t1; } } while (0)
#define HG_EX2(x_) __builtin_amdgcn_exp2f(x_)
#define HG_PREP(set_, nset_, ci_, ld_) do { \
            LAS bf16_t* Qt = img + ((ci_) & 1) * SET; LAS bf16_t* Kt = Qt + 64 * QROW; LAS bf16_t* KhT = Kt + 64 * QROW; LAS bf16_t* VT = KhT + 128 * TROW; LAS float* El = Elb + ((ci_) & 1) * 128; \
            HG_TOT(nset_, (ci_) + 1); \
            float off0 = 0.f, off1 = 0.f, tot0 = 0.f, tot1 = 0.f; \
            _Pragma("unroll") for (int s_ = 0; s_ < 4; ++s_) { const float a0 = qtb[(((ci_) & 1) * 4 + s_) * 128 + d0], a1 = qtb[(((ci_) & 1) * 4 + s_) * 128 + d0 + 1]; tot0 += a0; tot1 += a1; if (s_ < aw) { off0 += a0; off1 += a1; } } \
            const float E0 = HG_EX2(tot0), E1 = HG_EX2(tot1); \
            if (aw == 0) { El[d0] = E0; El[d0 + 1] = E1; } \
            const int qpos = hg_pos(d0), base0 = 32 * (aw >> 1) + 4 * (aw & 1); float cu0 = off0, cu1 = off1, rp0 = HG_EX2(-off0), rp1 = HG_EX2(-off1);     \
            _Pragma("unroll") for (int q_ = 0; q_ < 4; ++q_) { float kh0[4], kh1[4]; \
                _Pragma("unroll") for (int r_ = 0; r_ < 4; ++r_) { const int i = 4 * q_ + r_, pp = 16 * aw + i; \
                    const float l0 = (float)__builtin_bit_cast(__fp16, (unsigned short)(lfr[set_][i] & 0xffffu)), l1 = (float)__builtin_bit_cast(__fp16, (unsigned short)(lfr[set_][i] >> 16)); \
                    cu0 += l0; cu1 += l1; \
                    const float e0 = HG_EX2(cu0), e1 = HG_EX2(cu1), r0 = HG_EX2(-cu0), r1 = HG_EX2(-cu1); \
                    const float k0 = r0 - rp0, k1 = r1 - rp1;     \
                    rp0 = r0; rp1 = r1; \
                    *(LAS unsigned*)(Kt + pp * QROW + qpos) = pk2(k0, k1); \
                    { const float q0 = __uint_as_float(qr[set_][i] << 16), q1 = __uint_as_float(qr[set_][i] & 0xffff0000u); *(LAS unsigned*)(Qt + pp * QROW + qpos) = pk2(q0 * e0, q1 * e1); }     \
                    kh0[r_] = k0 * E0; kh1[r_] = k1 * E1; } \
                u32x2 w; w.x = pk2(kh0[0], kh0[1]); w.y = pk2(kh0[2], kh0[3]); *(LAS u32x2*)(KhT + d0 * TROW + base0 + 8 * q_) = w; \
                w.x = pk2(kh1[0], kh1[1]); w.y = pk2(kh1[2], kh1[3]); *(LAS u32x2*)(KhT + (d0 + 1) * TROW + base0 + 8 * q_) = w; } \
            { const int sp = hg_pos(pv); const unsigned wv[8] = {vr[set_][0].x, vr[set_][0].y, vr[set_][0].z, vr[set_][0].w, vr[set_][1].x, vr[set_][1].y, vr[set_][1].z, vr[set_][1].w}; \
              _Pragma("unroll") for (int j = 0; j < 8; ++j) { VT[(e16 + 2 * j) * TROW + sp] = (bf16_t)(wv[j] & 0xffffu); VT[(e16 + 2 * j + 1) * TROW + sp] = (bf16_t)(wv[j] >> 16); } } \
            if (ld_) HG_LOAD(set_, (ci_) + 3); } while (0)
#if PROBE_HG_ROLE
        unsigned long long hgw = 0;
#define HG_BAR() do { asm volatile("s_waitcnt lgkmcnt(0)" ::: "memory"); const unsigned long long t0_ = __builtin_amdgcn_s_memrealtime(); __builtin_amdgcn_s_barrier(); asm volatile("" ::: "memory"); hgw += __builtin_amdgcn_s_memrealtime() - t0_; } while (0)
#else
#define HG_BAR() do { asm volatile("s_waitcnt lgkmcnt(0)" ::: "memory"); __builtin_amdgcn_s_barrier(); asm volatile("" ::: "memory"); } while (0)
#endif
        if (prep) {
            int lanep = lane; asm volatile("" : "+v"(lanep));
            const int d0 = 2 * lanep, colq = h * 128 + d0;
            const int pv = 16 * aw + (lanep >> 2), e16 = (lanep & 3) * 16, colv = h * 128 + dvh * 64 + e16;
            HG_LOAD(0, 0); HG_LOAD(1, 1); HG_LOAD(2, 2); HG_TOT(0, 0);
            HG_BAR();
            HG_PREP(0, 1, 0, 1);
            HG_BAR();
            for (int ci3 = 0; ci3 < 33; ci3 += 3) {
                HG_PREP(1, 2, ci3 + 1, 1);
                HG_BAR();
                HG_PREP(2, 0, ci3 + 2, 1);
                HG_BAR();
                HG_PREP(0, 1, ci3 + 3, 1);
                HG_BAR();
            }
            HG_PREP(1, 2, 34, 0);
            HG_BAR();
            HG_PREP(2, 0, 35, 0);
            HG_BAR();
            HG_BAR();
        } else {
            int frp = lane & 15, fqp = lane >> 4; asm volatile("" : "+v"(frp), "+v"(fqp)); const int fr = frp, fq = fqp;
            __builtin_amdgcn_s_waitcnt(0x0F70);
            HG_BAR(); HG_BAR();
#define HG_SB() __builtin_amdgcn_sched_barrier(0)
#define HG_KH(db_, a2_) (*(const LAS bf16x8*)(KhT + (16 * (db_) + fr) * TROW + 32 * (a2_) + 8 * fq))
#define HG_SUPD(db_) do { S[db_] = S[db_] * EL[db_]; S[db_] = mfma16(KH[2 * (db_)], VF[0], S[db_]); S[db_] = mfma16(KH[2 * (db_) + 1], VF[1], S[db_]); } while (0)
            for (int ci = 0; ci < 36; ++ci) {
                const bool lat = ci >= 4;
                const LAS bf16_t* Qt = img + (ci & 1) * SET; const LAS bf16_t* Kt = Qt + 64 * QROW; const LAS bf16_t* KhT = Kt + 64 * QROW; const LAS bf16_t* VT = KhT + 128 * TROW; const LAS float* El = Elb + (ci & 1) * 128;
                bf16x8 VF[2], KH[16]; pg8::f32x4 EL[8];
#pragma unroll
                for (int a2 = 0; a2 < 2; ++a2) VF[a2] = *(const LAS bf16x8*)(VT + (16 * aw + fr) * TROW + 32 * a2 + 8 * fq);
#pragma unroll
                for (int db = 0; db < 4; ++db) { EL[db] = *(const LAS pg8::f32x4*)(El + 16 * db + 4 * fq); KH[2 * db] = HG_KH(db, 0); KH[2 * db + 1] = HG_KH(db, 1); }
                HG_SB();
                bf16x8 SF[4];
#pragma unroll
                for (int k = 0; k < 4; ++k) { u32x4 w; w.x = pk2(S[2 * k][0], S[2 * k][1]); w.y = pk2(S[2 * k][2], S[2 * k][3]); w.z = pk2(S[2 * k + 1][0], S[2 * k + 1][1]); w.w = pk2(S[2 * k + 1][2], S[2 * k + 1][3]); SF[k] = __builtin_bit_cast(bf16x8, w); }
#pragma unroll
                for (int db = 4; db < 8; ++db) { EL[db] = *(const LAS pg8::f32x4*)(El + 16 * db + 4 * fq); KH[2 * db] = HG_KH(db, 0); KH[2 * db + 1] = HG_KH(db, 1); }
                HG_SB();
                HG_SUPD(0); HG_SUPD(1); HG_SUPD(2); HG_SUPD(3);
                if (lat) {
                    bf16x8 KF[16], QF[2][4];
#define HG_KQ(ti_) do { _Pragma("unroll") for (int k = 0; k < 4; ++k) { KF[4 * (ti_) + k] = *(const LAS bf16x8*)(Kt + (16 * (ti_) + fr) * QROW + 32 * k + 8 * fq); \
                        QF[(ti_) & 1][k] = *(const LAS bf16x8*)(Qt + (16 * (ti_) + fr) * QROW + 32 * k + 8 * fq); } } while (0)
                    HG_KQ(0);
                    HG_SB();
                    HG_SUPD(4); HG_SUPD(5); HG_SUPD(6); HG_SUPD(7);
#pragma unroll
                    for (int ti = 0; ti < 4; ++ti) {
                        if (ti < 3) HG_KQ(ti + 1);
                        HG_SB();
                        pg8::f32x4 o = (pg8::f32x4){0.f, 0.f, 0.f, 0.f};
#pragma unroll
                        for (int k = 0; k < 4; ++k) o = mfma16(SF[k], QF[ti & 1][k], o);
#pragma unroll
                        for (int a2 = 0; a2 < 2; ++a2) if (2 * a2 <= ti) {
                            pg8::f32x4 P[2];
#pragma unroll
                            for (int s2 = 0; s2 < 2; ++s2) { const int si = 2 * a2 + s2; pg8::f32x4 acc = (pg8::f32x4){0.f, 0.f, 0.f, 0.f};
                                if (si <= ti) {
#pragma unroll
                                    for (int k = 0; k < 4; ++k) acc = mfma16(KF[4 * si + k], QF[ti & 1][k], acc);
                                    if (si == ti) {
#pragma unroll
                                        for (int r = 0; r < 4; ++r) acc[r] = (4 * fq + r <= fr) ? acc[r] : 0.f; } }
                                P[s2] = acc; }
                            u32x4 w; w.x = pk2(P[0][0], P[0][1]); w.y = pk2(P[0][2], P[0][3]); w.z = pk2(P[1][0], P[1][1]); w.w = pk2(P[1][2], P[1][3]);
                            o = mfma16(VF[a2], __builtin_bit_cast(bf16x8, w), o); }
                        const int row = HG_ROW(ci, 16 * ti + fr);
                        u32x2 ow; ow.x = pk2(o[0], o[1]); ow.y = pk2(o[2], o[3]); *(u32x2*)(outp + (size_t)row * 512 + h * 128 + dvh * 64 + 16 * aw + 4 * fq) = ow;
                    }
#undef HG_KQ
                } else { HG_SUPD(4); HG_SUPD(5); HG_SUPD(6); HG_SUPD(7); }
                HG_BAR();
            }
#undef HG_SB
#undef HG_KH
#undef HG_SUPD
        }
#if PROBE_HG_ROLE
        if (blockIdx.x == 0 && wid == (PROBE_HG_ROLE == 1 ? 0 : 4) && lane == 0) ((unsigned long long*)(ws + WS_CTL + 16384))[17 * 256] = hgw;
#endif
#undef HG_BAR
#undef HG_LOAD
#undef HG_TOT
#undef HG_PREP
#undef HG_EX2
#undef HG_ROW
    }
}

constexpr int ZROW = 2056;
__device__ __forceinline__ void phase_hy_prepass(const Params& p, const Ctx& c) {
    bf16_t* hy = (bf16_t*)(p.ws + WS_HY);
    constexpr int PROW = 2064;
    LAS bf16_t* pl = (LAS bf16_t*)c.lds;
    if (c.tid < 8) { pl[c.tid * PROW + 3] = (bf16_t)0; pl[c.tid * PROW + 4 + SEQ] = (bf16_t)0; }
    for (int blk = blockIdx.x; blk < (NHY / 8) * NB; blk += gridDim.x) {
        bf16_t* base = hy + (size_t)blk * SEQ * 8; const int cg = blk / NB;
        u32x4 ch4[4];
#pragma unroll
        for (int i = 0; i < 4; ++i) ch4[i] = *(const u32x4*)(base + (size_t)(4 * c.tid + i) * 8);
        __syncthreads();
#pragma unroll
        for (int j = 0; j < 4; ++j) { const unsigned a = ch4[0][j], b = ch4[1][j], cc = ch4[2][j], d = ch4[3][j];
            u32x2 we, wo; we.x = (a & 0xffffu) | (b << 16); we.y = (cc & 0xffffu) | (d << 16); wo.x = (a >> 16) | (b & 0xffff0000u); wo.y = (cc >> 16) | (d & 0xffff0000u);
            *(LAS u32x2*)(pl + (2 * j) * PROW + 4 + 4 * c.tid) = we; *(LAS u32x2*)(pl + (2 * j + 1) * PROW + 4 + 4 * c.tid) = wo; }
        __syncthreads();
        const int ch = cg * 8 + c.wid; const float w0 = p.conv_w[ch], w1 = p.conv_w[NHY + ch], w2 = p.conv_w[2 * NHY + ch], cb = p.conv_b[ch];
        const LAS unsigned* rowd = (const LAS unsigned*)(pl + c.wid * PROW + 2);
#pragma unroll 4
        for (int k = 0; k < 16; ++k) { const int t = 2 * c.lane + 128 * k;
            const unsigned d0 = rowd[(t >> 1)], d1 = rowd[(t >> 1) + 1], d2 = rowd[(t >> 1) + 2];
            const float x0 = __uint_as_float(d0 & 0xffff0000u), x1 = __uint_as_float(d1 << 16), x2 = __uint_as_float(d1 & 0xffff0000u), x3 = __uint_as_float(d2 << 16);
            *(unsigned*)(base + (size_t)c.wid * SEQ + t) = pk2(cb + w0 * x0 + w1 * x1 + w2 * x2, cb + w0 * x1 + w1 * x2 + w2 * x3); }
    }
}
template <int KIND>
__device__ __forceinline__ void hy_block(pg8::f32x4 (&acc)[16], bf16x8 (&Bw)[16], const LAS bf16_t* zl, const LAS bf16_t* krl, int ub, int i0, int lane) {
    const int fr = lane & 15, fq = lane >> 4;
    const LAS bf16_t* bbase = zl + fr * ZROW + 8 * fq;
    const int abase = KR_OFF - 16 * i0 - fr + 8 * fq;
    const unsigned sh = (unsigned)(fr & 1) * 16u;
#pragma unroll
    for (int uu = 0; uu < 16; ++uu) {
        const int u = ub + uu;
        const bool ldb = KIND == 0 ? (uu >= 1) : (KIND == 1 ? true : (uu == 0));
        if (ldb) Bw[(uu + 15) & 15] = *(const LAS bf16x8*)(bbase + 32 * (u + 15));
        const LAS unsigned* ap = (const LAS unsigned*)(krl + ((abase + 32 * u) & ~1));
        const unsigned d0 = ap[0], d1 = ap[1], d2 = ap[2], d3 = ap[3], d4 = ap[4];
        u32x4 aw; aw.x = __builtin_amdgcn_alignbit(d1, d0, sh); aw.y = __builtin_amdgcn_alignbit(d2, d1, sh); aw.z = __builtin_amdgcn_alignbit(d3, d2, sh); aw.w = __builtin_amdgcn_alignbit(d4, d3, sh);
        const bf16x8 A = __builtin_bit_cast(bf16x8, aw);
#pragma unroll
        for (int m = 0; m < 16; ++m) { const bool on = KIND == 0 ? (m >= 16 - uu) : (KIND == 1 ? true : (m <= 15 - uu));
            if (on) acc[m] = __builtin_amdgcn_mfma_f32_16x16x32_bf16(A, Bw[(uu + m) & 15], acc[m], 0, 0, 0); }
    }
}
__device__ __forceinline__ void hy_dma_img(LAS bf16_t* dst, const bf16_t* hy, int chx, int wid, int lane) {
#pragma unroll
    for (int i = 0; i < 8; ++i) { const int pc = wid + 8 * i, b = pc >> 2, k = pc & 3;
        __builtin_amdgcn_global_load_lds((const unsigned*)(hy + ((((size_t)(chx >> 3) * NB + b) * 8 + (chx & 7)) * SEQ) + 512 * k + 8 * lane), (LAS unsigned*)(dst + b * ZROW + 512 * k), 16, 0, 0); }
}
__device__ __forceinline__ void hy_dma_kr(LAS bf16_t* dst, const bf16_t* src, int wid, int lane) {
    __builtin_amdgcn_global_load_lds((const unsigned*)(src + 512 * wid + 8 * lane), (LAS unsigned*)(dst + 512 * wid), 16, 0, 0);
    if (wid == 0 && lane < (KR_LEN - 4096) / 8) __builtin_amdgcn_global_load_lds((const unsigned*)(src + 4096 + 8 * lane), (LAS unsigned*)(dst + 4096), 16, 0, 0);
}
__device__ __forceinline__ void hy_conv(pg8::f32x4 (&acc)[16], const LAS bf16_t* zl, const LAS bf16_t* krl, int i0, int lane) {
    bf16x8 Bw[16];
#pragma unroll
    for (int m = 0; m < 16; ++m) { acc[m] = (pg8::f32x4){0.f, 0.f, 0.f, 0.f}; Bw[m] = (bf16x8){0, 0, 0, 0, 0, 0, 0, 0}; }
    hy_block<0>(acc, Bw, zl, krl, -16, i0, lane);
    for (int ub = 0; ub < 48; ub += 16) hy_block<1>(acc, Bw, zl, krl, ub, i0, lane);
    hy_block<2>(acc, Bw, zl, krl, 48, i0, lane);
}
__device__ __forceinline__ void hy_gate(u32x2 (&res)[16], const pg8::f32x4 (&acc)[16], const LAS bf16_t* zl, const bf16_t* grow, float bias, int i0, int fr, int fq) {
    u32x2 gg[16];
#pragma unroll
    for (int m = 0; m < 16; ++m) gg[m] = *(const u32x2*)(grow + 16 * (i0 + 2 * m) + 4 * fq);
#pragma unroll
    for (int m = 0; m < 16; ++m) { const int t = 16 * (i0 + 2 * m) + 4 * fq; const u32x2 zo = *(const LAS u32x2*)(zl + fr * ZROW + t);
        const float z0 = __uint_as_float(zo.x << 16), z1 = __uint_as_float(zo.x & 0xffff0000u), z2 = __uint_as_float(zo.y << 16), z3 = __uint_as_float(zo.y & 0xffff0000u);
        const float g0 = __uint_as_float(gg[m].x << 16), g1 = __uint_as_float(gg[m].x & 0xffff0000u), g2 = __uint_as_float(gg[m].y << 16), g3 = __uint_as_float(gg[m].y & 0xffff0000u);
        res[m].x = pk2(g0 * (acc[m][0] + bias * z0), g1 * (acc[m][1] + bias * z1)); res[m].y = pk2(g2 * (acc[m][2] + bias * z2), g3 * (acc[m][3] + bias * z3)); }
}
__device__ __forceinline__ void phase_hyena_mfma(const Params& p, const Ctx& c) {
    unsigned char* ws = p.ws;
    const bf16_t* hy = (const bf16_t*)(ws + WS_HY); const bf16_t* krev = (const bf16_t*)(ws + WS_KREV); bf16_t* zb = (bf16_t*)(ws + WS_ZB);
    LAS bf16_t* zA = (LAS bf16_t*)c.lds;
    LAS bf16_t* zB = zA + NB * ZROW;
    LAS bf16_t* krA = zB + NB * ZROW;
    LAS bf16_t* krB = krA + KR_LEN;
    const int i0 = 32 * (c.wid >> 1) + (c.wid & 1), fr = c.lane & 15, fq = c.lane >> 4;
    __syncthreads();
    if ((int)blockIdx.x < BW) { hy_dma_img(zA, hy, blockIdx.x, c.wid, c.lane); hy_dma_kr(krA, krev + (size_t)blockIdx.x * KR_LEN, c.wid, c.lane); }
    asm volatile("s_waitcnt vmcnt(0)" ::: "memory"); __syncthreads();
    for (int ch = blockIdx.x; ch < BW; ch += gridDim.x) {
        const int nch = ch + gridDim.x;
        pg8::f32x4 acc[16]; u32x2 res[16];
        hy_dma_kr(krB, krev + ((size_t)512 + ch) * KR_LEN, c.wid, c.lane);
        hy_conv(acc, zA, krA, i0, c.lane);
        { const int chx = 512 + ch; hy_gate(res, acc, zA, hy + ((((size_t)(chx >> 3) * NB + fr) * 8 + (chx & 7)) * SEQ), p.hy_bias[ch], i0, fr, fq); }
#pragma unroll
        for (int m = 0; m < 16; ++m) *(LAS u32x2*)(zB + fr * ZROW + 16 * (i0 + 2 * m) + 4 * fq) = res[m];
        asm volatile("s_waitcnt vmcnt(0)" ::: "memory"); __syncthreads();
        if (nch < BW) { hy_dma_img(zA, hy, nch, c.wid, c.lane); hy_dma_kr(krA, krev + (size_t)nch * KR_LEN, c.wid, c.lane); }
        hy_conv(acc, zB, krB, i0, c.lane);
        { const int chx = 1024 + ch; hy_gate(res, acc, zB, hy + ((((size_t)(chx >> 3) * NB + fr) * 8 + (chx & 7)) * SEQ), p.hy_bias[512 + ch], i0, fr, fq); }
#pragma unroll
        for (int m = 0; m < 16; ++m) *(u32x2*)(zb + ((size_t)ch * NB + fr) * SEQ + 16 * (i0 + 2 * m) + 4 * fq) = res[m];
        asm volatile("s_waitcnt vmcnt(0)" ::: "memory"); __syncthreads();
    }
}

__device__ __forceinline__ void phase_combine(const Params& p, const Ctx& c) {
    unsigned char* ws = p.ws;
    const bf16_t* ofw = ((const bf16_t*)p.out + (size_t)T * D); const bf16_t* obw = ((const bf16_t*)p.out + (size_t)T * D + (size_t)T * 512); const bf16_t* g = (const bf16_t*)(ws + WS_G);
    bf16_t* oab = (bf16_t*)(ws + WS_OA); const bf16_t* zb = (const bf16_t*)(ws + WS_ZB);
    { const int col = 8 * c.lane; float w[8]; load_f32x8(p.a_norm_w + (col & 127), w);
      for (int row0 = 4 * c.gw; row0 < T; row0 += 4 * c.ngw) { u32x4 ra[4], rb[4], rg[4];
#pragma unroll
        for (int r = 0; r < 4; ++r) { const size_t o = (size_t)(row0 + r) * 512 + col; ra[r] = __builtin_nontemporal_load((const u32x4*)(ofw + o)); rb[r] = __builtin_nontemporal_load((const u32x4*)(obw + o)); rg[r] = __builtin_nontemporal_load((const u32x4*)(g + o)); }
#pragma unroll
        for (int r = 0; r < 4; ++r) { float a[8], bq[8], gg[8], o[8]; unpack_bf16x8(ra[r], a); unpack_bf16x8(rb[r], bq); unpack_bf16x8(rg[r], gg);
            float s = 0.f;
#pragma unroll
            for (int j = 0; j < 8; ++j) { a[j] += bq[j]; s += a[j] * a[j]; }
            s += __shfl_xor(s, 1); s += __shfl_xor(s, 2); s += __shfl_xor(s, 4); s += __shfl_xor(s, 8);
            const float rs = __builtin_amdgcn_rsqf(s * (1.0f / 128.0f) + RMS_EPS);
#pragma unroll
            for (int j = 0; j < 8; ++j) o[j] = a[j] * rs * w[j] * gg[j];
            store_bf16x8(oab + (size_t)(row0 + r) * 1024 + col, o); } } }
    LAS bf16_t* tile = (LAS bf16_t*)c.lds;
    { const int cl = c.tid >> 3, t8 = (c.tid & 7) * 8, tl = c.tid >> 3, c8 = (c.tid & 7) * 8; constexpr int NIT = NB * 8 * 8;
      u32x4 w[4];
#define CB_LOAD(it_) do { const int cb_ = (it_) & 7, tq_ = ((it_) >> 3) & 7, b_ = (it_) >> 6; const bf16_t* src_ = zb + ((size_t)(cb_ * 64 + cl) * NB + b_) * SEQ + tq_ * 256 + t8; \
          _Pragma("unroll") for (int q = 0; q < 4; ++q) w[q] = *(const u32x4*)(src_ + 64 * q); } while (0)
      if ((int)blockIdx.x < NIT) CB_LOAD((int)blockIdx.x);
      for (int it = blockIdx.x; it < NIT; it += gridDim.x) { const int cb = it & 7, tq = (it >> 3) & 7, b = it >> 6;
        __syncthreads();
#pragma unroll
        for (int q = 0; q < 4; ++q) *(LAS u32x4*)(tile + q * 64 * 72 + cl * 72 + t8) = w[q];
        __syncthreads();
        if (it + (int)gridDim.x < NIT) CB_LOAD(it + (int)gridDim.x);
#pragma unroll
        for (int q = 0; q < 4; ++q) { bf16_t v[8];
#pragma unroll
          for (int i = 0; i < 8; ++i) v[i] = tile[q * 64 * 72 + (c8 + i) * 72 + tl];
          u32x4 o; o.x = v[0] | ((unsigned)v[1] << 16); o.y = v[2] | ((unsigned)v[3] << 16); o.z = v[4] | ((unsigned)v[5] << 16); o.w = v[6] | ((unsigned)v[7] << 16);
          *(u32x4*)(oab + ((size_t)b * SEQ + tq * 256 + q * 64 + tl) * 1024 + 512 + cb * 64 + c8) = o; }
      }
#undef CB_LOAD
    }
}

__device__ __forceinline__ void phase_rstd(const float* ssq, float* rstd, int nrows, const Ctx& c) {
    for (int row = blockIdx.x * NTHR + c.tid; row < nrows; row += gridDim.x * NTHR) rstd[row] = rstd_from_ssq(ssq + (size_t)row * 16);
}
__device__ __forceinline__ void phase_ctx_combine(const Params& p, const Ctx& c) {
    unsigned char* ws = p.ws;
    const bf16_t* part = (const bf16_t*)(ws + WS_PART); const bf16_t* hcb = (const bf16_t*)(ws + WS_HCB); const float* m = (const float*)(ws + WS_MODV) + (size_t)16 * MODW;
    bf16_t* a2 = (bf16_t*)(ws + WS_A2) + (size_t)T * D; float* rstd = (float*)(ws + WS_RSTD1) + T;
    float g[2][8], sc[2][8];
#pragma unroll
    for (int j = 0; j < 2; ++j) { load_f32x8(m + 2 * D + 8 * c.lane + 512 * j, g[j]); load_f32x8(m + 4 * D + 8 * c.lane + 512 * j, sc[j]); }
    for (int row = c.gw; row < TC; row += c.ngw) { float ss = 0.f;
#pragma unroll
        for (int j = 0; j < 2; ++j) { const size_t o = (size_t)row * D + 8 * c.lane + 512 * j; float p0[8], p1[8], hb[8], a[8];
            load_bf16x8(part + o, p0); load_bf16x8(part + (size_t)TC * D + o, p1); load_bf16x8(hcb + o, hb);
#pragma unroll
            for (int e = 0; e < 8; ++e) { const float h = hb[e] + 0.5f * g[j][e] * (p0[e] + p1[e]); ss += h * h; a[e] = h * (1.0f + sc[j][e]); }
            store_bf16x8(a2 + o, a); }
#pragma unroll
        for (int d = 1; d < 64; d <<= 1) ss += __shfl_xor(ss, d);
        if (c.lane == 0) rstd[row] = __builtin_amdgcn_rsqf(ss * (1.0f / D) + RMS_EPS); }
}
__device__ __forceinline__ void phase_final(const Params& p, const Ctx& c) {
    const float* ssq = (const float*)(p.ws + WS_SSQ3); const bf16_t* h3 = (const bf16_t*)(p.ws + WS_H3);
    float w[2][8]; load_f32x8(p.fnw + 8 * c.lane, w[0]); load_f32x8(p.fnw + 8 * c.lane + 512, w[1]);
    for (int row0 = 4 * c.gw; row0 < T; row0 += 4 * c.ngw) { u32x4 hr[4][2]; float rs[4];
#pragma unroll
        for (int r = 0; r < 4; ++r) { rs[r] = rstd_from_ssq(ssq + (size_t)(row0 + r) * 16); hr[r][0] = __builtin_nontemporal_load((const u32x4*)(h3 + (size_t)(row0 + r) * D + 8 * c.lane)); hr[r][1] = __builtin_nontemporal_load((const u32x4*)(h3 + (size_t)(row0 + r) * D + 8 * c.lane + 512)); }
#pragma unroll
        for (int r = 0; r < 4; ++r)
#pragma unroll
            for (int j = 0; j < 2; ++j) { float h[8], o[8]; unpack_bf16x8(hr[r][j], h);
#pragma unroll
                for (int i = 0; i < 8; ++i) o[i] = h[i] * rs[r] * w[j][i];
                { float* dst = p.out + (size_t)(row0 + r) * D + 8 * c.lane + 512 * j; __builtin_nontemporal_store((f32x4){o[0], o[1], o[2], o[3]}, (f32x4*)dst); __builtin_nontemporal_store((f32x4){o[4], o[5], o[6], o[7]}, (f32x4*)(dst + 4)); } } }
}


#define XB_TMO      128
#define XB_XCNT(j)  (256  + 64 * (j))
#define XB_XSUB(j)  (1280 + 64 * (j))
#define XB_XGEN(j)  (2304 + 64 * (j))
#define XB_TOP      3328
#define XB_TOPGEN   3392
#define XCD_BAR_WORDS 3456
#define XB_SPIN_CAP (1u << 18)
__device__ __forceinline__ unsigned xb_ld(unsigned* p)              { return __hip_atomic_load(p, __ATOMIC_RELAXED, __HIP_MEMORY_SCOPE_AGENT); }
__device__ __forceinline__ unsigned xb_add(unsigned* p, unsigned v) { return __hip_atomic_fetch_add(p, v, __ATOMIC_RELAXED, __HIP_MEMORY_SCOPE_AGENT); }
__device__ __forceinline__ unsigned xb_xcc_id() { return (unsigned)__builtin_amdgcn_s_getreg((3 << 11) | 20) & 0xFu; }
#define XB_SPIN(cond, bar) do { unsigned _sp = 0; while (cond) { __builtin_amdgcn_s_sleep(1); \
    if ((++_sp & 255u) == 0u) { if (xb_ld(&(bar)[XB_TMO])) break; if (_sp > XB_SPIN_CAP) { atomicAdd(&(bar)[XB_TMO], 1u); break; } } } } while (0)
struct XcdBarrier { unsigned* bar; unsigned x; volatile LAS unsigned* st; };
__device__ __forceinline__ XcdBarrier xcd_barrier_post(unsigned* bar, volatile LAS unsigned* st) {
    XcdBarrier b; b.bar = bar; b.x = xb_xcc_id(); b.st = st;
    if (threadIdx.x == 0) st[2] = xb_add(&bar[XB_XCNT(b.x)], 1u);
    return b;
}
__device__ __forceinline__ void xcd_barrier_complete(unsigned* bar, unsigned x, unsigned& nloc, unsigned& nx) {
    const unsigned G = gridDim.x * gridDim.y * gridDim.z;
    unsigned sum, cnt, mine, sp = 0u;
    for (;;) {
        sum = 0u; cnt = 0u; mine = 0u;
#pragma unroll
        for (unsigned j = 0; j < 16; ++j) { const unsigned c = xb_ld(&bar[XB_XCNT(j)]); sum += c; cnt += (c > 0u) ? 1u : 0u; mine = (j == x) ? c : mine; }
        if (sum == G) break;
        __builtin_amdgcn_s_sleep(1);
        if ((++sp & 255u) == 0u) { if (xb_ld(&bar[XB_TMO])) break; if (sp > XB_SPIN_CAP) { atomicAdd(&bar[XB_TMO], 1u); break; } }
    }
    nloc = mine > 0u ? mine : 1u; nx = cnt > 0u ? cnt : 1u;
}
__device__ __forceinline__ void xcd_barrier(const XcdBarrier& b) {
    asm volatile("s_waitcnt vmcnt(0)" ::: "memory");
    __syncthreads();
    if (threadIdx.x == 0) {
        unsigned* bar = b.bar;
        __builtin_amdgcn_s_waitcnt(0);
        unsigned nloc = b.st[0], nx = b.st[1];
        if (nloc == 0u) { xcd_barrier_complete(bar, b.x, nloc, nx); b.st[0] = nloc; b.st[1] = nx; }
        const unsigned old = xb_add(&bar[XB_XSUB(b.x)], 1u);
        const unsigned gen = old / nloc;
        if (old + 1u == (gen + 1u) * nloc) {
            __builtin_amdgcn_fence(__ATOMIC_RELEASE, "agent");
            asm volatile("s_waitcnt vmcnt(0)" ::: "memory");
            const unsigned og = xb_add(&bar[XB_TOP], 1u);
            const unsigned tg = og / nx;
            if (og + 1u == (tg + 1u) * nx) xb_add(&bar[XB_TOPGEN], 1u);
            else XB_SPIN(xb_ld(&bar[XB_TOPGEN]) == tg, bar);
            __builtin_amdgcn_fence(__ATOMIC_ACQUIRE, "agent");
            xb_add(&bar[XB_XGEN(b.x)], 1u);
            asm volatile("s_waitcnt vmcnt(0)" ::: "memory");
        } else {
            XB_SPIN(xb_ld(&bar[XB_XGEN(b.x)]) == gen, bar);
            __builtin_amdgcn_fence(__ATOMIC_ACQUIRE, "agent");
            asm volatile("s_waitcnt vmcnt(0)" ::: "memory");
        }
    }
    __syncthreads();
}

constexpr int N_PHASES = 15;
#ifndef REPEAT_MASK
#define REPEAT_MASK 0
#endif
#ifndef HOST_REPEAT_MASK
#define HOST_REPEAT_MASK 0
#endif
#ifndef USE_XCD_BARRIER
#define USE_XCD_BARRIER 1
#endif
__global__ void __launch_bounds__(NTHR, 2) fwd_kernel(Params p) {
    extern __shared__ __attribute__((aligned(16))) unsigned char lds_raw[];
    Ctx c; c.lds = (LAS unsigned char*)lds_raw; c.tid = threadIdx.x; c.lane = c.tid & 63; c.wid = __builtin_amdgcn_readfirstlane(c.tid >> 6);
    c.gw = blockIdx.x * NWAVES + c.wid; c.ngw = gridDim.x * NWAVES; c.vc = blockIdx.x;
    unsigned char* ws = p.ws;
    const float* modv = (const float*)(ws + WS_MODV);
#if N_LAUNCH_MODE == 1
    cg::grid_group grid = cg::this_grid();
#if USE_XCD_BARRIER
    volatile LAS unsigned* xst = (volatile LAS unsigned*)(c.lds + LDS_BYTES - 16);
    if (c.tid < 4) xst[c.tid] = 0u;
    __syncthreads();
    XcdBarrier xbar = xcd_barrier_post((unsigned*)(ws + WS_CTL), xst);
    bool first_seam = true;
#define SEAM() do { if (first_seam) { if (p.ph_lo < 0) grid.sync();   xcd_barrier(xbar); first_seam = false; \
        if (c.tid == 0) { unsigned* bar_ = (unsigned*)(ws + WS_CTL); bool ok_ = (gridDim.x % 8u) == 0u; for (unsigned j_ = 0; j_ < 16; ++j_) { const unsigned n_ = xb_ld(&bar_[XB_XCNT(j_)]); ok_ = ok_ && (j_ < 8 ? n_ == gridDim.x / 8u : n_ == 0u); } \
            xst[3] = ok_ ? (xst[2] * 8u + xbar.x) : blockIdx.x; } \
        __syncthreads(); c.vc = (int)xst[3]; } else xcd_barrier(xbar); } while (0)
#else
#define SEAM() grid.sync()
#endif
#else
#define SEAM() do { } while (0)
#endif
#ifdef ONLY_PHASE
#define IN(k) ((k) == ONLY_PHASE && p.ph_lo <= (k) && (k) < p.ph_hi)
#else
#define IN(k) (p.ph_lo <= (k) && (k) < p.ph_hi)
#endif
#if PROBE_TS_MASK
#define TS_STAMP(k) do { if (c.tid == 0) ((unsigned long long*)(ws + WS_CTL + 16384))[(k) * 256 + blockIdx.x] = __builtin_amdgcn_s_memrealtime(); } while (0)
#else
#define TS_STAMP(k) do { } while (0)
#endif
#define PHASE(k, ...) if (IN(k)) { for (int rep_ = 0; rep_ <= ((REPEAT_MASK >> (k)) & 1); ++rep_) { __VA_ARGS__; if (rep_ < ((REPEAT_MASK >> (k)) & 1)) SEAM(); } TS_STAMP(k); if (IN((k) + 1)) SEAM(); }
    TS_STAMP(16);
#if USE_PG8
#define GEMM2(A_, Bt_, K_, nrows1_, npn1_, nrows2_, npn2_, E_, ssq_) gemm_mfma(c.lds, c.vc, A_, Bt_, K_, nrows1_, npn1_, nrows2_, npn2_, E_, ssq_)
#else
#define GEMM2(A_, Bt_, K_, nrows1_, npn1_, nrows2_, npn2_, E_, ssq_) do { gemm_simple(c.lds, A_, Bt_, K_, 0, nrows1_, npn1_, E_, ssq_); if ((nrows2_) > 0) gemm_simple(c.lds, A_, Bt_, K_, nrows1_, nrows2_, npn2_, E_, ssq_); } while (0)
#endif
#define GEMM(A_, Bt_, K_, nrows_, npn_, E_, ssq_) GEMM2(A_, Bt_, K_, nrows_, npn_, 0, 0, E_, ssq_)
    PHASE(0, phase_prep(p, c))
    PHASE(1, phase_n1(p, c))
    PHASE(2, { EpiGateUp1 E{(bf16_t*)(ws + WS_HID)};
        GEMM((const bf16_t*)(ws + WS_N1), (const bf16_t*)(ws + WS_WG1_T), D, MT, NGU / 256, E, nullptr);
        VGrid g; if (filler_grid(g, c.vc, (MT / 256) * (NGU / 256))) { task_transposes_b(p, c, g); task_shift_gemv(p, c, g, 0); } })
    PHASE(3, { if (PROBE_P3_CUT) TS_SUB(p, 18); EpiDown1 E{(const bf16_t*)(ws + WS_HCB), modv, (bf16_t*)p.out, (bf16_t*)(ws + WS_A2)};
        GEMM((const bf16_t*)(ws + WS_HID), (const bf16_t*)(ws + WS_WD1_T), DFF, T, D / 256, E, (float*)(ws + WS_SSQ1));
        gemm_splitk(c.lds, c.vc, (const bf16_t*)(ws + WS_HID) + (size_t)T * DFF, (const bf16_t*)(ws + WS_WD1_T), DFF, TC, D / 256, (bf16_t*)(ws + WS_PART));
        VGrid g; if (filler_grid(g, c.vc, 2 * (TC / 256) * (D / 256))) { task_transposes_c(p, c, g); if (PROBE_P3_CUT == 1) TS_SUB(p, 18); task_shift_gemv(p, c, g, 1); if (PROBE_P3_CUT == 2) TS_SUB(p, 18); task_filters(p, c, g, 0, 128); if (PROBE_P3_CUT == 3) TS_SUB(p, 18); } })
    PHASE(4, { phase_rstd((const float*)(ws + WS_SSQ1), (float*)(ws + WS_RSTD1), T, c); phase_ctx_combine(p, c); })
    PHASE(5, { EpiWin E{(const float*)(ws + WS_RSTD1), (const float*)(ws + WS_SWIN), (const float*)(ws + WS_LBV), (bf16_t*)(ws + WS_V), (bf16_t*)(ws + WS_Q), (bf16_t*)(ws + WS_G), (bf16_t*)(ws + WS_HY), (bf16_t*)(ws + WS_GAB), (f16_t*)(ws + WS_LFW), (f16_t*)(ws + WS_LBW)};
        GEMM2((const bf16_t*)(ws + WS_A2), (const bf16_t*)(ws + WS_WIN_T), D, T, NIN / 256, TC, 6, E, nullptr);
        VGrid g; if (filler_grid(g, c.vc, (T / 256) * (NIN / 256) + (TC / 256) * 6)) { task_filters(p, c, g, 128, 256); __syncthreads(); task_transposes_d(p, c, g); } })
    PHASE(6, { const bool pre_first = ((c.vc >> 4) & 1) != 0;
        _Pragma("nounroll") for (int step = 0; step < 2; ++step) {
            if ((step == 0) == pre_first) phase_hy_prepass(p, c);
            else { if (USE_MFMA_HGRN) phase_hgrn_mfma(p, c); else phase_hgrn_simple(p, c); TS_STAMP(15); }
            __syncthreads(); } })
    PHASE(7, phase_hyena_mfma(p, c))
    PHASE(8, phase_combine(p, c))
    PHASE(9, { EpiProj E{(const bf16_t*)(ws + WS_GAB), (bf16_t*)(ws + WS_Y)};
        gemm_pair(c.lds, c.vc, (const bf16_t*)(ws + WS_OA), (const bf16_t*)(ws + WS_WPA_T), 512, T, D / 256, E); })
    PHASE(10, { EpiWout E{modv, (bf16_t*)p.out, (bf16_t*)(ws + WS_A3)};
        GEMM((const bf16_t*)(ws + WS_Y), (const bf16_t*)(ws + WS_WOUT_T), D, T, D / 256, E, (float*)(ws + WS_SSQ2)); })
    PHASE(11, phase_rstd((const float*)(ws + WS_SSQ2), (float*)(ws + WS_RSTD2), T, c))
    PHASE(12, { EpiGateUp2 E{(bf16_t*)(ws + WS_HID2), (const float*)(ws + WS_RSTD2), (const float*)(ws + WS_SW2)};
        GEMM((const bf16_t*)(ws + WS_A3), (const bf16_t*)(ws + WS_WG2_T), D, T, NGU / 256, E, nullptr); })
    PHASE(13, { EpiDown2 E{modv, (const bf16_t*)p.out, (bf16_t*)(ws + WS_H3)};
        GEMM((const bf16_t*)(ws + WS_HID2), (const bf16_t*)(ws + WS_WD2_T), DFF, T, D / 256, E, (float*)(ws + WS_SSQ3)); })
    PHASE(14, phase_final(p, c))
#if PROBE_TS_MASK
    SEAM();
    if (blockIdx.x == 0 && c.tid == 0) {
        const unsigned long long* ts = (const unsigned long long*)(ws + WS_CTL + 16384); unsigned long long tot = 0;
        for (int k = 0; k < 19; ++k) if (((PROBE_TS_MASK >> k) & 1) && k != 16 && k != 17) { unsigned long long a = 0, b = 0; const int kp = k == 0 ? 16 : (k == 15 ? 5 : (k == 18 ? (PROBE_P3_CUT ? 2 : 16) : k - 1));
            for (int w = 0; w < (int)gridDim.x; ++w) { const unsigned long long x = __hip_atomic_load(ts + k * 256 + w, __ATOMIC_RELAXED, __HIP_MEMORY_SCOPE_AGENT), y = __hip_atomic_load(ts + kp * 256 + w, __ATOMIC_RELAXED, __HIP_MEMORY_SCOPE_AGENT); a = x > a ? x : a; b = y > b ? y : b; }
            tot += a - b; }
#if PROBE_HG_ROLE
        tot = __hip_atomic_load(ts + 17 * 256, __ATOMIC_RELAXED, __HIP_MEMORY_SCOPE_AGENT);
#endif
        const unsigned long long t0 = __builtin_amdgcn_s_memrealtime();
        while (__builtin_amdgcn_s_memrealtime() - t0 < tot * 8ull) __builtin_amdgcn_s_sleep(8);
    }
#endif
}

extern "C" void kernel_launch(void* const* d_in, const int* in_sizes, int n_in, void* d_out, int out_size, void* d_ws, size_t ws_size, hipStream_t stream) {
    static int grid = 0;
    if (grid == 0) {
        if (n_in != 26 || in_sizes[0] != T * D || out_size != T * D || ws_size < WS_TOTAL) { fprintf(stderr, "kernel_launch: unexpected shapes (n_in %d, in0 %d, out %d, ws %zu < %zu)\n", n_in, n_in > 0 ? in_sizes[0] : -1, out_size, ws_size, (size_t)WS_TOTAL); grid = -1; return; }
        int dev = 0, cus = 0, per_cu = 0;
        (void)hipGetDevice(&dev); (void)hipDeviceGetAttribute(&cus, hipDeviceAttributeMultiprocessorCount, dev);
        if (hipFuncSetAttribute((const void*)fwd_kernel, hipFuncAttributeMaxDynamicSharedMemorySize, LDS_BYTES) != hipSuccess) { fprintf(stderr, "kernel_launch: hipFuncSetAttribute failed\n"); grid = -1; return; }
        (void)hipOccupancyMaxActiveBlocksPerMultiprocessor(&per_cu, (const void*)fwd_kernel, NTHR, LDS_BYTES);
        if (per_cu < 1) { fprintf(stderr, "kernel_launch: occupancy query says %d blocks per CU\n", per_cu); per_cu = 1; }
        (void)hipGetLastError();
        grid = cus;
    }
    if (grid < 0) return;
    Params p{};
    const float** f = (const float**)&p;
    for (int i = 0; i < 26; ++i) f[i] = (const float*)d_in[i];
    p.out = (float*)d_out; p.ws = (unsigned char*)d_ws;
#if N_LAUNCH_MODE == 1
    p.ph_lo = 0; p.ph_hi = N_PHASES;
#if USE_XCD_BARRIER
    (void)hipMemsetAsync((unsigned char*)d_ws + WS_CTL, 0, XCD_BAR_WORDS * 4, stream);
#endif
    void* args[] = {&p};
    hipError_t e = hipLaunchCooperativeKernel((const void*)fwd_kernel, dim3(grid), dim3(NTHR), args, LDS_BYTES, stream);
    if (e != hipSuccess) fprintf(stderr, "cooperative launch failed: %s (grid %d)\n", hipGetErrorString(e), grid);
#else
    for (int k = 0; k < N_PHASES; ++k) { p.ph_lo = k; p.ph_hi = k + 1; for (int r = 0; r <= ((HOST_REPEAT_MASK >> k) & 1); ++r) hipLaunchKernelGGL(fwd_kernel, dim3(grid), dim3(NTHR), LDS_BYTES, stream, p); }
#endif
}
```
